# Optimizing an MI355X kernel written in HIP

```python
import math
import jax, jax.numpy as jnp
from jax import lax
import numpy as np

D_MODEL = 1024
BATCH = 4
SEQ = 8192
DEPTH = 2

N_EVEN = (DEPTH + 1) // 2
N_ODD = DEPTH // 2

GDN_HEAD_DIM = 128
GDN_WIDTH = D_MODEL // 2
GDN_HEADS = GDN_WIDTH // GDN_HEAD_DIM
CONV_K = 4
CHUNK = 64

S5_WIDTH = D_MODEL - GDN_WIDTH
S5_GROUP = 16
S5_GROUPS = S5_WIDTH // S5_GROUP
S5_STATE = 64

SB_HEAD_DIM = 128
SB_HEADS = D_MODEL // SB_HEAD_DIM
QBLOCK = 128

FFN_HIDDEN = -(-8 * D_MODEL // (3 * 256)) * 256

EVEN_IN = 4 * GDN_WIDTH + 2 * GDN_HEADS + S5_WIDTH
NORM_EPS = 1e-6

kernel_name = "hybrid_gdn_s5_stickbreak_adaln"


def rms_norm(x, w):
    xf = x.astype(jnp.float32)
    y = xf * lax.rsqrt(jnp.mean(xf * xf, axis=-1, keepdims=True) + NORM_EPS)
    return y.astype(x.dtype) * w


def l2_normalize(x):
    return x * lax.rsqrt(jnp.sum(x * x, axis=-1, keepdims=True) + NORM_EPS)


def causal_depthwise_conv(x, w):
    k_len, ch = w.shape
    return lax.conv_general_dilated(x, w[:, None, :].astype(x.dtype), window_strides=(1,),
                                    padding=[(k_len - 1, 0)],
                                    dimension_numbers=('NWC', 'WIO', 'NWC'),
                                    feature_group_count=ch)


def gated_delta_rule_chunked(q, k, v, g, beta):
    bsz, seq, nh, dk = q.shape
    dv = v.shape[-1]
    n = seq // CHUNK

    def to_chunks(t):
        return t.reshape(bsz, n, CHUNK, nh, -1).transpose(0, 3, 1, 2, 4)

    q, k, v = to_chunks(q), to_chunks(k), to_chunks(v)
    g = to_chunks(g[..., None])[..., 0]
    beta = to_chunks(beta[..., None])[..., 0]
    gc = jnp.cumsum(g, axis=-1)
    idx = jnp.arange(CHUNK)
    incl = idx[:, None] >= idx[None, :]
    strict = idx[:, None] > idx[None, :]
    decay = jnp.exp(jnp.where(incl, gc[..., :, None] - gc[..., None, :], -jnp.inf))

    k_beta = k * beta[..., None]
    lower = jnp.where(strict, jnp.einsum('bhnid,bhnjd->bhnij', k_beta, k) * decay, 0.0)
    lhs = lower + jnp.eye(CHUNK, dtype=lower.dtype)
    rhs = jnp.concatenate([v * beta[..., None], k_beta * jnp.exp(gc)[..., None]], axis=-1)
    sol = lax.linalg.triangular_solve(lhs, rhs, left_side=True, lower=True, unit_diagonal=True)
    u, w = sol[..., :dv], sol[..., dv:]

    attn = jnp.einsum('bhnid,bhnjd->bhnij', q, k) * decay
    q_dec = q * jnp.exp(gc)[..., None]
    g_last = gc[..., -1:]
    k_dec = k * jnp.exp(g_last - gc)[..., None]
    state_decay = jnp.exp(g_last[..., 0])

    xs = tuple(jnp.moveaxis(t, 2, 0) for t in (q_dec, k_dec, u, w, attn, state_decay))

    def step(state, inp):
        qd, kd, ui, wi, ai, sd = inp
        v_new = ui - jnp.einsum('bhck,bhkv->bhcv', wi, state)
        o = jnp.einsum('bhck,bhkv->bhcv', qd, state) + jnp.einsum('bhcs,bhsv->bhcv', ai, v_new)
        state = state * sd[..., None, None] + jnp.einsum('bhck,bhcv->bhkv', kd, v_new)
        return state, o

    s0 = jnp.zeros((bsz, nh, dk, dv), jnp.float32)
    _, o = lax.scan(step, s0, xs)
    return o.transpose(1, 0, 3, 2, 4).reshape(bsz, seq, nh, dv)


def s5_layer(u, lam_re, lam_im, log_dt, b_re, b_im, c_re, c_im, d_skip, glu_w, glu_b):
    f32 = jnp.float32
    bsz, seq, _ = u.shape
    uf = u.astype(f32).reshape(bsz, seq, S5_GROUPS, S5_GROUP)
    lr, li = lam_re.astype(f32), lam_im.astype(f32)
    dt = jnp.exp(log_dt.astype(f32))[:, None]
    mag = jnp.exp(lr * dt)
    lb_re, lb_im = mag * jnp.cos(li * dt), mag * jnp.sin(li * dt)
    den = lr * lr + li * li
    num_re, num_im = lb_re - 1.0, lb_im
    f_re = (num_re * lr + num_im * li) / den
    f_im = (num_im * lr - num_re * li) / den
    br, bi = b_re.astype(f32), b_im.astype(f32)
    bb_re = f_re[..., None] * br - f_im[..., None] * bi
    bb_im = f_re[..., None] * bi + f_im[..., None] * br
    bu_re = jnp.einsum('blgh,gph->lbgp', uf, bb_re)
    bu_im = jnp.einsum('blgh,gph->lbgp', uf, bb_im)
    a_re = jnp.broadcast_to(lb_re, (seq, 1, S5_GROUPS, S5_STATE))
    a_im = jnp.broadcast_to(lb_im, (seq, 1, S5_GROUPS, S5_STATE))

    def combine(e1, e2):
        a1r, a1i, b1r, b1i = e1
        a2r, a2i, b2r, b2i = e2
        return (a1r * a2r - a1i * a2i, a1r * a2i + a1i * a2r,
                a2r * b1r - a2i * b1i + b2r, a2r * b1i + a2i * b1r + b2i)

    _, _, xr, xi = lax.associative_scan(combine, (a_re, a_im, bu_re, bu_im), axis=0)
    y = (jnp.einsum('lbgp,ghp->blgh', xr, c_re.astype(f32))
         - jnp.einsum('lbgp,ghp->blgh', xi, c_im.astype(f32))
         + d_skip.astype(f32).reshape(S5_GROUPS, S5_GROUP) * uf)
    y = jax.nn.gelu(y.reshape(bsz, seq, S5_WIDTH))
    y = y * jax.nn.sigmoid(y @ glu_w.astype(f32) + glu_b.astype(f32))
    return y.astype(u.dtype)


def even_mixer(h, w_in, conv_w, a_log, dt_bias, head_norm_w, lam_re, lam_im, log_dt,
               b_re, b_im, c_re, c_im, d_skip, glu_w, glu_b, w_out):
    bsz, seq, _ = h.shape
    W, H = GDN_WIDTH, GDN_HEADS
    proj = h @ w_in
    qkv = jax.nn.silu(causal_depthwise_conv(proj[..., :3 * W], conv_w))
    z = proj[..., 3 * W:4 * W]
    b_lin = proj[..., 4 * W:4 * W + H]
    a_lin = proj[..., 4 * W + H:4 * W + 2 * H]
    u = proj[..., 4 * W + 2 * H:]

    f32 = jnp.float32
    q, k, v = (t.astype(f32).reshape(bsz, seq, H, GDN_HEAD_DIM) for t in jnp.split(qkv, 3, axis=-1))
    q = l2_normalize(q) * (GDN_HEAD_DIM ** -0.5)
    k = l2_normalize(k)
    beta = jax.nn.sigmoid(b_lin.astype(f32))
    g = -jnp.exp(a_log.astype(f32)) * jax.nn.softplus(a_lin.astype(f32) + dt_bias.astype(f32))
    o = gated_delta_rule_chunked(q, k, v, g, beta)
    o = rms_norm(o, head_norm_w.astype(f32)) * jax.nn.silu(z.astype(f32).reshape(bsz, seq, H, GDN_HEAD_DIM))
    o = o.reshape(bsz, seq, W).astype(h.dtype)

    y_s5 = s5_layer(u, lam_re, lam_im, log_dt, b_re, b_im, c_re, c_im, d_skip, glu_w, glu_b)
    return jnp.concatenate([o, y_s5], axis=-1) @ w_out


def stick_breaking_attention(q, k, v):
    bsz, seq, nh, d = q.shape
    nb = seq // QBLOCK
    f32 = jnp.float32
    scale = d ** -0.5
    qb = q.astype(f32).reshape(bsz, nb, QBLOCK, nh, d).transpose(1, 0, 3, 2, 4)
    kh = k.astype(f32).transpose(0, 2, 1, 3)
    vh = v.astype(f32).transpose(0, 2, 1, 3)
    key_pos = jnp.arange(seq)

    def block(args):
        qi, bi = args
        q_pos = bi * QBLOCK + jnp.arange(QBLOCK)
        z = jnp.einsum('bhqd,bhkd->bhqk', qi, kh) * scale
        valid = key_pos[None, :] < q_pos[:, None]
        log_1m = jnp.where(valid, jax.nn.log_sigmoid(-z), 0.0)
        between = lax.cumsum(log_1m, axis=3, reverse=True) - log_1m
        wts = jnp.where(valid, jnp.exp(jax.nn.log_sigmoid(z) + between), 0.0)
        return jnp.einsum('bhqk,bhkd->bhqd', wts, vh)

    o = lax.map(block, (qb, jnp.arange(nb)))
    return o.transpose(1, 0, 3, 2, 4).reshape(bsz, seq, nh, d).astype(q.dtype)


def odd_mixer(h, w_in, w_out):
    bsz, seq, _ = h.shape
    q, k, v = (t.reshape(bsz, seq, SB_HEADS, SB_HEAD_DIM) for t in jnp.split(h @ w_in, 3, axis=-1))
    o = stick_breaking_attention(q, k, v)
    return o.reshape(bsz, seq, D_MODEL) @ w_out


def swiglu(h, w_in, w_out):
    gate, up = jnp.split(h @ w_in, 2, axis=-1)
    return (jax.nn.silu(gate) * up) @ w_out


def setup_inputs(seed: int = 0) -> dict:
    key = jax.random.key(seed)
    ks = iter(jax.random.split(key, 32))
    f32 = jnp.float32
    D, F = D_MODEL, FFN_HIDDEN
    G, P, Hs = S5_GROUPS, S5_STATE, S5_GROUP

    def nrm(shape, scale):
        return scale * jax.random.normal(next(ks), shape, f32)

    def unif(shape, lo, hi):
        return jax.random.uniform(next(ks), shape, f32, lo, hi)

    x = nrm((BATCH, SEQ, D), 1.0)
    c = nrm((BATCH, D), 1.0)
    ada_w = nrm((DEPTH, D, 6 * D), D ** -0.5)
    ada_b = nrm((DEPTH, 6 * D), 0.02)
    norm_mix_w = 1.0 + nrm((DEPTH, D), 0.02)
    norm_ffn_w = 1.0 + nrm((DEPTH, D), 0.02)
    ffn_w_in = nrm((DEPTH, D, 2 * F), D ** -0.5)
    ffn_w_out = nrm((DEPTH, F, D), F ** -0.5)

    hy_w_in = nrm((N_EVEN, D, EVEN_IN), D ** -0.5)
    hy_conv_w = nrm((N_EVEN, CONV_K, 3 * GDN_WIDTH), CONV_K ** -0.5)
    hy_a_log = jnp.log(unif((N_EVEN, GDN_HEADS), 1.0, 16.0))
    dt = jnp.exp(unif((N_EVEN, GDN_HEADS), math.log(1e-3), math.log(1e-1)))
    hy_dt_bias = dt + jnp.log(-jnp.expm1(-dt))
    hy_head_norm_w = 1.0 + nrm((N_EVEN, GDN_HEAD_DIM), 0.02)
    s5_lam_re = -0.5 + nrm((N_EVEN, G, P), 0.01)
    s5_lam_im = jnp.pi * jnp.arange(P, dtype=f32) + nrm((N_EVEN, G, P), 0.01)
    s5_log_dt = unif((N_EVEN, G), math.log(1e-3), math.log(1e-1))
    s5_b_re = nrm((N_EVEN, G, P, Hs), (2 * Hs) ** -0.5)
    s5_b_im = nrm((N_EVEN, G, P, Hs), (2 * Hs) ** -0.5)
    s5_c_re = nrm((N_EVEN, G, Hs, P), 0.5)
    s5_c_im = nrm((N_EVEN, G, Hs, P), 0.5)
    s5_d = nrm((N_EVEN, S5_WIDTH), 1.0)
    s5_glu_w = nrm((N_EVEN, S5_WIDTH, S5_WIDTH), S5_WIDTH ** -0.5)
    s5_glu_b = nrm((N_EVEN, S5_WIDTH), 0.02)
    hy_w_out = nrm((N_EVEN, D, D), D ** -0.5)

    sb_w_in = nrm((N_ODD, D, 3 * D), D ** -0.5)
    sb_w_out = nrm((N_ODD, D, D), D ** -0.5)
    final_norm_w = 1.0 + nrm((D,), 0.02)
    return {"x": x, "c": c, "ada_w": ada_w, "ada_b": ada_b,
            "norm_mix_w": norm_mix_w, "norm_ffn_w": norm_ffn_w,
            "ffn_w_in": ffn_w_in, "ffn_w_out": ffn_w_out,
            "hy_w_in": hy_w_in, "hy_conv_w": hy_conv_w, "hy_a_log": hy_a_log,
            "hy_dt_bias": hy_dt_bias, "hy_head_norm_w": hy_head_norm_w,
            "s5_lam_re": s5_lam_re, "s5_lam_im": s5_lam_im, "s5_log_dt": s5_log_dt,
            "s5_b_re": s5_b_re, "s5_b_im": s5_b_im, "s5_c_re": s5_c_re, "s5_c_im": s5_c_im,
            "s5_d": s5_d, "s5_glu_w": s5_glu_w, "s5_glu_b": s5_glu_b, "hy_w_out": hy_w_out,
            "sb_w_in": sb_w_in, "sb_w_out": sb_w_out, "final_norm_w": final_norm_w}


def reference(x, c, ada_w, ada_b, norm_mix_w, norm_ffn_w, ffn_w_in, ffn_w_out,
              hy_w_in, hy_conv_w, hy_a_log, hy_dt_bias, hy_head_norm_w,
              s5_lam_re, s5_lam_im, s5_log_dt, s5_b_re, s5_b_im, s5_c_re, s5_c_im,
              s5_d, s5_glu_w, s5_glu_b, hy_w_out, sb_w_in, sb_w_out, final_norm_w):
    h = x
    c_act = jax.nn.silu(c)
    for i in range(DEPTH):
        mod = (c_act @ ada_w[i] + ada_b[i])[:, None, :]
        sh_m, sc_m, gt_m, sh_f, sc_f, gt_f = jnp.split(mod, 6, axis=-1)
        hn = rms_norm(h, norm_mix_w[i]) * (1.0 + sc_m) + sh_m
        j = i // 2
        if i % 2 == 0:
            y = even_mixer(hn, hy_w_in[j], hy_conv_w[j], hy_a_log[j], hy_dt_bias[j], hy_head_norm_w[j],
                           s5_lam_re[j], s5_lam_im[j], s5_log_dt[j], s5_b_re[j], s5_b_im[j],
                           s5_c_re[j], s5_c_im[j], s5_d[j], s5_glu_w[j], s5_glu_b[j], hy_w_out[j])
        else:
            y = odd_mixer(hn, sb_w_in[j], sb_w_out[j])
        h = h + gt_m * y
        hn = rms_norm(h, norm_ffn_w[i]) * (1.0 + sc_f) + sh_f
        h = h + gt_f * swiglu(hn, ffn_w_in[i], ffn_w_out[i])
    return rms_norm(h, final_norm_w)
```

```cpp
#include <hip/hip_runtime.h>
#include <hip/hip_cooperative_groups.h>
#include <stdint.h>
#include <cstdio>
namespace cg = cooperative_groups;

#ifndef ONE_LAUNCH
#define ONE_LAUNCH 0
#endif

typedef unsigned short u16;
using bf16x8 = __attribute__((ext_vector_type(8))) short;
using f32x4 = __attribute__((ext_vector_type(4))) float;
using u32x4 = __attribute__((ext_vector_type(4))) unsigned;

constexpr int D = 1024, NB = 4, SEQ = 8192, M = NB * SEQ, FF = 2816, EIN = 2568, PN = 2560;
constexpr int NPHASE = 17;

constexpr size_t SZ_WT_HYIN = (size_t)PN * 1024 * 2, SZ_WT_SQ = (size_t)1024 * 1024 * 2, SZ_WT_GLU = (size_t)512 * 512 * 2;
constexpr size_t SZ_WT_FFNIN = (size_t)2 * FF * 1024 * 2, SZ_WT_FFNOUT = (size_t)1024 * FF * 2, SZ_WT_SBIN = (size_t)3072 * 1024 * 2;
constexpr size_t OFF_WT_HYIN = 0;
constexpr size_t OFF_WT_HYOUT = OFF_WT_HYIN + SZ_WT_HYIN;
constexpr size_t OFF_WT_GLU = OFF_WT_HYOUT + SZ_WT_SQ;
constexpr size_t OFF_WT_FFNIN = OFF_WT_GLU + SZ_WT_GLU;
constexpr size_t OFF_WT_FFNOUT = OFF_WT_FFNIN + 2 * SZ_WT_FFNIN;
constexpr size_t OFF_WT_SBIN = OFF_WT_FFNOUT + 2 * SZ_WT_FFNOUT;
constexpr size_t OFF_WT_SBOUT = OFF_WT_SBIN + SZ_WT_SBIN;
constexpr size_t OFF_MOD = OFF_WT_SBOUT + SZ_WT_SQ;
constexpr size_t OFF_BETA = OFF_MOD + (size_t)2 * 4 * 6144 * 4;
constexpr size_t OFF_G = OFF_BETA + (size_t)M * 4 * 4;
constexpr size_t OFF_HN = OFF_G + (size_t)M * 4 * 4;
constexpr size_t OFF_Y5 = OFF_HN + (size_t)M * 1024 * 2;
constexpr size_t OFF_PROJ = OFF_Y5 + (size_t)M * 512 * 2;
constexpr size_t WS_TOTAL = OFF_PROJ + (size_t)M * PN * 4;
static_assert(WS_TOTAL <= (size_t)512 * 1024 * 1024, "workspace too large");

struct Params {
  const float *x, *c, *ada_w, *ada_b, *norm_mix_w, *norm_ffn_w, *ffn_w_in, *ffn_w_out;
  const float *hy_w_in, *hy_conv_w, *hy_a_log, *hy_dt_bias, *hy_head_norm_w;
  const float *s5_lam_re, *s5_lam_im, *s5_log_dt, *s5_b_re, *s5_b_im, *s5_c_re, *s5_c_im, *s5_d, *s5_glu_w, *s5_glu_b, *hy_w_out;
  const float *sb_w_in, *sb_w_out, *final_norm_w;
  float* out;
  char* ws;
  int phase_lo, phase_hi;
};

constexpr int SMEM_BYTES = 48 * 1024;

__device__ __forceinline__ u16 f2bf(float x) { unsigned u = __float_as_uint(x); u += 0x7fffu + ((u >> 16) & 1u); return (u16)(u >> 16); }
__device__ __forceinline__ float bf2f(u16 v) { return __uint_as_float(((unsigned)v) << 16); }
__device__ __forceinline__ float sigmoid_(float x) { return 1.f / (1.f + __expf(-x)); }
__device__ __forceinline__ float silu_(float x) { return x * sigmoid_(x); }
__device__ __forceinline__ float softplus_(float x) { return fmaxf(x, 0.f) + log1pf(__expf(-fabsf(x))); }
__device__ __forceinline__ float gelu_tanh_(float y) { return 0.5f * y * (1.f + tanhf(0.7978845608028654f * (y + 0.044715f * y * y * y))); }

struct TrJob { const float* src; u16* dst; int K, Nsrc, Nd, mode; };
__device__ __forceinline__ TrJob get_job(const Params& p, int j) {
  TrJob t;
  switch (j) {
    case 0: t = {p.hy_w_in, (u16*)(p.ws + OFF_WT_HYIN), 1024, EIN, PN, 1}; break;
    case 1: t = {p.hy_w_out, (u16*)(p.ws + OFF_WT_HYOUT), 1024, 1024, 1024, 0}; break;
    case 2: t = {p.s5_glu_w, (u16*)(p.ws + OFF_WT_GLU), 512, 512, 512, 0}; break;
    case 3: t = {p.ffn_w_in, (u16*)(p.ws + OFF_WT_FFNIN), 1024, 2 * FF, 2 * FF, 2}; break;
    case 4: t = {p.ffn_w_in + (size_t)1024 * 2 * FF, (u16*)(p.ws + OFF_WT_FFNIN + SZ_WT_FFNIN), 1024, 2 * FF, 2 * FF, 2}; break;
    case 5: t = {p.ffn_w_out, (u16*)(p.ws + OFF_WT_FFNOUT), FF, 1024, 1024, 0}; break;
    case 6: t = {p.ffn_w_out + (size_t)FF * 1024, (u16*)(p.ws + OFF_WT_FFNOUT + SZ_WT_FFNOUT), FF, 1024, 1024, 0}; break;
    case 7: t = {p.sb_w_in, (u16*)(p.ws + OFF_WT_SBIN), 1024, 3072, 3072, 0}; break;
    default: t = {p.sb_w_out, (u16*)(p.ws + OFF_WT_SBOUT), 1024, 1024, 1024, 0}; break;
  }
  return t;
}
__device__ __forceinline__ int src_col(int R, int mode) {
  if (mode == 0) return R;
  if (mode == 1) return R < 2048 ? R : R + 8;
  return ((R >> 4) & 1) * FF + (R >> 5) * 16 + (R & 15);
}
constexpr int N_TR_ITEMS = 640 + 256 + 64 + 2 * 1408 + 2 * 704 + 768 + 256;
constexpr int N_MOD_ITEMS = 2 * 6144 / 64;

__device__ void phase0(const Params& p, char* smem, int bid, int nblk) {
  const int tid = threadIdx.x;
  for (int it = bid; it < N_TR_ITEMS + N_MOD_ITEMS; it += nblk) {
    if (it < N_TR_ITEMS) {
      int rem = it, j = 0; TrJob jb;
      for (;; ++j) { jb = get_job(p, j); int n = (jb.Nd >> 6) * (jb.K >> 6); if (rem < n) break; rem -= n; }
      const int nk = jb.K >> 6, R0 = (rem / nk) * 64, k0 = (rem % nk) * 64;
      u16* s = (u16*)smem;
      {
        const int r = tid & 63, kk = tid >> 6;
        const float* sp = jb.src + (size_t)k0 * jb.Nsrc + src_col(R0 + r, jb.mode);
#pragma unroll
        for (int i = 0; i < 16; ++i) { int k = kk + 4 * i; s[r * 72 + k] = f2bf(sp[(size_t)k * jb.Nsrc]); }
      }
      __syncthreads();
      {
        const int r = tid >> 2, ch = tid & 3;
#pragma unroll
        for (int i = 0; i < 2; ++i) {
          int c8 = (ch + 4 * i) * 8;
          *(u32x4*)(jb.dst + (size_t)(R0 + r) * jb.K + k0 + c8) = *(const u32x4*)(s + r * 72 + c8);
        }
      }
      __syncthreads();
    } else {
      const int mi = it - N_TR_ITEMS, l = mi / 96, n0 = (mi % 96) * 64;
      float* cact = (float*)smem;
      float* red = cact + 4096;
      for (int i = tid; i < 4096; i += 256) cact[i] = silu_(p.c[i]);
      __syncthreads();
      const int wid = tid >> 6, lane = tid & 63;
      float a0 = 0, a1 = 0, a2 = 0, a3 = 0;
      const float* wp = p.ada_w + (size_t)l * 1024 * 6144 + n0 + lane;
#pragma unroll 8
      for (int k = wid * 256; k < wid * 256 + 256; ++k) {
        float w = wp[(size_t)k * 6144];
        a0 += cact[k] * w; a1 += cact[1024 + k] * w; a2 += cact[2048 + k] * w; a3 += cact[3072 + k] * w;
      }
      red[(wid * 4 + 0) * 64 + lane] = a0; red[(wid * 4 + 1) * 64 + lane] = a1;
      red[(wid * 4 + 2) * 64 + lane] = a2; red[(wid * 4 + 3) * 64 + lane] = a3;
      __syncthreads();
      {
        const int b = tid >> 6;
        float sum = red[(0 * 4 + b) * 64 + lane] + red[(1 * 4 + b) * 64 + lane] + red[(2 * 4 + b) * 64 + lane] + red[(3 * 4 + b) * 64 + lane];
        float* mod = (float*)(p.ws + OFF_MOD);
        mod[(size_t)(l * 4 + b) * 6144 + n0 + lane] = sum + p.ada_b[l * 6144 + n0 + lane];
      }
      __syncthreads();
    }
  }
}

template <int MODE>
__device__ void norm_phase(const Params& p, const float* src, const float* w, const float* modl, int sh_off, int sc_off,
                           char* smem, int bid, int nblk) {
  const int tid = threadIdx.x, wid = tid >> 6, lane = tid & 63;
  float* wba = (float*)smem;
  if (MODE == 1) {
    for (int i = tid; i < 1024 * 8; i += 256) wba[i] = p.hy_w_in[(size_t)(i >> 3) * EIN + 2048 + (i & 7)];
    __syncthreads();
  }
  u16* hn = (u16*)(p.ws + OFF_HN);
  for (int row = bid * 4 + wid; row < M; row += nblk * 4) {
    const float* sp = src + (size_t)row * 1024;
    f32x4 v[4]; float ss = 0;
#pragma unroll
    for (int i = 0; i < 4; ++i) { v[i] = *(const f32x4*)(sp + i * 256 + lane * 4); ss += v[i][0] * v[i][0] + v[i][1] * v[i][1] + v[i][2] * v[i][2] + v[i][3] * v[i][3]; }
#pragma unroll
    for (int o = 32; o >= 1; o >>= 1) ss += __shfl_xor(ss, o);
    const float rstd = rsqrtf(ss * (1.f / 1024.f) + 1e-6f);
    const int b = row >> 13;
    float dots[8];
    if (MODE == 1) { for (int j = 0; j < 8; ++j) dots[j] = 0.f; }
#pragma unroll
    for (int i = 0; i < 4; ++i) {
      const int c0 = i * 256 + lane * 4;
      f32x4 ww = *(const f32x4*)(w + c0);
      f32x4 y;
      if (MODE == 2) {
#pragma unroll
        for (int e = 0; e < 4; ++e) y[e] = v[i][e] * rstd * ww[e];
        *(f32x4*)(p.out + (size_t)row * 1024 + c0) = y;
      } else {
        f32x4 sc = *(const f32x4*)(modl + (size_t)b * 6144 + sc_off + c0);
        f32x4 sh = *(const f32x4*)(modl + (size_t)b * 6144 + sh_off + c0);
#pragma unroll
        for (int e = 0; e < 4; ++e) y[e] = v[i][e] * rstd * ww[e] * (1.f + sc[e]) + sh[e];
        uint2 pk; pk.x = (unsigned)f2bf(y[0]) | ((unsigned)f2bf(y[1]) << 16); pk.y = (unsigned)f2bf(y[2]) | ((unsigned)f2bf(y[3]) << 16);
        *(uint2*)(hn + (size_t)row * 1024 + c0) = pk;
        if (MODE == 1) {
#pragma unroll
          for (int e = 0; e < 4; ++e) {
            f32x4 w0 = *(const f32x4*)(wba + (c0 + e) * 8), w1 = *(const f32x4*)(wba + (c0 + e) * 8 + 4);
#pragma unroll
            for (int j = 0; j < 4; ++j) { dots[j] += y[e] * w0[j]; dots[4 + j] += y[e] * w1[j]; }
          }
        }
      }
    }
    if (MODE == 1) {
#pragma unroll
      for (int j = 0; j < 8; ++j) {
#pragma unroll
        for (int o = 32; o >= 1; o >>= 1) dots[j] += __shfl_xor(dots[j], o);
      }
      if (lane == 0) {
        float* beta = (float*)(p.ws + OFF_BETA); float* gg = (float*)(p.ws + OFF_G);
#pragma unroll
        for (int h = 0; h < 4; ++h) {
          beta[(size_t)row * 4 + h] = sigmoid_(dots[h]);
          gg[(size_t)row * 4 + h] = -__expf(p.hy_a_log[h]) * softplus_(dots[4 + h] + p.hy_dt_bias[h]);
        }
      }
    }
  }
}

enum { E_F32 = 0, E_BF16 = 1, E_RESID = 2, E_GLU = 3, E_SWIGLU = 4 };
struct EpiArgs { float* outf; u16* outb; const float* res; const float* gate; const u16* y5; const float* bias; int ldc; };

template <int EPI>
__device__ void gemm_phase(const u16* __restrict__ A, int lda, const u16* __restrict__ Bt, int K, int N, const EpiArgs ea,
                           char* smem, int bid, int nblk) {
  const int tid = threadIdx.x, wid = tid >> 6, lane = tid & 63, wr = wid >> 1, wc = wid & 1, fr = lane & 15, fq = lane >> 4;
  u16* SA = (u16*)smem; u16* SB = SA + 128 * 32;
  const int nN = N >> 7, ntiles = (M >> 7) * nN, nk = K >> 5;
  for (int t = bid; t < ntiles; t += nblk) {
    const int brow = (t / nN) << 7, bcol = (t % nN) << 7;
    f32x4 acc[4][4];
#pragma unroll
    for (int m = 0; m < 4; ++m)
#pragma unroll
      for (int n = 0; n < 4; ++n) acc[m][n] = f32x4{0.f, 0.f, 0.f, 0.f};
    for (int kt = 0; kt < nk; ++kt) {
#pragma unroll
      for (int i = 0; i < 2; ++i) {
        const int b = tid * 16 + i * 4096, r = b >> 6, c = (b & 63) >> 1;
        __builtin_amdgcn_global_load_lds((const unsigned*)(A + (size_t)(brow + r) * lda + kt * 32 + c), (__attribute__((address_space(3))) unsigned*)((char*)SA + b), 16, 0, 0);
        __builtin_amdgcn_global_load_lds((const unsigned*)(Bt + (size_t)(bcol + r) * K + kt * 32 + c), (__attribute__((address_space(3))) unsigned*)((char*)SB + b), 16, 0, 0);
      }
      asm volatile("s_waitcnt vmcnt(0)" ::: "memory");
      __syncthreads();
      bf16x8 At[4], Bl[4];
#pragma unroll
      for (int m = 0; m < 4; ++m) At[m] = *(const bf16x8*)((const char*)SA + (wr * 64 + m * 16 + fr) * 64 + fq * 16);
#pragma unroll
      for (int n = 0; n < 4; ++n) Bl[n] = *(const bf16x8*)((const char*)SB + (wc * 64 + n * 16 + fr) * 64 + fq * 16);
#pragma unroll
      for (int m = 0; m < 4; ++m)
#pragma unroll
        for (int n = 0; n < 4; ++n) acc[m][n] = __builtin_amdgcn_mfma_f32_16x16x32_bf16(At[m], Bl[n], acc[m][n], 0, 0, 0);
      __syncthreads();
    }
#pragma unroll
    for (int m = 0; m < 4; ++m)
#pragma unroll
      for (int n = 0; n < 4; ++n)
#pragma unroll
        for (int j = 0; j < 4; ++j) {
          const int row = brow + wr * 64 + m * 16 + fq * 4 + j, col = bcol + wc * 64 + n * 16 + fr;
          const float v = acc[m][n][j];
          if (EPI == E_F32) ea.outf[(size_t)row * ea.ldc + col] = v;
          if (EPI == E_BF16) ea.outb[(size_t)row * ea.ldc + col] = f2bf(v);
          if (EPI == E_RESID) { size_t idx = (size_t)row * 1024 + col; ea.outf[idx] = ea.res[idx] + ea.gate[(size_t)(row >> 13) * 6144 + col] * v; }
          if (EPI == E_GLU) { float y = bf2f(ea.y5[(size_t)row * 512 + col]); ea.outb[(size_t)row * 1024 + 512 + col] = f2bf(y * sigmoid_(v + ea.bias[col])); }
          if (EPI == E_SWIGLU) {
            if ((n & 1) == 0) {
              const float u = acc[m][n | 1][j];
              const int co = (bcol >> 1) + wc * 32 + (n >> 1) * 16 + fr;
              ea.outb[(size_t)row * FF + co] = f2bf(silu_(v) * u);
            }
          }
        }
  }
}

constexpr int GT = 16;
__device__ void gdn_naive_item(const Params& p, int item, char* smem) {
  const int tid = threadIdx.x, b = item >> 2, h = item & 3;
  float* qs = (float*)smem; float* ks = qs + GT * 128; float* vs = ks + GT * 128; float* os = vs + GT * 128;
  float* rq = os + GT * 128; float* rk = rq + GT; float* eg = rk + GT; float* bt = eg + GT; float* ro = bt + GT;
  const float* proj = (const float*)(p.ws + OFF_PROJ);
  const float* beta = (const float*)(p.ws + OFF_BETA); const float* gg = (const float*)(p.ws + OFF_G);
  u16* concat = (u16*)(p.ws + OFF_HN);
  const int c = tid & 127;
  const int colA = (tid < 128 ? 0 : 512) + h * 128 + c;
  const int colB = 1024 + h * 128 + c;
  float wa[4], wb[4];
#pragma unroll
  for (int j = 0; j < 4; ++j) { wa[j] = p.hy_conv_w[j * 1536 + colA]; wb[j] = p.hy_conv_w[j * 1536 + colB]; }
  float a1 = 0, a2 = 0, a3 = 0, b1 = 0, b2 = 0, b3 = 0;
  float S[64];
#pragma unroll
  for (int d = 0; d < 64; ++d) S[d] = 0.f;
  const int rc = tid >> 1, rhalf = tid & 1;
  for (int t0 = 0; t0 < SEQ; t0 += GT) {
    const size_t rbase = (size_t)b * SEQ + t0;
    {
      float xa[GT], xb[GT];
#pragma unroll
      for (int tt = 0; tt < GT; ++tt) { xa[tt] = proj[(rbase + tt) * PN + colA]; xb[tt] = (tid < 128) ? proj[(rbase + tt) * PN + colB] : 0.f; }
#pragma unroll
      for (int tt = 0; tt < GT; ++tt) {
        float ya = wa[0] * a3 + wa[1] * a2 + wa[2] * a1 + wa[3] * xa[tt]; a3 = a2; a2 = a1; a1 = xa[tt];
        float yb = wb[0] * b3 + wb[1] * b2 + wb[2] * b1 + wb[3] * xb[tt]; b3 = b2; b2 = b1; b1 = xb[tt];
        if (tid < 128) { qs[tt * 128 + c] = silu_(ya); vs[tt * 128 + c] = silu_(yb); } else { ks[tt * 128 + c] = silu_(ya); }
      }
    }
    __syncthreads();
    {
      const int tok = tid >> 4, part = tid & 15;
      float sq = 0, sk = 0;
#pragma unroll
      for (int e = 0; e < 8; ++e) { float a = qs[tok * 128 + part * 8 + e], k = ks[tok * 128 + part * 8 + e]; sq += a * a; sk += k * k; }
#pragma unroll
      for (int o = 8; o >= 1; o >>= 1) { sq += __shfl_xor(sq, o); sk += __shfl_xor(sk, o); }
      if (part == 0) { rq[tok] = rsqrtf(sq + 1e-6f) * 0.08838834764831845f; rk[tok] = rsqrtf(sk + 1e-6f); }
      if (tid < GT) { eg[tid] = __expf(gg[(rbase + tid) * 4 + h]); bt[tid] = beta[(rbase + tid) * 4 + h]; }
    }
    __syncthreads();
    {
      for (int tt = 0; tt < GT; ++tt) {
        const float* kr = ks + tt * 128 + rhalf * 64; const float* qr = qs + tt * 128 + rhalf * 64;
        float kS = 0.f;
#pragma unroll
        for (int d = 0; d < 64; d += 4) { f32x4 k4 = *(const f32x4*)(kr + d); kS += k4[0] * S[d] + k4[1] * S[d + 1] + k4[2] * S[d + 2] + k4[3] * S[d + 3]; }
        kS += __shfl_xor(kS, 1);
        const float e = eg[tt], rkk = rk[tt];
        const float delta = bt[tt] * (vs[tt * 128 + rc] - e * kS * rkk) * rkk;
        float o = 0.f;
#pragma unroll
        for (int d = 0; d < 64; d += 4) {
          f32x4 k4 = *(const f32x4*)(kr + d); f32x4 q4 = *(const f32x4*)(qr + d);
#pragma unroll
          for (int e4 = 0; e4 < 4; ++e4) { S[d + e4] = e * S[d + e4] + k4[e4] * delta; o += q4[e4] * S[d + e4]; }
        }
        o += __shfl_xor(o, 1);
        if (rhalf == 0) os[tt * 128 + rc] = o * rq[tt];
      }
    }
    __syncthreads();
    {
      const int tok = tid >> 4, part = tid & 15;
      float so = 0;
#pragma unroll
      for (int e = 0; e < 8; ++e) { float a = os[tok * 128 + part * 8 + e]; so += a * a; }
#pragma unroll
      for (int o = 8; o >= 1; o >>= 1) so += __shfl_xor(so, o);
      if (part == 0) ro[tok] = rsqrtf(so * (1.f / 128.f) + 1e-6f);
    }
    __syncthreads();
#pragma unroll
    for (int i = 0; i < GT * 128 / 256; ++i) {
      const int idx = tid + i * 256, tok = idx >> 7, cc = idx & 127;
      const float z = proj[(rbase + tok) * PN + 1536 + h * 128 + cc];
      const float val = os[idx] * ro[tok] * p.hy_head_norm_w[cc] * silu_(z);
      concat[(rbase + tok) * 1024 + h * 128 + cc] = f2bf(val);
    }
    __syncthreads();
  }

}

__device__ void s5_naive_item(const Params& p, int item, float* part) {
  const int lane = threadIdx.x & 63, b = item >> 5, g = item & 31;
  const float dt = expf(p.s5_log_dt[g]);
  const float lr = p.s5_lam_re[g * 64 + lane], li = p.s5_lam_im[g * 64 + lane];
  const float mag = expf(lr * dt);
  float sn, cs; sincosf(li * dt, &sn, &cs);
  const float ar = mag * cs, ai = mag * sn;
  const float den = lr * lr + li * li, nr = ar - 1.f, ni = ai;
  const float fre = (nr * lr + ni * li) / den, fim = (ni * lr - nr * li) / den;
  float bbr[16], bbi[16], cr[16], ci[16];
#pragma unroll
  for (int h = 0; h < 16; ++h) {
    const float br = p.s5_b_re[(size_t)(g * 64 + lane) * 16 + h], bi = p.s5_b_im[(size_t)(g * 64 + lane) * 16 + h];
    bbr[h] = fre * br - fim * bi; bbi[h] = fre * bi + fim * br;
    cr[h] = p.s5_c_re[(size_t)(g * 16 + h) * 64 + lane]; ci[h] = p.s5_c_im[(size_t)(g * 16 + h) * 64 + lane];
  }
  float xr = 0.f, xi = 0.f;
  const float* ub = (const float*)(p.ws + OFF_PROJ) + (size_t)b * SEQ * PN + 2048 + g * 16;
  u16* y5 = (u16*)(p.ws + OFF_Y5);
  const int rtok = lane >> 5, rh = (lane >> 1) & 15, rhalf = lane & 1;
  const float dsk = p.s5_d[g * 16 + rh];
  for (int t = 0; t < SEQ; t += 2) {
#pragma unroll
    for (int tok = 0; tok < 2; ++tok) {
      const f32x4* up = (const f32x4*)(ub + (size_t)(t + tok) * PN);
      f32x4 u0 = up[0], u1 = up[1], u2 = up[2], u3 = up[3];
      float bur = 0.f, bui = 0.f;
#pragma unroll
      for (int e = 0; e < 4; ++e) {
        bur += bbr[e] * u0[e] + bbr[4 + e] * u1[e] + bbr[8 + e] * u2[e] + bbr[12 + e] * u3[e];
        bui += bbi[e] * u0[e] + bbi[4 + e] * u1[e] + bbi[8 + e] * u2[e] + bbi[12 + e] * u3[e];
      }
      const float nxr = ar * xr - ai * xi + bur, nxi = ar * xi + ai * xr + bui;
      xr = nxr; xi = nxi;
#pragma unroll
      for (int h = 0; h < 16; ++h) part[(tok * 16 + h) * 65 + lane] = cr[h] * xr - ci[h] * xi;
    }
    __syncthreads();
    {
      float s = 0.f;
      const float* pr = part + (rtok * 16 + rh) * 65 + rhalf * 32;
#pragma unroll
      for (int k = 0; k < 32; ++k) s += pr[k];
      s += __shfl_xor(s, 1);
      if (rhalf == 0) {
        const float uu = ub[(size_t)(t + rtok) * PN + rh];
        const float y = gelu_tanh_(s + dsk * uu);
        y5[((size_t)b * SEQ + t + rtok) * 512 + g * 16 + rh] = f2bf(y);
      }
    }
    __syncthreads();
  }
}

__device__ void mixer0_phase(const Params& p, char* smem, int bid, int nblk) {
  for (int it = bid; it < 48; it += nblk) {
    if (it < 16) gdn_naive_item(p, it, smem);
    else s5_naive_item(p, (it - 16) * 4 + (threadIdx.x >> 6), (float*)smem + (threadIdx.x >> 6) * (2 * 16 * 65));
    __syncthreads();
  }
}

__device__ void attn_naive_phase(const Params& p, char* smem, int bid, int nblk) {
  const int tid = threadIdx.x, r = tid >> 2, qd = tid & 3;
  float* Ks = (float*)smem; float* Vs = Ks + 32 * 128;
  const u16* qkv = (const u16*)(p.ws + OFF_PROJ);
  u16* ao = (u16*)(p.ws + OFF_HN);
  for (int k = 0; k * nblk < 4096; ++k) {
    const int i = (k & 1) ? ((k + 1) * nblk - 1 - bid) : (k * nblk + bid);
    if (i >= 4096) continue;
    const int j = 127 - (i >> 5), bh = i & 31, b = bh >> 3, h = bh & 7;
    const int i0 = j * 64, t = i0 + r;
    const size_t rowb = (size_t)b * SEQ;
    float q[32], o[32];
    {
      const u16* qp = qkv + (rowb + t) * 3072 + h * 128 + qd * 32;
#pragma unroll
      for (int d = 0; d < 32; d += 8) {
        u32x4 w = *(const u32x4*)(qp + d);
#pragma unroll
        for (int e = 0; e < 4; ++e) { q[d + 2 * e] = __uint_as_float(w[e] << 16) * 0.08838834764831845f; q[d + 2 * e + 1] = __uint_as_float(w[e] & 0xffff0000u) * 0.08838834764831845f; }
      }
#pragma unroll
      for (int d = 0; d < 32; ++d) o[d] = 0.f;
    }
    float run = 0.f;
    for (int kt = (i0 >> 5) + 1; kt >= 0; --kt) {
      const int k0 = kt * 32;
      {
        const int key = tid >> 3, c0 = (tid & 7) * 16;
        const u16* kp = qkv + (rowb + k0 + key) * 3072 + 1024 + h * 128 + c0;
        const u16* vp = kp + 1024;
#pragma unroll
        for (int hh = 0; hh < 2; ++hh) {
          u32x4 wk = *(const u32x4*)(kp + hh * 8), wv = *(const u32x4*)(vp + hh * 8);
          f32x4 k0v, k1v, v0v, v1v;
          k0v[0] = __uint_as_float(wk[0] << 16); k0v[1] = __uint_as_float(wk[0] & 0xffff0000u); k0v[2] = __uint_as_float(wk[1] << 16); k0v[3] = __uint_as_float(wk[1] & 0xffff0000u);
          k1v[0] = __uint_as_float(wk[2] << 16); k1v[1] = __uint_as_float(wk[2] & 0xffff0000u); k1v[2] = __uint_as_float(wk[3] << 16); k1v[3] = __uint_as_float(wk[3] & 0xffff0000u);
          v0v[0] = __uint_as_float(wv[0] << 16); v0v[1] = __uint_as_float(wv[0] & 0xffff0000u); v0v[2] = __uint_as_float(wv[1] << 16); v0v[3] = __uint_as_float(wv[1] & 0xffff0000u);
          v1v[0] = __uint_as_float(wv[2] << 16); v1v[1] = __uint_as_float(wv[2] & 0xffff0000u); v1v[2] = __uint_as_float(wv[3] << 16); v1v[3] = __uint_as_float(wv[3] & 0xffff0000u);
          *(f32x4*)(Ks + key * 128 + c0 + hh * 8) = k0v; *(f32x4*)(Ks + key * 128 + c0 + hh * 8 + 4) = k1v;
          *(f32x4*)(Vs + key * 128 + c0 + hh * 8) = v0v; *(f32x4*)(Vs + key * 128 + c0 + hh * 8 + 4) = v1v;
        }
      }
      __syncthreads();
      for (int s = 31; s >= 0; --s) {
        const float* kr = Ks + s * 128 + qd * 32; const float* vr = Vs + s * 128 + qd * 32;
        float z = 0.f;
#pragma unroll
        for (int d = 0; d < 32; d += 4) { f32x4 k4 = *(const f32x4*)(kr + d); z += q[d] * k4[0] + q[d + 1] * k4[1] + q[d + 2] * k4[2] + q[d + 3] * k4[3]; }
        z += __shfl_xor(z, 1); z += __shfl_xor(z, 2);
        const bool valid = (k0 + s) < t;
        const float sp = softplus_(z);
        const float w = valid ? __expf(z - sp + run) : 0.f;
        run += valid ? -sp : 0.f;
#pragma unroll
        for (int d = 0; d < 32; d += 4) { f32x4 v4 = *(const f32x4*)(vr + d); o[d] += w * v4[0]; o[d + 1] += w * v4[1]; o[d + 2] += w * v4[2]; o[d + 3] += w * v4[3]; }
      }
      __syncthreads();
    }
    {
      u16* op = ao + (rowb + t) * 1024 + h * 128 + qd * 32;
#pragma unroll
      for (int d = 0; d < 32; d += 8) {
        u32x4 w;
#pragma unroll
        for (int e = 0; e < 4; ++e) w[e] = (unsigned)f2bf(o[d + 2 * e]) | ((unsigned)f2bf(o[d + 2 * e + 1]) << 16);
        *(u32x4*)(op + d) = w;
      }
    }
  }
}

__global__ void __launch_bounds__(256, 2) mega(Params p) {
  __shared__ __attribute__((aligned(16))) char smem[SMEM_BYTES];
  const int bid = blockIdx.x, nblk = gridDim.x;
  char* ws = p.ws;
  const float* mod = (const float*)(ws + OFF_MOD);
  u16* hn = (u16*)(ws + OFF_HN);
#define PH_BEGIN(n) if (p.phase_lo <= (n) && (n) < p.phase_hi) {
#define PH_END(n) if ((n) + 1 < p.phase_hi) cg::this_grid().sync(); }
  PH_BEGIN(0) phase0(p, smem, bid, nblk); PH_END(0)
  PH_BEGIN(1) norm_phase<1>(p, p.x, p.norm_mix_w, mod, 0, 1024, smem, bid, nblk); PH_END(1)
  PH_BEGIN(2) { EpiArgs ea{}; ea.outf = (float*)(ws + OFF_PROJ); ea.ldc = PN;
        gemm_phase<E_F32>(hn, 1024, (const u16*)(ws + OFF_WT_HYIN), 1024, PN, ea, smem, bid, nblk); } PH_END(2)
  PH_BEGIN(3) mixer0_phase(p, smem, bid, nblk); PH_END(3)
  PH_BEGIN(4) { EpiArgs ea{}; ea.outb = hn; ea.y5 = (const u16*)(ws + OFF_Y5); ea.bias = p.s5_glu_b;
        gemm_phase<E_GLU>((const u16*)(ws + OFF_Y5), 512, (const u16*)(ws + OFF_WT_GLU), 512, 512, ea, smem, bid, nblk); } PH_END(4)
  PH_BEGIN(5) { EpiArgs ea{}; ea.outf = p.out; ea.res = p.x; ea.gate = mod + 2048;
        gemm_phase<E_RESID>(hn, 1024, (const u16*)(ws + OFF_WT_HYOUT), 1024, 1024, ea, smem, bid, nblk); } PH_END(5)
  PH_BEGIN(6) norm_phase<0>(p, p.out, p.norm_ffn_w, mod, 3072, 4096, smem, bid, nblk); PH_END(6)
  PH_BEGIN(7) { EpiArgs ea{}; ea.outb = (u16*)(ws + OFF_PROJ);
        gemm_phase<E_SWIGLU>(hn, 1024, (const u16*)(ws + OFF_WT_FFNIN), 1024, 2 * FF, ea, smem, bid, nblk); } PH_END(7)
  PH_BEGIN(8) { EpiArgs ea{}; ea.outf = p.out; ea.res = p.out; ea.gate = mod + 5120;
        gemm_phase<E_RESID>((const u16*)(ws + OFF_PROJ), FF, (const u16*)(ws + OFF_WT_FFNOUT), FF, 1024, ea, smem, bid, nblk); } PH_END(8)
  PH_BEGIN(9) norm_phase<0>(p, p.out, p.norm_mix_w + 1024, mod + 4 * 6144, 0, 1024, smem, bid, nblk); PH_END(9)
  PH_BEGIN(10) { EpiArgs ea{}; ea.outb = (u16*)(ws + OFF_PROJ); ea.ldc = 3072;
        gemm_phase<E_BF16>(hn, 1024, (const u16*)(ws + OFF_WT_SBIN), 1024, 3072, ea, smem, bid, nblk); } PH_END(10)
  PH_BEGIN(11) attn_naive_phase(p, smem, bid, nblk); PH_END(11)
  PH_BEGIN(12) { EpiArgs ea{}; ea.outf = p.out; ea.res = p.out; ea.gate = mod + 4 * 6144 + 2048;
        gemm_phase<E_RESID>(hn, 1024, (const u16*)(ws + OFF_WT_SBOUT), 1024, 1024, ea, smem, bid, nblk); } PH_END(12)
  PH_BEGIN(13) norm_phase<0>(p, p.out, p.norm_ffn_w + 1024, mod + 4 * 6144, 3072, 4096, smem, bid, nblk); PH_END(13)
  PH_BEGIN(14) { EpiArgs ea{}; ea.outb = (u16*)(ws + OFF_PROJ);
        gemm_phase<E_SWIGLU>(hn, 1024, (const u16*)(ws + OFF_WT_FFNIN + SZ_WT_FFNIN), 1024, 2 * FF, ea, smem, bid, nblk); } PH_END(14)
  PH_BEGIN(15) { EpiArgs ea{}; ea.outf = p.out; ea.res = p.out; ea.gate = mod + 4 * 6144 + 5120;
        gemm_phase<E_RESID>((const u16*)(ws + OFF_PROJ), FF, (const u16*)(ws + OFF_WT_FFNOUT + SZ_WT_FFNOUT), FF, 1024, ea, smem, bid, nblk); } PH_END(15)
  PH_BEGIN(16) norm_phase<2>(p, p.out, p.final_norm_w, mod, 0, 0, smem, bid, nblk); PH_END(16)
}

extern "C" void kernel_launch(void* const* d_in, const int* in_sizes, int n_in, void* d_out, int out_size, void* d_ws, size_t ws_size,
                              hipStream_t stream) {
  static int grid_blocks = 0;
  if (!grid_blocks) {
    int dev = 0, cus = 0, per_cu = 0;
    hipGetDevice(&dev);
    hipDeviceGetAttribute(&cus, hipDeviceAttributeMultiprocessorCount, dev);
    hipOccupancyMaxActiveBlocksPerMultiprocessor(&per_cu, mega, 256, 0);
    if (per_cu > 2) per_cu = 2;
    if (per_cu < 1) per_cu = 1;
    grid_blocks = cus * per_cu;
  }
  Params p{};
  const float* const* in = (const float* const*)d_in;
  p.x = in[0]; p.c = in[1]; p.ada_w = in[2]; p.ada_b = in[3]; p.norm_mix_w = in[4]; p.norm_ffn_w = in[5]; p.ffn_w_in = in[6]; p.ffn_w_out = in[7];
  p.hy_w_in = in[8]; p.hy_conv_w = in[9]; p.hy_a_log = in[10]; p.hy_dt_bias = in[11]; p.hy_head_norm_w = in[12];
  p.s5_lam_re = in[13]; p.s5_lam_im = in[14]; p.s5_log_dt = in[15]; p.s5_b_re = in[16]; p.s5_b_im = in[17]; p.s5_c_re = in[18]; p.s5_c_im = in[19];
  p.s5_d = in[20]; p.s5_glu_w = in[21]; p.s5_glu_b = in[22]; p.hy_w_out = in[23]; p.sb_w_in = in[24]; p.sb_w_out = in[25]; p.final_norm_w = in[26];
  p.out = (float*)d_out; p.ws = (char*)d_ws;
#if ONE_LAUNCH
  p.phase_lo = 0; p.phase_hi = NPHASE;
  void* args[] = {&p};
  hipError_t e = hipLaunchCooperativeKernel((void*)mega, dim3(grid_blocks), dim3(256), args, 0, stream);
  if (e != hipSuccess) fprintf(stderr, "cooperative launch failed: %s (grid %d)\n", hipGetErrorString(e), grid_blocks);
#else
  for (int ph = 0; ph < NPHASE; ++ph) {
    p.phase_lo = ph; p.phase_hi = ph + 1;
    hipLaunchKernelGGL(mega, dim3(grid_blocks), dim3(256), 0, stream, p);
  }
#endif
}
```

```cpp
#include <hip/hip_runtime.h>
#include <hip/hip_cooperative_groups.h>
#include <stdint.h>
#include <cstdio>
namespace cg = cooperative_groups;

#ifndef ONE_LAUNCH
#define ONE_LAUNCH 1
#endif

typedef unsigned short u16;
using bf16x8 = __attribute__((ext_vector_type(8))) short;
using f32x4 = __attribute__((ext_vector_type(4))) float;
using u32x4 = __attribute__((ext_vector_type(4))) unsigned;

constexpr int D = 1024, NB = 4, SEQ = 8192, M = NB * SEQ, FF = 2816, EIN = 2568, PN = 2560;
constexpr int NPHASE = 17;

constexpr size_t SZ_WT_HYIN = (size_t)PN * 1024 * 2, SZ_WT_SQ = (size_t)1024 * 1024 * 2, SZ_WT_GLU = (size_t)512 * 512 * 2;
constexpr size_t SZ_WT_FFNIN = (size_t)2 * FF * 1024 * 2, SZ_WT_FFNOUT = (size_t)1024 * FF * 2, SZ_WT_SBIN = (size_t)3072 * 1024 * 2;
constexpr size_t OFF_WT_HYIN = 0;
constexpr size_t OFF_WT_HYOUT = OFF_WT_HYIN + SZ_WT_HYIN;
constexpr size_t OFF_WT_GLU = OFF_WT_HYOUT + SZ_WT_SQ;
constexpr size_t OFF_WT_FFNIN = OFF_WT_GLU + SZ_WT_GLU;
constexpr size_t OFF_WT_FFNOUT = OFF_WT_FFNIN + 2 * SZ_WT_FFNIN;
constexpr size_t OFF_WT_SBIN = OFF_WT_FFNOUT + 2 * SZ_WT_FFNOUT;
constexpr size_t OFF_WT_SBOUT = OFF_WT_SBIN + SZ_WT_SBIN;
constexpr size_t OFF_MOD = OFF_WT_SBOUT + SZ_WT_SQ;
constexpr size_t OFF_BETA = OFF_MOD + (size_t)2 * 4 * 6144 * 4;
constexpr size_t OFF_G = OFF_BETA + (size_t)M * 4 * 4;
constexpr size_t OFF_HN = OFF_G + (size_t)M * 4 * 4;
constexpr size_t OFF_Y5 = OFF_HN + (size_t)M * 1024 * 2;
constexpr size_t OFF_PROJ = OFF_Y5 + (size_t)M * 512 * 2;
constexpr size_t WS_TOTAL = OFF_PROJ + (size_t)M * PN * 4;
static_assert(WS_TOTAL <= (size_t)512 * 1024 * 1024, "workspace too large");

struct Params {
  const float *x, *c, *ada_w, *ada_b, *norm_mix_w, *norm_ffn_w, *ffn_w_in, *ffn_w_out;
  const float *hy_w_in, *hy_conv_w, *hy_a_log, *hy_dt_bias, *hy_head_norm_w;
  const float *s5_lam_re, *s5_lam_im, *s5_log_dt, *s5_b_re, *s5_b_im, *s5_c_re, *s5_c_im, *s5_d, *s5_glu_w, *s5_glu_b, *hy_w_out;
  const float *sb_w_in, *sb_w_out, *final_norm_w;
  float* out;
  char* ws;
  int phase_lo, phase_hi;
};

constexpr int SMEM_BYTES = 48 * 1024;

__device__ __forceinline__ u16 f2bf(float x) { unsigned u = __float_as_uint(x); u += 0x7fffu + ((u >> 16) & 1u); return (u16)(u >> 16); }
__device__ __forceinline__ float bf2f(u16 v) { return __uint_as_float(((unsigned)v) << 16); }
__device__ __forceinline__ float sigmoid_(float x) { return 1.f / (1.f + __expf(-x)); }
__device__ __forceinline__ float silu_(float x) { return x * sigmoid_(x); }
__device__ __forceinline__ float softplus_(float x) { return fmaxf(x, 0.f) + log1pf(__expf(-fabsf(x))); }
__device__ __forceinline__ float gelu_tanh_(float y) { return 0.5f * y * (1.f + tanhf(0.7978845608028654f * (y + 0.044715f * y * y * y))); }

struct TrJob { const float* src; u16* dst; int K, Nsrc, Nd, mode; };
__device__ __forceinline__ TrJob get_job(const Params& p, int j) {
  TrJob t;
  switch (j) {
    case 0: t = {p.hy_w_in, (u16*)(p.ws + OFF_WT_HYIN), 1024, EIN, PN, 1}; break;
    case 1: t = {p.hy_w_out, (u16*)(p.ws + OFF_WT_HYOUT), 1024, 1024, 1024, 0}; break;
    case 2: t = {p.s5_glu_w, (u16*)(p.ws + OFF_WT_GLU), 512, 512, 512, 0}; break;
    case 3: t = {p.ffn_w_in, (u16*)(p.ws + OFF_WT_FFNIN), 1024, 2 * FF, 2 * FF, 2}; break;
    case 4: t = {p.ffn_w_in + (size_t)1024 * 2 * FF, (u16*)(p.ws + OFF_WT_FFNIN + SZ_WT_FFNIN), 1024, 2 * FF, 2 * FF, 2}; break;
    case 5: t = {p.ffn_w_out, (u16*)(p.ws + OFF_WT_FFNOUT), FF, 1024, 1024, 0}; break;
    case 6: t = {p.ffn_w_out + (size_t)FF * 1024, (u16*)(p.ws + OFF_WT_FFNOUT + SZ_WT_FFNOUT), FF, 1024, 1024, 0}; break;
    case 7: t = {p.sb_w_in, (u16*)(p.ws + OFF_WT_SBIN), 1024, 3072, 3072, 0}; break;
    default: t = {p.sb_w_out, (u16*)(p.ws + OFF_WT_SBOUT), 1024, 1024, 1024, 0}; break;
  }
  return t;
}
__device__ __forceinline__ int src_col(int R, int mode) {
  if (mode == 0) return R;
  if (mode == 1) return R < 2048 ? R : R + 8;
  return ((R >> 4) & 1) * FF + (R >> 5) * 16 + (R & 15);
}
constexpr int N_TR_ITEMS = 640 + 256 + 64 + 2 * 1408 + 2 * 704 + 768 + 256;
constexpr int N_MOD_ITEMS = 2 * 6144 / 64;

__device__ void phase0(const Params& p, char* smem, int bid, int nblk) {
  const int tid = threadIdx.x;
  for (int it = bid; it < N_TR_ITEMS + N_MOD_ITEMS; it += nblk) {
    if (it < N_TR_ITEMS) {
      int rem = it, j = 0; TrJob jb;
      for (;; ++j) { jb = get_job(p, j); int n = (jb.Nd >> 6) * (jb.K >> 6); if (rem < n) break; rem -= n; }
      const int nk = jb.K >> 6, R0 = (rem / nk) * 64, k0 = (rem % nk) * 64;
      u16* s = (u16*)smem;
      {
        const int r = tid & 63, kk = tid >> 6;
        const float* sp = jb.src + (size_t)k0 * jb.Nsrc + src_col(R0 + r, jb.mode);
#pragma unroll
        for (int i = 0; i < 16; ++i) { int k = kk + 4 * i; s[r * 72 + k] = f2bf(sp[(size_t)k * jb.Nsrc]); }
      }
      __syncthreads();
      {
        const int r = tid >> 2, ch = tid & 3;
#pragma unroll
        for (int i = 0; i < 2; ++i) {
          int c8 = (ch + 4 * i) * 8;
          *(u32x4*)(jb.dst + (size_t)(R0 + r) * jb.K + k0 + c8) = *(const u32x4*)(s + r * 72 + c8);
        }
      }
      __syncthreads();
    } else {
      const int mi = it - N_TR_ITEMS, l = mi / 96, n0 = (mi % 96) * 64;
      float* cact = (float*)smem;
      float* red = cact + 4096;
      for (int i = tid; i < 4096; i += 256) cact[i] = silu_(p.c[i]);
      __syncthreads();
      const int wid = tid >> 6, lane = tid & 63;
      float a0 = 0, a1 = 0, a2 = 0, a3 = 0;
      const float* wp = p.ada_w + (size_t)l * 1024 * 6144 + n0 + lane;
#pragma unroll 8
      for (int k = wid * 256; k < wid * 256 + 256; ++k) {
        float w = wp[(size_t)k * 6144];
        a0 += cact[k] * w; a1 += cact[1024 + k] * w; a2 += cact[2048 + k] * w; a3 += cact[3072 + k] * w;
      }
      red[(wid * 4 + 0) * 64 + lane] = a0; red[(wid * 4 + 1) * 64 + lane] = a1;
      red[(wid * 4 + 2) * 64 + lane] = a2; red[(wid * 4 + 3) * 64 + lane] = a3;
      __syncthreads();
      {
        const int b = tid >> 6;
        float sum = red[(0 * 4 + b) * 64 + lane] + red[(1 * 4 + b) * 64 + lane] + red[(2 * 4 + b) * 64 + lane] + red[(3 * 4 + b) * 64 + lane];
        float* mod = (float*)(p.ws + OFF_MOD);
        mod[(size_t)(l * 4 + b) * 6144 + n0 + lane] = sum + p.ada_b[l * 6144 + n0 + lane];
      }
      __syncthreads();
    }
  }
}

template <int MODE>
__device__ void norm_phase(const Params& p, const float* src, const float* w, const float* modl, int sh_off, int sc_off,
                           char* smem, int bid, int nblk) {
  const int tid = threadIdx.x, wid = tid >> 6, lane = tid & 63;
  float* wba = (float*)smem;
  if (MODE == 1) {
    for (int i = tid; i < 1024 * 8; i += 256) wba[i] = p.hy_w_in[(size_t)(i >> 3) * EIN + 2048 + (i & 7)];
    __syncthreads();
  }
  u16* hn = (u16*)(p.ws + OFF_HN);
  for (int row = bid * 4 + wid; row < M; row += nblk * 4) {
    const float* sp = src + (size_t)row * 1024;
    f32x4 v[4]; float ss = 0;
#pragma unroll
    for (int i = 0; i < 4; ++i) { v[i] = *(const f32x4*)(sp + i * 256 + lane * 4); ss += v[i][0] * v[i][0] + v[i][1] * v[i][1] + v[i][2] * v[i][2] + v[i][3] * v[i][3]; }
#pragma unroll
    for (int o = 32; o >= 1; o >>= 1) ss += __shfl_xor(ss, o);
    const float rstd = rsqrtf(ss * (1.f / 1024.f) + 1e-6f);
    const int b = row >> 13;
    float dots[8];
    if (MODE == 1) { for (int j = 0; j < 8; ++j) dots[j] = 0.f; }
#pragma unroll
    for (int i = 0; i < 4; ++i) {
      const int c0 = i * 256 + lane * 4;
      f32x4 ww = *(const f32x4*)(w + c0);
      f32x4 y;
      if (MODE == 2) {
#pragma unroll
        for (int e = 0; e < 4; ++e) y[e] = v[i][e] * rstd * ww[e];
        *(f32x4*)(p.out + (size_t)row * 1024 + c0) = y;
      } else {
        f32x4 sc = *(const f32x4*)(modl + (size_t)b * 6144 + sc_off + c0);
        f32x4 sh = *(const f32x4*)(modl + (size_t)b * 6144 + sh_off + c0);
#pragma unroll
        for (int e = 0; e < 4; ++e) y[e] = v[i][e] * rstd * ww[e] * (1.f + sc[e]) + sh[e];
        uint2 pk; pk.x = (unsigned)f2bf(y[0]) | ((unsigned)f2bf(y[1]) << 16); pk.y = (unsigned)f2bf(y[2]) | ((unsigned)f2bf(y[3]) << 16);
        *(uint2*)(hn + (size_t)row * 1024 + c0) = pk;
        if (MODE == 1) {
#pragma unroll
          for (int e = 0; e < 4; ++e) {
            f32x4 w0 = *(const f32x4*)(wba + (c0 + e) * 8), w1 = *(const f32x4*)(wba + (c0 + e) * 8 + 4);
#pragma unroll
            for (int j = 0; j < 4; ++j) { dots[j] += y[e] * w0[j]; dots[4 + j] += y[e] * w1[j]; }
          }
        }
      }
    }
    if (MODE == 1) {
#pragma unroll
      for (int j = 0; j < 8; ++j) {
#pragma unroll
        for (int o = 32; o >= 1; o >>= 1) dots[j] += __shfl_xor(dots[j], o);
      }
      if (lane == 0) {
        float* beta = (float*)(p.ws + OFF_BETA); float* gg = (float*)(p.ws + OFF_G);
#pragma unroll
        for (int h = 0; h < 4; ++h) {
          beta[(size_t)row * 4 + h] = sigmoid_(dots[h]);
          gg[(size_t)row * 4 + h] = -__expf(p.hy_a_log[h]) * softplus_(dots[4 + h] + p.hy_dt_bias[h]);
        }
      }
    }
  }
}

enum { E_F32 = 0, E_BF16 = 1, E_RESID = 2, E_GLU = 3, E_SWIGLU = 4 };
struct EpiArgs { float* outf; u16* outb; const float* res; const float* gate; const u16* y5; const float* bias; int ldc; };

template <int EPI>
__device__ void gemm_phase(const u16* __restrict__ A, int lda, const u16* __restrict__ Bt, int K, int N, const EpiArgs ea,
                           char* smem, int bid, int nblk) {
  const int tid = threadIdx.x, wid = tid >> 6, lane = tid & 63, wr = wid >> 1, wc = wid & 1, fr = lane & 15, fq = lane >> 4;
  u16* SA = (u16*)smem; u16* SB = SA + 128 * 32;
  const int nN = N >> 7, ntiles = (M >> 7) * nN, nk = K >> 5;
  for (int t = bid; t < ntiles; t += nblk) {
    const int brow = (t / nN) << 7, bcol = (t % nN) << 7;
    f32x4 acc[4][4];
#pragma unroll
    for (int m = 0; m < 4; ++m)
#pragma unroll
      for (int n = 0; n < 4; ++n) acc[m][n] = f32x4{0.f, 0.f, 0.f, 0.f};
    for (int kt = 0; kt < nk; ++kt) {
#pragma unroll
      for (int i = 0; i < 2; ++i) {
        const int b = tid * 16 + i * 4096, r = b >> 6, c = (b & 63) >> 1;
        __builtin_amdgcn_global_load_lds((const unsigned*)(A + (size_t)(brow + r) * lda + kt * 32 + c), (__attribute__((address_space(3))) unsigned*)((char*)SA + b), 16, 0, 0);
        __builtin_amdgcn_global_load_lds((const unsigned*)(Bt + (size_t)(bcol + r) * K + kt * 32 + c), (__attribute__((address_space(3))) unsigned*)((char*)SB + b), 16, 0, 0);
      }
      asm volatile("s_waitcnt vmcnt(0)" ::: "memory");
      __syncthreads();
      bf16x8 At[4], Bl[4];
#pragma unroll
      for (int m = 0; m < 4; ++m) At[m] = *(const bf16x8*)((const char*)SA + (wr * 64 + m * 16 + fr) * 64 + fq * 16);
#pragma unroll
      for (int n = 0; n < 4; ++n) Bl[n] = *(const bf16x8*)((const char*)SB + (wc * 64 + n * 16 + fr) * 64 + fq * 16);
#pragma unroll
      for (int m = 0; m < 4; ++m)
#pragma unroll
        for (int n = 0; n < 4; ++n) acc[m][n] = __builtin_amdgcn_mfma_f32_16x16x32_bf16(At[m], Bl[n], acc[m][n], 0, 0, 0);
      __syncthreads();
    }
#pragma unroll
    for (int m = 0; m < 4; ++m)
#pragma unroll
      for (int n = 0; n < 4; ++n)
#pragma unroll
        for (int j = 0; j < 4; ++j) {
          const int row = brow + wr * 64 + m * 16 + fq * 4 + j, col = bcol + wc * 64 + n * 16 + fr;
          const float v = acc[m][n][j];
          if (EPI == E_F32) ea.outf[(size_t)row * ea.ldc + col] = v;
          if (EPI == E_BF16) ea.outb[(size_t)row * ea.ldc + col] = f2bf(v);
          if (EPI == E_RESID) { size_t idx = (size_t)row * 1024 + col; ea.outf[idx] = ea.res[idx] + ea.gate[(size_t)(row >> 13) * 6144 + col] * v; }
          if (EPI == E_GLU) { float y = bf2f(ea.y5[(size_t)row * 512 + col]); ea.outb[(size_t)row * 1024 + 512 + col] = f2bf(y * sigmoid_(v + ea.bias[col])); }
          if (EPI == E_SWIGLU) {
            if ((n & 1) == 0) {
              const float u = acc[m][n | 1][j];
              const int co = (bcol >> 1) + wc * 32 + (n >> 1) * 16 + fr;
              ea.outb[(size_t)row * FF + co] = f2bf(silu_(v) * u);
            }
          }
        }
  }
}

constexpr int GT = 16;
__device__ void gdn_naive_item(const Params& p, int item, char* smem) {
  const int tid = threadIdx.x, b = item >> 2, h = item & 3;
  float* qs = (float*)smem; float* ks = qs + GT * 128; float* vs = ks + GT * 128; float* os = vs + GT * 128;
  float* rq = os + GT * 128; float* rk = rq + GT; float* eg = rk + GT; float* bt = eg + GT; float* ro = bt + GT;
  const float* proj = (const float*)(p.ws + OFF_PROJ);
  const float* beta = (const float*)(p.ws + OFF_BETA); const float* gg = (const float*)(p.ws + OFF_G);
  u16* concat = (u16*)(p.ws + OFF_HN);
  const int c = tid & 127;
  const int colA = (tid < 128 ? 0 : 512) + h * 128 + c;
  const int colB = 1024 + h * 128 + c;
  float wa[4], wb[4];
#pragma unroll
  for (int j = 0; j < 4; ++j) { wa[j] = p.hy_conv_w[j * 1536 + colA]; wb[j] = p.hy_conv_w[j * 1536 + colB]; }
  float a1 = 0, a2 = 0, a3 = 0, b1 = 0, b2 = 0, b3 = 0;
  float S[64];
#pragma unroll
  for (int d = 0; d < 64; ++d) S[d] = 0.f;
  const int rc = tid >> 1, rhalf = tid & 1;
  for (int t0 = 0; t0 < SEQ; t0 += GT) {
    const size_t rbase = (size_t)b * SEQ + t0;
    {
      float xa[GT], xb[GT];
#pragma unroll
      for (int tt = 0; tt < GT; ++tt) { xa[tt] = proj[(rbase + tt) * PN + colA]; xb[tt] = (tid < 128) ? proj[(rbase + tt) * PN + colB] : 0.f; }
#pragma unroll
      for (int tt = 0; tt < GT; ++tt) {
        float ya = wa[0] * a3 + wa[1] * a2 + wa[2] * a1 + wa[3] * xa[tt]; a3 = a2; a2 = a1; a1 = xa[tt];
        float yb = wb[0] * b3 + wb[1] * b2 + wb[2] * b1 + wb[3] * xb[tt]; b3 = b2; b2 = b1; b1 = xb[tt];
        if (tid < 128) { qs[tt * 128 + c] = silu_(ya); vs[tt * 128 + c] = silu_(yb); } else { ks[tt * 128 + c] = silu_(ya); }
      }
    }
    __syncthreads();
    {
      const int tok = tid >> 4, part = tid & 15;
      float sq = 0, sk = 0;
#pragma unroll
      for (int e = 0; e < 8; ++e) { float a = qs[tok * 128 + part * 8 + e], k = ks[tok * 128 + part * 8 + e]; sq += a * a; sk += k * k; }
#pragma unroll
      for (int o = 8; o >= 1; o >>= 1) { sq += __shfl_xor(sq, o); sk += __shfl_xor(sk, o); }
      if (part == 0) { rq[tok] = rsqrtf(sq + 1e-6f) * 0.08838834764831845f; rk[tok] = rsqrtf(sk + 1e-6f); }
      if (tid < GT) { eg[tid] = __expf(gg[(rbase + tid) * 4 + h]); bt[tid] = beta[(rbase + tid) * 4 + h]; }
    }
    __syncthreads();
    {
      for (int tt = 0; tt < GT; ++tt) {
        const float* kr = ks + tt * 128 + rhalf * 64; const float* qr = qs + tt * 128 + rhalf * 64;
        float kS = 0.f;
#pragma unroll
        for (int d = 0; d < 64; d += 4) { f32x4 k4 = *(const f32x4*)(kr + d); kS += k4[0] * S[d] + k4[1] * S[d + 1] + k4[2] * S[d + 2] + k4[3] * S[d + 3]; }
        kS += __shfl_xor(kS, 1);
        const float e = eg[tt], rkk = rk[tt];
        const float delta = bt[tt] * (vs[tt * 128 + rc] - e * kS * rkk) * rkk;
        float o = 0.f;
#pragma unroll
        for (int d = 0; d < 64; d += 4) {
          f32x4 k4 = *(const f32x4*)(kr + d); f32x4 q4 = *(const f32x4*)(qr + d);
#pragma unroll
          for (int e4 = 0; e4 < 4; ++e4) { S[d + e4] = e * S[d + e4] + k4[e4] * delta; o += q4[e4] * S[d + e4]; }
        }
        o += __shfl_xor(o, 1);
        if (rhalf == 0) os[tt * 128 + rc] = o * rq[tt];
      }
    }
    __syncthreads();
    {
      const int tok = tid >> 4, part = tid & 15;
      float so = 0;
#pragma unroll
      for (int e = 0; e < 8; ++e) { float a = os[tok * 128 + part * 8 + e]; so += a * a; }
#pragma unroll
      for (int o = 8; o >= 1; o >>= 1) so += __shfl_xor(so, o);
      if (part == 0) ro[tok] = rsqrtf(so * (1.f / 128.f) + 1e-6f);
    }
    __syncthreads();
#pragma unroll
    for (int i = 0; i < GT * 128 / 256; ++i) {
      const int idx = tid + i * 256, tok = idx >> 7, cc = idx & 127;
      const float z = proj[(rbase + tok) * PN + 1536 + h * 128 + cc];
      const float val = os[idx] * ro[tok] * p.hy_head_norm_w[cc] * silu_(z);
      concat[(rbase + tok) * 1024 + h * 128 + cc] = f2bf(val);
    }
    __syncthreads();
  }

}

__device__ void s5_naive_item(const Params& p, int item, float* part) {
  const int lane = threadIdx.x & 63, b = item >> 5, g = item & 31;
  const float dt = expf(p.s5_log_dt[g]);
  const float lr = p.s5_lam_re[g * 64 + lane], li = p.s5_lam_im[g * 64 + lane];
  const float mag = expf(lr * dt);
  float sn, cs; sincosf(li * dt, &sn, &cs);
  const float ar = mag * cs, ai = mag * sn;
  const float den = lr * lr + li * li, nr = ar - 1.f, ni = ai;
  const float fre = (nr * lr + ni * li) / den, fim = (ni * lr - nr * li) / den;
  float bbr[16], bbi[16], cr[16], ci[16];
#pragma unroll
  for (int h = 0; h < 16; ++h) {
    const float br = p.s5_b_re[(size_t)(g * 64 + lane) * 16 + h], bi = p.s5_b_im[(size_t)(g * 64 + lane) * 16 + h];
    bbr[h] = fre * br - fim * bi; bbi[h] = fre * bi + fim * br;
    cr[h] = p.s5_c_re[(size_t)(g * 16 + h) * 64 + lane]; ci[h] = p.s5_c_im[(size_t)(g * 16 + h) * 64 + lane];
  }
  float xr = 0.f, xi = 0.f;
  const float* ub = (const float*)(p.ws + OFF_PROJ) + (size_t)b * SEQ * PN + 2048 + g * 16;
  u16* y5 = (u16*)(p.ws + OFF_Y5);
  const int rtok = lane >> 5, rh = (lane >> 1) & 15, rhalf = lane & 1;
  const float dsk = p.s5_d[g * 16 + rh];
  for (int t = 0; t < SEQ; t += 2) {
#pragma unroll
    for (int tok = 0; tok < 2; ++tok) {
      const f32x4* up = (const f32x4*)(ub + (size_t)(t + tok) * PN);
      f32x4 u0 = up[0], u1 = up[1], u2 = up[2], u3 = up[3];
      float bur = 0.f, bui = 0.f;
#pragma unroll
      for (int e = 0; e < 4; ++e) {
        bur += bbr[e] * u0[e] + bbr[4 + e] * u1[e] + bbr[8 + e] * u2[e] + bbr[12 + e] * u3[e];
        bui += bbi[e] * u0[e] + bbi[4 + e] * u1[e] + bbi[8 + e] * u2[e] + bbi[12 + e] * u3[e];
      }
      const float nxr = ar * xr - ai * xi + bur, nxi = ar * xi + ai * xr + bui;
      xr = nxr; xi = nxi;
#pragma unroll
      for (int h = 0; h < 16; ++h) part[(tok * 16 + h) * 65 + lane] = cr[h] * xr - ci[h] * xi;
    }
    __syncthreads();
    {
      float s = 0.f;
      const float* pr = part + (rtok * 16 + rh) * 65 + rhalf * 32;
#pragma unroll
      for (int k = 0; k < 32; ++k) s += pr[k];
      s += __shfl_xor(s, 1);
      if (rhalf == 0) {
        const float uu = ub[(size_t)(t + rtok) * PN + rh];
        const float y = gelu_tanh_(s + dsk * uu);
        y5[((size_t)b * SEQ + t + rtok) * 512 + g * 16 + rh] = f2bf(y);
      }
    }
    __syncthreads();
  }
}

__device__ void mixer0_phase(const Params& p, char* smem, int bid, int nblk) {
  for (int it = bid; it < 48; it += nblk) {
    if (it < 16) gdn_naive_item(p, it, smem);
    else s5_naive_item(p, (it - 16) * 4 + (threadIdx.x >> 6), (float*)smem + (threadIdx.x >> 6) * (2 * 16 * 65));
    __syncthreads();
  }
}

__device__ void attn_naive_phase(const Params& p, char* smem, int bid, int nblk) {
  const int tid = threadIdx.x, r = tid >> 2, qd = tid & 3;
  float* Ks = (float*)smem; float* Vs = Ks + 32 * 128;
  const u16* qkv = (const u16*)(p.ws + OFF_PROJ);
  u16* ao = (u16*)(p.ws + OFF_HN);
  for (int k = 0; k * nblk < 4096; ++k) {
    const int i = (k & 1) ? ((k + 1) * nblk - 1 - bid) : (k * nblk + bid);
    if (i >= 4096) continue;
    const int j = 127 - (i >> 5), bh = i & 31, b = bh >> 3, h = bh & 7;
    const int i0 = j * 64, t = i0 + r;
    const size_t rowb = (size_t)b * SEQ;
    float q[32], o[32];
    {
      const u16* qp = qkv + (rowb + t) * 3072 + h * 128 + qd * 32;
#pragma unroll
      for (int d = 0; d < 32; d += 8) {
        u32x4 w = *(const u32x4*)(qp + d);
#pragma unroll
        for (int e = 0; e < 4; ++e) { q[d + 2 * e] = __uint_as_float(w[e] << 16) * 0.08838834764831845f; q[d + 2 * e + 1] = __uint_as_float(w[e] & 0xffff0000u) * 0.08838834764831845f; }
      }
#pragma unroll
      for (int d = 0; d < 32; ++d) o[d] = 0.f;
    }
    float run = 0.f;
    for (int kt = (i0 >> 5) + 1; kt >= 0; --kt) {
      const int k0 = kt * 32;
      {
        const int key = tid >> 3, c0 = (tid & 7) * 16;
        const u16* kp = qkv + (rowb + k0 + key) * 3072 + 1024 + h * 128 + c0;
        const u16* vp = kp + 1024;
#pragma unroll
        for (int hh = 0; hh < 2; ++hh) {
          u32x4 wk = *(const u32x4*)(kp + hh * 8), wv = *(const u32x4*)(vp + hh * 8);
          f32x4 k0v, k1v, v0v, v1v;
          k0v[0] = __uint_as_float(wk[0] << 16); k0v[1] = __uint_as_float(wk[0] & 0xffff0000u); k0v[2] = __uint_as_float(wk[1] << 16); k0v[3] = __uint_as_float(wk[1] & 0xffff0000u);
          k1v[0] = __uint_as_float(wk[2] << 16); k1v[1] = __uint_as_float(wk[2] & 0xffff0000u); k1v[2] = __uint_as_float(wk[3] << 16); k1v[3] = __uint_as_float(wk[3] & 0xffff0000u);
          v0v[0] = __uint_as_float(wv[0] << 16); v0v[1] = __uint_as_float(wv[0] & 0xffff0000u); v0v[2] = __uint_as_float(wv[1] << 16); v0v[3] = __uint_as_float(wv[1] & 0xffff0000u);
          v1v[0] = __uint_as_float(wv[2] << 16); v1v[1] = __uint_as_float(wv[2] & 0xffff0000u); v1v[2] = __uint_as_float(wv[3] << 16); v1v[3] = __uint_as_float(wv[3] & 0xffff0000u);
          *(f32x4*)(Ks + key * 128 + c0 + hh * 8) = k0v; *(f32x4*)(Ks + key * 128 + c0 + hh * 8 + 4) = k1v;
          *(f32x4*)(Vs + key * 128 + c0 + hh * 8) = v0v; *(f32x4*)(Vs + key * 128 + c0 + hh * 8 + 4) = v1v;
        }
      }
      __syncthreads();
      for (int s = 31; s >= 0; --s) {
        const float* kr = Ks + s * 128 + qd * 32; const float* vr = Vs + s * 128 + qd * 32;
        float z = 0.f;
#pragma unroll
        for (int d = 0; d < 32; d += 4) { f32x4 k4 = *(const f32x4*)(kr + d); z += q[d] * k4[0] + q[d + 1] * k4[1] + q[d + 2] * k4[2] + q[d + 3] * k4[3]; }
        z += __shfl_xor(z, 1); z += __shfl_xor(z, 2);
        const bool valid = (k0 + s) < t;
        const float sp = softplus_(z);
        const float w = valid ? __expf(z - sp + run) : 0.f;
        run += valid ? -sp : 0.f;
#pragma unroll
        for (int d = 0; d < 32; d += 4) { f32x4 v4 = *(const f32x4*)(vr + d); o[d] += w * v4[0]; o[d + 1] += w * v4[1]; o[d + 2] += w * v4[2]; o[d + 3] += w * v4[3]; }
      }
      __syncthreads();
    }
    {
      u16* op = ao + (rowb + t) * 1024 + h * 128 + qd * 32;
#pragma unroll
      for (int d = 0; d < 32; d += 8) {
        u32x4 w;
#pragma unroll
        for (int e = 0; e < 4; ++e) w[e] = (unsigned)f2bf(o[d + 2 * e]) | ((unsigned)f2bf(o[d + 2 * e + 1]) << 16);
        *(u32x4*)(op + d) = w;
      }
    }
  }
}

__global__ void __launch_bounds__(256, 2) mega(Params p) {
  __shared__ __attribute__((aligned(16))) char smem[SMEM_BYTES];
  const int bid = blockIdx.x, nblk = gridDim.x;
  char* ws = p.ws;
  const float* mod = (const float*)(ws + OFF_MOD);
  u16* hn = (u16*)(ws + OFF_HN);
#define PH_BEGIN(n) if (p.phase_lo <= (n) && (n) < p.phase_hi) {
#define PH_END(n) if ((n) + 1 < p.phase_hi) cg::this_grid().sync(); }
  PH_BEGIN(0) phase0(p, smem, bid, nblk); PH_END(0)
  PH_BEGIN(1) norm_phase<1>(p, p.x, p.norm_mix_w, mod, 0, 1024, smem, bid, nblk); PH_END(1)
  PH_BEGIN(2) { EpiArgs ea{}; ea.outf = (float*)(ws + OFF_PROJ); ea.ldc = PN;
        gemm_phase<E_F32>(hn, 1024, (const u16*)(ws + OFF_WT_HYIN), 1024, PN, ea, smem, bid, nblk); } PH_END(2)
  PH_BEGIN(3) mixer0_phase(p, smem, bid, nblk); PH_END(3)
  PH_BEGIN(4) { EpiArgs ea{}; ea.outb = hn; ea.y5 = (const u16*)(ws + OFF_Y5); ea.bias = p.s5_glu_b;
        gemm_phase<E_GLU>((const u16*)(ws + OFF_Y5), 512, (const u16*)(ws + OFF_WT_GLU), 512, 512, ea, smem, bid, nblk); } PH_END(4)
  PH_BEGIN(5) { EpiArgs ea{}; ea.outf = p.out; ea.res = p.x; ea.gate = mod + 2048;
        gemm_phase<E_RESID>(hn, 1024, (const u16*)(ws + OFF_WT_HYOUT), 1024, 1024, ea, smem, bid, nblk); } PH_END(5)
  PH_BEGIN(6) norm_phase<0>(p, p.out, p.norm_ffn_w, mod, 3072, 4096, smem, bid, nblk); PH_END(6)
  PH_BEGIN(7) { EpiArgs ea{}; ea.outb = (u16*)(ws + OFF_PROJ);
        gemm_phase<E_SWIGLU>(hn, 1024, (const u16*)(ws + OFF_WT_FFNIN), 1024, 2 * FF, ea, smem, bid, nblk); } PH_END(7)
  PH_BEGIN(8) { EpiArgs ea{}; ea.outf = p.out; ea.res = p.out; ea.gate = mod + 5120;
        gemm_phase<E_RESID>((const u16*)(ws + OFF_PROJ), FF, (const u16*)(ws + OFF_WT_FFNOUT), FF, 1024, ea, smem, bid, nblk); } PH_END(8)
  PH_BEGIN(9) norm_phase<0>(p, p.out, p.norm_mix_w + 1024, mod + 4 * 6144, 0, 1024, smem, bid, nblk); PH_END(9)
  PH_BEGIN(10) { EpiArgs ea{}; ea.outb = (u16*)(ws + OFF_PROJ); ea.ldc = 3072;
        gemm_phase<E_BF16>(hn, 1024, (const u16*)(ws + OFF_WT_SBIN), 1024, 3072, ea, smem, bid, nblk); } PH_END(10)
  PH_BEGIN(11) attn_naive_phase(p, smem, bid, nblk); PH_END(11)
  PH_BEGIN(12) { EpiArgs ea{}; ea.outf = p.out; ea.res = p.out; ea.gate = mod + 4 * 6144 + 2048;
        gemm_phase<E_RESID>(hn, 1024, (const u16*)(ws + OFF_WT_SBOUT), 1024, 1024, ea, smem, bid, nblk); } PH_END(12)
  PH_BEGIN(13) norm_phase<0>(p, p.out, p.norm_ffn_w + 1024, mod + 4 * 6144, 3072, 4096, smem, bid, nblk); PH_END(13)
  PH_BEGIN(14) { EpiArgs ea{}; ea.outb = (u16*)(ws + OFF_PROJ);
        gemm_phase<E_SWIGLU>(hn, 1024, (const u16*)(ws + OFF_WT_FFNIN + SZ_WT_FFNIN), 1024, 2 * FF, ea, smem, bid, nblk); } PH_END(14)
  PH_BEGIN(15) { EpiArgs ea{}; ea.outf = p.out; ea.res = p.out; ea.gate = mod + 4 * 6144 + 5120;
        gemm_phase<E_RESID>((const u16*)(ws + OFF_PROJ), FF, (const u16*)(ws + OFF_WT_FFNOUT + SZ_WT_FFNOUT), FF, 1024, ea, smem, bid, nblk); } PH_END(15)
  PH_BEGIN(16) norm_phase<2>(p, p.out, p.final_norm_w, mod, 0, 0, smem, bid, nblk); PH_END(16)
}

extern "C" void kernel_launch(void* const* d_in, const int* in_sizes, int n_in, void* d_out, int out_size, void* d_ws, size_t ws_size,
                              hipStream_t stream) {
  static int grid_blocks = 0;
  if (!grid_blocks) {
    int dev = 0, cus = 0, per_cu = 0;
    hipGetDevice(&dev);
    hipDeviceGetAttribute(&cus, hipDeviceAttributeMultiprocessorCount, dev);
    hipOccupancyMaxActiveBlocksPerMultiprocessor(&per_cu, mega, 256, 0);
    if (per_cu > 2) per_cu = 2;
    if (per_cu < 1) per_cu = 1;
    grid_blocks = cus * per_cu;
  }
  Params p{};
  const float* const* in = (const float* const*)d_in;
  p.x = in[0]; p.c = in[1]; p.ada_w = in[2]; p.ada_b = in[3]; p.norm_mix_w = in[4]; p.norm_ffn_w = in[5]; p.ffn_w_in = in[6]; p.ffn_w_out = in[7];
  p.hy_w_in = in[8]; p.hy_conv_w = in[9]; p.hy_a_log = in[10]; p.hy_dt_bias = in[11]; p.hy_head_norm_w = in[12];
  p.s5_lam_re = in[13]; p.s5_lam_im = in[14]; p.s5_log_dt = in[15]; p.s5_b_re = in[16]; p.s5_b_im = in[17]; p.s5_c_re = in[18]; p.s5_c_im = in[19];
  p.s5_d = in[20]; p.s5_glu_w = in[21]; p.s5_glu_b = in[22]; p.hy_w_out = in[23]; p.sb_w_in = in[24]; p.sb_w_out = in[25]; p.final_norm_w = in[26];
  p.out = (float*)d_out; p.ws = (char*)d_ws;
#if ONE_LAUNCH
  p.phase_lo = 0; p.phase_hi = NPHASE;
  void* args[] = {&p};
  hipError_t e = hipLaunchCooperativeKernel((void*)mega, dim3(grid_blocks), dim3(256), args, 0, stream);
  if (e != hipSuccess) fprintf(stderr, "cooperative launch failed: %s (grid %d)\n", hipGetErrorString(e), grid_blocks);
#else
  for (int ph = 0; ph < NPHASE; ++ph) {
    p.phase_lo = ph; p.phase_hi = ph + 1;
    hipLaunchKernelGGL(mega, dim3(grid_blocks), dim3(256), 0, stream, p);
  }
#endif
}
```

```cpp
#include <hip/hip_runtime.h>
#include <hip/hip_cooperative_groups.h>
#include <stdint.h>
#include <cstdio>
namespace cg = cooperative_groups;

#ifndef ONE_LAUNCH
#define ONE_LAUNCH 1
#endif

typedef unsigned short u16;
using bf16x8 = __attribute__((ext_vector_type(8))) short;
using f32x4 = __attribute__((ext_vector_type(4))) float;
using u32x4 = __attribute__((ext_vector_type(4))) unsigned;

constexpr int D = 1024, NB = 4, SEQ = 8192, M = NB * SEQ, FF = 2816, EIN = 2568, PN = 2560;
constexpr int NPHASE = 17;

constexpr size_t SZ_WT_HYIN = (size_t)PN * 1024 * 2, SZ_WT_SQ = (size_t)1024 * 1024 * 2, SZ_WT_GLU = (size_t)512 * 512 * 2;
constexpr size_t SZ_WT_FFNIN = (size_t)2 * FF * 1024 * 2, SZ_WT_FFNOUT = (size_t)1024 * FF * 2, SZ_WT_SBIN = (size_t)3072 * 1024 * 2;
constexpr size_t OFF_WT_HYIN = 0;
constexpr size_t OFF_WT_HYOUT = OFF_WT_HYIN + SZ_WT_HYIN;
constexpr size_t OFF_WT_GLU = OFF_WT_HYOUT + SZ_WT_SQ;
constexpr size_t OFF_WT_FFNIN = OFF_WT_GLU + SZ_WT_GLU;
constexpr size_t OFF_WT_FFNOUT = OFF_WT_FFNIN + 2 * SZ_WT_FFNIN;
constexpr size_t OFF_WT_SBIN = OFF_WT_FFNOUT + 2 * SZ_WT_FFNOUT;
constexpr size_t OFF_WT_SBOUT = OFF_WT_SBIN + SZ_WT_SBIN;
constexpr size_t OFF_MOD = OFF_WT_SBOUT + SZ_WT_SQ;
constexpr size_t OFF_BETA = OFF_MOD + (size_t)2 * 4 * 6144 * 4;
constexpr size_t OFF_G = OFF_BETA + (size_t)M * 4 * 4;
constexpr size_t OFF_HN = OFF_G + (size_t)M * 4 * 4;
constexpr size_t OFF_Y5 = OFF_HN + (size_t)M * 1024 * 2;
constexpr size_t OFF_PROJ = OFF_Y5 + (size_t)M * 512 * 2;
constexpr size_t WS_TOTAL = OFF_PROJ + (size_t)M * PN * 4;
static_assert(WS_TOTAL <= (size_t)512 * 1024 * 1024, "workspace too large");

struct Params {
  const float *x, *c, *ada_w, *ada_b, *norm_mix_w, *norm_ffn_w, *ffn_w_in, *ffn_w_out;
  const float *hy_w_in, *hy_conv_w, *hy_a_log, *hy_dt_bias, *hy_head_norm_w;
  const float *s5_lam_re, *s5_lam_im, *s5_log_dt, *s5_b_re, *s5_b_im, *s5_c_re, *s5_c_im, *s5_d, *s5_glu_w, *s5_glu_b, *hy_w_out;
  const float *sb_w_in, *sb_w_out, *final_norm_w;
  float* out;
  char* ws;
  int phase_lo, phase_hi;
};

constexpr int SMEM_BYTES = 48 * 1024;

__device__ __forceinline__ u16 f2bf(float x) { unsigned u = __float_as_uint(x); u += 0x7fffu + ((u >> 16) & 1u); return (u16)(u >> 16); }
__device__ __forceinline__ float bf2f(u16 v) { return __uint_as_float(((unsigned)v) << 16); }
__device__ __forceinline__ float sigmoid_(float x) { return 1.f / (1.f + __expf(-x)); }
__device__ __forceinline__ float silu_(float x) { return x * sigmoid_(x); }
__device__ __forceinline__ float softplus_(float x) { return fmaxf(x, 0.f) + log1pf(__expf(-fabsf(x))); }
__device__ __forceinline__ float gelu_tanh_(float y) { return 0.5f * y * (1.f + tanhf(0.7978845608028654f * (y + 0.044715f * y * y * y))); }

struct TrJob { const float* src; u16* dst; int K, Nsrc, Nd, mode; };
__device__ __forceinline__ TrJob get_job(const Params& p, int j) {
  TrJob t;
  switch (j) {
    case 0: t = {p.hy_w_in, (u16*)(p.ws + OFF_WT_HYIN), 1024, EIN, PN, 1}; break;
    case 1: t = {p.hy_w_out, (u16*)(p.ws + OFF_WT_HYOUT), 1024, 1024, 1024, 0}; break;
    case 2: t = {p.s5_glu_w, (u16*)(p.ws + OFF_WT_GLU), 512, 512, 512, 0}; break;
    case 3: t = {p.ffn_w_in, (u16*)(p.ws + OFF_WT_FFNIN), 1024, 2 * FF, 2 * FF, 2}; break;
    case 4: t = {p.ffn_w_in + (size_t)1024 * 2 * FF, (u16*)(p.ws + OFF_WT_FFNIN + SZ_WT_FFNIN), 1024, 2 * FF, 2 * FF, 2}; break;
    case 5: t = {p.ffn_w_out, (u16*)(p.ws + OFF_WT_FFNOUT), FF, 1024, 1024, 0}; break;
    case 6: t = {p.ffn_w_out + (size_t)FF * 1024, (u16*)(p.ws + OFF_WT_FFNOUT + SZ_WT_FFNOUT), FF, 1024, 1024, 0}; break;
    case 7: t = {p.sb_w_in, (u16*)(p.ws + OFF_WT_SBIN), 1024, 3072, 3072, 0}; break;
    default: t = {p.sb_w_out, (u16*)(p.ws + OFF_WT_SBOUT), 1024, 1024, 1024, 0}; break;
  }
  return t;
}
__device__ __forceinline__ int src_col(int R, int mode) {
  if (mode == 0) return R;
  if (mode == 1) return R < 2048 ? R : R + 8;
  return ((R >> 4) & 1) * FF + (R >> 5) * 16 + (R & 15);
}
constexpr int N_TR_ITEMS = 640 + 256 + 64 + 2 * 1408 + 2 * 704 + 768 + 256;
constexpr int N_MOD_ITEMS = 2 * 6144 / 64;

__device__ __forceinline__ void phase0(const Params& p, char* smem, int bid, int nblk) {
  const int tid = threadIdx.x;
  for (int it = bid; it < N_TR_ITEMS + N_MOD_ITEMS; it += nblk) {
    if (it < N_TR_ITEMS) {
      int rem = it, j = 0; TrJob jb;
      for (;; ++j) { jb = get_job(p, j); int n = (jb.Nd >> 6) * (jb.K >> 6); if (rem < n) break; rem -= n; }
      const int nk = jb.K >> 6, R0 = (rem / nk) * 64, k0 = (rem % nk) * 64;
      u16* s = (u16*)smem;
      {
        const int r = tid & 63, kk = tid >> 6;
        const float* sp = jb.src + (size_t)k0 * jb.Nsrc + src_col(R0 + r, jb.mode);
#pragma unroll
        for (int i = 0; i < 16; ++i) { int k = kk + 4 * i; s[r * 72 + k] = f2bf(sp[(size_t)k * jb.Nsrc]); }
      }
      __syncthreads();
      {
        const int r = tid >> 2, ch = tid & 3;
#pragma unroll
        for (int i = 0; i < 2; ++i) {
          int c8 = (ch + 4 * i) * 8;
          *(u32x4*)(jb.dst + (size_t)(R0 + r) * jb.K + k0 + c8) = *(const u32x4*)(s + r * 72 + c8);
        }
      }
      __syncthreads();
    } else {
      const int mi = it - N_TR_ITEMS, l = mi / 96, n0 = (mi % 96) * 64;
      float* cact = (float*)smem;
      float* red = cact + 4096;
      for (int i = tid; i < 4096; i += 256) cact[i] = silu_(p.c[i]);
      __syncthreads();
      const int wid = tid >> 6, lane = tid & 63;
      float a0 = 0, a1 = 0, a2 = 0, a3 = 0;
      const float* wp = p.ada_w + (size_t)l * 1024 * 6144 + n0 + lane;
#pragma unroll 8
      for (int k = wid * 256; k < wid * 256 + 256; ++k) {
        float w = wp[(size_t)k * 6144];
        a0 += cact[k] * w; a1 += cact[1024 + k] * w; a2 += cact[2048 + k] * w; a3 += cact[3072 + k] * w;
      }
      red[(wid * 4 + 0) * 64 + lane] = a0; red[(wid * 4 + 1) * 64 + lane] = a1;
      red[(wid * 4 + 2) * 64 + lane] = a2; red[(wid * 4 + 3) * 64 + lane] = a3;
      __syncthreads();
      {
        const int b = tid >> 6;
        float sum = red[(0 * 4 + b) * 64 + lane] + red[(1 * 4 + b) * 64 + lane] + red[(2 * 4 + b) * 64 + lane] + red[(3 * 4 + b) * 64 + lane];
        float* mod = (float*)(p.ws + OFF_MOD);
        mod[(size_t)(l * 4 + b) * 6144 + n0 + lane] = sum + p.ada_b[l * 6144 + n0 + lane];
      }
      __syncthreads();
    }
  }
}

template <int MODE>
__device__ __forceinline__ void norm_phase(const Params& p, const float* src, const float* w, const float* modl, int sh_off, int sc_off,
                           char* smem, int bid, int nblk) {
  const int tid = threadIdx.x, wid = tid >> 6, lane = tid & 63;
  float* wba = (float*)smem;
  if (MODE == 1) {
    for (int i = tid; i < 1024 * 8; i += 256) wba[i] = p.hy_w_in[(size_t)(i >> 3) * EIN + 2048 + (i & 7)];
    __syncthreads();
  }
  u16* hn = (u16*)(p.ws + OFF_HN);
  for (int row = bid * 4 + wid; row < M; row += nblk * 4) {
    const float* sp = src + (size_t)row * 1024;
    f32x4 v[4]; float ss = 0;
#pragma unroll
    for (int i = 0; i < 4; ++i) { v[i] = *(const f32x4*)(sp + i * 256 + lane * 4); ss += v[i][0] * v[i][0] + v[i][1] * v[i][1] + v[i][2] * v[i][2] + v[i][3] * v[i][3]; }
#pragma unroll
    for (int o = 32; o >= 1; o >>= 1) ss += __shfl_xor(ss, o);
    const float rstd = rsqrtf(ss * (1.f / 1024.f) + 1e-6f);
    const int b = row >> 13;
    float dots[8];
    if (MODE == 1) { for (int j = 0; j < 8; ++j) dots[j] = 0.f; }
#pragma unroll
    for (int i = 0; i < 4; ++i) {
      const int c0 = i * 256 + lane * 4;
      f32x4 ww = *(const f32x4*)(w + c0);
      f32x4 y;
      if (MODE == 2) {
#pragma unroll
        for (int e = 0; e < 4; ++e) y[e] = v[i][e] * rstd * ww[e];
        *(f32x4*)(p.out + (size_t)row * 1024 + c0) = y;
      } else {
        f32x4 sc = *(const f32x4*)(modl + (size_t)b * 6144 + sc_off + c0);
        f32x4 sh = *(const f32x4*)(modl + (size_t)b * 6144 + sh_off + c0);
#pragma unroll
        for (int e = 0; e < 4; ++e) y[e] = v[i][e] * rstd * ww[e] * (1.f + sc[e]) + sh[e];
        uint2 pk; pk.x = (unsigned)f2bf(y[0]) | ((unsigned)f2bf(y[1]) << 16); pk.y = (unsigned)f2bf(y[2]) | ((unsigned)f2bf(y[3]) << 16);
        *(uint2*)(hn + (size_t)row * 1024 + c0) = pk;
        if (MODE == 1) {
#pragma unroll
          for (int e = 0; e < 4; ++e) {
            f32x4 w0 = *(const f32x4*)(wba + (c0 + e) * 8), w1 = *(const f32x4*)(wba + (c0 + e) * 8 + 4);
#pragma unroll
            for (int j = 0; j < 4; ++j) { dots[j] += y[e] * w0[j]; dots[4 + j] += y[e] * w1[j]; }
          }
        }
      }
    }
    if (MODE == 1) {
#pragma unroll
      for (int j = 0; j < 8; ++j) {
#pragma unroll
        for (int o = 32; o >= 1; o >>= 1) dots[j] += __shfl_xor(dots[j], o);
      }
      if (lane == 0) {
        float* beta = (float*)(p.ws + OFF_BETA); float* gg = (float*)(p.ws + OFF_G);
#pragma unroll
        for (int h = 0; h < 4; ++h) {
          beta[(size_t)row * 4 + h] = sigmoid_(dots[h]);
          gg[(size_t)row * 4 + h] = -__expf(p.hy_a_log[h]) * softplus_(dots[4 + h] + p.hy_dt_bias[h]);
        }
      }
    }
  }
}

enum { E_F32 = 0, E_BF16 = 1, E_RESID = 2, E_GLU = 3, E_SWIGLU = 4 };
struct EpiArgs { float* outf; u16* outb; const float* res; const float* gate; const u16* y5; const float* bias; int ldc; };

template <int EPI>
__device__ __forceinline__ void gemm_phase(const u16* __restrict__ A, int lda, const u16* __restrict__ Bt, int K, int N, const EpiArgs ea,
                           char* smem, int bid, int nblk) {
  const int tid = threadIdx.x, wid = tid >> 6, lane = tid & 63, wr = wid >> 1, wc = wid & 1, fr = lane & 15, fq = lane >> 4;
  u16* SA = (u16*)smem; u16* SB = SA + 128 * 32;
  const int nN = N >> 7, ntiles = (M >> 7) * nN, nk = K >> 5;
  for (int t = bid; t < ntiles; t += nblk) {
    const int brow = (t / nN) << 7, bcol = (t % nN) << 7;
    f32x4 acc[4][4];
#pragma unroll
    for (int m = 0; m < 4; ++m)
#pragma unroll
      for (int n = 0; n < 4; ++n) acc[m][n] = f32x4{0.f, 0.f, 0.f, 0.f};
    for (int kt = 0; kt < nk; ++kt) {
#pragma unroll
      for (int i = 0; i < 2; ++i) {
        const int b = tid * 16 + i * 4096, r = b >> 6, c = (b & 63) >> 1;
        __builtin_amdgcn_global_load_lds((const unsigned*)(A + (size_t)(brow + r) * lda + kt * 32 + c), (__attribute__((address_space(3))) unsigned*)((char*)SA + b), 16, 0, 0);
        __builtin_amdgcn_global_load_lds((const unsigned*)(Bt + (size_t)(bcol + r) * K + kt * 32 + c), (__attribute__((address_space(3))) unsigned*)((char*)SB + b), 16, 0, 0);
      }
      asm volatile("s_waitcnt vmcnt(0)" ::: "memory");
      __syncthreads();
      bf16x8 At[4], Bl[4];
#pragma unroll
      for (int m = 0; m < 4; ++m) At[m] = *(const bf16x8*)((const char*)SA + (wr * 64 + m * 16 + fr) * 64 + fq * 16);
#pragma unroll
      for (int n = 0; n < 4; ++n) Bl[n] = *(const bf16x8*)((const char*)SB + (wc * 64 + n * 16 + fr) * 64 + fq * 16);
#pragma unroll
      for (int m = 0; m < 4; ++m)
#pragma unroll
        for (int n = 0; n < 4; ++n) acc[m][n] = __builtin_amdgcn_mfma_f32_16x16x32_bf16(At[m], Bl[n], acc[m][n], 0, 0, 0);
      __syncthreads();
    }
#pragma unroll
    for (int m = 0; m < 4; ++m)
#pragma unroll
      for (int n = 0; n < 4; ++n)
#pragma unroll
        for (int j = 0; j < 4; ++j) {
          const int row = brow + wr * 64 + m * 16 + fq * 4 + j, col = bcol + wc * 64 + n * 16 + fr;
          const float v = acc[m][n][j];
          if (EPI == E_F32) ea.outf[(size_t)row * ea.ldc + col] = v;
          if (EPI == E_BF16) ea.outb[(size_t)row * ea.ldc + col] = f2bf(v);
          if (EPI == E_RESID) { size_t idx = (size_t)row * 1024 + col; ea.outf[idx] = ea.res[idx] + ea.gate[(size_t)(row >> 13) * 6144 + col] * v; }
          if (EPI == E_GLU) { float y = bf2f(ea.y5[(size_t)row * 512 + col]); ea.outb[(size_t)row * 1024 + 512 + col] = f2bf(y * sigmoid_(v + ea.bias[col])); }
          if (EPI == E_SWIGLU) {
            if ((n & 1) == 0) {
              const float u = acc[m][n | 1][j];
              const int co = (bcol >> 1) + wc * 32 + (n >> 1) * 16 + fr;
              ea.outb[(size_t)row * FF + co] = f2bf(silu_(v) * u);
            }
          }
        }
  }
}

constexpr int GT = 16;
__device__ __forceinline__ void gdn_naive_item(const Params& p, int item, char* smem) {
  const int tid = threadIdx.x, b = item >> 2, h = item & 3;
  float* qs = (float*)smem; float* ks = qs + GT * 128; float* vs = ks + GT * 128; float* os = vs + GT * 128;
  float* rq = os + GT * 128; float* rk = rq + GT; float* eg = rk + GT; float* bt = eg + GT; float* ro = bt + GT;
  const float* proj = (const float*)(p.ws + OFF_PROJ);
  const float* beta = (const float*)(p.ws + OFF_BETA); const float* gg = (const float*)(p.ws + OFF_G);
  u16* concat = (u16*)(p.ws + OFF_HN);
  const int c = tid & 127;
  const int colA = (tid < 128 ? 0 : 512) + h * 128 + c;
  const int colB = 1024 + h * 128 + c;
  float wa[4], wb[4];
#pragma unroll
  for (int j = 0; j < 4; ++j) { wa[j] = p.hy_conv_w[j * 1536 + colA]; wb[j] = p.hy_conv_w[j * 1536 + colB]; }
  float a1 = 0, a2 = 0, a3 = 0, b1 = 0, b2 = 0, b3 = 0;
  float S[64];
#pragma unroll
  for (int d = 0; d < 64; ++d) S[d] = 0.f;
  const int rc = tid >> 1, rhalf = tid & 1;
  for (int t0 = 0; t0 < SEQ; t0 += GT) {
    const size_t rbase = (size_t)b * SEQ + t0;
    {
      float xa[GT], xb[GT];
#pragma unroll
      for (int tt = 0; tt < GT; ++tt) { xa[tt] = proj[(rbase + tt) * PN + colA]; xb[tt] = (tid < 128) ? proj[(rbase + tt) * PN + colB] : 0.f; }
#pragma unroll
      for (int tt = 0; tt < GT; ++tt) {
        float ya = wa[0] * a3 + wa[1] * a2 + wa[2] * a1 + wa[3] * xa[tt]; a3 = a2; a2 = a1; a1 = xa[tt];
        float yb = wb[0] * b3 + wb[1] * b2 + wb[2] * b1 + wb[3] * xb[tt]; b3 = b2; b2 = b1; b1 = xb[tt];
        if (tid < 128) { qs[tt * 128 + c] = silu_(ya); vs[tt * 128 + c] = silu_(yb); } else { ks[tt * 128 + c] = silu_(ya); }
      }
    }
    __syncthreads();
    {
      const int tok = tid >> 4, part = tid & 15;
      float sq = 0, sk = 0;
#pragma unroll
      for (int e = 0; e < 8; ++e) { float a = qs[tok * 128 + part * 8 + e], k = ks[tok * 128 + part * 8 + e]; sq += a * a; sk += k * k; }
#pragma unroll
      for (int o = 8; o >= 1; o >>= 1) { sq += __shfl_xor(sq, o); sk += __shfl_xor(sk, o); }
      if (part == 0) { rq[tok] = rsqrtf(sq + 1e-6f) * 0.08838834764831845f; rk[tok] = rsqrtf(sk + 1e-6f); }
      if (tid < GT) { eg[tid] = __expf(gg[(rbase + tid) * 4 + h]); bt[tid] = beta[(rbase + tid) * 4 + h]; }
    }
    __syncthreads();
    {
      for (int tt = 0; tt < GT; ++tt) {
        const float* kr = ks + tt * 128 + rhalf * 64; const float* qr = qs + tt * 128 + rhalf * 64;
        float kS = 0.f;
#pragma unroll
        for (int d = 0; d < 64; d += 4) { f32x4 k4 = *(const f32x4*)(kr + d); kS += k4[0] * S[d] + k4[1] * S[d + 1] + k4[2] * S[d + 2] + k4[3] * S[d + 3]; }
        kS += __shfl_xor(kS, 1);
        const float e = eg[tt], rkk = rk[tt];
        const float delta = bt[tt] * (vs[tt * 128 + rc] - e * kS * rkk) * rkk;
        float o = 0.f;
#pragma unroll
        for (int d = 0; d < 64; d += 4) {
          f32x4 k4 = *(const f32x4*)(kr + d); f32x4 q4 = *(const f32x4*)(qr + d);
#pragma unroll
          for (int e4 = 0; e4 < 4; ++e4) { S[d + e4] = e * S[d + e4] + k4[e4] * delta; o += q4[e4] * S[d + e4]; }
        }
        o += __shfl_xor(o, 1);
        if (rhalf == 0) os[tt * 128 + rc] = o * rq[tt];
      }
    }
    __syncthreads();
    {
      const int tok = tid >> 4, part = tid & 15;
      float so = 0;
#pragma unroll
      for (int e = 0; e < 8; ++e) { float a = os[tok * 128 + part * 8 + e]; so += a * a; }
#pragma unroll
      for (int o = 8; o >= 1; o >>= 1) so += __shfl_xor(so, o);
      if (part == 0) ro[tok] = rsqrtf(so * (1.f / 128.f) + 1e-6f);
    }
    __syncthreads();
#pragma unroll
    for (int i = 0; i < GT * 128 / 256; ++i) {
      const int idx = tid + i * 256, tok = idx >> 7, cc = idx & 127;
      const float z = proj[(rbase + tok) * PN + 1536 + h * 128 + cc];
      const float val = os[idx] * ro[tok] * p.hy_head_norm_w[cc] * silu_(z);
      concat[(rbase + tok) * 1024 + h * 128 + cc] = f2bf(val);
    }
    __syncthreads();
  }

}

__device__ __forceinline__ void s5_naive_item(const Params& p, int item, float* part) {
  const int lane = threadIdx.x & 63, b = item >> 5, g = item & 31;
  const float dt = expf(p.s5_log_dt[g]);
  const float lr = p.s5_lam_re[g * 64 + lane], li = p.s5_lam_im[g * 64 + lane];
  const float mag = expf(lr * dt);
  float sn, cs; sincosf(li * dt, &sn, &cs);
  const float ar = mag * cs, ai = mag * sn;
  const float den = lr * lr + li * li, nr = ar - 1.f, ni = ai;
  const float fre = (nr * lr + ni * li) / den, fim = (ni * lr - nr * li) / den;
  float bbr[16], bbi[16], cr[16], ci[16];
#pragma unroll
  for (int h = 0; h < 16; ++h) {
    const float br = p.s5_b_re[(size_t)(g * 64 + lane) * 16 + h], bi = p.s5_b_im[(size_t)(g * 64 + lane) * 16 + h];
    bbr[h] = fre * br - fim * bi; bbi[h] = fre * bi + fim * br;
    cr[h] = p.s5_c_re[(size_t)(g * 16 + h) * 64 + lane]; ci[h] = p.s5_c_im[(size_t)(g * 16 + h) * 64 + lane];
  }
  float xr = 0.f, xi = 0.f;
  const float* ub = (const float*)(p.ws + OFF_PROJ) + (size_t)b * SEQ * PN + 2048 + g * 16;
  u16* y5 = (u16*)(p.ws + OFF_Y5);
  const int rtok = lane >> 5, rh = (lane >> 1) & 15, rhalf = lane & 1;
  const float dsk = p.s5_d[g * 16 + rh];
  for (int t = 0; t < SEQ; t += 2) {
#pragma unroll
    for (int tok = 0; tok < 2; ++tok) {
      const f32x4* up = (const f32x4*)(ub + (size_t)(t + tok) * PN);
      f32x4 u0 = up[0], u1 = up[1], u2 = up[2], u3 = up[3];
      float bur = 0.f, bui = 0.f;
#pragma unroll
      for (int e = 0; e < 4; ++e) {
        bur += bbr[e] * u0[e] + bbr[4 + e] * u1[e] + bbr[8 + e] * u2[e] + bbr[12 + e] * u3[e];
        bui += bbi[e] * u0[e] + bbi[4 + e] * u1[e] + bbi[8 + e] * u2[e] + bbi[12 + e] * u3[e];
      }
      const float nxr = ar * xr - ai * xi + bur, nxi = ar * xi + ai * xr + bui;
      xr = nxr; xi = nxi;
#pragma unroll
      for (int h = 0; h < 16; ++h) part[(tok * 16 + h) * 65 + lane] = cr[h] * xr - ci[h] * xi;
    }
    __syncthreads();
    {
      float s = 0.f;
      const float* pr = part + (rtok * 16 + rh) * 65 + rhalf * 32;
#pragma unroll
      for (int k = 0; k < 32; ++k) s += pr[k];
      s += __shfl_xor(s, 1);
      if (rhalf == 0) {
        const float uu = ub[(size_t)(t + rtok) * PN + rh];
        const float y = gelu_tanh_(s + dsk * uu);
        y5[((size_t)b * SEQ + t + rtok) * 512 + g * 16 + rh] = f2bf(y);
      }
    }
    __syncthreads();
  }
}

__device__ __forceinline__ void mixer0_phase(const Params& p, char* smem, int bid, int nblk) {
  for (int it = bid; it < 48; it += nblk) {
    if (it < 16) gdn_naive_item(p, it, smem);
    else s5_naive_item(p, (it - 16) * 4 + (threadIdx.x >> 6), (float*)smem + (threadIdx.x >> 6) * (2 * 16 * 65));
    __syncthreads();
  }
}

using s16x4 = __attribute__((ext_vector_type(4))) short;
using f32x16 = __attribute__((ext_vector_type(16))) float;
#define KSWZ(row, colB) ((row) * 256 + ((colB) ^ (((row) & 7) << 4)))
#define SBAR() __builtin_amdgcn_sched_barrier(0)
__device__ __forceinline__ int crow(int r, int hi) { return (r & 3) + 8 * (r >> 2) + 4 * hi; }
__device__ __forceinline__ unsigned cvtpk(float lo, float hi) { unsigned r; asm volatile("v_cvt_pk_bf16_f32 %0, %1, %2" : "=v"(r) : "v"(lo), "v"(hi)); return r; }
__device__ __forceinline__ int v_st(int k, int c) { const int kk = (k & ~0xC) | ((k & 4) << 1) | ((k & 8) >> 1); return ((kk >> 3) * 4 + (c >> 5)) * 512 + ((kk & 7) * 32 + (c & 31)) * 2; }
__device__ __forceinline__ int v_rd_base(int lane) { return ((lane & 3) << 3) | (((lane >> 2) & 3) << 6) | (((lane >> 4) & 1) << 5) | (((lane >> 5) & 1) << 8); }
constexpr int v_rd_off(int d0, int ks, int half) { return d0 * 512 + ks * 4096 + half * 2048; }
template <int OFF> __device__ __forceinline__ s16x4 tr_read(int vb) {
  s16x4 r; asm volatile("ds_read_b64_tr_b16 %0, %1 offset:%2" : "=&v"(r) : "v"(vb), "i"(OFF) : "memory"); return r;
}
template <int D0> __device__ __forceinline__ void pv_one(f32x16& od, int vb, bf16x8 pa0, bf16x8 pa1, bf16x8 pa2, bf16x8 pa3) {
  const s16x4 l0 = tr_read<v_rd_off(D0, 0, 0)>(vb), h0 = tr_read<v_rd_off(D0, 0, 1)>(vb), l1 = tr_read<v_rd_off(D0, 1, 0)>(vb), h1 = tr_read<v_rd_off(D0, 1, 1)>(vb);
  const s16x4 l2 = tr_read<v_rd_off(D0, 2, 0)>(vb), h2 = tr_read<v_rd_off(D0, 2, 1)>(vb), l3 = tr_read<v_rd_off(D0, 3, 0)>(vb), h3 = tr_read<v_rd_off(D0, 3, 1)>(vb);
  asm volatile("s_waitcnt lgkmcnt(0)" ::: "memory"); SBAR();
#define PK(L, H) (bf16x8){L[0], L[1], L[2], L[3], H[0], H[1], H[2], H[3]}
  od = __builtin_amdgcn_mfma_f32_32x32x16_bf16(pa0, PK(l0, h0), od, 0, 0, 0);
  od = __builtin_amdgcn_mfma_f32_32x32x16_bf16(pa1, PK(l1, h1), od, 0, 0, 0);
  od = __builtin_amdgcn_mfma_f32_32x32x16_bf16(pa2, PK(l2, h2), od, 0, 0, 0);
  od = __builtin_amdgcn_mfma_f32_32x32x16_bf16(pa3, PK(l3, h3), od, 0, 0, 0);
#undef PK
}
__device__ __forceinline__ float pl32_other(float a, float b, int hi) {
  auto rr = __builtin_amdgcn_permlane32_swap(__float_as_uint(a), __float_as_uint(b), false, false);
  return __uint_as_float(hi ? rr[0] : rr[1]);
}
__device__ __forceinline__ void sb_half(f32x16& pz, float& run, bool need_mask, int kb, int t, int hi) {
  constexpr float SC = 0.08838834764831845f;
  f32x16 l;
#pragma unroll
  for (int r = 0; r < 16; ++r) {
    const float z = pz[r] * SC;
    l[r] = -(fmaxf(z, 0.f) + __logf(1.f + __expf(-fabsf(z))));
    pz[r] = z;
  }
  if (need_mask) {
#pragma unroll
    for (int r = 0; r < 16; ++r) { if (kb + crow(r, hi) >= t) l[r] = 0.f; }
  }
#pragma unroll
  for (int g = 0; g < 4; ++g) { l[4 * g + 2] += l[4 * g + 3]; l[4 * g + 1] += l[4 * g + 2]; l[4 * g] += l[4 * g + 1]; }
  const float cs3 = l[12], cs2 = l[8] + cs3, cs1 = l[4] + cs2, cs0 = l[0] + cs1;
  const float off0 = cs1 + pl32_other(cs0, cs1, hi) + run;
  const float off1 = cs2 + pl32_other(cs1, cs2, hi) + run;
  const float off2 = cs3 + pl32_other(cs2, cs3, hi) + run;
  const float off3 = pl32_other(cs3, 0.f, hi) + run;
  float tot;
  { auto rr = __builtin_amdgcn_permlane32_swap(__float_as_uint(cs0), __float_as_uint(cs0), false, false); tot = __uint_as_float(rr[0]) + __uint_as_float(rr[1]); }
#pragma unroll
  for (int r = 0; r < 4; ++r) {
    pz[r] = __expf(pz[r] + l[r] + off0); pz[4 + r] = __expf(pz[4 + r] + l[4 + r] + off1);
    pz[8 + r] = __expf(pz[8 + r] + l[8 + r] + off2); pz[12 + r] = __expf(pz[12 + r] + l[12 + r] + off3);
  }
  if (need_mask) {
#pragma unroll
    for (int r = 0; r < 16; ++r) { if (kb + crow(r, hi) >= t) pz[r] = 0.f; }
  }
  run += tot;
}

__device__ __forceinline__ void attn_phase(const Params& p, char* smem, int bid, int nblk) {
  const int tid = threadIdx.x, wid = tid >> 6, lane = tid & 63, r32 = lane & 31, hi = lane >> 5;
  char* K_lds = smem; char* V_lds = smem + 16384;
  const u16* qkv = (const u16*)(p.ws + OFF_PROJ);
  u16* ao = (u16*)(p.ws + OFF_HN);
  const int sr = tid >> 4, sc = (tid & 15) * 8;
  const int vb0 = (int)(uintptr_t)V_lds + v_rd_base(lane);
  for (int k = 0; k * nblk < 2048; ++k) {
    const int i = (k & 1) ? ((k + 1) * nblk - 1 - bid) : (k * nblk + bid);
    if (i >= 2048) continue;
    const int j = 63 - (i >> 5), bh = i & 31, b = bh >> 3, h = bh & 7;
    const int i0 = j * 128;
    const size_t rowb = (size_t)b * SEQ;
    const int t = i0 + wid * 32 + r32, tmin = i0 + wid * 32, tmax = tmin + 31;
    bf16x8 qr[8];
    {
      const u16* qp = qkv + (rowb + t) * 3072 + h * 128 + hi * 8;
#pragma unroll
      for (int d0 = 0; d0 < 8; ++d0) qr[d0] = *(const bf16x8*)(qp + d0 * 16);
    }
    f32x16 o[4];
#pragma unroll
    for (int d = 0; d < 4; ++d)
#pragma unroll
      for (int r = 0; r < 16; ++r) o[d][r] = 0.f;
    float run = 0.f;
    const u16* kbase = qkv + rowb * 3072 + 1024 + h * 128 + sc;
    u32x4 stk[4], stv[4];
#define SLOAD(KT) do { _Pragma("unroll") for (int ii = 0; ii < 4; ++ii) { const u16* kp = kbase + (size_t)((KT) * 64 + sr + 16 * ii) * 3072; \
      stk[ii] = *(const u32x4*)kp; stv[ii] = *(const u32x4*)(kp + 1024); } } while (0)
#define SWRITE() do { _Pragma("unroll") for (int ii = 0; ii < 4; ++ii) { const int row = sr + 16 * ii; \
      *(u32x4*)(K_lds + KSWZ(row, sc * 2)) = stk[ii]; *(u32x4*)(V_lds + v_st(row, sc)) = stv[ii]; } } while (0)
    const int NT = 2 * j + 2;
    SLOAD(NT - 1); SWRITE(); __syncthreads();
    for (int kt = NT - 1; kt >= 0; --kt) {
      const int k0 = kt * 64;
      if (k0 <= tmax) {
        bf16x8 pa0, pa1, pa2, pa3;
#define PK4(P, BASE, OUT) do { unsigned a0 = cvtpk(P[BASE + 0], P[BASE + 1]), a1 = cvtpk(P[BASE + 2], P[BASE + 3]); \
    unsigned b0_ = cvtpk(P[BASE + 4], P[BASE + 5]), b1_ = cvtpk(P[BASE + 6], P[BASE + 7]); \
    auto r0 = __builtin_amdgcn_permlane32_swap(a0, b0_, false, false); auto r1 = __builtin_amdgcn_permlane32_swap(a1, b1_, false, false); \
    u32x4 w = {r0[0], r1[0], r0[1], r1[1]}; OUT = *reinterpret_cast<bf16x8*>(&w); } while (0)
        if (k0 + 32 <= tmax) {
          f32x16 pz;
#pragma unroll
          for (int r = 0; r < 16; ++r) pz[r] = 0.f;
#pragma unroll
          for (int d0 = 0; d0 < 8; ++d0) {
            const bf16x8 kf = *(const bf16x8*)(K_lds + KSWZ(32 + r32, (d0 * 16 + hi * 8) * 2));
            pz = __builtin_amdgcn_mfma_f32_32x32x16_bf16(kf, qr[d0], pz, 0, 0, 0);
          }
          sb_half(pz, run, k0 + 63 >= tmin, k0 + 32, t, hi);
          PK4(pz, 0, pa2); PK4(pz, 8, pa3);
        } else {
          pa2 = bf16x8{0, 0, 0, 0, 0, 0, 0, 0}; pa3 = pa2;
        }
        {
          f32x16 pz;
#pragma unroll
          for (int r = 0; r < 16; ++r) pz[r] = 0.f;
#pragma unroll
          for (int d0 = 0; d0 < 8; ++d0) {
            const bf16x8 kf = *(const bf16x8*)(K_lds + KSWZ(r32, (d0 * 16 + hi * 8) * 2));
            pz = __builtin_amdgcn_mfma_f32_32x32x16_bf16(kf, qr[d0], pz, 0, 0, 0);
          }
          sb_half(pz, run, k0 + 31 >= tmin, k0, t, hi);
          PK4(pz, 0, pa0); PK4(pz, 8, pa1);
        }
#undef PK4
        if (kt > 0) SLOAD(kt - 1);
        pv_one<0>(o[0], vb0, pa0, pa1, pa2, pa3); pv_one<1>(o[1], vb0, pa0, pa1, pa2, pa3);
        pv_one<2>(o[2], vb0, pa0, pa1, pa2, pa3); pv_one<3>(o[3], vb0, pa0, pa1, pa2, pa3);
      } else {
        if (kt > 0) SLOAD(kt - 1);
      }
      __syncthreads();
      if (kt > 0) SWRITE();
      __syncthreads();
    }
#undef SLOAD
#undef SWRITE
    {
      u16* op = ao + (rowb + i0 + wid * 32) * 1024 + h * 128 + r32;
#pragma unroll
      for (int r = 0; r < 16; ++r) {
        const int orow = crow(r, hi);
#pragma unroll
        for (int d0 = 0; d0 < 4; ++d0) op[(size_t)orow * 1024 + d0 * 32] = f2bf(o[d0][r]);
      }
    }
  }
}

__global__ void __launch_bounds__(256, 2) mega(Params p) {
  __shared__ __attribute__((aligned(16))) char smem[SMEM_BYTES];
  const int bid = blockIdx.x, nblk = gridDim.x;
  char* ws = p.ws;
  const float* mod = (const float*)(ws + OFF_MOD);
  u16* hn = (u16*)(ws + OFF_HN);
#define PH_BEGIN(n) if (p.phase_lo <= (n) && (n) < p.phase_hi) {
#define PH_END(n) if ((n) + 1 < p.phase_hi) cg::this_grid().sync(); }
  PH_BEGIN(0) phase0(p, smem, bid, nblk); PH_END(0)
  PH_BEGIN(1) norm_phase<1>(p, p.x, p.norm_mix_w, mod, 0, 1024, smem, bid, nblk); PH_END(1)
  PH_BEGIN(2) { EpiArgs ea{}; ea.outf = (float*)(ws + OFF_PROJ); ea.ldc = PN;
        gemm_phase<E_F32>(hn, 1024, (const u16*)(ws + OFF_WT_HYIN), 1024, PN, ea, smem, bid, nblk); } PH_END(2)
  PH_BEGIN(3) mixer0_phase(p, smem, bid, nblk); PH_END(3)
  PH_BEGIN(4) { EpiArgs ea{}; ea.outb = hn; ea.y5 = (const u16*)(ws + OFF_Y5); ea.bias = p.s5_glu_b;
        gemm_phase<E_GLU>((const u16*)(ws + OFF_Y5), 512, (const u16*)(ws + OFF_WT_GLU), 512, 512, ea, smem, bid, nblk); } PH_END(4)
  PH_BEGIN(5) { EpiArgs ea{}; ea.outf = p.out; ea.res = p.x; ea.gate = mod + 2048;
        gemm_phase<E_RESID>(hn, 1024, (const u16*)(ws + OFF_WT_HYOUT), 1024, 1024, ea, smem, bid, nblk); } PH_END(5)
  PH_BEGIN(6) norm_phase<0>(p, p.out, p.norm_ffn_w, mod, 3072, 4096, smem, bid, nblk); PH_END(6)
  PH_BEGIN(7) { EpiArgs ea{}; ea.outb = (u16*)(ws + OFF_PROJ);
        gemm_phase<E_SWIGLU>(hn, 1024, (const u16*)(ws + OFF_WT_FFNIN), 1024, 2 * FF, ea, smem, bid, nblk); } PH_END(7)
  PH_BEGIN(8) { EpiArgs ea{}; ea.outf = p.out; ea.res = p.out; ea.gate = mod + 5120;
        gemm_phase<E_RESID>((const u16*)(ws + OFF_PROJ), FF, (const u16*)(ws + OFF_WT_FFNOUT), FF, 1024, ea, smem, bid, nblk); } PH_END(8)
  PH_BEGIN(9) norm_phase<0>(p, p.out, p.norm_mix_w + 1024, mod + 4 * 6144, 0, 1024, smem, bid, nblk); PH_END(9)
  PH_BEGIN(10) { EpiArgs ea{}; ea.outb = (u16*)(ws + OFF_PROJ); ea.ldc = 3072;
        gemm_phase<E_BF16>(hn, 1024, (const u16*)(ws + OFF_WT_SBIN), 1024, 3072, ea, smem, bid, nblk); } PH_END(10)
  PH_BEGIN(11) attn_phase(p, smem, bid, nblk); PH_END(11)
  PH_BEGIN(12) { EpiArgs ea{}; ea.outf = p.out; ea.res = p.out; ea.gate = mod + 4 * 6144 + 2048;
        gemm_phase<E_RESID>(hn, 1024, (const u16*)(ws + OFF_WT_SBOUT), 1024, 1024, ea, smem, bid, nblk); } PH_END(12)
  PH_BEGIN(13) norm_phase<0>(p, p.out, p.norm_ffn_w + 1024, mod + 4 * 6144, 3072, 4096, smem, bid, nblk); PH_END(13)
  PH_BEGIN(14) { EpiArgs ea{}; ea.outb = (u16*)(ws + OFF_PROJ);
        gemm_phase<E_SWIGLU>(hn, 1024, (const u16*)(ws + OFF_WT_FFNIN + SZ_WT_FFNIN), 1024, 2 * FF, ea, smem, bid, nblk); } PH_END(14)
  PH_BEGIN(15) { EpiArgs ea{}; ea.outf = p.out; ea.res = p.out; ea.gate = mod + 4 * 6144 + 5120;
        gemm_phase<E_RESID>((const u16*)(ws + OFF_PROJ), FF, (const u16*)(ws + OFF_WT_FFNOUT + SZ_WT_FFNOUT), FF, 1024, ea, smem, bid, nblk); } PH_END(15)
  PH_BEGIN(16) norm_phase<2>(p, p.out, p.final_norm_w, mod, 0, 0, smem, bid, nblk); PH_END(16)
}

extern "C" void kernel_launch(void* const* d_in, const int* in_sizes, int n_in, void* d_out, int out_size, void* d_ws, size_t ws_size,
                              hipStream_t stream) {
  static int grid_blocks = 0;
  if (!grid_blocks) {
    int dev = 0, cus = 0, per_cu = 0;
    hipGetDevice(&dev);
    hipDeviceGetAttribute(&cus, hipDeviceAttributeMultiprocessorCount, dev);
    hipOccupancyMaxActiveBlocksPerMultiprocessor(&per_cu, mega, 256, 0);
    if (per_cu > 2) per_cu = 2;
    if (per_cu < 1) per_cu = 1;
    grid_blocks = cus * per_cu;
  }
  Params p{};
  const float* const* in = (const float* const*)d_in;
  p.x = in[0]; p.c = in[1]; p.ada_w = in[2]; p.ada_b = in[3]; p.norm_mix_w = in[4]; p.norm_ffn_w = in[5]; p.ffn_w_in = in[6]; p.ffn_w_out = in[7];
  p.hy_w_in = in[8]; p.hy_conv_w = in[9]; p.hy_a_log = in[10]; p.hy_dt_bias = in[11]; p.hy_head_norm_w = in[12];
  p.s5_lam_re = in[13]; p.s5_lam_im = in[14]; p.s5_log_dt = in[15]; p.s5_b_re = in[16]; p.s5_b_im = in[17]; p.s5_c_re = in[18]; p.s5_c_im = in[19];
  p.s5_d = in[20]; p.s5_glu_w = in[21]; p.s5_glu_b = in[22]; p.hy_w_out = in[23]; p.sb_w_in = in[24]; p.sb_w_out = in[25]; p.final_norm_w = in[26];
  p.out = (float*)d_out; p.ws = (char*)d_ws;
#if ONE_LAUNCH
  p.phase_lo = 0; p.phase_hi = NPHASE;
  void* args[] = {&p};
  hipError_t e = hipLaunchCooperativeKernel((void*)mega, dim3(grid_blocks), dim3(256), args, 0, stream);
  if (e != hipSuccess) fprintf(stderr, "cooperative launch failed: %s (grid %d)\n", hipGetErrorString(e), grid_blocks);
#else
  for (int ph = 0; ph < NPHASE; ++ph) {
    p.phase_lo = ph; p.phase_hi = ph + 1;
    hipLaunchKernelGGL(mega, dim3(grid_blocks), dim3(256), 0, stream, p);
  }
#endif
}
```

```cpp
#include <hip/hip_runtime.h>
#include <hip/hip_cooperative_groups.h>
#include <stdint.h>
#include <cstdio>
namespace cg = cooperative_groups;

#ifndef ONE_LAUNCH
#define ONE_LAUNCH 1
#endif

typedef unsigned short u16;
using bf16x8 = __attribute__((ext_vector_type(8))) short;
using f32x4 = __attribute__((ext_vector_type(4))) float;
using u32x4 = __attribute__((ext_vector_type(4))) unsigned;

constexpr int D = 1024, NB = 4, SEQ = 8192, M = NB * SEQ, FF = 2816, EIN = 2568, PN = 2560, PJ = 2048;
constexpr int NPHASE = 19;
constexpr int S5T = 32, S5C = M / S5T, UXW = 640;

constexpr size_t SZ_WT_HYIN = (size_t)PN * 1024 * 2, SZ_WT_SQ = (size_t)1024 * 1024 * 2, SZ_WT_GLU = (size_t)512 * 512 * 2;
constexpr size_t SZ_WT_FFNIN = (size_t)2 * FF * 1024 * 2, SZ_WT_FFNOUT = (size_t)1024 * FF * 2, SZ_WT_SBIN = (size_t)3072 * 1024 * 2;
constexpr size_t OFF_WT_HYIN = 0;
constexpr size_t OFF_WT_HYOUT = OFF_WT_HYIN + SZ_WT_HYIN;
constexpr size_t OFF_WT_GLU = OFF_WT_HYOUT + SZ_WT_SQ;
constexpr size_t OFF_WT_FFNIN = OFF_WT_GLU + SZ_WT_GLU;
constexpr size_t OFF_WT_FFNOUT = OFF_WT_FFNIN + 2 * SZ_WT_FFNIN;
constexpr size_t OFF_WT_SBIN = OFF_WT_FFNOUT + 2 * SZ_WT_FFNOUT;
constexpr size_t OFF_WT_SBOUT = OFF_WT_SBIN + SZ_WT_SBIN;
constexpr size_t OFF_MOD = OFF_WT_SBOUT + SZ_WT_SQ;
constexpr size_t OFF_BETA = OFF_MOD + (size_t)2 * 4 * 6144 * 4;
constexpr size_t OFF_G = OFF_BETA + (size_t)M * 4 * 4;
constexpr size_t OFF_HN = OFF_G + (size_t)M * 4 * 4;
constexpr size_t OFF_Y5 = OFF_HN + (size_t)M * 1024 * 2;
constexpr size_t OFF_UX = OFF_Y5 + (size_t)M * 512 * 2;
constexpr size_t OFF_MF = OFF_UX + (size_t)32 * S5C * UXW * 2;
constexpr size_t OFF_EG = OFF_MF + (size_t)32 * 512 * UXW * 2;
constexpr size_t OFF_XE = OFF_EG + (size_t)32 * 128 * 512 * 2;
constexpr size_t OFF_A32 = OFF_XE + (size_t)32 * S5C * 128 * 4;
constexpr size_t OFF_PROJ = OFF_A32 + (size_t)32 * 64 * 2 * 4;
constexpr size_t WS_TOTAL = OFF_PROJ + (size_t)M * PJ * 4;
static_assert(WS_TOTAL <= (size_t)512 * 1024 * 1024, "workspace too large");

struct Params {
  const float *x, *c, *ada_w, *ada_b, *norm_mix_w, *norm_ffn_w, *ffn_w_in, *ffn_w_out;
  const float *hy_w_in, *hy_conv_w, *hy_a_log, *hy_dt_bias, *hy_head_norm_w;
  const float *s5_lam_re, *s5_lam_im, *s5_log_dt, *s5_b_re, *s5_b_im, *s5_c_re, *s5_c_im, *s5_d, *s5_glu_w, *s5_glu_b, *hy_w_out;
  const float *sb_w_in, *sb_w_out, *final_norm_w;
  float* out;
  char* ws;
  int phase_lo, phase_hi;
};

constexpr int SMEM_BYTES = 48 * 1024;

__device__ __forceinline__ int otid() { int t = __builtin_amdgcn_workitem_id_x(); asm volatile("" : "+v"(t)); return t; }
__device__ __forceinline__ u16 f2bf(float x) { unsigned u = __float_as_uint(x); u += 0x7fffu + ((u >> 16) & 1u); return (u16)(u >> 16); }
__device__ __forceinline__ float bf2f(u16 v) { return __uint_as_float(((unsigned)v) << 16); }
__device__ __forceinline__ float sigmoid_(float x) { return 1.f / (1.f + __expf(-x)); }
__device__ __forceinline__ float silu_(float x) { return x * sigmoid_(x); }
__device__ __forceinline__ float softplus_(float x) { return fmaxf(x, 0.f) + log1pf(__expf(-fabsf(x))); }
__device__ __forceinline__ float gelu_tanh_(float y) { return 0.5f * y * (1.f + tanhf(0.7978845608028654f * (y + 0.044715f * y * y * y))); }

struct TrJob { const float* src; u16* dst; int K, Nsrc, Nd, mode; };
__device__ __forceinline__ TrJob get_job(const Params& p, int j) {
  TrJob t;
  switch (j) {
    case 0: t = {p.hy_w_in, (u16*)(p.ws + OFF_WT_HYIN), 1024, EIN, PN, 1}; break;
    case 1: t = {p.hy_w_out, (u16*)(p.ws + OFF_WT_HYOUT), 1024, 1024, 1024, 0}; break;
    case 2: t = {p.s5_glu_w, (u16*)(p.ws + OFF_WT_GLU), 512, 512, 512, 0}; break;
    case 3: t = {p.ffn_w_in, (u16*)(p.ws + OFF_WT_FFNIN), 1024, 2 * FF, 2 * FF, 2}; break;
    case 4: t = {p.ffn_w_in + (size_t)1024 * 2 * FF, (u16*)(p.ws + OFF_WT_FFNIN + SZ_WT_FFNIN), 1024, 2 * FF, 2 * FF, 2}; break;
    case 5: t = {p.ffn_w_out, (u16*)(p.ws + OFF_WT_FFNOUT), FF, 1024, 1024, 0}; break;
    case 6: t = {p.ffn_w_out + (size_t)FF * 1024, (u16*)(p.ws + OFF_WT_FFNOUT + SZ_WT_FFNOUT), FF, 1024, 1024, 0}; break;
    case 7: t = {p.sb_w_in, (u16*)(p.ws + OFF_WT_SBIN), 1024, 3072, 3072, 0}; break;
    default: t = {p.sb_w_out, (u16*)(p.ws + OFF_WT_SBOUT), 1024, 1024, 1024, 0}; break;
  }
  return t;
}
__device__ __forceinline__ int src_col(int R, int mode) {
  if (mode == 0) return R;
  if (mode == 1) return R < 2048 ? R : R + 8;
  return ((R >> 4) & 1) * FF + (R >> 5) * 16 + (R & 15);
}
constexpr int N_TR_ITEMS = 640 + 256 + 64 + 2 * 1408 + 2 * 704 + 768 + 256;
constexpr int N_MOD_ITEMS = 2 * 6144 / 64;

__device__ __forceinline__ void s5_table_item(const Params& p, int item, char* smem) {
  const int tid = otid(), g = item >> 5, tau = item & 31;
  float* pwr = (float*)smem; float* pwi = pwr + 64; float* p1r = pwi + 64; float* p1i = p1r + 64;
  float* bbr = p1i + 64; float* bbi = bbr + 1024; float* cre = bbi + 1024; float* cim = cre + 1024;
  const float dt = expf(p.s5_log_dt[g]);
  if (tid < 64) {
    const float lr = p.s5_lam_re[g * 64 + tid], li = p.s5_lam_im[g * 64 + tid];
    float sn, cs;
    float mg = expf(lr * dt * (float)tau); sincosf(li * dt * (float)tau, &sn, &cs); pwr[tid] = mg * cs; pwi[tid] = mg * sn;
    mg = expf(lr * dt * (float)(tau + 1)); sincosf(li * dt * (float)(tau + 1), &sn, &cs); p1r[tid] = mg * cs; p1i[tid] = mg * sn;
    if (tau == 31) { float* a32 = (float*)(p.ws + OFF_A32); a32[(g * 64 + tid) * 2] = mg * cs; a32[(g * 64 + tid) * 2 + 1] = mg * sn; }
  }
  {
    const int pp = tid >> 2, hq = (tid & 3) * 4;
    const float lr = p.s5_lam_re[g * 64 + pp], li = p.s5_lam_im[g * 64 + pp];
    const float mg = expf(lr * dt); float sn, cs; sincosf(li * dt, &sn, &cs);
    const float ar = mg * cs, ai = mg * sn, den = lr * lr + li * li, nr = ar - 1.f, ni = ai;
    const float fre = (nr * lr + ni * li) / den, fim = (ni * lr - nr * li) / den;
#pragma unroll
    for (int e = 0; e < 4; ++e) {
      const float br = p.s5_b_re[(size_t)(g * 64 + pp) * 16 + hq + e], bi = p.s5_b_im[(size_t)(g * 64 + pp) * 16 + hq + e];
      bbr[pp * 16 + hq + e] = fre * br - fim * bi; bbi[pp * 16 + hq + e] = fre * bi + fim * br;
    }
    for (int i = tid; i < 1024; i += 256) { cre[i] = p.s5_c_re[(size_t)g * 1024 + i]; cim[i] = p.s5_c_im[(size_t)g * 1024 + i]; }
  }
  __syncthreads();
  u16* mf = (u16*)(p.ws + OFF_MF) + (size_t)g * 512 * UXW;
  u16* eg = (u16*)(p.ws + OFF_EG) + (size_t)g * 128 * 512;
  {
    const int h = tid >> 4, hp = tid & 15;
    float kv = 0.f;
    for (int pp = 0; pp < 64; ++pp) {
      const float cr = cre[h * 64 + pp], ci = cim[h * 64 + pp], pr = pwr[pp], pi = pwi[pp];
      kv += (cr * pr - ci * pi) * bbr[pp * 16 + hp] - (cr * pi + ci * pr) * bbi[pp * 16 + hp];
    }
    const u16 kb = f2bf(kv);
    for (int s0 = 0; s0 + tau < 32; ++s0) mf[(size_t)((s0 + tau) * 16 + h) * UXW + s0 * 16 + hp] = kb;
    for (int t0 = 0; t0 + tau + 1 < 32; ++t0) mf[(size_t)(t0 * 16 + h) * UXW + (t0 + tau + 1) * 16 + hp] = 0;
#pragma unroll
    for (int e = 0; e < 4; ++e) {
      const int pp = hp * 4 + e;
      const float cr = cre[h * 64 + pp], ci = cim[h * 64 + pp], pr = p1r[pp], pi = p1i[pp];
      mf[(size_t)(tau * 16 + h) * UXW + 512 + pp] = f2bf(cr * pr - ci * pi);
      mf[(size_t)(tau * 16 + h) * UXW + 576 + pp] = f2bf(-(cr * pi + ci * pr));
    }
  }
  {
    const int pp = tid >> 2, hq = (tid & 3) * 4, s0 = 31 - tau;
#pragma unroll
    for (int e = 0; e < 4; ++e) {
      const float br = bbr[pp * 16 + hq + e], bi = bbi[pp * 16 + hq + e], pr = pwr[pp], pi = pwi[pp];
      eg[(size_t)pp * 512 + s0 * 16 + hq + e] = f2bf(pr * br - pi * bi);
      eg[(size_t)(64 + pp) * 512 + s0 * 16 + hq + e] = f2bf(pr * bi + pi * br);
    }
  }
  __syncthreads();
}

__device__ __forceinline__ void phase0(const Params& p, char* smem, int bid, int nblk) {
  const int tid = otid();
  for (int it = bid; it < N_TR_ITEMS + N_MOD_ITEMS + 1024; it += nblk) {
    if (it >= N_TR_ITEMS + N_MOD_ITEMS) { s5_table_item(p, it - N_TR_ITEMS - N_MOD_ITEMS, smem); continue; }
    if (it < N_TR_ITEMS) {
      int rem = it, j = 0; TrJob jb;
      for (;; ++j) { jb = get_job(p, j); int n = (jb.Nd >> 6) * (jb.K >> 6); if (rem < n) break; rem -= n; }
      const int nk = jb.K >> 6, R0 = (rem / nk) * 64, k0 = (rem % nk) * 64;
      u16* s = (u16*)smem;
      {
        const int r = tid & 63, kk = tid >> 6;
        const float* sp = jb.src + (size_t)k0 * jb.Nsrc + src_col(R0 + r, jb.mode);
#pragma unroll
        for (int i = 0; i < 16; ++i) { int k = kk + 4 * i; s[r * 72 + k] = f2bf(sp[(size_t)k * jb.Nsrc]); }
      }
      __syncthreads();
      {
        const int r = tid >> 2, ch = tid & 3;
#pragma unroll
        for (int i = 0; i < 2; ++i) {
          int c8 = (ch + 4 * i) * 8;
          *(u32x4*)(jb.dst + (size_t)(R0 + r) * jb.K + k0 + c8) = *(const u32x4*)(s + r * 72 + c8);
        }
      }
      __syncthreads();
    } else {
      const int mi = it - N_TR_ITEMS, l = mi / 96, n0 = (mi % 96) * 64;
      float* cact = (float*)smem;
      float* red = cact + 4096;
      for (int i = tid; i < 4096; i += 256) cact[i] = silu_(p.c[i]);
      __syncthreads();
      const int wid = tid >> 6, lane = tid & 63;
      float a0 = 0, a1 = 0, a2 = 0, a3 = 0;
      const float* wp = p.ada_w + (size_t)l * 1024 * 6144 + n0 + lane;
#pragma unroll 8
      for (int k = wid * 256; k < wid * 256 + 256; ++k) {
        float w = wp[(size_t)k * 6144];
        a0 += cact[k] * w; a1 += cact[1024 + k] * w; a2 += cact[2048 + k] * w; a3 += cact[3072 + k] * w;
      }
      red[(wid * 4 + 0) * 64 + lane] = a0; red[(wid * 4 + 1) * 64 + lane] = a1;
      red[(wid * 4 + 2) * 64 + lane] = a2; red[(wid * 4 + 3) * 64 + lane] = a3;
      __syncthreads();
      {
        const int b = tid >> 6;
        float sum = red[(0 * 4 + b) * 64 + lane] + red[(1 * 4 + b) * 64 + lane] + red[(2 * 4 + b) * 64 + lane] + red[(3 * 4 + b) * 64 + lane];
        float* mod = (float*)(p.ws + OFF_MOD);
        mod[(size_t)(l * 4 + b) * 6144 + n0 + lane] = sum + p.ada_b[l * 6144 + n0 + lane];
      }
      __syncthreads();
    }
  }
}

template <int MODE>
__device__ __forceinline__ void norm_phase(const Params& p, const float* src, const float* w, const float* modl, int sh_off, int sc_off,
                           char* smem, int bid, int nblk) {
  const int tid = otid(), wid = tid >> 6, lane = tid & 63;
  float* wba = (float*)smem;
  if (MODE == 1) {
    for (int i = tid; i < 1024 * 8; i += 256) wba[i] = p.hy_w_in[(size_t)(i >> 3) * EIN + 2048 + (i & 7)];
    __syncthreads();
  }
  u16* hn = (u16*)(p.ws + OFF_HN);
  for (int row = bid * 4 + wid; row < M; row += nblk * 4) {
    const float* sp = src + (size_t)row * 1024;
    f32x4 v[4]; float ss = 0;
#pragma unroll
    for (int i = 0; i < 4; ++i) { v[i] = *(const f32x4*)(sp + i * 256 + lane * 4); ss += v[i][0] * v[i][0] + v[i][1] * v[i][1] + v[i][2] * v[i][2] + v[i][3] * v[i][3]; }
#pragma unroll
    for (int o = 32; o >= 1; o >>= 1) ss += __shfl_xor(ss, o);
    const float rstd = rsqrtf(ss * (1.f / 1024.f) + 1e-6f);
    const int b = row >> 13;
    float dots[8];
    if (MODE == 1) { for (int j = 0; j < 8; ++j) dots[j] = 0.f; }
#pragma unroll
    for (int i = 0; i < 4; ++i) {
      const int c0 = i * 256 + lane * 4;
      f32x4 ww = *(const f32x4*)(w + c0);
      f32x4 y;
      if (MODE == 2) {
#pragma unroll
        for (int e = 0; e < 4; ++e) y[e] = v[i][e] * rstd * ww[e];
        *(f32x4*)(p.out + (size_t)row * 1024 + c0) = y;
      } else {
        f32x4 sc = *(const f32x4*)(modl + (size_t)b * 6144 + sc_off + c0);
        f32x4 sh = *(const f32x4*)(modl + (size_t)b * 6144 + sh_off + c0);
#pragma unroll
        for (int e = 0; e < 4; ++e) y[e] = v[i][e] * rstd * ww[e] * (1.f + sc[e]) + sh[e];
        uint2 pk; pk.x = (unsigned)f2bf(y[0]) | ((unsigned)f2bf(y[1]) << 16); pk.y = (unsigned)f2bf(y[2]) | ((unsigned)f2bf(y[3]) << 16);
        *(uint2*)(hn + (size_t)row * 1024 + c0) = pk;
        if (MODE == 1) {
#pragma unroll
          for (int e = 0; e < 4; ++e) {
            f32x4 w0 = *(const f32x4*)(wba + (c0 + e) * 8), w1 = *(const f32x4*)(wba + (c0 + e) * 8 + 4);
#pragma unroll
            for (int j = 0; j < 4; ++j) { dots[j] += y[e] * w0[j]; dots[4 + j] += y[e] * w1[j]; }
          }
        }
      }
    }
    if (MODE == 1) {
#pragma unroll
      for (int j = 0; j < 8; ++j) {
#pragma unroll
        for (int o = 32; o >= 1; o >>= 1) dots[j] += __shfl_xor(dots[j], o);
      }
      if (lane == 0) {
        float* beta = (float*)(p.ws + OFF_BETA); float* gg = (float*)(p.ws + OFF_G);
#pragma unroll
        for (int h = 0; h < 4; ++h) {
          beta[(size_t)row * 4 + h] = sigmoid_(dots[h]);
          gg[(size_t)row * 4 + h] = -__expf(p.hy_a_log[h]) * softplus_(dots[4 + h] + p.hy_dt_bias[h]);
        }
      }
    }
  }
}

enum { E_PROJ0 = 0, E_BF16 = 1, E_RESID = 2, E_GLU = 3, E_SWIGLU = 4, E_XE = 5, E_S5Y = 6 };
struct EpiArgs { float* outf; u16* outb; const float* res; const float* gate; const u16* y5; const float* bias; u16* ux; int ldc; };

template <int EPI>
__device__ __forceinline__ void gemm_phase(const u16* __restrict__ A0, int lda, size_t sA, const u16* __restrict__ B0, int ldb, size_t sB,
                                           int K, int nM, int nN, int nbatch, const EpiArgs ea, char* smem, int bid, int nblk) {
  const int tid = otid(), wid = tid >> 6, lane = tid & 63, wr = wid >> 1, wc = wid & 1, fr = lane & 15, fq = lane >> 4;
  u16* SA = (u16*)smem; u16* SB = SA + 128 * 32;
  const int ntiles = nbatch * nM * nN;
#pragma unroll 1
  for (int t = bid; t < ntiles; t += nblk) {
    const int g = t / (nM * nN), rem = t % (nM * nN);
    const int brow = (rem / nN) << 7, bcol = (rem % nN) << 7;
    const u16* A = A0 + (size_t)g * sA; const u16* Bt = B0 + (size_t)g * sB;
    int nk = K >> 5, klim = nk;
    if (EPI == E_S5Y) { klim = 4 * ((bcol >> 7) + 1); nk = klim + 4; }
    f32x4 acc[4][4];
#pragma unroll
    for (int m = 0; m < 4; ++m)
#pragma unroll
      for (int n = 0; n < 4; ++n) acc[m][n] = f32x4{0.f, 0.f, 0.f, 0.f};
#pragma unroll 1
    for (int kk = 0; kk < nk; ++kk) {
      const int kt = (EPI == E_S5Y && kk >= klim) ? (16 + kk - klim) : kk;
#pragma unroll
      for (int i = 0; i < 2; ++i) {
        const int b = tid * 16 + i * 4096, r = b >> 6, c = (b & 63) >> 1;
        __builtin_amdgcn_global_load_lds((const unsigned*)(A + (size_t)(brow + r) * lda + kt * 32 + c), (__attribute__((address_space(3))) unsigned*)((char*)SA + b), 16, 0, 0);
        __builtin_amdgcn_global_load_lds((const unsigned*)(Bt + (size_t)(bcol + r) * ldb + kt * 32 + c), (__attribute__((address_space(3))) unsigned*)((char*)SB + b), 16, 0, 0);
      }
      asm volatile("s_waitcnt vmcnt(0)" ::: "memory");
      __syncthreads();
      bf16x8 At[4], Bl[4];
#pragma unroll
      for (int m = 0; m < 4; ++m) At[m] = *(const bf16x8*)((const char*)SA + (wr * 64 + m * 16 + fr) * 64 + fq * 16);
#pragma unroll
      for (int n = 0; n < 4; ++n) Bl[n] = *(const bf16x8*)((const char*)SB + (wc * 64 + n * 16 + fr) * 64 + fq * 16);
#pragma unroll
      for (int m = 0; m < 4; ++m)
#pragma unroll
        for (int n = 0; n < 4; ++n) acc[m][n] = __builtin_amdgcn_mfma_f32_16x16x32_bf16(At[m], Bl[n], acc[m][n], 0, 0, 0);
      __syncthreads();
    }
#pragma unroll
    for (int m = 0; m < 4; ++m)
#pragma unroll
      for (int n = 0; n < 4; ++n)
#pragma unroll
        for (int j = 0; j < 4; ++j) {
          const int row = brow + wr * 64 + m * 16 + fq * 4 + j, col = bcol + wc * 64 + n * 16 + fr;
          const float v = acc[m][n][j];
          if (EPI == E_PROJ0) {
            if (bcol < 2048) ea.outf[(size_t)row * PJ + col] = v;
            else { const int cc = col - 2048; ea.ux[((size_t)(cc >> 4) * S5C + (row >> 5)) * UXW + (row & 31) * 16 + (cc & 15)] = f2bf(v); }
          }
          if (EPI == E_BF16) ea.outb[(size_t)row * ea.ldc + col] = f2bf(v);
          if (EPI == E_RESID) { size_t idx = (size_t)row * 1024 + col; ea.outf[idx] = ea.res[idx] + ea.gate[(size_t)(row >> 13) * 6144 + col] * v; }
          if (EPI == E_GLU) { float y = bf2f(ea.y5[(size_t)row * 512 + col]); ea.outb[(size_t)row * 1024 + 512 + col] = f2bf(y * sigmoid_(v + ea.bias[col])); }
          if (EPI == E_SWIGLU) {
            if ((n & 1) == 0) {
              const float u = acc[m][n | 1][j];
              const int co = (bcol >> 1) + wc * 32 + (n >> 1) * 16 + fr;
              ea.outb[(size_t)row * FF + co] = f2bf(silu_(v) * u);
            }
          }
          if (EPI == E_XE) ea.outf[((size_t)g * S5C + row) * 128 + col] = v;
          if (EPI == E_S5Y) {
            const float u = bf2f(ea.ux[((size_t)g * S5C + row) * UXW + col]);
            const float y = gelu_tanh_(v + ea.bias[g * 16 + (col & 15)] * u);
            ea.outb[((size_t)row * 32 + (col >> 4)) * 512 + g * 16 + (col & 15)] = f2bf(y);
          }
        }
  }
}

__device__ __forceinline__ void s5_carry_phase(const Params& p, int bid, int nblk) {
  const float* xe = (const float*)(p.ws + OFF_XE); const float* a32 = (const float*)(p.ws + OFF_A32);
  u16* ux = (u16*)(p.ws + OFF_UX);
  for (int it = bid; it < 32; it += nblk) {
    const int idx = it * 256 + otid(), pp = idx & 63, g = (idx >> 6) & 31, b = idx >> 11;
    const float ar = a32[(g * 64 + pp) * 2], ai = a32[(g * 64 + pp) * 2 + 1];
    float xr = 0.f, xi = 0.f;
    const size_t cbase = (size_t)g * S5C + b * 256;
    for (int n = 0; n < 256; n += 8) {
      float er[8], ei[8];
#pragma unroll
      for (int e = 0; e < 8; ++e) { er[e] = xe[(cbase + n + e) * 128 + pp]; ei[e] = xe[(cbase + n + e) * 128 + 64 + pp]; }
#pragma unroll
      for (int e = 0; e < 8; ++e) {
        ux[(cbase + n + e) * UXW + 512 + pp] = f2bf(xr); ux[(cbase + n + e) * UXW + 576 + pp] = f2bf(xi);
        const float nr = ar * xr - ai * xi + er[e], ni = ar * xi + ai * xr + ei[e];
        xr = nr; xi = ni;
      }
    }
  }
}

constexpr int GT = 16;
__device__ __forceinline__ void gdn_naive_item(const Params& p, int item, char* smem) {
  const int tid = otid(), b = item >> 2, h = item & 3;
  float* qs = (float*)smem; float* ks = qs + GT * 128; float* vs = ks + GT * 128; float* os = vs + GT * 128;
  float* rq = os + GT * 128; float* rk = rq + GT; float* eg = rk + GT; float* bt = eg + GT; float* ro = bt + GT;
  const float* proj = (const float*)(p.ws + OFF_PROJ);
  const float* beta = (const float*)(p.ws + OFF_BETA); const float* gg = (const float*)(p.ws + OFF_G);
  u16* concat = (u16*)(p.ws + OFF_HN);
  const int c = tid & 127;
  const int colA = (tid < 128 ? 0 : 512) + h * 128 + c;
  const int colB = 1024 + h * 128 + c;
  float wa[4], wb[4];
#pragma unroll
  for (int j = 0; j < 4; ++j) { wa[j] = p.hy_conv_w[j * 1536 + colA]; wb[j] = p.hy_conv_w[j * 1536 + colB]; }
  float a1 = 0, a2 = 0, a3 = 0, b1 = 0, b2 = 0, b3 = 0;
  float S[64];
#pragma unroll
  for (int d = 0; d < 64; ++d) S[d] = 0.f;
  const int rc = tid >> 1, rhalf = tid & 1;
  for (int t0 = 0; t0 < SEQ; t0 += GT) {
    const size_t rbase = (size_t)b * SEQ + t0;
    {
      float xa[GT], xb[GT];
#pragma unroll
      for (int tt = 0; tt < GT; ++tt) { xa[tt] = proj[(rbase + tt) * PJ + colA]; xb[tt] = (tid < 128) ? proj[(rbase + tt) * PJ + colB] : 0.f; }
#pragma unroll
      for (int tt = 0; tt < GT; ++tt) {
        float ya = wa[0] * a3 + wa[1] * a2 + wa[2] * a1 + wa[3] * xa[tt]; a3 = a2; a2 = a1; a1 = xa[tt];
        float yb = wb[0] * b3 + wb[1] * b2 + wb[2] * b1 + wb[3] * xb[tt]; b3 = b2; b2 = b1; b1 = xb[tt];
        if (tid < 128) { qs[tt * 128 + c] = silu_(ya); vs[tt * 128 + c] = silu_(yb); } else { ks[tt * 128 + c] = silu_(ya); }
      }
    }
    __syncthreads();
    {
      const int tok = tid >> 4, part = tid & 15;
      float sq = 0, sk = 0;
#pragma unroll
      for (int e = 0; e < 8; ++e) { float a = qs[tok * 128 + part * 8 + e], k = ks[tok * 128 + part * 8 + e]; sq += a * a; sk += k * k; }
#pragma unroll
      for (int o = 8; o >= 1; o >>= 1) { sq += __shfl_xor(sq, o); sk += __shfl_xor(sk, o); }
      if (part == 0) { rq[tok] = rsqrtf(sq + 1e-6f) * 0.08838834764831845f; rk[tok] = rsqrtf(sk + 1e-6f); }
      if (tid < GT) { eg[tid] = __expf(gg[(rbase + tid) * 4 + h]); bt[tid] = beta[(rbase + tid) * 4 + h]; }
    }
    __syncthreads();
    {
      for (int tt = 0; tt < GT; ++tt) {
        const float* kr = ks + tt * 128 + rhalf * 64; const float* qr = qs + tt * 128 + rhalf * 64;
        float kS = 0.f;
#pragma unroll
        for (int d = 0; d < 64; d += 4) { f32x4 k4 = *(const f32x4*)(kr + d); kS += k4[0] * S[d] + k4[1] * S[d + 1] + k4[2] * S[d + 2] + k4[3] * S[d + 3]; }
        kS += __shfl_xor(kS, 1);
        const float e = eg[tt], rkk = rk[tt];
        const float delta = bt[tt] * (vs[tt * 128 + rc] - e * kS * rkk) * rkk;
        float o = 0.f;
#pragma unroll
        for (int d = 0; d < 64; d += 4) {
          f32x4 k4 = *(const f32x4*)(kr + d); f32x4 q4 = *(const f32x4*)(qr + d);
#pragma unroll
          for (int e4 = 0; e4 < 4; ++e4) { S[d + e4] = e * S[d + e4] + k4[e4] * delta; o += q4[e4] * S[d + e4]; }
        }
        o += __shfl_xor(o, 1);
        if (rhalf == 0) os[tt * 128 + rc] = o * rq[tt];
      }
    }
    __syncthreads();
    {
      const int tok = tid >> 4, part = tid & 15;
      float so = 0;
#pragma unroll
      for (int e = 0; e < 8; ++e) { float a = os[tok * 128 + part * 8 + e]; so += a * a; }
#pragma unroll
      for (int o = 8; o >= 1; o >>= 1) so += __shfl_xor(so, o);
      if (part == 0) ro[tok] = rsqrtf(so * (1.f / 128.f) + 1e-6f);
    }
    __syncthreads();
#pragma unroll
    for (int i = 0; i < GT * 128 / 256; ++i) {
      const int idx = tid + i * 256, tok = idx >> 7, cc = idx & 127;
      const float z = proj[(rbase + tok) * PJ + 1536 + h * 128 + cc];
      const float val = os[idx] * ro[tok] * p.hy_head_norm_w[cc] * silu_(z);
      concat[(rbase + tok) * 1024 + h * 128 + cc] = f2bf(val);
    }
    __syncthreads();
  }

}

using s16x4 = __attribute__((ext_vector_type(4))) short;
using f32x16 = __attribute__((ext_vector_type(16))) float;
#define KSWZ(row, colB) ((row) * 256 + ((colB) ^ (((row) & 7) << 4)))
#define SBAR() __builtin_amdgcn_sched_barrier(0)
__device__ __forceinline__ int crow(int r, int hi) { return (r & 3) + 8 * (r >> 2) + 4 * hi; }
__device__ __forceinline__ unsigned cvtpk(float lo, float hi) { unsigned r; asm volatile("v_cvt_pk_bf16_f32 %0, %1, %2" : "=v"(r) : "v"(lo), "v"(hi)); return r; }
__device__ __forceinline__ int v_st(int k, int c) { const int kk = (k & ~0xC) | ((k & 4) << 1) | ((k & 8) >> 1); return ((kk >> 3) * 4 + (c >> 5)) * 512 + ((kk & 7) * 32 + (c & 31)) * 2; }
__device__ __forceinline__ int v_rd_base(int lane) { return ((lane & 3) << 3) | (((lane >> 2) & 3) << 6) | (((lane >> 4) & 1) << 5) | (((lane >> 5) & 1) << 8); }
constexpr int v_rd_off(int d0, int ks, int half) { return d0 * 512 + ks * 4096 + half * 2048; }
template <int OFF> __device__ __forceinline__ s16x4 tr_read(int vb) {
  s16x4 r; asm volatile("ds_read_b64_tr_b16 %0, %1 offset:%2" : "=&v"(r) : "v"(vb), "i"(OFF) : "memory"); return r;
}
template <int D0> __device__ __forceinline__ void pv_one(f32x16& od, int vb, bf16x8 pa0, bf16x8 pa1, bf16x8 pa2, bf16x8 pa3) {
  const s16x4 l0 = tr_read<v_rd_off(D0, 0, 0)>(vb), h0 = tr_read<v_rd_off(D0, 0, 1)>(vb), l1 = tr_read<v_rd_off(D0, 1, 0)>(vb), h1 = tr_read<v_rd_off(D0, 1, 1)>(vb);
  const s16x4 l2 = tr_read<v_rd_off(D0, 2, 0)>(vb), h2 = tr_read<v_rd_off(D0, 2, 1)>(vb), l3 = tr_read<v_rd_off(D0, 3, 0)>(vb), h3 = tr_read<v_rd_off(D0, 3, 1)>(vb);
  asm volatile("s_waitcnt lgkmcnt(0)" ::: "memory"); SBAR();
#define PK(L, H) (bf16x8){L[0], L[1], L[2], L[3], H[0], H[1], H[2], H[3]}
  od = __builtin_amdgcn_mfma_f32_32x32x16_bf16(pa0, PK(l0, h0), od, 0, 0, 0);
  od = __builtin_amdgcn_mfma_f32_32x32x16_bf16(pa1, PK(l1, h1), od, 0, 0, 0);
  od = __builtin_amdgcn_mfma_f32_32x32x16_bf16(pa2, PK(l2, h2), od, 0, 0, 0);
  od = __builtin_amdgcn_mfma_f32_32x32x16_bf16(pa3, PK(l3, h3), od, 0, 0, 0);
#undef PK
}
__device__ __forceinline__ float pl32_other(float a, float b, int hi) {
  auto rr = __builtin_amdgcn_permlane32_swap(__float_as_uint(a), __float_as_uint(b), false, false);
  return __uint_as_float(hi ? rr[0] : rr[1]);
}
__device__ __forceinline__ void sb_half(f32x16& pz, float& run, bool need_mask, int kb, int t, int hi) {
  constexpr float SC = 0.08838834764831845f;
  f32x16 l;
#pragma unroll
  for (int r = 0; r < 16; ++r) {
    const float z = pz[r] * SC;
    l[r] = -(fmaxf(z, 0.f) + __logf(1.f + __expf(-fabsf(z))));
    pz[r] = z;
  }
  if (need_mask) {
#pragma unroll
    for (int r = 0; r < 16; ++r) { if (kb + crow(r, hi) >= t) l[r] = 0.f; }
  }
#pragma unroll
  for (int g = 0; g < 4; ++g) { l[4 * g + 2] += l[4 * g + 3]; l[4 * g + 1] += l[4 * g + 2]; l[4 * g] += l[4 * g + 1]; }
  const float cs3 = l[12], cs2 = l[8] + cs3, cs1 = l[4] + cs2, cs0 = l[0] + cs1;
  const float off0 = cs1 + pl32_other(cs0, cs1, hi) + run;
  const float off1 = cs2 + pl32_other(cs1, cs2, hi) + run;
  const float off2 = cs3 + pl32_other(cs2, cs3, hi) + run;
  const float off3 = pl32_other(cs3, 0.f, hi) + run;
  float tot;
  { auto rr = __builtin_amdgcn_permlane32_swap(__float_as_uint(cs0), __float_as_uint(cs0), false, false); tot = __uint_as_float(rr[0]) + __uint_as_float(rr[1]); }
#pragma unroll
  for (int r = 0; r < 4; ++r) {
    pz[r] = __expf(pz[r] + l[r] + off0); pz[4 + r] = __expf(pz[4 + r] + l[4 + r] + off1);
    pz[8 + r] = __expf(pz[8 + r] + l[8 + r] + off2); pz[12 + r] = __expf(pz[12 + r] + l[12 + r] + off3);
  }
  if (need_mask) {
#pragma unroll
    for (int r = 0; r < 16; ++r) { if (kb + crow(r, hi) >= t) pz[r] = 0.f; }
  }
  run += tot;
}

__device__ __forceinline__ void attn_phase(const Params& p, char* smem, int bid, int nblk) {
  const int tid = otid(), wid = tid >> 6, lane = tid & 63, r32 = lane & 31, hi = lane >> 5;
  char* K_lds = smem; char* V_lds = smem + 16384;
  const u16* qkv = (const u16*)(p.ws + OFF_PROJ);
  u16* ao = (u16*)(p.ws + OFF_HN);
  const int sr = tid >> 4, sc = (tid & 15) * 8;
  const int vb0 = (int)(uintptr_t)V_lds + v_rd_base(lane);
  for (int k = 0; k * nblk < 2048; ++k) {
    const int i = (k & 1) ? ((k + 1) * nblk - 1 - bid) : (k * nblk + bid);
    if (i >= 2048) continue;
    const int j = 63 - (i >> 5), bh = i & 31, b = bh >> 3, h = bh & 7;
    const int i0 = j * 128;
    const size_t rowb = (size_t)b * SEQ;
    const int t = i0 + wid * 32 + r32, tmin = i0 + wid * 32, tmax = tmin + 31;
    bf16x8 qr[8];
    {
      const u16* qp = qkv + (rowb + t) * 3072 + h * 128 + hi * 8;
#pragma unroll
      for (int d0 = 0; d0 < 8; ++d0) qr[d0] = *(const bf16x8*)(qp + d0 * 16);
    }
    f32x16 o[4];
#pragma unroll
    for (int d = 0; d < 4; ++d)
#pragma unroll
      for (int r = 0; r < 16; ++r) o[d][r] = 0.f;
    float run = 0.f;
    const u16* kbase = qkv + rowb * 3072 + 1024 + h * 128 + sc;
    u32x4 stk[4], stv[4];
#define SLOAD(KT) do { _Pragma("unroll") for (int ii = 0; ii < 4; ++ii) { const u16* kp = kbase + (size_t)((KT) * 64 + sr + 16 * ii) * 3072; \
      stk[ii] = *(const u32x4*)kp; stv[ii] = *(const u32x4*)(kp + 1024); } } while (0)
#define SWRITE() do { _Pragma("unroll") for (int ii = 0; ii < 4; ++ii) { const int row = sr + 16 * ii; \
      *(u32x4*)(K_lds + KSWZ(row, sc * 2)) = stk[ii]; *(u32x4*)(V_lds + v_st(row, sc)) = stv[ii]; } } while (0)
    const int NT = 2 * j + 2;
    SLOAD(NT - 1); SWRITE(); __syncthreads();
    for (int kt = NT - 1; kt >= 0; --kt) {
      const int k0 = kt * 64;
      if (k0 <= tmax) {
        bf16x8 pa0, pa1, pa2, pa3;
#define PK4(P, BASE, OUT) do { unsigned a0 = cvtpk(P[BASE + 0], P[BASE + 1]), a1 = cvtpk(P[BASE + 2], P[BASE + 3]); \
    unsigned b0_ = cvtpk(P[BASE + 4], P[BASE + 5]), b1_ = cvtpk(P[BASE + 6], P[BASE + 7]); \
    auto r0 = __builtin_amdgcn_permlane32_swap(a0, b0_, false, false); auto r1 = __builtin_amdgcn_permlane32_swap(a1, b1_, false, false); \
    u32x4 w = {r0[0], r1[0], r0[1], r1[1]}; OUT = *reinterpret_cast<bf16x8*>(&w); } while (0)
        if (k0 + 32 <= tmax) {
          f32x16 pz;
#pragma unroll
          for (int r = 0; r < 16; ++r) pz[r] = 0.f;
#pragma unroll
          for (int d0 = 0; d0 < 8; ++d0) {
            const bf16x8 kf = *(const bf16x8*)(K_lds + KSWZ(32 + r32, (d0 * 16 + hi * 8) * 2));
            pz = __builtin_amdgcn_mfma_f32_32x32x16_bf16(kf, qr[d0], pz, 0, 0, 0);
          }
          sb_half(pz, run, k0 + 63 >= tmin, k0 + 32, t, hi);
          PK4(pz, 0, pa2); PK4(pz, 8, pa3);
        } else {
          pa2 = bf16x8{0, 0, 0, 0, 0, 0, 0, 0}; pa3 = pa2;
        }
        {
          f32x16 pz;
#pragma unroll
          for (int r = 0; r < 16; ++r) pz[r] = 0.f;
#pragma unroll
          for (int d0 = 0; d0 < 8; ++d0) {
            const bf16x8 kf = *(const bf16x8*)(K_lds + KSWZ(r32, (d0 * 16 + hi * 8) * 2));
            pz = __builtin_amdgcn_mfma_f32_32x32x16_bf16(kf, qr[d0], pz, 0, 0, 0);
          }
          sb_half(pz, run, k0 + 31 >= tmin, k0, t, hi);
          PK4(pz, 0, pa0); PK4(pz, 8, pa1);
        }
#undef PK4
        if (kt > 0) SLOAD(kt - 1);
        pv_one<0>(o[0], vb0, pa0, pa1, pa2, pa3); pv_one<1>(o[1], vb0, pa0, pa1, pa2, pa3);
        pv_one<2>(o[2], vb0, pa0, pa1, pa2, pa3); pv_one<3>(o[3], vb0, pa0, pa1, pa2, pa3);
      } else {
        if (kt > 0) SLOAD(kt - 1);
      }
      __syncthreads();
      if (kt > 0) SWRITE();
      __syncthreads();
    }
#undef SLOAD
#undef SWRITE
    {
      u16* op = ao + (rowb + i0 + wid * 32) * 1024 + h * 128 + r32;
#pragma unroll
      for (int r = 0; r < 16; ++r) {
        const int orow = crow(r, hi);
#pragma unroll
        for (int d0 = 0; d0 < 4; ++d0) op[(size_t)orow * 1024 + d0 * 32] = f2bf(o[d0][r]);
      }
    }
  }
}

__global__ void __launch_bounds__(256, 2) mega(Params p) {
  __shared__ __attribute__((aligned(16))) char smem[SMEM_BYTES];
  const int bid = blockIdx.x, nblk = gridDim.x;
  char* ws = p.ws;
  const float* mod = (const float*)(ws + OFF_MOD);
  u16* hn = (u16*)(ws + OFF_HN);
#define PH_BEGIN(n) if (p.phase_lo <= (n) && (n) < p.phase_hi) {
#define PH_END(n) if ((n) + 1 < p.phase_hi) cg::this_grid().sync(); }
  PH_BEGIN(0) phase0(p, smem, bid, nblk); PH_END(0)
  PH_BEGIN(1) norm_phase<1>(p, p.x, p.norm_mix_w, mod, 0, 1024, smem, bid, nblk); PH_END(1)
  PH_BEGIN(2) { EpiArgs ea{}; ea.outf = (float*)(ws + OFF_PROJ); ea.ux = (u16*)(ws + OFF_UX);
        gemm_phase<E_PROJ0>(hn, 1024, 0, (const u16*)(ws + OFF_WT_HYIN), 1024, 0, 1024, M / 128, PN / 128, 1, ea, smem, bid, nblk); } PH_END(2)
  PH_BEGIN(3) { EpiArgs ea{}; ea.outf = (float*)(ws + OFF_XE);
        gemm_phase<E_XE>((const u16*)(ws + OFF_UX), UXW, (size_t)S5C * UXW, (const u16*)(ws + OFF_EG), 512, (size_t)128 * 512, 512, S5C / 128, 1, 32, ea, smem, bid, nblk); } PH_END(3)
  PH_BEGIN(4) s5_carry_phase(p, bid, nblk); PH_END(4)
  PH_BEGIN(5) {
        if (bid < 16) { gdn_naive_item(p, bid, smem); }
        else { EpiArgs ea{}; ea.outb = (u16*)(ws + OFF_Y5); ea.ux = (u16*)(ws + OFF_UX); ea.bias = p.s5_d;
          gemm_phase<E_S5Y>((const u16*)(ws + OFF_UX), UXW, (size_t)S5C * UXW, (const u16*)(ws + OFF_MF), UXW, (size_t)512 * UXW, UXW, S5C / 128, 4, 32, ea, smem, bid - 16, nblk - 16); }
      } PH_END(5)
  PH_BEGIN(6) { EpiArgs ea{}; ea.outb = hn; ea.y5 = (const u16*)(ws + OFF_Y5); ea.bias = p.s5_glu_b;
        gemm_phase<E_GLU>((const u16*)(ws + OFF_Y5), 512, 0, (const u16*)(ws + OFF_WT_GLU), 512, 0, 512, M / 128, 4, 1, ea, smem, bid, nblk); } PH_END(6)
  PH_BEGIN(7) { EpiArgs ea{}; ea.outf = p.out; ea.res = p.x; ea.gate = mod + 2048;
        gemm_phase<E_RESID>(hn, 1024, 0, (const u16*)(ws + OFF_WT_HYOUT), 1024, 0, 1024, M / 128, 8, 1, ea, smem, bid, nblk); } PH_END(7)
  PH_BEGIN(8) norm_phase<0>(p, p.out, p.norm_ffn_w, mod, 3072, 4096, smem, bid, nblk); PH_END(8)
  PH_BEGIN(9) { EpiArgs ea{}; ea.outb = (u16*)(ws + OFF_PROJ);
        gemm_phase<E_SWIGLU>(hn, 1024, 0, (const u16*)(ws + OFF_WT_FFNIN), 1024, 0, 1024, M / 128, 2 * FF / 128, 1, ea, smem, bid, nblk); } PH_END(9)
  PH_BEGIN(10) { EpiArgs ea{}; ea.outf = p.out; ea.res = p.out; ea.gate = mod + 5120;
        gemm_phase<E_RESID>((const u16*)(ws + OFF_PROJ), FF, 0, (const u16*)(ws + OFF_WT_FFNOUT), FF, 0, FF, M / 128, 8, 1, ea, smem, bid, nblk); } PH_END(10)
  PH_BEGIN(11) norm_phase<0>(p, p.out, p.norm_mix_w + 1024, mod + 4 * 6144, 0, 1024, smem, bid, nblk); PH_END(11)
  PH_BEGIN(12) { EpiArgs ea{}; ea.outb = (u16*)(ws + OFF_PROJ); ea.ldc = 3072;
        gemm_phase<E_BF16>(hn, 1024, 0, (const u16*)(ws + OFF_WT_SBIN), 1024, 0, 1024, M / 128, 24, 1, ea, smem, bid, nblk); } PH_END(12)
  PH_BEGIN(13) attn_phase(p, smem, bid, nblk); PH_END(13)
  PH_BEGIN(14) { EpiArgs ea{}; ea.outf = p.out; ea.res = p.out; ea.gate = mod + 4 * 6144 + 2048;
        gemm_phase<E_RESID>(hn, 1024, 0, (const u16*)(ws + OFF_WT_SBOUT), 1024, 0, 1024, M / 128, 8, 1, ea, smem, bid, nblk); } PH_END(14)
  PH_BEGIN(15) norm_phase<0>(p, p.out, p.norm_ffn_w + 1024, mod + 4 * 6144, 3072, 4096, smem, bid, nblk); PH_END(15)
  PH_BEGIN(16) { EpiArgs ea{}; ea.outb = (u16*)(ws + OFF_PROJ);
        gemm_phase<E_SWIGLU>(hn, 1024, 0, (const u16*)(ws + OFF_WT_FFNIN + SZ_WT_FFNIN), 1024, 0, 1024, M / 128, 2 * FF / 128, 1, ea, smem, bid, nblk); } PH_END(16)
  PH_BEGIN(17) { EpiArgs ea{}; ea.outf = p.out; ea.res = p.out; ea.gate = mod + 4 * 6144 + 5120;
        gemm_phase<E_RESID>((const u16*)(ws + OFF_PROJ), FF, 0, (const u16*)(ws + OFF_WT_FFNOUT + SZ_WT_FFNOUT), FF, 0, FF, M / 128, 8, 1, ea, smem, bid, nblk); } PH_END(17)
  PH_BEGIN(18) norm_phase<2>(p, p.out, p.final_norm_w, mod, 0, 0, smem, bid, nblk); PH_END(18)
}

extern "C" void kernel_launch(void* const* d_in, const int* in_sizes, int n_in, void* d_out, int out_size, void* d_ws, size_t ws_size,
                              hipStream_t stream) {
  static int grid_blocks = 0;
  if (!grid_blocks) {
    int dev = 0, cus = 0, per_cu = 0;
    hipGetDevice(&dev);
    hipDeviceGetAttribute(&cus, hipDeviceAttributeMultiprocessorCount, dev);
    hipOccupancyMaxActiveBlocksPerMultiprocessor(&per_cu, mega, 256, 0);
    if (per_cu > 2) per_cu = 2;
    if (per_cu < 1) per_cu = 1;
    grid_blocks = cus * per_cu;
  }
  Params p{};
  const float* const* in = (const float* const*)d_in;
  p.x = in[0]; p.c = in[1]; p.ada_w = in[2]; p.ada_b = in[3]; p.norm_mix_w = in[4]; p.norm_ffn_w = in[5]; p.ffn_w_in = in[6]; p.ffn_w_out = in[7];
  p.hy_w_in = in[8]; p.hy_conv_w = in[9]; p.hy_a_log = in[10]; p.hy_dt_bias = in[11]; p.hy_head_norm_w = in[12];
  p.s5_lam_re = in[13]; p.s5_lam_im = in[14]; p.s5_log_dt = in[15]; p.s5_b_re = in[16]; p.s5_b_im = in[17]; p.s5_c_re = in[18]; p.s5_c_im = in[19];
  p.s5_d = in[20]; p.s5_glu_w = in[21]; p.s5_glu_b = in[22]; p.hy_w_out = in[23]; p.sb_w_in = in[24]; p.sb_w_out = in[25]; p.final_norm_w = in[26];
  p.out = (float*)d_out; p.ws = (char*)d_ws;
#if ONE_LAUNCH
  p.phase_lo = 0; p.phase_hi = NPHASE;
  void* args[] = {&p};
  hipError_t e = hipLaunchCooperativeKernel((void*)mega, dim3(grid_blocks), dim3(256), args, 0, stream);
  if (e != hipSuccess) fprintf(stderr, "cooperative launch failed: %s (grid %d)\n", hipGetErrorString(e), grid_blocks);
#else
  for (int ph = 0; ph < NPHASE; ++ph) {
    p.phase_lo = ph; p.phase_hi = ph + 1;
    hipLaunchKernelGGL(mega, dim3(grid_blocks), dim3(256), 0, stream, p);
  }
#endif
}
```

```cpp
#include <hip/hip_runtime.h>
#include <hip/hip_cooperative_groups.h>
#include <stdint.h>
#include <cstdio>
namespace cg = cooperative_groups;

#ifndef ONE_LAUNCH
#define ONE_LAUNCH 1
#endif

typedef unsigned short u16;
using bf16x8 = __attribute__((ext_vector_type(8))) short;
using f32x4 = __attribute__((ext_vector_type(4))) float;
using u32x4 = __attribute__((ext_vector_type(4))) unsigned;

constexpr int D = 1024, NB = 4, SEQ = 8192, M = NB * SEQ, FF = 2816, EIN = 2568, PN = 2560, PJ = 2048;
constexpr int NPHASE = 20;
constexpr int S5T = 32, S5C = M / S5T, UXW = 640;

constexpr size_t SZ_WT_HYIN = (size_t)PN * 1024 * 2, SZ_WT_SQ = (size_t)1024 * 1024 * 2, SZ_WT_GLU = (size_t)512 * 512 * 2;
constexpr size_t SZ_WT_FFNIN = (size_t)2 * FF * 1024 * 2, SZ_WT_FFNOUT = (size_t)1024 * FF * 2, SZ_WT_SBIN = (size_t)3072 * 1024 * 2;
constexpr size_t OFF_WT_HYIN = 0;
constexpr size_t OFF_WT_HYOUT = OFF_WT_HYIN + SZ_WT_HYIN;
constexpr size_t OFF_WT_GLU = OFF_WT_HYOUT + SZ_WT_SQ;
constexpr size_t OFF_WT_FFNIN = OFF_WT_GLU + SZ_WT_GLU;
constexpr size_t OFF_WT_FFNOUT = OFF_WT_FFNIN + 2 * SZ_WT_FFNIN;
constexpr size_t OFF_WT_SBIN = OFF_WT_FFNOUT + 2 * SZ_WT_FFNOUT;
constexpr size_t OFF_WT_SBOUT = OFF_WT_SBIN + SZ_WT_SBIN;
constexpr size_t OFF_MOD = OFF_WT_SBOUT + SZ_WT_SQ;
constexpr size_t OFF_BETA = OFF_MOD + (size_t)2 * 4 * 6144 * 4;
constexpr size_t OFF_G = OFF_BETA + (size_t)M * 4 * 4;
constexpr size_t OFF_HN = OFF_G + (size_t)M * 4 * 4;
constexpr size_t OFF_Y5 = OFF_HN + (size_t)M * 1024 * 2;
constexpr size_t OFF_UX = OFF_Y5 + (size_t)M * 512 * 2;
constexpr size_t OFF_MF = OFF_UX + (size_t)32 * S5C * UXW * 2;
constexpr size_t OFF_EG = OFF_MF + (size_t)32 * 512 * UXW * 2;
constexpr size_t OFF_XE = OFF_EG + (size_t)32 * 128 * 512 * 2;
constexpr size_t OFF_A32 = OFF_XE + (size_t)32 * S5C * 128 * 4;
constexpr size_t OFF_PROJ = OFF_A32 + (size_t)32 * 64 * 2 * 4;
constexpr size_t OFF_GW = OFF_PROJ + (size_t)M * PJ * 2;
constexpr size_t OFF_GQD = OFF_GW + (size_t)2048 * 8192 * 2;
constexpr size_t OFF_GKT = OFF_GQD + (size_t)2048 * 8192 * 2;
constexpr size_t OFF_GUT = OFF_GKT + (size_t)2048 * 8192 * 2;
constexpr size_t OFF_GAT = OFF_GUT + (size_t)2048 * 8192 * 2;
constexpr size_t OFF_GSD = OFF_GAT + (size_t)2048 * 4096 * 2;
constexpr size_t WS_TOTAL = OFF_GSD + (size_t)2048 * 4;
static_assert((size_t)M * 3072 * 2 <= WS_TOTAL - OFF_PROJ, "QKV alias");
static_assert(WS_TOTAL <= (size_t)512 * 1024 * 1024, "workspace too large");

struct Params {
  const float *x, *c, *ada_w, *ada_b, *norm_mix_w, *norm_ffn_w, *ffn_w_in, *ffn_w_out;
  const float *hy_w_in, *hy_conv_w, *hy_a_log, *hy_dt_bias, *hy_head_norm_w;
  const float *s5_lam_re, *s5_lam_im, *s5_log_dt, *s5_b_re, *s5_b_im, *s5_c_re, *s5_c_im, *s5_d, *s5_glu_w, *s5_glu_b, *hy_w_out;
  const float *sb_w_in, *sb_w_out, *final_norm_w;
  float* out;
  char* ws;
  int phase_lo, phase_hi;
};

constexpr int SMEM_BYTES = 59904;

__device__ __forceinline__ int otid() { int t = __builtin_amdgcn_workitem_id_x(); asm volatile("" : "+v"(t)); return t; }
__device__ __forceinline__ u16 f2bf(float x) { unsigned u = __float_as_uint(x); u += 0x7fffu + ((u >> 16) & 1u); return (u16)(u >> 16); }
typedef __bf16 bf16v2 __attribute__((ext_vector_type(2)));
typedef float f32v2 __attribute__((ext_vector_type(2)));
__device__ __forceinline__ unsigned pk2(float a, float b) { f32v2 v = {a, b}; bf16v2 r = __builtin_convertvector(v, bf16v2); return __builtin_bit_cast(unsigned, r); }
__device__ __forceinline__ float bf2f(u16 v) { return __uint_as_float(((unsigned)v) << 16); }
__device__ __forceinline__ float sigmoid_(float x) { return 1.f / (1.f + __expf(-x)); }
__device__ __forceinline__ float silu_(float x) { return x * sigmoid_(x); }
__device__ __forceinline__ float softplus_(float x) { return fmaxf(x, 0.f) + log1pf(__expf(-fabsf(x))); }
__device__ __forceinline__ float gelu_tanh_(float y) { return 0.5f * y * (1.f + tanhf(0.7978845608028654f * (y + 0.044715f * y * y * y))); }

struct TrJob { const float* src; u16* dst; int K, Nsrc, Nd, mode; };
__device__ __forceinline__ TrJob get_job(const Params& p, int j) {
  TrJob t;
  switch (j) {
    case 0: t = {p.hy_w_in, (u16*)(p.ws + OFF_WT_HYIN), 1024, EIN, PN, 1}; break;
    case 1: t = {p.hy_w_out, (u16*)(p.ws + OFF_WT_HYOUT), 1024, 1024, 1024, 0}; break;
    case 2: t = {p.s5_glu_w, (u16*)(p.ws + OFF_WT_GLU), 512, 512, 512, 0}; break;
    case 3: t = {p.ffn_w_in, (u16*)(p.ws + OFF_WT_FFNIN), 1024, 2 * FF, 2 * FF, 2}; break;
    case 4: t = {p.ffn_w_in + (size_t)1024 * 2 * FF, (u16*)(p.ws + OFF_WT_FFNIN + SZ_WT_FFNIN), 1024, 2 * FF, 2 * FF, 2}; break;
    case 5: t = {p.ffn_w_out, (u16*)(p.ws + OFF_WT_FFNOUT), FF, 1024, 1024, 0}; break;
    case 6: t = {p.ffn_w_out + (size_t)FF * 1024, (u16*)(p.ws + OFF_WT_FFNOUT + SZ_WT_FFNOUT), FF, 1024, 1024, 0}; break;
    case 7: t = {p.sb_w_in, (u16*)(p.ws + OFF_WT_SBIN), 1024, 3072, 3072, 0}; break;
    default: t = {p.sb_w_out, (u16*)(p.ws + OFF_WT_SBOUT), 1024, 1024, 1024, 0}; break;
  }
  return t;
}
__device__ __forceinline__ int src_col(int R, int mode) {
  if (mode == 0) return R;
  if (mode == 1) return R < 2048 ? R : R + 8;
  return ((R >> 4) & 1) * FF + (R >> 5) * 16 + (R & 15);
}
constexpr int N_TR_ITEMS = 640 + 256 + 64 + 2 * 1408 + 2 * 704 + 768 + 256;
constexpr int N_MOD_ITEMS = 2 * 6144 / 64;

__device__ __forceinline__ void s5_table_item(const Params& p, int item, char* smem) {
  const int tid = otid(), g = item >> 5, tau = item & 31;
  float* pwr = (float*)smem; float* pwi = pwr + 64; float* p1r = pwi + 64; float* p1i = p1r + 64;
  float* bbr = p1i + 64; float* bbi = bbr + 1024; float* cre = bbi + 1024; float* cim = cre + 1024;
  const float dt = expf(p.s5_log_dt[g]);
  if (tid < 64) {
    const float lr = p.s5_lam_re[g * 64 + tid], li = p.s5_lam_im[g * 64 + tid];
    float sn, cs;
    float mg = expf(lr * dt * (float)tau); sincosf(li * dt * (float)tau, &sn, &cs); pwr[tid] = mg * cs; pwi[tid] = mg * sn;
    mg = expf(lr * dt * (float)(tau + 1)); sincosf(li * dt * (float)(tau + 1), &sn, &cs); p1r[tid] = mg * cs; p1i[tid] = mg * sn;
    if (tau == 31) { float* a32 = (float*)(p.ws + OFF_A32); a32[(g * 64 + tid) * 2] = mg * cs; a32[(g * 64 + tid) * 2 + 1] = mg * sn; }
  }
  {
    const int pp = tid >> 2, hq = (tid & 3) * 4;
    const float lr = p.s5_lam_re[g * 64 + pp], li = p.s5_lam_im[g * 64 + pp];
    const float mg = expf(lr * dt); float sn, cs; sincosf(li * dt, &sn, &cs);
    const float ar = mg * cs, ai = mg * sn, den = lr * lr + li * li, nr = ar - 1.f, ni = ai;
    const float fre = (nr * lr + ni * li) / den, fim = (ni * lr - nr * li) / den;
#pragma unroll
    for (int e = 0; e < 4; ++e) {
      const float br = p.s5_b_re[(size_t)(g * 64 + pp) * 16 + hq + e], bi = p.s5_b_im[(size_t)(g * 64 + pp) * 16 + hq + e];
      bbr[pp * 16 + hq + e] = fre * br - fim * bi; bbi[pp * 16 + hq + e] = fre * bi + fim * br;
    }
    for (int i = tid; i < 1024; i += 256) { cre[i] = p.s5_c_re[(size_t)g * 1024 + i]; cim[i] = p.s5_c_im[(size_t)g * 1024 + i]; }
  }
  __syncthreads();
  u16* mf = (u16*)(p.ws + OFF_MF) + (size_t)g * 512 * UXW;
  u16* eg = (u16*)(p.ws + OFF_EG) + (size_t)g * 128 * 512;
  {
    const int h = tid >> 4, hp = tid & 15;
    float kv = 0.f;
    for (int pp = 0; pp < 64; ++pp) {
      const float cr = cre[h * 64 + pp], ci = cim[h * 64 + pp], pr = pwr[pp], pi = pwi[pp];
      kv += (cr * pr - ci * pi) * bbr[pp * 16 + hp] - (cr * pi + ci * pr) * bbi[pp * 16 + hp];
    }
    const u16 kb = f2bf(kv);
    for (int s0 = 0; s0 + tau < 32; ++s0) mf[(size_t)((s0 + tau) * 16 + h) * UXW + s0 * 16 + hp] = kb;
    for (int t0 = 0; t0 + tau + 1 < 32; ++t0) mf[(size_t)(t0 * 16 + h) * UXW + (t0 + tau + 1) * 16 + hp] = 0;
#pragma unroll
    for (int e = 0; e < 4; ++e) {
      const int pp = hp * 4 + e;
      const float cr = cre[h * 64 + pp], ci = cim[h * 64 + pp], pr = p1r[pp], pi = p1i[pp];
      mf[(size_t)(tau * 16 + h) * UXW + 512 + pp] = f2bf(cr * pr - ci * pi);
      mf[(size_t)(tau * 16 + h) * UXW + 576 + pp] = f2bf(-(cr * pi + ci * pr));
    }
  }
  {
    const int pp = tid >> 2, hq = (tid & 3) * 4, s0 = 31 - tau;
#pragma unroll
    for (int e = 0; e < 4; ++e) {
      const float br = bbr[pp * 16 + hq + e], bi = bbi[pp * 16 + hq + e], pr = pwr[pp], pi = pwi[pp];
      eg[(size_t)pp * 512 + s0 * 16 + hq + e] = f2bf(pr * br - pi * bi);
      eg[(size_t)(64 + pp) * 512 + s0 * 16 + hq + e] = f2bf(pr * bi + pi * br);
    }
  }
  __syncthreads();
}

__device__ __forceinline__ void phase0(const Params& p, char* smem, int bid, int nblk) {
  const int tid = otid();
  for (int it = bid; it < N_TR_ITEMS + N_MOD_ITEMS + 1024; it += nblk) {
    if (it >= N_TR_ITEMS + N_MOD_ITEMS) { s5_table_item(p, it - N_TR_ITEMS - N_MOD_ITEMS, smem); continue; }
    if (it < N_TR_ITEMS) {
      int rem = it, j = 0; TrJob jb;
      for (;; ++j) { jb = get_job(p, j); int n = (jb.Nd >> 6) * (jb.K >> 6); if (rem < n) break; rem -= n; }
      const int nk = jb.K >> 6, R0 = (rem / nk) * 64, k0 = (rem % nk) * 64;
      u16* s = (u16*)smem;
      {
        const int r = tid & 63, kk = tid >> 6;
        const float* sp = jb.src + (size_t)k0 * jb.Nsrc + src_col(R0 + r, jb.mode);
#pragma unroll
        for (int i = 0; i < 16; ++i) { int k = kk + 4 * i; s[r * 72 + k] = f2bf(sp[(size_t)k * jb.Nsrc]); }
      }
      __syncthreads();
      {
        const int r = tid >> 2, ch = tid & 3;
#pragma unroll
        for (int i = 0; i < 2; ++i) {
          int c8 = (ch + 4 * i) * 8;
          *(u32x4*)(jb.dst + (size_t)(R0 + r) * jb.K + k0 + c8) = *(const u32x4*)(s + r * 72 + c8);
        }
      }
      __syncthreads();
    } else {
      const int mi = it - N_TR_ITEMS, l = mi / 96, n0 = (mi % 96) * 64;
      float* cact = (float*)smem;
      float* red = cact + 4096;
      for (int i = tid; i < 4096; i += 256) cact[i] = silu_(p.c[i]);
      __syncthreads();
      const int wid = tid >> 6, lane = tid & 63;
      float a0 = 0, a1 = 0, a2 = 0, a3 = 0;
      const float* wp = p.ada_w + (size_t)l * 1024 * 6144 + n0 + lane;
#pragma unroll 8
      for (int k = wid * 256; k < wid * 256 + 256; ++k) {
        float w = wp[(size_t)k * 6144];
        a0 += cact[k] * w; a1 += cact[1024 + k] * w; a2 += cact[2048 + k] * w; a3 += cact[3072 + k] * w;
      }
      red[(wid * 4 + 0) * 64 + lane] = a0; red[(wid * 4 + 1) * 64 + lane] = a1;
      red[(wid * 4 + 2) * 64 + lane] = a2; red[(wid * 4 + 3) * 64 + lane] = a3;
      __syncthreads();
      {
        const int b = tid >> 6;
        float sum = red[(0 * 4 + b) * 64 + lane] + red[(1 * 4 + b) * 64 + lane] + red[(2 * 4 + b) * 64 + lane] + red[(3 * 4 + b) * 64 + lane];
        float* mod = (float*)(p.ws + OFF_MOD);
        mod[(size_t)(l * 4 + b) * 6144 + n0 + lane] = sum + p.ada_b[l * 6144 + n0 + lane];
      }
      __syncthreads();
    }
  }
}

template <int MODE>
__device__ __forceinline__ void norm_phase(const Params& p, const float* src, const float* w, const float* modl, int sh_off, int sc_off,
                           char* smem, int bid, int nblk) {
  const int tid = otid(), wid = tid >> 6, lane = tid & 63;
  float* wba = (float*)smem;
  if (MODE == 1) {
    for (int i = tid; i < 1024 * 8; i += 256) wba[i] = p.hy_w_in[(size_t)(i >> 3) * EIN + 2048 + (i & 7)];
    __syncthreads();
  }
  u16* hn = (u16*)(p.ws + OFF_HN);
  for (int row = bid * 4 + wid; row < M; row += nblk * 4) {
    const float* sp = src + (size_t)row * 1024;
    f32x4 v[4]; float ss = 0;
#pragma unroll
    for (int i = 0; i < 4; ++i) { v[i] = *(const f32x4*)(sp + i * 256 + lane * 4); ss += v[i][0] * v[i][0] + v[i][1] * v[i][1] + v[i][2] * v[i][2] + v[i][3] * v[i][3]; }
#pragma unroll
    for (int o = 32; o >= 1; o >>= 1) ss += __shfl_xor(ss, o);
    const float rstd = rsqrtf(ss * (1.f / 1024.f) + 1e-6f);
    const int b = row >> 13;
    float dots[8];
    if (MODE == 1) { for (int j = 0; j < 8; ++j) dots[j] = 0.f; }
#pragma unroll
    for (int i = 0; i < 4; ++i) {
      const int c0 = i * 256 + lane * 4;
      f32x4 ww = *(const f32x4*)(w + c0);
      f32x4 y;
      if (MODE == 2) {
#pragma unroll
        for (int e = 0; e < 4; ++e) y[e] = v[i][e] * rstd * ww[e];
        *(f32x4*)(p.out + (size_t)row * 1024 + c0) = y;
      } else {
        f32x4 sc = *(const f32x4*)(modl + (size_t)b * 6144 + sc_off + c0);
        f32x4 sh = *(const f32x4*)(modl + (size_t)b * 6144 + sh_off + c0);
#pragma unroll
        for (int e = 0; e < 4; ++e) y[e] = v[i][e] * rstd * ww[e] * (1.f + sc[e]) + sh[e];
        uint2 pk; pk.x = (unsigned)f2bf(y[0]) | ((unsigned)f2bf(y[1]) << 16); pk.y = (unsigned)f2bf(y[2]) | ((unsigned)f2bf(y[3]) << 16);
        *(uint2*)(hn + (size_t)row * 1024 + c0) = pk;
        if (MODE == 1) {
#pragma unroll
          for (int e = 0; e < 4; ++e) {
            f32x4 w0 = *(const f32x4*)(wba + (c0 + e) * 8), w1 = *(const f32x4*)(wba + (c0 + e) * 8 + 4);
#pragma unroll
            for (int j = 0; j < 4; ++j) { dots[j] += y[e] * w0[j]; dots[4 + j] += y[e] * w1[j]; }
          }
        }
      }
    }
    if (MODE == 1) {
#pragma unroll
      for (int j = 0; j < 8; ++j) {
#pragma unroll
        for (int o = 32; o >= 1; o >>= 1) dots[j] += __shfl_xor(dots[j], o);
      }
      if (lane == 0) {
        float* beta = (float*)(p.ws + OFF_BETA); float* gg = (float*)(p.ws + OFF_G);
#pragma unroll
        for (int h = 0; h < 4; ++h) {
          beta[(size_t)row * 4 + h] = sigmoid_(dots[h]);
          gg[(size_t)row * 4 + h] = -__expf(p.hy_a_log[h]) * softplus_(dots[4 + h] + p.hy_dt_bias[h]);
        }
      }
    }
  }
}

enum { E_PROJ0 = 0, E_BF16 = 1, E_RESID = 2, E_GLU = 3, E_SWIGLU = 4, E_XE = 5, E_S5Y = 6 };
struct EpiArgs { float* outf; u16* outb; const float* res; const float* gate; const u16* y5; const float* bias; u16* ux; int ldc; };

template <int EPI>
__device__ __forceinline__ void gemm_phase(const u16* __restrict__ A0, int lda, size_t sA, const u16* __restrict__ B0, int ldb, size_t sB,
                                           int K, int nM, int nN, int nbatch, const EpiArgs ea, char* smem, int bid, int nblk) {
  const int tid = otid(), wid = tid >> 6, lane = tid & 63, wr = wid >> 1, wc = wid & 1, fr = lane & 15, fq = lane >> 4;
  u16* SA = (u16*)smem; u16* SB = SA + 128 * 32;
  const int ntiles = nbatch * nM * nN;
#pragma unroll 1
  for (int t = bid; t < ntiles; t += nblk) {
    const int g = t / (nM * nN), rem = t % (nM * nN);
    const int brow = (rem / nN) << 7, bcol = (rem % nN) << 7;
    const u16* A = A0 + (size_t)g * sA; const u16* Bt = B0 + (size_t)g * sB;
    int nk = K >> 5, klim = nk;
    if (EPI == E_S5Y) { klim = 4 * ((bcol >> 7) + 1); nk = klim + 4; }
    f32x4 acc[4][4];
#pragma unroll
    for (int m = 0; m < 4; ++m)
#pragma unroll
      for (int n = 0; n < 4; ++n) acc[m][n] = f32x4{0.f, 0.f, 0.f, 0.f};
#pragma unroll 1
    for (int kk = 0; kk < nk; ++kk) {
      const int kt = (EPI == E_S5Y && kk >= klim) ? (16 + kk - klim) : kk;
#pragma unroll
      for (int i = 0; i < 2; ++i) {
        const int b = tid * 16 + i * 4096, r = b >> 6, c = (b & 63) >> 1;
        __builtin_amdgcn_global_load_lds((const unsigned*)(A + (size_t)(brow + r) * lda + kt * 32 + c), (__attribute__((address_space(3))) unsigned*)((char*)SA + b), 16, 0, 0);
        __builtin_amdgcn_global_load_lds((const unsigned*)(Bt + (size_t)(bcol + r) * ldb + kt * 32 + c), (__attribute__((address_space(3))) unsigned*)((char*)SB + b), 16, 0, 0);
      }
      asm volatile("s_waitcnt vmcnt(0)" ::: "memory");
      __syncthreads();
      bf16x8 At[4], Bl[4];
#pragma unroll
      for (int m = 0; m < 4; ++m) At[m] = *(const bf16x8*)((const char*)SA + (wr * 64 + m * 16 + fr) * 64 + fq * 16);
#pragma unroll
      for (int n = 0; n < 4; ++n) Bl[n] = *(const bf16x8*)((const char*)SB + (wc * 64 + n * 16 + fr) * 64 + fq * 16);
#pragma unroll
      for (int m = 0; m < 4; ++m)
#pragma unroll
        for (int n = 0; n < 4; ++n) acc[m][n] = __builtin_amdgcn_mfma_f32_16x16x32_bf16(At[m], Bl[n], acc[m][n], 0, 0, 0);
      __syncthreads();
    }
#pragma unroll
    for (int m = 0; m < 4; ++m)
#pragma unroll
      for (int n = 0; n < 4; ++n)
#pragma unroll
        for (int j = 0; j < 4; ++j) {
          const int row = brow + wr * 64 + m * 16 + fq * 4 + j, col = bcol + wc * 64 + n * 16 + fr;
          const float v = acc[m][n][j];
          if (EPI == E_PROJ0) {
            if (bcol < 2048) ea.outb[(size_t)row * PJ + col] = f2bf(v);
            else { const int cc = col - 2048; ea.ux[((size_t)(cc >> 4) * S5C + (row >> 5)) * UXW + (row & 31) * 16 + (cc & 15)] = f2bf(v); }
          }
          if (EPI == E_BF16) ea.outb[(size_t)row * ea.ldc + col] = f2bf(v);
          if (EPI == E_RESID) { size_t idx = (size_t)row * 1024 + col; ea.outf[idx] = ea.res[idx] + ea.gate[(size_t)(row >> 13) * 6144 + col] * v; }
          if (EPI == E_GLU) { float y = bf2f(ea.y5[(size_t)row * 512 + col]); ea.outb[(size_t)row * 1024 + 512 + col] = f2bf(y * sigmoid_(v + ea.bias[col])); }
          if (EPI == E_SWIGLU) {
            if ((n & 1) == 0) {
              const float u = acc[m][n | 1][j];
              const int co = (bcol >> 1) + wc * 32 + (n >> 1) * 16 + fr;
              ea.outb[(size_t)row * FF + co] = f2bf(silu_(v) * u);
            }
          }
          if (EPI == E_XE) ea.outf[((size_t)g * S5C + row) * 128 + col] = v;
          if (EPI == E_S5Y) {
            const float u = bf2f(ea.ux[((size_t)g * S5C + row) * UXW + col]);
            const float y = gelu_tanh_(v + ea.bias[g * 16 + (col & 15)] * u);
            ea.outb[((size_t)row * 32 + (col >> 4)) * 512 + g * 16 + (col & 15)] = f2bf(y);
          }
        }
  }
}

__device__ __forceinline__ void s5_carry_phase(const Params& p, int bid, int nblk) {
  const float* xe = (const float*)(p.ws + OFF_XE); const float* a32 = (const float*)(p.ws + OFF_A32);
  u16* ux = (u16*)(p.ws + OFF_UX);
  for (int it = bid; it < 32; it += nblk) {
    const int idx = it * 256 + otid(), pp = idx & 63, g = (idx >> 6) & 31, b = idx >> 11;
    const float ar = a32[(g * 64 + pp) * 2], ai = a32[(g * 64 + pp) * 2 + 1];
    float xr = 0.f, xi = 0.f;
    const size_t cbase = (size_t)g * S5C + b * 256;
    for (int n = 0; n < 256; n += 8) {
      float er[8], ei[8];
#pragma unroll
      for (int e = 0; e < 8; ++e) { er[e] = xe[(cbase + n + e) * 128 + pp]; ei[e] = xe[(cbase + n + e) * 128 + 64 + pp]; }
#pragma unroll
      for (int e = 0; e < 8; ++e) {
        ux[(cbase + n + e) * UXW + 512 + pp] = f2bf(xr); ux[(cbase + n + e) * UXW + 576 + pp] = f2bf(xi);
        const float nr = ar * xr - ai * xi + er[e], ni = ar * xi + ai * xr + ei[e];
        xr = nr; xi = ni;
      }
    }
  }
}

__device__ __forceinline__ int crow(int r, int hi) { return (r & 3) + 8 * (r >> 2) + 4 * hi; }
using f32x16 = __attribute__((ext_vector_type(16))) float;
__device__ __forceinline__ void unpack8(const u32x4 w, float* f) {
#pragma unroll
  for (int e = 0; e < 4; ++e) { f[2 * e] = __uint_as_float(w[e] << 16); f[2 * e + 1] = __uint_as_float(w[e] & 0xffff0000u); }
}
__device__ __forceinline__ void gdn_prep_phase(const Params& p, char* smem, int bid, int nblk) {
  const int tid = otid(), wid = tid >> 6, lane = tid & 63, fr = lane & 15, fq = lane >> 4;
  u16* qs = (u16*)smem;
  u16* ks = qs + 64 * 136;
  float* Lm = (float*)(ks + 64 * 136);
  float* gcs = Lm + 4096; float* bts = gcs + 64; float* egs = bts + 64;
  const u16* proj = (const u16*)(p.ws + OFF_PROJ);
  const float* beta = (const float*)(p.ws + OFF_BETA); const float* gg = (const float*)(p.ws + OFF_G);
#pragma unroll 1
  for (int it = bid; it < 2048; it += nblk) {
    const int n = it & 127, bh = it >> 7, b = bh >> 2, h = bh & 3;
    const size_t row0 = (size_t)b * SEQ + n * 64;
    if (wid == 0) {
      float c = gg[(row0 + lane) * 4 + h];
#pragma unroll
      for (int o = 1; o < 64; o <<= 1) { const float tt = __shfl_up(c, o); if (lane >= o) c += tt; }
      gcs[lane] = c; egs[lane] = __expf(c); bts[lane] = beta[(row0 + lane) * 4 + h];
    }
    {
      const int tok = tid >> 2, part = tid & 3, l = n * 64 + tok;
      float qo[32], ko[32]; float sq = 0.f, sk = 0.f;
#pragma unroll
      for (int cb = 0; cb < 4; ++cb) {
        const int colq = h * 128 + part * 32 + cb * 8, colk = 512 + colq;
        float aq[8], ak[8];
#pragma unroll
        for (int e = 0; e < 8; ++e) { aq[e] = 0.f; ak[e] = 0.f; }
#pragma unroll
        for (int j = 0; j < 4; ++j) {
          const int lt = l - 3 + j;
          if (lt >= 0) {
            const u16* rp = proj + ((size_t)b * SEQ + lt) * PJ;
            float xq[8], xk[8];
            unpack8(*(const u32x4*)(rp + colq), xq); unpack8(*(const u32x4*)(rp + colk), xk);
            const f32x4 wq0 = *(const f32x4*)(p.hy_conv_w + j * 1536 + colq), wq1 = *(const f32x4*)(p.hy_conv_w + j * 1536 + colq + 4);
            const f32x4 wk0 = *(const f32x4*)(p.hy_conv_w + j * 1536 + colk), wk1 = *(const f32x4*)(p.hy_conv_w + j * 1536 + colk + 4);
#pragma unroll
            for (int e = 0; e < 4; ++e) { aq[e] += wq0[e] * xq[e]; aq[4 + e] += wq1[e] * xq[4 + e]; ak[e] += wk0[e] * xk[e]; ak[4 + e] += wk1[e] * xk[4 + e]; }
          }
        }
#pragma unroll
        for (int e = 0; e < 8; ++e) { const float a = silu_(aq[e]), k = silu_(ak[e]); qo[cb * 8 + e] = a; ko[cb * 8 + e] = k; sq += a * a; sk += k * k; }
      }
      sq += __shfl_xor(sq, 1); sq += __shfl_xor(sq, 2); sk += __shfl_xor(sk, 1); sk += __shfl_xor(sk, 2);
      const float rq = rsqrtf(sq + 1e-6f) * 0.08838834764831845f, rk = rsqrtf(sk + 1e-6f);
#pragma unroll
      for (int cb = 0; cb < 4; ++cb) {
        u32x4 wq, wk;
#pragma unroll
        for (int e = 0; e < 4; ++e) { wq[e] = pk2(qo[cb * 8 + 2 * e] * rq, qo[cb * 8 + 2 * e + 1] * rq); wk[e] = pk2(ko[cb * 8 + 2 * e] * rk, ko[cb * 8 + 2 * e + 1] * rk); }
        *(u32x4*)(qs + tok * 136 + part * 32 + cb * 8) = wq; *(u32x4*)(ks + tok * 136 + part * 32 + cb * 8) = wk;
      }
    }
    __syncthreads();
    {
      f32x4 akk[4], aqk[4];
#pragma unroll
      for (int nb = 0; nb < 4; ++nb) { akk[nb] = f32x4{0.f, 0.f, 0.f, 0.f}; aqk[nb] = f32x4{0.f, 0.f, 0.f, 0.f}; }
#pragma unroll
      for (int kk = 0; kk < 4; ++kk) {
        const bf16x8 ak = *(const bf16x8*)(ks + (16 * wid + fr) * 136 + kk * 32 + fq * 8);
        const bf16x8 aq = *(const bf16x8*)(qs + (16 * wid + fr) * 136 + kk * 32 + fq * 8);
#pragma unroll
        for (int nb = 0; nb < 4; ++nb) {
          const bf16x8 bk = *(const bf16x8*)(ks + (16 * nb + fr) * 136 + kk * 32 + fq * 8);
          akk[nb] = __builtin_amdgcn_mfma_f32_16x16x32_bf16(ak, bk, akk[nb], 0, 0, 0);
          aqk[nb] = __builtin_amdgcn_mfma_f32_16x16x32_bf16(aq, bk, aqk[nb], 0, 0, 0);
        }
      }
      u16* att = (u16*)(p.ws + OFF_GAT) + (size_t)it * 4096;
#pragma unroll
      for (int nb = 0; nb < 4; ++nb)
#pragma unroll
        for (int r = 0; r < 4; ++r) {
          const int i = 16 * wid + fq * 4 + r, j = 16 * nb + fr;
          const float dec = __expf(fminf(gcs[i] - gcs[j], 0.f));
          Lm[i * 64 + j] = (i > j) ? bts[i] * akk[nb][r] * dec : 0.f;
          att[i * 64 + j] = f2bf((i >= j) ? aqk[nb][r] * dec : 0.f);
        }
    }
    __syncthreads();
    {
      float x[64];
      if (tid < 128) {
        const int col = 1024 + h * 128 + tid;
        const float w0 = p.hy_conv_w[col], w1 = p.hy_conv_w[1536 + col], w2 = p.hy_conv_w[2 * 1536 + col], w3 = p.hy_conv_w[3 * 1536 + col];
        float x1 = 0.f, x2 = 0.f, x3 = 0.f;
        if (n > 0) { x3 = bf2f(proj[(row0 - 3) * PJ + col]); x2 = bf2f(proj[(row0 - 2) * PJ + col]); x1 = bf2f(proj[(row0 - 1) * PJ + col]); }
#pragma unroll
        for (int i = 0; i < 64; ++i) {
          const float xv = bf2f(proj[(row0 + i) * PJ + col]);
          x[i] = silu_(w0 * x3 + w1 * x2 + w2 * x1 + w3 * xv) * bts[i];
          x3 = x2; x2 = x1; x1 = xv;
        }
      } else {
#pragma unroll
        for (int i = 0; i < 64; ++i) x[i] = bf2f(ks[i * 136 + tid - 128]) * bts[i] * egs[i];
      }
#pragma unroll
      for (int i = 1; i < 64; ++i) {
        float acc = x[i];
#pragma unroll
        for (int j4 = 0; j4 < (i + 3) / 4; ++j4) {
          const f32x4 l4 = *(const f32x4*)(Lm + i * 64 + j4 * 4);
#pragma unroll
          for (int e = 0; e < 4; ++e) if (j4 * 4 + e < i) acc -= l4[e] * x[j4 * 4 + e];
        }
        x[i] = acc;
      }
      if (tid < 128) {
        u16* ut = (u16*)(p.ws + OFF_GUT) + (size_t)it * 8192 + tid * 64;
#pragma unroll
        for (int c8 = 0; c8 < 8; ++c8) {
          u32x4 w;
#pragma unroll
          for (int e = 0; e < 4; ++e) w[e] = pk2(x[c8 * 8 + 2 * e], x[c8 * 8 + 2 * e + 1]);
          *(u32x4*)(ut + c8 * 8) = w;
        }
      } else {
        u16* wg = (u16*)(p.ws + OFF_GW) + (size_t)it * 8192 + (tid - 128);
#pragma unroll
        for (int i = 0; i < 64; ++i) wg[i * 128] = f2bf(x[i]);
      }
    }
    {
      u16* qd = (u16*)(p.ws + OFF_GQD) + (size_t)it * 8192;
#pragma unroll
      for (int k = 0; k < 4; ++k) {
        const int piece = tid + 256 * k, i = piece >> 4, d0 = (piece & 15) * 8;
        float f[8]; unpack8(*(const u32x4*)(qs + i * 136 + d0), f);
        const float e = egs[i];
        u32x4 w;
#pragma unroll
        for (int e2 = 0; e2 < 4; ++e2) w[e2] = pk2(f[2 * e2] * e, f[2 * e2 + 1] * e);
        *(u32x4*)(qd + i * 128 + d0) = w;
      }
      u16* kt = (u16*)(p.ws + OFF_GKT) + (size_t)it * 8192;
      const int dk = tid & 127, half = tid >> 7;
      const float gl = gcs[63];
#pragma unroll
      for (int c8 = 0; c8 < 4; ++c8) {
        u32x4 w;
#pragma unroll
        for (int e = 0; e < 4; ++e) {
          const int i0 = half * 32 + c8 * 8 + 2 * e;
          w[e] = pk2(bf2f(ks[i0 * 136 + dk]) * __expf(gl - gcs[i0]), bf2f(ks[(i0 + 1) * 136 + dk]) * __expf(gl - gcs[i0 + 1]));
        }
        *(u32x4*)(kt + dk * 64 + half * 32 + c8 * 8) = w;
      }
      if (tid == 0) ((float*)(p.ws + OFF_GSD))[it] = egs[63];
    }
    __syncthreads();
  }
}

__device__ __forceinline__ uint2 lds64(const char* p) { return *(const uint2*)p; }
__device__ __forceinline__ bf16x8 mk8(uint2 a, uint2 b) { u32x4 w = {a.x, a.y, b.x, b.y}; return __builtin_bit_cast(bf16x8, w); }
__device__ __forceinline__ bf16x8 pack8(const f32x16& x, int s) {
  u32x4 w = {pk2(x[8 * s], x[8 * s + 1]), pk2(x[8 * s + 2], x[8 * s + 3]), pk2(x[8 * s + 4], x[8 * s + 5]), pk2(x[8 * s + 6], x[8 * s + 7])};
  return __builtin_bit_cast(bf16x8, w);
}
__device__ __forceinline__ void gdn_scan_item(const Params& p, int bh, char* smem) {
  const int tid = otid(), wid = tid >> 6, lane = tid & 63, r32 = lane & 31, hi = lane >> 5;
  char* Wl = smem; char* QDl = smem + 16896; char* KTl = smem + 33792; char* ATl = smem + 51200;
  const int b = bh >> 2, h = bh & 3;
  const char* gw = p.ws + OFF_GW; const char* gqd = p.ws + OFF_GQD; const char* gkt = p.ws + OFF_GKT; const char* gat = p.ws + OFF_GAT;
  const u16* gut = (const u16*)(p.ws + OFF_GUT);
  const float* gsd = (const float*)(p.ws + OFF_GSD);
  float* og = (float*)(p.ws + OFF_HN);
  f32x16 S[4];
#pragma unroll
  for (int T = 0; T < 4; ++T)
#pragma unroll
    for (int r = 0; r < 16; ++r) S[T][r] = 0.f;
  u32x4 st[14]; uint2 uc[8];
  const int dv = wid * 32 + r32;
#define G_LOAD(IT) do { const size_t o16 = (size_t)(IT) * 16384, o8 = (size_t)(IT) * 8192; \
    _Pragma("unroll") for (int k = 0; k < 4; ++k) { st[k] = *(const u32x4*)(gw + o16 + (tid + 256 * k) * 16); st[4 + k] = *(const u32x4*)(gqd + o16 + (tid + 256 * k) * 16); \
      st[8 + k] = *(const u32x4*)(gkt + o16 + (tid + 256 * k) * 16); } \
    _Pragma("unroll") for (int k = 0; k < 2; ++k) st[12 + k] = *(const u32x4*)(gat + o8 + (tid + 256 * k) * 16); } while (0)
#define U_LOAD(IT) do { _Pragma("unroll") for (int k = 0; k < 8; ++k) uc[k] = *(const uint2*)(gut + (size_t)(IT) * 8192 + dv * 64 + 32 * (k >> 2) + 8 * (k & 3) + 4 * hi); } while (0)
#define G_WRITE() do { \
    _Pragma("unroll") for (int k = 0; k < 4; ++k) { const int pc = tid + 256 * k; \
      { char* d = Wl + (pc >> 4) * 264 + (pc & 15) * 16; *(uint2*)d = uint2{st[k][0], st[k][1]}; *(uint2*)(d + 8) = uint2{st[k][2], st[k][3]}; } \
      { char* d = QDl + (pc >> 4) * 264 + (pc & 15) * 16; *(uint2*)d = uint2{st[4 + k][0], st[4 + k][1]}; *(uint2*)(d + 8) = uint2{st[4 + k][2], st[4 + k][3]}; } \
      { char* d = KTl + (pc >> 3) * 136 + (pc & 7) * 16; *(uint2*)d = uint2{st[8 + k][0], st[8 + k][1]}; *(uint2*)(d + 8) = uint2{st[8 + k][2], st[8 + k][3]}; } } \
    _Pragma("unroll") for (int k = 0; k < 2; ++k) { const int pc = tid + 256 * k; \
      char* d = ATl + (pc >> 3) * 136 + (pc & 7) * 16; *(uint2*)d = uint2{st[12 + k][0], st[12 + k][1]}; *(uint2*)(d + 8) = uint2{st[12 + k][2], st[12 + k][3]}; } } while (0)
  G_LOAD(bh * 128); U_LOAD(bh * 128); G_WRITE(); __syncthreads();
#pragma unroll 1
  for (int n = 0; n < 128; ++n) {
    const int item = bh * 128 + n;
    if (n + 1 < 128) G_LOAD(item + 1);
    f32x16 av[2], ao[2];
#pragma unroll
    for (int r = 0; r < 16; ++r) { av[0][r] = 0.f; av[1][r] = 0.f; ao[0][r] = 0.f; ao[1][r] = 0.f; }
#pragma unroll
    for (int T = 0; T < 4; ++T)
#pragma unroll
      for (int s = 0; s < 2; ++s) {
        const bf16x8 sb = pack8(S[T], s);
        const int cb = (32 * T + 16 * s + 4 * hi) * 2;
#pragma unroll
        for (int it = 0; it < 2; ++it) {
          const char* wp = Wl + (32 * it + r32) * 264 + cb; const char* qp = QDl + (32 * it + r32) * 264 + cb;
          av[it] = __builtin_amdgcn_mfma_f32_32x32x16_bf16(mk8(lds64(wp), lds64(wp + 16)), sb, av[it], 0, 0, 0);
          ao[it] = __builtin_amdgcn_mfma_f32_32x32x16_bf16(mk8(lds64(qp), lds64(qp + 16)), sb, ao[it], 0, 0, 0);
        }
      }
    bf16x8 vb[2][2];
#pragma unroll
    for (int it = 0; it < 2; ++it) {
      f32x16 vn;
#pragma unroll
      for (int g = 0; g < 4; ++g) {
        const uint2 u2 = uc[it * 4 + g];
        vn[4 * g] = __uint_as_float(u2.x << 16) - av[it][4 * g]; vn[4 * g + 1] = __uint_as_float(u2.x & 0xffff0000u) - av[it][4 * g + 1];
        vn[4 * g + 2] = __uint_as_float(u2.y << 16) - av[it][4 * g + 2]; vn[4 * g + 3] = __uint_as_float(u2.y & 0xffff0000u) - av[it][4 * g + 3];
      }
      vb[it][0] = pack8(vn, 0); vb[it][1] = pack8(vn, 1);
    }
    if (n + 1 < 128) U_LOAD(item + 1);
#pragma unroll
    for (int it2 = 0; it2 < 2; ++it2)
#pragma unroll
      for (int it = 0; it <= it2; ++it)
#pragma unroll
        for (int s = 0; s < 2; ++s) {
          const char* ap = ATl + (32 * it2 + r32) * 136 + (32 * it + 16 * s + 4 * hi) * 2;
          ao[it2] = __builtin_amdgcn_mfma_f32_32x32x16_bf16(mk8(lds64(ap), lds64(ap + 16)), vb[it][s], ao[it2], 0, 0, 0);
        }
    {
      float* op = og + ((size_t)b * SEQ + n * 64) * 512 + h * 128 + dv;
#pragma unroll
      for (int it = 0; it < 2; ++it)
#pragma unroll
        for (int r = 0; r < 16; ++r) op[(size_t)(32 * it + crow(r, hi)) * 512] = ao[it][r];
    }
    const float sd = gsd[item];
#pragma unroll
    for (int T = 0; T < 4; ++T) {
#pragma unroll
      for (int r = 0; r < 16; ++r) S[T][r] *= sd;
#pragma unroll
      for (int it = 0; it < 2; ++it)
#pragma unroll
        for (int s = 0; s < 2; ++s) {
          const char* kp = KTl + (32 * T + r32) * 136 + (32 * it + 16 * s + 4 * hi) * 2;
          S[T] = __builtin_amdgcn_mfma_f32_32x32x16_bf16(mk8(lds64(kp), lds64(kp + 16)), vb[it][s], S[T], 0, 0, 0);
        }
    }
    __syncthreads();
    if (n + 1 < 128) G_WRITE();
    __syncthreads();
  }
#undef G_LOAD
#undef G_WRITE
#undef U_LOAD
}

__device__ __forceinline__ void gdn_normgate_phase(const Params& p, int bid, int nblk) {
  const int tid = otid(), wid = tid >> 6, lane = tid & 63;
  const float* og = (const float*)(p.ws + OFF_HN);
  u16* concat = (u16*)(p.ws + OFF_HN);
  const u16* proj = (const u16*)(p.ws + OFF_PROJ);
  const f32x4 hw0 = *(const f32x4*)(p.hy_head_norm_w + (lane & 15) * 8), hw1 = *(const f32x4*)(p.hy_head_norm_w + (lane & 15) * 8 + 4);
#pragma unroll 1
  for (int row = bid * 4 + wid; row < M; row += nblk * 4) {
    const f32x4 a0 = *(const f32x4*)(og + (size_t)row * 512 + lane * 8), a1 = *(const f32x4*)(og + (size_t)row * 512 + lane * 8 + 4);
    float zf[8]; unpack8(*(const u32x4*)(proj + (size_t)row * PJ + 1536 + lane * 8), zf);
    float ss = a0[0] * a0[0] + a0[1] * a0[1] + a0[2] * a0[2] + a0[3] * a0[3] + a1[0] * a1[0] + a1[1] * a1[1] + a1[2] * a1[2] + a1[3] * a1[3];
#pragma unroll
    for (int o = 8; o >= 1; o >>= 1) ss += __shfl_xor(ss, o);
    const float rs = rsqrtf(ss * (1.f / 128.f) + 1e-6f);
    u32x4 w;
    w[0] = pk2(a0[0] * rs * hw0[0] * silu_(zf[0]), a0[1] * rs * hw0[1] * silu_(zf[1]));
    w[1] = pk2(a0[2] * rs * hw0[2] * silu_(zf[2]), a0[3] * rs * hw0[3] * silu_(zf[3]));
    w[2] = pk2(a1[0] * rs * hw1[0] * silu_(zf[4]), a1[1] * rs * hw1[1] * silu_(zf[5]));
    w[3] = pk2(a1[2] * rs * hw1[2] * silu_(zf[6]), a1[3] * rs * hw1[3] * silu_(zf[7]));
    *(u32x4*)(concat + (size_t)row * 1024 + lane * 8) = w;
  }
}

using s16x4 = __attribute__((ext_vector_type(4))) short;
#define KSWZ(row, colB) ((row) * 256 + ((colB) ^ (((row) & 7) << 4)))
#define SBAR() __builtin_amdgcn_sched_barrier(0)
__device__ __forceinline__ unsigned cvtpk(float lo, float hi) { unsigned r; asm volatile("v_cvt_pk_bf16_f32 %0, %1, %2" : "=v"(r) : "v"(lo), "v"(hi)); return r; }
__device__ __forceinline__ int v_st(int k, int c) { const int kk = (k & ~0xC) | ((k & 4) << 1) | ((k & 8) >> 1); return ((kk >> 3) * 4 + (c >> 5)) * 512 + ((kk & 7) * 32 + (c & 31)) * 2; }
__device__ __forceinline__ int v_rd_base(int lane) { return ((lane & 3) << 3) | (((lane >> 2) & 3) << 6) | (((lane >> 4) & 1) << 5) | (((lane >> 5) & 1) << 8); }
constexpr int v_rd_off(int d0, int ks, int half) { return d0 * 512 + ks * 4096 + half * 2048; }
template <int OFF> __device__ __forceinline__ s16x4 tr_read(int vb) {
  s16x4 r; asm volatile("ds_read_b64_tr_b16 %0, %1 offset:%2" : "=&v"(r) : "v"(vb), "i"(OFF) : "memory"); return r;
}
template <int D0> __device__ __forceinline__ void pv_one(f32x16& od, int vb, bf16x8 pa0, bf16x8 pa1, bf16x8 pa2, bf16x8 pa3) {
  const s16x4 l0 = tr_read<v_rd_off(D0, 0, 0)>(vb), h0 = tr_read<v_rd_off(D0, 0, 1)>(vb), l1 = tr_read<v_rd_off(D0, 1, 0)>(vb), h1 = tr_read<v_rd_off(D0, 1, 1)>(vb);
  const s16x4 l2 = tr_read<v_rd_off(D0, 2, 0)>(vb), h2 = tr_read<v_rd_off(D0, 2, 1)>(vb), l3 = tr_read<v_rd_off(D0, 3, 0)>(vb), h3 = tr_read<v_rd_off(D0, 3, 1)>(vb);
  asm volatile("s_waitcnt lgkmcnt(0)" ::: "memory"); SBAR();
#define PK(L, H) (bf16x8){L[0], L[1], L[2], L[3], H[0], H[1], H[2], H[3]}
  od = __builtin_amdgcn_mfma_f32_32x32x16_bf16(pa0, PK(l0, h0), od, 0, 0, 0);
  od = __builtin_amdgcn_mfma_f32_32x32x16_bf16(pa1, PK(l1, h1), od, 0, 0, 0);
  od = __builtin_amdgcn_mfma_f32_32x32x16_bf16(pa2, PK(l2, h2), od, 0, 0, 0);
  od = __builtin_amdgcn_mfma_f32_32x32x16_bf16(pa3, PK(l3, h3), od, 0, 0, 0);
#undef PK
}
__device__ __forceinline__ float pl32_other(float a, float b, int hi) {
  auto rr = __builtin_amdgcn_permlane32_swap(__float_as_uint(a), __float_as_uint(b), false, false);
  return __uint_as_float(hi ? rr[0] : rr[1]);
}
__device__ __forceinline__ void sb_half(f32x16& pz, float& run, bool need_mask, int kb, int t, int hi) {
  constexpr float SC = 0.08838834764831845f;
  f32x16 l;
#pragma unroll
  for (int r = 0; r < 16; ++r) {
    const float z = pz[r] * SC;
    l[r] = -(fmaxf(z, 0.f) + __logf(1.f + __expf(-fabsf(z))));
    pz[r] = z;
  }
  if (need_mask) {
#pragma unroll
    for (int r = 0; r < 16; ++r) { if (kb + crow(r, hi) >= t) l[r] = 0.f; }
  }
#pragma unroll
  for (int g = 0; g < 4; ++g) { l[4 * g + 2] += l[4 * g + 3]; l[4 * g + 1] += l[4 * g + 2]; l[4 * g] += l[4 * g + 1]; }
  const float cs3 = l[12], cs2 = l[8] + cs3, cs1 = l[4] + cs2, cs0 = l[0] + cs1;
  const float off0 = cs1 + pl32_other(cs0, cs1, hi) + run;
  const float off1 = cs2 + pl32_other(cs1, cs2, hi) + run;
  const float off2 = cs3 + pl32_other(cs2, cs3, hi) + run;
  const float off3 = pl32_other(cs3, 0.f, hi) + run;
  float tot;
  { auto rr = __builtin_amdgcn_permlane32_swap(__float_as_uint(cs0), __float_as_uint(cs0), false, false); tot = __uint_as_float(rr[0]) + __uint_as_float(rr[1]); }
#pragma unroll
  for (int r = 0; r < 4; ++r) {
    pz[r] = __expf(pz[r] + l[r] + off0); pz[4 + r] = __expf(pz[4 + r] + l[4 + r] + off1);
    pz[8 + r] = __expf(pz[8 + r] + l[8 + r] + off2); pz[12 + r] = __expf(pz[12 + r] + l[12 + r] + off3);
  }
  if (need_mask) {
#pragma unroll
    for (int r = 0; r < 16; ++r) { if (kb + crow(r, hi) >= t) pz[r] = 0.f; }
  }
  run += tot;
}

__device__ __forceinline__ void attn_phase(const Params& p, char* smem, int bid, int nblk) {
  const int tid = otid(), wid = tid >> 6, lane = tid & 63, r32 = lane & 31, hi = lane >> 5;
  char* K_lds = smem; char* V_lds = smem + 16384;
  const u16* qkv = (const u16*)(p.ws + OFF_PROJ);
  u16* ao = (u16*)(p.ws + OFF_HN);
  const int sr = tid >> 4, sc = (tid & 15) * 8;
  const int vb0 = (int)(uintptr_t)V_lds + v_rd_base(lane);
  for (int k = 0; k * nblk < 2048; ++k) {
    const int i = (k & 1) ? ((k + 1) * nblk - 1 - bid) : (k * nblk + bid);
    if (i >= 2048) continue;
    const int j = 63 - (i >> 5), bh = i & 31, b = bh >> 3, h = bh & 7;
    const int i0 = j * 128;
    const size_t rowb = (size_t)b * SEQ;
    const int t = i0 + wid * 32 + r32, tmin = i0 + wid * 32, tmax = tmin + 31;
    bf16x8 qr[8];
    {
      const u16* qp = qkv + (rowb + t) * 3072 + h * 128 + hi * 8;
#pragma unroll
      for (int d0 = 0; d0 < 8; ++d0) qr[d0] = *(const bf16x8*)(qp + d0 * 16);
    }
    f32x16 o[4];
#pragma unroll
    for (int d = 0; d < 4; ++d)
#pragma unroll
      for (int r = 0; r < 16; ++r) o[d][r] = 0.f;
    float run = 0.f;
    const u16* kbase = qkv + rowb * 3072 + 1024 + h * 128 + sc;
    u32x4 stk[4], stv[4];
#define SLOAD(KT) do { _Pragma("unroll") for (int ii = 0; ii < 4; ++ii) { const u16* kp = kbase + (size_t)((KT) * 64 + sr + 16 * ii) * 3072; \
      stk[ii] = *(const u32x4*)kp; stv[ii] = *(const u32x4*)(kp + 1024); } } while (0)
#define SWRITE() do { _Pragma("unroll") for (int ii = 0; ii < 4; ++ii) { const int row = sr + 16 * ii; \
      *(u32x4*)(K_lds + KSWZ(row, sc * 2)) = stk[ii]; *(u32x4*)(V_lds + v_st(row, sc)) = stv[ii]; } } while (0)
    const int NT = 2 * j + 2;
    SLOAD(NT - 1); SWRITE(); __syncthreads();
    for (int kt = NT - 1; kt >= 0; --kt) {
      const int k0 = kt * 64;
      if (k0 <= tmax) {
        bf16x8 pa0, pa1, pa2, pa3;
#define PK4(P, BASE, OUT) do { unsigned a0 = cvtpk(P[BASE + 0], P[BASE + 1]), a1 = cvtpk(P[BASE + 2], P[BASE + 3]); \
    unsigned b0_ = cvtpk(P[BASE + 4], P[BASE + 5]), b1_ = cvtpk(P[BASE + 6], P[BASE + 7]); \
    auto r0 = __builtin_amdgcn_permlane32_swap(a0, b0_, false, false); auto r1 = __builtin_amdgcn_permlane32_swap(a1, b1_, false, false); \
    u32x4 w = {r0[0], r1[0], r0[1], r1[1]}; OUT = *reinterpret_cast<bf16x8*>(&w); } while (0)
        if (k0 + 32 <= tmax) {
          f32x16 pz;
#pragma unroll
          for (int r = 0; r < 16; ++r) pz[r] = 0.f;
#pragma unroll
          for (int d0 = 0; d0 < 8; ++d0) {
            const bf16x8 kf = *(const bf16x8*)(K_lds + KSWZ(32 + r32, (d0 * 16 + hi * 8) * 2));
            pz = __builtin_amdgcn_mfma_f32_32x32x16_bf16(kf, qr[d0], pz, 0, 0, 0);
          }
          sb_half(pz, run, k0 + 63 >= tmin, k0 + 32, t, hi);
          PK4(pz, 0, pa2); PK4(pz, 8, pa3);
        } else {
          pa2 = bf16x8{0, 0, 0, 0, 0, 0, 0, 0}; pa3 = pa2;
        }
        {
          f32x16 pz;
#pragma unroll
          for (int r = 0; r < 16; ++r) pz[r] = 0.f;
#pragma unroll
          for (int d0 = 0; d0 < 8; ++d0) {
            const bf16x8 kf = *(const bf16x8*)(K_lds + KSWZ(r32, (d0 * 16 + hi * 8) * 2));
            pz = __builtin_amdgcn_mfma_f32_32x32x16_bf16(kf, qr[d0], pz, 0, 0, 0);
          }
          sb_half(pz, run, k0 + 31 >= tmin, k0, t, hi);
          PK4(pz, 0, pa0); PK4(pz, 8, pa1);
        }
#undef PK4
        if (kt > 0) SLOAD(kt - 1);
        pv_one<0>(o[0], vb0, pa0, pa1, pa2, pa3); pv_one<1>(o[1], vb0, pa0, pa1, pa2, pa3);
        pv_one<2>(o[2], vb0, pa0, pa1, pa2, pa3); pv_one<3>(o[3], vb0, pa0, pa1, pa2, pa3);
      } else {
        if (kt > 0) SLOAD(kt - 1);
      }
      __syncthreads();
      if (kt > 0) SWRITE();
      __syncthreads();
    }
#undef SLOAD
#undef SWRITE
    {
      u16* op = ao + (rowb + i0 + wid * 32) * 1024 + h * 128 + r32;
#pragma unroll
      for (int r = 0; r < 16; ++r) {
        const int orow = crow(r, hi);
#pragma unroll
        for (int d0 = 0; d0 < 4; ++d0) op[(size_t)orow * 1024 + d0 * 32] = f2bf(o[d0][r]);
      }
    }
  }
}

__global__ void __launch_bounds__(256, 2) mega(Params p) {
  __shared__ __attribute__((aligned(16))) char smem[SMEM_BYTES];
  const int bid = blockIdx.x, nblk = gridDim.x;
  char* ws = p.ws;
  const float* mod = (const float*)(ws + OFF_MOD);
  u16* hn = (u16*)(ws + OFF_HN);
#define PH_BEGIN(n) if (p.phase_lo <= (n) && (n) < p.phase_hi) {
#define PH_END(n) if ((n) + 1 < p.phase_hi) cg::this_grid().sync(); }
  PH_BEGIN(0) phase0(p, smem, bid, nblk); PH_END(0)
  PH_BEGIN(1) norm_phase<1>(p, p.x, p.norm_mix_w, mod, 0, 1024, smem, bid, nblk); PH_END(1)
  PH_BEGIN(2) { EpiArgs ea{}; ea.outb = (u16*)(ws + OFF_PROJ); ea.ux = (u16*)(ws + OFF_UX);
        gemm_phase<E_PROJ0>(hn, 1024, 0, (const u16*)(ws + OFF_WT_HYIN), 1024, 0, 1024, M / 128, PN / 128, 1, ea, smem, bid, nblk); } PH_END(2)
  PH_BEGIN(3) { EpiArgs ea{}; ea.outf = (float*)(ws + OFF_XE);
        gemm_phase<E_XE>((const u16*)(ws + OFF_UX), UXW, (size_t)S5C * UXW, (const u16*)(ws + OFF_EG), 512, (size_t)128 * 512, 512, S5C / 128, 1, 32, ea, smem, bid, nblk); } PH_END(3)
  PH_BEGIN(4) { s5_carry_phase(p, bid, nblk); gdn_prep_phase(p, smem, bid, nblk); } PH_END(4)
  PH_BEGIN(5) {
        if (bid < 16) { gdn_scan_item(p, bid, smem); }
        else { EpiArgs ea{}; ea.outb = (u16*)(ws + OFF_Y5); ea.ux = (u16*)(ws + OFF_UX); ea.bias = p.s5_d;
          gemm_phase<E_S5Y>((const u16*)(ws + OFF_UX), UXW, (size_t)S5C * UXW, (const u16*)(ws + OFF_MF), UXW, (size_t)512 * UXW, UXW, S5C / 128, 4, 32, ea, smem, bid - 16, nblk - 16); }
      } PH_END(5)
  PH_BEGIN(6) { gdn_normgate_phase(p, bid, nblk); } PH_END(6)
  PH_BEGIN(7) { EpiArgs ea{}; ea.outb = hn; ea.y5 = (const u16*)(ws + OFF_Y5); ea.bias = p.s5_glu_b;
        gemm_phase<E_GLU>((const u16*)(ws + OFF_Y5), 512, 0, (const u16*)(ws + OFF_WT_GLU), 512, 0, 512, M / 128, 4, 1, ea, smem, bid, nblk); } PH_END(7)
  PH_BEGIN(8) { EpiArgs ea{}; ea.outf = p.out; ea.res = p.x; ea.gate = mod + 2048;
        gemm_phase<E_RESID>(hn, 1024, 0, (const u16*)(ws + OFF_WT_HYOUT), 1024, 0, 1024, M / 128, 8, 1, ea, smem, bid, nblk); } PH_END(8)
  PH_BEGIN(9) norm_phase<0>(p, p.out, p.norm_ffn_w, mod, 3072, 4096, smem, bid, nblk); PH_END(9)
  PH_BEGIN(10) { EpiArgs ea{}; ea.outb = (u16*)(ws + OFF_PROJ);
        gemm_phase<E_SWIGLU>(hn, 1024, 0, (const u16*)(ws + OFF_WT_FFNIN), 1024, 0, 1024, M / 128, 2 * FF / 128, 1, ea, smem, bid, nblk); } PH_END(10)
  PH_BEGIN(11) { EpiArgs ea{}; ea.outf = p.out; ea.res = p.out; ea.gate = mod + 5120;
        gemm_phase<E_RESID>((const u16*)(ws + OFF_PROJ), FF, 0, (const u16*)(ws + OFF_WT_FFNOUT), FF, 0, FF, M / 128, 8, 1, ea, smem, bid, nblk); } PH_END(11)
  PH_BEGIN(12) norm_phase<0>(p, p.out, p.norm_mix_w + 1024, mod + 4 * 6144, 0, 1024, smem, bid, nblk); PH_END(12)
  PH_BEGIN(13) { EpiArgs ea{}; ea.outb = (u16*)(ws + OFF_PROJ); ea.ldc = 3072;
        gemm_phase<E_BF16>(hn, 1024, 0, (const u16*)(ws + OFF_WT_SBIN), 1024, 0, 1024, M / 128, 24, 1, ea, smem, bid, nblk); } PH_END(13)
  PH_BEGIN(14) attn_phase(p, smem, bid, nblk); PH_END(14)
  PH_BEGIN(15) { EpiArgs ea{}; ea.outf = p.out; ea.res = p.out; ea.gate = mod + 4 * 6144 + 2048;
        gemm_phase<E_RESID>(hn, 1024, 0, (const u16*)(ws + OFF_WT_SBOUT), 1024, 0, 1024, M / 128, 8, 1, ea, smem, bid, nblk); } PH_END(15)
  PH_BEGIN(16) norm_phase<0>(p, p.out, p.norm_ffn_w + 1024, mod + 4 * 6144, 3072, 4096, smem, bid, nblk); PH_END(16)
  PH_BEGIN(17) { EpiArgs ea{}; ea.outb = (u16*)(ws + OFF_PROJ);
        gemm_phase<E_SWIGLU>(hn, 1024, 0, (const u16*)(ws + OFF_WT_FFNIN + SZ_WT_FFNIN), 1024, 0, 1024, M / 128, 2 * FF / 128, 1, ea, smem, bid, nblk); } PH_END(17)
  PH_BEGIN(18) { EpiArgs ea{}; ea.outf = p.out; ea.res = p.out; ea.gate = mod + 4 * 6144 + 5120;
        gemm_phase<E_RESID>((const u16*)(ws + OFF_PROJ), FF, 0, (const u16*)(ws + OFF_WT_FFNOUT + SZ_WT_FFNOUT), FF, 0, FF, M / 128, 8, 1, ea, smem, bid, nblk); } PH_END(18)
  PH_BEGIN(19) norm_phase<2>(p, p.out, p.final_norm_w, mod, 0, 0, smem, bid, nblk); PH_END(19)
}

extern "C" void kernel_launch(void* const* d_in, const int* in_sizes, int n_in, void* d_out, int out_size, void* d_ws, size_t ws_size,
                              hipStream_t stream) {
  static int grid_blocks = 0;
  if (!grid_blocks) {
    int dev = 0, cus = 0, per_cu = 0;
    hipGetDevice(&dev);
    hipDeviceGetAttribute(&cus, hipDeviceAttributeMultiprocessorCount, dev);
    hipOccupancyMaxActiveBlocksPerMultiprocessor(&per_cu, mega, 256, 0);
    if (per_cu > 2) per_cu = 2;
    if (per_cu < 1) per_cu = 1;
    grid_blocks = cus * per_cu;
  }
  Params p{};
  const float* const* in = (const float* const*)d_in;
  p.x = in[0]; p.c = in[1]; p.ada_w = in[2]; p.ada_b = in[3]; p.norm_mix_w = in[4]; p.norm_ffn_w = in[5]; p.ffn_w_in = in[6]; p.ffn_w_out = in[7];
  p.hy_w_in = in[8]; p.hy_conv_w = in[9]; p.hy_a_log = in[10]; p.hy_dt_bias = in[11]; p.hy_head_norm_w = in[12];
  p.s5_lam_re = in[13]; p.s5_lam_im = in[14]; p.s5_log_dt = in[15]; p.s5_b_re = in[16]; p.s5_b_im = in[17]; p.s5_c_re = in[18]; p.s5_c_im = in[19];
  p.s5_d = in[20]; p.s5_glu_w = in[21]; p.s5_glu_b = in[22]; p.hy_w_out = in[23]; p.sb_w_in = in[24]; p.sb_w_out = in[25]; p.final_norm_w = in[26];
  p.out = (float*)d_out; p.ws = (char*)d_ws;
#if ONE_LAUNCH
  p.phase_lo = 0; p.phase_hi = NPHASE;
  void* args[] = {&p};
  hipError_t e = hipLaunchCooperativeKernel((void*)mega, dim3(grid_blocks), dim3(256), args, 0, stream);
  if (e != hipSuccess) fprintf(stderr, "cooperative launch failed: %s (grid %d)\n", hipGetErrorString(e), grid_blocks);
#else
  for (int ph = 0; ph < NPHASE; ++ph) {
    p.phase_lo = ph; p.phase_hi = ph + 1;
    hipLaunchKernelGGL(mega, dim3(grid_blocks), dim3(256), 0, stream, p);
  }
#endif
}
```

```cpp
#include <hip/hip_runtime.h>
#include <hip/hip_cooperative_groups.h>
#include <stdint.h>
#include <cstdio>
namespace cg = cooperative_groups;

#ifndef ONE_LAUNCH
#define ONE_LAUNCH 1
#endif

typedef unsigned short u16;
using bf16x8 = __attribute__((ext_vector_type(8))) short;
using f32x4 = __attribute__((ext_vector_type(4))) float;
using u32x4 = __attribute__((ext_vector_type(4))) unsigned;

constexpr int D = 1024, NB = 4, SEQ = 8192, M = NB * SEQ, FF = 2816, EIN = 2568, PN = 2560, PJ = 2048;
constexpr int NPHASE = 20;
constexpr int S5T = 32, S5C = M / S5T, UXW = 640;

constexpr size_t SZ_WT_HYIN = (size_t)PN * 1024 * 2, SZ_WT_SQ = (size_t)1024 * 1024 * 2, SZ_WT_GLU = (size_t)512 * 512 * 2;
constexpr size_t SZ_WT_FFNIN = (size_t)2 * FF * 1024 * 2, SZ_WT_FFNOUT = (size_t)1024 * FF * 2, SZ_WT_SBIN = (size_t)3072 * 1024 * 2;
constexpr size_t OFF_WT_HYIN = 0;
constexpr size_t OFF_WT_HYOUT = OFF_WT_HYIN + SZ_WT_HYIN;
constexpr size_t OFF_WT_GLU = OFF_WT_HYOUT + SZ_WT_SQ;
constexpr size_t OFF_WT_FFNIN = OFF_WT_GLU + SZ_WT_GLU;
constexpr size_t OFF_WT_FFNOUT = OFF_WT_FFNIN + 2 * SZ_WT_FFNIN;
constexpr size_t OFF_WT_SBIN = OFF_WT_FFNOUT + 2 * SZ_WT_FFNOUT;
constexpr size_t OFF_WT_SBOUT = OFF_WT_SBIN + SZ_WT_SBIN;
constexpr size_t OFF_MOD = OFF_WT_SBOUT + SZ_WT_SQ;
constexpr size_t OFF_BETA = OFF_MOD + (size_t)2 * 4 * 6144 * 4;
constexpr size_t OFF_G = OFF_BETA + (size_t)M * 4 * 4;
constexpr size_t OFF_HN = OFF_G + (size_t)M * 4 * 4;
constexpr size_t OFF_Y5 = OFF_HN + (size_t)M * 1024 * 2;
constexpr size_t OFF_UX = OFF_Y5 + (size_t)M * 512 * 2;
constexpr size_t OFF_MF = OFF_UX + (size_t)32 * S5C * UXW * 2;
constexpr size_t OFF_EG = OFF_MF + (size_t)32 * 512 * UXW * 2;
constexpr size_t OFF_XE = OFF_EG + (size_t)32 * 128 * 512 * 2;
constexpr size_t OFF_A32 = OFF_XE + (size_t)32 * S5C * 128 * 4;
constexpr size_t OFF_PROJ = OFF_A32 + (size_t)32 * 64 * 2 * 4;
constexpr size_t OFF_GW = OFF_PROJ + (size_t)M * PJ * 2;
constexpr size_t OFF_GQD = OFF_GW + (size_t)2048 * 8192 * 2;
constexpr size_t OFF_GKT = OFF_GQD + (size_t)2048 * 8192 * 2;
constexpr size_t OFF_GUT = OFF_GKT + (size_t)2048 * 8192 * 2;
constexpr size_t OFF_GAT = OFF_GUT + (size_t)2048 * 8192 * 2;
constexpr size_t OFF_GSD = OFF_GAT + (size_t)2048 * 4096 * 2;
constexpr size_t WS_TOTAL = OFF_GSD + (size_t)2048 * 4;
static_assert((size_t)M * 3072 * 2 <= WS_TOTAL - OFF_PROJ, "QKV alias");
static_assert(WS_TOTAL <= (size_t)512 * 1024 * 1024, "workspace too large");

struct Params {
  const float *x, *c, *ada_w, *ada_b, *norm_mix_w, *norm_ffn_w, *ffn_w_in, *ffn_w_out;
  const float *hy_w_in, *hy_conv_w, *hy_a_log, *hy_dt_bias, *hy_head_norm_w;
  const float *s5_lam_re, *s5_lam_im, *s5_log_dt, *s5_b_re, *s5_b_im, *s5_c_re, *s5_c_im, *s5_d, *s5_glu_w, *s5_glu_b, *hy_w_out;
  const float *sb_w_in, *sb_w_out, *final_norm_w;
  float* out;
  char* ws;
  int phase_lo, phase_hi;
};

constexpr int SMEM_BYTES = 59904;

__device__ __forceinline__ int otid() { int t = __builtin_amdgcn_workitem_id_x(); asm volatile("" : "+v"(t)); return t; }
__device__ __forceinline__ u16 f2bf(float x) { unsigned u = __float_as_uint(x); u += 0x7fffu + ((u >> 16) & 1u); return (u16)(u >> 16); }
typedef __bf16 bf16v2 __attribute__((ext_vector_type(2)));
typedef float f32v2 __attribute__((ext_vector_type(2)));
__device__ __forceinline__ unsigned pk2(float a, float b) { f32v2 v = {a, b}; bf16v2 r = __builtin_convertvector(v, bf16v2); return __builtin_bit_cast(unsigned, r); }
__device__ __forceinline__ float bf2f(u16 v) { return __uint_as_float(((unsigned)v) << 16); }
__device__ __forceinline__ float sigmoid_(float x) { return 1.f / (1.f + __expf(-x)); }
__device__ __forceinline__ float silu_(float x) { return x * sigmoid_(x); }
__device__ __forceinline__ float softplus_(float x) { return fmaxf(x, 0.f) + log1pf(__expf(-fabsf(x))); }
__device__ __forceinline__ float gelu_tanh_(float y) { return 0.5f * y * (1.f + tanhf(0.7978845608028654f * (y + 0.044715f * y * y * y))); }

struct TrJob { const float* src; u16* dst; int K, Nsrc, Nd, mode; };
__device__ __forceinline__ TrJob get_job(const Params& p, int j) {
  TrJob t;
  switch (j) {
    case 0: t = {p.hy_w_in, (u16*)(p.ws + OFF_WT_HYIN), 1024, EIN, PN, 1}; break;
    case 1: t = {p.hy_w_out, (u16*)(p.ws + OFF_WT_HYOUT), 1024, 1024, 1024, 0}; break;
    case 2: t = {p.s5_glu_w, (u16*)(p.ws + OFF_WT_GLU), 512, 512, 512, 0}; break;
    case 3: t = {p.ffn_w_in, (u16*)(p.ws + OFF_WT_FFNIN), 1024, 2 * FF, 2 * FF, 2}; break;
    case 4: t = {p.ffn_w_in + (size_t)1024 * 2 * FF, (u16*)(p.ws + OFF_WT_FFNIN + SZ_WT_FFNIN), 1024, 2 * FF, 2 * FF, 2}; break;
    case 5: t = {p.ffn_w_out, (u16*)(p.ws + OFF_WT_FFNOUT), FF, 1024, 1024, 0}; break;
    case 6: t = {p.ffn_w_out + (size_t)FF * 1024, (u16*)(p.ws + OFF_WT_FFNOUT + SZ_WT_FFNOUT), FF, 1024, 1024, 0}; break;
    case 7: t = {p.sb_w_in, (u16*)(p.ws + OFF_WT_SBIN), 1024, 3072, 3072, 0}; break;
    default: t = {p.sb_w_out, (u16*)(p.ws + OFF_WT_SBOUT), 1024, 1024, 1024, 0}; break;
  }
  return t;
}
__device__ __forceinline__ int src_col(int R, int mode) {
  if (mode == 0) return R;
  if (mode == 1) return R < 2048 ? R : R + 8;
  return ((R >> 4) & 1) * FF + (R >> 5) * 16 + (R & 15);
}
constexpr int N_TR_ITEMS = 640 + 256 + 64 + 2 * 1408 + 2 * 704 + 768 + 256;
constexpr int N_MOD_ITEMS = 2 * 6144 / 64;

__device__ __forceinline__ void s5_table_item(const Params& p, int item, char* smem) {
  const int tid = otid(), g = item >> 5, tau = item & 31;
  float* pwr = (float*)smem; float* pwi = pwr + 64; float* p1r = pwi + 64; float* p1i = p1r + 64;
  float* bbr = p1i + 64; float* bbi = bbr + 1024; float* cre = bbi + 1024; float* cim = cre + 1024;
  const float dt = expf(p.s5_log_dt[g]);
  if (tid < 64) {
    const float lr = p.s5_lam_re[g * 64 + tid], li = p.s5_lam_im[g * 64 + tid];
    float sn, cs;
    float mg = expf(lr * dt * (float)tau); sincosf(li * dt * (float)tau, &sn, &cs); pwr[tid] = mg * cs; pwi[tid] = mg * sn;
    mg = expf(lr * dt * (float)(tau + 1)); sincosf(li * dt * (float)(tau + 1), &sn, &cs); p1r[tid] = mg * cs; p1i[tid] = mg * sn;
    if (tau == 31) { float* a32 = (float*)(p.ws + OFF_A32); a32[(g * 64 + tid) * 2] = mg * cs; a32[(g * 64 + tid) * 2 + 1] = mg * sn; }
  }
  {
    const int pp = tid >> 2, hq = (tid & 3) * 4;
    const float lr = p.s5_lam_re[g * 64 + pp], li = p.s5_lam_im[g * 64 + pp];
    const float mg = expf(lr * dt); float sn, cs; sincosf(li * dt, &sn, &cs);
    const float ar = mg * cs, ai = mg * sn, den = lr * lr + li * li, nr = ar - 1.f, ni = ai;
    const float fre = (nr * lr + ni * li) / den, fim = (ni * lr - nr * li) / den;
#pragma unroll
    for (int e = 0; e < 4; ++e) {
      const float br = p.s5_b_re[(size_t)(g * 64 + pp) * 16 + hq + e], bi = p.s5_b_im[(size_t)(g * 64 + pp) * 16 + hq + e];
      bbr[pp * 16 + hq + e] = fre * br - fim * bi; bbi[pp * 16 + hq + e] = fre * bi + fim * br;
    }
    for (int i = tid; i < 1024; i += 256) { cre[i] = p.s5_c_re[(size_t)g * 1024 + i]; cim[i] = p.s5_c_im[(size_t)g * 1024 + i]; }
  }
  __syncthreads();
  u16* mf = (u16*)(p.ws + OFF_MF) + (size_t)g * 512 * UXW;
  u16* eg = (u16*)(p.ws + OFF_EG) + (size_t)g * 128 * 512;
  {
    const int h = tid >> 4, hp = tid & 15;
    float kv = 0.f;
    for (int pp = 0; pp < 64; ++pp) {
      const float cr = cre[h * 64 + pp], ci = cim[h * 64 + pp], pr = pwr[pp], pi = pwi[pp];
      kv += (cr * pr - ci * pi) * bbr[pp * 16 + hp] - (cr * pi + ci * pr) * bbi[pp * 16 + hp];
    }
    const u16 kb = f2bf(kv);
    for (int s0 = 0; s0 + tau < 32; ++s0) mf[(size_t)((s0 + tau) * 16 + h) * UXW + s0 * 16 + hp] = kb;
    for (int t0 = 0; t0 + tau + 1 < 32; ++t0) mf[(size_t)(t0 * 16 + h) * UXW + (t0 + tau + 1) * 16 + hp] = 0;
#pragma unroll
    for (int e = 0; e < 4; ++e) {
      const int pp = hp * 4 + e;
      const float cr = cre[h * 64 + pp], ci = cim[h * 64 + pp], pr = p1r[pp], pi = p1i[pp];
      mf[(size_t)(tau * 16 + h) * UXW + 512 + pp] = f2bf(cr * pr - ci * pi);
      mf[(size_t)(tau * 16 + h) * UXW + 576 + pp] = f2bf(-(cr * pi + ci * pr));
    }
  }
  {
    const int pp = tid >> 2, hq = (tid & 3) * 4, s0 = 31 - tau;
#pragma unroll
    for (int e = 0; e < 4; ++e) {
      const float br = bbr[pp * 16 + hq + e], bi = bbi[pp * 16 + hq + e], pr = pwr[pp], pi = pwi[pp];
      eg[(size_t)pp * 512 + s0 * 16 + hq + e] = f2bf(pr * br - pi * bi);
      eg[(size_t)(64 + pp) * 512 + s0 * 16 + hq + e] = f2bf(pr * bi + pi * br);
    }
  }
  __syncthreads();
}

__device__ __forceinline__ void phase0(const Params& p, char* smem, int bid, int nblk) {
  const int tid = otid();
  for (int it = bid; it < N_TR_ITEMS + N_MOD_ITEMS + 1024; it += nblk) {
    if (it >= N_TR_ITEMS + N_MOD_ITEMS) { s5_table_item(p, it - N_TR_ITEMS - N_MOD_ITEMS, smem); continue; }
    if (it < N_TR_ITEMS) {
      int rem = it, j = 0; TrJob jb;
      for (;; ++j) { jb = get_job(p, j); int n = (jb.Nd >> 6) * (jb.K >> 6); if (rem < n) break; rem -= n; }
      const int nk = jb.K >> 6, R0 = (rem / nk) * 64, k0 = (rem % nk) * 64;
      u16* s = (u16*)smem;
      {
        const int r = tid & 63, kk = tid >> 6;
        const float* sp = jb.src + (size_t)k0 * jb.Nsrc + src_col(R0 + r, jb.mode);
#pragma unroll
        for (int i = 0; i < 16; ++i) { int k = kk + 4 * i; s[r * 72 + k] = f2bf(sp[(size_t)k * jb.Nsrc]); }
      }
      __syncthreads();
      {
        const int r = tid >> 2, ch = tid & 3;
#pragma unroll
        for (int i = 0; i < 2; ++i) {
          int c8 = (ch + 4 * i) * 8;
          *(u32x4*)(jb.dst + (size_t)(R0 + r) * jb.K + k0 + c8) = *(const u32x4*)(s + r * 72 + c8);
        }
      }
      __syncthreads();
    } else {
      const int mi = it - N_TR_ITEMS, l = mi / 96, n0 = (mi % 96) * 64;
      float* cact = (float*)smem;
      float* red = cact + 4096;
      for (int i = tid; i < 4096; i += 256) cact[i] = silu_(p.c[i]);
      __syncthreads();
      const int wid = tid >> 6, lane = tid & 63;
      float a0 = 0, a1 = 0, a2 = 0, a3 = 0;
      const float* wp = p.ada_w + (size_t)l * 1024 * 6144 + n0 + lane;
#pragma unroll 8
      for (int k = wid * 256; k < wid * 256 + 256; ++k) {
        float w = wp[(size_t)k * 6144];
        a0 += cact[k] * w; a1 += cact[1024 + k] * w; a2 += cact[2048 + k] * w; a3 += cact[3072 + k] * w;
      }
      red[(wid * 4 + 0) * 64 + lane] = a0; red[(wid * 4 + 1) * 64 + lane] = a1;
      red[(wid * 4 + 2) * 64 + lane] = a2; red[(wid * 4 + 3) * 64 + lane] = a3;
      __syncthreads();
      {
        const int b = tid >> 6;
        float sum = red[(0 * 4 + b) * 64 + lane] + red[(1 * 4 + b) * 64 + lane] + red[(2 * 4 + b) * 64 + lane] + red[(3 * 4 + b) * 64 + lane];
        float* mod = (float*)(p.ws + OFF_MOD);
        mod[(size_t)(l * 4 + b) * 6144 + n0 + lane] = sum + p.ada_b[l * 6144 + n0 + lane];
      }
      __syncthreads();
    }
  }
}

template <int MODE>
__device__ __forceinline__ void norm_phase(const Params& p, const float* src, const float* w, const float* modl, int sh_off, int sc_off,
                           char* smem, int bid, int nblk) {
  const int tid = otid(), wid = tid >> 6, lane = tid & 63;
  float* wba = (float*)smem;
  if (MODE == 1) {
    for (int i = tid; i < 1024 * 8; i += 256) wba[i] = p.hy_w_in[(size_t)(i >> 3) * EIN + 2048 + (i & 7)];
    __syncthreads();
  }
  u16* hn = (u16*)(p.ws + OFF_HN);
  for (int row = bid * 4 + wid; row < M; row += nblk * 4) {
    const float* sp = src + (size_t)row * 1024;
    f32x4 v[4]; float ss = 0;
#pragma unroll
    for (int i = 0; i < 4; ++i) { v[i] = *(const f32x4*)(sp + i * 256 + lane * 4); ss += v[i][0] * v[i][0] + v[i][1] * v[i][1] + v[i][2] * v[i][2] + v[i][3] * v[i][3]; }
#pragma unroll
    for (int o = 32; o >= 1; o >>= 1) ss += __shfl_xor(ss, o);
    const float rstd = rsqrtf(ss * (1.f / 1024.f) + 1e-6f);
    const int b = row >> 13;
    float dots[8];
    if (MODE == 1) { for (int j = 0; j < 8; ++j) dots[j] = 0.f; }
#pragma unroll
    for (int i = 0; i < 4; ++i) {
      const int c0 = i * 256 + lane * 4;
      f32x4 ww = *(const f32x4*)(w + c0);
      f32x4 y;
      if (MODE == 2) {
#pragma unroll
        for (int e = 0; e < 4; ++e) y[e] = v[i][e] * rstd * ww[e];
        *(f32x4*)(p.out + (size_t)row * 1024 + c0) = y;
      } else {
        f32x4 sc = *(const f32x4*)(modl + (size_t)b * 6144 + sc_off + c0);
        f32x4 sh = *(const f32x4*)(modl + (size_t)b * 6144 + sh_off + c0);
#pragma unroll
        for (int e = 0; e < 4; ++e) y[e] = v[i][e] * rstd * ww[e] * (1.f + sc[e]) + sh[e];
        uint2 pk; pk.x = (unsigned)f2bf(y[0]) | ((unsigned)f2bf(y[1]) << 16); pk.y = (unsigned)f2bf(y[2]) | ((unsigned)f2bf(y[3]) << 16);
        *(uint2*)(hn + (size_t)row * 1024 + c0) = pk;
        if (MODE == 1) {
#pragma unroll
          for (int e = 0; e < 4; ++e) {
            f32x4 w0 = *(const f32x4*)(wba + (c0 + e) * 8), w1 = *(const f32x4*)(wba + (c0 + e) * 8 + 4);
#pragma unroll
            for (int j = 0; j < 4; ++j) { dots[j] += y[e] * w0[j]; dots[4 + j] += y[e] * w1[j]; }
          }
        }
      }
    }
    if (MODE == 1) {
#pragma unroll
      for (int j = 0; j < 8; ++j) {
#pragma unroll
        for (int o = 32; o >= 1; o >>= 1) dots[j] += __shfl_xor(dots[j], o);
      }
      if (lane == 0) {
        float* beta = (float*)(p.ws + OFF_BETA); float* gg = (float*)(p.ws + OFF_G);
#pragma unroll
        for (int h = 0; h < 4; ++h) {
          beta[(size_t)row * 4 + h] = sigmoid_(dots[h]);
          gg[(size_t)row * 4 + h] = -__expf(p.hy_a_log[h]) * softplus_(dots[4 + h] + p.hy_dt_bias[h]);
        }
      }
    }
  }
}

enum { E_PROJ0 = 0, E_BF16 = 1, E_RESID = 2, E_GLU = 3, E_SWIGLU = 4, E_XE = 5, E_S5Y = 6 };
struct EpiArgs { float* outf; u16* outb; const float* res; const float* gate; const u16* y5; const float* bias; u16* ux; int ldc; };

template <int EPI>
__device__ __forceinline__ void gemm_phase(const u16* __restrict__ A0, int lda, size_t sA, const u16* __restrict__ B0, int ldb, size_t sB,
                                           int K, int nM, int nN, int nbatch, const EpiArgs ea, char* smem, int bid, int nblk) {
  const int tid = otid(), wid = tid >> 6, lane = tid & 63, wr = wid >> 1, wc = wid & 1, fr = lane & 15, fq = lane >> 4;
  char* SA = smem; char* SB = smem + 32768;
  const int ntiles = nbatch * nM * nN;
#pragma unroll 1
  for (int t = bid; t < ntiles; t += nblk) {
    const int g = t / (nM * nN), rem = t % (nM * nN);
    const int brow = (rem / nN) << 8, bcol = (rem % nN) << 7;
    const u16* A = A0 + (size_t)g * sA; const u16* Bt = B0 + (size_t)g * sB;
    int nk = K >> 5, klim = nk;
    if (EPI == E_S5Y) { klim = 4 * ((bcol >> 7) + 1); nk = klim + 4; }
    f32x4 acc[8][4];
#pragma unroll
    for (int m = 0; m < 8; ++m)
#pragma unroll
      for (int n = 0; n < 4; ++n) acc[m][n] = f32x4{0.f, 0.f, 0.f, 0.f};
#define GSTAGE(KK, BUF) do { const int kt_ = (EPI == E_S5Y && (KK) >= klim) ? (16 + (KK) - klim) : (KK); \
      _Pragma("unroll") for (int i = 0; i < 4; ++i) { const int b_ = tid * 16 + i * 4096, r_ = b_ >> 6, c_ = (b_ & 63) >> 1; \
        __builtin_amdgcn_global_load_lds((const unsigned*)(A + (size_t)(brow + r_) * lda + kt_ * 32 + c_), (__attribute__((address_space(3))) unsigned*)(SA + (BUF) * 16384 + b_), 16, 0, 0); } \
      _Pragma("unroll") for (int i = 0; i < 2; ++i) { const int b_ = tid * 16 + i * 4096, r_ = b_ >> 6, c_ = (b_ & 63) >> 1; \
        __builtin_amdgcn_global_load_lds((const unsigned*)(Bt + (size_t)(bcol + r_) * ldb + kt_ * 32 + c_), (__attribute__((address_space(3))) unsigned*)(SB + (BUF) * 8192 + b_), 16, 0, 0); } } while (0)
    GSTAGE(0, 0);
    asm volatile("s_waitcnt vmcnt(0)" ::: "memory");
    __syncthreads();
#pragma unroll 1
    for (int kk = 0; kk < nk; ++kk) {
      const int buf = kk & 1;
      if (kk + 1 < nk) GSTAGE(kk + 1, buf ^ 1);
      bf16x8 Bl[4];
#pragma unroll
      for (int n = 0; n < 4; ++n) Bl[n] = *(const bf16x8*)(SB + buf * 8192 + (wc * 64 + n * 16 + fr) * 64 + fq * 16);
#pragma unroll
      for (int mh = 0; mh < 2; ++mh) {
        bf16x8 At[4];
#pragma unroll
        for (int m = 0; m < 4; ++m) At[m] = *(const bf16x8*)(SA + buf * 16384 + (wr * 128 + (mh * 4 + m) * 16 + fr) * 64 + fq * 16);
#pragma unroll
        for (int m = 0; m < 4; ++m)
#pragma unroll
          for (int n = 0; n < 4; ++n) acc[mh * 4 + m][n] = __builtin_amdgcn_mfma_f32_16x16x32_bf16(At[m], Bl[n], acc[mh * 4 + m][n], 0, 0, 0);
      }
      asm volatile("s_waitcnt vmcnt(0)" ::: "memory");
      __syncthreads();
    }
#undef GSTAGE
#pragma unroll
    for (int m = 0; m < 8; ++m)
#pragma unroll
      for (int n = 0; n < 4; ++n)
#pragma unroll
        for (int j = 0; j < 4; ++j) {
          const int row = brow + wr * 128 + m * 16 + fq * 4 + j, col = bcol + wc * 64 + n * 16 + fr;
          const float v = acc[m][n][j];
          if (EPI == E_PROJ0) {
            if (bcol < 2048) ea.outb[(size_t)row * PJ + col] = f2bf(v);
            else { const int cc = col - 2048; ea.ux[((size_t)(cc >> 4) * S5C + (row >> 5)) * UXW + (row & 31) * 16 + (cc & 15)] = f2bf(v); }
          }
          if (EPI == E_BF16) ea.outb[(size_t)row * ea.ldc + col] = f2bf(v);
          if (EPI == E_RESID) { size_t idx = (size_t)row * 1024 + col; ea.outf[idx] = ea.res[idx] + ea.gate[(size_t)(row >> 13) * 6144 + col] * v; }
          if (EPI == E_GLU) { float y = bf2f(ea.y5[(size_t)row * 512 + col]); ea.outb[(size_t)row * 1024 + 512 + col] = f2bf(y * sigmoid_(v + ea.bias[col])); }
          if (EPI == E_SWIGLU) {
            if ((n & 1) == 0) {
              const float u = acc[m][n | 1][j];
              const int co = (bcol >> 1) + wc * 32 + (n >> 1) * 16 + fr;
              ea.outb[(size_t)row * FF + co] = f2bf(silu_(v) * u);
            }
          }
          if (EPI == E_XE) ea.outf[((size_t)g * S5C + row) * 128 + col] = v;
          if (EPI == E_S5Y) {
            const float u = bf2f(ea.ux[((size_t)g * S5C + row) * UXW + col]);
            const float y = gelu_tanh_(v + ea.bias[g * 16 + (col & 15)] * u);
            ea.outb[((size_t)row * 32 + (col >> 4)) * 512 + g * 16 + (col & 15)] = f2bf(y);
          }
        }
  }
}

__device__ __forceinline__ void s5_carry_phase(const Params& p, int bid, int nblk) {
  const float* xe = (const float*)(p.ws + OFF_XE); const float* a32 = (const float*)(p.ws + OFF_A32);
  u16* ux = (u16*)(p.ws + OFF_UX);
  for (int it = bid; it < 32; it += nblk) {
    const int idx = it * 256 + otid(), pp = idx & 63, g = (idx >> 6) & 31, b = idx >> 11;
    const float ar = a32[(g * 64 + pp) * 2], ai = a32[(g * 64 + pp) * 2 + 1];
    float xr = 0.f, xi = 0.f;
    const size_t cbase = (size_t)g * S5C + b * 256;
    for (int n = 0; n < 256; n += 8) {
      float er[8], ei[8];
#pragma unroll
      for (int e = 0; e < 8; ++e) { er[e] = xe[(cbase + n + e) * 128 + pp]; ei[e] = xe[(cbase + n + e) * 128 + 64 + pp]; }
#pragma unroll
      for (int e = 0; e < 8; ++e) {
        ux[(cbase + n + e) * UXW + 512 + pp] = f2bf(xr); ux[(cbase + n + e) * UXW + 576 + pp] = f2bf(xi);
        const float nr = ar * xr - ai * xi + er[e], ni = ar * xi + ai * xr + ei[e];
        xr = nr; xi = ni;
      }
    }
  }
}

__device__ __forceinline__ int crow(int r, int hi) { return (r & 3) + 8 * (r >> 2) + 4 * hi; }
using f32x16 = __attribute__((ext_vector_type(16))) float;
__device__ __forceinline__ void unpack8(const u32x4 w, float* f) {
#pragma unroll
  for (int e = 0; e < 4; ++e) { f[2 * e] = __uint_as_float(w[e] << 16); f[2 * e + 1] = __uint_as_float(w[e] & 0xffff0000u); }
}
__device__ __forceinline__ void gdn_prep_phase(const Params& p, char* smem, int bid, int nblk) {
  const int tid = otid(), wid = tid >> 6, lane = tid & 63, fr = lane & 15, fq = lane >> 4;
  u16* qs = (u16*)smem;
  u16* ks = qs + 64 * 136;
  float* Lm = (float*)(ks + 64 * 136);
  float* gcs = Lm + 4096; float* bts = gcs + 64; float* egs = bts + 64;
  const u16* proj = (const u16*)(p.ws + OFF_PROJ);
  const float* beta = (const float*)(p.ws + OFF_BETA); const float* gg = (const float*)(p.ws + OFF_G);
#pragma unroll 1
  for (int it = bid; it < 2048; it += nblk) {
    const int n = it & 127, bh = it >> 7, b = bh >> 2, h = bh & 3;
    const size_t row0 = (size_t)b * SEQ + n * 64;
    if (wid == 0) {
      float c = gg[(row0 + lane) * 4 + h];
#pragma unroll
      for (int o = 1; o < 64; o <<= 1) { const float tt = __shfl_up(c, o); if (lane >= o) c += tt; }
      gcs[lane] = c; egs[lane] = __expf(c); bts[lane] = beta[(row0 + lane) * 4 + h];
    }
    {
      const int tok = tid >> 2, part = tid & 3, l = n * 64 + tok;
      float qo[32], ko[32]; float sq = 0.f, sk = 0.f;
#pragma unroll
      for (int cb = 0; cb < 4; ++cb) {
        const int colq = h * 128 + part * 32 + cb * 8, colk = 512 + colq;
        float aq[8], ak[8];
#pragma unroll
        for (int e = 0; e < 8; ++e) { aq[e] = 0.f; ak[e] = 0.f; }
#pragma unroll
        for (int j = 0; j < 4; ++j) {
          const int lt = l - 3 + j;
          if (lt >= 0) {
            const u16* rp = proj + ((size_t)b * SEQ + lt) * PJ;
            float xq[8], xk[8];
            unpack8(*(const u32x4*)(rp + colq), xq); unpack8(*(const u32x4*)(rp + colk), xk);
            const f32x4 wq0 = *(const f32x4*)(p.hy_conv_w + j * 1536 + colq), wq1 = *(const f32x4*)(p.hy_conv_w + j * 1536 + colq + 4);
            const f32x4 wk0 = *(const f32x4*)(p.hy_conv_w + j * 1536 + colk), wk1 = *(const f32x4*)(p.hy_conv_w + j * 1536 + colk + 4);
#pragma unroll
            for (int e = 0; e < 4; ++e) { aq[e] += wq0[e] * xq[e]; aq[4 + e] += wq1[e] * xq[4 + e]; ak[e] += wk0[e] * xk[e]; ak[4 + e] += wk1[e] * xk[4 + e]; }
          }
        }
#pragma unroll
        for (int e = 0; e < 8; ++e) { const float a = silu_(aq[e]), k = silu_(ak[e]); qo[cb * 8 + e] = a; ko[cb * 8 + e] = k; sq += a * a; sk += k * k; }
      }
      sq += __shfl_xor(sq, 1); sq += __shfl_xor(sq, 2); sk += __shfl_xor(sk, 1); sk += __shfl_xor(sk, 2);
      const float rq = rsqrtf(sq + 1e-6f) * 0.08838834764831845f, rk = rsqrtf(sk + 1e-6f);
#pragma unroll
      for (int cb = 0; cb < 4; ++cb) {
        u32x4 wq, wk;
#pragma unroll
        for (int e = 0; e < 4; ++e) { wq[e] = pk2(qo[cb * 8 + 2 * e] * rq, qo[cb * 8 + 2 * e + 1] * rq); wk[e] = pk2(ko[cb * 8 + 2 * e] * rk, ko[cb * 8 + 2 * e + 1] * rk); }
        *(u32x4*)(qs + tok * 136 + part * 32 + cb * 8) = wq; *(u32x4*)(ks + tok * 136 + part * 32 + cb * 8) = wk;
      }
    }
    __syncthreads();
    {
      f32x4 akk[4], aqk[4];
#pragma unroll
      for (int nb = 0; nb < 4; ++nb) { akk[nb] = f32x4{0.f, 0.f, 0.f, 0.f}; aqk[nb] = f32x4{0.f, 0.f, 0.f, 0.f}; }
#pragma unroll
      for (int kk = 0; kk < 4; ++kk) {
        const bf16x8 ak = *(const bf16x8*)(ks + (16 * wid + fr) * 136 + kk * 32 + fq * 8);
        const bf16x8 aq = *(const bf16x8*)(qs + (16 * wid + fr) * 136 + kk * 32 + fq * 8);
#pragma unroll
        for (int nb = 0; nb < 4; ++nb) {
          const bf16x8 bk = *(const bf16x8*)(ks + (16 * nb + fr) * 136 + kk * 32 + fq * 8);
          akk[nb] = __builtin_amdgcn_mfma_f32_16x16x32_bf16(ak, bk, akk[nb], 0, 0, 0);
          aqk[nb] = __builtin_amdgcn_mfma_f32_16x16x32_bf16(aq, bk, aqk[nb], 0, 0, 0);
        }
      }
      u16* att = (u16*)(p.ws + OFF_GAT) + (size_t)it * 4096;
#pragma unroll
      for (int nb = 0; nb < 4; ++nb)
#pragma unroll
        for (int r = 0; r < 4; ++r) {
          const int i = 16 * wid + fq * 4 + r, j = 16 * nb + fr;
          const float dec = __expf(fminf(gcs[i] - gcs[j], 0.f));
          Lm[i * 64 + j] = (i > j) ? bts[i] * akk[nb][r] * dec : 0.f;
          att[i * 64 + j] = f2bf((i >= j) ? aqk[nb][r] * dec : 0.f);
        }
    }
    __syncthreads();
    {
      float x[64];
      if (tid < 128) {
        const int col = 1024 + h * 128 + tid;
        const float w0 = p.hy_conv_w[col], w1 = p.hy_conv_w[1536 + col], w2 = p.hy_conv_w[2 * 1536 + col], w3 = p.hy_conv_w[3 * 1536 + col];
        float x1 = 0.f, x2 = 0.f, x3 = 0.f;
        if (n > 0) { x3 = bf2f(proj[(row0 - 3) * PJ + col]); x2 = bf2f(proj[(row0 - 2) * PJ + col]); x1 = bf2f(proj[(row0 - 1) * PJ + col]); }
#pragma unroll
        for (int i = 0; i < 64; ++i) {
          const float xv = bf2f(proj[(row0 + i) * PJ + col]);
          x[i] = silu_(w0 * x3 + w1 * x2 + w2 * x1 + w3 * xv) * bts[i];
          x3 = x2; x2 = x1; x1 = xv;
        }
      } else {
#pragma unroll
        for (int i = 0; i < 64; ++i) x[i] = bf2f(ks[i * 136 + tid - 128]) * bts[i] * egs[i];
      }
#pragma unroll
      for (int i = 1; i < 64; ++i) {
        float acc = x[i];
#pragma unroll
        for (int j4 = 0; j4 < (i + 3) / 4; ++j4) {
          const f32x4 l4 = *(const f32x4*)(Lm + i * 64 + j4 * 4);
#pragma unroll
          for (int e = 0; e < 4; ++e) if (j4 * 4 + e < i) acc -= l4[e] * x[j4 * 4 + e];
        }
        x[i] = acc;
      }
      if (tid < 128) {
        u16* ut = (u16*)(p.ws + OFF_GUT) + (size_t)it * 8192 + tid * 64;
#pragma unroll
        for (int c8 = 0; c8 < 8; ++c8) {
          u32x4 w;
#pragma unroll
          for (int e = 0; e < 4; ++e) w[e] = pk2(x[c8 * 8 + 2 * e], x[c8 * 8 + 2 * e + 1]);
          *(u32x4*)(ut + c8 * 8) = w;
        }
      } else {
        u16* wg = (u16*)(p.ws + OFF_GW) + (size_t)it * 8192 + (tid - 128);
#pragma unroll
        for (int i = 0; i < 64; ++i) wg[i * 128] = f2bf(x[i]);
      }
    }
    {
      u16* qd = (u16*)(p.ws + OFF_GQD) + (size_t)it * 8192;
#pragma unroll
      for (int k = 0; k < 4; ++k) {
        const int piece = tid + 256 * k, i = piece >> 4, d0 = (piece & 15) * 8;
        float f[8]; unpack8(*(const u32x4*)(qs + i * 136 + d0), f);
        const float e = egs[i];
        u32x4 w;
#pragma unroll
        for (int e2 = 0; e2 < 4; ++e2) w[e2] = pk2(f[2 * e2] * e, f[2 * e2 + 1] * e);
        *(u32x4*)(qd + i * 128 + d0) = w;
      }
      u16* kt = (u16*)(p.ws + OFF_GKT) + (size_t)it * 8192;
      const int dk = tid & 127, half = tid >> 7;
      const float gl = gcs[63];
#pragma unroll
      for (int c8 = 0; c8 < 4; ++c8) {
        u32x4 w;
#pragma unroll
        for (int e = 0; e < 4; ++e) {
          const int i0 = half * 32 + c8 * 8 + 2 * e;
          w[e] = pk2(bf2f(ks[i0 * 136 + dk]) * __expf(gl - gcs[i0]), bf2f(ks[(i0 + 1) * 136 + dk]) * __expf(gl - gcs[i0 + 1]));
        }
        *(u32x4*)(kt + dk * 64 + half * 32 + c8 * 8) = w;
      }
      if (tid == 0) ((float*)(p.ws + OFF_GSD))[it] = egs[63];
    }
    __syncthreads();
  }
}

__device__ __forceinline__ uint2 lds64(const char* p) { return *(const uint2*)p; }
__device__ __forceinline__ bf16x8 mk8(uint2 a, uint2 b) { u32x4 w = {a.x, a.y, b.x, b.y}; return __builtin_bit_cast(bf16x8, w); }
__device__ __forceinline__ bf16x8 pack8(const f32x16& x, int s) {
  u32x4 w = {pk2(x[8 * s], x[8 * s + 1]), pk2(x[8 * s + 2], x[8 * s + 3]), pk2(x[8 * s + 4], x[8 * s + 5]), pk2(x[8 * s + 6], x[8 * s + 7])};
  return __builtin_bit_cast(bf16x8, w);
}
__device__ __forceinline__ void gdn_scan_item(const Params& p, int bh, char* smem) {
  const int tid = otid(), wid = tid >> 6, lane = tid & 63, r32 = lane & 31, hi = lane >> 5;
  char* Wl = smem; char* QDl = smem + 16896; char* KTl = smem + 33792; char* ATl = smem + 51200;
  const int b = bh >> 2, h = bh & 3;
  const char* gw = p.ws + OFF_GW; const char* gqd = p.ws + OFF_GQD; const char* gkt = p.ws + OFF_GKT; const char* gat = p.ws + OFF_GAT;
  const u16* gut = (const u16*)(p.ws + OFF_GUT);
  const float* gsd = (const float*)(p.ws + OFF_GSD);
  float* og = (float*)(p.ws + OFF_HN);
  f32x16 S[4];
#pragma unroll
  for (int T = 0; T < 4; ++T)
#pragma unroll
    for (int r = 0; r < 16; ++r) S[T][r] = 0.f;
  u32x4 st[14]; uint2 uc[8];
  const int dv = wid * 32 + r32;
#define G_LOAD(IT) do { const size_t o16 = (size_t)(IT) * 16384, o8 = (size_t)(IT) * 8192; \
    _Pragma("unroll") for (int k = 0; k < 4; ++k) { st[k] = *(const u32x4*)(gw + o16 + (tid + 256 * k) * 16); st[4 + k] = *(const u32x4*)(gqd + o16 + (tid + 256 * k) * 16); \
      st[8 + k] = *(const u32x4*)(gkt + o16 + (tid + 256 * k) * 16); } \
    _Pragma("unroll") for (int k = 0; k < 2; ++k) st[12 + k] = *(const u32x4*)(gat + o8 + (tid + 256 * k) * 16); } while (0)
#define U_LOAD(IT) do { _Pragma("unroll") for (int k = 0; k < 8; ++k) uc[k] = *(const uint2*)(gut + (size_t)(IT) * 8192 + dv * 64 + 32 * (k >> 2) + 8 * (k & 3) + 4 * hi); } while (0)
#define G_WRITE() do { \
    _Pragma("unroll") for (int k = 0; k < 4; ++k) { const int pc = tid + 256 * k; \
      { char* d = Wl + (pc >> 4) * 264 + (pc & 15) * 16; *(uint2*)d = uint2{st[k][0], st[k][1]}; *(uint2*)(d + 8) = uint2{st[k][2], st[k][3]}; } \
      { char* d = QDl + (pc >> 4) * 264 + (pc & 15) * 16; *(uint2*)d = uint2{st[4 + k][0], st[4 + k][1]}; *(uint2*)(d + 8) = uint2{st[4 + k][2], st[4 + k][3]}; } \
      { char* d = KTl + (pc >> 3) * 136 + (pc & 7) * 16; *(uint2*)d = uint2{st[8 + k][0], st[8 + k][1]}; *(uint2*)(d + 8) = uint2{st[8 + k][2], st[8 + k][3]}; } } \
    _Pragma("unroll") for (int k = 0; k < 2; ++k) { const int pc = tid + 256 * k; \
      char* d = ATl + (pc >> 3) * 136 + (pc & 7) * 16; *(uint2*)d = uint2{st[12 + k][0], st[12 + k][1]}; *(uint2*)(d + 8) = uint2{st[12 + k][2], st[12 + k][3]}; } } while (0)
  G_LOAD(bh * 128); U_LOAD(bh * 128); G_WRITE(); __syncthreads();
#pragma unroll 1
  for (int n = 0; n < 128; ++n) {
    const int item = bh * 128 + n;
    if (n + 1 < 128) G_LOAD(item + 1);
    f32x16 av[2], ao[2];
#pragma unroll
    for (int r = 0; r < 16; ++r) { av[0][r] = 0.f; av[1][r] = 0.f; ao[0][r] = 0.f; ao[1][r] = 0.f; }
#pragma unroll
    for (int T = 0; T < 4; ++T)
#pragma unroll
      for (int s = 0; s < 2; ++s) {
        const bf16x8 sb = pack8(S[T], s);
        const int cb = (32 * T + 16 * s + 4 * hi) * 2;
#pragma unroll
        for (int it = 0; it < 2; ++it) {
          const char* wp = Wl + (32 * it + r32) * 264 + cb; const char* qp = QDl + (32 * it + r32) * 264 + cb;
          av[it] = __builtin_amdgcn_mfma_f32_32x32x16_bf16(mk8(lds64(wp), lds64(wp + 16)), sb, av[it], 0, 0, 0);
          ao[it] = __builtin_amdgcn_mfma_f32_32x32x16_bf16(mk8(lds64(qp), lds64(qp + 16)), sb, ao[it], 0, 0, 0);
        }
      }
    bf16x8 vb[2][2];
#pragma unroll
    for (int it = 0; it < 2; ++it) {
      f32x16 vn;
#pragma unroll
      for (int g = 0; g < 4; ++g) {
        const uint2 u2 = uc[it * 4 + g];
        vn[4 * g] = __uint_as_float(u2.x << 16) - av[it][4 * g]; vn[4 * g + 1] = __uint_as_float(u2.x & 0xffff0000u) - av[it][4 * g + 1];
        vn[4 * g + 2] = __uint_as_float(u2.y << 16) - av[it][4 * g + 2]; vn[4 * g + 3] = __uint_as_float(u2.y & 0xffff0000u) - av[it][4 * g + 3];
      }
      vb[it][0] = pack8(vn, 0); vb[it][1] = pack8(vn, 1);
    }
    if (n + 1 < 128) U_LOAD(item + 1);
#pragma unroll
    for (int it2 = 0; it2 < 2; ++it2)
#pragma unroll
      for (int it = 0; it <= it2; ++it)
#pragma unroll
        for (int s = 0; s < 2; ++s) {
          const char* ap = ATl + (32 * it2 + r32) * 136 + (32 * it + 16 * s + 4 * hi) * 2;
          ao[it2] = __builtin_amdgcn_mfma_f32_32x32x16_bf16(mk8(lds64(ap), lds64(ap + 16)), vb[it][s], ao[it2], 0, 0, 0);
        }
    {
      float* op = og + ((size_t)b * SEQ + n * 64) * 512 + h * 128 + dv;
#pragma unroll
      for (int it = 0; it < 2; ++it)
#pragma unroll
        for (int r = 0; r < 16; ++r) op[(size_t)(32 * it + crow(r, hi)) * 512] = ao[it][r];
    }
    const float sd = gsd[item];
#pragma unroll
    for (int T = 0; T < 4; ++T) {
#pragma unroll
      for (int r = 0; r < 16; ++r) S[T][r] *= sd;
#pragma unroll
      for (int it = 0; it < 2; ++it)
#pragma unroll
        for (int s = 0; s < 2; ++s) {
          const char* kp = KTl + (32 * T + r32) * 136 + (32 * it + 16 * s + 4 * hi) * 2;
          S[T] = __builtin_amdgcn_mfma_f32_32x32x16_bf16(mk8(lds64(kp), lds64(kp + 16)), vb[it][s], S[T], 0, 0, 0);
        }
    }
    __syncthreads();
    if (n + 1 < 128) G_WRITE();
    __syncthreads();
  }
#undef G_LOAD
#undef G_WRITE
#undef U_LOAD
}

__device__ __forceinline__ void gdn_normgate_phase(const Params& p, int bid, int nblk) {
  const int tid = otid(), wid = tid >> 6, lane = tid & 63;
  const float* og = (const float*)(p.ws + OFF_HN);
  u16* concat = (u16*)(p.ws + OFF_HN);
  const u16* proj = (const u16*)(p.ws + OFF_PROJ);
  const f32x4 hw0 = *(const f32x4*)(p.hy_head_norm_w + (lane & 15) * 8), hw1 = *(const f32x4*)(p.hy_head_norm_w + (lane & 15) * 8 + 4);
#pragma unroll 1
  for (int row = bid * 4 + wid; row < M; row += nblk * 4) {
    const f32x4 a0 = *(const f32x4*)(og + (size_t)row * 512 + lane * 8), a1 = *(const f32x4*)(og + (size_t)row * 512 + lane * 8 + 4);
    float zf[8]; unpack8(*(const u32x4*)(proj + (size_t)row * PJ + 1536 + lane * 8), zf);
    float ss = a0[0] * a0[0] + a0[1] * a0[1] + a0[2] * a0[2] + a0[3] * a0[3] + a1[0] * a1[0] + a1[1] * a1[1] + a1[2] * a1[2] + a1[3] * a1[3];
#pragma unroll
    for (int o = 8; o >= 1; o >>= 1) ss += __shfl_xor(ss, o);
    const float rs = rsqrtf(ss * (1.f / 128.f) + 1e-6f);
    u32x4 w;
    w[0] = pk2(a0[0] * rs * hw0[0] * silu_(zf[0]), a0[1] * rs * hw0[1] * silu_(zf[1]));
    w[1] = pk2(a0[2] * rs * hw0[2] * silu_(zf[2]), a0[3] * rs * hw0[3] * silu_(zf[3]));
    w[2] = pk2(a1[0] * rs * hw1[0] * silu_(zf[4]), a1[1] * rs * hw1[1] * silu_(zf[5]));
    w[3] = pk2(a1[2] * rs * hw1[2] * silu_(zf[6]), a1[3] * rs * hw1[3] * silu_(zf[7]));
    *(u32x4*)(concat + (size_t)row * 1024 + lane * 8) = w;
  }
}

using s16x4 = __attribute__((ext_vector_type(4))) short;
#define KSWZ(row, colB) ((row) * 256 + ((colB) ^ (((row) & 7) << 4)))
#define SBAR() __builtin_amdgcn_sched_barrier(0)
__device__ __forceinline__ unsigned cvtpk(float lo, float hi) { unsigned r; asm volatile("v_cvt_pk_bf16_f32 %0, %1, %2" : "=v"(r) : "v"(lo), "v"(hi)); return r; }
__device__ __forceinline__ int v_st(int k, int c) { const int kk = (k & ~0xC) | ((k & 4) << 1) | ((k & 8) >> 1); return ((kk >> 3) * 4 + (c >> 5)) * 512 + ((kk & 7) * 32 + (c & 31)) * 2; }
__device__ __forceinline__ int v_rd_base(int lane) { return ((lane & 3) << 3) | (((lane >> 2) & 3) << 6) | (((lane >> 4) & 1) << 5) | (((lane >> 5) & 1) << 8); }
constexpr int v_rd_off(int d0, int ks, int half) { return d0 * 512 + ks * 4096 + half * 2048; }
template <int OFF> __device__ __forceinline__ s16x4 tr_read(int vb) {
  s16x4 r; asm volatile("ds_read_b64_tr_b16 %0, %1 offset:%2" : "=&v"(r) : "v"(vb), "i"(OFF) : "memory"); return r;
}
template <int D0> __device__ __forceinline__ void pv_one(f32x16& od, int vb, bf16x8 pa0, bf16x8 pa1, bf16x8 pa2, bf16x8 pa3) {
  const s16x4 l0 = tr_read<v_rd_off(D0, 0, 0)>(vb), h0 = tr_read<v_rd_off(D0, 0, 1)>(vb), l1 = tr_read<v_rd_off(D0, 1, 0)>(vb), h1 = tr_read<v_rd_off(D0, 1, 1)>(vb);
  const s16x4 l2 = tr_read<v_rd_off(D0, 2, 0)>(vb), h2 = tr_read<v_rd_off(D0, 2, 1)>(vb), l3 = tr_read<v_rd_off(D0, 3, 0)>(vb), h3 = tr_read<v_rd_off(D0, 3, 1)>(vb);
  asm volatile("s_waitcnt lgkmcnt(0)" ::: "memory"); SBAR();
#define PK(L, H) (bf16x8){L[0], L[1], L[2], L[3], H[0], H[1], H[2], H[3]}
  od = __builtin_amdgcn_mfma_f32_32x32x16_bf16(pa0, PK(l0, h0), od, 0, 0, 0);
  od = __builtin_amdgcn_mfma_f32_32x32x16_bf16(pa1, PK(l1, h1), od, 0, 0, 0);
  od = __builtin_amdgcn_mfma_f32_32x32x16_bf16(pa2, PK(l2, h2), od, 0, 0, 0);
  od = __builtin_amdgcn_mfma_f32_32x32x16_bf16(pa3, PK(l3, h3), od, 0, 0, 0);
#undef PK
}
__device__ __forceinline__ float pl32_other(float a, float b, int hi) {
  auto rr = __builtin_amdgcn_permlane32_swap(__float_as_uint(a), __float_as_uint(b), false, false);
  return __uint_as_float(hi ? rr[0] : rr[1]);
}
__device__ __forceinline__ void sb_half(f32x16& pz, float& run, bool need_mask, int kb, int t, int hi) {
  constexpr float SC = 0.08838834764831845f;
  f32x16 l;
#pragma unroll
  for (int r = 0; r < 16; ++r) {
    const float z = pz[r] * SC;
    l[r] = -(fmaxf(z, 0.f) + __logf(1.f + __expf(-fabsf(z))));
    pz[r] = z;
  }
  if (need_mask) {
#pragma unroll
    for (int r = 0; r < 16; ++r) { if (kb + crow(r, hi) >= t) l[r] = 0.f; }
  }
#pragma unroll
  for (int g = 0; g < 4; ++g) { l[4 * g + 2] += l[4 * g + 3]; l[4 * g + 1] += l[4 * g + 2]; l[4 * g] += l[4 * g + 1]; }
  const float cs3 = l[12], cs2 = l[8] + cs3, cs1 = l[4] + cs2, cs0 = l[0] + cs1;
  const float off0 = cs1 + pl32_other(cs0, cs1, hi) + run;
  const float off1 = cs2 + pl32_other(cs1, cs2, hi) + run;
  const float off2 = cs3 + pl32_other(cs2, cs3, hi) + run;
  const float off3 = pl32_other(cs3, 0.f, hi) + run;
  float tot;
  { auto rr = __builtin_amdgcn_permlane32_swap(__float_as_uint(cs0), __float_as_uint(cs0), false, false); tot = __uint_as_float(rr[0]) + __uint_as_float(rr[1]); }
#pragma unroll
  for (int r = 0; r < 4; ++r) {
    pz[r] = __expf(pz[r] + l[r] + off0); pz[4 + r] = __expf(pz[4 + r] + l[4 + r] + off1);
    pz[8 + r] = __expf(pz[8 + r] + l[8 + r] + off2); pz[12 + r] = __expf(pz[12 + r] + l[12 + r] + off3);
  }
  if (need_mask) {
#pragma unroll
    for (int r = 0; r < 16; ++r) { if (kb + crow(r, hi) >= t) pz[r] = 0.f; }
  }
  run += tot;
}

__device__ __forceinline__ void attn_phase(const Params& p, char* smem, int bid, int nblk) {
  const int tid = otid(), wid = tid >> 6, lane = tid & 63, r32 = lane & 31, hi = lane >> 5;
  char* K_lds = smem; char* V_lds = smem + 16384;
  const u16* qkv = (const u16*)(p.ws + OFF_PROJ);
  u16* ao = (u16*)(p.ws + OFF_HN);
  const int sr = tid >> 4, sc = (tid & 15) * 8;
  const int vb0 = (int)(uintptr_t)V_lds + v_rd_base(lane);
  for (int k = 0; k * nblk < 2048; ++k) {
    const int i = (k & 1) ? ((k + 1) * nblk - 1 - bid) : (k * nblk + bid);
    if (i >= 2048) continue;
    const int j = 63 - (i >> 5), bh = i & 31, b = bh >> 3, h = bh & 7;
    const int i0 = j * 128;
    const size_t rowb = (size_t)b * SEQ;
    const int t = i0 + wid * 32 + r32, tmin = i0 + wid * 32, tmax = tmin + 31;
    bf16x8 qr[8];
    {
      const u16* qp = qkv + (rowb + t) * 3072 + h * 128 + hi * 8;
#pragma unroll
      for (int d0 = 0; d0 < 8; ++d0) qr[d0] = *(const bf16x8*)(qp + d0 * 16);
    }
    f32x16 o[4];
#pragma unroll
    for (int d = 0; d < 4; ++d)
#pragma unroll
      for (int r = 0; r < 16; ++r) o[d][r] = 0.f;
    float run = 0.f;
    const u16* kbase = qkv + rowb * 3072 + 1024 + h * 128 + sc;
    u32x4 stk[4], stv[4];
#define SLOAD(KT) do { _Pragma("unroll") for (int ii = 0; ii < 4; ++ii) { const u16* kp = kbase + (size_t)((KT) * 64 + sr + 16 * ii) * 3072; \
      stk[ii] = *(const u32x4*)kp; stv[ii] = *(const u32x4*)(kp + 1024); } } while (0)
#define SWRITE() do { _Pragma("unroll") for (int ii = 0; ii < 4; ++ii) { const int row = sr + 16 * ii; \
      *(u32x4*)(K_lds + KSWZ(row, sc * 2)) = stk[ii]; *(u32x4*)(V_lds + v_st(row, sc)) = stv[ii]; } } while (0)
    const int NT = 2 * j + 2;
    SLOAD(NT - 1); SWRITE(); __syncthreads();
    for (int kt = NT - 1; kt >= 0; --kt) {
      const int k0 = kt * 64;
      if (k0 <= tmax) {
        bf16x8 pa0, pa1, pa2, pa3;
#define PK4(P, BASE, OUT) do { unsigned a0 = cvtpk(P[BASE + 0], P[BASE + 1]), a1 = cvtpk(P[BASE + 2], P[BASE + 3]); \
    unsigned b0_ = cvtpk(P[BASE + 4], P[BASE + 5]), b1_ = cvtpk(P[BASE + 6], P[BASE + 7]); \
    auto r0 = __builtin_amdgcn_permlane32_swap(a0, b0_, false, false); auto r1 = __builtin_amdgcn_permlane32_swap(a1, b1_, false, false); \
    u32x4 w = {r0[0], r1[0], r0[1], r1[1]}; OUT = *reinterpret_cast<bf16x8*>(&w); } while (0)
        if (k0 + 32 <= tmax) {
          f32x16 pz;
#pragma unroll
          for (int r = 0; r < 16; ++r) pz[r] = 0.f;
#pragma unroll
          for (int d0 = 0; d0 < 8; ++d0) {
            const bf16x8 kf = *(const bf16x8*)(K_lds + KSWZ(32 + r32, (d0 * 16 + hi * 8) * 2));
            pz = __builtin_amdgcn_mfma_f32_32x32x16_bf16(kf, qr[d0], pz, 0, 0, 0);
          }
          sb_half(pz, run, k0 + 63 >= tmin, k0 + 32, t, hi);
          PK4(pz, 0, pa2); PK4(pz, 8, pa3);
        } else {
          pa2 = bf16x8{0, 0, 0, 0, 0, 0, 0, 0}; pa3 = pa2;
        }
        {
          f32x16 pz;
#pragma unroll
          for (int r = 0; r < 16; ++r) pz[r] = 0.f;
#pragma unroll
          for (int d0 = 0; d0 < 8; ++d0) {
            const bf16x8 kf = *(const bf16x8*)(K_lds + KSWZ(r32, (d0 * 16 + hi * 8) * 2));
            pz = __builtin_amdgcn_mfma_f32_32x32x16_bf16(kf, qr[d0], pz, 0, 0, 0);
          }
          sb_half(pz, run, k0 + 31 >= tmin, k0, t, hi);
          PK4(pz, 0, pa0); PK4(pz, 8, pa1);
        }
#undef PK4
        if (kt > 0) SLOAD(kt - 1);
        pv_one<0>(o[0], vb0, pa0, pa1, pa2, pa3); pv_one<1>(o[1], vb0, pa0, pa1, pa2, pa3);
        pv_one<2>(o[2], vb0, pa0, pa1, pa2, pa3); pv_one<3>(o[3], vb0, pa0, pa1, pa2, pa3);
      } else {
        if (kt > 0) SLOAD(kt - 1);
      }
      __syncthreads();
      if (kt > 0) SWRITE();
      __syncthreads();
    }
#undef SLOAD
#undef SWRITE
    {
      u16* op = ao + (rowb + i0 + wid * 32) * 1024 + h * 128 + r32;
#pragma unroll
      for (int r = 0; r < 16; ++r) {
        const int orow = crow(r, hi);
#pragma unroll
        for (int d0 = 0; d0 < 4; ++d0) op[(size_t)orow * 1024 + d0 * 32] = f2bf(o[d0][r]);
      }
    }
  }
}

__global__ void __launch_bounds__(256, 2) mega(Params p) {
  __shared__ __attribute__((aligned(16))) char smem[SMEM_BYTES];
  const int bid = blockIdx.x, nblk = gridDim.x;
  char* ws = p.ws;
  const float* mod = (const float*)(ws + OFF_MOD);
  u16* hn = (u16*)(ws + OFF_HN);
#define PH_BEGIN(n) if (p.phase_lo <= (n) && (n) < p.phase_hi) {
#define PH_END(n) if ((n) + 1 < p.phase_hi) cg::this_grid().sync(); }
  PH_BEGIN(0) phase0(p, smem, bid, nblk); PH_END(0)
  PH_BEGIN(1) norm_phase<1>(p, p.x, p.norm_mix_w, mod, 0, 1024, smem, bid, nblk); PH_END(1)
  PH_BEGIN(2) { EpiArgs ea{}; ea.outb = (u16*)(ws + OFF_PROJ); ea.ux = (u16*)(ws + OFF_UX);
        gemm_phase<E_PROJ0>(hn, 1024, 0, (const u16*)(ws + OFF_WT_HYIN), 1024, 0, 1024, M / 256, PN / 128, 1, ea, smem, bid, nblk); } PH_END(2)
  PH_BEGIN(3) { EpiArgs ea{}; ea.outf = (float*)(ws + OFF_XE);
        gemm_phase<E_XE>((const u16*)(ws + OFF_UX), UXW, (size_t)S5C * UXW, (const u16*)(ws + OFF_EG), 512, (size_t)128 * 512, 512, S5C / 256, 1, 32, ea, smem, bid, nblk); } PH_END(3)
  PH_BEGIN(4) { s5_carry_phase(p, bid, nblk); gdn_prep_phase(p, smem, bid, nblk); } PH_END(4)
  PH_BEGIN(5) {
        if (bid < 16) { gdn_scan_item(p, bid, smem); }
        else { EpiArgs ea{}; ea.outb = (u16*)(ws + OFF_Y5); ea.ux = (u16*)(ws + OFF_UX); ea.bias = p.s5_d;
          gemm_phase<E_S5Y>((const u16*)(ws + OFF_UX), UXW, (size_t)S5C * UXW, (const u16*)(ws + OFF_MF), UXW, (size_t)512 * UXW, UXW, S5C / 256, 4, 32, ea, smem, bid - 16, nblk - 16); }
      } PH_END(5)
  PH_BEGIN(6) { gdn_normgate_phase(p, bid, nblk); } PH_END(6)
  PH_BEGIN(7) { EpiArgs ea{}; ea.outb = hn; ea.y5 = (const u16*)(ws + OFF_Y5); ea.bias = p.s5_glu_b;
        gemm_phase<E_GLU>((const u16*)(ws + OFF_Y5), 512, 0, (const u16*)(ws + OFF_WT_GLU), 512, 0, 512, M / 256, 4, 1, ea, smem, bid, nblk); } PH_END(7)
  PH_BEGIN(8) { EpiArgs ea{}; ea.outf = p.out; ea.res = p.x; ea.gate = mod + 2048;
        gemm_phase<E_RESID>(hn, 1024, 0, (const u16*)(ws + OFF_WT_HYOUT), 1024, 0, 1024, M / 256, 8, 1, ea, smem, bid, nblk); } PH_END(8)
  PH_BEGIN(9) norm_phase<0>(p, p.out, p.norm_ffn_w, mod, 3072, 4096, smem, bid, nblk); PH_END(9)
  PH_BEGIN(10) { EpiArgs ea{}; ea.outb = (u16*)(ws + OFF_PROJ);
        gemm_phase<E_SWIGLU>(hn, 1024, 0, (const u16*)(ws + OFF_WT_FFNIN), 1024, 0, 1024, M / 256, 2 * FF / 128, 1, ea, smem, bid, nblk); } PH_END(10)
  PH_BEGIN(11) { EpiArgs ea{}; ea.outf = p.out; ea.res = p.out; ea.gate = mod + 5120;
        gemm_phase<E_RESID>((const u16*)(ws + OFF_PROJ), FF, 0, (const u16*)(ws + OFF_WT_FFNOUT), FF, 0, FF, M / 256, 8, 1, ea, smem, bid, nblk); } PH_END(11)
  PH_BEGIN(12) norm_phase<0>(p, p.out, p.norm_mix_w + 1024, mod + 4 * 6144, 0, 1024, smem, bid, nblk); PH_END(12)
  PH_BEGIN(13) { EpiArgs ea{}; ea.outb = (u16*)(ws + OFF_PROJ); ea.ldc = 3072;
        gemm_phase<E_BF16>(hn, 1024, 0, (const u16*)(ws + OFF_WT_SBIN), 1024, 0, 1024, M / 256, 24, 1, ea, smem, bid, nblk); } PH_END(13)
  PH_BEGIN(14) attn_phase(p, smem, bid, nblk); PH_END(14)
  PH_BEGIN(15) { EpiArgs ea{}; ea.outf = p.out; ea.res = p.out; ea.gate = mod + 4 * 6144 + 2048;
        gemm_phase<E_RESID>(hn, 1024, 0, (const u16*)(ws + OFF_WT_SBOUT), 1024, 0, 1024, M / 256, 8, 1, ea, smem, bid, nblk); } PH_END(15)
  PH_BEGIN(16) norm_phase<0>(p, p.out, p.norm_ffn_w + 1024, mod + 4 * 6144, 3072, 4096, smem, bid, nblk); PH_END(16)
  PH_BEGIN(17) { EpiArgs ea{}; ea.outb = (u16*)(ws + OFF_PROJ);
        gemm_phase<E_SWIGLU>(hn, 1024, 0, (const u16*)(ws + OFF_WT_FFNIN + SZ_WT_FFNIN), 1024, 0, 1024, M / 256, 2 * FF / 128, 1, ea, smem, bid, nblk); } PH_END(17)
  PH_BEGIN(18) { EpiArgs ea{}; ea.outf = p.out; ea.res = p.out; ea.gate = mod + 4 * 6144 + 5120;
        gemm_phase<E_RESID>((const u16*)(ws + OFF_PROJ), FF, 0, (const u16*)(ws + OFF_WT_FFNOUT + SZ_WT_FFNOUT), FF, 0, FF, M / 256, 8, 1, ea, smem, bid, nblk); } PH_END(18)
  PH_BEGIN(19) norm_phase<2>(p, p.out, p.final_norm_w, mod, 0, 0, smem, bid, nblk); PH_END(19)
}

extern "C" void kernel_launch(void* const* d_in, const int* in_sizes, int n_in, void* d_out, int out_size, void* d_ws, size_t ws_size,
                              hipStream_t stream) {
  static int grid_blocks = 0;
  if (!grid_blocks) {
    int dev = 0, cus = 0, per_cu = 0;
    hipGetDevice(&dev);
    hipDeviceGetAttribute(&cus, hipDeviceAttributeMultiprocessorCount, dev);
    hipOccupancyMaxActiveBlocksPerMultiprocessor(&per_cu, mega, 256, 0);
    if (per_cu > 2) per_cu = 2;
    if (per_cu < 1) per_cu = 1;
    grid_blocks = cus * per_cu;
  }
  Params p{};
  const float* const* in = (const float* const*)d_in;
  p.x = in[0]; p.c = in[1]; p.ada_w = in[2]; p.ada_b = in[3]; p.norm_mix_w = in[4]; p.norm_ffn_w = in[5]; p.ffn_w_in = in[6]; p.ffn_w_out = in[7];
  p.hy_w_in = in[8]; p.hy_conv_w = in[9]; p.hy_a_log = in[10]; p.hy_dt_bias = in[11]; p.hy_head_norm_w = in[12];
  p.s5_lam_re = in[13]; p.s5_lam_im = in[14]; p.s5_log_dt = in[15]; p.s5_b_re = in[16]; p.s5_b_im = in[17]; p.s5_c_re = in[18]; p.s5_c_im = in[19];
  p.s5_d = in[20]; p.s5_glu_w = in[21]; p.s5_glu_b = in[22]; p.hy_w_out = in[23]; p.sb_w_in = in[24]; p.sb_w_out = in[25]; p.final_norm_w = in[26];
  p.out = (float*)d_out; p.ws = (char*)d_ws;
#if ONE_LAUNCH
  p.phase_lo = 0; p.phase_hi = NPHASE;
  void* args[] = {&p};
  hipError_t e = hipLaunchCooperativeKernel((void*)mega, dim3(grid_blocks), dim3(256), args, 0, stream);
  if (e != hipSuccess) fprintf(stderr, "cooperative launch failed: %s (grid %d)\n", hipGetErrorString(e), grid_blocks);
#else
  for (int ph = 0; ph < NPHASE; ++ph) {
    p.phase_lo = ph; p.phase_hi = ph + 1;
    hipLaunchKernelGGL(mega, dim3(grid_blocks), dim3(256), 0, stream, p);
  }
#endif
}
```

```cpp
#include <hip/hip_runtime.h>
#include <hip/hip_cooperative_groups.h>
#include <stdint.h>
#include <cstdio>
namespace cg = cooperative_groups;

#ifndef ONE_LAUNCH
#define ONE_LAUNCH 1
#endif

typedef unsigned short u16;
using bf16x8 = __attribute__((ext_vector_type(8))) short;
using f32x4 = __attribute__((ext_vector_type(4))) float;
using u32x4 = __attribute__((ext_vector_type(4))) unsigned;

constexpr int D = 1024, NB = 4, SEQ = 8192, M = NB * SEQ, FF = 2816, EIN = 2568, PN = 2560, PJ = 2048;
constexpr int NPHASE = 20;
constexpr int S5T = 32, S5C = M / S5T, UXW = 640;

constexpr size_t SZ_WT_HYIN = (size_t)PN * 1024 * 2, SZ_WT_SQ = (size_t)1024 * 1024 * 2, SZ_WT_GLU = (size_t)512 * 512 * 2;
constexpr size_t SZ_WT_FFNIN = (size_t)2 * FF * 1024 * 2, SZ_WT_FFNOUT = (size_t)1024 * FF * 2, SZ_WT_SBIN = (size_t)3072 * 1024 * 2;
constexpr size_t OFF_WT_HYIN = 0;
constexpr size_t OFF_WT_HYOUT = OFF_WT_HYIN + SZ_WT_HYIN;
constexpr size_t OFF_WT_GLU = OFF_WT_HYOUT + SZ_WT_SQ;
constexpr size_t OFF_WT_FFNIN = OFF_WT_GLU + SZ_WT_GLU;
constexpr size_t OFF_WT_FFNOUT = OFF_WT_FFNIN + 2 * SZ_WT_FFNIN;
constexpr size_t OFF_WT_SBIN = OFF_WT_FFNOUT + 2 * SZ_WT_FFNOUT;
constexpr size_t OFF_WT_SBOUT = OFF_WT_SBIN + SZ_WT_SBIN;
constexpr size_t OFF_MOD = OFF_WT_SBOUT + SZ_WT_SQ;
constexpr size_t OFF_BETA = OFF_MOD + (size_t)2 * 4 * 6144 * 4;
constexpr size_t OFF_G = OFF_BETA + (size_t)M * 4 * 4;
constexpr size_t OFF_HN = OFF_G + (size_t)M * 4 * 4;
constexpr size_t OFF_Y5 = OFF_HN + (size_t)M * 1024 * 2;
constexpr size_t OFF_UX = OFF_Y5 + (size_t)M * 512 * 2;
constexpr size_t OFF_MF = OFF_UX + (size_t)32 * S5C * UXW * 2;
constexpr size_t OFF_EG = OFF_MF + (size_t)32 * 512 * UXW * 2;
constexpr size_t OFF_XE = OFF_EG + (size_t)32 * 128 * 512 * 2;
constexpr size_t OFF_A32 = OFF_XE + (size_t)32 * S5C * 128 * 4;
constexpr size_t OFF_PROJ = OFF_A32 + (size_t)32 * 64 * 2 * 4;
constexpr size_t OFF_GW = OFF_PROJ + (size_t)M * PJ * 2;
constexpr size_t OFF_GQD = OFF_GW + (size_t)2048 * 8192 * 2;
constexpr size_t OFF_GKT = OFF_GQD + (size_t)2048 * 8192 * 2;
constexpr size_t OFF_GUT = OFF_GKT + (size_t)2048 * 8192 * 2;
constexpr size_t OFF_GAT = OFF_GUT + (size_t)2048 * 8192 * 2;
constexpr size_t OFF_GSD = OFF_GAT + (size_t)2048 * 4096 * 2;
constexpr size_t WS_TOTAL = OFF_GSD + (size_t)2048 * 4;
static_assert((size_t)M * 3072 * 2 <= WS_TOTAL - OFF_PROJ, "QKV alias");
static_assert(WS_TOTAL <= (size_t)512 * 1024 * 1024, "workspace too large");

struct Params {
  const float *x, *c, *ada_w, *ada_b, *norm_mix_w, *norm_ffn_w, *ffn_w_in, *ffn_w_out;
  const float *hy_w_in, *hy_conv_w, *hy_a_log, *hy_dt_bias, *hy_head_norm_w;
  const float *s5_lam_re, *s5_lam_im, *s5_log_dt, *s5_b_re, *s5_b_im, *s5_c_re, *s5_c_im, *s5_d, *s5_glu_w, *s5_glu_b, *hy_w_out;
  const float *sb_w_in, *sb_w_out, *final_norm_w;
  float* out;
  char* ws;
  int phase_lo, phase_hi;
};

constexpr int SMEM_BYTES = 59904;

__device__ __forceinline__ int otid() { int t = __builtin_amdgcn_workitem_id_x(); asm volatile("" : "+v"(t)); return t; }
__device__ __forceinline__ u16 f2bf(float x) { unsigned u = __float_as_uint(x); u += 0x7fffu + ((u >> 16) & 1u); return (u16)(u >> 16); }
typedef __bf16 bf16v2 __attribute__((ext_vector_type(2)));
typedef float f32v2 __attribute__((ext_vector_type(2)));
__device__ __forceinline__ unsigned pk2(float a, float b) { f32v2 v = {a, b}; bf16v2 r = __builtin_convertvector(v, bf16v2); return __builtin_bit_cast(unsigned, r); }
__device__ __forceinline__ float bf2f(u16 v) { return __uint_as_float(((unsigned)v) << 16); }
__device__ __forceinline__ float sigmoid_(float x) { return 1.f / (1.f + __expf(-x)); }
__device__ __forceinline__ float silu_(float x) { return x * sigmoid_(x); }
__device__ __forceinline__ float softplus_(float x) { return fmaxf(x, 0.f) + log1pf(__expf(-fabsf(x))); }
__device__ __forceinline__ float gelu_tanh_(float y) { return 0.5f * y * (1.f + tanhf(0.7978845608028654f * (y + 0.044715f * y * y * y))); }

struct TrJob { const float* src; u16* dst; int K, Nsrc, Nd, mode; };
__device__ __forceinline__ TrJob get_job(const Params& p, int j) {
  TrJob t;
  switch (j) {
    case 0: t = {p.hy_w_in, (u16*)(p.ws + OFF_WT_HYIN), 1024, EIN, PN, 1}; break;
    case 1: t = {p.hy_w_out, (u16*)(p.ws + OFF_WT_HYOUT), 1024, 1024, 1024, 0}; break;
    case 2: t = {p.s5_glu_w, (u16*)(p.ws + OFF_WT_GLU), 512, 512, 512, 0}; break;
    case 3: t = {p.ffn_w_in, (u16*)(p.ws + OFF_WT_FFNIN), 1024, 2 * FF, 2 * FF, 2}; break;
    case 4: t = {p.ffn_w_in + (size_t)1024 * 2 * FF, (u16*)(p.ws + OFF_WT_FFNIN + SZ_WT_FFNIN), 1024, 2 * FF, 2 * FF, 2}; break;
    case 5: t = {p.ffn_w_out, (u16*)(p.ws + OFF_WT_FFNOUT), FF, 1024, 1024, 0}; break;
    case 6: t = {p.ffn_w_out + (size_t)FF * 1024, (u16*)(p.ws + OFF_WT_FFNOUT + SZ_WT_FFNOUT), FF, 1024, 1024, 0}; break;
    case 7: t = {p.sb_w_in, (u16*)(p.ws + OFF_WT_SBIN), 1024, 3072, 3072, 0}; break;
    default: t = {p.sb_w_out, (u16*)(p.ws + OFF_WT_SBOUT), 1024, 1024, 1024, 0}; break;
  }
  return t;
}
__device__ __forceinline__ int src_col(int R, int mode) {
  if (mode == 0) return R;
  if (mode == 1) return R < 2048 ? R : R + 8;
  return ((R >> 4) & 1) * FF + (R >> 5) * 16 + (R & 15);
}
constexpr int N_TR_ITEMS = 640 + 256 + 64 + 2 * 1408 + 2 * 704 + 768 + 256;
constexpr int N_MOD_ITEMS = 2 * 6144 / 64;

__device__ __forceinline__ void s5_table_item(const Params& p, int item, char* smem) {
  const int tid = otid(), g = item >> 5, tau = item & 31;
  float* pwr = (float*)smem; float* pwi = pwr + 64; float* p1r = pwi + 64; float* p1i = p1r + 64;
  float* bbr = p1i + 64; float* bbi = bbr + 1024; float* cre = bbi + 1024; float* cim = cre + 1024;
  const float dt = expf(p.s5_log_dt[g]);
  if (tid < 64) {
    const float lr = p.s5_lam_re[g * 64 + tid], li = p.s5_lam_im[g * 64 + tid];
    float sn, cs;
    float mg = expf(lr * dt * (float)tau); sincosf(li * dt * (float)tau, &sn, &cs); pwr[tid] = mg * cs; pwi[tid] = mg * sn;
    mg = expf(lr * dt * (float)(tau + 1)); sincosf(li * dt * (float)(tau + 1), &sn, &cs); p1r[tid] = mg * cs; p1i[tid] = mg * sn;
    if (tau == 31) { float* a32 = (float*)(p.ws + OFF_A32); a32[(g * 64 + tid) * 2] = mg * cs; a32[(g * 64 + tid) * 2 + 1] = mg * sn; }
  }
  {
    const int pp = tid >> 2, hq = (tid & 3) * 4;
    const float lr = p.s5_lam_re[g * 64 + pp], li = p.s5_lam_im[g * 64 + pp];
    const float mg = expf(lr * dt); float sn, cs; sincosf(li * dt, &sn, &cs);
    const float ar = mg * cs, ai = mg * sn, den = lr * lr + li * li, nr = ar - 1.f, ni = ai;
    const float fre = (nr * lr + ni * li) / den, fim = (ni * lr - nr * li) / den;
#pragma unroll
    for (int e = 0; e < 4; ++e) {
      const float br = p.s5_b_re[(size_t)(g * 64 + pp) * 16 + hq + e], bi = p.s5_b_im[(size_t)(g * 64 + pp) * 16 + hq + e];
      bbr[pp * 16 + hq + e] = fre * br - fim * bi; bbi[pp * 16 + hq + e] = fre * bi + fim * br;
    }
    for (int i = tid; i < 1024; i += 256) { cre[i] = p.s5_c_re[(size_t)g * 1024 + i]; cim[i] = p.s5_c_im[(size_t)g * 1024 + i]; }
  }
  __syncthreads();
  u16* mf = (u16*)(p.ws + OFF_MF) + (size_t)g * 512 * UXW;
  u16* eg = (u16*)(p.ws + OFF_EG) + (size_t)g * 128 * 512;
  {
    const int h = tid >> 4, hp = tid & 15;
    float kv = 0.f;
    for (int pp = 0; pp < 64; ++pp) {
      const float cr = cre[h * 64 + pp], ci = cim[h * 64 + pp], pr = pwr[pp], pi = pwi[pp];
      kv += (cr * pr - ci * pi) * bbr[pp * 16 + hp] - (cr * pi + ci * pr) * bbi[pp * 16 + hp];
    }
    const u16 kb = f2bf(kv);
    for (int s0 = 0; s0 + tau < 32; ++s0) mf[(size_t)((s0 + tau) * 16 + h) * UXW + s0 * 16 + hp] = kb;
    for (int t0 = 0; t0 + tau + 1 < 32; ++t0) mf[(size_t)(t0 * 16 + h) * UXW + (t0 + tau + 1) * 16 + hp] = 0;
#pragma unroll
    for (int e = 0; e < 4; ++e) {
      const int pp = hp * 4 + e;
      const float cr = cre[h * 64 + pp], ci = cim[h * 64 + pp], pr = p1r[pp], pi = p1i[pp];
      mf[(size_t)(tau * 16 + h) * UXW + 512 + pp] = f2bf(cr * pr - ci * pi);
      mf[(size_t)(tau * 16 + h) * UXW + 576 + pp] = f2bf(-(cr * pi + ci * pr));
    }
  }
  {
    const int pp = tid >> 2, hq = (tid & 3) * 4, s0 = 31 - tau;
#pragma unroll
    for (int e = 0; e < 4; ++e) {
      const float br = bbr[pp * 16 + hq + e], bi = bbi[pp * 16 + hq + e], pr = pwr[pp], pi = pwi[pp];
      eg[(size_t)pp * 512 + s0 * 16 + hq + e] = f2bf(pr * br - pi * bi);
      eg[(size_t)(64 + pp) * 512 + s0 * 16 + hq + e] = f2bf(pr * bi + pi * br);
    }
  }
  __syncthreads();
}

__device__ __forceinline__ void phase0(const Params& p, char* smem, int bid, int nblk) {
  const int tid = otid();
  for (int it = bid; it < N_TR_ITEMS + N_MOD_ITEMS + 1024; it += nblk) {
    if (it >= N_TR_ITEMS + N_MOD_ITEMS) { s5_table_item(p, it - N_TR_ITEMS - N_MOD_ITEMS, smem); continue; }
    if (it < N_TR_ITEMS) {
      int rem = it, j = 0; TrJob jb;
      for (;; ++j) { jb = get_job(p, j); int n = (jb.Nd >> 6) * (jb.K >> 6); if (rem < n) break; rem -= n; }
      const int nk = jb.K >> 6, R0 = (rem / nk) * 64, k0 = (rem % nk) * 64;
      u16* s = (u16*)smem;
      {
        const int r = tid & 63, kk = tid >> 6;
        const float* sp = jb.src + (size_t)k0 * jb.Nsrc + src_col(R0 + r, jb.mode);
#pragma unroll
        for (int i = 0; i < 16; ++i) { int k = kk + 4 * i; s[r * 72 + k] = f2bf(sp[(size_t)k * jb.Nsrc]); }
      }
      __syncthreads();
      {
        const int r = tid >> 2, ch = tid & 3;
#pragma unroll
        for (int i = 0; i < 2; ++i) {
          int c8 = (ch + 4 * i) * 8;
          *(u32x4*)(jb.dst + (size_t)(R0 + r) * jb.K + k0 + c8) = *(const u32x4*)(s + r * 72 + c8);
        }
      }
      __syncthreads();
    } else {
      const int mi = it - N_TR_ITEMS, l = mi / 96, n0 = (mi % 96) * 64;
      float* cact = (float*)smem;
      float* red = cact + 4096;
      for (int i = tid; i < 4096; i += 256) cact[i] = silu_(p.c[i]);
      __syncthreads();
      const int wid = tid >> 6, lane = tid & 63;
      float a0 = 0, a1 = 0, a2 = 0, a3 = 0;
      const float* wp = p.ada_w + (size_t)l * 1024 * 6144 + n0 + lane;
#pragma unroll 8
      for (int k = wid * 256; k < wid * 256 + 256; ++k) {
        float w = wp[(size_t)k * 6144];
        a0 += cact[k] * w; a1 += cact[1024 + k] * w; a2 += cact[2048 + k] * w; a3 += cact[3072 + k] * w;
      }
      red[(wid * 4 + 0) * 64 + lane] = a0; red[(wid * 4 + 1) * 64 + lane] = a1;
      red[(wid * 4 + 2) * 64 + lane] = a2; red[(wid * 4 + 3) * 64 + lane] = a3;
      __syncthreads();
      {
        const int b = tid >> 6;
        float sum = red[(0 * 4 + b) * 64 + lane] + red[(1 * 4 + b) * 64 + lane] + red[(2 * 4 + b) * 64 + lane] + red[(3 * 4 + b) * 64 + lane];
        float* mod = (float*)(p.ws + OFF_MOD);
        mod[(size_t)(l * 4 + b) * 6144 + n0 + lane] = sum + p.ada_b[l * 6144 + n0 + lane];
      }
      __syncthreads();
    }
  }
}

template <int MODE>
__device__ __forceinline__ void norm_phase(const Params& p, const float* src, const float* w, const float* modl, int sh_off, int sc_off,
                           char* smem, int bid, int nblk) {
  const int tid = otid(), wid = tid >> 6, lane = tid & 63;
  float* wba = (float*)smem;
  if (MODE == 1) {
    for (int i = tid; i < 1024 * 8; i += 256) wba[i] = p.hy_w_in[(size_t)(i >> 3) * EIN + 2048 + (i & 7)];
    __syncthreads();
  }
  u16* hn = (u16*)(p.ws + OFF_HN);
  for (int row = bid * 4 + wid; row < M; row += nblk * 4) {
    const float* sp = src + (size_t)row * 1024;
    f32x4 v[4]; float ss = 0;
#pragma unroll
    for (int i = 0; i < 4; ++i) { v[i] = *(const f32x4*)(sp + i * 256 + lane * 4); ss += v[i][0] * v[i][0] + v[i][1] * v[i][1] + v[i][2] * v[i][2] + v[i][3] * v[i][3]; }
#pragma unroll
    for (int o = 32; o >= 1; o >>= 1) ss += __shfl_xor(ss, o);
    const float rstd = rsqrtf(ss * (1.f / 1024.f) + 1e-6f);
    const int b = row >> 13;
    float dots[8];
    if (MODE == 1) { for (int j = 0; j < 8; ++j) dots[j] = 0.f; }
#pragma unroll
    for (int i = 0; i < 4; ++i) {
      const int c0 = i * 256 + lane * 4;
      f32x4 ww = *(const f32x4*)(w + c0);
      f32x4 y;
      if (MODE == 2) {
#pragma unroll
        for (int e = 0; e < 4; ++e) y[e] = v[i][e] * rstd * ww[e];
        *(f32x4*)(p.out + (size_t)row * 1024 + c0) = y;
      } else {
        f32x4 sc = *(const f32x4*)(modl + (size_t)b * 6144 + sc_off + c0);
        f32x4 sh = *(const f32x4*)(modl + (size_t)b * 6144 + sh_off + c0);
#pragma unroll
        for (int e = 0; e < 4; ++e) y[e] = v[i][e] * rstd * ww[e] * (1.f + sc[e]) + sh[e];
        uint2 pk; pk.x = (unsigned)f2bf(y[0]) | ((unsigned)f2bf(y[1]) << 16); pk.y = (unsigned)f2bf(y[2]) | ((unsigned)f2bf(y[3]) << 16);
        *(uint2*)(hn + (size_t)row * 1024 + c0) = pk;
        if (MODE == 1) {
#pragma unroll
          for (int e = 0; e < 4; ++e) {
            f32x4 w0 = *(const f32x4*)(wba + (c0 + e) * 8), w1 = *(const f32x4*)(wba + (c0 + e) * 8 + 4);
#pragma unroll
            for (int j = 0; j < 4; ++j) { dots[j] += y[e] * w0[j]; dots[4 + j] += y[e] * w1[j]; }
          }
        }
      }
    }
    if (MODE == 1) {
#pragma unroll
      for (int j = 0; j < 8; ++j) {
#pragma unroll
        for (int o = 32; o >= 1; o >>= 1) dots[j] += __shfl_xor(dots[j], o);
      }
      if (lane == 0) {
        float* beta = (float*)(p.ws + OFF_BETA); float* gg = (float*)(p.ws + OFF_G);
#pragma unroll
        for (int h = 0; h < 4; ++h) {
          beta[(size_t)row * 4 + h] = sigmoid_(dots[h]);
          gg[(size_t)row * 4 + h] = -__expf(p.hy_a_log[h]) * softplus_(dots[4 + h] + p.hy_dt_bias[h]);
        }
      }
    }
  }
}

enum { E_PROJ0 = 0, E_BF16 = 1, E_RESID = 2, E_GLU = 3, E_SWIGLU = 4, E_XE = 5, E_S5Y = 6 };
struct EpiArgs { float* outf; u16* outb; const float* res; const float* gate; const u16* y5; const float* bias; u16* ux; int ldc; };

template <int EPI>
__device__ __forceinline__ void gemm_phase(const u16* __restrict__ A0, int lda, size_t sA, const u16* __restrict__ B0, int ldb, size_t sB,
                                           int K, int nM, int nN, int nbatch, const EpiArgs ea, char* smem, int bid, int nblk) {
  const int tid = otid(), wid = tid >> 6, lane = tid & 63, wr = wid >> 1, wc = wid & 1, fr = lane & 15, fq = lane >> 4;
  char* SA = smem; char* SB = smem + 32768;
  const int ntiles = nbatch * nM * nN;
#pragma unroll 1
  for (int t = bid; t < ntiles; t += nblk) {
    const int g = t / (nM * nN), rem = t % (nM * nN);
    const int brow = (rem / nN) << 8, bcol = (rem % nN) << 7;
    const u16* A = A0 + (size_t)g * sA; const u16* Bt = B0 + (size_t)g * sB;
    int nk = K >> 5, klim = nk;
    if (EPI == E_S5Y) { klim = 4 * ((bcol >> 7) + 1); nk = klim + 4; }
    f32x4 acc[8][4];
#pragma unroll
    for (int m = 0; m < 8; ++m)
#pragma unroll
      for (int n = 0; n < 4; ++n) acc[m][n] = f32x4{0.f, 0.f, 0.f, 0.f};
#define GSTAGE(KK, BUF) do { const int kt_ = (EPI == E_S5Y && (KK) >= klim) ? (16 + (KK) - klim) : (KK); \
      _Pragma("unroll") for (int i = 0; i < 4; ++i) { const int b_ = tid * 16 + i * 4096, r_ = b_ >> 6, c_ = (b_ & 63) >> 1; \
        __builtin_amdgcn_global_load_lds((const unsigned*)(A + (size_t)(brow + r_) * lda + kt_ * 32 + c_), (__attribute__((address_space(3))) unsigned*)(SA + (BUF) * 16384 + b_), 16, 0, 0); } \
      _Pragma("unroll") for (int i = 0; i < 2; ++i) { const int b_ = tid * 16 + i * 4096, r_ = b_ >> 6, c_ = (b_ & 63) >> 1; \
        __builtin_amdgcn_global_load_lds((const unsigned*)(Bt + (size_t)(bcol + r_) * ldb + kt_ * 32 + c_), (__attribute__((address_space(3))) unsigned*)(SB + (BUF) * 8192 + b_), 16, 0, 0); } } while (0)
    GSTAGE(0, 0);
    asm volatile("s_waitcnt vmcnt(0)" ::: "memory");
    __syncthreads();
#pragma unroll 1
    for (int kk = 0; kk < nk; ++kk) {
      const int buf = kk & 1;
      if (kk + 1 < nk) GSTAGE(kk + 1, buf ^ 1);
      bf16x8 Bl[4];
#pragma unroll
      for (int n = 0; n < 4; ++n) Bl[n] = *(const bf16x8*)(SB + buf * 8192 + (wc * 64 + n * 16 + fr) * 64 + fq * 16);
#pragma unroll
      for (int mh = 0; mh < 2; ++mh) {
        bf16x8 At[4];
#pragma unroll
        for (int m = 0; m < 4; ++m) At[m] = *(const bf16x8*)(SA + buf * 16384 + (wr * 128 + (mh * 4 + m) * 16 + fr) * 64 + fq * 16);
#pragma unroll
        for (int m = 0; m < 4; ++m)
#pragma unroll
          for (int n = 0; n < 4; ++n) acc[mh * 4 + m][n] = __builtin_amdgcn_mfma_f32_16x16x32_bf16(At[m], Bl[n], acc[mh * 4 + m][n], 0, 0, 0);
      }
      asm volatile("s_waitcnt vmcnt(0)" ::: "memory");
      __syncthreads();
    }
#undef GSTAGE
#pragma unroll
    for (int m = 0; m < 8; ++m)
#pragma unroll
      for (int n = 0; n < 4; ++n)
#pragma unroll
        for (int j = 0; j < 4; ++j) {
          const int row = brow + wr * 128 + m * 16 + fq * 4 + j, col = bcol + wc * 64 + n * 16 + fr;
          const float v = acc[m][n][j];
          if (EPI == E_PROJ0) {
            if (bcol < 2048) ea.outb[(size_t)row * PJ + col] = f2bf(v);
            else { const int cc = col - 2048; ea.ux[((size_t)(cc >> 4) * S5C + (row >> 5)) * UXW + (row & 31) * 16 + (cc & 15)] = f2bf(v); }
          }
          if (EPI == E_BF16) ea.outb[(size_t)row * ea.ldc + col] = f2bf(v);
          if (EPI == E_RESID) { size_t idx = (size_t)row * 1024 + col; ea.outf[idx] = ea.res[idx] + ea.gate[(size_t)(row >> 13) * 6144 + col] * v; }
          if (EPI == E_GLU) { float y = bf2f(ea.y5[(size_t)row * 512 + col]); ea.outb[(size_t)row * 1024 + 512 + col] = f2bf(y * sigmoid_(v + ea.bias[col])); }
          if (EPI == E_SWIGLU) {
            if ((n & 1) == 0) {
              const float u = acc[m][n | 1][j];
              const int co = (bcol >> 1) + wc * 32 + (n >> 1) * 16 + fr;
              ea.outb[(size_t)row * FF + co] = f2bf(silu_(v) * u);
            }
          }
          if (EPI == E_XE) ea.outf[((size_t)g * S5C + row) * 128 + col] = v;
          if (EPI == E_S5Y) {
            const float u = bf2f(ea.ux[((size_t)g * S5C + row) * UXW + col]);
            const float y = gelu_tanh_(v + ea.bias[g * 16 + (col & 15)] * u);
            ea.outb[((size_t)row * 32 + (col >> 4)) * 512 + g * 16 + (col & 15)] = f2bf(y);
          }
        }
  }
}

__device__ __forceinline__ void s5_carry_phase(const Params& p, int bid, int nblk) {
  const float* xe = (const float*)(p.ws + OFF_XE); const float* a32 = (const float*)(p.ws + OFF_A32);
  u16* ux = (u16*)(p.ws + OFF_UX);
  for (int it = bid; it < 32; it += nblk) {
    const int idx = it * 256 + otid(), pp = idx & 63, g = (idx >> 6) & 31, b = idx >> 11;
    const float ar = a32[(g * 64 + pp) * 2], ai = a32[(g * 64 + pp) * 2 + 1];
    float xr = 0.f, xi = 0.f;
    const size_t cbase = (size_t)g * S5C + b * 256;
    for (int n = 0; n < 256; n += 8) {
      float er[8], ei[8];
#pragma unroll
      for (int e = 0; e < 8; ++e) { er[e] = xe[(cbase + n + e) * 128 + pp]; ei[e] = xe[(cbase + n + e) * 128 + 64 + pp]; }
#pragma unroll
      for (int e = 0; e < 8; ++e) {
        ux[(cbase + n + e) * UXW + 512 + pp] = f2bf(xr); ux[(cbase + n + e) * UXW + 576 + pp] = f2bf(xi);
        const float nr = ar * xr - ai * xi + er[e], ni = ar * xi + ai * xr + ei[e];
        xr = nr; xi = ni;
      }
    }
  }
}

__device__ __forceinline__ int crow(int r, int hi) { return (r & 3) + 8 * (r >> 2) + 4 * hi; }
using f32x16 = __attribute__((ext_vector_type(16))) float;
__device__ __forceinline__ void unpack8(const u32x4 w, float* f) {
#pragma unroll
  for (int e = 0; e < 4; ++e) { f[2 * e] = __uint_as_float(w[e] << 16); f[2 * e + 1] = __uint_as_float(w[e] & 0xffff0000u); }
}
__device__ __forceinline__ void gdn_prep_phase(const Params& p, char* smem, int bid, int nblk) {
  const int tid = otid(), wid = tid >> 6, lane = tid & 63, fr = lane & 15, fq = lane >> 4;
  u16* qs = (u16*)smem;
  u16* ks = qs + 64 * 136;
  float* Lm = (float*)(ks + 64 * 136);
  float* gcs = Lm + 4096; float* bts = gcs + 64; float* egs = bts + 64;
  const u16* proj = (const u16*)(p.ws + OFF_PROJ);
  const float* beta = (const float*)(p.ws + OFF_BETA); const float* gg = (const float*)(p.ws + OFF_G);
#pragma unroll 1
  for (int it = bid; it < 2048; it += nblk) {
    const int n = it & 127, bh = it >> 7, b = bh >> 2, h = bh & 3;
    const size_t row0 = (size_t)b * SEQ + n * 64;
    if (wid == 0) {
      float c = gg[(row0 + lane) * 4 + h];
#pragma unroll
      for (int o = 1; o < 64; o <<= 1) { const float tt = __shfl_up(c, o); if (lane >= o) c += tt; }
      gcs[lane] = c; egs[lane] = __expf(c); bts[lane] = beta[(row0 + lane) * 4 + h];
    }
    {
      const int tok = tid >> 2, part = tid & 3, l = n * 64 + tok;
      float qo[32], ko[32]; float sq = 0.f, sk = 0.f;
#pragma unroll
      for (int cb = 0; cb < 4; ++cb) {
        const int colq = h * 128 + part * 32 + cb * 8, colk = 512 + colq;
        float aq[8], ak[8];
#pragma unroll
        for (int e = 0; e < 8; ++e) { aq[e] = 0.f; ak[e] = 0.f; }
#pragma unroll
        for (int j = 0; j < 4; ++j) {
          const int lt = l - 3 + j;
          if (lt >= 0) {
            const u16* rp = proj + ((size_t)b * SEQ + lt) * PJ;
            float xq[8], xk[8];
            unpack8(*(const u32x4*)(rp + colq), xq); unpack8(*(const u32x4*)(rp + colk), xk);
            const f32x4 wq0 = *(const f32x4*)(p.hy_conv_w + j * 1536 + colq), wq1 = *(const f32x4*)(p.hy_conv_w + j * 1536 + colq + 4);
            const f32x4 wk0 = *(const f32x4*)(p.hy_conv_w + j * 1536 + colk), wk1 = *(const f32x4*)(p.hy_conv_w + j * 1536 + colk + 4);
#pragma unroll
            for (int e = 0; e < 4; ++e) { aq[e] += wq0[e] * xq[e]; aq[4 + e] += wq1[e] * xq[4 + e]; ak[e] += wk0[e] * xk[e]; ak[4 + e] += wk1[e] * xk[4 + e]; }
          }
        }
#pragma unroll
        for (int e = 0; e < 8; ++e) { const float a = silu_(aq[e]), k = silu_(ak[e]); qo[cb * 8 + e] = a; ko[cb * 8 + e] = k; sq += a * a; sk += k * k; }
      }
      sq += __shfl_xor(sq, 1); sq += __shfl_xor(sq, 2); sk += __shfl_xor(sk, 1); sk += __shfl_xor(sk, 2);
      const float rq = rsqrtf(sq + 1e-6f) * 0.08838834764831845f, rk = rsqrtf(sk + 1e-6f);
#pragma unroll
      for (int cb = 0; cb < 4; ++cb) {
        u32x4 wq, wk;
#pragma unroll
        for (int e = 0; e < 4; ++e) { wq[e] = pk2(qo[cb * 8 + 2 * e] * rq, qo[cb * 8 + 2 * e + 1] * rq); wk[e] = pk2(ko[cb * 8 + 2 * e] * rk, ko[cb * 8 + 2 * e + 1] * rk); }
        *(u32x4*)(qs + tok * 136 + part * 32 + cb * 8) = wq; *(u32x4*)(ks + tok * 136 + part * 32 + cb * 8) = wk;
      }
    }
    __syncthreads();
    {
      f32x4 akk[4], aqk[4];
#pragma unroll
      for (int nb = 0; nb < 4; ++nb) { akk[nb] = f32x4{0.f, 0.f, 0.f, 0.f}; aqk[nb] = f32x4{0.f, 0.f, 0.f, 0.f}; }
#pragma unroll
      for (int kk = 0; kk < 4; ++kk) {
        const bf16x8 ak = *(const bf16x8*)(ks + (16 * wid + fr) * 136 + kk * 32 + fq * 8);
        const bf16x8 aq = *(const bf16x8*)(qs + (16 * wid + fr) * 136 + kk * 32 + fq * 8);
#pragma unroll
        for (int nb = 0; nb < 4; ++nb) {
          const bf16x8 bk = *(const bf16x8*)(ks + (16 * nb + fr) * 136 + kk * 32 + fq * 8);
          akk[nb] = __builtin_amdgcn_mfma_f32_16x16x32_bf16(ak, bk, akk[nb], 0, 0, 0);
          aqk[nb] = __builtin_amdgcn_mfma_f32_16x16x32_bf16(aq, bk, aqk[nb], 0, 0, 0);
        }
      }
      u16* att = (u16*)(p.ws + OFF_GAT) + (size_t)it * 4096;
#pragma unroll
      for (int nb = 0; nb < 4; ++nb)
#pragma unroll
        for (int r = 0; r < 4; ++r) {
          const int i = 16 * wid + fq * 4 + r, j = 16 * nb + fr;
          const float dec = __expf(fminf(gcs[i] - gcs[j], 0.f));
          Lm[i * 64 + j] = (i > j) ? bts[i] * akk[nb][r] * dec : 0.f;
          att[i * 64 + j] = f2bf((i >= j) ? aqk[nb][r] * dec : 0.f);
        }
    }
    __syncthreads();
    {
      float x[64];
      if (tid < 128) {
        const int col = 1024 + h * 128 + tid;
        const float w0 = p.hy_conv_w[col], w1 = p.hy_conv_w[1536 + col], w2 = p.hy_conv_w[2 * 1536 + col], w3 = p.hy_conv_w[3 * 1536 + col];
        float x1 = 0.f, x2 = 0.f, x3 = 0.f;
        if (n > 0) { x3 = bf2f(proj[(row0 - 3) * PJ + col]); x2 = bf2f(proj[(row0 - 2) * PJ + col]); x1 = bf2f(proj[(row0 - 1) * PJ + col]); }
#pragma unroll
        for (int i = 0; i < 64; ++i) {
          const float xv = bf2f(proj[(row0 + i) * PJ + col]);
          x[i] = silu_(w0 * x3 + w1 * x2 + w2 * x1 + w3 * xv) * bts[i];
          x3 = x2; x2 = x1; x1 = xv;
        }
      } else {
#pragma unroll
        for (int i = 0; i < 64; ++i) x[i] = bf2f(ks[i * 136 + tid - 128]) * bts[i] * egs[i];
      }
#pragma unroll
      for (int i = 1; i < 64; ++i) {
        float acc = x[i];
#pragma unroll
        for (int j4 = 0; j4 < (i + 3) / 4; ++j4) {
          const f32x4 l4 = *(const f32x4*)(Lm + i * 64 + j4 * 4);
#pragma unroll
          for (int e = 0; e < 4; ++e) if (j4 * 4 + e < i) acc -= l4[e] * x[j4 * 4 + e];
        }
        x[i] = acc;
      }
      if (tid < 128) {
        u16* ut = (u16*)(p.ws + OFF_GUT) + (size_t)it * 8192 + tid * 64;
#pragma unroll
        for (int c8 = 0; c8 < 8; ++c8) {
          u32x4 w;
#pragma unroll
          for (int e = 0; e < 4; ++e) w[e] = pk2(x[c8 * 8 + 2 * e], x[c8 * 8 + 2 * e + 1]);
          *(u32x4*)(ut + c8 * 8) = w;
        }
      } else {
        u16* wg = (u16*)(p.ws + OFF_GW) + (size_t)it * 8192 + (tid - 128);
#pragma unroll
        for (int i = 0; i < 64; ++i) wg[i * 128] = f2bf(x[i]);
      }
    }
    {
      u16* qd = (u16*)(p.ws + OFF_GQD) + (size_t)it * 8192;
#pragma unroll
      for (int k = 0; k < 4; ++k) {
        const int piece = tid + 256 * k, i = piece >> 4, d0 = (piece & 15) * 8;
        float f[8]; unpack8(*(const u32x4*)(qs + i * 136 + d0), f);
        const float e = egs[i];
        u32x4 w;
#pragma unroll
        for (int e2 = 0; e2 < 4; ++e2) w[e2] = pk2(f[2 * e2] * e, f[2 * e2 + 1] * e);
        *(u32x4*)(qd + i * 128 + d0) = w;
      }
      u16* kt = (u16*)(p.ws + OFF_GKT) + (size_t)it * 8192;
      const int dk = tid & 127, half = tid >> 7;
      const float gl = gcs[63];
#pragma unroll
      for (int c8 = 0; c8 < 4; ++c8) {
        u32x4 w;
#pragma unroll
        for (int e = 0; e < 4; ++e) {
          const int i0 = half * 32 + c8 * 8 + 2 * e;
          w[e] = pk2(bf2f(ks[i0 * 136 + dk]) * __expf(gl - gcs[i0]), bf2f(ks[(i0 + 1) * 136 + dk]) * __expf(gl - gcs[i0 + 1]));
        }
        *(u32x4*)(kt + dk * 64 + half * 32 + c8 * 8) = w;
      }
      if (tid == 0) ((float*)(p.ws + OFF_GSD))[it] = egs[63];
    }
    __syncthreads();
  }
}

__device__ __forceinline__ uint2 lds64(const char* p) { return *(const uint2*)p; }
__device__ __forceinline__ bf16x8 mk8(uint2 a, uint2 b) { u32x4 w = {a.x, a.y, b.x, b.y}; return __builtin_bit_cast(bf16x8, w); }
__device__ __forceinline__ bf16x8 pack8(const f32x16& x, int s) {
  u32x4 w = {pk2(x[8 * s], x[8 * s + 1]), pk2(x[8 * s + 2], x[8 * s + 3]), pk2(x[8 * s + 4], x[8 * s + 5]), pk2(x[8 * s + 6], x[8 * s + 7])};
  return __builtin_bit_cast(bf16x8, w);
}
__device__ __forceinline__ void gdn_scan_item(const Params& p, int bh, char* smem) {
  const int tid = otid(), wid = tid >> 6, lane = tid & 63, r32 = lane & 31, hi = lane >> 5;
  char* Wl = smem; char* QDl = smem + 16896; char* KTl = smem + 33792; char* ATl = smem + 51200;
  const int b = bh >> 2, h = bh & 3;
  const char* gw = p.ws + OFF_GW; const char* gqd = p.ws + OFF_GQD; const char* gkt = p.ws + OFF_GKT; const char* gat = p.ws + OFF_GAT;
  const u16* gut = (const u16*)(p.ws + OFF_GUT);
  const float* gsd = (const float*)(p.ws + OFF_GSD);
  float* og = (float*)(p.ws + OFF_HN);
  f32x16 S[4];
#pragma unroll
  for (int T = 0; T < 4; ++T)
#pragma unroll
    for (int r = 0; r < 16; ++r) S[T][r] = 0.f;
  u32x4 st[14]; uint2 uc[8];
  const int dv = wid * 32 + r32;
#define G_LOAD(IT) do { const size_t o16 = (size_t)(IT) * 16384, o8 = (size_t)(IT) * 8192; \
    _Pragma("unroll") for (int k = 0; k < 4; ++k) { st[k] = *(const u32x4*)(gw + o16 + (tid + 256 * k) * 16); st[4 + k] = *(const u32x4*)(gqd + o16 + (tid + 256 * k) * 16); \
      st[8 + k] = *(const u32x4*)(gkt + o16 + (tid + 256 * k) * 16); } \
    _Pragma("unroll") for (int k = 0; k < 2; ++k) st[12 + k] = *(const u32x4*)(gat + o8 + (tid + 256 * k) * 16); } while (0)
#define U_LOAD(IT) do { _Pragma("unroll") for (int k = 0; k < 8; ++k) uc[k] = *(const uint2*)(gut + (size_t)(IT) * 8192 + dv * 64 + 32 * (k >> 2) + 8 * (k & 3) + 4 * hi); } while (0)
#define G_WRITE() do { \
    _Pragma("unroll") for (int k = 0; k < 4; ++k) { const int pc = tid + 256 * k; \
      { char* d = Wl + (pc >> 4) * 264 + (pc & 15) * 16; *(uint2*)d = uint2{st[k][0], st[k][1]}; *(uint2*)(d + 8) = uint2{st[k][2], st[k][3]}; } \
      { char* d = QDl + (pc >> 4) * 264 + (pc & 15) * 16; *(uint2*)d = uint2{st[4 + k][0], st[4 + k][1]}; *(uint2*)(d + 8) = uint2{st[4 + k][2], st[4 + k][3]}; } \
      { char* d = KTl + (pc >> 3) * 136 + (pc & 7) * 16; *(uint2*)d = uint2{st[8 + k][0], st[8 + k][1]}; *(uint2*)(d + 8) = uint2{st[8 + k][2], st[8 + k][3]}; } } \
    _Pragma("unroll") for (int k = 0; k < 2; ++k) { const int pc = tid + 256 * k; \
      char* d = ATl + (pc >> 3) * 136 + (pc & 7) * 16; *(uint2*)d = uint2{st[12 + k][0], st[12 + k][1]}; *(uint2*)(d + 8) = uint2{st[12 + k][2], st[12 + k][3]}; } } while (0)
  G_LOAD(bh * 128); U_LOAD(bh * 128); G_WRITE(); __syncthreads();
#pragma unroll 1
  for (int n = 0; n < 128; ++n) {
    const int item = bh * 128 + n;
    if (n + 1 < 128) G_LOAD(item + 1);
    f32x16 av[2], ao[2];
#pragma unroll
    for (int r = 0; r < 16; ++r) { av[0][r] = 0.f; av[1][r] = 0.f; ao[0][r] = 0.f; ao[1][r] = 0.f; }
#pragma unroll
    for (int T = 0; T < 4; ++T)
#pragma unroll
      for (int s = 0; s < 2; ++s) {
        const bf16x8 sb = pack8(S[T], s);
        const int cb = (32 * T + 16 * s + 4 * hi) * 2;
#pragma unroll
        for (int it = 0; it < 2; ++it) {
          const char* wp = Wl + (32 * it + r32) * 264 + cb; const char* qp = QDl + (32 * it + r32) * 264 + cb;
          av[it] = __builtin_amdgcn_mfma_f32_32x32x16_bf16(mk8(lds64(wp), lds64(wp + 16)), sb, av[it], 0, 0, 0);
          ao[it] = __builtin_amdgcn_mfma_f32_32x32x16_bf16(mk8(lds64(qp), lds64(qp + 16)), sb, ao[it], 0, 0, 0);
        }
      }
    bf16x8 vb[2][2];
#pragma unroll
    for (int it = 0; it < 2; ++it) {
      f32x16 vn;
#pragma unroll
      for (int g = 0; g < 4; ++g) {
        const uint2 u2 = uc[it * 4 + g];
        vn[4 * g] = __uint_as_float(u2.x << 16) - av[it][4 * g]; vn[4 * g + 1] = __uint_as_float(u2.x & 0xffff0000u) - av[it][4 * g + 1];
        vn[4 * g + 2] = __uint_as_float(u2.y << 16) - av[it][4 * g + 2]; vn[4 * g + 3] = __uint_as_float(u2.y & 0xffff0000u) - av[it][4 * g + 3];
      }
      vb[it][0] = pack8(vn, 0); vb[it][1] = pack8(vn, 1);
    }
    if (n + 1 < 128) U_LOAD(item + 1);
#pragma unroll
    for (int it2 = 0; it2 < 2; ++it2)
#pragma unroll
      for (int it = 0; it <= it2; ++it)
#pragma unroll
        for (int s = 0; s < 2; ++s) {
          const char* ap = ATl + (32 * it2 + r32) * 136 + (32 * it + 16 * s + 4 * hi) * 2;
          ao[it2] = __builtin_amdgcn_mfma_f32_32x32x16_bf16(mk8(lds64(ap), lds64(ap + 16)), vb[it][s], ao[it2], 0, 0, 0);
        }
    {
      float* op = og + ((size_t)b * SEQ + n * 64) * 512 + h * 128 + dv;
#pragma unroll
      for (int it = 0; it < 2; ++it)
#pragma unroll
        for (int r = 0; r < 16; ++r) op[(size_t)(32 * it + crow(r, hi)) * 512] = ao[it][r];
    }
    const float sd = gsd[item];
#pragma unroll
    for (int T = 0; T < 4; ++T) {
#pragma unroll
      for (int r = 0; r < 16; ++r) S[T][r] *= sd;
#pragma unroll
      for (int it = 0; it < 2; ++it)
#pragma unroll
        for (int s = 0; s < 2; ++s) {
          const char* kp = KTl + (32 * T + r32) * 136 + (32 * it + 16 * s + 4 * hi) * 2;
          S[T] = __builtin_amdgcn_mfma_f32_32x32x16_bf16(mk8(lds64(kp), lds64(kp + 16)), vb[it][s], S[T], 0, 0, 0);
        }
    }
    __syncthreads();
    if (n + 1 < 128) G_WRITE();
    __syncthreads();
  }
#undef G_LOAD
#undef G_WRITE
#undef U_LOAD
}

__device__ __forceinline__ void gdn_normgate_phase(const Params& p, int bid, int nblk) {
  const int tid = otid(), wid = tid >> 6, lane = tid & 63;
  const float* og = (const float*)(p.ws + OFF_HN);
  u16* concat = (u16*)(p.ws + OFF_HN);
  const u16* proj = (const u16*)(p.ws + OFF_PROJ);
  const f32x4 hw0 = *(const f32x4*)(p.hy_head_norm_w + (lane & 15) * 8), hw1 = *(const f32x4*)(p.hy_head_norm_w + (lane & 15) * 8 + 4);
#pragma unroll 1
  for (int row = bid * 4 + wid; row < M; row += nblk * 4) {
    const f32x4 a0 = *(const f32x4*)(og + (size_t)row * 512 + lane * 8), a1 = *(const f32x4*)(og + (size_t)row * 512 + lane * 8 + 4);
    float zf[8]; unpack8(*(const u32x4*)(proj + (size_t)row * PJ + 1536 + lane * 8), zf);
    float ss = a0[0] * a0[0] + a0[1] * a0[1] + a0[2] * a0[2] + a0[3] * a0[3] + a1[0] * a1[0] + a1[1] * a1[1] + a1[2] * a1[2] + a1[3] * a1[3];
#pragma unroll
    for (int o = 8; o >= 1; o >>= 1) ss += __shfl_xor(ss, o);
    const float rs = rsqrtf(ss * (1.f / 128.f) + 1e-6f);
    u32x4 w;
    w[0] = pk2(a0[0] * rs * hw0[0] * silu_(zf[0]), a0[1] * rs * hw0[1] * silu_(zf[1]));
    w[1] = pk2(a0[2] * rs * hw0[2] * silu_(zf[2]), a0[3] * rs * hw0[3] * silu_(zf[3]));
    w[2] = pk2(a1[0] * rs * hw1[0] * silu_(zf[4]), a1[1] * rs * hw1[1] * silu_(zf[5]));
    w[3] = pk2(a1[2] * rs * hw1[2] * silu_(zf[6]), a1[3] * rs * hw1[3] * silu_(zf[7]));
    *(u32x4*)(concat + (size_t)row * 1024 + lane * 8) = w;
  }
}

using s16x4 = __attribute__((ext_vector_type(4))) short;
#define KSWZ(row, colB) ((row) * 256 + ((colB) ^ (((row) & 7) << 4)))
#define SBAR() __builtin_amdgcn_sched_barrier(0)
__device__ __forceinline__ unsigned cvtpk(float lo, float hi) { unsigned r; asm volatile("v_cvt_pk_bf16_f32 %0, %1, %2" : "=v"(r) : "v"(lo), "v"(hi)); return r; }
__device__ __forceinline__ int v_st(int k, int c) { const int kk = (k & ~0xC) | ((k & 4) << 1) | ((k & 8) >> 1); return ((kk >> 3) * 4 + (c >> 5)) * 512 + ((kk & 7) * 32 + (c & 31)) * 2; }
__device__ __forceinline__ int v_rd_base(int lane) { return ((lane & 3) << 3) | (((lane >> 2) & 3) << 6) | (((lane >> 4) & 1) << 5) | (((lane >> 5) & 1) << 8); }
constexpr int v_rd_off(int d0, int ks, int half) { return d0 * 512 + ks * 4096 + half * 2048; }
template <int OFF> __device__ __forceinline__ s16x4 tr_read(int vb) {
  s16x4 r; asm volatile("ds_read_b64_tr_b16 %0, %1 offset:%2" : "=&v"(r) : "v"(vb), "i"(OFF) : "memory"); return r;
}
template <int D0> __device__ __forceinline__ void pv_one(f32x16& od, int vb, bf16x8 pa0, bf16x8 pa1, bf16x8 pa2, bf16x8 pa3) {
  const s16x4 l0 = tr_read<v_rd_off(D0, 0, 0)>(vb), h0 = tr_read<v_rd_off(D0, 0, 1)>(vb), l1 = tr_read<v_rd_off(D0, 1, 0)>(vb), h1 = tr_read<v_rd_off(D0, 1, 1)>(vb);
  const s16x4 l2 = tr_read<v_rd_off(D0, 2, 0)>(vb), h2 = tr_read<v_rd_off(D0, 2, 1)>(vb), l3 = tr_read<v_rd_off(D0, 3, 0)>(vb), h3 = tr_read<v_rd_off(D0, 3, 1)>(vb);
  asm volatile("s_waitcnt lgkmcnt(0)" ::: "memory"); SBAR();
#define PK(L, H) (bf16x8){L[0], L[1], L[2], L[3], H[0], H[1], H[2], H[3]}
  od = __builtin_amdgcn_mfma_f32_32x32x16_bf16(pa0, PK(l0, h0), od, 0, 0, 0);
  od = __builtin_amdgcn_mfma_f32_32x32x16_bf16(pa1, PK(l1, h1), od, 0, 0, 0);
  od = __builtin_amdgcn_mfma_f32_32x32x16_bf16(pa2, PK(l2, h2), od, 0, 0, 0);
  od = __builtin_amdgcn_mfma_f32_32x32x16_bf16(pa3, PK(l3, h3), od, 0, 0, 0);
#undef PK
}
__device__ __forceinline__ float pl32_other(float a, float b, int hi) {
  auto rr = __builtin_amdgcn_permlane32_swap(__float_as_uint(a), __float_as_uint(b), false, false);
  return __uint_as_float(hi ? rr[0] : rr[1]);
}
__device__ __forceinline__ void sb_half(f32x16& pz, float& run, bool need_mask, int kb, int t, int hi) {
  constexpr float C2 = 0.08838834764831845f * 1.4426950408889634f;
  f32x16 l;
#pragma unroll
  for (int r = 0; r < 16; ++r) {
    const float e = __builtin_amdgcn_exp2f(fminf(pz[r] * C2, 60.f));
    l[r] = __builtin_amdgcn_rcpf(1.f + e);
    pz[r] = e;
  }
  if (need_mask) {
#pragma unroll
    for (int r = 0; r < 16; ++r) { if (kb + crow(r, hi) >= t) { l[r] = 1.f; pz[r] = 0.f; } }
  }
#pragma unroll
  for (int g = 0; g < 4; ++g) { l[4 * g + 2] *= l[4 * g + 3]; l[4 * g + 1] *= l[4 * g + 2]; l[4 * g] *= l[4 * g + 1]; }
  const float cs3 = l[12], cs2 = l[8] * cs3, cs1 = l[4] * cs2, cs0 = l[0] * cs1;
  const float off0 = cs1 * pl32_other(cs0, cs1, hi) * run;
  const float off1 = cs2 * pl32_other(cs1, cs2, hi) * run;
  const float off2 = cs3 * pl32_other(cs2, cs3, hi) * run;
  const float off3 = pl32_other(cs3, 1.f, hi) * run;
  float tot;
  { auto rr = __builtin_amdgcn_permlane32_swap(__float_as_uint(cs0), __float_as_uint(cs0), false, false); tot = __uint_as_float(rr[0]) * __uint_as_float(rr[1]); }
#pragma unroll
  for (int r = 0; r < 4; ++r) {
    pz[r] = pz[r] * l[r] * off0; pz[4 + r] = pz[4 + r] * l[4 + r] * off1;
    pz[8 + r] = pz[8 + r] * l[8 + r] * off2; pz[12 + r] = pz[12 + r] * l[12 + r] * off3;
  }
  run *= tot;
}

__device__ __forceinline__ void attn_phase(const Params& p, char* smem, int bid, int nblk) {
  const int tid = otid(), wid = tid >> 6, lane = tid & 63, r32 = lane & 31, hi = lane >> 5;
  char* K_lds = smem; char* V_lds = smem + 16384;
  const u16* qkv = (const u16*)(p.ws + OFF_PROJ);
  u16* ao = (u16*)(p.ws + OFF_HN);
  const int sr = tid >> 4, sc = (tid & 15) * 8;
  const int vb0 = (int)(uintptr_t)V_lds + v_rd_base(lane);
  for (int k = 0; k * nblk < 2048; ++k) {
    const int i = (k & 1) ? ((k + 1) * nblk - 1 - bid) : (k * nblk + bid);
    if (i >= 2048) continue;
    const int j = 63 - (i >> 5), bh = i & 31, b = bh >> 3, h = bh & 7;
    const int i0 = j * 128;
    const size_t rowb = (size_t)b * SEQ;
    const int t = i0 + wid * 32 + r32, tmin = i0 + wid * 32, tmax = tmin + 31;
    bf16x8 qr[8];
    {
      const u16* qp = qkv + (rowb + t) * 3072 + h * 128 + hi * 8;
#pragma unroll
      for (int d0 = 0; d0 < 8; ++d0) qr[d0] = *(const bf16x8*)(qp + d0 * 16);
    }
    f32x16 o[4];
#pragma unroll
    for (int d = 0; d < 4; ++d)
#pragma unroll
      for (int r = 0; r < 16; ++r) o[d][r] = 0.f;
    float run = 1.f;
    const u16* kbase = qkv + rowb * 3072 + 1024 + h * 128 + sc;
    u32x4 stk[4], stv[4];
#define SLOAD(KT) do { _Pragma("unroll") for (int ii = 0; ii < 4; ++ii) { const u16* kp = kbase + (size_t)((KT) * 64 + sr + 16 * ii) * 3072; \
      stk[ii] = *(const u32x4*)kp; stv[ii] = *(const u32x4*)(kp + 1024); } } while (0)
#define SWRITE() do { _Pragma("unroll") for (int ii = 0; ii < 4; ++ii) { const int row = sr + 16 * ii; \
      *(u32x4*)(K_lds + KSWZ(row, sc * 2)) = stk[ii]; *(u32x4*)(V_lds + v_st(row, sc)) = stv[ii]; } } while (0)
    const int NT = 2 * j + 2;
    SLOAD(NT - 1); SWRITE(); __syncthreads();
    for (int kt = NT - 1; kt >= 0; --kt) {
      const int k0 = kt * 64;
      if (k0 <= tmax) {
        bf16x8 pa0, pa1, pa2, pa3;
#define PK4(P, BASE, OUT) do { unsigned a0 = cvtpk(P[BASE + 0], P[BASE + 1]), a1 = cvtpk(P[BASE + 2], P[BASE + 3]); \
    unsigned b0_ = cvtpk(P[BASE + 4], P[BASE + 5]), b1_ = cvtpk(P[BASE + 6], P[BASE + 7]); \
    auto r0 = __builtin_amdgcn_permlane32_swap(a0, b0_, false, false); auto r1 = __builtin_amdgcn_permlane32_swap(a1, b1_, false, false); \
    u32x4 w = {r0[0], r1[0], r0[1], r1[1]}; OUT = *reinterpret_cast<bf16x8*>(&w); } while (0)
        if (k0 + 32 <= tmax) {
          f32x16 pz;
#pragma unroll
          for (int r = 0; r < 16; ++r) pz[r] = 0.f;
#pragma unroll
          for (int d0 = 0; d0 < 8; ++d0) {
            const bf16x8 kf = *(const bf16x8*)(K_lds + KSWZ(32 + r32, (d0 * 16 + hi * 8) * 2));
            pz = __builtin_amdgcn_mfma_f32_32x32x16_bf16(kf, qr[d0], pz, 0, 0, 0);
          }
          sb_half(pz, run, k0 + 63 >= tmin, k0 + 32, t, hi);
          PK4(pz, 0, pa2); PK4(pz, 8, pa3);
        } else {
          pa2 = bf16x8{0, 0, 0, 0, 0, 0, 0, 0}; pa3 = pa2;
        }
        {
          f32x16 pz;
#pragma unroll
          for (int r = 0; r < 16; ++r) pz[r] = 0.f;
#pragma unroll
          for (int d0 = 0; d0 < 8; ++d0) {
            const bf16x8 kf = *(const bf16x8*)(K_lds + KSWZ(r32, (d0 * 16 + hi * 8) * 2));
            pz = __builtin_amdgcn_mfma_f32_32x32x16_bf16(kf, qr[d0], pz, 0, 0, 0);
          }
          sb_half(pz, run, k0 + 31 >= tmin, k0, t, hi);
          PK4(pz, 0, pa0); PK4(pz, 8, pa1);
        }
#undef PK4
        if (kt > 0) SLOAD(kt - 1);
        pv_one<0>(o[0], vb0, pa0, pa1, pa2, pa3); pv_one<1>(o[1], vb0, pa0, pa1, pa2, pa3);
        pv_one<2>(o[2], vb0, pa0, pa1, pa2, pa3); pv_one<3>(o[3], vb0, pa0, pa1, pa2, pa3);
      } else {
        if (kt > 0) SLOAD(kt - 1);
      }
      __syncthreads();
      if (kt > 0) SWRITE();
      __syncthreads();
    }
#undef SLOAD
#undef SWRITE
    {
      u16* op = ao + (rowb + i0 + wid * 32) * 1024 + h * 128 + r32;
#pragma unroll
      for (int r = 0; r < 16; ++r) {
        const int orow = crow(r, hi);
#pragma unroll
        for (int d0 = 0; d0 < 4; ++d0) op[(size_t)orow * 1024 + d0 * 32] = f2bf(o[d0][r]);
      }
    }
  }
}

__global__ void __launch_bounds__(256, 2) mega(Params p) {
  __shared__ __attribute__((aligned(16))) char smem[SMEM_BYTES];
  const int bid = blockIdx.x, nblk = gridDim.x;
  char* ws = p.ws;
  const float* mod = (const float*)(ws + OFF_MOD);
  u16* hn = (u16*)(ws + OFF_HN);
#define PH_BEGIN(n) if (p.phase_lo <= (n) && (n) < p.phase_hi) {
#define PH_END(n) if ((n) + 1 < p.phase_hi) cg::this_grid().sync(); }
  PH_BEGIN(0) phase0(p, smem, bid, nblk); PH_END(0)
  PH_BEGIN(1) norm_phase<1>(p, p.x, p.norm_mix_w, mod, 0, 1024, smem, bid, nblk); PH_END(1)
  PH_BEGIN(2) { EpiArgs ea{}; ea.outb = (u16*)(ws + OFF_PROJ); ea.ux = (u16*)(ws + OFF_UX);
        gemm_phase<E_PROJ0>(hn, 1024, 0, (const u16*)(ws + OFF_WT_HYIN), 1024, 0, 1024, M / 256, PN / 128, 1, ea, smem, bid, nblk); } PH_END(2)
  PH_BEGIN(3) { EpiArgs ea{}; ea.outf = (float*)(ws + OFF_XE);
        gemm_phase<E_XE>((const u16*)(ws + OFF_UX), UXW, (size_t)S5C * UXW, (const u16*)(ws + OFF_EG), 512, (size_t)128 * 512, 512, S5C / 256, 1, 32, ea, smem, bid, nblk); } PH_END(3)
  PH_BEGIN(4) { s5_carry_phase(p, bid, nblk); gdn_prep_phase(p, smem, bid, nblk); } PH_END(4)
  PH_BEGIN(5) {
        if (bid < 16) { gdn_scan_item(p, bid, smem); }
        else { EpiArgs ea{}; ea.outb = (u16*)(ws + OFF_Y5); ea.ux = (u16*)(ws + OFF_UX); ea.bias = p.s5_d;
          gemm_phase<E_S5Y>((const u16*)(ws + OFF_UX), UXW, (size_t)S5C * UXW, (const u16*)(ws + OFF_MF), UXW, (size_t)512 * UXW, UXW, S5C / 256, 4, 32, ea, smem, bid - 16, nblk - 16); }
      } PH_END(5)
  PH_BEGIN(6) { gdn_normgate_phase(p, bid, nblk); } PH_END(6)
  PH_BEGIN(7) { EpiArgs ea{}; ea.outb = hn; ea.y5 = (const u16*)(ws + OFF_Y5); ea.bias = p.s5_glu_b;
        gemm_phase<E_GLU>((const u16*)(ws + OFF_Y5), 512, 0, (const u16*)(ws + OFF_WT_GLU), 512, 0, 512, M / 256, 4, 1, ea, smem, bid, nblk); } PH_END(7)
  PH_BEGIN(8) { EpiArgs ea{}; ea.outf = p.out; ea.res = p.x; ea.gate = mod + 2048;
        gemm_phase<E_RESID>(hn, 1024, 0, (const u16*)(ws + OFF_WT_HYOUT), 1024, 0, 1024, M / 256, 8, 1, ea, smem, bid, nblk); } PH_END(8)
  PH_BEGIN(9) norm_phase<0>(p, p.out, p.norm_ffn_w, mod, 3072, 4096, smem, bid, nblk); PH_END(9)
  PH_BEGIN(10) { EpiArgs ea{}; ea.outb = (u16*)(ws + OFF_PROJ);
        gemm_phase<E_SWIGLU>(hn, 1024, 0, (const u16*)(ws + OFF_WT_FFNIN), 1024, 0, 1024, M / 256, 2 * FF / 128, 1, ea, smem, bid, nblk); } PH_END(10)
  PH_BEGIN(11) { EpiArgs ea{}; ea.outf = p.out; ea.res = p.out; ea.gate = mod + 5120;
        gemm_phase<E_RESID>((const u16*)(ws + OFF_PROJ), FF, 0, (const u16*)(ws + OFF_WT_FFNOUT), FF, 0, FF, M / 256, 8, 1, ea, smem, bid, nblk); } PH_END(11)
  PH_BEGIN(12) norm_phase<0>(p, p.out, p.norm_mix_w + 1024, mod + 4 * 6144, 0, 1024, smem, bid, nblk); PH_END(12)
  PH_BEGIN(13) { EpiArgs ea{}; ea.outb = (u16*)(ws + OFF_PROJ); ea.ldc = 3072;
        gemm_phase<E_BF16>(hn, 1024, 0, (const u16*)(ws + OFF_WT_SBIN), 1024, 0, 1024, M / 256, 24, 1, ea, smem, bid, nblk); } PH_END(13)
  PH_BEGIN(14) attn_phase(p, smem, bid, nblk); PH_END(14)
  PH_BEGIN(15) { EpiArgs ea{}; ea.outf = p.out; ea.res = p.out; ea.gate = mod + 4 * 6144 + 2048;
        gemm_phase<E_RESID>(hn, 1024, 0, (const u16*)(ws + OFF_WT_SBOUT), 1024, 0, 1024, M / 256, 8, 1, ea, smem, bid, nblk); } PH_END(15)
  PH_BEGIN(16) norm_phase<0>(p, p.out, p.norm_ffn_w + 1024, mod + 4 * 6144, 3072, 4096, smem, bid, nblk); PH_END(16)
  PH_BEGIN(17) { EpiArgs ea{}; ea.outb = (u16*)(ws + OFF_PROJ);
        gemm_phase<E_SWIGLU>(hn, 1024, 0, (const u16*)(ws + OFF_WT_FFNIN + SZ_WT_FFNIN), 1024, 0, 1024, M / 256, 2 * FF / 128, 1, ea, smem, bid, nblk); } PH_END(17)
  PH_BEGIN(18) { EpiArgs ea{}; ea.outf = p.out; ea.res = p.out; ea.gate = mod + 4 * 6144 + 5120;
        gemm_phase<E_RESID>((const u16*)(ws + OFF_PROJ), FF, 0, (const u16*)(ws + OFF_WT_FFNOUT + SZ_WT_FFNOUT), FF, 0, FF, M / 256, 8, 1, ea, smem, bid, nblk); } PH_END(18)
  PH_BEGIN(19) norm_phase<2>(p, p.out, p.final_norm_w, mod, 0, 0, smem, bid, nblk); PH_END(19)
}

extern "C" void kernel_launch(void* const* d_in, const int* in_sizes, int n_in, void* d_out, int out_size, void* d_ws, size_t ws_size,
                              hipStream_t stream) {
  static int grid_blocks = 0;
  if (!grid_blocks) {
    int dev = 0, cus = 0, per_cu = 0;
    hipGetDevice(&dev);
    hipDeviceGetAttribute(&cus, hipDeviceAttributeMultiprocessorCount, dev);
    hipOccupancyMaxActiveBlocksPerMultiprocessor(&per_cu, mega, 256, 0);
    if (per_cu > 2) per_cu = 2;
    if (per_cu < 1) per_cu = 1;
    grid_blocks = cus * per_cu;
  }
  Params p{};
  const float* const* in = (const float* const*)d_in;
  p.x = in[0]; p.c = in[1]; p.ada_w = in[2]; p.ada_b = in[3]; p.norm_mix_w = in[4]; p.norm_ffn_w = in[5]; p.ffn_w_in = in[6]; p.ffn_w_out = in[7];
  p.hy_w_in = in[8]; p.hy_conv_w = in[9]; p.hy_a_log = in[10]; p.hy_dt_bias = in[11]; p.hy_head_norm_w = in[12];
  p.s5_lam_re = in[13]; p.s5_lam_im = in[14]; p.s5_log_dt = in[15]; p.s5_b_re = in[16]; p.s5_b_im = in[17]; p.s5_c_re = in[18]; p.s5_c_im = in[19];
  p.s5_d = in[20]; p.s5_glu_w = in[21]; p.s5_glu_b = in[22]; p.hy_w_out = in[23]; p.sb_w_in = in[24]; p.sb_w_out = in[25]; p.final_norm_w = in[26];
  p.out = (float*)d_out; p.ws = (char*)d_ws;
#if ONE_LAUNCH
  p.phase_lo = 0; p.phase_hi = NPHASE;
  void* args[] = {&p};
  hipError_t e = hipLaunchCooperativeKernel((void*)mega, dim3(grid_blocks), dim3(256), args, 0, stream);
  if (e != hipSuccess) fprintf(stderr, "cooperative launch failed: %s (grid %d)\n", hipGetErrorString(e), grid_blocks);
#else
  for (int ph = 0; ph < NPHASE; ++ph) {
    p.phase_lo = ph; p.phase_hi = ph + 1;
    hipLaunchKernelGGL(mega, dim3(grid_blocks), dim3(256), 0, stream, p);
  }
#endif
}
```

```cpp
#include <hip/hip_runtime.h>
#include <hip/hip_cooperative_groups.h>
#include <stdint.h>
#include <cstdio>
namespace cg = cooperative_groups;

#ifndef ONE_LAUNCH
#define ONE_LAUNCH 1
#endif

typedef unsigned short u16;
using bf16x8 = __attribute__((ext_vector_type(8))) short;
using f32x4 = __attribute__((ext_vector_type(4))) float;
using u32x4 = __attribute__((ext_vector_type(4))) unsigned;

constexpr int D = 1024, NB = 4, SEQ = 8192, M = NB * SEQ, FF = 2816, EIN = 2568, PN = 2560, PJ = 2048;
constexpr int NPHASE = 20;
constexpr int S5T = 32, S5C = M / S5T, UXW = 640;

constexpr size_t SZ_WT_HYIN = (size_t)PN * 1024 * 2, SZ_WT_SQ = (size_t)1024 * 1024 * 2, SZ_WT_GLU = (size_t)512 * 512 * 2;
constexpr size_t SZ_WT_FFNIN = (size_t)2 * FF * 1024 * 2, SZ_WT_FFNOUT = (size_t)1024 * FF * 2, SZ_WT_SBIN = (size_t)3072 * 1024 * 2;
constexpr size_t OFF_WT_HYIN = 0;
constexpr size_t OFF_WT_HYOUT = OFF_WT_HYIN + SZ_WT_HYIN;
constexpr size_t OFF_WT_GLU = OFF_WT_HYOUT + SZ_WT_SQ;
constexpr size_t OFF_WT_FFNIN = OFF_WT_GLU + SZ_WT_GLU;
constexpr size_t OFF_WT_FFNOUT = OFF_WT_FFNIN + 2 * SZ_WT_FFNIN;
constexpr size_t OFF_WT_SBIN = OFF_WT_FFNOUT + 2 * SZ_WT_FFNOUT;
constexpr size_t OFF_WT_SBOUT = OFF_WT_SBIN + SZ_WT_SBIN;
constexpr size_t OFF_MOD = OFF_WT_SBOUT + SZ_WT_SQ;
constexpr size_t OFF_BETA = OFF_MOD + (size_t)2 * 4 * 6144 * 4;
constexpr size_t OFF_G = OFF_BETA + (size_t)M * 4 * 4;
constexpr size_t OFF_HN = OFF_G + (size_t)M * 4 * 4;
constexpr size_t OFF_Y5 = OFF_HN + (size_t)M * 1024 * 2;
constexpr size_t OFF_UX = OFF_Y5 + (size_t)M * 512 * 2;
constexpr size_t OFF_MF = OFF_UX + (size_t)32 * S5C * UXW * 2;
constexpr size_t OFF_EG = OFF_MF + (size_t)32 * 512 * UXW * 2;
constexpr size_t OFF_XE = OFF_EG + (size_t)32 * 128 * 512 * 2;
constexpr size_t OFF_A32 = OFF_XE + (size_t)32 * S5C * 128 * 4;
constexpr size_t OFF_PROJ = OFF_A32 + (size_t)32 * 64 * 2 * 4;
constexpr size_t OFF_GW = OFF_PROJ + (size_t)M * PJ * 2;
constexpr size_t OFF_GQD = OFF_GW + (size_t)2048 * 8192 * 2;
constexpr size_t OFF_GKT = OFF_GQD + (size_t)2048 * 8192 * 2;
constexpr size_t OFF_GUT = OFF_GKT + (size_t)2048 * 8192 * 2;
constexpr size_t OFF_GAT = OFF_GUT + (size_t)2048 * 8192 * 2;
constexpr size_t OFF_GSD = OFF_GAT + (size_t)2048 * 4096 * 2;
constexpr size_t WS_TOTAL = OFF_GSD + (size_t)2048 * 4;
static_assert((size_t)M * 3072 * 2 <= WS_TOTAL - OFF_PROJ, "QKV alias");
static_assert(WS_TOTAL <= (size_t)512 * 1024 * 1024, "workspace too large");

struct Params {
  const float *x, *c, *ada_w, *ada_b, *norm_mix_w, *norm_ffn_w, *ffn_w_in, *ffn_w_out;
  const float *hy_w_in, *hy_conv_w, *hy_a_log, *hy_dt_bias, *hy_head_norm_w;
  const float *s5_lam_re, *s5_lam_im, *s5_log_dt, *s5_b_re, *s5_b_im, *s5_c_re, *s5_c_im, *s5_d, *s5_glu_w, *s5_glu_b, *hy_w_out;
  const float *sb_w_in, *sb_w_out, *final_norm_w;
  float* out;
  char* ws;
  int phase_lo, phase_hi;
};

constexpr int SMEM_BYTES = 73728;

__device__ __forceinline__ int otid() { int t = __builtin_amdgcn_workitem_id_x(); asm volatile("" : "+v"(t)); return t; }
__device__ __forceinline__ u16 f2bf(float x) { unsigned u = __float_as_uint(x); u += 0x7fffu + ((u >> 16) & 1u); return (u16)(u >> 16); }
typedef __bf16 bf16v2 __attribute__((ext_vector_type(2)));
typedef float f32v2 __attribute__((ext_vector_type(2)));
__device__ __forceinline__ unsigned pk2(float a, float b) { f32v2 v = {a, b}; bf16v2 r = __builtin_convertvector(v, bf16v2); return __builtin_bit_cast(unsigned, r); }
__device__ __forceinline__ float bf2f(u16 v) { return __uint_as_float(((unsigned)v) << 16); }
__device__ __forceinline__ float sigmoid_(float x) { return 1.f / (1.f + __expf(-x)); }
__device__ __forceinline__ float silu_(float x) { return x * sigmoid_(x); }
__device__ __forceinline__ float softplus_(float x) { return fmaxf(x, 0.f) + log1pf(__expf(-fabsf(x))); }
__device__ __forceinline__ float gelu_tanh_(float y) { return 0.5f * y * (1.f + tanhf(0.7978845608028654f * (y + 0.044715f * y * y * y))); }

struct TrJob { const float* src; u16* dst; int K, Nsrc, Nd, mode; };
__device__ __forceinline__ TrJob get_job(const Params& p, int j) {
  TrJob t;
  switch (j) {
    case 0: t = {p.hy_w_in, (u16*)(p.ws + OFF_WT_HYIN), 1024, EIN, PN, 1}; break;
    case 1: t = {p.hy_w_out, (u16*)(p.ws + OFF_WT_HYOUT), 1024, 1024, 1024, 0}; break;
    case 2: t = {p.s5_glu_w, (u16*)(p.ws + OFF_WT_GLU), 512, 512, 512, 0}; break;
    case 3: t = {p.ffn_w_in, (u16*)(p.ws + OFF_WT_FFNIN), 1024, 2 * FF, 2 * FF, 2}; break;
    case 4: t = {p.ffn_w_in + (size_t)1024 * 2 * FF, (u16*)(p.ws + OFF_WT_FFNIN + SZ_WT_FFNIN), 1024, 2 * FF, 2 * FF, 2}; break;
    case 5: t = {p.ffn_w_out, (u16*)(p.ws + OFF_WT_FFNOUT), FF, 1024, 1024, 0}; break;
    case 6: t = {p.ffn_w_out + (size_t)FF * 1024, (u16*)(p.ws + OFF_WT_FFNOUT + SZ_WT_FFNOUT), FF, 1024, 1024, 0}; break;
    case 7: t = {p.sb_w_in, (u16*)(p.ws + OFF_WT_SBIN), 1024, 3072, 3072, 0}; break;
    default: t = {p.sb_w_out, (u16*)(p.ws + OFF_WT_SBOUT), 1024, 1024, 1024, 0}; break;
  }
  return t;
}
__device__ __forceinline__ int src_col(int R, int mode) {
  if (mode == 0) return R;
  if (mode == 1) return R < 2048 ? R : R + 8;
  return ((R >> 4) & 1) * FF + (R >> 5) * 16 + (R & 15);
}
constexpr int N_TR_ITEMS = 640 + 256 + 64 + 2 * 1408 + 2 * 704 + 768 + 256;
constexpr int N_MOD_ITEMS = 2 * 6144 / 64;

__device__ __forceinline__ void s5_table_item(const Params& p, int item, char* smem) {
  const int tid = otid(), g = item >> 5, tau = item & 31;
  float* pwr = (float*)smem; float* pwi = pwr + 64; float* p1r = pwi + 64; float* p1i = p1r + 64;
  float* bbr = p1i + 64; float* bbi = bbr + 1024; float* cre = bbi + 1024; float* cim = cre + 1024;
  const float dt = expf(p.s5_log_dt[g]);
  if (tid < 64) {
    const float lr = p.s5_lam_re[g * 64 + tid], li = p.s5_lam_im[g * 64 + tid];
    float sn, cs;
    float mg = expf(lr * dt * (float)tau); sincosf(li * dt * (float)tau, &sn, &cs); pwr[tid] = mg * cs; pwi[tid] = mg * sn;
    mg = expf(lr * dt * (float)(tau + 1)); sincosf(li * dt * (float)(tau + 1), &sn, &cs); p1r[tid] = mg * cs; p1i[tid] = mg * sn;
    if (tau == 31) { float* a32 = (float*)(p.ws + OFF_A32); a32[(g * 64 + tid) * 2] = mg * cs; a32[(g * 64 + tid) * 2 + 1] = mg * sn; }
  }
  {
    const int pp = tid >> 2, hq = (tid & 3) * 4;
    const float lr = p.s5_lam_re[g * 64 + pp], li = p.s5_lam_im[g * 64 + pp];
    const float mg = expf(lr * dt); float sn, cs; sincosf(li * dt, &sn, &cs);
    const float ar = mg * cs, ai = mg * sn, den = lr * lr + li * li, nr = ar - 1.f, ni = ai;
    const float fre = (nr * lr + ni * li) / den, fim = (ni * lr - nr * li) / den;
#pragma unroll
    for (int e = 0; e < 4; ++e) {
      const float br = p.s5_b_re[(size_t)(g * 64 + pp) * 16 + hq + e], bi = p.s5_b_im[(size_t)(g * 64 + pp) * 16 + hq + e];
      bbr[pp * 16 + hq + e] = fre * br - fim * bi; bbi[pp * 16 + hq + e] = fre * bi + fim * br;
    }
    for (int i = tid; i < 1024; i += 256) { cre[i] = p.s5_c_re[(size_t)g * 1024 + i]; cim[i] = p.s5_c_im[(size_t)g * 1024 + i]; }
  }
  __syncthreads();
  u16* mf = (u16*)(p.ws + OFF_MF) + (size_t)g * 512 * UXW;
  u16* eg = (u16*)(p.ws + OFF_EG) + (size_t)g * 128 * 512;
  {
    const int h = tid >> 4, hp = tid & 15;
    float kv = 0.f;
    for (int pp = 0; pp < 64; ++pp) {
      const float cr = cre[h * 64 + pp], ci = cim[h * 64 + pp], pr = pwr[pp], pi = pwi[pp];
      kv += (cr * pr - ci * pi) * bbr[pp * 16 + hp] - (cr * pi + ci * pr) * bbi[pp * 16 + hp];
    }
    const u16 kb = f2bf(kv);
    for (int s0 = 0; s0 + tau < 32; ++s0) mf[(size_t)((s0 + tau) * 16 + h) * UXW + s0 * 16 + hp] = kb;
    for (int t0 = 0; t0 + tau + 1 < 32; ++t0) mf[(size_t)(t0 * 16 + h) * UXW + (t0 + tau + 1) * 16 + hp] = 0;
#pragma unroll
    for (int e = 0; e < 4; ++e) {
      const int pp = hp * 4 + e;
      const float cr = cre[h * 64 + pp], ci = cim[h * 64 + pp], pr = p1r[pp], pi = p1i[pp];
      mf[(size_t)(tau * 16 + h) * UXW + 512 + pp] = f2bf(cr * pr - ci * pi);
      mf[(size_t)(tau * 16 + h) * UXW + 576 + pp] = f2bf(-(cr * pi + ci * pr));
    }
  }
  {
    const int pp = tid >> 2, hq = (tid & 3) * 4, s0 = 31 - tau;
#pragma unroll
    for (int e = 0; e < 4; ++e) {
      const float br = bbr[pp * 16 + hq + e], bi = bbi[pp * 16 + hq + e], pr = pwr[pp], pi = pwi[pp];
      eg[(size_t)pp * 512 + s0 * 16 + hq + e] = f2bf(pr * br - pi * bi);
      eg[(size_t)(64 + pp) * 512 + s0 * 16 + hq + e] = f2bf(pr * bi + pi * br);
    }
  }
  __syncthreads();
}

__device__ __forceinline__ void phase0(const Params& p, char* smem, int bid, int nblk) {
  const int tid = otid();
  for (int it = bid; it < N_TR_ITEMS + N_MOD_ITEMS + 1024; it += nblk) {
    if (it >= N_TR_ITEMS + N_MOD_ITEMS) { s5_table_item(p, it - N_TR_ITEMS - N_MOD_ITEMS, smem); continue; }
    if (it < N_TR_ITEMS) {
      int rem = it, j = 0; TrJob jb;
      for (;; ++j) { jb = get_job(p, j); int n = (jb.Nd >> 6) * (jb.K >> 6); if (rem < n) break; rem -= n; }
      const int nk = jb.K >> 6, R0 = (rem / nk) * 64, k0 = (rem % nk) * 64;
      u16* s = (u16*)smem;
      {
        const int r = tid & 63, kk = tid >> 6;
        const float* sp = jb.src + (size_t)k0 * jb.Nsrc + src_col(R0 + r, jb.mode);
#pragma unroll
        for (int i = 0; i < 16; ++i) { int k = kk + 4 * i; s[r * 72 + k] = f2bf(sp[(size_t)k * jb.Nsrc]); }
      }
      __syncthreads();
      {
        const int r = tid >> 2, ch = tid & 3;
#pragma unroll
        for (int i = 0; i < 2; ++i) {
          int c8 = (ch + 4 * i) * 8;
          *(u32x4*)(jb.dst + (size_t)(R0 + r) * jb.K + k0 + c8) = *(const u32x4*)(s + r * 72 + c8);
        }
      }
      __syncthreads();
    } else {
      const int mi = it - N_TR_ITEMS, l = mi / 96, n0 = (mi % 96) * 64;
      float* cact = (float*)smem;
      float* red = cact + 4096;
      for (int i = tid; i < 4096; i += 256) cact[i] = silu_(p.c[i]);
      __syncthreads();
      const int wid = tid >> 6, lane = tid & 63;
      float a0 = 0, a1 = 0, a2 = 0, a3 = 0;
      const float* wp = p.ada_w + (size_t)l * 1024 * 6144 + n0 + lane;
#pragma unroll 8
      for (int k = wid * 256; k < wid * 256 + 256; ++k) {
        float w = wp[(size_t)k * 6144];
        a0 += cact[k] * w; a1 += cact[1024 + k] * w; a2 += cact[2048 + k] * w; a3 += cact[3072 + k] * w;
      }
      red[(wid * 4 + 0) * 64 + lane] = a0; red[(wid * 4 + 1) * 64 + lane] = a1;
      red[(wid * 4 + 2) * 64 + lane] = a2; red[(wid * 4 + 3) * 64 + lane] = a3;
      __syncthreads();
      {
        const int b = tid >> 6;
        float sum = red[(0 * 4 + b) * 64 + lane] + red[(1 * 4 + b) * 64 + lane] + red[(2 * 4 + b) * 64 + lane] + red[(3 * 4 + b) * 64 + lane];
        float* mod = (float*)(p.ws + OFF_MOD);
        mod[(size_t)(l * 4 + b) * 6144 + n0 + lane] = sum + p.ada_b[l * 6144 + n0 + lane];
      }
      __syncthreads();
    }
  }
}

template <int MODE>
__device__ __forceinline__ void norm_phase(const Params& p, const float* src, const float* w, const float* modl, int sh_off, int sc_off,
                           char* smem, int bid, int nblk) {
  const int tid = otid(), wid = tid >> 6, lane = tid & 63;
  float* wba = (float*)smem;
  if (MODE == 1) {
    for (int i = tid; i < 1024 * 8; i += 256) wba[i] = p.hy_w_in[(size_t)(i >> 3) * EIN + 2048 + (i & 7)];
    __syncthreads();
  }
  u16* hn = (u16*)(p.ws + OFF_HN);
  for (int row = bid * 4 + wid; row < M; row += nblk * 4) {
    const float* sp = src + (size_t)row * 1024;
    f32x4 v[4]; float ss = 0;
#pragma unroll
    for (int i = 0; i < 4; ++i) { v[i] = *(const f32x4*)(sp + i * 256 + lane * 4); ss += v[i][0] * v[i][0] + v[i][1] * v[i][1] + v[i][2] * v[i][2] + v[i][3] * v[i][3]; }
#pragma unroll
    for (int o = 32; o >= 1; o >>= 1) ss += __shfl_xor(ss, o);
    const float rstd = rsqrtf(ss * (1.f / 1024.f) + 1e-6f);
    const int b = row >> 13;
    float dots[8];
    if (MODE == 1) { for (int j = 0; j < 8; ++j) dots[j] = 0.f; }
#pragma unroll
    for (int i = 0; i < 4; ++i) {
      const int c0 = i * 256 + lane * 4;
      f32x4 ww = *(const f32x4*)(w + c0);
      f32x4 y;
      if (MODE == 2) {
#pragma unroll
        for (int e = 0; e < 4; ++e) y[e] = v[i][e] * rstd * ww[e];
        *(f32x4*)(p.out + (size_t)row * 1024 + c0) = y;
      } else {
        f32x4 sc = *(const f32x4*)(modl + (size_t)b * 6144 + sc_off + c0);
        f32x4 sh = *(const f32x4*)(modl + (size_t)b * 6144 + sh_off + c0);
#pragma unroll
        for (int e = 0; e < 4; ++e) y[e] = v[i][e] * rstd * ww[e] * (1.f + sc[e]) + sh[e];
        uint2 pk; pk.x = (unsigned)f2bf(y[0]) | ((unsigned)f2bf(y[1]) << 16); pk.y = (unsigned)f2bf(y[2]) | ((unsigned)f2bf(y[3]) << 16);
        *(uint2*)(hn + (size_t)row * 1024 + c0) = pk;
        if (MODE == 1) {
#pragma unroll
          for (int e = 0; e < 4; ++e) {
            f32x4 w0 = *(const f32x4*)(wba + (c0 + e) * 8), w1 = *(const f32x4*)(wba + (c0 + e) * 8 + 4);
#pragma unroll
            for (int j = 0; j < 4; ++j) { dots[j] += y[e] * w0[j]; dots[4 + j] += y[e] * w1[j]; }
          }
        }
      }
    }
    if (MODE == 1) {
#pragma unroll
      for (int j = 0; j < 8; ++j) {
#pragma unroll
        for (int o = 32; o >= 1; o >>= 1) dots[j] += __shfl_xor(dots[j], o);
      }
      if (lane == 0) {
        float* beta = (float*)(p.ws + OFF_BETA); float* gg = (float*)(p.ws + OFF_G);
#pragma unroll
        for (int h = 0; h < 4; ++h) {
          beta[(size_t)row * 4 + h] = sigmoid_(dots[h]);
          gg[(size_t)row * 4 + h] = -__expf(p.hy_a_log[h]) * softplus_(dots[4 + h] + p.hy_dt_bias[h]);
        }
      }
    }
  }
}

enum { E_PROJ0 = 0, E_BF16 = 1, E_RESID = 2, E_GLU = 3, E_SWIGLU = 4, E_XE = 5, E_S5Y = 6 };
struct EpiArgs { float* outf; u16* outb; const float* res; const float* gate; const u16* y5; const float* bias; u16* ux; int ldc; };

template <int EPI>
__device__ __forceinline__ void gemm_phase(const u16* __restrict__ A0, int lda, size_t sA, const u16* __restrict__ B0, int ldb, size_t sB,
                                           int K, int nM, int nN, int nbatch, const EpiArgs ea, char* smem, int bid, int nblk) {
  const int tid = otid(), wid = tid >> 6, lane = tid & 63, wr = wid >> 1, wc = wid & 1, fr = lane & 15, fq = lane >> 4;
  char* SA = smem; char* SB = smem + 49152;
  const int NR = nbatch * nM, ntiles = NR * nN;
  const int STN = (nN & 7) == 0 ? 8 : ((nN & 3) == 0 ? 4 : 1), STM = 64 / STN, nSN = nN / STN;
  const bool swz = ((nblk & 7) == 0) && (NR % STM == 0);
  const int lpx = nblk >> 3;
  int si = bid & 7, l = bid >> 3, tl = bid;
#pragma unroll 1
  for (;;) {
    int R, pn;
    if (swz) {
      if (si >= (NR / STM) * nSN) break;
      R = (si / nSN) * STM + l / STN; pn = (si % nSN) * STN + l % STN;
      l += lpx; if (l >= 64) { l = bid >> 3; si += 8; }
    } else {
      if (tl >= ntiles) break;
      R = tl / nN; pn = tl % nN; tl += nblk;
    }
    const int g = R / nM, brow = (R % nM) << 8, bcol = pn << 7;
    const u16* A = A0 + (size_t)g * sA; const u16* Bt = B0 + (size_t)g * sB;
    int nk = K >> 5, klim = nk;
    if (EPI == E_S5Y) { klim = 4 * ((bcol >> 7) + 1); nk = klim + 4; }
    f32x4 acc[8][4];
#pragma unroll
    for (int m = 0; m < 8; ++m)
#pragma unroll
      for (int n = 0; n < 4; ++n) acc[m][n] = f32x4{0.f, 0.f, 0.f, 0.f};
#define GSTAGE(KK, BUF) do { const int kt_ = (EPI == E_S5Y && (KK) >= klim) ? (16 + (KK) - klim) : (KK); \
      _Pragma("unroll") for (int i = 0; i < 4; ++i) { const int b_ = tid * 16 + i * 4096, r_ = b_ >> 6, c_ = (b_ & 63) >> 1; \
        __builtin_amdgcn_global_load_lds((const unsigned*)(A + (size_t)(brow + r_) * lda + kt_ * 32 + c_), (__attribute__((address_space(3))) unsigned*)(SA + (BUF) * 16384 + b_), 16, 0, 0); } \
      _Pragma("unroll") for (int i = 0; i < 2; ++i) { const int b_ = tid * 16 + i * 4096, r_ = b_ >> 6, c_ = (b_ & 63) >> 1; \
        __builtin_amdgcn_global_load_lds((const unsigned*)(Bt + (size_t)(bcol + r_) * ldb + kt_ * 32 + c_), (__attribute__((address_space(3))) unsigned*)(SB + (BUF) * 8192 + b_), 16, 0, 0); } } while (0)
    asm volatile("s_waitcnt vmcnt(0)" ::: "memory");
    GSTAGE(0, 0);
    if (nk > 1) { GSTAGE(1, 1); asm volatile("s_waitcnt vmcnt(6)\n\ts_barrier" ::: "memory"); }
    else { asm volatile("s_waitcnt vmcnt(0)\n\ts_barrier" ::: "memory"); }
    int buf = 0, nbuf = 2;
#pragma unroll 1
    for (int kk = 0; kk < nk; ++kk) {
      const bool more = kk + 2 < nk;
      if (more) GSTAGE(kk + 2, nbuf);
      bf16x8 Bl[4];
#pragma unroll
      for (int n = 0; n < 4; ++n) Bl[n] = *(const bf16x8*)(SB + buf * 8192 + (wc * 64 + n * 16 + fr) * 64 + fq * 16);
#pragma unroll
      for (int mh = 0; mh < 2; ++mh) {
        bf16x8 At[4];
#pragma unroll
        for (int m = 0; m < 4; ++m) At[m] = *(const bf16x8*)(SA + buf * 16384 + (wr * 128 + (mh * 4 + m) * 16 + fr) * 64 + fq * 16);
#pragma unroll
        for (int m = 0; m < 4; ++m)
#pragma unroll
          for (int n = 0; n < 4; ++n) acc[mh * 4 + m][n] = __builtin_amdgcn_mfma_f32_16x16x32_bf16(At[m], Bl[n], acc[mh * 4 + m][n], 0, 0, 0);
      }
      if (more) asm volatile("s_waitcnt vmcnt(6)\n\ts_barrier" ::: "memory");
      else asm volatile("s_waitcnt vmcnt(0)\n\ts_barrier" ::: "memory");
      buf = (buf == 2) ? 0 : buf + 1; nbuf = (nbuf == 2) ? 0 : nbuf + 1;
    }
#undef GSTAGE
#pragma unroll
    for (int m = 0; m < 8; ++m)
#pragma unroll
      for (int n = 0; n < 4; ++n)
#pragma unroll
        for (int j = 0; j < 4; ++j) {
          const int row = brow + wr * 128 + m * 16 + fq * 4 + j, col = bcol + wc * 64 + n * 16 + fr;
          const float v = acc[m][n][j];
          if (EPI == E_PROJ0) {
            if (bcol < 2048) ea.outb[(size_t)row * PJ + col] = f2bf(v);
            else { const int cc = col - 2048; ea.ux[((size_t)(cc >> 4) * S5C + (row >> 5)) * UXW + (row & 31) * 16 + (cc & 15)] = f2bf(v); }
          }
          if (EPI == E_BF16) ea.outb[(size_t)row * ea.ldc + col] = f2bf(v);
          if (EPI == E_RESID) { size_t idx = (size_t)row * 1024 + col; ea.outf[idx] = ea.res[idx] + ea.gate[(size_t)(row >> 13) * 6144 + col] * v; }
          if (EPI == E_GLU) { float y = bf2f(ea.y5[(size_t)row * 512 + col]); ea.outb[(size_t)row * 1024 + 512 + col] = f2bf(y * sigmoid_(v + ea.bias[col])); }
          if (EPI == E_SWIGLU) {
            if ((n & 1) == 0) {
              const float u = acc[m][n | 1][j];
              const int co = (bcol >> 1) + wc * 32 + (n >> 1) * 16 + fr;
              ea.outb[(size_t)row * FF + co] = f2bf(silu_(v) * u);
            }
          }
          if (EPI == E_XE) ea.outf[((size_t)g * S5C + row) * 128 + col] = v;
          if (EPI == E_S5Y) {
            const float u = bf2f(ea.ux[((size_t)g * S5C + row) * UXW + col]);
            const float y = gelu_tanh_(v + ea.bias[g * 16 + (col & 15)] * u);
            ea.outb[((size_t)row * 32 + (col >> 4)) * 512 + g * 16 + (col & 15)] = f2bf(y);
          }
        }
  }
}

__device__ __forceinline__ void s5_carry_phase(const Params& p, int bid, int nblk) {
  const float* xe = (const float*)(p.ws + OFF_XE); const float* a32 = (const float*)(p.ws + OFF_A32);
  u16* ux = (u16*)(p.ws + OFF_UX);
  for (int it = bid; it < 32; it += nblk) {
    const int idx = it * 256 + otid(), pp = idx & 63, g = (idx >> 6) & 31, b = idx >> 11;
    const float ar = a32[(g * 64 + pp) * 2], ai = a32[(g * 64 + pp) * 2 + 1];
    float xr = 0.f, xi = 0.f;
    const size_t cbase = (size_t)g * S5C + b * 256;
    for (int n = 0; n < 256; n += 8) {
      float er[8], ei[8];
#pragma unroll
      for (int e = 0; e < 8; ++e) { er[e] = xe[(cbase + n + e) * 128 + pp]; ei[e] = xe[(cbase + n + e) * 128 + 64 + pp]; }
#pragma unroll
      for (int e = 0; e < 8; ++e) {
        ux[(cbase + n + e) * UXW + 512 + pp] = f2bf(xr); ux[(cbase + n + e) * UXW + 576 + pp] = f2bf(xi);
        const float nr = ar * xr - ai * xi + er[e], ni = ar * xi + ai * xr + ei[e];
        xr = nr; xi = ni;
      }
    }
  }
}

__device__ __forceinline__ int crow(int r, int hi) { return (r & 3) + 8 * (r >> 2) + 4 * hi; }
using f32x16 = __attribute__((ext_vector_type(16))) float;
__device__ __forceinline__ void unpack8(const u32x4 w, float* f) {
#pragma unroll
  for (int e = 0; e < 4; ++e) { f[2 * e] = __uint_as_float(w[e] << 16); f[2 * e + 1] = __uint_as_float(w[e] & 0xffff0000u); }
}
__device__ __forceinline__ void gdn_prep_phase(const Params& p, char* smem, int bid, int nblk) {
  const int tid = otid(), wid = tid >> 6, lane = tid & 63, fr = lane & 15, fq = lane >> 4;
  u16* qs = (u16*)smem;
  u16* ks = qs + 64 * 136;
  float* Lm = (float*)(ks + 64 * 136);
  float* gcs = Lm + 4096; float* bts = gcs + 64; float* egs = bts + 64;
  const u16* proj = (const u16*)(p.ws + OFF_PROJ);
  const float* beta = (const float*)(p.ws + OFF_BETA); const float* gg = (const float*)(p.ws + OFF_G);
#pragma unroll 1
  for (int it = bid; it < 2048; it += nblk) {
    const int n = it & 127, bh = it >> 7, b = bh >> 2, h = bh & 3;
    const size_t row0 = (size_t)b * SEQ + n * 64;
    if (wid == 0) {
      float c = gg[(row0 + lane) * 4 + h];
#pragma unroll
      for (int o = 1; o < 64; o <<= 1) { const float tt = __shfl_up(c, o); if (lane >= o) c += tt; }
      gcs[lane] = c; egs[lane] = __expf(c); bts[lane] = beta[(row0 + lane) * 4 + h];
    }
    {
      const int tok = tid >> 2, part = tid & 3, l = n * 64 + tok;
      float qo[32], ko[32]; float sq = 0.f, sk = 0.f;
#pragma unroll
      for (int cb = 0; cb < 4; ++cb) {
        const int colq = h * 128 + part * 32 + cb * 8, colk = 512 + colq;
        float aq[8], ak[8];
#pragma unroll
        for (int e = 0; e < 8; ++e) { aq[e] = 0.f; ak[e] = 0.f; }
#pragma unroll
        for (int j = 0; j < 4; ++j) {
          const int lt = l - 3 + j;
          if (lt >= 0) {
            const u16* rp = proj + ((size_t)b * SEQ + lt) * PJ;
            float xq[8], xk[8];
            unpack8(*(const u32x4*)(rp + colq), xq); unpack8(*(const u32x4*)(rp + colk), xk);
            const f32x4 wq0 = *(const f32x4*)(p.hy_conv_w + j * 1536 + colq), wq1 = *(const f32x4*)(p.hy_conv_w + j * 1536 + colq + 4);
            const f32x4 wk0 = *(const f32x4*)(p.hy_conv_w + j * 1536 + colk), wk1 = *(const f32x4*)(p.hy_conv_w + j * 1536 + colk + 4);
#pragma unroll
            for (int e = 0; e < 4; ++e) { aq[e] += wq0[e] * xq[e]; aq[4 + e] += wq1[e] * xq[4 + e]; ak[e] += wk0[e] * xk[e]; ak[4 + e] += wk1[e] * xk[4 + e]; }
          }
        }
#pragma unroll
        for (int e = 0; e < 8; ++e) { const float a = silu_(aq[e]), k = silu_(ak[e]); qo[cb * 8 + e] = a; ko[cb * 8 + e] = k; sq += a * a; sk += k * k; }
      }
      sq += __shfl_xor(sq, 1); sq += __shfl_xor(sq, 2); sk += __shfl_xor(sk, 1); sk += __shfl_xor(sk, 2);
      const float rq = rsqrtf(sq + 1e-6f) * 0.08838834764831845f, rk = rsqrtf(sk + 1e-6f);
#pragma unroll
      for (int cb = 0; cb < 4; ++cb) {
        u32x4 wq, wk;
#pragma unroll
        for (int e = 0; e < 4; ++e) { wq[e] = pk2(qo[cb * 8 + 2 * e] * rq, qo[cb * 8 + 2 * e + 1] * rq); wk[e] = pk2(ko[cb * 8 + 2 * e] * rk, ko[cb * 8 + 2 * e + 1] * rk); }
        *(u32x4*)(qs + tok * 136 + part * 32 + cb * 8) = wq; *(u32x4*)(ks + tok * 136 + part * 32 + cb * 8) = wk;
      }
    }
    __syncthreads();
    {
      f32x4 akk[4], aqk[4];
#pragma unroll
      for (int nb = 0; nb < 4; ++nb) { akk[nb] = f32x4{0.f, 0.f, 0.f, 0.f}; aqk[nb] = f32x4{0.f, 0.f, 0.f, 0.f}; }
#pragma unroll
      for (int kk = 0; kk < 4; ++kk) {
        const bf16x8 ak = *(const bf16x8*)(ks + (16 * wid + fr) * 136 + kk * 32 + fq * 8);
        const bf16x8 aq = *(const bf16x8*)(qs + (16 * wid + fr) * 136 + kk * 32 + fq * 8);
#pragma unroll
        for (int nb = 0; nb < 4; ++nb) {
          const bf16x8 bk = *(const bf16x8*)(ks + (16 * nb + fr) * 136 + kk * 32 + fq * 8);
          akk[nb] = __builtin_amdgcn_mfma_f32_16x16x32_bf16(ak, bk, akk[nb], 0, 0, 0);
          aqk[nb] = __builtin_amdgcn_mfma_f32_16x16x32_bf16(aq, bk, aqk[nb], 0, 0, 0);
        }
      }
      u16* att = (u16*)(p.ws + OFF_GAT) + (size_t)it * 4096;
#pragma unroll
      for (int nb = 0; nb < 4; ++nb)
#pragma unroll
        for (int r = 0; r < 4; ++r) {
          const int i = 16 * wid + fq * 4 + r, j = 16 * nb + fr;
          const float dec = __expf(fminf(gcs[i] - gcs[j], 0.f));
          Lm[i * 64 + j] = (i > j) ? bts[i] * akk[nb][r] * dec : 0.f;
          att[i * 64 + j] = f2bf((i >= j) ? aqk[nb][r] * dec : 0.f);
        }
    }
    __syncthreads();
    {
      float x[64];
      if (tid < 128) {
        const int col = 1024 + h * 128 + tid;
        const float w0 = p.hy_conv_w[col], w1 = p.hy_conv_w[1536 + col], w2 = p.hy_conv_w[2 * 1536 + col], w3 = p.hy_conv_w[3 * 1536 + col];
        float x1 = 0.f, x2 = 0.f, x3 = 0.f;
        if (n > 0) { x3 = bf2f(proj[(row0 - 3) * PJ + col]); x2 = bf2f(proj[(row0 - 2) * PJ + col]); x1 = bf2f(proj[(row0 - 1) * PJ + col]); }
#pragma unroll
        for (int i = 0; i < 64; ++i) {
          const float xv = bf2f(proj[(row0 + i) * PJ + col]);
          x[i] = silu_(w0 * x3 + w1 * x2 + w2 * x1 + w3 * xv) * bts[i];
          x3 = x2; x2 = x1; x1 = xv;
        }
      } else {
#pragma unroll
        for (int i = 0; i < 64; ++i) x[i] = bf2f(ks[i * 136 + tid - 128]) * bts[i] * egs[i];
      }
#pragma unroll
      for (int i = 1; i < 64; ++i) {
        float acc = x[i];
#pragma unroll
        for (int j4 = 0; j4 < (i + 3) / 4; ++j4) {
          const f32x4 l4 = *(const f32x4*)(Lm + i * 64 + j4 * 4);
#pragma unroll
          for (int e = 0; e < 4; ++e) if (j4 * 4 + e < i) acc -= l4[e] * x[j4 * 4 + e];
        }
        x[i] = acc;
      }
      if (tid < 128) {
        u16* ut = (u16*)(p.ws + OFF_GUT) + (size_t)it * 8192 + tid * 64;
#pragma unroll
        for (int c8 = 0; c8 < 8; ++c8) {
          u32x4 w;
#pragma unroll
          for (int e = 0; e < 4; ++e) w[e] = pk2(x[c8 * 8 + 2 * e], x[c8 * 8 + 2 * e + 1]);
          *(u32x4*)(ut + c8 * 8) = w;
        }
      } else {
        u16* wg = (u16*)(p.ws + OFF_GW) + (size_t)it * 8192 + (tid - 128);
#pragma unroll
        for (int i = 0; i < 64; ++i) wg[i * 128] = f2bf(x[i]);
      }
    }
    {
      u16* qd = (u16*)(p.ws + OFF_GQD) + (size_t)it * 8192;
#pragma unroll
      for (int k = 0; k < 4; ++k) {
        const int piece = tid + 256 * k, i = piece >> 4, d0 = (piece & 15) * 8;
        float f[8]; unpack8(*(const u32x4*)(qs + i * 136 + d0), f);
        const float e = egs[i];
        u32x4 w;
#pragma unroll
        for (int e2 = 0; e2 < 4; ++e2) w[e2] = pk2(f[2 * e2] * e, f[2 * e2 + 1] * e);
        *(u32x4*)(qd + i * 128 + d0) = w;
      }
      u16* kt = (u16*)(p.ws + OFF_GKT) + (size_t)it * 8192;
      const int dk = tid & 127, half = tid >> 7;
      const float gl = gcs[63];
#pragma unroll
      for (int c8 = 0; c8 < 4; ++c8) {
        u32x4 w;
#pragma unroll
        for (int e = 0; e < 4; ++e) {
          const int i0 = half * 32 + c8 * 8 + 2 * e;
          w[e] = pk2(bf2f(ks[i0 * 136 + dk]) * __expf(gl - gcs[i0]), bf2f(ks[(i0 + 1) * 136 + dk]) * __expf(gl - gcs[i0 + 1]));
        }
        *(u32x4*)(kt + dk * 64 + half * 32 + c8 * 8) = w;
      }
      if (tid == 0) ((float*)(p.ws + OFF_GSD))[it] = egs[63];
    }
    __syncthreads();
  }
}

__device__ __forceinline__ uint2 lds64(const char* p) { return *(const uint2*)p; }
__device__ __forceinline__ bf16x8 mk8(uint2 a, uint2 b) { u32x4 w = {a.x, a.y, b.x, b.y}; return __builtin_bit_cast(bf16x8, w); }
__device__ __forceinline__ bf16x8 pack8(const f32x16& x, int s) {
  u32x4 w = {pk2(x[8 * s], x[8 * s + 1]), pk2(x[8 * s + 2], x[8 * s + 3]), pk2(x[8 * s + 4], x[8 * s + 5]), pk2(x[8 * s + 6], x[8 * s + 7])};
  return __builtin_bit_cast(bf16x8, w);
}
__device__ __forceinline__ void gdn_scan_item(const Params& p, int bh, char* smem) {
  const int tid = otid(), wid = tid >> 6, lane = tid & 63, r32 = lane & 31, hi = lane >> 5;
  char* Wl = smem; char* QDl = smem + 16896; char* KTl = smem + 33792; char* ATl = smem + 51200;
  const int b = bh >> 2, h = bh & 3;
  const char* gw = p.ws + OFF_GW; const char* gqd = p.ws + OFF_GQD; const char* gkt = p.ws + OFF_GKT; const char* gat = p.ws + OFF_GAT;
  const u16* gut = (const u16*)(p.ws + OFF_GUT);
  const float* gsd = (const float*)(p.ws + OFF_GSD);
  float* og = (float*)(p.ws + OFF_HN);
  f32x16 S[4];
#pragma unroll
  for (int T = 0; T < 4; ++T)
#pragma unroll
    for (int r = 0; r < 16; ++r) S[T][r] = 0.f;
  u32x4 st[14]; uint2 uc[8];
  const int dv = wid * 32 + r32;
#define G_LOAD(IT) do { const size_t o16 = (size_t)(IT) * 16384, o8 = (size_t)(IT) * 8192; \
    _Pragma("unroll") for (int k = 0; k < 4; ++k) { st[k] = *(const u32x4*)(gw + o16 + (tid + 256 * k) * 16); st[4 + k] = *(const u32x4*)(gqd + o16 + (tid + 256 * k) * 16); \
      st[8 + k] = *(const u32x4*)(gkt + o16 + (tid + 256 * k) * 16); } \
    _Pragma("unroll") for (int k = 0; k < 2; ++k) st[12 + k] = *(const u32x4*)(gat + o8 + (tid + 256 * k) * 16); } while (0)
#define U_LOAD(IT) do { _Pragma("unroll") for (int k = 0; k < 8; ++k) uc[k] = *(const uint2*)(gut + (size_t)(IT) * 8192 + dv * 64 + 32 * (k >> 2) + 8 * (k & 3) + 4 * hi); } while (0)
#define G_WRITE() do { \
    _Pragma("unroll") for (int k = 0; k < 4; ++k) { const int pc = tid + 256 * k; \
      { char* d = Wl + (pc >> 4) * 264 + (pc & 15) * 16; *(uint2*)d = uint2{st[k][0], st[k][1]}; *(uint2*)(d + 8) = uint2{st[k][2], st[k][3]}; } \
      { char* d = QDl + (pc >> 4) * 264 + (pc & 15) * 16; *(uint2*)d = uint2{st[4 + k][0], st[4 + k][1]}; *(uint2*)(d + 8) = uint2{st[4 + k][2], st[4 + k][3]}; } \
      { char* d = KTl + (pc >> 3) * 136 + (pc & 7) * 16; *(uint2*)d = uint2{st[8 + k][0], st[8 + k][1]}; *(uint2*)(d + 8) = uint2{st[8 + k][2], st[8 + k][3]}; } } \
    _Pragma("unroll") for (int k = 0; k < 2; ++k) { const int pc = tid + 256 * k; \
      char* d = ATl + (pc >> 3) * 136 + (pc & 7) * 16; *(uint2*)d = uint2{st[12 + k][0], st[12 + k][1]}; *(uint2*)(d + 8) = uint2{st[12 + k][2], st[12 + k][3]}; } } while (0)
  G_LOAD(bh * 128); U_LOAD(bh * 128); G_WRITE(); __syncthreads();
#pragma unroll 1
  for (int n = 0; n < 128; ++n) {
    const int item = bh * 128 + n;
    if (n + 1 < 128) G_LOAD(item + 1);
    f32x16 av[2], ao[2];
#pragma unroll
    for (int r = 0; r < 16; ++r) { av[0][r] = 0.f; av[1][r] = 0.f; ao[0][r] = 0.f; ao[1][r] = 0.f; }
#pragma unroll
    for (int T = 0; T < 4; ++T)
#pragma unroll
      for (int s = 0; s < 2; ++s) {
        const bf16x8 sb = pack8(S[T], s);
        const int cb = (32 * T + 16 * s + 4 * hi) * 2;
#pragma unroll
        for (int it = 0; it < 2; ++it) {
          const char* wp = Wl + (32 * it + r32) * 264 + cb; const char* qp = QDl + (32 * it + r32) * 264 + cb;
          av[it] = __builtin_amdgcn_mfma_f32_32x32x16_bf16(mk8(lds64(wp), lds64(wp + 16)), sb, av[it], 0, 0, 0);
          ao[it] = __builtin_amdgcn_mfma_f32_32x32x16_bf16(mk8(lds64(qp), lds64(qp + 16)), sb, ao[it], 0, 0, 0);
        }
      }
    bf16x8 vb[2][2];
#pragma unroll
    for (int it = 0; it < 2; ++it) {
      f32x16 vn;
#pragma unroll
      for (int g = 0; g < 4; ++g) {
        const uint2 u2 = uc[it * 4 + g];
        vn[4 * g] = __uint_as_float(u2.x << 16) - av[it][4 * g]; vn[4 * g + 1] = __uint_as_float(u2.x & 0xffff0000u) - av[it][4 * g + 1];
        vn[4 * g + 2] = __uint_as_float(u2.y << 16) - av[it][4 * g + 2]; vn[4 * g + 3] = __uint_as_float(u2.y & 0xffff0000u) - av[it][4 * g + 3];
      }
      vb[it][0] = pack8(vn, 0); vb[it][1] = pack8(vn, 1);
    }
    if (n + 1 < 128) U_LOAD(item + 1);
#pragma unroll
    for (int it2 = 0; it2 < 2; ++it2)
#pragma unroll
      for (int it = 0; it <= it2; ++it)
#pragma unroll
        for (int s = 0; s < 2; ++s) {
          const char* ap = ATl + (32 * it2 + r32) * 136 + (32 * it + 16 * s + 4 * hi) * 2;
          ao[it2] = __builtin_amdgcn_mfma_f32_32x32x16_bf16(mk8(lds64(ap), lds64(ap + 16)), vb[it][s], ao[it2], 0, 0, 0);
        }
    {
      float* op = og + ((size_t)b * SEQ + n * 64) * 512 + h * 128 + dv;
#pragma unroll
      for (int it = 0; it < 2; ++it)
#pragma unroll
        for (int r = 0; r < 16; ++r) op[(size_t)(32 * it + crow(r, hi)) * 512] = ao[it][r];
    }
    const float sd = gsd[item];
#pragma unroll
    for (int T = 0; T < 4; ++T) {
#pragma unroll
      for (int r = 0; r < 16; ++r) S[T][r] *= sd;
#pragma unroll
      for (int it = 0; it < 2; ++it)
#pragma unroll
        for (int s = 0; s < 2; ++s) {
          const char* kp = KTl + (32 * T + r32) * 136 + (32 * it + 16 * s + 4 * hi) * 2;
          S[T] = __builtin_amdgcn_mfma_f32_32x32x16_bf16(mk8(lds64(kp), lds64(kp + 16)), vb[it][s], S[T], 0, 0, 0);
        }
    }
    __syncthreads();
    if (n + 1 < 128) G_WRITE();
    __syncthreads();
  }
#undef G_LOAD
#undef G_WRITE
#undef U_LOAD
}

__device__ __forceinline__ void gdn_normgate_phase(const Params& p, int bid, int nblk) {
  const int tid = otid(), wid = tid >> 6, lane = tid & 63;
  const float* og = (const float*)(p.ws + OFF_HN);
  u16* concat = (u16*)(p.ws + OFF_HN);
  const u16* proj = (const u16*)(p.ws + OFF_PROJ);
  const f32x4 hw0 = *(const f32x4*)(p.hy_head_norm_w + (lane & 15) * 8), hw1 = *(const f32x4*)(p.hy_head_norm_w + (lane & 15) * 8 + 4);
#pragma unroll 1
  for (int row = bid * 4 + wid; row < M; row += nblk * 4) {
    const f32x4 a0 = *(const f32x4*)(og + (size_t)row * 512 + lane * 8), a1 = *(const f32x4*)(og + (size_t)row * 512 + lane * 8 + 4);
    float zf[8]; unpack8(*(const u32x4*)(proj + (size_t)row * PJ + 1536 + lane * 8), zf);
    float ss = a0[0] * a0[0] + a0[1] * a0[1] + a0[2] * a0[2] + a0[3] * a0[3] + a1[0] * a1[0] + a1[1] * a1[1] + a1[2] * a1[2] + a1[3] * a1[3];
#pragma unroll
    for (int o = 8; o >= 1; o >>= 1) ss += __shfl_xor(ss, o);
    const float rs = rsqrtf(ss * (1.f / 128.f) + 1e-6f);
    u32x4 w;
    w[0] = pk2(a0[0] * rs * hw0[0] * silu_(zf[0]), a0[1] * rs * hw0[1] * silu_(zf[1]));
    w[1] = pk2(a0[2] * rs * hw0[2] * silu_(zf[2]), a0[3] * rs * hw0[3] * silu_(zf[3]));
    w[2] = pk2(a1[0] * rs * hw1[0] * silu_(zf[4]), a1[1] * rs * hw1[1] * silu_(zf[5]));
    w[3] = pk2(a1[2] * rs * hw1[2] * silu_(zf[6]), a1[3] * rs * hw1[3] * silu_(zf[7]));
    *(u32x4*)(concat + (size_t)row * 1024 + lane * 8) = w;
  }
}

using s16x4 = __attribute__((ext_vector_type(4))) short;
#define KSWZ(row, colB) ((row) * 256 + ((colB) ^ (((row) & 7) << 4)))
#define SBAR() __builtin_amdgcn_sched_barrier(0)
__device__ __forceinline__ unsigned cvtpk(float lo, float hi) { unsigned r; asm volatile("v_cvt_pk_bf16_f32 %0, %1, %2" : "=v"(r) : "v"(lo), "v"(hi)); return r; }
__device__ __forceinline__ int v_st(int k, int c) { const int kk = (k & ~0xC) | ((k & 4) << 1) | ((k & 8) >> 1); return ((kk >> 3) * 4 + (c >> 5)) * 512 + ((kk & 7) * 32 + (c & 31)) * 2; }
__device__ __forceinline__ int v_rd_base(int lane) { return ((lane & 3) << 3) | (((lane >> 2) & 3) << 6) | (((lane >> 4) & 1) << 5) | (((lane >> 5) & 1) << 8); }
constexpr int v_rd_off(int d0, int ks, int half) { return d0 * 512 + ks * 4096 + half * 2048; }
template <int OFF> __device__ __forceinline__ s16x4 tr_read(int vb) {
  s16x4 r; asm volatile("ds_read_b64_tr_b16 %0, %1 offset:%2" : "=&v"(r) : "v"(vb), "i"(OFF) : "memory"); return r;
}
template <int D0> __device__ __forceinline__ void pv_one(f32x16& od, int vb, bf16x8 pa0, bf16x8 pa1, bf16x8 pa2, bf16x8 pa3) {
  const s16x4 l0 = tr_read<v_rd_off(D0, 0, 0)>(vb), h0 = tr_read<v_rd_off(D0, 0, 1)>(vb), l1 = tr_read<v_rd_off(D0, 1, 0)>(vb), h1 = tr_read<v_rd_off(D0, 1, 1)>(vb);
  const s16x4 l2 = tr_read<v_rd_off(D0, 2, 0)>(vb), h2 = tr_read<v_rd_off(D0, 2, 1)>(vb), l3 = tr_read<v_rd_off(D0, 3, 0)>(vb), h3 = tr_read<v_rd_off(D0, 3, 1)>(vb);
  asm volatile("s_waitcnt lgkmcnt(0)" ::: "memory"); SBAR();
#define PK(L, H) (bf16x8){L[0], L[1], L[2], L[3], H[0], H[1], H[2], H[3]}
  od = __builtin_amdgcn_mfma_f32_32x32x16_bf16(pa0, PK(l0, h0), od, 0, 0, 0);
  od = __builtin_amdgcn_mfma_f32_32x32x16_bf16(pa1, PK(l1, h1), od, 0, 0, 0);
  od = __builtin_amdgcn_mfma_f32_32x32x16_bf16(pa2, PK(l2, h2), od, 0, 0, 0);
  od = __builtin_amdgcn_mfma_f32_32x32x16_bf16(pa3, PK(l3, h3), od, 0, 0, 0);
#undef PK
}
__device__ __forceinline__ float pl32_other(float a, float b, int hi) {
  auto rr = __builtin_amdgcn_permlane32_swap(__float_as_uint(a), __float_as_uint(b), false, false);
  return __uint_as_float(hi ? rr[0] : rr[1]);
}
__device__ __forceinline__ void sb_half(f32x16& pz, float& run, bool need_mask, int kb, int t, int hi) {
  constexpr float C2 = 0.08838834764831845f * 1.4426950408889634f;
  f32x16 l;
#pragma unroll
  for (int r = 0; r < 16; ++r) {
    const float e = __builtin_amdgcn_exp2f(fminf(pz[r] * C2, 60.f));
    l[r] = __builtin_amdgcn_rcpf(1.f + e);
    pz[r] = e;
  }
  if (need_mask) {
#pragma unroll
    for (int r = 0; r < 16; ++r) { if (kb + crow(r, hi) >= t) { l[r] = 1.f; pz[r] = 0.f; } }
  }
#pragma unroll
  for (int g = 0; g < 4; ++g) { l[4 * g + 2] *= l[4 * g + 3]; l[4 * g + 1] *= l[4 * g + 2]; l[4 * g] *= l[4 * g + 1]; }
  const float cs3 = l[12], cs2 = l[8] * cs3, cs1 = l[4] * cs2, cs0 = l[0] * cs1;
  const float off0 = cs1 * pl32_other(cs0, cs1, hi) * run;
  const float off1 = cs2 * pl32_other(cs1, cs2, hi) * run;
  const float off2 = cs3 * pl32_other(cs2, cs3, hi) * run;
  const float off3 = pl32_other(cs3, 1.f, hi) * run;
  float tot;
  { auto rr = __builtin_amdgcn_permlane32_swap(__float_as_uint(cs0), __float_as_uint(cs0), false, false); tot = __uint_as_float(rr[0]) * __uint_as_float(rr[1]); }
#pragma unroll
  for (int r = 0; r < 4; ++r) {
    pz[r] = pz[r] * l[r] * off0; pz[4 + r] = pz[4 + r] * l[4 + r] * off1;
    pz[8 + r] = pz[8 + r] * l[8 + r] * off2; pz[12 + r] = pz[12 + r] * l[12 + r] * off3;
  }
  run *= tot;
}

__device__ __forceinline__ void attn_phase(const Params& p, char* smem, int bid, int nblk) {
  const int tid = otid(), wid = tid >> 6, lane = tid & 63, r32 = lane & 31, hi = lane >> 5;
  char* K_lds = smem; char* V_lds = smem + 16384;
  const u16* qkv = (const u16*)(p.ws + OFF_PROJ);
  u16* ao = (u16*)(p.ws + OFF_HN);
  const int sr = tid >> 4, sc = (tid & 15) * 8;
  const int vb0 = (int)(uintptr_t)V_lds + v_rd_base(lane);
  for (int k = 0; k * nblk < 2048; ++k) {
    const int i = (k & 1) ? ((k + 1) * nblk - 1 - bid) : (k * nblk + bid);
    if (i >= 2048) continue;
    const int j = 63 - (i >> 5), bh = i & 31, b = bh >> 3, h = bh & 7;
    const int i0 = j * 128;
    const size_t rowb = (size_t)b * SEQ;
    const int t = i0 + wid * 32 + r32, tmin = i0 + wid * 32, tmax = tmin + 31;
    bf16x8 qr[8];
    {
      const u16* qp = qkv + (rowb + t) * 3072 + h * 128 + hi * 8;
#pragma unroll
      for (int d0 = 0; d0 < 8; ++d0) qr[d0] = *(const bf16x8*)(qp + d0 * 16);
    }
    f32x16 o[4];
#pragma unroll
    for (int d = 0; d < 4; ++d)
#pragma unroll
      for (int r = 0; r < 16; ++r) o[d][r] = 0.f;
    float run = 1.f;
    const u16* kbase = qkv + rowb * 3072 + 1024 + h * 128 + sc;
    u32x4 stk[4], stv[4];
#define SLOAD(KT) do { _Pragma("unroll") for (int ii = 0; ii < 4; ++ii) { const u16* kp = kbase + (size_t)((KT) * 64 + sr + 16 * ii) * 3072; \
      stk[ii] = *(const u32x4*)kp; stv[ii] = *(const u32x4*)(kp + 1024); } } while (0)
#define SWRITE() do { _Pragma("unroll") for (int ii = 0; ii < 4; ++ii) { const int row = sr + 16 * ii; \
      *(u32x4*)(K_lds + KSWZ(row, sc * 2)) = stk[ii]; *(u32x4*)(V_lds + v_st(row, sc)) = stv[ii]; } } while (0)
    const int NT = 2 * j + 2;
    SLOAD(NT - 1); SWRITE(); __syncthreads();
    for (int kt = NT - 1; kt >= 0; --kt) {
      const int k0 = kt * 64;
      if (k0 <= tmax) {
        bf16x8 pa0, pa1, pa2, pa3;
#define PK4(P, BASE, OUT) do { unsigned a0 = cvtpk(P[BASE + 0], P[BASE + 1]), a1 = cvtpk(P[BASE + 2], P[BASE + 3]); \
    unsigned b0_ = cvtpk(P[BASE + 4], P[BASE + 5]), b1_ = cvtpk(P[BASE + 6], P[BASE + 7]); \
    auto r0 = __builtin_amdgcn_permlane32_swap(a0, b0_, false, false); auto r1 = __builtin_amdgcn_permlane32_swap(a1, b1_, false, false); \
    u32x4 w = {r0[0], r1[0], r0[1], r1[1]}; OUT = *reinterpret_cast<bf16x8*>(&w); } while (0)
        if (k0 + 32 <= tmax) {
          f32x16 pz;
#pragma unroll
          for (int r = 0; r < 16; ++r) pz[r] = 0.f;
#pragma unroll
          for (int d0 = 0; d0 < 8; ++d0) {
            const bf16x8 kf = *(const bf16x8*)(K_lds + KSWZ(32 + r32, (d0 * 16 + hi * 8) * 2));
            pz = __builtin_amdgcn_mfma_f32_32x32x16_bf16(kf, qr[d0], pz, 0, 0, 0);
          }
          sb_half(pz, run, k0 + 63 >= tmin, k0 + 32, t, hi);
          PK4(pz, 0, pa2); PK4(pz, 8, pa3);
        } else {
          pa2 = bf16x8{0, 0, 0, 0, 0, 0, 0, 0}; pa3 = pa2;
        }
        {
          f32x16 pz;
#pragma unroll
          for (int r = 0; r < 16; ++r) pz[r] = 0.f;
#pragma unroll
          for (int d0 = 0; d0 < 8; ++d0) {
            const bf16x8 kf = *(const bf16x8*)(K_lds + KSWZ(r32, (d0 * 16 + hi * 8) * 2));
            pz = __builtin_amdgcn_mfma_f32_32x32x16_bf16(kf, qr[d0], pz, 0, 0, 0);
          }
          sb_half(pz, run, k0 + 31 >= tmin, k0, t, hi);
          PK4(pz, 0, pa0); PK4(pz, 8, pa1);
        }
#undef PK4
        if (kt > 0) SLOAD(kt - 1);
        pv_one<0>(o[0], vb0, pa0, pa1, pa2, pa3); pv_one<1>(o[1], vb0, pa0, pa1, pa2, pa3);
        pv_one<2>(o[2], vb0, pa0, pa1, pa2, pa3); pv_one<3>(o[3], vb0, pa0, pa1, pa2, pa3);
      } else {
        if (kt > 0) SLOAD(kt - 1);
      }
      __syncthreads();
      if (kt > 0) SWRITE();
      __syncthreads();
    }
#undef SLOAD
#undef SWRITE
    {
      u16* op = ao + (rowb + i0 + wid * 32) * 1024 + h * 128 + r32;
#pragma unroll
      for (int r = 0; r < 16; ++r) {
        const int orow = crow(r, hi);
#pragma unroll
        for (int d0 = 0; d0 < 4; ++d0) op[(size_t)orow * 1024 + d0 * 32] = f2bf(o[d0][r]);
      }
    }
  }
}

__global__ void __launch_bounds__(256, 2) mega(Params p) {
  __shared__ __attribute__((aligned(16))) char smem[SMEM_BYTES];
  const int bid = blockIdx.x, nblk = gridDim.x;
  char* ws = p.ws;
  const float* mod = (const float*)(ws + OFF_MOD);
  u16* hn = (u16*)(ws + OFF_HN);
#define PH_BEGIN(n) if (p.phase_lo <= (n) && (n) < p.phase_hi) {
#define PH_END(n) if ((n) + 1 < p.phase_hi) cg::this_grid().sync(); }
  PH_BEGIN(0) phase0(p, smem, bid, nblk); PH_END(0)
  PH_BEGIN(1) norm_phase<1>(p, p.x, p.norm_mix_w, mod, 0, 1024, smem, bid, nblk); PH_END(1)
  PH_BEGIN(2) { EpiArgs ea{}; ea.outb = (u16*)(ws + OFF_PROJ); ea.ux = (u16*)(ws + OFF_UX);
        gemm_phase<E_PROJ0>(hn, 1024, 0, (const u16*)(ws + OFF_WT_HYIN), 1024, 0, 1024, M / 256, PN / 128, 1, ea, smem, bid, nblk); } PH_END(2)
  PH_BEGIN(3) { EpiArgs ea{}; ea.outf = (float*)(ws + OFF_XE);
        gemm_phase<E_XE>((const u16*)(ws + OFF_UX), UXW, (size_t)S5C * UXW, (const u16*)(ws + OFF_EG), 512, (size_t)128 * 512, 512, S5C / 256, 1, 32, ea, smem, bid, nblk); } PH_END(3)
  PH_BEGIN(4) { s5_carry_phase(p, bid, nblk); gdn_prep_phase(p, smem, bid, nblk); } PH_END(4)
  PH_BEGIN(5) {
        if (bid < 16) { gdn_scan_item(p, bid, smem); }
        else { EpiArgs ea{}; ea.outb = (u16*)(ws + OFF_Y5); ea.ux = (u16*)(ws + OFF_UX); ea.bias = p.s5_d;
          gemm_phase<E_S5Y>((const u16*)(ws + OFF_UX), UXW, (size_t)S5C * UXW, (const u16*)(ws + OFF_MF), UXW, (size_t)512 * UXW, UXW, S5C / 256, 4, 32, ea, smem, bid - 16, nblk - 16); }
      } PH_END(5)
  PH_BEGIN(6) { gdn_normgate_phase(p, bid, nblk); } PH_END(6)
  PH_BEGIN(7) { EpiArgs ea{}; ea.outb = hn; ea.y5 = (const u16*)(ws + OFF_Y5); ea.bias = p.s5_glu_b;
        gemm_phase<E_GLU>((const u16*)(ws + OFF_Y5), 512, 0, (const u16*)(ws + OFF_WT_GLU), 512, 0, 512, M / 256, 4, 1, ea, smem, bid, nblk); } PH_END(7)
  PH_BEGIN(8) { EpiArgs ea{}; ea.outf = p.out; ea.res = p.x; ea.gate = mod + 2048;
        gemm_phase<E_RESID>(hn, 1024, 0, (const u16*)(ws + OFF_WT_HYOUT), 1024, 0, 1024, M / 256, 8, 1, ea, smem, bid, nblk); } PH_END(8)
  PH_BEGIN(9) norm_phase<0>(p, p.out, p.norm_ffn_w, mod, 3072, 4096, smem, bid, nblk); PH_END(9)
  PH_BEGIN(10) { EpiArgs ea{}; ea.outb = (u16*)(ws + OFF_PROJ);
        gemm_phase<E_SWIGLU>(hn, 1024, 0, (const u16*)(ws + OFF_WT_FFNIN), 1024, 0, 1024, M / 256, 2 * FF / 128, 1, ea, smem, bid, nblk); } PH_END(10)
  PH_BEGIN(11) { EpiArgs ea{}; ea.outf = p.out; ea.res = p.out; ea.gate = mod + 5120;
        gemm_phase<E_RESID>((const u16*)(ws + OFF_PROJ), FF, 0, (const u16*)(ws + OFF_WT_FFNOUT), FF, 0, FF, M / 256, 8, 1, ea, smem, bid, nblk); } PH_END(11)
  PH_BEGIN(12) norm_phase<0>(p, p.out, p.norm_mix_w + 1024, mod + 4 * 6144, 0, 1024, smem, bid, nblk); PH_END(12)
  PH_BEGIN(13) { EpiArgs ea{}; ea.outb = (u16*)(ws + OFF_PROJ); ea.ldc = 3072;
        gemm_phase<E_BF16>(hn, 1024, 0, (const u16*)(ws + OFF_WT_SBIN), 1024, 0, 1024, M / 256, 24, 1, ea, smem, bid, nblk); } PH_END(13)
  PH_BEGIN(14) attn_phase(p, smem, bid, nblk); PH_END(14)
  PH_BEGIN(15) { EpiArgs ea{}; ea.outf = p.out; ea.res = p.out; ea.gate = mod + 4 * 6144 + 2048;
        gemm_phase<E_RESID>(hn, 1024, 0, (const u16*)(ws + OFF_WT_SBOUT), 1024, 0, 1024, M / 256, 8, 1, ea, smem, bid, nblk); } PH_END(15)
  PH_BEGIN(16) norm_phase<0>(p, p.out, p.norm_ffn_w + 1024, mod + 4 * 6144, 3072, 4096, smem, bid, nblk); PH_END(16)
  PH_BEGIN(17) { EpiArgs ea{}; ea.outb = (u16*)(ws + OFF_PROJ);
        gemm_phase<E_SWIGLU>(hn, 1024, 0, (const u16*)(ws + OFF_WT_FFNIN + SZ_WT_FFNIN), 1024, 0, 1024, M / 256, 2 * FF / 128, 1, ea, smem, bid, nblk); } PH_END(17)
  PH_BEGIN(18) { EpiArgs ea{}; ea.outf = p.out; ea.res = p.out; ea.gate = mod + 4 * 6144 + 5120;
        gemm_phase<E_RESID>((const u16*)(ws + OFF_PROJ), FF, 0, (const u16*)(ws + OFF_WT_FFNOUT + SZ_WT_FFNOUT), FF, 0, FF, M / 256, 8, 1, ea, smem, bid, nblk); } PH_END(18)
  PH_BEGIN(19) norm_phase<2>(p, p.out, p.final_norm_w, mod, 0, 0, smem, bid, nblk); PH_END(19)
}

extern "C" void kernel_launch(void* const* d_in, const int* in_sizes, int n_in, void* d_out, int out_size, void* d_ws, size_t ws_size,
                              hipStream_t stream) {
  static int grid_blocks = 0;
  if (!grid_blocks) {
    int dev = 0, cus = 0, per_cu = 0;
    hipGetDevice(&dev);
    hipDeviceGetAttribute(&cus, hipDeviceAttributeMultiprocessorCount, dev);
    hipOccupancyMaxActiveBlocksPerMultiprocessor(&per_cu, mega, 256, 0);
    if (per_cu > 2) per_cu = 2;
    if (per_cu < 1) per_cu = 1;
    grid_blocks = cus * per_cu;
  }
  Params p{};
  const float* const* in = (const float* const*)d_in;
  p.x = in[0]; p.c = in[1]; p.ada_w = in[2]; p.ada_b = in[3]; p.norm_mix_w = in[4]; p.norm_ffn_w = in[5]; p.ffn_w_in = in[6]; p.ffn_w_out = in[7];
  p.hy_w_in = in[8]; p.hy_conv_w = in[9]; p.hy_a_log = in[10]; p.hy_dt_bias = in[11]; p.hy_head_norm_w = in[12];
  p.s5_lam_re = in[13]; p.s5_lam_im = in[14]; p.s5_log_dt = in[15]; p.s5_b_re = in[16]; p.s5_b_im = in[17]; p.s5_c_re = in[18]; p.s5_c_im = in[19];
  p.s5_d = in[20]; p.s5_glu_w = in[21]; p.s5_glu_b = in[22]; p.hy_w_out = in[23]; p.sb_w_in = in[24]; p.sb_w_out = in[25]; p.final_norm_w = in[26];
  p.out = (float*)d_out; p.ws = (char*)d_ws;
#if ONE_LAUNCH
  p.phase_lo = 0; p.phase_hi = NPHASE;
  void* args[] = {&p};
  hipError_t e = hipLaunchCooperativeKernel((void*)mega, dim3(grid_blocks), dim3(256), args, 0, stream);
  if (e != hipSuccess) fprintf(stderr, "cooperative launch failed: %s (grid %d)\n", hipGetErrorString(e), grid_blocks);
#else
  for (int ph = 0; ph < NPHASE; ++ph) {
    p.phase_lo = ph; p.phase_hi = ph + 1;
    hipLaunchKernelGGL(mega, dim3(grid_blocks), dim3(256), 0, stream, p);
  }
#endif
}
```

```cpp
#include <hip/hip_runtime.h>
#include <hip/hip_cooperative_groups.h>
#include <stdint.h>
#include <cstdio>
namespace cg = cooperative_groups;

#ifndef ONE_LAUNCH
#define ONE_LAUNCH 1
#endif

typedef unsigned short u16;
using bf16x8 = __attribute__((ext_vector_type(8))) short;
using f32x4 = __attribute__((ext_vector_type(4))) float;
using u32x4 = __attribute__((ext_vector_type(4))) unsigned;

constexpr int D = 1024, NB = 4, SEQ = 8192, M = NB * SEQ, FF = 2816, EIN = 2568, PN = 2560, PJ = 2048;
constexpr int NPHASE = 20;
constexpr int S5T = 32, S5C = M / S5T, UXW = 640;

constexpr size_t SZ_WT_HYIN = (size_t)PN * 1024 * 2, SZ_WT_SQ = (size_t)1024 * 1024 * 2, SZ_WT_GLU = (size_t)512 * 512 * 2;
constexpr size_t SZ_WT_FFNIN = (size_t)2 * FF * 1024 * 2, SZ_WT_FFNOUT = (size_t)1024 * FF * 2, SZ_WT_SBIN = (size_t)3072 * 1024 * 2;
constexpr size_t OFF_WT_HYIN = 0;
constexpr size_t OFF_WT_HYOUT = OFF_WT_HYIN + SZ_WT_HYIN;
constexpr size_t OFF_WT_GLU = OFF_WT_HYOUT + SZ_WT_SQ;
constexpr size_t OFF_WT_FFNIN = OFF_WT_GLU + SZ_WT_GLU;
constexpr size_t OFF_WT_FFNOUT = OFF_WT_FFNIN + 2 * SZ_WT_FFNIN;
constexpr size_t OFF_WT_SBIN = OFF_WT_FFNOUT + 2 * SZ_WT_FFNOUT;
constexpr size_t OFF_WT_SBOUT = OFF_WT_SBIN + SZ_WT_SBIN;
constexpr size_t OFF_MOD = OFF_WT_SBOUT + SZ_WT_SQ;
constexpr size_t OFF_BETA = OFF_MOD + (size_t)2 * 4 * 6144 * 4;
constexpr size_t OFF_G = OFF_BETA + (size_t)M * 4 * 4;
constexpr size_t OFF_HN = OFF_G + (size_t)M * 4 * 4;
constexpr size_t OFF_Y5 = OFF_HN + (size_t)M * 1024 * 2;
constexpr size_t OFF_UX = OFF_Y5 + (size_t)M * 512 * 2;
constexpr size_t OFF_MF = OFF_UX + (size_t)32 * S5C * UXW * 2;
constexpr size_t OFF_EG = OFF_MF + (size_t)32 * 512 * UXW * 2;
constexpr size_t OFF_XE = OFF_EG + (size_t)32 * 128 * 512 * 2;
constexpr size_t OFF_A32 = OFF_XE + (size_t)32 * S5C * 128 * 4;
constexpr size_t OFF_PROJ = OFF_A32 + (size_t)32 * 64 * 2 * 4;
constexpr size_t OFF_GW = OFF_PROJ + (size_t)M * PJ * 2;
constexpr size_t OFF_GQD = OFF_GW + (size_t)2048 * 8192 * 2;
constexpr size_t OFF_GKT = OFF_GQD + (size_t)2048 * 8192 * 2;
constexpr size_t OFF_GUT = OFF_GKT + (size_t)2048 * 8192 * 2;
constexpr size_t OFF_GAT = OFF_GUT + (size_t)2048 * 8192 * 2;
constexpr size_t OFF_GSD = OFF_GAT + (size_t)2048 * 4096 * 2;
constexpr size_t WS_TOTAL = OFF_GSD + (size_t)2048 * 4;
static_assert((size_t)M * 3072 * 2 <= WS_TOTAL - OFF_PROJ, "QKV alias");
static_assert(WS_TOTAL <= (size_t)512 * 1024 * 1024, "workspace too large");

struct Params {
  const float *x, *c, *ada_w, *ada_b, *norm_mix_w, *norm_ffn_w, *ffn_w_in, *ffn_w_out;
  const float *hy_w_in, *hy_conv_w, *hy_a_log, *hy_dt_bias, *hy_head_norm_w;
  const float *s5_lam_re, *s5_lam_im, *s5_log_dt, *s5_b_re, *s5_b_im, *s5_c_re, *s5_c_im, *s5_d, *s5_glu_w, *s5_glu_b, *hy_w_out;
  const float *sb_w_in, *sb_w_out, *final_norm_w;
  float* out;
  char* ws;
  int phase_lo, phase_hi;
};

constexpr int SMEM_BYTES = 73728;

__device__ __forceinline__ int otid() { int t = __builtin_amdgcn_workitem_id_x(); asm volatile("" : "+v"(t)); return t; }
__device__ __forceinline__ u16 f2bf(float x) { unsigned u = __float_as_uint(x); u += 0x7fffu + ((u >> 16) & 1u); return (u16)(u >> 16); }
typedef __bf16 bf16v2 __attribute__((ext_vector_type(2)));
typedef float f32v2 __attribute__((ext_vector_type(2)));
__device__ __forceinline__ unsigned pk2(float a, float b) { f32v2 v = {a, b}; bf16v2 r = __builtin_convertvector(v, bf16v2); return __builtin_bit_cast(unsigned, r); }
__device__ __forceinline__ float bf2f(u16 v) { return __uint_as_float(((unsigned)v) << 16); }
__device__ __forceinline__ float sigmoid_(float x) { return 1.f / (1.f + __expf(-x)); }
__device__ __forceinline__ float silu_(float x) { return x * sigmoid_(x); }
__device__ __forceinline__ float softplus_(float x) { return fmaxf(x, 0.f) + log1pf(__expf(-fabsf(x))); }
__device__ __forceinline__ float gelu_tanh_(float y) { return 0.5f * y * (1.f + tanhf(0.7978845608028654f * (y + 0.044715f * y * y * y))); }

__device__ __forceinline__ size_t a_off(int row, int col, int nks) { return ((size_t)((row >> 8) * nks + (col >> 5)) << 13) + ((row & 255) << 5) + (col & 31); }
__device__ __forceinline__ size_t b_off(int n, int k, int nks) { return ((size_t)((n >> 7) * nks + (k >> 5)) << 12) + ((n & 127) << 5) + (k & 31); }

struct TrJob { const float* src; u16* dst; int K, Nsrc, Nd, mode; };
__device__ __forceinline__ TrJob get_job(const Params& p, int j) {
  TrJob t;
  switch (j) {
    case 0: t = {p.hy_w_in, (u16*)(p.ws + OFF_WT_HYIN), 1024, EIN, PN, 1}; break;
    case 1: t = {p.hy_w_out, (u16*)(p.ws + OFF_WT_HYOUT), 1024, 1024, 1024, 0}; break;
    case 2: t = {p.s5_glu_w, (u16*)(p.ws + OFF_WT_GLU), 512, 512, 512, 0}; break;
    case 3: t = {p.ffn_w_in, (u16*)(p.ws + OFF_WT_FFNIN), 1024, 2 * FF, 2 * FF, 2}; break;
    case 4: t = {p.ffn_w_in + (size_t)1024 * 2 * FF, (u16*)(p.ws + OFF_WT_FFNIN + SZ_WT_FFNIN), 1024, 2 * FF, 2 * FF, 2}; break;
    case 5: t = {p.ffn_w_out, (u16*)(p.ws + OFF_WT_FFNOUT), FF, 1024, 1024, 0}; break;
    case 6: t = {p.ffn_w_out + (size_t)FF * 1024, (u16*)(p.ws + OFF_WT_FFNOUT + SZ_WT_FFNOUT), FF, 1024, 1024, 0}; break;
    case 7: t = {p.sb_w_in, (u16*)(p.ws + OFF_WT_SBIN), 1024, 3072, 3072, 0}; break;
    default: t = {p.sb_w_out, (u16*)(p.ws + OFF_WT_SBOUT), 1024, 1024, 1024, 0}; break;
  }
  return t;
}
__device__ __forceinline__ int src_col(int R, int mode) {
  if (mode == 0) return R;
  if (mode == 1) return R < 2048 ? R : R + 8;
  return ((R >> 4) & 1) * FF + (R >> 5) * 16 + (R & 15);
}
constexpr int N_TR_ITEMS = 640 + 256 + 64 + 2 * 1408 + 2 * 704 + 768 + 256;
constexpr int N_MOD_ITEMS = 2 * 6144 / 64;

__device__ __forceinline__ void s5_table_item(const Params& p, int item, char* smem) {
  const int tid = otid(), g = item >> 5, tau = item & 31;
  float* pwr = (float*)smem; float* pwi = pwr + 64; float* p1r = pwi + 64; float* p1i = p1r + 64;
  float* bbr = p1i + 64; float* bbi = bbr + 1024; float* cre = bbi + 1024; float* cim = cre + 1024;
  const float dt = expf(p.s5_log_dt[g]);
  if (tid < 64) {
    const float lr = p.s5_lam_re[g * 64 + tid], li = p.s5_lam_im[g * 64 + tid];
    float sn, cs;
    float mg = expf(lr * dt * (float)tau); sincosf(li * dt * (float)tau, &sn, &cs); pwr[tid] = mg * cs; pwi[tid] = mg * sn;
    mg = expf(lr * dt * (float)(tau + 1)); sincosf(li * dt * (float)(tau + 1), &sn, &cs); p1r[tid] = mg * cs; p1i[tid] = mg * sn;
    if (tau == 31) { float* a32 = (float*)(p.ws + OFF_A32); a32[(g * 64 + tid) * 2] = mg * cs; a32[(g * 64 + tid) * 2 + 1] = mg * sn; }
  }
  {
    const int pp = tid >> 2, hq = (tid & 3) * 4;
    const float lr = p.s5_lam_re[g * 64 + pp], li = p.s5_lam_im[g * 64 + pp];
    const float mg = expf(lr * dt); float sn, cs; sincosf(li * dt, &sn, &cs);
    const float ar = mg * cs, ai = mg * sn, den = lr * lr + li * li, nr = ar - 1.f, ni = ai;
    const float fre = (nr * lr + ni * li) / den, fim = (ni * lr - nr * li) / den;
#pragma unroll
    for (int e = 0; e < 4; ++e) {
      const float br = p.s5_b_re[(size_t)(g * 64 + pp) * 16 + hq + e], bi = p.s5_b_im[(size_t)(g * 64 + pp) * 16 + hq + e];
      bbr[pp * 16 + hq + e] = fre * br - fim * bi; bbi[pp * 16 + hq + e] = fre * bi + fim * br;
    }
    for (int i = tid; i < 1024; i += 256) { cre[i] = p.s5_c_re[(size_t)g * 1024 + i]; cim[i] = p.s5_c_im[(size_t)g * 1024 + i]; }
  }
  __syncthreads();
  u16* mf = (u16*)(p.ws + OFF_MF) + (size_t)g * 512 * UXW;
  u16* eg = (u16*)(p.ws + OFF_EG) + (size_t)g * 128 * 512;
  {
    const int h = tid >> 4, hp = tid & 15;
    float kv = 0.f;
    for (int pp = 0; pp < 64; ++pp) {
      const float cr = cre[h * 64 + pp], ci = cim[h * 64 + pp], pr = pwr[pp], pi = pwi[pp];
      kv += (cr * pr - ci * pi) * bbr[pp * 16 + hp] - (cr * pi + ci * pr) * bbi[pp * 16 + hp];
    }
    const u16 kb = f2bf(kv);
    for (int s0 = 0; s0 + tau < 32; ++s0) mf[b_off((s0 + tau) * 16 + h, s0 * 16 + hp, 20)] = kb;
    for (int t0 = 0; t0 + tau + 1 < 32; ++t0) mf[b_off(t0 * 16 + h, (t0 + tau + 1) * 16 + hp, 20)] = 0;
#pragma unroll
    for (int e = 0; e < 4; ++e) {
      const int pp = hp * 4 + e;
      const float cr = cre[h * 64 + pp], ci = cim[h * 64 + pp], pr = p1r[pp], pi = p1i[pp];
      mf[b_off(tau * 16 + h, 512 + pp, 20)] = f2bf(cr * pr - ci * pi);
      mf[b_off(tau * 16 + h, 576 + pp, 20)] = f2bf(-(cr * pi + ci * pr));
    }
  }
  {
    const int pp = tid >> 2, hq = (tid & 3) * 4, s0 = 31 - tau;
#pragma unroll
    for (int e = 0; e < 4; ++e) {
      const float br = bbr[pp * 16 + hq + e], bi = bbi[pp * 16 + hq + e], pr = pwr[pp], pi = pwi[pp];
      eg[b_off(pp, s0 * 16 + hq + e, 16)] = f2bf(pr * br - pi * bi);
      eg[b_off(64 + pp, s0 * 16 + hq + e, 16)] = f2bf(pr * bi + pi * br);
    }
  }
  __syncthreads();
}

__device__ __forceinline__ void phase0(const Params& p, char* smem, int bid, int nblk) {
  const int tid = otid();
  for (int it = bid; it < N_TR_ITEMS + N_MOD_ITEMS + 1024; it += nblk) {
    if (it >= N_TR_ITEMS + N_MOD_ITEMS) { s5_table_item(p, it - N_TR_ITEMS - N_MOD_ITEMS, smem); continue; }
    if (it < N_TR_ITEMS) {
      int rem = it, j = 0; TrJob jb;
      for (;; ++j) { jb = get_job(p, j); int n = (jb.Nd >> 6) * (jb.K >> 6); if (rem < n) break; rem -= n; }
      const int nk = jb.K >> 6, R0 = (rem / nk) * 64, k0 = (rem % nk) * 64;
      u16* s = (u16*)smem;
      {
        const int r = tid & 63, kk = tid >> 6;
        const float* sp = jb.src + (size_t)k0 * jb.Nsrc + src_col(R0 + r, jb.mode);
#pragma unroll
        for (int i = 0; i < 16; ++i) { int k = kk + 4 * i; s[r * 72 + k] = f2bf(sp[(size_t)k * jb.Nsrc]); }
      }
      __syncthreads();
      {
        const int r = tid >> 2, ch = tid & 3;
#pragma unroll
        for (int i = 0; i < 2; ++i) {
          int c8 = (ch + 4 * i) * 8;
          *(u32x4*)(jb.dst + b_off(R0 + r, k0 + c8, jb.K >> 5)) = *(const u32x4*)(s + r * 72 + c8);
        }
      }
      __syncthreads();
    } else {
      const int mi = it - N_TR_ITEMS, l = mi / 96, n0 = (mi % 96) * 64;
      float* cact = (float*)smem;
      float* red = cact + 4096;
      for (int i = tid; i < 4096; i += 256) cact[i] = silu_(p.c[i]);
      __syncthreads();
      const int wid = tid >> 6, lane = tid & 63;
      float a0 = 0, a1 = 0, a2 = 0, a3 = 0;
      const float* wp = p.ada_w + (size_t)l * 1024 * 6144 + n0 + lane;
#pragma unroll 8
      for (int k = wid * 256; k < wid * 256 + 256; ++k) {
        float w = wp[(size_t)k * 6144];
        a0 += cact[k] * w; a1 += cact[1024 + k] * w; a2 += cact[2048 + k] * w; a3 += cact[3072 + k] * w;
      }
      red[(wid * 4 + 0) * 64 + lane] = a0; red[(wid * 4 + 1) * 64 + lane] = a1;
      red[(wid * 4 + 2) * 64 + lane] = a2; red[(wid * 4 + 3) * 64 + lane] = a3;
      __syncthreads();
      {
        const int b = tid >> 6;
        float sum = red[(0 * 4 + b) * 64 + lane] + red[(1 * 4 + b) * 64 + lane] + red[(2 * 4 + b) * 64 + lane] + red[(3 * 4 + b) * 64 + lane];
        float* mod = (float*)(p.ws + OFF_MOD);
        mod[(size_t)(l * 4 + b) * 6144 + n0 + lane] = sum + p.ada_b[l * 6144 + n0 + lane];
      }
      __syncthreads();
    }
  }
}

template <int MODE>
__device__ __forceinline__ void norm_phase(const Params& p, const float* src, const float* w, const float* modl, int sh_off, int sc_off,
                           char* smem, int bid, int nblk) {
  const int tid = otid(), wid = tid >> 6, lane = tid & 63;
  float* wba = (float*)smem;
  if (MODE == 1) {
    for (int i = tid; i < 1024 * 8; i += 256) wba[i] = p.hy_w_in[(size_t)(i >> 3) * EIN + 2048 + (i & 7)];
    __syncthreads();
  }
  u16* hn = (u16*)(p.ws + OFF_HN);
  for (int row = bid * 4 + wid; row < M; row += nblk * 4) {
    const float* sp = src + (size_t)row * 1024;
    f32x4 v[4]; float ss = 0;
#pragma unroll
    for (int i = 0; i < 4; ++i) { v[i] = *(const f32x4*)(sp + i * 256 + lane * 4); ss += v[i][0] * v[i][0] + v[i][1] * v[i][1] + v[i][2] * v[i][2] + v[i][3] * v[i][3]; }
#pragma unroll
    for (int o = 32; o >= 1; o >>= 1) ss += __shfl_xor(ss, o);
    const float rstd = rsqrtf(ss * (1.f / 1024.f) + 1e-6f);
    const int b = row >> 13;
    float dots[8];
    if (MODE == 1) { for (int j = 0; j < 8; ++j) dots[j] = 0.f; }
#pragma unroll
    for (int i = 0; i < 4; ++i) {
      const int c0 = i * 256 + lane * 4;
      f32x4 ww = *(const f32x4*)(w + c0);
      f32x4 y;
      if (MODE == 2) {
#pragma unroll
        for (int e = 0; e < 4; ++e) y[e] = v[i][e] * rstd * ww[e];
        *(f32x4*)(p.out + (size_t)row * 1024 + c0) = y;
      } else {
        f32x4 sc = *(const f32x4*)(modl + (size_t)b * 6144 + sc_off + c0);
        f32x4 sh = *(const f32x4*)(modl + (size_t)b * 6144 + sh_off + c0);
#pragma unroll
        for (int e = 0; e < 4; ++e) y[e] = v[i][e] * rstd * ww[e] * (1.f + sc[e]) + sh[e];
        uint2 pk; pk.x = (unsigned)f2bf(y[0]) | ((unsigned)f2bf(y[1]) << 16); pk.y = (unsigned)f2bf(y[2]) | ((unsigned)f2bf(y[3]) << 16);
        *(uint2*)(hn + a_off(row, c0, 32)) = pk;
        if (MODE == 1) {
#pragma unroll
          for (int e = 0; e < 4; ++e) {
            f32x4 w0 = *(const f32x4*)(wba + (c0 + e) * 8), w1 = *(const f32x4*)(wba + (c0 + e) * 8 + 4);
#pragma unroll
            for (int j = 0; j < 4; ++j) { dots[j] += y[e] * w0[j]; dots[4 + j] += y[e] * w1[j]; }
          }
        }
      }
    }
    if (MODE == 1) {
#pragma unroll
      for (int j = 0; j < 8; ++j) {
#pragma unroll
        for (int o = 32; o >= 1; o >>= 1) dots[j] += __shfl_xor(dots[j], o);
      }
      if (lane == 0) {
        float* beta = (float*)(p.ws + OFF_BETA); float* gg = (float*)(p.ws + OFF_G);
#pragma unroll
        for (int h = 0; h < 4; ++h) {
          beta[(size_t)row * 4 + h] = sigmoid_(dots[h]);
          gg[(size_t)row * 4 + h] = -__expf(p.hy_a_log[h]) * softplus_(dots[4 + h] + p.hy_dt_bias[h]);
        }
      }
    }
  }
}

enum { E_PROJ0 = 0, E_BF16 = 1, E_RESID = 2, E_GLU = 3, E_SWIGLU = 4, E_XE = 5, E_S5Y = 6 };
struct EpiArgs { float* outf; u16* outb; const float* res; const float* gate; const u16* y5; const float* bias; u16* ux; int ldc; };

template <int EPI>
__device__ __forceinline__ void gemm_phase(const u16* __restrict__ A0, int nksA, size_t sA, const u16* __restrict__ B0, int nksB, size_t sB,
                                           int K, int nM, int nN, int nbatch, const EpiArgs ea, char* smem, int bid, int nblk) {
  const int tid = otid(), wid = tid >> 6, lane = tid & 63, wr = wid >> 1, wc = wid & 1, fr = lane & 15, fq = lane >> 4;
  char* SA = smem; char* SB = smem + 49152;
  const int NR = nbatch * nM, ntiles = NR * nN;
  const int STN = (nN & 7) == 0 ? 8 : ((nN & 3) == 0 ? 4 : 1), STM = 64 / STN, nSN = nN / STN;
  const bool swz = ((nblk & 7) == 0) && (NR % STM == 0);
  const int lpx = nblk >> 3;
  int si = bid & 7, l = bid >> 3, tl = bid;
#pragma unroll 1
  for (;;) {
    int R, pn;
    if (swz) {
      if (si >= (NR / STM) * nSN) break;
      R = (si / nSN) * STM + l / STN; pn = (si % nSN) * STN + l % STN;
      l += lpx; if (l >= 64) { l = bid >> 3; si += 8; }
    } else {
      if (tl >= ntiles) break;
      R = tl / nN; pn = tl % nN; tl += nblk;
    }
    const int g = R / nM, rt = R % nM, brow = rt << 8, bcol = pn << 7;
    const char* A = (const char*)(A0 + (size_t)g * sA) + ((size_t)rt * nksA << 14) + tid * 16;
    const char* Bt = (const char*)(B0 + (size_t)g * sB) + ((size_t)pn * nksB << 13) + tid * 16;
    int nk = K >> 5, klim = nk;
    if (EPI == E_S5Y) { klim = 4 * (pn + 1); nk = klim + 4; }
    f32x4 acc[8][4];
#pragma unroll
    for (int m = 0; m < 8; ++m)
#pragma unroll
      for (int n = 0; n < 4; ++n) acc[m][n] = f32x4{0.f, 0.f, 0.f, 0.f};
#define GSTAGE(KK, BUF) do { const int kt_ = (EPI == E_S5Y && (KK) >= klim) ? (16 + (KK) - klim) : (KK); \
      _Pragma("unroll") for (int i = 0; i < 4; ++i) \
        __builtin_amdgcn_global_load_lds((const unsigned*)(A + ((size_t)kt_ << 14) + i * 4096), (__attribute__((address_space(3))) unsigned*)(SA + (BUF) * 16384 + tid * 16 + i * 4096), 16, 0, 0); \
      _Pragma("unroll") for (int i = 0; i < 2; ++i) \
        __builtin_amdgcn_global_load_lds((const unsigned*)(Bt + ((size_t)kt_ << 13) + i * 4096), (__attribute__((address_space(3))) unsigned*)(SB + (BUF) * 8192 + tid * 16 + i * 4096), 16, 0, 0); } while (0)
    asm volatile("s_waitcnt vmcnt(0)" ::: "memory");
    GSTAGE(0, 0);
    if (nk > 1) { GSTAGE(1, 1); asm volatile("s_waitcnt vmcnt(6)\n\ts_barrier" ::: "memory"); }
    else { asm volatile("s_waitcnt vmcnt(0)\n\ts_barrier" ::: "memory"); }
    int buf = 0, nbuf = 2;
#pragma unroll 1
    for (int kk = 0; kk < nk; ++kk) {
      const bool more = kk + 2 < nk;
      if (more) GSTAGE(kk + 2, nbuf);
      bf16x8 Bl[4];
#pragma unroll
      for (int n = 0; n < 4; ++n) Bl[n] = *(const bf16x8*)(SB + buf * 8192 + (wc * 64 + n * 16 + fr) * 64 + fq * 16);
#pragma unroll
      for (int mh = 0; mh < 2; ++mh) {
        bf16x8 At[4];
#pragma unroll
        for (int m = 0; m < 4; ++m) At[m] = *(const bf16x8*)(SA + buf * 16384 + (wr * 128 + (mh * 4 + m) * 16 + fr) * 64 + fq * 16);
#pragma unroll
        for (int m = 0; m < 4; ++m)
#pragma unroll
          for (int n = 0; n < 4; ++n) acc[mh * 4 + m][n] = __builtin_amdgcn_mfma_f32_16x16x32_bf16(Bl[n], At[m], acc[mh * 4 + m][n], 0, 0, 0);
      }
      if (more) asm volatile("s_waitcnt vmcnt(6)\n\ts_barrier" ::: "memory");
      else asm volatile("s_waitcnt vmcnt(0)\n\ts_barrier" ::: "memory");
      buf = (buf == 2) ? 0 : buf + 1; nbuf = (nbuf == 2) ? 0 : nbuf + 1;
    }
#undef GSTAGE
#pragma unroll
    for (int m = 0; m < 8; ++m)
#pragma unroll
      for (int n = 0; n < 4; ++n) {
        const int row = brow + wr * 128 + m * 16 + fr, col = bcol + wc * 64 + n * 16 + fq * 4;
        const f32x4 v = acc[m][n];
        if (EPI == E_PROJ0) {
          const uint2 pk = uint2{pk2(v[0], v[1]), pk2(v[2], v[3])};
          if (bcol < 2048) *(uint2*)(ea.outb + (size_t)row * PJ + col) = pk;
          else { const int cc = col - 2048; *(uint2*)(ea.ux + (size_t)(cc >> 4) * S5C * UXW + a_off(row >> 5, (row & 31) * 16 + (cc & 15), 20)) = pk; }
        }
        if (EPI == E_BF16) *(uint2*)(ea.outb + (size_t)row * ea.ldc + col) = uint2{pk2(v[0], v[1]), pk2(v[2], v[3])};
        if (EPI == E_RESID) {
          const size_t idx = (size_t)row * 1024 + col;
          const f32x4 r4 = *(const f32x4*)(ea.res + idx), g4 = *(const f32x4*)(ea.gate + (size_t)(row >> 13) * 6144 + col);
          *(f32x4*)(ea.outf + idx) = f32x4{r4[0] + g4[0] * v[0], r4[1] + g4[1] * v[1], r4[2] + g4[2] * v[2], r4[3] + g4[3] * v[3]};
        }
        if (EPI == E_GLU) {
          const uint2 yy = *(const uint2*)(ea.y5 + a_off(row, col, 16));
          const f32x4 b4 = *(const f32x4*)(ea.bias + col);
          const float y0 = __uint_as_float(yy.x << 16), y1 = __uint_as_float(yy.x & 0xffff0000u), y2 = __uint_as_float(yy.y << 16), y3 = __uint_as_float(yy.y & 0xffff0000u);
          *(uint2*)(ea.outb + a_off(row, 512 + col, 32)) = uint2{pk2(y0 * sigmoid_(v[0] + b4[0]), y1 * sigmoid_(v[1] + b4[1])), pk2(y2 * sigmoid_(v[2] + b4[2]), y3 * sigmoid_(v[3] + b4[3]))};
        }
        if (EPI == E_SWIGLU) {
          if ((n & 1) == 0) {
            const f32x4 u = acc[m][n | 1];
            const int co = (bcol >> 1) + wc * 32 + (n >> 1) * 16 + fq * 4;
            *(uint2*)(ea.outb + a_off(row, co, FF / 32)) = uint2{pk2(silu_(v[0]) * u[0], silu_(v[1]) * u[1]), pk2(silu_(v[2]) * u[2], silu_(v[3]) * u[3])};
          }
        }
        if (EPI == E_XE) *(f32x4*)(ea.outf + ((size_t)g * S5C + row) * 128 + col) = v;
        if (EPI == E_S5Y) {
          const uint2 uu = *(const uint2*)(ea.ux + (size_t)g * S5C * UXW + a_off(row, col, 20));
          const f32x4 d4 = *(const f32x4*)(ea.bias + g * 16 + (col & 15));
          const float u0 = __uint_as_float(uu.x << 16), u1 = __uint_as_float(uu.x & 0xffff0000u), u2 = __uint_as_float(uu.y << 16), u3 = __uint_as_float(uu.y & 0xffff0000u);
          *(uint2*)(ea.outb + a_off(row * 32 + (col >> 4), g * 16 + (col & 15), 16)) =
              uint2{pk2(gelu_tanh_(v[0] + d4[0] * u0), gelu_tanh_(v[1] + d4[1] * u1)), pk2(gelu_tanh_(v[2] + d4[2] * u2), gelu_tanh_(v[3] + d4[3] * u3))};
        }
      }
  }
}

__device__ __forceinline__ void s5_carry_phase(const Params& p, int bid, int nblk) {
  const float* xe = (const float*)(p.ws + OFF_XE); const float* a32 = (const float*)(p.ws + OFF_A32);
  u16* ux = (u16*)(p.ws + OFF_UX);
  for (int it = bid; it < 32; it += nblk) {
    const int idx = it * 256 + otid(), pp = idx & 63, g = (idx >> 6) & 31, b = idx >> 11;
    const float ar = a32[(g * 64 + pp) * 2], ai = a32[(g * 64 + pp) * 2 + 1];
    float xr = 0.f, xi = 0.f;
    const size_t cbase = (size_t)g * S5C + b * 256, gbase = (size_t)g * S5C * UXW;
    for (int n = 0; n < 256; n += 8) {
      float er[8], ei[8];
#pragma unroll
      for (int e = 0; e < 8; ++e) { er[e] = xe[(cbase + n + e) * 128 + pp]; ei[e] = xe[(cbase + n + e) * 128 + 64 + pp]; }
#pragma unroll
      for (int e = 0; e < 8; ++e) {
        ux[gbase + a_off(b * 256 + n + e, 512 + pp, 20)] = f2bf(xr); ux[gbase + a_off(b * 256 + n + e, 576 + pp, 20)] = f2bf(xi);
        const float nr = ar * xr - ai * xi + er[e], ni = ar * xi + ai * xr + ei[e];
        xr = nr; xi = ni;
      }
    }
  }
}

__device__ __forceinline__ int crow(int r, int hi) { return (r & 3) + 8 * (r >> 2) + 4 * hi; }
using f32x16 = __attribute__((ext_vector_type(16))) float;
__device__ __forceinline__ void unpack8(const u32x4 w, float* f) {
#pragma unroll
  for (int e = 0; e < 4; ++e) { f[2 * e] = __uint_as_float(w[e] << 16); f[2 * e + 1] = __uint_as_float(w[e] & 0xffff0000u); }
}
__device__ __forceinline__ void gdn_prep_phase(const Params& p, char* smem, int bid, int nblk) {
  const int tid = otid(), wid = tid >> 6, lane = tid & 63, fr = lane & 15, fq = lane >> 4;
  u16* qs = (u16*)smem;
  u16* ks = qs + 64 * 136;
  float* Lm = (float*)(ks + 64 * 136);
  float* gcs = Lm + 4096; float* bts = gcs + 64; float* egs = bts + 64;
  const u16* proj = (const u16*)(p.ws + OFF_PROJ);
  const float* beta = (const float*)(p.ws + OFF_BETA); const float* gg = (const float*)(p.ws + OFF_G);
#pragma unroll 1
  for (int it = bid; it < 2048; it += nblk) {
    const int n = it & 127, bh = it >> 7, b = bh >> 2, h = bh & 3;
    const size_t row0 = (size_t)b * SEQ + n * 64;
    if (wid == 0) {
      float c = gg[(row0 + lane) * 4 + h];
#pragma unroll
      for (int o = 1; o < 64; o <<= 1) { const float tt = __shfl_up(c, o); if (lane >= o) c += tt; }
      gcs[lane] = c; egs[lane] = __expf(c); bts[lane] = beta[(row0 + lane) * 4 + h];
    }
    {
      const int tok = tid >> 2, part = tid & 3, l = n * 64 + tok;
      float qo[32], ko[32]; float sq = 0.f, sk = 0.f;
#pragma unroll
      for (int cb = 0; cb < 4; ++cb) {
        const int colq = h * 128 + part * 32 + cb * 8, colk = 512 + colq;
        float aq[8], ak[8];
#pragma unroll
        for (int e = 0; e < 8; ++e) { aq[e] = 0.f; ak[e] = 0.f; }
#pragma unroll
        for (int j = 0; j < 4; ++j) {
          const int lt = l - 3 + j;
          if (lt >= 0) {
            const u16* rp = proj + ((size_t)b * SEQ + lt) * PJ;
            float xq[8], xk[8];
            unpack8(*(const u32x4*)(rp + colq), xq); unpack8(*(const u32x4*)(rp + colk), xk);
            const f32x4 wq0 = *(const f32x4*)(p.hy_conv_w + j * 1536 + colq), wq1 = *(const f32x4*)(p.hy_conv_w + j * 1536 + colq + 4);
            const f32x4 wk0 = *(const f32x4*)(p.hy_conv_w + j * 1536 + colk), wk1 = *(const f32x4*)(p.hy_conv_w + j * 1536 + colk + 4);
#pragma unroll
            for (int e = 0; e < 4; ++e) { aq[e] += wq0[e] * xq[e]; aq[4 + e] += wq1[e] * xq[4 + e]; ak[e] += wk0[e] * xk[e]; ak[4 + e] += wk1[e] * xk[4 + e]; }
          }
        }
#pragma unroll
        for (int e = 0; e < 8; ++e) { const float a = silu_(aq[e]), k = silu_(ak[e]); qo[cb * 8 + e] = a; ko[cb * 8 + e] = k; sq += a * a; sk += k * k; }
      }
      sq += __shfl_xor(sq, 1); sq += __shfl_xor(sq, 2); sk += __shfl_xor(sk, 1); sk += __shfl_xor(sk, 2);
      const float rq = rsqrtf(sq + 1e-6f) * 0.08838834764831845f, rk = rsqrtf(sk + 1e-6f);
#pragma unroll
      for (int cb = 0; cb < 4; ++cb) {
        u32x4 wq, wk;
#pragma unroll
        for (int e = 0; e < 4; ++e) { wq[e] = pk2(qo[cb * 8 + 2 * e] * rq, qo[cb * 8 + 2 * e + 1] * rq); wk[e] = pk2(ko[cb * 8 + 2 * e] * rk, ko[cb * 8 + 2 * e + 1] * rk); }
        *(u32x4*)(qs + tok * 136 + part * 32 + cb * 8) = wq; *(u32x4*)(ks + tok * 136 + part * 32 + cb * 8) = wk;
      }
    }
    __syncthreads();
    {
      f32x4 akk[4], aqk[4];
#pragma unroll
      for (int nb = 0; nb < 4; ++nb) { akk[nb] = f32x4{0.f, 0.f, 0.f, 0.f}; aqk[nb] = f32x4{0.f, 0.f, 0.f, 0.f}; }
#pragma unroll
      for (int kk = 0; kk < 4; ++kk) {
        const bf16x8 ak = *(const bf16x8*)(ks + (16 * wid + fr) * 136 + kk * 32 + fq * 8);
        const bf16x8 aq = *(const bf16x8*)(qs + (16 * wid + fr) * 136 + kk * 32 + fq * 8);
#pragma unroll
        for (int nb = 0; nb < 4; ++nb) {
          const bf16x8 bk = *(const bf16x8*)(ks + (16 * nb + fr) * 136 + kk * 32 + fq * 8);
          akk[nb] = __builtin_amdgcn_mfma_f32_16x16x32_bf16(ak, bk, akk[nb], 0, 0, 0);
          aqk[nb] = __builtin_amdgcn_mfma_f32_16x16x32_bf16(aq, bk, aqk[nb], 0, 0, 0);
        }
      }
      u16* att = (u16*)(p.ws + OFF_GAT) + (size_t)it * 4096;
#pragma unroll
      for (int nb = 0; nb < 4; ++nb)
#pragma unroll
        for (int r = 0; r < 4; ++r) {
          const int i = 16 * wid + fq * 4 + r, j = 16 * nb + fr;
          const float dec = __expf(fminf(gcs[i] - gcs[j], 0.f));
          Lm[i * 64 + j] = (i > j) ? bts[i] * akk[nb][r] * dec : 0.f;
          att[i * 64 + j] = f2bf((i >= j) ? aqk[nb][r] * dec : 0.f);
        }
    }
    __syncthreads();
    {
      float x[64];
      if (tid < 128) {
        const int col = 1024 + h * 128 + tid;
        const float w0 = p.hy_conv_w[col], w1 = p.hy_conv_w[1536 + col], w2 = p.hy_conv_w[2 * 1536 + col], w3 = p.hy_conv_w[3 * 1536 + col];
        float x1 = 0.f, x2 = 0.f, x3 = 0.f;
        if (n > 0) { x3 = bf2f(proj[(row0 - 3) * PJ + col]); x2 = bf2f(proj[(row0 - 2) * PJ + col]); x1 = bf2f(proj[(row0 - 1) * PJ + col]); }
#pragma unroll
        for (int i = 0; i < 64; ++i) {
          const float xv = bf2f(proj[(row0 + i) * PJ + col]);
          x[i] = silu_(w0 * x3 + w1 * x2 + w2 * x1 + w3 * xv) * bts[i];
          x3 = x2; x2 = x1; x1 = xv;
        }
      } else {
#pragma unroll
        for (int i = 0; i < 64; ++i) x[i] = bf2f(ks[i * 136 + tid - 128]) * bts[i] * egs[i];
      }
#pragma unroll
      for (int i = 1; i < 64; ++i) {
        float acc = x[i];
#pragma unroll
        for (int j4 = 0; j4 < (i + 3) / 4; ++j4) {
          const f32x4 l4 = *(const f32x4*)(Lm + i * 64 + j4 * 4);
#pragma unroll
          for (int e = 0; e < 4; ++e) if (j4 * 4 + e < i) acc -= l4[e] * x[j4 * 4 + e];
        }
        x[i] = acc;
      }
      if (tid < 128) {
        u16* ut = (u16*)(p.ws + OFF_GUT) + (size_t)it * 8192 + tid * 64;
#pragma unroll
        for (int c8 = 0; c8 < 8; ++c8) {
          u32x4 w;
#pragma unroll
          for (int e = 0; e < 4; ++e) w[e] = pk2(x[c8 * 8 + 2 * e], x[c8 * 8 + 2 * e + 1]);
          *(u32x4*)(ut + c8 * 8) = w;
        }
      } else {
        u16* wg = (u16*)(p.ws + OFF_GW) + (size_t)it * 8192 + (tid - 128);
#pragma unroll
        for (int i = 0; i < 64; ++i) wg[i * 128] = f2bf(x[i]);
      }
    }
    {
      u16* qd = (u16*)(p.ws + OFF_GQD) + (size_t)it * 8192;
#pragma unroll
      for (int k = 0; k < 4; ++k) {
        const int piece = tid + 256 * k, i = piece >> 4, d0 = (piece & 15) * 8;
        float f[8]; unpack8(*(const u32x4*)(qs + i * 136 + d0), f);
        const float e = egs[i];
        u32x4 w;
#pragma unroll
        for (int e2 = 0; e2 < 4; ++e2) w[e2] = pk2(f[2 * e2] * e, f[2 * e2 + 1] * e);
        *(u32x4*)(qd + i * 128 + d0) = w;
      }
      u16* kt = (u16*)(p.ws + OFF_GKT) + (size_t)it * 8192;
      const int dk = tid & 127, half = tid >> 7;
      const float gl = gcs[63];
#pragma unroll
      for (int c8 = 0; c8 < 4; ++c8) {
        u32x4 w;
#pragma unroll
        for (int e = 0; e < 4; ++e) {
          const int i0 = half * 32 + c8 * 8 + 2 * e;
          w[e] = pk2(bf2f(ks[i0 * 136 + dk]) * __expf(gl - gcs[i0]), bf2f(ks[(i0 + 1) * 136 + dk]) * __expf(gl - gcs[i0 + 1]));
        }
        *(u32x4*)(kt + dk * 64 + half * 32 + c8 * 8) = w;
      }
      if (tid == 0) ((float*)(p.ws + OFF_GSD))[it] = egs[63];
    }
    __syncthreads();
  }
}

__device__ __forceinline__ uint2 lds64(const char* p) { return *(const uint2*)p; }
__device__ __forceinline__ bf16x8 mk8(uint2 a, uint2 b) { u32x4 w = {a.x, a.y, b.x, b.y}; return __builtin_bit_cast(bf16x8, w); }
__device__ __forceinline__ bf16x8 pack8(const f32x16& x, int s) {
  u32x4 w = {pk2(x[8 * s], x[8 * s + 1]), pk2(x[8 * s + 2], x[8 * s + 3]), pk2(x[8 * s + 4], x[8 * s + 5]), pk2(x[8 * s + 6], x[8 * s + 7])};
  return __builtin_bit_cast(bf16x8, w);
}
__device__ __forceinline__ void gdn_scan_item(const Params& p, int bh, char* smem) {
  const int tid = otid(), wid = tid >> 6, lane = tid & 63, r32 = lane & 31, hi = lane >> 5;
  char* Wl = smem; char* QDl = smem + 16896; char* KTl = smem + 33792; char* ATl = smem + 51200;
  const int b = bh >> 2, h = bh & 3;
  const char* gw = p.ws + OFF_GW; const char* gqd = p.ws + OFF_GQD; const char* gkt = p.ws + OFF_GKT; const char* gat = p.ws + OFF_GAT;
  const u16* gut = (const u16*)(p.ws + OFF_GUT);
  const float* gsd = (const float*)(p.ws + OFF_GSD);
  f32x16 S[4];
#pragma unroll
  for (int T = 0; T < 4; ++T)
#pragma unroll
    for (int r = 0; r < 16; ++r) S[T][r] = 0.f;
  u32x4 st[14]; uint2 uc[8];
  const int dv = wid * 32 + r32;
#define G_LOAD(IT) do { const size_t o16 = (size_t)(IT) * 16384, o8 = (size_t)(IT) * 8192; \
    _Pragma("unroll") for (int k = 0; k < 4; ++k) { st[k] = *(const u32x4*)(gw + o16 + (tid + 256 * k) * 16); st[4 + k] = *(const u32x4*)(gqd + o16 + (tid + 256 * k) * 16); \
      st[8 + k] = *(const u32x4*)(gkt + o16 + (tid + 256 * k) * 16); } \
    _Pragma("unroll") for (int k = 0; k < 2; ++k) st[12 + k] = *(const u32x4*)(gat + o8 + (tid + 256 * k) * 16); } while (0)
#define U_LOAD(IT) do { _Pragma("unroll") for (int k = 0; k < 8; ++k) uc[k] = *(const uint2*)(gut + (size_t)(IT) * 8192 + dv * 64 + 32 * (k >> 2) + 8 * (k & 3) + 4 * hi); } while (0)
#define G_WRITE() do { \
    _Pragma("unroll") for (int k = 0; k < 4; ++k) { const int pc = tid + 256 * k; \
      { char* d = Wl + (pc >> 4) * 264 + (pc & 15) * 16; *(uint2*)d = uint2{st[k][0], st[k][1]}; *(uint2*)(d + 8) = uint2{st[k][2], st[k][3]}; } \
      { char* d = QDl + (pc >> 4) * 264 + (pc & 15) * 16; *(uint2*)d = uint2{st[4 + k][0], st[4 + k][1]}; *(uint2*)(d + 8) = uint2{st[4 + k][2], st[4 + k][3]}; } \
      { char* d = KTl + (pc >> 3) * 136 + (pc & 7) * 16; *(uint2*)d = uint2{st[8 + k][0], st[8 + k][1]}; *(uint2*)(d + 8) = uint2{st[8 + k][2], st[8 + k][3]}; } } \
    _Pragma("unroll") for (int k = 0; k < 2; ++k) { const int pc = tid + 256 * k; \
      char* d = ATl + (pc >> 3) * 136 + (pc & 7) * 16; *(uint2*)d = uint2{st[12 + k][0], st[12 + k][1]}; *(uint2*)(d + 8) = uint2{st[12 + k][2], st[12 + k][3]}; } } while (0)
  G_LOAD(bh * 128); U_LOAD(bh * 128); G_WRITE(); __syncthreads();
#pragma unroll 1
  for (int n = 0; n < 128; ++n) {
    const int item = bh * 128 + n;
    if (n + 1 < 128) G_LOAD(item + 1);
    f32x16 av[2], ao[2];
#pragma unroll
    for (int r = 0; r < 16; ++r) { av[0][r] = 0.f; av[1][r] = 0.f; ao[0][r] = 0.f; ao[1][r] = 0.f; }
#pragma unroll
    for (int T = 0; T < 4; ++T)
#pragma unroll
      for (int s = 0; s < 2; ++s) {
        const bf16x8 sb = pack8(S[T], s);
        const int cb = (32 * T + 16 * s + 4 * hi) * 2;
#pragma unroll
        for (int it = 0; it < 2; ++it) {
          const char* wp = Wl + (32 * it + r32) * 264 + cb; const char* qp = QDl + (32 * it + r32) * 264 + cb;
          av[it] = __builtin_amdgcn_mfma_f32_32x32x16_bf16(mk8(lds64(wp), lds64(wp + 16)), sb, av[it], 0, 0, 0);
          ao[it] = __builtin_amdgcn_mfma_f32_32x32x16_bf16(mk8(lds64(qp), lds64(qp + 16)), sb, ao[it], 0, 0, 0);
        }
      }
    bf16x8 vb[2][2];
#pragma unroll
    for (int it = 0; it < 2; ++it) {
      f32x16 vn;
#pragma unroll
      for (int g = 0; g < 4; ++g) {
        const uint2 u2 = uc[it * 4 + g];
        vn[4 * g] = __uint_as_float(u2.x << 16) - av[it][4 * g]; vn[4 * g + 1] = __uint_as_float(u2.x & 0xffff0000u) - av[it][4 * g + 1];
        vn[4 * g + 2] = __uint_as_float(u2.y << 16) - av[it][4 * g + 2]; vn[4 * g + 3] = __uint_as_float(u2.y & 0xffff0000u) - av[it][4 * g + 3];
      }
      vb[it][0] = pack8(vn, 0); vb[it][1] = pack8(vn, 1);
    }
    if (n + 1 < 128) U_LOAD(item + 1);
#pragma unroll
    for (int it2 = 0; it2 < 2; ++it2)
#pragma unroll
      for (int it = 0; it <= it2; ++it)
#pragma unroll
        for (int s = 0; s < 2; ++s) {
          const char* ap = ATl + (32 * it2 + r32) * 136 + (32 * it + 16 * s + 4 * hi) * 2;
          ao[it2] = __builtin_amdgcn_mfma_f32_32x32x16_bf16(mk8(lds64(ap), lds64(ap + 16)), vb[it][s], ao[it2], 0, 0, 0);
        }
    {
#pragma unroll
      for (int it = 0; it < 2; ++it) {
        float* op = (float*)((it ? p.ws + OFF_GQD : p.ws + OFF_GW) + (size_t)item * 16384) + dv;
#pragma unroll
        for (int r = 0; r < 16; ++r) op[crow(r, hi) * 128] = ao[it][r];
      }
    }
    const float sd = gsd[item];
#pragma unroll
    for (int T = 0; T < 4; ++T) {
#pragma unroll
      for (int r = 0; r < 16; ++r) S[T][r] *= sd;
#pragma unroll
      for (int it = 0; it < 2; ++it)
#pragma unroll
        for (int s = 0; s < 2; ++s) {
          const char* kp = KTl + (32 * T + r32) * 136 + (32 * it + 16 * s + 4 * hi) * 2;
          S[T] = __builtin_amdgcn_mfma_f32_32x32x16_bf16(mk8(lds64(kp), lds64(kp + 16)), vb[it][s], S[T], 0, 0, 0);
        }
    }
    __syncthreads();
    if (n + 1 < 128) G_WRITE();
    __syncthreads();
  }
#undef G_LOAD
#undef G_WRITE
#undef U_LOAD
}

__device__ __forceinline__ void gdn_normgate_phase(const Params& p, int bid, int nblk) {
  const int tid = otid(), wid = tid >> 6, lane = tid & 63;
  u16* concat = (u16*)(p.ws + OFF_HN);
  const u16* proj = (const u16*)(p.ws + OFF_PROJ);
  const f32x4 hw0 = *(const f32x4*)(p.hy_head_norm_w + (lane & 15) * 8), hw1 = *(const f32x4*)(p.hy_head_norm_w + (lane & 15) * 8 + 4);
#pragma unroll 1
  for (int row = bid * 4 + wid; row < M; row += nblk * 4) {
    const int l_ = row & (SEQ - 1), item_ = (((row >> 13) * 4 + (lane >> 4)) << 7) + (l_ >> 6), i_ = l_ & 63;
    const float* og = (const float*)(((i_ & 32) ? p.ws + OFF_GQD : p.ws + OFF_GW) + (size_t)item_ * 16384) + (i_ & 31) * 128 + (lane & 15) * 8;
    const f32x4 a0 = *(const f32x4*)(og), a1 = *(const f32x4*)(og + 4);
    float zf[8]; unpack8(*(const u32x4*)(proj + (size_t)row * PJ + 1536 + lane * 8), zf);
    float ss = a0[0] * a0[0] + a0[1] * a0[1] + a0[2] * a0[2] + a0[3] * a0[3] + a1[0] * a1[0] + a1[1] * a1[1] + a1[2] * a1[2] + a1[3] * a1[3];
#pragma unroll
    for (int o = 8; o >= 1; o >>= 1) ss += __shfl_xor(ss, o);
    const float rs = rsqrtf(ss * (1.f / 128.f) + 1e-6f);
    u32x4 w;
    w[0] = pk2(a0[0] * rs * hw0[0] * silu_(zf[0]), a0[1] * rs * hw0[1] * silu_(zf[1]));
    w[1] = pk2(a0[2] * rs * hw0[2] * silu_(zf[2]), a0[3] * rs * hw0[3] * silu_(zf[3]));
    w[2] = pk2(a1[0] * rs * hw1[0] * silu_(zf[4]), a1[1] * rs * hw1[1] * silu_(zf[5]));
    w[3] = pk2(a1[2] * rs * hw1[2] * silu_(zf[6]), a1[3] * rs * hw1[3] * silu_(zf[7]));
    *(u32x4*)(concat + a_off(row, lane * 8, 32)) = w;
  }
}

using s16x4 = __attribute__((ext_vector_type(4))) short;
#define KSWZ(row, colB) ((row) * 256 + ((colB) ^ (((row) & 7) << 4)))
#define SBAR() __builtin_amdgcn_sched_barrier(0)
__device__ __forceinline__ unsigned cvtpk(float lo, float hi) { unsigned r; asm volatile("v_cvt_pk_bf16_f32 %0, %1, %2" : "=v"(r) : "v"(lo), "v"(hi)); return r; }
__device__ __forceinline__ int v_st(int k, int c) { const int kk = (k & ~0xC) | ((k & 4) << 1) | ((k & 8) >> 1); return ((kk >> 3) * 4 + (c >> 5)) * 512 + ((kk & 7) * 32 + (c & 31)) * 2; }
__device__ __forceinline__ int v_rd_base(int lane) { return ((lane & 3) << 3) | (((lane >> 2) & 3) << 6) | (((lane >> 4) & 1) << 5) | (((lane >> 5) & 1) << 8); }
constexpr int v_rd_off(int d0, int ks, int half) { return d0 * 512 + ks * 4096 + half * 2048; }
template <int OFF> __device__ __forceinline__ s16x4 tr_read(int vb) {
  s16x4 r; asm volatile("ds_read_b64_tr_b16 %0, %1 offset:%2" : "=&v"(r) : "v"(vb), "i"(OFF) : "memory"); return r;
}
template <int D0> __device__ __forceinline__ void pv_one(f32x16& od, int vb, bf16x8 pa0, bf16x8 pa1, bf16x8 pa2, bf16x8 pa3) {
  const s16x4 l0 = tr_read<v_rd_off(D0, 0, 0)>(vb), h0 = tr_read<v_rd_off(D0, 0, 1)>(vb), l1 = tr_read<v_rd_off(D0, 1, 0)>(vb), h1 = tr_read<v_rd_off(D0, 1, 1)>(vb);
  const s16x4 l2 = tr_read<v_rd_off(D0, 2, 0)>(vb), h2 = tr_read<v_rd_off(D0, 2, 1)>(vb), l3 = tr_read<v_rd_off(D0, 3, 0)>(vb), h3 = tr_read<v_rd_off(D0, 3, 1)>(vb);
  asm volatile("s_waitcnt lgkmcnt(0)" ::: "memory"); SBAR();
#define PK(L, H) (bf16x8){L[0], L[1], L[2], L[3], H[0], H[1], H[2], H[3]}
  od = __builtin_amdgcn_mfma_f32_32x32x16_bf16(pa0, PK(l0, h0), od, 0, 0, 0);
  od = __builtin_amdgcn_mfma_f32_32x32x16_bf16(pa1, PK(l1, h1), od, 0, 0, 0);
  od = __builtin_amdgcn_mfma_f32_32x32x16_bf16(pa2, PK(l2, h2), od, 0, 0, 0);
  od = __builtin_amdgcn_mfma_f32_32x32x16_bf16(pa3, PK(l3, h3), od, 0, 0, 0);
#undef PK
}
__device__ __forceinline__ float pl32_other(float a, float b, int hi) {
  auto rr = __builtin_amdgcn_permlane32_swap(__float_as_uint(a), __float_as_uint(b), false, false);
  return __uint_as_float(hi ? rr[0] : rr[1]);
}
__device__ __forceinline__ void sb_half(f32x16& pz, float& run, bool need_mask, int kb, int t, int hi) {
  constexpr float C2 = 0.08838834764831845f * 1.4426950408889634f;
  f32x16 l;
#pragma unroll
  for (int r = 0; r < 16; ++r) {
    const float e = __builtin_amdgcn_exp2f(fminf(pz[r] * C2, 60.f));
    l[r] = __builtin_amdgcn_rcpf(1.f + e);
    pz[r] = e;
  }
  if (need_mask) {
#pragma unroll
    for (int r = 0; r < 16; ++r) { if (kb + crow(r, hi) >= t) { l[r] = 1.f; pz[r] = 0.f; } }
  }
#pragma unroll
  for (int g = 0; g < 4; ++g) { l[4 * g + 2] *= l[4 * g + 3]; l[4 * g + 1] *= l[4 * g + 2]; l[4 * g] *= l[4 * g + 1]; }
  const float cs3 = l[12], cs2 = l[8] * cs3, cs1 = l[4] * cs2, cs0 = l[0] * cs1;
  const float off0 = cs1 * pl32_other(cs0, cs1, hi) * run;
  const float off1 = cs2 * pl32_other(cs1, cs2, hi) * run;
  const float off2 = cs3 * pl32_other(cs2, cs3, hi) * run;
  const float off3 = pl32_other(cs3, 1.f, hi) * run;
  float tot;
  { auto rr = __builtin_amdgcn_permlane32_swap(__float_as_uint(cs0), __float_as_uint(cs0), false, false); tot = __uint_as_float(rr[0]) * __uint_as_float(rr[1]); }
#pragma unroll
  for (int r = 0; r < 4; ++r) {
    pz[r] = pz[r] * l[r] * off0; pz[4 + r] = pz[4 + r] * l[4 + r] * off1;
    pz[8 + r] = pz[8 + r] * l[8 + r] * off2; pz[12 + r] = pz[12 + r] * l[12 + r] * off3;
  }
  run *= tot;
}

__device__ __forceinline__ void attn_phase(const Params& p, char* smem, int bid, int nblk) {
  const int tid = otid(), wid = tid >> 6, lane = tid & 63, r32 = lane & 31, hi = lane >> 5;
  char* K_lds = smem; char* V_lds = smem + 16384;
  const u16* qkv = (const u16*)(p.ws + OFF_PROJ);
  u16* ao = (u16*)(p.ws + OFF_HN);
  const int sr = tid >> 4, sc = (tid & 15) * 8;
  const int vb0 = (int)(uintptr_t)V_lds + v_rd_base(lane);
  for (int k = 0; k * nblk < 2048; ++k) {
    const int i = (k & 1) ? ((k + 1) * nblk - 1 - bid) : (k * nblk + bid);
    if (i >= 2048) continue;
    const int j = 63 - (i >> 5), bh = i & 31, b = bh >> 3, h = bh & 7;
    const int i0 = j * 128;
    const size_t rowb = (size_t)b * SEQ;
    const int t = i0 + wid * 32 + r32, tmin = i0 + wid * 32, tmax = tmin + 31;
    bf16x8 qr[8];
    {
      const u16* qp = qkv + (rowb + t) * 3072 + h * 128 + hi * 8;
#pragma unroll
      for (int d0 = 0; d0 < 8; ++d0) qr[d0] = *(const bf16x8*)(qp + d0 * 16);
    }
    f32x16 o[4];
#pragma unroll
    for (int d = 0; d < 4; ++d)
#pragma unroll
      for (int r = 0; r < 16; ++r) o[d][r] = 0.f;
    float run = 1.f;
    const u16* kbase = qkv + rowb * 3072 + 1024 + h * 128 + sc;
    u32x4 stk[4], stv[4];
#define SLOAD(KT) do { _Pragma("unroll") for (int ii = 0; ii < 4; ++ii) { const u16* kp = kbase + (size_t)((KT) * 64 + sr + 16 * ii) * 3072; \
      stk[ii] = *(const u32x4*)kp; stv[ii] = *(const u32x4*)(kp + 1024); } } while (0)
#define SWRITE() do { _Pragma("unroll") for (int ii = 0; ii < 4; ++ii) { const int row = sr + 16 * ii; \
      *(u32x4*)(K_lds + KSWZ(row, sc * 2)) = stk[ii]; *(u32x4*)(V_lds + v_st(row, sc)) = stv[ii]; } } while (0)
    const int NT = 2 * j + 2;
    SLOAD(NT - 1); SWRITE(); __syncthreads();
    for (int kt = NT - 1; kt >= 0; --kt) {
      const int k0 = kt * 64;
      if (k0 <= tmax) {
        bf16x8 pa0, pa1, pa2, pa3;
#define PK4(P, BASE, OUT) do { unsigned a0 = cvtpk(P[BASE + 0], P[BASE + 1]), a1 = cvtpk(P[BASE + 2], P[BASE + 3]); \
    unsigned b0_ = cvtpk(P[BASE + 4], P[BASE + 5]), b1_ = cvtpk(P[BASE + 6], P[BASE + 7]); \
    auto r0 = __builtin_amdgcn_permlane32_swap(a0, b0_, false, false); auto r1 = __builtin_amdgcn_permlane32_swap(a1, b1_, false, false); \
    u32x4 w = {r0[0], r1[0], r0[1], r1[1]}; OUT = *reinterpret_cast<bf16x8*>(&w); } while (0)
        if (k0 + 32 <= tmax) {
          f32x16 pz;
#pragma unroll
          for (int r = 0; r < 16; ++r) pz[r] = 0.f;
#pragma unroll
          for (int d0 = 0; d0 < 8; ++d0) {
            const bf16x8 kf = *(const bf16x8*)(K_lds + KSWZ(32 + r32, (d0 * 16 + hi * 8) * 2));
            pz = __builtin_amdgcn_mfma_f32_32x32x16_bf16(kf, qr[d0], pz, 0, 0, 0);
          }
          sb_half(pz, run, k0 + 63 >= tmin, k0 + 32, t, hi);
          PK4(pz, 0, pa2); PK4(pz, 8, pa3);
        } else {
          pa2 = bf16x8{0, 0, 0, 0, 0, 0, 0, 0}; pa3 = pa2;
        }
        {
          f32x16 pz;
#pragma unroll
          for (int r = 0; r < 16; ++r) pz[r] = 0.f;
#pragma unroll
          for (int d0 = 0; d0 < 8; ++d0) {
            const bf16x8 kf = *(const bf16x8*)(K_lds + KSWZ(r32, (d0 * 16 + hi * 8) * 2));
            pz = __builtin_amdgcn_mfma_f32_32x32x16_bf16(kf, qr[d0], pz, 0, 0, 0);
          }
          sb_half(pz, run, k0 + 31 >= tmin, k0, t, hi);
          PK4(pz, 0, pa0); PK4(pz, 8, pa1);
        }
#undef PK4
        if (kt > 0) SLOAD(kt - 1);
        pv_one<0>(o[0], vb0, pa0, pa1, pa2, pa3); pv_one<1>(o[1], vb0, pa0, pa1, pa2, pa3);
        pv_one<2>(o[2], vb0, pa0, pa1, pa2, pa3); pv_one<3>(o[3], vb0, pa0, pa1, pa2, pa3);
      } else {
        if (kt > 0) SLOAD(kt - 1);
      }
      __syncthreads();
      if (kt > 0) SWRITE();
      __syncthreads();
    }
#undef SLOAD
#undef SWRITE
    {
      const int orow0 = (int)rowb + i0 + wid * 32;
#pragma unroll
      for (int r = 0; r < 16; ++r) {
        const int orow = crow(r, hi);
#pragma unroll
        for (int d0 = 0; d0 < 4; ++d0) ao[a_off(orow0 + orow, h * 128 + d0 * 32 + r32, 32)] = f2bf(o[d0][r]);
      }
    }
  }
}

__global__ void __launch_bounds__(256, 2) mega(Params p) {
  __shared__ __attribute__((aligned(16))) char smem[SMEM_BYTES];
  const int bid = blockIdx.x, nblk = gridDim.x;
  char* ws = p.ws;
  const float* mod = (const float*)(ws + OFF_MOD);
  u16* hn = (u16*)(ws + OFF_HN);
#define PH_BEGIN(n) if (p.phase_lo <= (n) && (n) < p.phase_hi) {
#define PH_END(n) if ((n) + 1 < p.phase_hi) cg::this_grid().sync(); }
  PH_BEGIN(0) phase0(p, smem, bid, nblk); PH_END(0)
  PH_BEGIN(1) norm_phase<1>(p, p.x, p.norm_mix_w, mod, 0, 1024, smem, bid, nblk); PH_END(1)
  PH_BEGIN(2) { EpiArgs ea{}; ea.outb = (u16*)(ws + OFF_PROJ); ea.ux = (u16*)(ws + OFF_UX);
        gemm_phase<E_PROJ0>(hn, 32, 0, (const u16*)(ws + OFF_WT_HYIN), 32, 0, 1024, M / 256, PN / 128, 1, ea, smem, bid, nblk); } PH_END(2)
  PH_BEGIN(3) { EpiArgs ea{}; ea.outf = (float*)(ws + OFF_XE);
        gemm_phase<E_XE>((const u16*)(ws + OFF_UX), 20, (size_t)S5C * UXW, (const u16*)(ws + OFF_EG), 16, (size_t)128 * 512, 512, S5C / 256, 1, 32, ea, smem, bid, nblk); } PH_END(3)
  PH_BEGIN(4) { s5_carry_phase(p, bid, nblk); gdn_prep_phase(p, smem, bid, nblk); } PH_END(4)
  PH_BEGIN(5) {
        if (bid < 16) { gdn_scan_item(p, bid, smem); }
        else { EpiArgs ea{}; ea.outb = (u16*)(ws + OFF_Y5); ea.ux = (u16*)(ws + OFF_UX); ea.bias = p.s5_d;
          gemm_phase<E_S5Y>((const u16*)(ws + OFF_UX), 20, (size_t)S5C * UXW, (const u16*)(ws + OFF_MF), 20, (size_t)512 * UXW, UXW, S5C / 256, 4, 32, ea, smem, bid - 16, nblk - 16); }
      } PH_END(5)
  PH_BEGIN(6) { gdn_normgate_phase(p, bid, nblk); } PH_END(6)
  PH_BEGIN(7) { EpiArgs ea{}; ea.outb = hn; ea.y5 = (const u16*)(ws + OFF_Y5); ea.bias = p.s5_glu_b;
        gemm_phase<E_GLU>((const u16*)(ws + OFF_Y5), 16, 0, (const u16*)(ws + OFF_WT_GLU), 16, 0, 512, M / 256, 4, 1, ea, smem, bid, nblk); } PH_END(7)
  PH_BEGIN(8) { EpiArgs ea{}; ea.outf = p.out; ea.res = p.x; ea.gate = mod + 2048;
        gemm_phase<E_RESID>(hn, 32, 0, (const u16*)(ws + OFF_WT_HYOUT), 32, 0, 1024, M / 256, 8, 1, ea, smem, bid, nblk); } PH_END(8)
  PH_BEGIN(9) norm_phase<0>(p, p.out, p.norm_ffn_w, mod, 3072, 4096, smem, bid, nblk); PH_END(9)
  PH_BEGIN(10) { EpiArgs ea{}; ea.outb = (u16*)(ws + OFF_PROJ);
        gemm_phase<E_SWIGLU>(hn, 32, 0, (const u16*)(ws + OFF_WT_FFNIN), 32, 0, 1024, M / 256, 2 * FF / 128, 1, ea, smem, bid, nblk); } PH_END(10)
  PH_BEGIN(11) { EpiArgs ea{}; ea.outf = p.out; ea.res = p.out; ea.gate = mod + 5120;
        gemm_phase<E_RESID>((const u16*)(ws + OFF_PROJ), FF / 32, 0, (const u16*)(ws + OFF_WT_FFNOUT), FF / 32, 0, FF, M / 256, 8, 1, ea, smem, bid, nblk); } PH_END(11)
  PH_BEGIN(12) norm_phase<0>(p, p.out, p.norm_mix_w + 1024, mod + 4 * 6144, 0, 1024, smem, bid, nblk); PH_END(12)
  PH_BEGIN(13) { EpiArgs ea{}; ea.outb = (u16*)(ws + OFF_PROJ); ea.ldc = 3072;
        gemm_phase<E_BF16>(hn, 32, 0, (const u16*)(ws + OFF_WT_SBIN), 32, 0, 1024, M / 256, 24, 1, ea, smem, bid, nblk); } PH_END(13)
  PH_BEGIN(14) attn_phase(p, smem, bid, nblk); PH_END(14)
  PH_BEGIN(15) { EpiArgs ea{}; ea.outf = p.out; ea.res = p.out; ea.gate = mod + 4 * 6144 + 2048;
        gemm_phase<E_RESID>(hn, 32, 0, (const u16*)(ws + OFF_WT_SBOUT), 32, 0, 1024, M / 256, 8, 1, ea, smem, bid, nblk); } PH_END(15)
  PH_BEGIN(16) norm_phase<0>(p, p.out, p.norm_ffn_w + 1024, mod + 4 * 6144, 3072, 4096, smem, bid, nblk); PH_END(16)
  PH_BEGIN(17) { EpiArgs ea{}; ea.outb = (u16*)(ws + OFF_PROJ);
        gemm_phase<E_SWIGLU>(hn, 32, 0, (const u16*)(ws + OFF_WT_FFNIN + SZ_WT_FFNIN), 32, 0, 1024, M / 256, 2 * FF / 128, 1, ea, smem, bid, nblk); } PH_END(17)
  PH_BEGIN(18) { EpiArgs ea{}; ea.outf = p.out; ea.res = p.out; ea.gate = mod + 4 * 6144 + 5120;
        gemm_phase<E_RESID>((const u16*)(ws + OFF_PROJ), FF / 32, 0, (const u16*)(ws + OFF_WT_FFNOUT + SZ_WT_FFNOUT), FF / 32, 0, FF, M / 256, 8, 1, ea, smem, bid, nblk); } PH_END(18)
  PH_BEGIN(19) norm_phase<2>(p, p.out, p.final_norm_w, mod, 0, 0, smem, bid, nblk); PH_END(19)
}

extern "C" void kernel_launch(void* const* d_in, const int* in_sizes, int n_in, void* d_out, int out_size, void* d_ws, size_t ws_size,
                              hipStream_t stream) {
  static int grid_blocks = 0;
  if (!grid_blocks) {
    int dev = 0, cus = 0, per_cu = 0;
    hipGetDevice(&dev);
    hipDeviceGetAttribute(&cus, hipDeviceAttributeMultiprocessorCount, dev);
    hipOccupancyMaxActiveBlocksPerMultiprocessor(&per_cu, mega, 256, 0);
    if (per_cu > 2) per_cu = 2;
    if (per_cu < 1) per_cu = 1;
    grid_blocks = cus * per_cu;
  }
  Params p{};
  const float* const* in = (const float* const*)d_in;
  p.x = in[0]; p.c = in[1]; p.ada_w = in[2]; p.ada_b = in[3]; p.norm_mix_w = in[4]; p.norm_ffn_w = in[5]; p.ffn_w_in = in[6]; p.ffn_w_out = in[7];
  p.hy_w_in = in[8]; p.hy_conv_w = in[9]; p.hy_a_log = in[10]; p.hy_dt_bias = in[11]; p.hy_head_norm_w = in[12];
  p.s5_lam_re = in[13]; p.s5_lam_im = in[14]; p.s5_log_dt = in[15]; p.s5_b_re = in[16]; p.s5_b_im = in[17]; p.s5_c_re = in[18]; p.s5_c_im = in[19];
  p.s5_d = in[20]; p.s5_glu_w = in[21]; p.s5_glu_b = in[22]; p.hy_w_out = in[23]; p.sb_w_in = in[24]; p.sb_w_out = in[25]; p.final_norm_w = in[26];
  p.out = (float*)d_out; p.ws = (char*)d_ws;
#if ONE_LAUNCH
  p.phase_lo = 0; p.phase_hi = NPHASE;
  void* args[] = {&p};
  hipError_t e = hipLaunchCooperativeKernel((void*)mega, dim3(grid_blocks), dim3(256), args, 0, stream);
  if (e != hipSuccess) fprintf(stderr, "cooperative launch failed: %s (grid %d)\n", hipGetErrorString(e), grid_blocks);
#else
  for (int ph = 0; ph < NPHASE; ++ph) {
    p.phase_lo = ph; p.phase_hi = ph + 1;
    hipLaunchKernelGGL(mega, dim3(grid_blocks), dim3(256), 0, stream, p);
  }
#endif
}
```

```cpp
#include <hip/hip_runtime.h>
#include <hip/hip_cooperative_groups.h>
#include <stdint.h>
#include <cstdio>
namespace cg = cooperative_groups;

#ifndef ONE_LAUNCH
#define ONE_LAUNCH 1
#endif

typedef unsigned short u16;
using bf16x8 = __attribute__((ext_vector_type(8))) short;
using f32x4 = __attribute__((ext_vector_type(4))) float;
using u32x4 = __attribute__((ext_vector_type(4))) unsigned;

constexpr int D = 1024, NB = 4, SEQ = 8192, M = NB * SEQ, FF = 2816, EIN = 2568, PN = 2560, PJ = 2048;
constexpr int NPHASE = 20;
constexpr int S5T = 32, S5C = M / S5T, UXW = 640;

constexpr size_t SZ_WT_HYIN = (size_t)PN * 1024 * 2, SZ_WT_SQ = (size_t)1024 * 1024 * 2, SZ_WT_GLU = (size_t)512 * 512 * 2;
constexpr size_t SZ_WT_FFNIN = (size_t)2 * FF * 1024 * 2, SZ_WT_FFNOUT = (size_t)1024 * FF * 2, SZ_WT_SBIN = (size_t)3072 * 1024 * 2;
constexpr size_t OFF_WT_HYIN = 0;
constexpr size_t OFF_WT_HYOUT = OFF_WT_HYIN + SZ_WT_HYIN;
constexpr size_t OFF_WT_GLU = OFF_WT_HYOUT + SZ_WT_SQ;
constexpr size_t OFF_WT_FFNIN = OFF_WT_GLU + SZ_WT_GLU;
constexpr size_t OFF_WT_FFNOUT = OFF_WT_FFNIN + 2 * SZ_WT_FFNIN;
constexpr size_t OFF_WT_SBIN = OFF_WT_FFNOUT + 2 * SZ_WT_FFNOUT;
constexpr size_t OFF_WT_SBOUT = OFF_WT_SBIN + SZ_WT_SBIN;
constexpr size_t OFF_MOD = OFF_WT_SBOUT + SZ_WT_SQ;
constexpr size_t OFF_BETA = OFF_MOD + (size_t)2 * 4 * 6144 * 4;
constexpr size_t OFF_G = OFF_BETA + (size_t)M * 4 * 4;
constexpr size_t OFF_HN = OFF_G + (size_t)M * 4 * 4;
constexpr size_t OFF_Y5 = OFF_HN + (size_t)M * 1024 * 2;
constexpr size_t OFF_UX = OFF_Y5 + (size_t)M * 512 * 2;
constexpr size_t OFF_MF = OFF_UX + (size_t)32 * S5C * UXW * 2;
constexpr size_t OFF_EG = OFF_MF + (size_t)32 * 512 * UXW * 2;
constexpr size_t OFF_XE = OFF_EG + (size_t)32 * 128 * 512 * 2;
constexpr size_t OFF_A32 = OFF_XE + (size_t)32 * S5C * 128 * 4;
constexpr size_t OFF_PROJ = OFF_A32 + (size_t)32 * 64 * 2 * 4;
constexpr size_t OFF_GW = OFF_PROJ + (size_t)M * PJ * 2;
constexpr size_t OFF_GQD = OFF_GW + (size_t)2048 * 8192 * 2;
constexpr size_t OFF_GKT = OFF_GQD + (size_t)2048 * 8192 * 2;
constexpr size_t OFF_GUT = OFF_GKT + (size_t)2048 * 8192 * 2;
constexpr size_t OFF_GAT = OFF_GUT + (size_t)2048 * 8192 * 2;
constexpr size_t OFF_GSD = OFF_GAT + (size_t)2048 * 4096 * 2;
constexpr size_t WS_TOTAL = OFF_GSD + (size_t)2048 * 4;
static_assert((size_t)M * 3072 * 2 <= WS_TOTAL - OFF_PROJ, "QKV alias");
static_assert(WS_TOTAL <= (size_t)512 * 1024 * 1024, "workspace too large");

struct Params {
  const float *x, *c, *ada_w, *ada_b, *norm_mix_w, *norm_ffn_w, *ffn_w_in, *ffn_w_out;
  const float *hy_w_in, *hy_conv_w, *hy_a_log, *hy_dt_bias, *hy_head_norm_w;
  const float *s5_lam_re, *s5_lam_im, *s5_log_dt, *s5_b_re, *s5_b_im, *s5_c_re, *s5_c_im, *s5_d, *s5_glu_w, *s5_glu_b, *hy_w_out;
  const float *sb_w_in, *sb_w_out, *final_norm_w;
  float* out;
  char* ws;
  int phase_lo, phase_hi;
};

constexpr int SMEM_BYTES = 73728;

__device__ __forceinline__ int otid() { int t = __builtin_amdgcn_workitem_id_x(); asm volatile("" : "+v"(t)); return t; }
__device__ __forceinline__ u16 f2bf(float x) { unsigned u = __float_as_uint(x); u += 0x7fffu + ((u >> 16) & 1u); return (u16)(u >> 16); }
typedef __bf16 bf16v2 __attribute__((ext_vector_type(2)));
typedef float f32v2 __attribute__((ext_vector_type(2)));
__device__ __forceinline__ unsigned pk2(float a, float b) { f32v2 v = {a, b}; bf16v2 r = __builtin_convertvector(v, bf16v2); return __builtin_bit_cast(unsigned, r); }
__device__ __forceinline__ float bf2f(u16 v) { return __uint_as_float(((unsigned)v) << 16); }
__device__ __forceinline__ float sigmoid_(float x) { return 1.f / (1.f + __expf(-x)); }
__device__ __forceinline__ float silu_(float x) { return x * sigmoid_(x); }
__device__ __forceinline__ float softplus_(float x) { return fmaxf(x, 0.f) + log1pf(__expf(-fabsf(x))); }
__device__ __forceinline__ float gelu_tanh_(float y) { return 0.5f * y * (1.f + tanhf(0.7978845608028654f * (y + 0.044715f * y * y * y))); }

__device__ __forceinline__ size_t a_off(int row, int col, int nks) { return ((size_t)((row >> 8) * nks + (col >> 5)) << 13) + ((row & 255) << 5) + (col & 31); }
__device__ __forceinline__ size_t b_off(int n, int k, int nks) { return ((size_t)((n >> 7) * nks + (k >> 5)) << 12) + ((n & 127) << 5) + (k & 31); }

struct TrJob { const float* src; u16* dst; int K, Nsrc, Nd, mode; };
__device__ __forceinline__ TrJob get_job(const Params& p, int j) {
  TrJob t;
  switch (j) {
    case 0: t = {p.hy_w_in, (u16*)(p.ws + OFF_WT_HYIN), 1024, EIN, PN, 1}; break;
    case 1: t = {p.hy_w_out, (u16*)(p.ws + OFF_WT_HYOUT), 1024, 1024, 1024, 0}; break;
    case 2: t = {p.s5_glu_w, (u16*)(p.ws + OFF_WT_GLU), 512, 512, 512, 0}; break;
    case 3: t = {p.ffn_w_in, (u16*)(p.ws + OFF_WT_FFNIN), 1024, 2 * FF, 2 * FF, 2}; break;
    case 4: t = {p.ffn_w_in + (size_t)1024 * 2 * FF, (u16*)(p.ws + OFF_WT_FFNIN + SZ_WT_FFNIN), 1024, 2 * FF, 2 * FF, 2}; break;
    case 5: t = {p.ffn_w_out, (u16*)(p.ws + OFF_WT_FFNOUT), FF, 1024, 1024, 0}; break;
    case 6: t = {p.ffn_w_out + (size_t)FF * 1024, (u16*)(p.ws + OFF_WT_FFNOUT + SZ_WT_FFNOUT), FF, 1024, 1024, 0}; break;
    case 7: t = {p.sb_w_in, (u16*)(p.ws + OFF_WT_SBIN), 1024, 3072, 3072, 0}; break;
    default: t = {p.sb_w_out, (u16*)(p.ws + OFF_WT_SBOUT), 1024, 1024, 1024, 0}; break;
  }
  return t;
}
__device__ __forceinline__ int src_col(int R, int mode) {
  if (mode == 0) return R;
  if (mode == 1) return R < 2048 ? R : R + 8;
  return ((R >> 4) & 1) * FF + (R >> 5) * 16 + (R & 15);
}
constexpr int N_TR_ITEMS = 640 + 256 + 64 + 2 * 1408 + 2 * 704 + 768 + 256;
constexpr int N_MOD_ITEMS = 2 * 6144 / 16;

__device__ __forceinline__ void s5_table_item(const Params& p, int item, char* smem) {
  const int tid = otid(), g = item >> 5, tau = item & 31;
  float* pwr = (float*)smem; float* pwi = pwr + 64; float* p1r = pwi + 64; float* p1i = p1r + 64;
  float* bbr = p1i + 64; float* bbi = bbr + 1024; float* cre = bbi + 1024; float* cim = cre + 1024;
  const float dt = expf(p.s5_log_dt[g]);
  if (tid < 64) {
    const float lr = p.s5_lam_re[g * 64 + tid], li = p.s5_lam_im[g * 64 + tid];
    float sn, cs;
    float mg = expf(lr * dt * (float)tau); sincosf(li * dt * (float)tau, &sn, &cs); pwr[tid] = mg * cs; pwi[tid] = mg * sn;
    mg = expf(lr * dt * (float)(tau + 1)); sincosf(li * dt * (float)(tau + 1), &sn, &cs); p1r[tid] = mg * cs; p1i[tid] = mg * sn;
    if (tau == 31) { float* a32 = (float*)(p.ws + OFF_A32); a32[(g * 64 + tid) * 2] = mg * cs; a32[(g * 64 + tid) * 2 + 1] = mg * sn; }
  }
  {
    const int pp = tid >> 2, hq = (tid & 3) * 4;
    const float lr = p.s5_lam_re[g * 64 + pp], li = p.s5_lam_im[g * 64 + pp];
    const float mg = expf(lr * dt); float sn, cs; sincosf(li * dt, &sn, &cs);
    const float ar = mg * cs, ai = mg * sn, den = lr * lr + li * li, nr = ar - 1.f, ni = ai;
    const float fre = (nr * lr + ni * li) / den, fim = (ni * lr - nr * li) / den;
#pragma unroll
    for (int e = 0; e < 4; ++e) {
      const float br = p.s5_b_re[(size_t)(g * 64 + pp) * 16 + hq + e], bi = p.s5_b_im[(size_t)(g * 64 + pp) * 16 + hq + e];
      bbr[pp * 16 + hq + e] = fre * br - fim * bi; bbi[pp * 16 + hq + e] = fre * bi + fim * br;
    }
    for (int i = tid; i < 1024; i += 256) { cre[i] = p.s5_c_re[(size_t)g * 1024 + i]; cim[i] = p.s5_c_im[(size_t)g * 1024 + i]; }
  }
  __syncthreads();
  u16* mf = (u16*)(p.ws + OFF_MF) + (size_t)g * 512 * UXW;
  u16* eg = (u16*)(p.ws + OFF_EG) + (size_t)g * 128 * 512;
  {
    const int h = tid >> 4, hp = tid & 15;
    float kv = 0.f;
    for (int pp = 0; pp < 64; ++pp) {
      const float cr = cre[h * 64 + pp], ci = cim[h * 64 + pp], pr = pwr[pp], pi = pwi[pp];
      kv += (cr * pr - ci * pi) * bbr[pp * 16 + hp] - (cr * pi + ci * pr) * bbi[pp * 16 + hp];
    }
    const u16 kb = f2bf(kv);
    for (int s0 = 0; s0 + tau < 32; ++s0) mf[b_off((s0 + tau) * 16 + h, s0 * 16 + hp, 20)] = kb;
    for (int t0 = 0; t0 + tau + 1 < 32; ++t0) mf[b_off(t0 * 16 + h, (t0 + tau + 1) * 16 + hp, 20)] = 0;
#pragma unroll
    for (int e = 0; e < 4; ++e) {
      const int pp = hp * 4 + e;
      const float cr = cre[h * 64 + pp], ci = cim[h * 64 + pp], pr = p1r[pp], pi = p1i[pp];
      mf[b_off(tau * 16 + h, 512 + pp, 20)] = f2bf(cr * pr - ci * pi);
      mf[b_off(tau * 16 + h, 576 + pp, 20)] = f2bf(-(cr * pi + ci * pr));
    }
  }
  {
    const int pp = tid >> 2, hq = (tid & 3) * 4, s0 = 31 - tau;
#pragma unroll
    for (int e = 0; e < 4; ++e) {
      const float br = bbr[pp * 16 + hq + e], bi = bbi[pp * 16 + hq + e], pr = pwr[pp], pi = pwi[pp];
      eg[b_off(pp, s0 * 16 + hq + e, 16)] = f2bf(pr * br - pi * bi);
      eg[b_off(64 + pp, s0 * 16 + hq + e, 16)] = f2bf(pr * bi + pi * br);
    }
  }
  __syncthreads();
}

__device__ __forceinline__ void phase0(const Params& p, char* smem, int bid, int nblk) {
  const int tid = otid();
  for (int it = bid; it < N_TR_ITEMS + N_MOD_ITEMS + 1024; it += nblk) {
    if (it >= N_TR_ITEMS + N_MOD_ITEMS) { s5_table_item(p, it - N_TR_ITEMS - N_MOD_ITEMS, smem); continue; }
    if (it < N_TR_ITEMS) {
      int rem = it, j = 0; TrJob jb;
      for (;; ++j) { jb = get_job(p, j); int n = (jb.Nd >> 6) * (jb.K >> 6); if (rem < n) break; rem -= n; }
      const int nk = jb.K >> 6, R0 = (rem / nk) * 64, k0 = (rem % nk) * 64;
      u16* s = (u16*)smem;
      {
        const int r = tid & 63, kk = tid >> 6;
        const float* sp = jb.src + (size_t)k0 * jb.Nsrc + src_col(R0 + r, jb.mode);
#pragma unroll
        for (int i = 0; i < 16; ++i) { int k = kk + 4 * i; s[r * 72 + k] = f2bf(sp[(size_t)k * jb.Nsrc]); }
      }
      __syncthreads();
      {
        const int r = tid >> 2, ch = tid & 3;
#pragma unroll
        for (int i = 0; i < 2; ++i) {
          int c8 = (ch + 4 * i) * 8;
          *(u32x4*)(jb.dst + b_off(R0 + r, k0 + c8, jb.K >> 5)) = *(const u32x4*)(s + r * 72 + c8);
        }
      }
      __syncthreads();
    } else {
      const int mi = it - N_TR_ITEMS, l = mi / 384, n0 = (mi % 384) * 16;
      float* cact = (float*)smem;
      float* red = cact + 4096;
      for (int i = tid; i < 4096; i += 256) cact[i] = silu_(p.c[i]);
      __syncthreads();
      const int cl = tid & 15, ksub = tid >> 4;
      float a0 = 0, a1 = 0, a2 = 0, a3 = 0;
      const float* wp = p.ada_w + (size_t)l * 1024 * 6144 + n0 + cl;
#pragma unroll 16
      for (int k = ksub * 64; k < ksub * 64 + 64; ++k) {
        float w = wp[(size_t)k * 6144];
        a0 += cact[k] * w; a1 += cact[1024 + k] * w; a2 += cact[2048 + k] * w; a3 += cact[3072 + k] * w;
      }
      red[(ksub * 4 + 0) * 16 + cl] = a0; red[(ksub * 4 + 1) * 16 + cl] = a1;
      red[(ksub * 4 + 2) * 16 + cl] = a2; red[(ksub * 4 + 3) * 16 + cl] = a3;
      __syncthreads();
      if (tid < 64) {
        const int b = tid >> 4;
        float sum = 0.f;
#pragma unroll
        for (int q = 0; q < 16; ++q) sum += red[(q * 4 + b) * 16 + cl];
        float* mod = (float*)(p.ws + OFF_MOD);
        mod[(size_t)(l * 4 + b) * 6144 + n0 + cl] = sum + p.ada_b[l * 6144 + n0 + cl];
      }
      __syncthreads();
    }
  }
}

template <int MODE>
__device__ __forceinline__ void norm_phase(const Params& p, const float* src, const float* w, const float* modl, int sh_off, int sc_off,
                           char* smem, int bid, int nblk) {
  const int tid = otid(), wid = tid >> 6, lane = tid & 63;
  float* wba = (float*)smem;
  if (MODE == 1) {
    for (int i = tid; i < 1024 * 8; i += 256) wba[i] = p.hy_w_in[(size_t)(i >> 3) * EIN + 2048 + (i & 7)];
    __syncthreads();
  }
  u16* hn = (u16*)(p.ws + OFF_HN);
  auto process = [&](int row, f32x4 (&v)[4]) {
    float ss = 0.f;
#pragma unroll
    for (int i = 0; i < 4; ++i) ss += v[i][0] * v[i][0] + v[i][1] * v[i][1] + v[i][2] * v[i][2] + v[i][3] * v[i][3];
#pragma unroll
    for (int o = 32; o >= 1; o >>= 1) ss += __shfl_xor(ss, o);
    const float rstd = rsqrtf(ss * (1.f / 1024.f) + 1e-6f);
    const int b = row >> 13;
    float dots[8];
    if (MODE == 1) { for (int j = 0; j < 8; ++j) dots[j] = 0.f; }
#pragma unroll
    for (int i = 0; i < 4; ++i) {
      const int c0 = i * 256 + lane * 4;
      f32x4 ww = *(const f32x4*)(w + c0);
      f32x4 y;
      if (MODE == 2) {
#pragma unroll
        for (int e = 0; e < 4; ++e) y[e] = v[i][e] * rstd * ww[e];
        *(f32x4*)(p.out + (size_t)row * 1024 + c0) = y;
      } else {
        f32x4 sc = *(const f32x4*)(modl + (size_t)b * 6144 + sc_off + c0);
        f32x4 sh = *(const f32x4*)(modl + (size_t)b * 6144 + sh_off + c0);
#pragma unroll
        for (int e = 0; e < 4; ++e) y[e] = v[i][e] * rstd * ww[e] * (1.f + sc[e]) + sh[e];
        uint2 pk; pk.x = (unsigned)f2bf(y[0]) | ((unsigned)f2bf(y[1]) << 16); pk.y = (unsigned)f2bf(y[2]) | ((unsigned)f2bf(y[3]) << 16);
        *(uint2*)(hn + a_off(row, c0, 32)) = pk;
        if (MODE == 1) {
#pragma unroll
          for (int e = 0; e < 4; ++e) {
            f32x4 w0 = *(const f32x4*)(wba + (c0 + e) * 8), w1 = *(const f32x4*)(wba + (c0 + e) * 8 + 4);
#pragma unroll
            for (int j = 0; j < 4; ++j) { dots[j] += y[e] * w0[j]; dots[4 + j] += y[e] * w1[j]; }
          }
        }
      }
    }
    if (MODE == 1) {
#pragma unroll
      for (int j = 0; j < 8; ++j) {
#pragma unroll
        for (int o = 32; o >= 1; o >>= 1) dots[j] += __shfl_xor(dots[j], o);
      }
      if (lane == 0) {
        float* beta = (float*)(p.ws + OFF_BETA); float* gg = (float*)(p.ws + OFF_G);
#pragma unroll
        for (int h = 0; h < 4; ++h) {
          beta[(size_t)row * 4 + h] = sigmoid_(dots[h]);
          gg[(size_t)row * 4 + h] = -__expf(p.hy_a_log[h]) * softplus_(dots[4 + h] + p.hy_dt_bias[h]);
        }
      }
    }
  };
#pragma unroll 1
  for (int row = bid * 4 + wid; row < M; row += nblk * 8) {
    const int row1 = row + nblk * 4;
    const bool has1 = row1 < M;
    f32x4 v0[4], v1[4];
#pragma unroll
    for (int i = 0; i < 4; ++i) v0[i] = *(const f32x4*)(src + (size_t)row * 1024 + i * 256 + lane * 4);
#pragma unroll
    for (int i = 0; i < 4; ++i) v1[i] = has1 ? *(const f32x4*)(src + (size_t)row1 * 1024 + i * 256 + lane * 4) : f32x4{0.f, 0.f, 0.f, 0.f};
    process(row, v0);
    if (has1) process(row1, v1);
  }
}

enum { E_PROJ0 = 0, E_BF16 = 1, E_RESID = 2, E_GLU = 3, E_SWIGLU = 4, E_XE = 5, E_S5Y = 6 };
struct EpiArgs { float* outf; u16* outb; const float* res; const float* gate; const u16* y5; const float* bias; u16* ux; int ldc; };

template <int EPI>
__device__ __forceinline__ void gemm_phase(const u16* __restrict__ A0, int nksA, size_t sA, const u16* __restrict__ B0, int nksB, size_t sB,
                                           int K, int nM, int nN, int nbatch, const EpiArgs ea, char* smem, int bid, int nblk) {
  const int tid = otid(), wid = tid >> 6, lane = tid & 63, wr = wid >> 1, wc = wid & 1, fr = lane & 15, fq = lane >> 4;
  char* SA = smem; char* SB = smem + 49152;
  const int NR = nbatch * nM, ntiles = NR * nN;
  const int STN = (nN & 7) == 0 ? 8 : ((nN & 3) == 0 ? 4 : 1), STM = 64 / STN, nSN = nN / STN;
  const bool swz = ((nblk & 7) == 0) && (NR % STM == 0);
  const int lpx = nblk >> 3;
  int si = bid & 7, l = bid >> 3, tl = bid;
#pragma unroll 1
  for (;;) {
    int R, pn;
    if (swz) {
      if (si >= (NR / STM) * nSN) break;
      R = (si / nSN) * STM + l / STN; pn = (si % nSN) * STN + l % STN;
      l += lpx; if (l >= 64) { l = bid >> 3; si += 8; }
    } else {
      if (tl >= ntiles) break;
      R = tl / nN; pn = tl % nN; tl += nblk;
    }
    const int g = R / nM, rt = R % nM, brow = rt << 8, bcol = pn << 7;
    const char* A = (const char*)(A0 + (size_t)g * sA) + ((size_t)rt * nksA << 14) + tid * 16;
    const char* Bt = (const char*)(B0 + (size_t)g * sB) + ((size_t)pn * nksB << 13) + tid * 16;
    int nk = K >> 5, klim = nk;
    if (EPI == E_S5Y) { klim = 4 * (pn + 1); nk = klim + 4; }
    f32x4 acc[8][4];
#pragma unroll
    for (int m = 0; m < 8; ++m)
#pragma unroll
      for (int n = 0; n < 4; ++n) acc[m][n] = f32x4{0.f, 0.f, 0.f, 0.f};
#define GSTAGE(KK, BUF) do { const int kt_ = (EPI == E_S5Y && (KK) >= klim) ? (16 + (KK) - klim) : (KK); \
      _Pragma("unroll") for (int i = 0; i < 4; ++i) \
        __builtin_amdgcn_global_load_lds((const unsigned*)(A + ((size_t)kt_ << 14) + i * 4096), (__attribute__((address_space(3))) unsigned*)(SA + (BUF) * 16384 + tid * 16 + i * 4096), 16, 0, 0); \
      _Pragma("unroll") for (int i = 0; i < 2; ++i) \
        __builtin_amdgcn_global_load_lds((const unsigned*)(Bt + ((size_t)kt_ << 13) + i * 4096), (__attribute__((address_space(3))) unsigned*)(SB + (BUF) * 8192 + tid * 16 + i * 4096), 16, 0, 0); } while (0)
    asm volatile("s_waitcnt vmcnt(0)" ::: "memory");
    GSTAGE(0, 0);
    if (nk > 1) { GSTAGE(1, 1); asm volatile("s_waitcnt vmcnt(6)\n\ts_barrier" ::: "memory"); }
    else { asm volatile("s_waitcnt vmcnt(0)\n\ts_barrier" ::: "memory"); }
    int buf = 0, nbuf = 2;
#pragma unroll 1
    for (int kk = 0; kk < nk; ++kk) {
      const bool more = kk + 2 < nk;
      if (more) GSTAGE(kk + 2, nbuf);
      bf16x8 Bl[4], At[8];
#pragma unroll
      for (int n = 0; n < 4; ++n) Bl[n] = *(const bf16x8*)(SB + buf * 8192 + (wc * 64 + n * 16 + fr) * 64 + fq * 16);
#pragma unroll
      for (int m = 0; m < 8; ++m) At[m] = *(const bf16x8*)(SA + buf * 16384 + (wr * 128 + m * 16 + fr) * 64 + fq * 16);
#pragma unroll
      for (int m = 0; m < 8; ++m)
#pragma unroll
        for (int n = 0; n < 4; ++n) acc[m][n] = __builtin_amdgcn_mfma_f32_16x16x32_bf16(Bl[n], At[m], acc[m][n], 0, 0, 0);
      if (more) asm volatile("s_waitcnt vmcnt(6)\n\ts_barrier" ::: "memory");
      else asm volatile("s_waitcnt vmcnt(0)\n\ts_barrier" ::: "memory");
      buf = (buf == 2) ? 0 : buf + 1; nbuf = (nbuf == 2) ? 0 : nbuf + 1;
    }
#undef GSTAGE
#pragma unroll
    for (int m = 0; m < 8; ++m)
#pragma unroll
      for (int n = 0; n < 4; ++n) {
        const int row = brow + wr * 128 + m * 16 + fr, col = bcol + wc * 64 + n * 16 + fq * 4;
        const f32x4 v = acc[m][n];
        if (EPI == E_PROJ0) {
          const uint2 pk = uint2{pk2(v[0], v[1]), pk2(v[2], v[3])};
          if (bcol < 2048) *(uint2*)(ea.outb + (size_t)row * PJ + col) = pk;
          else { const int cc = col - 2048; *(uint2*)(ea.ux + (size_t)(cc >> 4) * S5C * UXW + a_off(row >> 5, (row & 31) * 16 + (cc & 15), 20)) = pk; }
        }
        if (EPI == E_BF16) *(uint2*)(ea.outb + (size_t)row * ea.ldc + col) = uint2{pk2(v[0], v[1]), pk2(v[2], v[3])};
        if (EPI == E_RESID) {
          const size_t idx = (size_t)row * 1024 + col;
          const f32x4 r4 = *(const f32x4*)(ea.res + idx), g4 = *(const f32x4*)(ea.gate + (size_t)(row >> 13) * 6144 + col);
          *(f32x4*)(ea.outf + idx) = f32x4{r4[0] + g4[0] * v[0], r4[1] + g4[1] * v[1], r4[2] + g4[2] * v[2], r4[3] + g4[3] * v[3]};
        }
        if (EPI == E_GLU) {
          const uint2 yy = *(const uint2*)(ea.y5 + a_off(row, col, 16));
          const f32x4 b4 = *(const f32x4*)(ea.bias + col);
          const float y0 = __uint_as_float(yy.x << 16), y1 = __uint_as_float(yy.x & 0xffff0000u), y2 = __uint_as_float(yy.y << 16), y3 = __uint_as_float(yy.y & 0xffff0000u);
          *(uint2*)(ea.outb + a_off(row, 512 + col, 32)) = uint2{pk2(y0 * sigmoid_(v[0] + b4[0]), y1 * sigmoid_(v[1] + b4[1])), pk2(y2 * sigmoid_(v[2] + b4[2]), y3 * sigmoid_(v[3] + b4[3]))};
        }
        if (EPI == E_SWIGLU) {
          if ((n & 1) == 0) {
            const f32x4 u = acc[m][n | 1];
            const int co = (bcol >> 1) + wc * 32 + (n >> 1) * 16 + fq * 4;
            *(uint2*)(ea.outb + a_off(row, co, FF / 32)) = uint2{pk2(silu_(v[0]) * u[0], silu_(v[1]) * u[1]), pk2(silu_(v[2]) * u[2], silu_(v[3]) * u[3])};
          }
        }
        if (EPI == E_XE) *(f32x4*)(ea.outf + ((size_t)g * S5C + row) * 128 + col) = v;
        if (EPI == E_S5Y) {
          const uint2 uu = *(const uint2*)(ea.ux + (size_t)g * S5C * UXW + a_off(row, col, 20));
          const f32x4 d4 = *(const f32x4*)(ea.bias + g * 16 + (col & 15));
          const float u0 = __uint_as_float(uu.x << 16), u1 = __uint_as_float(uu.x & 0xffff0000u), u2 = __uint_as_float(uu.y << 16), u3 = __uint_as_float(uu.y & 0xffff0000u);
          *(uint2*)(ea.outb + a_off(row * 32 + (col >> 4), g * 16 + (col & 15), 16)) =
              uint2{pk2(gelu_tanh_(v[0] + d4[0] * u0), gelu_tanh_(v[1] + d4[1] * u1)), pk2(gelu_tanh_(v[2] + d4[2] * u2), gelu_tanh_(v[3] + d4[3] * u3))};
        }
      }
  }
}

__device__ __forceinline__ void s5_carry_phase(const Params& p, int bid, int nblk) {
  const float* xe = (const float*)(p.ws + OFF_XE); const float* a32 = (const float*)(p.ws + OFF_A32);
  u16* ux = (u16*)(p.ws + OFF_UX);
  for (int it = bid; it < 32; it += nblk) {
    const int idx = it * 256 + otid(), pp = idx & 63, g = (idx >> 6) & 31, b = idx >> 11;
    const float ar = a32[(g * 64 + pp) * 2], ai = a32[(g * 64 + pp) * 2 + 1];
    float xr = 0.f, xi = 0.f;
    const size_t cbase = (size_t)g * S5C + b * 256, gbase = (size_t)g * S5C * UXW;
    for (int n = 0; n < 256; n += 8) {
      float er[8], ei[8];
#pragma unroll
      for (int e = 0; e < 8; ++e) { er[e] = xe[(cbase + n + e) * 128 + pp]; ei[e] = xe[(cbase + n + e) * 128 + 64 + pp]; }
#pragma unroll
      for (int e = 0; e < 8; ++e) {
        ux[gbase + a_off(b * 256 + n + e, 512 + pp, 20)] = f2bf(xr); ux[gbase + a_off(b * 256 + n + e, 576 + pp, 20)] = f2bf(xi);
        const float nr = ar * xr - ai * xi + er[e], ni = ar * xi + ai * xr + ei[e];
        xr = nr; xi = ni;
      }
    }
  }
}

__device__ __forceinline__ int crow(int r, int hi) { return (r & 3) + 8 * (r >> 2) + 4 * hi; }
using f32x16 = __attribute__((ext_vector_type(16))) float;
__device__ __forceinline__ void unpack8(const u32x4 w, float* f) {
#pragma unroll
  for (int e = 0; e < 4; ++e) { f[2 * e] = __uint_as_float(w[e] << 16); f[2 * e + 1] = __uint_as_float(w[e] & 0xffff0000u); }
}
__device__ __forceinline__ void gdn_prep_phase(const Params& p, char* smem, int bid, int nblk) {
  const int tid = otid(), wid = tid >> 6, lane = tid & 63, fr = lane & 15, fq = lane >> 4;
  u16* qs = (u16*)smem;
  u16* ks = qs + 64 * 136;
  float* Lm = (float*)(ks + 64 * 136);
  float* gcs = Lm + 4096; float* bts = gcs + 64; float* egs = bts + 64;
  const u16* proj = (const u16*)(p.ws + OFF_PROJ);
  const float* beta = (const float*)(p.ws + OFF_BETA); const float* gg = (const float*)(p.ws + OFF_G);
#pragma unroll 1
  for (int it = bid; it < 2048; it += nblk) {
    const int n = it & 127, bh = it >> 7, b = bh >> 2, h = bh & 3;
    const size_t row0 = (size_t)b * SEQ + n * 64;
    if (wid == 0) {
      float c = gg[(row0 + lane) * 4 + h];
#pragma unroll
      for (int o = 1; o < 64; o <<= 1) { const float tt = __shfl_up(c, o); if (lane >= o) c += tt; }
      gcs[lane] = c; egs[lane] = __expf(c); bts[lane] = beta[(row0 + lane) * 4 + h];
    }
    {
      const int tok = tid >> 2, part = tid & 3, l = n * 64 + tok;
      float qo[32], ko[32]; float sq = 0.f, sk = 0.f;
#pragma unroll
      for (int cb = 0; cb < 4; ++cb) {
        const int colq = h * 128 + part * 32 + cb * 8, colk = 512 + colq;
        float aq[8], ak[8];
#pragma unroll
        for (int e = 0; e < 8; ++e) { aq[e] = 0.f; ak[e] = 0.f; }
#pragma unroll
        for (int j = 0; j < 4; ++j) {
          const int lt = l - 3 + j;
          if (lt >= 0) {
            const u16* rp = proj + ((size_t)b * SEQ + lt) * PJ;
            float xq[8], xk[8];
            unpack8(*(const u32x4*)(rp + colq), xq); unpack8(*(const u32x4*)(rp + colk), xk);
            const f32x4 wq0 = *(const f32x4*)(p.hy_conv_w + j * 1536 + colq), wq1 = *(const f32x4*)(p.hy_conv_w + j * 1536 + colq + 4);
            const f32x4 wk0 = *(const f32x4*)(p.hy_conv_w + j * 1536 + colk), wk1 = *(const f32x4*)(p.hy_conv_w + j * 1536 + colk + 4);
#pragma unroll
            for (int e = 0; e < 4; ++e) { aq[e] += wq0[e] * xq[e]; aq[4 + e] += wq1[e] * xq[4 + e]; ak[e] += wk0[e] * xk[e]; ak[4 + e] += wk1[e] * xk[4 + e]; }
          }
        }
#pragma unroll
        for (int e = 0; e < 8; ++e) { const float a = silu_(aq[e]), k = silu_(ak[e]); qo[cb * 8 + e] = a; ko[cb * 8 + e] = k; sq += a * a; sk += k * k; }
      }
      sq += __shfl_xor(sq, 1); sq += __shfl_xor(sq, 2); sk += __shfl_xor(sk, 1); sk += __shfl_xor(sk, 2);
      const float rq = rsqrtf(sq + 1e-6f) * 0.08838834764831845f, rk = rsqrtf(sk + 1e-6f);
#pragma unroll
      for (int cb = 0; cb < 4; ++cb) {
        u32x4 wq, wk;
#pragma unroll
        for (int e = 0; e < 4; ++e) { wq[e] = pk2(qo[cb * 8 + 2 * e] * rq, qo[cb * 8 + 2 * e + 1] * rq); wk[e] = pk2(ko[cb * 8 + 2 * e] * rk, ko[cb * 8 + 2 * e + 1] * rk); }
        *(u32x4*)(qs + tok * 136 + part * 32 + cb * 8) = wq; *(u32x4*)(ks + tok * 136 + part * 32 + cb * 8) = wk;
      }
    }
    __syncthreads();
    {
      f32x4 akk[4], aqk[4];
#pragma unroll
      for (int nb = 0; nb < 4; ++nb) { akk[nb] = f32x4{0.f, 0.f, 0.f, 0.f}; aqk[nb] = f32x4{0.f, 0.f, 0.f, 0.f}; }
#pragma unroll
      for (int kk = 0; kk < 4; ++kk) {
        const bf16x8 ak = *(const bf16x8*)(ks + (16 * wid + fr) * 136 + kk * 32 + fq * 8);
        const bf16x8 aq = *(const bf16x8*)(qs + (16 * wid + fr) * 136 + kk * 32 + fq * 8);
#pragma unroll
        for (int nb = 0; nb < 4; ++nb) {
          const bf16x8 bk = *(const bf16x8*)(ks + (16 * nb + fr) * 136 + kk * 32 + fq * 8);
          akk[nb] = __builtin_amdgcn_mfma_f32_16x16x32_bf16(ak, bk, akk[nb], 0, 0, 0);
          aqk[nb] = __builtin_amdgcn_mfma_f32_16x16x32_bf16(aq, bk, aqk[nb], 0, 0, 0);
        }
      }
      u16* att = (u16*)(p.ws + OFF_GAT) + (size_t)it * 4096;
#pragma unroll
      for (int nb = 0; nb < 4; ++nb)
#pragma unroll
        for (int r = 0; r < 4; ++r) {
          const int i = 16 * wid + fq * 4 + r, j = 16 * nb + fr;
          const float dec = __expf(fminf(gcs[i] - gcs[j], 0.f));
          Lm[i * 64 + j] = (i > j) ? bts[i] * akk[nb][r] * dec : 0.f;
          att[i * 64 + j] = f2bf((i >= j) ? aqk[nb][r] * dec : 0.f);
        }
    }
    __syncthreads();
    {
      float x[64];
      if (tid < 128) {
        const int col = 1024 + h * 128 + tid;
        const float w0 = p.hy_conv_w[col], w1 = p.hy_conv_w[1536 + col], w2 = p.hy_conv_w[2 * 1536 + col], w3 = p.hy_conv_w[3 * 1536 + col];
        float x1 = 0.f, x2 = 0.f, x3 = 0.f;
        if (n > 0) { x3 = bf2f(proj[(row0 - 3) * PJ + col]); x2 = bf2f(proj[(row0 - 2) * PJ + col]); x1 = bf2f(proj[(row0 - 1) * PJ + col]); }
#pragma unroll
        for (int i = 0; i < 64; ++i) {
          const float xv = bf2f(proj[(row0 + i) * PJ + col]);
          x[i] = silu_(w0 * x3 + w1 * x2 + w2 * x1 + w3 * xv) * bts[i];
          x3 = x2; x2 = x1; x1 = xv;
        }
      } else {
#pragma unroll
        for (int i = 0; i < 64; ++i) x[i] = bf2f(ks[i * 136 + tid - 128]) * bts[i] * egs[i];
      }
#pragma unroll
      for (int i = 1; i < 64; ++i) {
        float acc = x[i];
#pragma unroll
        for (int j4 = 0; j4 < (i + 3) / 4; ++j4) {
          const f32x4 l4 = *(const f32x4*)(Lm + i * 64 + j4 * 4);
#pragma unroll
          for (int e = 0; e < 4; ++e) if (j4 * 4 + e < i) acc -= l4[e] * x[j4 * 4 + e];
        }
        x[i] = acc;
      }
      if (tid < 128) {
        u16* ut = (u16*)(p.ws + OFF_GUT) + (size_t)it * 8192 + tid * 64;
#pragma unroll
        for (int c8 = 0; c8 < 8; ++c8) {
          u32x4 w;
#pragma unroll
          for (int e = 0; e < 4; ++e) w[e] = pk2(x[c8 * 8 + 2 * e], x[c8 * 8 + 2 * e + 1]);
          *(u32x4*)(ut + c8 * 8) = w;
        }
      } else {
        u16* wg = (u16*)(p.ws + OFF_GW) + (size_t)it * 8192 + (tid - 128);
#pragma unroll
        for (int i = 0; i < 64; ++i) wg[i * 128] = f2bf(x[i]);
      }
    }
    {
      u16* qd = (u16*)(p.ws + OFF_GQD) + (size_t)it * 8192;
#pragma unroll
      for (int k = 0; k < 4; ++k) {
        const int piece = tid + 256 * k, i = piece >> 4, d0 = (piece & 15) * 8;
        float f[8]; unpack8(*(const u32x4*)(qs + i * 136 + d0), f);
        const float e = egs[i];
        u32x4 w;
#pragma unroll
        for (int e2 = 0; e2 < 4; ++e2) w[e2] = pk2(f[2 * e2] * e, f[2 * e2 + 1] * e);
        *(u32x4*)(qd + i * 128 + d0) = w;
      }
      u16* kt = (u16*)(p.ws + OFF_GKT) + (size_t)it * 8192;
      const int dk = tid & 127, half = tid >> 7;
      const float gl = gcs[63];
#pragma unroll
      for (int c8 = 0; c8 < 4; ++c8) {
        u32x4 w;
#pragma unroll
        for (int e = 0; e < 4; ++e) {
          const int i0 = half * 32 + c8 * 8 + 2 * e;
          w[e] = pk2(bf2f(ks[i0 * 136 + dk]) * __expf(gl - gcs[i0]), bf2f(ks[(i0 + 1) * 136 + dk]) * __expf(gl - gcs[i0 + 1]));
        }
        *(u32x4*)(kt + dk * 64 + half * 32 + c8 * 8) = w;
      }
      if (tid == 0) ((float*)(p.ws + OFF_GSD))[it] = egs[63];
    }
    __syncthreads();
  }
}

__device__ __forceinline__ uint2 lds64(const char* p) { return *(const uint2*)p; }
__device__ __forceinline__ bf16x8 mk8(uint2 a, uint2 b) { u32x4 w = {a.x, a.y, b.x, b.y}; return __builtin_bit_cast(bf16x8, w); }
__device__ __forceinline__ bf16x8 pack8(const f32x16& x, int s) {
  u32x4 w = {pk2(x[8 * s], x[8 * s + 1]), pk2(x[8 * s + 2], x[8 * s + 3]), pk2(x[8 * s + 4], x[8 * s + 5]), pk2(x[8 * s + 6], x[8 * s + 7])};
  return __builtin_bit_cast(bf16x8, w);
}
__device__ __forceinline__ void gdn_scan_item(const Params& p, int bh, char* smem) {
  const int tid = otid(), wid = tid >> 6, lane = tid & 63, r32 = lane & 31, hi = lane >> 5;
  char* Wl = smem; char* QDl = smem + 16896; char* KTl = smem + 33792; char* ATl = smem + 51200;
  const int b = bh >> 2, h = bh & 3;
  const char* gw = p.ws + OFF_GW; const char* gqd = p.ws + OFF_GQD; const char* gkt = p.ws + OFF_GKT; const char* gat = p.ws + OFF_GAT;
  const u16* gut = (const u16*)(p.ws + OFF_GUT);
  const float* gsd = (const float*)(p.ws + OFF_GSD);
  f32x16 S[4];
#pragma unroll
  for (int T = 0; T < 4; ++T)
#pragma unroll
    for (int r = 0; r < 16; ++r) S[T][r] = 0.f;
  u32x4 st[14]; uint2 uc[8];
  const int dv = wid * 32 + r32;
#define G_LOAD(IT) do { const size_t o16 = (size_t)(IT) * 16384, o8 = (size_t)(IT) * 8192; \
    _Pragma("unroll") for (int k = 0; k < 4; ++k) { st[k] = *(const u32x4*)(gw + o16 + (tid + 256 * k) * 16); st[4 + k] = *(const u32x4*)(gqd + o16 + (tid + 256 * k) * 16); \
      st[8 + k] = *(const u32x4*)(gkt + o16 + (tid + 256 * k) * 16); } \
    _Pragma("unroll") for (int k = 0; k < 2; ++k) st[12 + k] = *(const u32x4*)(gat + o8 + (tid + 256 * k) * 16); } while (0)
#define U_LOAD(IT) do { _Pragma("unroll") for (int k = 0; k < 8; ++k) uc[k] = *(const uint2*)(gut + (size_t)(IT) * 8192 + dv * 64 + 32 * (k >> 2) + 8 * (k & 3) + 4 * hi); } while (0)
#define G_WRITE() do { \
    _Pragma("unroll") for (int k = 0; k < 4; ++k) { const int pc = tid + 256 * k; \
      { char* d = Wl + (pc >> 4) * 264 + (pc & 15) * 16; *(uint2*)d = uint2{st[k][0], st[k][1]}; *(uint2*)(d + 8) = uint2{st[k][2], st[k][3]}; } \
      { char* d = QDl + (pc >> 4) * 264 + (pc & 15) * 16; *(uint2*)d = uint2{st[4 + k][0], st[4 + k][1]}; *(uint2*)(d + 8) = uint2{st[4 + k][2], st[4 + k][3]}; } \
      { char* d = KTl + (pc >> 3) * 136 + (pc & 7) * 16; *(uint2*)d = uint2{st[8 + k][0], st[8 + k][1]}; *(uint2*)(d + 8) = uint2{st[8 + k][2], st[8 + k][3]}; } } \
    _Pragma("unroll") for (int k = 0; k < 2; ++k) { const int pc = tid + 256 * k; \
      char* d = ATl + (pc >> 3) * 136 + (pc & 7) * 16; *(uint2*)d = uint2{st[12 + k][0], st[12 + k][1]}; *(uint2*)(d + 8) = uint2{st[12 + k][2], st[12 + k][3]}; } } while (0)
  G_LOAD(bh * 128); U_LOAD(bh * 128); G_WRITE(); __syncthreads();
#pragma unroll 1
  for (int n = 0; n < 128; ++n) {
    const int item = bh * 128 + n;
    if (n + 1 < 128) G_LOAD(item + 1);
    f32x16 av[2], ao[2];
#pragma unroll
    for (int r = 0; r < 16; ++r) { av[0][r] = 0.f; av[1][r] = 0.f; ao[0][r] = 0.f; ao[1][r] = 0.f; }
#pragma unroll
    for (int T = 0; T < 4; ++T)
#pragma unroll
      for (int s = 0; s < 2; ++s) {
        const bf16x8 sb = pack8(S[T], s);
        const int cb = (32 * T + 16 * s + 4 * hi) * 2;
#pragma unroll
        for (int it = 0; it < 2; ++it) {
          const char* wp = Wl + (32 * it + r32) * 264 + cb; const char* qp = QDl + (32 * it + r32) * 264 + cb;
          av[it] = __builtin_amdgcn_mfma_f32_32x32x16_bf16(mk8(lds64(wp), lds64(wp + 16)), sb, av[it], 0, 0, 0);
          ao[it] = __builtin_amdgcn_mfma_f32_32x32x16_bf16(mk8(lds64(qp), lds64(qp + 16)), sb, ao[it], 0, 0, 0);
        }
      }
    bf16x8 vb[2][2];
#pragma unroll
    for (int it = 0; it < 2; ++it) {
      f32x16 vn;
#pragma unroll
      for (int g = 0; g < 4; ++g) {
        const uint2 u2 = uc[it * 4 + g];
        vn[4 * g] = __uint_as_float(u2.x << 16) - av[it][4 * g]; vn[4 * g + 1] = __uint_as_float(u2.x & 0xffff0000u) - av[it][4 * g + 1];
        vn[4 * g + 2] = __uint_as_float(u2.y << 16) - av[it][4 * g + 2]; vn[4 * g + 3] = __uint_as_float(u2.y & 0xffff0000u) - av[it][4 * g + 3];
      }
      vb[it][0] = pack8(vn, 0); vb[it][1] = pack8(vn, 1);
    }
    if (n + 1 < 128) U_LOAD(item + 1);
#pragma unroll
    for (int it2 = 0; it2 < 2; ++it2)
#pragma unroll
      for (int it = 0; it <= it2; ++it)
#pragma unroll
        for (int s = 0; s < 2; ++s) {
          const char* ap = ATl + (32 * it2 + r32) * 136 + (32 * it + 16 * s + 4 * hi) * 2;
          ao[it2] = __builtin_amdgcn_mfma_f32_32x32x16_bf16(mk8(lds64(ap), lds64(ap + 16)), vb[it][s], ao[it2], 0, 0, 0);
        }
    {
#pragma unroll
      for (int it = 0; it < 2; ++it) {
        float* op = (float*)((it ? p.ws + OFF_GQD : p.ws + OFF_GW) + (size_t)item * 16384) + dv;
#pragma unroll
        for (int r = 0; r < 16; ++r) op[crow(r, hi) * 128] = ao[it][r];
      }
    }
    const float sd = gsd[item];
#pragma unroll
    for (int T = 0; T < 4; ++T) {
#pragma unroll
      for (int r = 0; r < 16; ++r) S[T][r] *= sd;
#pragma unroll
      for (int it = 0; it < 2; ++it)
#pragma unroll
        for (int s = 0; s < 2; ++s) {
          const char* kp = KTl + (32 * T + r32) * 136 + (32 * it + 16 * s + 4 * hi) * 2;
          S[T] = __builtin_amdgcn_mfma_f32_32x32x16_bf16(mk8(lds64(kp), lds64(kp + 16)), vb[it][s], S[T], 0, 0, 0);
        }
    }
    __syncthreads();
    if (n + 1 < 128) G_WRITE();
    __syncthreads();
  }
#undef G_LOAD
#undef G_WRITE
#undef U_LOAD
}

__device__ __forceinline__ void gdn_normgate_phase(const Params& p, int bid, int nblk) {
  const int tid = otid(), wid = tid >> 6, lane = tid & 63;
  u16* concat = (u16*)(p.ws + OFF_HN);
  const u16* proj = (const u16*)(p.ws + OFF_PROJ);
  const f32x4 hw0 = *(const f32x4*)(p.hy_head_norm_w + (lane & 15) * 8), hw1 = *(const f32x4*)(p.hy_head_norm_w + (lane & 15) * 8 + 4);
#pragma unroll 1
  for (int row = bid * 4 + wid; row < M; row += nblk * 4) {
    const int l_ = row & (SEQ - 1), item_ = (((row >> 13) * 4 + (lane >> 4)) << 7) + (l_ >> 6), i_ = l_ & 63;
    const float* og = (const float*)(((i_ & 32) ? p.ws + OFF_GQD : p.ws + OFF_GW) + (size_t)item_ * 16384) + (i_ & 31) * 128 + (lane & 15) * 8;
    const f32x4 a0 = *(const f32x4*)(og), a1 = *(const f32x4*)(og + 4);
    float zf[8]; unpack8(*(const u32x4*)(proj + (size_t)row * PJ + 1536 + lane * 8), zf);
    float ss = a0[0] * a0[0] + a0[1] * a0[1] + a0[2] * a0[2] + a0[3] * a0[3] + a1[0] * a1[0] + a1[1] * a1[1] + a1[2] * a1[2] + a1[3] * a1[3];
#pragma unroll
    for (int o = 8; o >= 1; o >>= 1) ss += __shfl_xor(ss, o);
    const float rs = rsqrtf(ss * (1.f / 128.f) + 1e-6f);
    u32x4 w;
    w[0] = pk2(a0[0] * rs * hw0[0] * silu_(zf[0]), a0[1] * rs * hw0[1] * silu_(zf[1]));
    w[1] = pk2(a0[2] * rs * hw0[2] * silu_(zf[2]), a0[3] * rs * hw0[3] * silu_(zf[3]));
    w[2] = pk2(a1[0] * rs * hw1[0] * silu_(zf[4]), a1[1] * rs * hw1[1] * silu_(zf[5]));
    w[3] = pk2(a1[2] * rs * hw1[2] * silu_(zf[6]), a1[3] * rs * hw1[3] * silu_(zf[7]));
    *(u32x4*)(concat + a_off(row, lane * 8, 32)) = w;
  }
}

using s16x4 = __attribute__((ext_vector_type(4))) short;
#define KSWZ(row, colB) ((row) * 256 + ((colB) ^ (((row) & 7) << 4)))
#define SBAR() __builtin_amdgcn_sched_barrier(0)
__device__ __forceinline__ unsigned cvtpk(float lo, float hi) { unsigned r; asm volatile("v_cvt_pk_bf16_f32 %0, %1, %2" : "=v"(r) : "v"(lo), "v"(hi)); return r; }
__device__ __forceinline__ int v_st(int k, int c) { const int kk = (k & ~0xC) | ((k & 4) << 1) | ((k & 8) >> 1); return ((kk >> 3) * 4 + (c >> 5)) * 512 + ((kk & 7) * 32 + (c & 31)) * 2; }
__device__ __forceinline__ int v_rd_base(int lane) { return ((lane & 3) << 3) | (((lane >> 2) & 3) << 6) | (((lane >> 4) & 1) << 5) | (((lane >> 5) & 1) << 8); }
constexpr int v_rd_off(int d0, int ks, int half) { return d0 * 512 + ks * 4096 + half * 2048; }
template <int OFF> __device__ __forceinline__ s16x4 tr_read(int vb) {
  s16x4 r; asm volatile("ds_read_b64_tr_b16 %0, %1 offset:%2" : "=&v"(r) : "v"(vb), "i"(OFF) : "memory"); return r;
}
template <int D0> __device__ __forceinline__ void pv_one(f32x16& od, int vb, bf16x8 pa0, bf16x8 pa1, bf16x8 pa2, bf16x8 pa3) {
  const s16x4 l0 = tr_read<v_rd_off(D0, 0, 0)>(vb), h0 = tr_read<v_rd_off(D0, 0, 1)>(vb), l1 = tr_read<v_rd_off(D0, 1, 0)>(vb), h1 = tr_read<v_rd_off(D0, 1, 1)>(vb);
  const s16x4 l2 = tr_read<v_rd_off(D0, 2, 0)>(vb), h2 = tr_read<v_rd_off(D0, 2, 1)>(vb), l3 = tr_read<v_rd_off(D0, 3, 0)>(vb), h3 = tr_read<v_rd_off(D0, 3, 1)>(vb);
  asm volatile("s_waitcnt lgkmcnt(0)" ::: "memory"); SBAR();
#define PK(L, H) (bf16x8){L[0], L[1], L[2], L[3], H[0], H[1], H[2], H[3]}
  od = __builtin_amdgcn_mfma_f32_32x32x16_bf16(pa0, PK(l0, h0), od, 0, 0, 0);
  od = __builtin_amdgcn_mfma_f32_32x32x16_bf16(pa1, PK(l1, h1), od, 0, 0, 0);
  od = __builtin_amdgcn_mfma_f32_32x32x16_bf16(pa2, PK(l2, h2), od, 0, 0, 0);
  od = __builtin_amdgcn_mfma_f32_32x32x16_bf16(pa3, PK(l3, h3), od, 0, 0, 0);
#undef PK
}
__device__ __forceinline__ float pl32_other(float a, float b, int hi) {
  auto rr = __builtin_amdgcn_permlane32_swap(__float_as_uint(a), __float_as_uint(b), false, false);
  return __uint_as_float(hi ? rr[0] : rr[1]);
}
__device__ __forceinline__ void sb_half(f32x16& pz, float& run, bool need_mask, int kb, int t, int hi) {
  constexpr float C2 = 0.08838834764831845f * 1.4426950408889634f;
  f32x16 l;
#pragma unroll
  for (int r = 0; r < 16; ++r) {
    const float e = __builtin_amdgcn_exp2f(fminf(pz[r] * C2, 60.f));
    l[r] = __builtin_amdgcn_rcpf(1.f + e);
    pz[r] = e;
  }
  if (need_mask) {
#pragma unroll
    for (int r = 0; r < 16; ++r) { if (kb + crow(r, hi) >= t) { l[r] = 1.f; pz[r] = 0.f; } }
  }
#pragma unroll
  for (int g = 0; g < 4; ++g) { l[4 * g + 2] *= l[4 * g + 3]; l[4 * g + 1] *= l[4 * g + 2]; l[4 * g] *= l[4 * g + 1]; }
  const float cs3 = l[12], cs2 = l[8] * cs3, cs1 = l[4] * cs2, cs0 = l[0] * cs1;
  const float off0 = cs1 * pl32_other(cs0, cs1, hi) * run;
  const float off1 = cs2 * pl32_other(cs1, cs2, hi) * run;
  const float off2 = cs3 * pl32_other(cs2, cs3, hi) * run;
  const float off3 = pl32_other(cs3, 1.f, hi) * run;
  float tot;
  { auto rr = __builtin_amdgcn_permlane32_swap(__float_as_uint(cs0), __float_as_uint(cs0), false, false); tot = __uint_as_float(rr[0]) * __uint_as_float(rr[1]); }
#pragma unroll
  for (int r = 0; r < 4; ++r) {
    pz[r] = pz[r] * l[r] * off0; pz[4 + r] = pz[4 + r] * l[4 + r] * off1;
    pz[8 + r] = pz[8 + r] * l[8 + r] * off2; pz[12 + r] = pz[12 + r] * l[12 + r] * off3;
  }
  run *= tot;
}

__device__ __forceinline__ void attn_phase(const Params& p, char* smem, int bid, int nblk) {
  const int tid = otid(), wid = tid >> 6, lane = tid & 63, r32 = lane & 31, hi = lane >> 5;
  char* K_lds = smem; char* V_lds = smem + 16384;
  const u16* qkv = (const u16*)(p.ws + OFF_PROJ);
  u16* ao = (u16*)(p.ws + OFF_HN);
  const int sr = tid >> 4, sc = (tid & 15) * 8;
  const int vb0 = (int)(uintptr_t)V_lds + v_rd_base(lane);
  for (int k = 0; k * nblk < 2048; ++k) {
    const int i = (k & 1) ? ((k + 1) * nblk - 1 - bid) : (k * nblk + bid);
    if (i >= 2048) continue;
    const int j = 63 - (i >> 5), bh = i & 31, b = bh >> 3, h = bh & 7;
    const int i0 = j * 128;
    const size_t rowb = (size_t)b * SEQ;
    const int t = i0 + wid * 32 + r32, tmin = i0 + wid * 32, tmax = tmin + 31;
    bf16x8 qr[8];
    {
      const u16* qp = qkv + (rowb + t) * 3072 + h * 128 + hi * 8;
#pragma unroll
      for (int d0 = 0; d0 < 8; ++d0) qr[d0] = *(const bf16x8*)(qp + d0 * 16);
    }
    f32x16 o[4];
#pragma unroll
    for (int d = 0; d < 4; ++d)
#pragma unroll
      for (int r = 0; r < 16; ++r) o[d][r] = 0.f;
    float run = 1.f;
    const u16* kbase = qkv + rowb * 3072 + 1024 + h * 128 + sc;
    u32x4 stk[4], stv[4];
#define SLOAD(KT) do { _Pragma("unroll") for (int ii = 0; ii < 4; ++ii) { const u16* kp = kbase + (size_t)((KT) * 64 + sr + 16 * ii) * 3072; \
      stk[ii] = *(const u32x4*)kp; stv[ii] = *(const u32x4*)(kp + 1024); } } while (0)
#define SWRITE() do { _Pragma("unroll") for (int ii = 0; ii < 4; ++ii) { const int row = sr + 16 * ii; \
      *(u32x4*)(K_lds + KSWZ(row, sc * 2)) = stk[ii]; *(u32x4*)(V_lds + v_st(row, sc)) = stv[ii]; } } while (0)
    const int NT = 2 * j + 2;
    SLOAD(NT - 1); SWRITE(); __syncthreads();
    for (int kt = NT - 1; kt >= 0; --kt) {
      const int k0 = kt * 64;
      if (k0 <= tmax) {
        bf16x8 pa0, pa1, pa2, pa3;
#define PK4(P, BASE, OUT) do { unsigned a0 = cvtpk(P[BASE + 0], P[BASE + 1]), a1 = cvtpk(P[BASE + 2], P[BASE + 3]); \
    unsigned b0_ = cvtpk(P[BASE + 4], P[BASE + 5]), b1_ = cvtpk(P[BASE + 6], P[BASE + 7]); \
    auto r0 = __builtin_amdgcn_permlane32_swap(a0, b0_, false, false); auto r1 = __builtin_amdgcn_permlane32_swap(a1, b1_, false, false); \
    u32x4 w = {r0[0], r1[0], r0[1], r1[1]}; OUT = *reinterpret_cast<bf16x8*>(&w); } while (0)
        if (k0 + 32 <= tmax) {
          f32x16 pz;
#pragma unroll
          for (int r = 0; r < 16; ++r) pz[r] = 0.f;
#pragma unroll
          for (int d0 = 0; d0 < 8; ++d0) {
            const bf16x8 kf = *(const bf16x8*)(K_lds + KSWZ(32 + r32, (d0 * 16 + hi * 8) * 2));
            pz = __builtin_amdgcn_mfma_f32_32x32x16_bf16(kf, qr[d0], pz, 0, 0, 0);
          }
          sb_half(pz, run, k0 + 63 >= tmin, k0 + 32, t, hi);
          PK4(pz, 0, pa2); PK4(pz, 8, pa3);
        } else {
          pa2 = bf16x8{0, 0, 0, 0, 0, 0, 0, 0}; pa3 = pa2;
        }
        {
          f32x16 pz;
#pragma unroll
          for (int r = 0; r < 16; ++r) pz[r] = 0.f;
#pragma unroll
          for (int d0 = 0; d0 < 8; ++d0) {
            const bf16x8 kf = *(const bf16x8*)(K_lds + KSWZ(r32, (d0 * 16 + hi * 8) * 2));
            pz = __builtin_amdgcn_mfma_f32_32x32x16_bf16(kf, qr[d0], pz, 0, 0, 0);
          }
          sb_half(pz, run, k0 + 31 >= tmin, k0, t, hi);
          PK4(pz, 0, pa0); PK4(pz, 8, pa1);
        }
#undef PK4
        if (kt > 0) SLOAD(kt - 1);
        pv_one<0>(o[0], vb0, pa0, pa1, pa2, pa3); pv_one<1>(o[1], vb0, pa0, pa1, pa2, pa3);
        pv_one<2>(o[2], vb0, pa0, pa1, pa2, pa3); pv_one<3>(o[3], vb0, pa0, pa1, pa2, pa3);
      } else {
        if (kt > 0) SLOAD(kt - 1);
      }
      __syncthreads();
      if (kt > 0) SWRITE();
      __syncthreads();
    }
#undef SLOAD
#undef SWRITE
    {
      const int orow0 = (int)rowb + i0 + wid * 32;
#pragma unroll
      for (int r = 0; r < 16; ++r) {
        const int orow = crow(r, hi);
#pragma unroll
        for (int d0 = 0; d0 < 4; ++d0) ao[a_off(orow0 + orow, h * 128 + d0 * 32 + r32, 32)] = f2bf(o[d0][r]);
      }
    }
  }
}

__global__ void __launch_bounds__(256, 2) mega(Params p) {
  __shared__ __attribute__((aligned(16))) char smem[SMEM_BYTES];
  const int bid = blockIdx.x, nblk = gridDim.x;
  char* ws = p.ws;
  const float* mod = (const float*)(ws + OFF_MOD);
  u16* hn = (u16*)(ws + OFF_HN);
#define PH_BEGIN(n) if (p.phase_lo <= (n) && (n) < p.phase_hi) {
#define PH_END(n) if ((n) + 1 < p.phase_hi) cg::this_grid().sync(); }
  PH_BEGIN(0) phase0(p, smem, bid, nblk); PH_END(0)
  PH_BEGIN(1) norm_phase<1>(p, p.x, p.norm_mix_w, mod, 0, 1024, smem, bid, nblk); PH_END(1)
  PH_BEGIN(2) { EpiArgs ea{}; ea.outb = (u16*)(ws + OFF_PROJ); ea.ux = (u16*)(ws + OFF_UX);
        gemm_phase<E_PROJ0>(hn, 32, 0, (const u16*)(ws + OFF_WT_HYIN), 32, 0, 1024, M / 256, PN / 128, 1, ea, smem, bid, nblk); } PH_END(2)
  PH_BEGIN(3) { EpiArgs ea{}; ea.outf = (float*)(ws + OFF_XE);
        gemm_phase<E_XE>((const u16*)(ws + OFF_UX), 20, (size_t)S5C * UXW, (const u16*)(ws + OFF_EG), 16, (size_t)128 * 512, 512, S5C / 256, 1, 32, ea, smem, bid, nblk); } PH_END(3)
  PH_BEGIN(4) { s5_carry_phase(p, bid, nblk); gdn_prep_phase(p, smem, bid, nblk); } PH_END(4)
  PH_BEGIN(5) {
        if (bid < 16) { gdn_scan_item(p, bid, smem); }
        else { EpiArgs ea{}; ea.outb = (u16*)(ws + OFF_Y5); ea.ux = (u16*)(ws + OFF_UX); ea.bias = p.s5_d;
          gemm_phase<E_S5Y>((const u16*)(ws + OFF_UX), 20, (size_t)S5C * UXW, (const u16*)(ws + OFF_MF), 20, (size_t)512 * UXW, UXW, S5C / 256, 4, 32, ea, smem, bid - 16, nblk - 16); }
      } PH_END(5)
  PH_BEGIN(6) { gdn_normgate_phase(p, bid, nblk); } PH_END(6)
  PH_BEGIN(7) { EpiArgs ea{}; ea.outb = hn; ea.y5 = (const u16*)(ws + OFF_Y5); ea.bias = p.s5_glu_b;
        gemm_phase<E_GLU>((const u16*)(ws + OFF_Y5), 16, 0, (const u16*)(ws + OFF_WT_GLU), 16, 0, 512, M / 256, 4, 1, ea, smem, bid, nblk); } PH_END(7)
  PH_BEGIN(8) { EpiArgs ea{}; ea.outf = p.out; ea.res = p.x; ea.gate = mod + 2048;
        gemm_phase<E_RESID>(hn, 32, 0, (const u16*)(ws + OFF_WT_HYOUT), 32, 0, 1024, M / 256, 8, 1, ea, smem, bid, nblk); } PH_END(8)
  PH_BEGIN(9) norm_phase<0>(p, p.out, p.norm_ffn_w, mod, 3072, 4096, smem, bid, nblk); PH_END(9)
  PH_BEGIN(10) { EpiArgs ea{}; ea.outb = (u16*)(ws + OFF_PROJ);
        gemm_phase<E_SWIGLU>(hn, 32, 0, (const u16*)(ws + OFF_WT_FFNIN), 32, 0, 1024, M / 256, 2 * FF / 128, 1, ea, smem, bid, nblk); } PH_END(10)
  PH_BEGIN(11) { EpiArgs ea{}; ea.outf = p.out; ea.res = p.out; ea.gate = mod + 5120;
        gemm_phase<E_RESID>((const u16*)(ws + OFF_PROJ), FF / 32, 0, (const u16*)(ws + OFF_WT_FFNOUT), FF / 32, 0, FF, M / 256, 8, 1, ea, smem, bid, nblk); } PH_END(11)
  PH_BEGIN(12) norm_phase<0>(p, p.out, p.norm_mix_w + 1024, mod + 4 * 6144, 0, 1024, smem, bid, nblk); PH_END(12)
  PH_BEGIN(13) { EpiArgs ea{}; ea.outb = (u16*)(ws + OFF_PROJ); ea.ldc = 3072;
        gemm_phase<E_BF16>(hn, 32, 0, (const u16*)(ws + OFF_WT_SBIN), 32, 0, 1024, M / 256, 24, 1, ea, smem, bid, nblk); } PH_END(13)
  PH_BEGIN(14) attn_phase(p, smem, bid, nblk); PH_END(14)
  PH_BEGIN(15) { EpiArgs ea{}; ea.outf = p.out; ea.res = p.out; ea.gate = mod + 4 * 6144 + 2048;
        gemm_phase<E_RESID>(hn, 32, 0, (const u16*)(ws + OFF_WT_SBOUT), 32, 0, 1024, M / 256, 8, 1, ea, smem, bid, nblk); } PH_END(15)
  PH_BEGIN(16) norm_phase<0>(p, p.out, p.norm_ffn_w + 1024, mod + 4 * 6144, 3072, 4096, smem, bid, nblk); PH_END(16)
  PH_BEGIN(17) { EpiArgs ea{}; ea.outb = (u16*)(ws + OFF_PROJ);
        gemm_phase<E_SWIGLU>(hn, 32, 0, (const u16*)(ws + OFF_WT_FFNIN + SZ_WT_FFNIN), 32, 0, 1024, M / 256, 2 * FF / 128, 1, ea, smem, bid, nblk); } PH_END(17)
  PH_BEGIN(18) { EpiArgs ea{}; ea.outf = p.out; ea.res = p.out; ea.gate = mod + 4 * 6144 + 5120;
        gemm_phase<E_RESID>((const u16*)(ws + OFF_PROJ), FF / 32, 0, (const u16*)(ws + OFF_WT_FFNOUT + SZ_WT_FFNOUT), FF / 32, 0, FF, M / 256, 8, 1, ea, smem, bid, nblk); } PH_END(18)
  PH_BEGIN(19) norm_phase<2>(p, p.out, p.final_norm_w, mod, 0, 0, smem, bid, nblk); PH_END(19)
}

extern "C" void kernel_launch(void* const* d_in, const int* in_sizes, int n_in, void* d_out, int out_size, void* d_ws, size_t ws_size,
                              hipStream_t stream) {
  static int grid_blocks = 0;
  if (!grid_blocks) {
    int dev = 0, cus = 0, per_cu = 0;
    hipGetDevice(&dev);
    hipDeviceGetAttribute(&cus, hipDeviceAttributeMultiprocessorCount, dev);
    hipOccupancyMaxActiveBlocksPerMultiprocessor(&per_cu, mega, 256, 0);
    if (per_cu > 2) per_cu = 2;
    if (per_cu < 1) per_cu = 1;
    grid_blocks = cus * per_cu;
  }
  Params p{};
  const float* const* in = (const float* const*)d_in;
  p.x = in[0]; p.c = in[1]; p.ada_w = in[2]; p.ada_b = in[3]; p.norm_mix_w = in[4]; p.norm_ffn_w = in[5]; p.ffn_w_in = in[6]; p.ffn_w_out = in[7];
  p.hy_w_in = in[8]; p.hy_conv_w = in[9]; p.hy_a_log = in[10]; p.hy_dt_bias = in[11]; p.hy_head_norm_w = in[12];
  p.s5_lam_re = in[13]; p.s5_lam_im = in[14]; p.s5_log_dt = in[15]; p.s5_b_re = in[16]; p.s5_b_im = in[17]; p.s5_c_re = in[18]; p.s5_c_im = in[19];
  p.s5_d = in[20]; p.s5_glu_w = in[21]; p.s5_glu_b = in[22]; p.hy_w_out = in[23]; p.sb_w_in = in[24]; p.sb_w_out = in[25]; p.final_norm_w = in[26];
  p.out = (float*)d_out; p.ws = (char*)d_ws;
#if ONE_LAUNCH
  p.phase_lo = 0; p.phase_hi = NPHASE;
  void* args[] = {&p};
  hipError_t e = hipLaunchCooperativeKernel((void*)mega, dim3(grid_blocks), dim3(256), args, 0, stream);
  if (e != hipSuccess) fprintf(stderr, "cooperative launch failed: %s (grid %d)\n", hipGetErrorString(e), grid_blocks);
#else
  for (int ph = 0; ph < NPHASE; ++ph) {
    p.phase_lo = ph; p.phase_hi = ph + 1;
    hipLaunchKernelGGL(mega, dim3(grid_blocks), dim3(256), 0, stream, p);
  }
#endif
}
```

```cpp
#include <hip/hip_runtime.h>
#include <hip/hip_cooperative_groups.h>
#include <stdint.h>
#include <cstdio>
namespace cg = cooperative_groups;

#ifndef ONE_LAUNCH
#define ONE_LAUNCH 1
#endif

typedef unsigned short u16;
using bf16x8 = __attribute__((ext_vector_type(8))) short;
using f32x4 = __attribute__((ext_vector_type(4))) float;
using u32x4 = __attribute__((ext_vector_type(4))) unsigned;

constexpr int D = 1024, NB = 4, SEQ = 8192, M = NB * SEQ, FF = 2816, EIN = 2568, PN = 2560, PJ = 2048;
constexpr int NPHASE = 20;
constexpr int XCD_BAR_WORDS_C = 3456;
constexpr int S5T = 32, S5C = M / S5T, UXW = 640;

constexpr size_t SZ_WT_HYIN = (size_t)PN * 1024 * 2, SZ_WT_SQ = (size_t)1024 * 1024 * 2, SZ_WT_GLU = (size_t)512 * 512 * 2;
constexpr size_t SZ_WT_FFNIN = (size_t)2 * FF * 1024 * 2, SZ_WT_FFNOUT = (size_t)1024 * FF * 2, SZ_WT_SBIN = (size_t)3072 * 1024 * 2;
constexpr size_t OFF_WT_HYIN = 0;
constexpr size_t OFF_WT_HYOUT = OFF_WT_HYIN + SZ_WT_HYIN;
constexpr size_t OFF_WT_GLU = OFF_WT_HYOUT + SZ_WT_SQ;
constexpr size_t OFF_WT_FFNIN = OFF_WT_GLU + SZ_WT_GLU;
constexpr size_t OFF_WT_FFNOUT = OFF_WT_FFNIN + 2 * SZ_WT_FFNIN;
constexpr size_t OFF_WT_SBIN = OFF_WT_FFNOUT + 2 * SZ_WT_FFNOUT;
constexpr size_t OFF_WT_SBOUT = OFF_WT_SBIN + SZ_WT_SBIN;
constexpr size_t OFF_MOD = OFF_WT_SBOUT + SZ_WT_SQ;
constexpr size_t OFF_BETA = OFF_MOD + (size_t)2 * 4 * 6144 * 4;
constexpr size_t OFF_G = OFF_BETA + (size_t)M * 4 * 4;
constexpr size_t OFF_HN = OFF_G + (size_t)M * 4 * 4;
constexpr size_t OFF_Y5 = OFF_HN + (size_t)M * 1024 * 2;
constexpr size_t OFF_UX = OFF_Y5 + (size_t)M * 512 * 2;
constexpr size_t OFF_MF = OFF_UX + (size_t)32 * S5C * UXW * 2;
constexpr size_t OFF_EG = OFF_MF + (size_t)32 * 512 * UXW * 2;
constexpr size_t OFF_XE = OFF_EG + (size_t)32 * 128 * 512 * 2;
constexpr size_t OFF_A32 = OFF_XE + (size_t)32 * S5C * 128 * 4;
constexpr size_t OFF_PROJ = OFF_A32 + (size_t)32 * 64 * 2 * 4;
constexpr size_t OFF_GW = OFF_PROJ + (size_t)M * PJ * 2;
constexpr size_t OFF_GQD = OFF_GW + (size_t)2048 * 8192 * 2;
constexpr size_t OFF_GKT = OFF_GQD + (size_t)2048 * 8192 * 2;
constexpr size_t OFF_GUT = OFF_GKT + (size_t)2048 * 8192 * 2;
constexpr size_t OFF_GAT = OFF_GUT + (size_t)2048 * 8192 * 2;
constexpr size_t OFF_GSD = OFF_GAT + (size_t)2048 * 4096 * 2;
constexpr size_t OFF_BAR = OFF_GSD + (size_t)2048 * 4;
constexpr size_t WS_TOTAL = OFF_BAR + (size_t)XCD_BAR_WORDS_C * 4;
static_assert((size_t)M * 3072 * 2 <= WS_TOTAL - OFF_PROJ, "QKV alias");
static_assert(WS_TOTAL <= (size_t)512 * 1024 * 1024, "workspace too large");

struct Params {
  const float *x, *c, *ada_w, *ada_b, *norm_mix_w, *norm_ffn_w, *ffn_w_in, *ffn_w_out;
  const float *hy_w_in, *hy_conv_w, *hy_a_log, *hy_dt_bias, *hy_head_norm_w;
  const float *s5_lam_re, *s5_lam_im, *s5_log_dt, *s5_b_re, *s5_b_im, *s5_c_re, *s5_c_im, *s5_d, *s5_glu_w, *s5_glu_b, *hy_w_out;
  const float *sb_w_in, *sb_w_out, *final_norm_w;
  float* out;
  char* ws;
  int phase_lo, phase_hi;
};

constexpr int SMEM_BYTES = 73728;

__device__ __forceinline__ int otid() { int t = __builtin_amdgcn_workitem_id_x(); asm volatile("" : "+v"(t)); return t; }
__device__ __forceinline__ u16 f2bf(float x) { unsigned u = __float_as_uint(x); u += 0x7fffu + ((u >> 16) & 1u); return (u16)(u >> 16); }
typedef __bf16 bf16v2 __attribute__((ext_vector_type(2)));
typedef float f32v2 __attribute__((ext_vector_type(2)));
__device__ __forceinline__ unsigned pk2(float a, float b) { f32v2 v = {a, b}; bf16v2 r = __builtin_convertvector(v, bf16v2); return __builtin_bit_cast(unsigned, r); }
__device__ __forceinline__ float bf2f(u16 v) { return __uint_as_float(((unsigned)v) << 16); }
__device__ __forceinline__ float sigmoid_(float x) { return 1.f / (1.f + __expf(-x)); }
__device__ __forceinline__ float silu_(float x) { return x * sigmoid_(x); }
__device__ __forceinline__ float softplus_(float x) { return fmaxf(x, 0.f) + log1pf(__expf(-fabsf(x))); }
__device__ __forceinline__ float gelu_tanh_(float y) { return 0.5f * y * (1.f + tanhf(0.7978845608028654f * (y + 0.044715f * y * y * y))); }

__device__ __forceinline__ size_t a_off(int row, int col, int nks) { return ((size_t)((row >> 8) * nks + (col >> 5)) << 13) + ((row & 255) << 5) + (col & 31); }
__device__ __forceinline__ size_t b_off(int n, int k, int nks) { return ((size_t)((n >> 7) * nks + (k >> 5)) << 12) + ((n & 127) << 5) + (k & 31); }

struct TrJob { const float* src; u16* dst; int K, Nsrc, Nd, mode; };
__device__ __forceinline__ TrJob get_job(const Params& p, int j) {
  TrJob t;
  switch (j) {
    case 0: t = {p.hy_w_in, (u16*)(p.ws + OFF_WT_HYIN), 1024, EIN, PN, 1}; break;
    case 1: t = {p.hy_w_out, (u16*)(p.ws + OFF_WT_HYOUT), 1024, 1024, 1024, 0}; break;
    case 2: t = {p.s5_glu_w, (u16*)(p.ws + OFF_WT_GLU), 512, 512, 512, 0}; break;
    case 3: t = {p.ffn_w_in, (u16*)(p.ws + OFF_WT_FFNIN), 1024, 2 * FF, 2 * FF, 2}; break;
    case 4: t = {p.ffn_w_in + (size_t)1024 * 2 * FF, (u16*)(p.ws + OFF_WT_FFNIN + SZ_WT_FFNIN), 1024, 2 * FF, 2 * FF, 2}; break;
    case 5: t = {p.ffn_w_out, (u16*)(p.ws + OFF_WT_FFNOUT), FF, 1024, 1024, 0}; break;
    case 6: t = {p.ffn_w_out + (size_t)FF * 1024, (u16*)(p.ws + OFF_WT_FFNOUT + SZ_WT_FFNOUT), FF, 1024, 1024, 0}; break;
    case 7: t = {p.sb_w_in, (u16*)(p.ws + OFF_WT_SBIN), 1024, 3072, 3072, 0}; break;
    default: t = {p.sb_w_out, (u16*)(p.ws + OFF_WT_SBOUT), 1024, 1024, 1024, 0}; break;
  }
  return t;
}
__device__ __forceinline__ int src_col(int R, int mode) {
  if (mode == 0) return R;
  if (mode == 1) return R < 2048 ? R : R + 8;
  return ((R >> 4) & 1) * FF + (R >> 5) * 16 + (R & 15);
}
constexpr int N_TR_ITEMS = 640 + 256 + 64 + 2 * 1408 + 2 * 704 + 768 + 256;
constexpr int N_MOD_ITEMS = 2 * 6144 / 16;

__device__ __forceinline__ void s5_table_item(const Params& p, int item, char* smem) {
  const int tid = otid(), g = item >> 5, tau = item & 31;
  float* pwr = (float*)smem; float* pwi = pwr + 64; float* p1r = pwi + 64; float* p1i = p1r + 64;
  float* bbr = p1i + 64; float* bbi = bbr + 1024; float* cre = bbi + 1024; float* cim = cre + 1024;
  const float dt = expf(p.s5_log_dt[g]);
  if (tid < 64) {
    const float lr = p.s5_lam_re[g * 64 + tid], li = p.s5_lam_im[g * 64 + tid];
    float sn, cs;
    float mg = expf(lr * dt * (float)tau); sincosf(li * dt * (float)tau, &sn, &cs); pwr[tid] = mg * cs; pwi[tid] = mg * sn;
    mg = expf(lr * dt * (float)(tau + 1)); sincosf(li * dt * (float)(tau + 1), &sn, &cs); p1r[tid] = mg * cs; p1i[tid] = mg * sn;
    if (tau == 31) { float* a32 = (float*)(p.ws + OFF_A32); a32[(g * 64 + tid) * 2] = mg * cs; a32[(g * 64 + tid) * 2 + 1] = mg * sn; }
  }
  {
    const int pp = tid >> 2, hq = (tid & 3) * 4;
    const float lr = p.s5_lam_re[g * 64 + pp], li = p.s5_lam_im[g * 64 + pp];
    const float mg = expf(lr * dt); float sn, cs; sincosf(li * dt, &sn, &cs);
    const float ar = mg * cs, ai = mg * sn, den = lr * lr + li * li, nr = ar - 1.f, ni = ai;
    const float fre = (nr * lr + ni * li) / den, fim = (ni * lr - nr * li) / den;
#pragma unroll
    for (int e = 0; e < 4; ++e) {
      const float br = p.s5_b_re[(size_t)(g * 64 + pp) * 16 + hq + e], bi = p.s5_b_im[(size_t)(g * 64 + pp) * 16 + hq + e];
      bbr[pp * 16 + hq + e] = fre * br - fim * bi; bbi[pp * 16 + hq + e] = fre * bi + fim * br;
    }
    for (int i = tid; i < 1024; i += 256) { cre[i] = p.s5_c_re[(size_t)g * 1024 + i]; cim[i] = p.s5_c_im[(size_t)g * 1024 + i]; }
  }
  __syncthreads();
  u16* mf = (u16*)(p.ws + OFF_MF) + (size_t)g * 512 * UXW;
  u16* eg = (u16*)(p.ws + OFF_EG) + (size_t)g * 128 * 512;
  {
    const int h = tid >> 4, hp = tid & 15;
    float kv = 0.f;
    for (int pp = 0; pp < 64; ++pp) {
      const float cr = cre[h * 64 + pp], ci = cim[h * 64 + pp], pr = pwr[pp], pi = pwi[pp];
      kv += (cr * pr - ci * pi) * bbr[pp * 16 + hp] - (cr * pi + ci * pr) * bbi[pp * 16 + hp];
    }
    const u16 kb = f2bf(kv);
    for (int s0 = 0; s0 + tau < 32; ++s0) mf[b_off((s0 + tau) * 16 + h, s0 * 16 + hp, 20)] = kb;
    for (int t0 = 0; t0 + tau + 1 < 32; ++t0) mf[b_off(t0 * 16 + h, (t0 + tau + 1) * 16 + hp, 20)] = 0;
#pragma unroll
    for (int e = 0; e < 4; ++e) {
      const int pp = hp * 4 + e;
      const float cr = cre[h * 64 + pp], ci = cim[h * 64 + pp], pr = p1r[pp], pi = p1i[pp];
      mf[b_off(tau * 16 + h, 512 + pp, 20)] = f2bf(cr * pr - ci * pi);
      mf[b_off(tau * 16 + h, 576 + pp, 20)] = f2bf(-(cr * pi + ci * pr));
    }
  }
  {
    const int pp = tid >> 2, hq = (tid & 3) * 4, s0 = 31 - tau;
#pragma unroll
    for (int e = 0; e < 4; ++e) {
      const float br = bbr[pp * 16 + hq + e], bi = bbi[pp * 16 + hq + e], pr = pwr[pp], pi = pwi[pp];
      eg[b_off(pp, s0 * 16 + hq + e, 16)] = f2bf(pr * br - pi * bi);
      eg[b_off(64 + pp, s0 * 16 + hq + e, 16)] = f2bf(pr * bi + pi * br);
    }
  }
  __syncthreads();
}

__device__ __forceinline__ void phase0(const Params& p, char* smem, int bid, int nblk) {
  const int tid = otid();
  for (int it = bid; it < N_TR_ITEMS + N_MOD_ITEMS + 1024; it += nblk) {
    if (it >= N_TR_ITEMS + N_MOD_ITEMS) { s5_table_item(p, it - N_TR_ITEMS - N_MOD_ITEMS, smem); continue; }
    if (it < N_TR_ITEMS) {
      int rem = it, j = 0; TrJob jb;
      for (;; ++j) { jb = get_job(p, j); int n = (jb.Nd >> 6) * (jb.K >> 6); if (rem < n) break; rem -= n; }
      const int nk = jb.K >> 6, R0 = (rem / nk) * 64, k0 = (rem % nk) * 64;
      u16* s = (u16*)smem;
      {
        const int r = tid & 63, kk = tid >> 6;
        const float* sp = jb.src + (size_t)k0 * jb.Nsrc + src_col(R0 + r, jb.mode);
#pragma unroll
        for (int i = 0; i < 16; ++i) { int k = kk + 4 * i; s[r * 72 + k] = f2bf(sp[(size_t)k * jb.Nsrc]); }
      }
      __syncthreads();
      {
        const int r = tid >> 2, ch = tid & 3;
#pragma unroll
        for (int i = 0; i < 2; ++i) {
          int c8 = (ch + 4 * i) * 8;
          *(u32x4*)(jb.dst + b_off(R0 + r, k0 + c8, jb.K >> 5)) = *(const u32x4*)(s + r * 72 + c8);
        }
      }
      __syncthreads();
    } else {
      const int mi = it - N_TR_ITEMS, l = mi / 384, n0 = (mi % 384) * 16;
      float* cact = (float*)smem;
      float* red = cact + 4096;
      for (int i = tid; i < 4096; i += 256) cact[i] = silu_(p.c[i]);
      __syncthreads();
      const int cl = tid & 15, ksub = tid >> 4;
      float a0 = 0, a1 = 0, a2 = 0, a3 = 0;
      const float* wp = p.ada_w + (size_t)l * 1024 * 6144 + n0 + cl;
#pragma unroll 16
      for (int k = ksub * 64; k < ksub * 64 + 64; ++k) {
        float w = wp[(size_t)k * 6144];
        a0 += cact[k] * w; a1 += cact[1024 + k] * w; a2 += cact[2048 + k] * w; a3 += cact[3072 + k] * w;
      }
      red[(ksub * 4 + 0) * 16 + cl] = a0; red[(ksub * 4 + 1) * 16 + cl] = a1;
      red[(ksub * 4 + 2) * 16 + cl] = a2; red[(ksub * 4 + 3) * 16 + cl] = a3;
      __syncthreads();
      if (tid < 64) {
        const int b = tid >> 4;
        float sum = 0.f;
#pragma unroll
        for (int q = 0; q < 16; ++q) sum += red[(q * 4 + b) * 16 + cl];
        float* mod = (float*)(p.ws + OFF_MOD);
        mod[(size_t)(l * 4 + b) * 6144 + n0 + cl] = sum + p.ada_b[l * 6144 + n0 + cl];
      }
      __syncthreads();
    }
  }
}

template <int MODE>
__device__ __forceinline__ void norm_phase(const Params& p, const float* src, const float* w, const float* modl, int sh_off, int sc_off,
                           char* smem, int bid, int nblk) {
  const int tid = otid(), wid = tid >> 6, lane = tid & 63;
  float* wba = (float*)smem;
  if (MODE == 1) {
    for (int i = tid; i < 1024 * 8; i += 256) wba[i] = p.hy_w_in[(size_t)(i >> 3) * EIN + 2048 + (i & 7)];
    __syncthreads();
  }
  u16* hn = (u16*)(p.ws + OFF_HN);
  auto process = [&](int row, f32x4 (&v)[4]) {
    float ss = 0.f;
#pragma unroll
    for (int i = 0; i < 4; ++i) ss += v[i][0] * v[i][0] + v[i][1] * v[i][1] + v[i][2] * v[i][2] + v[i][3] * v[i][3];
#pragma unroll
    for (int o = 32; o >= 1; o >>= 1) ss += __shfl_xor(ss, o);
    const float rstd = rsqrtf(ss * (1.f / 1024.f) + 1e-6f);
    const int b = row >> 13;
    float dots[8];
    if (MODE == 1) { for (int j = 0; j < 8; ++j) dots[j] = 0.f; }
#pragma unroll
    for (int i = 0; i < 4; ++i) {
      const int c0 = i * 256 + lane * 4;
      f32x4 ww = *(const f32x4*)(w + c0);
      f32x4 y;
      if (MODE == 2) {
#pragma unroll
        for (int e = 0; e < 4; ++e) y[e] = v[i][e] * rstd * ww[e];
        *(f32x4*)(p.out + (size_t)row * 1024 + c0) = y;
      } else {
        f32x4 sc = *(const f32x4*)(modl + (size_t)b * 6144 + sc_off + c0);
        f32x4 sh = *(const f32x4*)(modl + (size_t)b * 6144 + sh_off + c0);
#pragma unroll
        for (int e = 0; e < 4; ++e) y[e] = v[i][e] * rstd * ww[e] * (1.f + sc[e]) + sh[e];
        uint2 pk; pk.x = (unsigned)f2bf(y[0]) | ((unsigned)f2bf(y[1]) << 16); pk.y = (unsigned)f2bf(y[2]) | ((unsigned)f2bf(y[3]) << 16);
        *(uint2*)(hn + a_off(row, c0, 32)) = pk;
        if (MODE == 1) {
#pragma unroll
          for (int e = 0; e < 4; ++e) {
            f32x4 w0 = *(const f32x4*)(wba + (c0 + e) * 8), w1 = *(const f32x4*)(wba + (c0 + e) * 8 + 4);
#pragma unroll
            for (int j = 0; j < 4; ++j) { dots[j] += y[e] * w0[j]; dots[4 + j] += y[e] * w1[j]; }
          }
        }
      }
    }
    if (MODE == 1) {
#pragma unroll
      for (int j = 0; j < 8; ++j) {
#pragma unroll
        for (int o = 32; o >= 1; o >>= 1) dots[j] += __shfl_xor(dots[j], o);
      }
      if (lane == 0) {
        float* beta = (float*)(p.ws + OFF_BETA); float* gg = (float*)(p.ws + OFF_G);
#pragma unroll
        for (int h = 0; h < 4; ++h) {
          beta[(size_t)row * 4 + h] = sigmoid_(dots[h]);
          gg[(size_t)row * 4 + h] = -__expf(p.hy_a_log[h]) * softplus_(dots[4 + h] + p.hy_dt_bias[h]);
        }
      }
    }
  };
#pragma unroll 1
  for (int row = bid * 4 + wid; row < M; row += nblk * 8) {
    const int row1 = row + nblk * 4;
    const bool has1 = row1 < M;
    f32x4 v0[4], v1[4];
#pragma unroll
    for (int i = 0; i < 4; ++i) v0[i] = *(const f32x4*)(src + (size_t)row * 1024 + i * 256 + lane * 4);
#pragma unroll
    for (int i = 0; i < 4; ++i) v1[i] = has1 ? *(const f32x4*)(src + (size_t)row1 * 1024 + i * 256 + lane * 4) : f32x4{0.f, 0.f, 0.f, 0.f};
    process(row, v0);
    if (has1) process(row1, v1);
  }
}

enum { E_PROJ0 = 0, E_BF16 = 1, E_RESID = 2, E_GLU = 3, E_SWIGLU = 4, E_XE = 5, E_S5Y = 6 };
struct EpiArgs { float* outf; u16* outb; const float* res; const float* gate; const u16* y5; const float* bias; u16* ux; int ldc; };

template <int EPI>
__device__ __forceinline__ void gemm_phase(const u16* __restrict__ A0, int nksA, size_t sA, const u16* __restrict__ B0, int nksB, size_t sB,
                                           int K, int nM, int nN, int nbatch, const EpiArgs ea, char* smem, int bid, int nblk) {
  const int tid = otid(), wid = tid >> 6, lane = tid & 63, wr = wid >> 1, wc = wid & 1, fr = lane & 15, fq = lane >> 4;
  char* SA = smem; char* SB = smem + 49152;
  const int NR = nbatch * nM, ntiles = NR * nN;
  const int STN = (nN & 7) == 0 ? 8 : ((nN & 3) == 0 ? 4 : 1), STM = 64 / STN, nSN = nN / STN;
  const bool swz = ((nblk & 7) == 0) && (NR % STM == 0);
  const int lpx = nblk >> 3;
  int si = bid & 7, l = bid >> 3, tl = bid;
#pragma unroll 1
  for (;;) {
    int R, pn;
    if (swz) {
      if (si >= (NR / STM) * nSN) break;
      R = (si / nSN) * STM + l / STN; pn = (si % nSN) * STN + l % STN;
      l += lpx; if (l >= 64) { l = bid >> 3; si += 8; }
    } else {
      if (tl >= ntiles) break;
      R = tl / nN; pn = tl % nN; tl += nblk;
    }
    const int g = R / nM, rt = R % nM, brow = rt << 8, bcol = pn << 7;
    const char* A = (const char*)(A0 + (size_t)g * sA) + ((size_t)rt * nksA << 14) + tid * 16;
    const char* Bt = (const char*)(B0 + (size_t)g * sB) + ((size_t)pn * nksB << 13) + tid * 16;
    int nk = K >> 5, klim = nk;
    if (EPI == E_S5Y) { klim = 4 * (pn + 1); nk = klim + 4; }
    f32x4 acc[8][4];
#pragma unroll
    for (int m = 0; m < 8; ++m)
#pragma unroll
      for (int n = 0; n < 4; ++n) acc[m][n] = f32x4{0.f, 0.f, 0.f, 0.f};
#define GSTAGE(KK, BUF) do { const int kt_ = (EPI == E_S5Y && (KK) >= klim) ? (16 + (KK) - klim) : (KK); \
      _Pragma("unroll") for (int i = 0; i < 4; ++i) \
        __builtin_amdgcn_global_load_lds((const unsigned*)(A + ((size_t)kt_ << 14) + i * 4096), (__attribute__((address_space(3))) unsigned*)(SA + (BUF) * 16384 + tid * 16 + i * 4096), 16, 0, 0); \
      _Pragma("unroll") for (int i = 0; i < 2; ++i) \
        __builtin_amdgcn_global_load_lds((const unsigned*)(Bt + ((size_t)kt_ << 13) + i * 4096), (__attribute__((address_space(3))) unsigned*)(SB + (BUF) * 8192 + tid * 16 + i * 4096), 16, 0, 0); } while (0)
    asm volatile("s_waitcnt vmcnt(0)" ::: "memory");
    GSTAGE(0, 0);
    if (nk > 1) { GSTAGE(1, 1); asm volatile("s_waitcnt vmcnt(6)\n\ts_barrier" ::: "memory"); }
    else { asm volatile("s_waitcnt vmcnt(0)\n\ts_barrier" ::: "memory"); }
    int buf = 0, nbuf = 2;
#pragma unroll 1
    for (int kk = 0; kk < nk; ++kk) {
      const bool more = kk + 2 < nk;
      if (more) GSTAGE(kk + 2, nbuf);
      bf16x8 Bl[4], At[8];
#pragma unroll
      for (int n = 0; n < 4; ++n) Bl[n] = *(const bf16x8*)(SB + buf * 8192 + (wc * 64 + n * 16 + fr) * 64 + fq * 16);
#pragma unroll
      for (int m = 0; m < 8; ++m) At[m] = *(const bf16x8*)(SA + buf * 16384 + (wr * 128 + m * 16 + fr) * 64 + fq * 16);
#pragma unroll
      for (int m = 0; m < 8; ++m)
#pragma unroll
        for (int n = 0; n < 4; ++n) acc[m][n] = __builtin_amdgcn_mfma_f32_16x16x32_bf16(Bl[n], At[m], acc[m][n], 0, 0, 0);
      if (more) asm volatile("s_waitcnt vmcnt(6)\n\ts_barrier" ::: "memory");
      else asm volatile("s_waitcnt vmcnt(0)\n\ts_barrier" ::: "memory");
      buf = (buf == 2) ? 0 : buf + 1; nbuf = (nbuf == 2) ? 0 : nbuf + 1;
    }
#undef GSTAGE
#pragma unroll
    for (int m = 0; m < 8; ++m)
#pragma unroll
      for (int n = 0; n < 4; ++n) {
        const int row = brow + wr * 128 + m * 16 + fr, col = bcol + wc * 64 + n * 16 + fq * 4;
        const f32x4 v = acc[m][n];
        if (EPI == E_PROJ0) {
          const uint2 pk = uint2{pk2(v[0], v[1]), pk2(v[2], v[3])};
          if (bcol < 2048) *(uint2*)(ea.outb + (size_t)row * PJ + col) = pk;
          else { const int cc = col - 2048; *(uint2*)(ea.ux + (size_t)(cc >> 4) * S5C * UXW + a_off(row >> 5, (row & 31) * 16 + (cc & 15), 20)) = pk; }
        }
        if (EPI == E_BF16) *(uint2*)(ea.outb + (size_t)row * ea.ldc + col) = uint2{pk2(v[0], v[1]), pk2(v[2], v[3])};
        if (EPI == E_RESID) {
          const size_t idx = (size_t)row * 1024 + col;
          const f32x4 r4 = *(const f32x4*)(ea.res + idx), g4 = *(const f32x4*)(ea.gate + (size_t)(row >> 13) * 6144 + col);
          *(f32x4*)(ea.outf + idx) = f32x4{r4[0] + g4[0] * v[0], r4[1] + g4[1] * v[1], r4[2] + g4[2] * v[2], r4[3] + g4[3] * v[3]};
        }
        if (EPI == E_GLU) {
          const uint2 yy = *(const uint2*)(ea.y5 + a_off(row, col, 16));
          const f32x4 b4 = *(const f32x4*)(ea.bias + col);
          const float y0 = __uint_as_float(yy.x << 16), y1 = __uint_as_float(yy.x & 0xffff0000u), y2 = __uint_as_float(yy.y << 16), y3 = __uint_as_float(yy.y & 0xffff0000u);
          *(uint2*)(ea.outb + a_off(row, 512 + col, 32)) = uint2{pk2(y0 * sigmoid_(v[0] + b4[0]), y1 * sigmoid_(v[1] + b4[1])), pk2(y2 * sigmoid_(v[2] + b4[2]), y3 * sigmoid_(v[3] + b4[3]))};
        }
        if (EPI == E_SWIGLU) {
          if ((n & 1) == 0) {
            const f32x4 u = acc[m][n | 1];
            const int co = (bcol >> 1) + wc * 32 + (n >> 1) * 16 + fq * 4;
            *(uint2*)(ea.outb + a_off(row, co, FF / 32)) = uint2{pk2(silu_(v[0]) * u[0], silu_(v[1]) * u[1]), pk2(silu_(v[2]) * u[2], silu_(v[3]) * u[3])};
          }
        }
        if (EPI == E_XE) *(f32x4*)(ea.outf + ((size_t)g * S5C + row) * 128 + col) = v;
        if (EPI == E_S5Y) {
          const uint2 uu = *(const uint2*)(ea.ux + (size_t)g * S5C * UXW + a_off(row, col, 20));
          const f32x4 d4 = *(const f32x4*)(ea.bias + g * 16 + (col & 15));
          const float u0 = __uint_as_float(uu.x << 16), u1 = __uint_as_float(uu.x & 0xffff0000u), u2 = __uint_as_float(uu.y << 16), u3 = __uint_as_float(uu.y & 0xffff0000u);
          *(uint2*)(ea.outb + a_off(row * 32 + (col >> 4), g * 16 + (col & 15), 16)) =
              uint2{pk2(gelu_tanh_(v[0] + d4[0] * u0), gelu_tanh_(v[1] + d4[1] * u1)), pk2(gelu_tanh_(v[2] + d4[2] * u2), gelu_tanh_(v[3] + d4[3] * u3))};
        }
      }
  }
}

__device__ __forceinline__ void s5_carry_phase(const Params& p, int bid, int nblk) {
  const float* xe = (const float*)(p.ws + OFF_XE); const float* a32 = (const float*)(p.ws + OFF_A32);
  u16* ux = (u16*)(p.ws + OFF_UX);
  for (int it = bid; it < 32; it += nblk) {
    const int idx = it * 256 + otid(), pp = idx & 63, g = (idx >> 6) & 31, b = idx >> 11;
    const float ar = a32[(g * 64 + pp) * 2], ai = a32[(g * 64 + pp) * 2 + 1];
    float xr = 0.f, xi = 0.f;
    const size_t cbase = (size_t)g * S5C + b * 256, gbase = (size_t)g * S5C * UXW;
    for (int n = 0; n < 256; n += 8) {
      float er[8], ei[8];
#pragma unroll
      for (int e = 0; e < 8; ++e) { er[e] = xe[(cbase + n + e) * 128 + pp]; ei[e] = xe[(cbase + n + e) * 128 + 64 + pp]; }
#pragma unroll
      for (int e = 0; e < 8; ++e) {
        ux[gbase + a_off(b * 256 + n + e, 512 + pp, 20)] = f2bf(xr); ux[gbase + a_off(b * 256 + n + e, 576 + pp, 20)] = f2bf(xi);
        const float nr = ar * xr - ai * xi + er[e], ni = ar * xi + ai * xr + ei[e];
        xr = nr; xi = ni;
      }
    }
  }
}

__device__ __forceinline__ int crow(int r, int hi) { return (r & 3) + 8 * (r >> 2) + 4 * hi; }
using f32x16 = __attribute__((ext_vector_type(16))) float;
__device__ __forceinline__ void unpack8(const u32x4 w, float* f) {
#pragma unroll
  for (int e = 0; e < 4; ++e) { f[2 * e] = __uint_as_float(w[e] << 16); f[2 * e + 1] = __uint_as_float(w[e] & 0xffff0000u); }
}
__device__ __forceinline__ void gdn_prep_phase(const Params& p, char* smem, int bid, int nblk) {
  const int tid = otid(), wid = tid >> 6, lane = tid & 63, fr = lane & 15, fq = lane >> 4;
  u16* qs = (u16*)smem;
  u16* ks = qs + 64 * 136;
  float* Lm = (float*)(ks + 64 * 136);
  float* gcs = Lm + 4096; float* bts = gcs + 64; float* egs = bts + 64;
  const u16* proj = (const u16*)(p.ws + OFF_PROJ);
  const float* beta = (const float*)(p.ws + OFF_BETA); const float* gg = (const float*)(p.ws + OFF_G);
#pragma unroll 1
  for (int it = bid; it < 2048; it += nblk) {
    const int n = it & 127, bh = it >> 7, b = bh >> 2, h = bh & 3;
    const size_t row0 = (size_t)b * SEQ + n * 64;
    if (wid == 0) {
      float c = gg[(row0 + lane) * 4 + h];
#pragma unroll
      for (int o = 1; o < 64; o <<= 1) { const float tt = __shfl_up(c, o); if (lane >= o) c += tt; }
      gcs[lane] = c; egs[lane] = __expf(c); bts[lane] = beta[(row0 + lane) * 4 + h];
    }
    {
      const int tok = tid >> 2, part = tid & 3, l = n * 64 + tok;
      float qo[32], ko[32]; float sq = 0.f, sk = 0.f;
#pragma unroll
      for (int cb = 0; cb < 4; ++cb) {
        const int colq = h * 128 + part * 32 + cb * 8, colk = 512 + colq;
        float aq[8], ak[8];
#pragma unroll
        for (int e = 0; e < 8; ++e) { aq[e] = 0.f; ak[e] = 0.f; }
#pragma unroll
        for (int j = 0; j < 4; ++j) {
          const int lt = l - 3 + j;
          if (lt >= 0) {
            const u16* rp = proj + ((size_t)b * SEQ + lt) * PJ;
            float xq[8], xk[8];
            unpack8(*(const u32x4*)(rp + colq), xq); unpack8(*(const u32x4*)(rp + colk), xk);
            const f32x4 wq0 = *(const f32x4*)(p.hy_conv_w + j * 1536 + colq), wq1 = *(const f32x4*)(p.hy_conv_w + j * 1536 + colq + 4);
            const f32x4 wk0 = *(const f32x4*)(p.hy_conv_w + j * 1536 + colk), wk1 = *(const f32x4*)(p.hy_conv_w + j * 1536 + colk + 4);
#pragma unroll
            for (int e = 0; e < 4; ++e) { aq[e] += wq0[e] * xq[e]; aq[4 + e] += wq1[e] * xq[4 + e]; ak[e] += wk0[e] * xk[e]; ak[4 + e] += wk1[e] * xk[4 + e]; }
          }
        }
#pragma unroll
        for (int e = 0; e < 8; ++e) { const float a = silu_(aq[e]), k = silu_(ak[e]); qo[cb * 8 + e] = a; ko[cb * 8 + e] = k; sq += a * a; sk += k * k; }
      }
      sq += __shfl_xor(sq, 1); sq += __shfl_xor(sq, 2); sk += __shfl_xor(sk, 1); sk += __shfl_xor(sk, 2);
      const float rq = rsqrtf(sq + 1e-6f) * 0.08838834764831845f, rk = rsqrtf(sk + 1e-6f);
#pragma unroll
      for (int cb = 0; cb < 4; ++cb) {
        u32x4 wq, wk;
#pragma unroll
        for (int e = 0; e < 4; ++e) { wq[e] = pk2(qo[cb * 8 + 2 * e] * rq, qo[cb * 8 + 2 * e + 1] * rq); wk[e] = pk2(ko[cb * 8 + 2 * e] * rk, ko[cb * 8 + 2 * e + 1] * rk); }
        *(u32x4*)(qs + tok * 136 + part * 32 + cb * 8) = wq; *(u32x4*)(ks + tok * 136 + part * 32 + cb * 8) = wk;
      }
    }
    __syncthreads();
    {
      f32x4 akk[4], aqk[4];
#pragma unroll
      for (int nb = 0; nb < 4; ++nb) { akk[nb] = f32x4{0.f, 0.f, 0.f, 0.f}; aqk[nb] = f32x4{0.f, 0.f, 0.f, 0.f}; }
#pragma unroll
      for (int kk = 0; kk < 4; ++kk) {
        const bf16x8 ak = *(const bf16x8*)(ks + (16 * wid + fr) * 136 + kk * 32 + fq * 8);
        const bf16x8 aq = *(const bf16x8*)(qs + (16 * wid + fr) * 136 + kk * 32 + fq * 8);
#pragma unroll
        for (int nb = 0; nb < 4; ++nb) {
          const bf16x8 bk = *(const bf16x8*)(ks + (16 * nb + fr) * 136 + kk * 32 + fq * 8);
          akk[nb] = __builtin_amdgcn_mfma_f32_16x16x32_bf16(ak, bk, akk[nb], 0, 0, 0);
          aqk[nb] = __builtin_amdgcn_mfma_f32_16x16x32_bf16(aq, bk, aqk[nb], 0, 0, 0);
        }
      }
      u16* att = (u16*)(p.ws + OFF_GAT) + (size_t)it * 4096;
#pragma unroll
      for (int nb = 0; nb < 4; ++nb)
#pragma unroll
        for (int r = 0; r < 4; ++r) {
          const int i = 16 * wid + fq * 4 + r, j = 16 * nb + fr;
          const float dec = __expf(fminf(gcs[i] - gcs[j], 0.f));
          Lm[i * 64 + j] = (i > j) ? bts[i] * akk[nb][r] * dec : 0.f;
          att[i * 64 + j] = f2bf((i >= j) ? aqk[nb][r] * dec : 0.f);
        }
    }
    __syncthreads();
    {
      float x[64];
      if (tid < 128) {
        const int col = 1024 + h * 128 + tid;
        const float w0 = p.hy_conv_w[col], w1 = p.hy_conv_w[1536 + col], w2 = p.hy_conv_w[2 * 1536 + col], w3 = p.hy_conv_w[3 * 1536 + col];
        float x1 = 0.f, x2 = 0.f, x3 = 0.f;
        if (n > 0) { x3 = bf2f(proj[(row0 - 3) * PJ + col]); x2 = bf2f(proj[(row0 - 2) * PJ + col]); x1 = bf2f(proj[(row0 - 1) * PJ + col]); }
#pragma unroll
        for (int i = 0; i < 64; ++i) {
          const float xv = bf2f(proj[(row0 + i) * PJ + col]);
          x[i] = silu_(w0 * x3 + w1 * x2 + w2 * x1 + w3 * xv) * bts[i];
          x3 = x2; x2 = x1; x1 = xv;
        }
      } else {
#pragma unroll
        for (int i = 0; i < 64; ++i) x[i] = bf2f(ks[i * 136 + tid - 128]) * bts[i] * egs[i];
      }
#pragma unroll
      for (int i = 1; i < 64; ++i) {
        float acc = x[i];
#pragma unroll
        for (int j4 = 0; j4 < (i + 3) / 4; ++j4) {
          const f32x4 l4 = *(const f32x4*)(Lm + i * 64 + j4 * 4);
#pragma unroll
          for (int e = 0; e < 4; ++e) if (j4 * 4 + e < i) acc -= l4[e] * x[j4 * 4 + e];
        }
        x[i] = acc;
      }
      if (tid < 128) {
        u16* ut = (u16*)(p.ws + OFF_GUT) + (size_t)it * 8192 + tid * 64;
#pragma unroll
        for (int c8 = 0; c8 < 8; ++c8) {
          u32x4 w;
#pragma unroll
          for (int e = 0; e < 4; ++e) w[e] = pk2(x[c8 * 8 + 2 * e], x[c8 * 8 + 2 * e + 1]);
          *(u32x4*)(ut + c8 * 8) = w;
        }
      } else {
        u16* wg = (u16*)(p.ws + OFF_GW) + (size_t)it * 8192 + (tid - 128);
#pragma unroll
        for (int i = 0; i < 64; ++i) wg[i * 128] = f2bf(x[i]);
      }
    }
    {
      u16* qd = (u16*)(p.ws + OFF_GQD) + (size_t)it * 8192;
#pragma unroll
      for (int k = 0; k < 4; ++k) {
        const int piece = tid + 256 * k, i = piece >> 4, d0 = (piece & 15) * 8;
        float f[8]; unpack8(*(const u32x4*)(qs + i * 136 + d0), f);
        const float e = egs[i];
        u32x4 w;
#pragma unroll
        for (int e2 = 0; e2 < 4; ++e2) w[e2] = pk2(f[2 * e2] * e, f[2 * e2 + 1] * e);
        *(u32x4*)(qd + i * 128 + d0) = w;
      }
      u16* kt = (u16*)(p.ws + OFF_GKT) + (size_t)it * 8192;
      const int dk = tid & 127, half = tid >> 7;
      const float gl = gcs[63];
#pragma unroll
      for (int c8 = 0; c8 < 4; ++c8) {
        u32x4 w;
#pragma unroll
        for (int e = 0; e < 4; ++e) {
          const int i0 = half * 32 + c8 * 8 + 2 * e;
          w[e] = pk2(bf2f(ks[i0 * 136 + dk]) * __expf(gl - gcs[i0]), bf2f(ks[(i0 + 1) * 136 + dk]) * __expf(gl - gcs[i0 + 1]));
        }
        *(u32x4*)(kt + dk * 64 + half * 32 + c8 * 8) = w;
      }
      if (tid == 0) ((float*)(p.ws + OFF_GSD))[it] = egs[63];
    }
    __syncthreads();
  }
}

__device__ __forceinline__ uint2 lds64(const char* p) { return *(const uint2*)p; }
__device__ __forceinline__ bf16x8 mk8(uint2 a, uint2 b) { u32x4 w = {a.x, a.y, b.x, b.y}; return __builtin_bit_cast(bf16x8, w); }
__device__ __forceinline__ bf16x8 pack8(const f32x16& x, int s) {
  u32x4 w = {pk2(x[8 * s], x[8 * s + 1]), pk2(x[8 * s + 2], x[8 * s + 3]), pk2(x[8 * s + 4], x[8 * s + 5]), pk2(x[8 * s + 6], x[8 * s + 7])};
  return __builtin_bit_cast(bf16x8, w);
}
__device__ __forceinline__ void gdn_scan_item(const Params& p, int bh, char* smem) {
  const int tid = otid(), wid = tid >> 6, lane = tid & 63, r32 = lane & 31, hi = lane >> 5;
  char* Wl = smem; char* QDl = smem + 16896; char* KTl = smem + 33792; char* ATl = smem + 51200;
  const int b = bh >> 2, h = bh & 3;
  const char* gw = p.ws + OFF_GW; const char* gqd = p.ws + OFF_GQD; const char* gkt = p.ws + OFF_GKT; const char* gat = p.ws + OFF_GAT;
  const u16* gut = (const u16*)(p.ws + OFF_GUT);
  const float* gsd = (const float*)(p.ws + OFF_GSD);
  f32x16 S[4];
#pragma unroll
  for (int T = 0; T < 4; ++T)
#pragma unroll
    for (int r = 0; r < 16; ++r) S[T][r] = 0.f;
  u32x4 st[14]; uint2 uc[8];
  const int dv = wid * 32 + r32;
#define G_LOAD(IT) do { const size_t o16 = (size_t)(IT) * 16384, o8 = (size_t)(IT) * 8192; \
    _Pragma("unroll") for (int k = 0; k < 4; ++k) { st[k] = *(const u32x4*)(gw + o16 + (tid + 256 * k) * 16); st[4 + k] = *(const u32x4*)(gqd + o16 + (tid + 256 * k) * 16); \
      st[8 + k] = *(const u32x4*)(gkt + o16 + (tid + 256 * k) * 16); } \
    _Pragma("unroll") for (int k = 0; k < 2; ++k) st[12 + k] = *(const u32x4*)(gat + o8 + (tid + 256 * k) * 16); } while (0)
#define U_LOAD(IT) do { _Pragma("unroll") for (int k = 0; k < 8; ++k) uc[k] = *(const uint2*)(gut + (size_t)(IT) * 8192 + dv * 64 + 32 * (k >> 2) + 8 * (k & 3) + 4 * hi); } while (0)
#define G_WRITE() do { \
    _Pragma("unroll") for (int k = 0; k < 4; ++k) { const int pc = tid + 256 * k; \
      { char* d = Wl + (pc >> 4) * 264 + (pc & 15) * 16; *(uint2*)d = uint2{st[k][0], st[k][1]}; *(uint2*)(d + 8) = uint2{st[k][2], st[k][3]}; } \
      { char* d = QDl + (pc >> 4) * 264 + (pc & 15) * 16; *(uint2*)d = uint2{st[4 + k][0], st[4 + k][1]}; *(uint2*)(d + 8) = uint2{st[4 + k][2], st[4 + k][3]}; } \
      { char* d = KTl + (pc >> 3) * 136 + (pc & 7) * 16; *(uint2*)d = uint2{st[8 + k][0], st[8 + k][1]}; *(uint2*)(d + 8) = uint2{st[8 + k][2], st[8 + k][3]}; } } \
    _Pragma("unroll") for (int k = 0; k < 2; ++k) { const int pc = tid + 256 * k; \
      char* d = ATl + (pc >> 3) * 136 + (pc & 7) * 16; *(uint2*)d = uint2{st[12 + k][0], st[12 + k][1]}; *(uint2*)(d + 8) = uint2{st[12 + k][2], st[12 + k][3]}; } } while (0)
  G_LOAD(bh * 128); U_LOAD(bh * 128); G_WRITE(); __syncthreads();
#pragma unroll 1
  for (int n = 0; n < 128; ++n) {
    const int item = bh * 128 + n;
    if (n + 1 < 128) G_LOAD(item + 1);
    f32x16 av[2], ao[2];
#pragma unroll
    for (int r = 0; r < 16; ++r) { av[0][r] = 0.f; av[1][r] = 0.f; ao[0][r] = 0.f; ao[1][r] = 0.f; }
#pragma unroll
    for (int T = 0; T < 4; ++T)
#pragma unroll
      for (int s = 0; s < 2; ++s) {
        const bf16x8 sb = pack8(S[T], s);
        const int cb = (32 * T + 16 * s + 4 * hi) * 2;
#pragma unroll
        for (int it = 0; it < 2; ++it) {
          const char* wp = Wl + (32 * it + r32) * 264 + cb; const char* qp = QDl + (32 * it + r32) * 264 + cb;
          av[it] = __builtin_amdgcn_mfma_f32_32x32x16_bf16(mk8(lds64(wp), lds64(wp + 16)), sb, av[it], 0, 0, 0);
          ao[it] = __builtin_amdgcn_mfma_f32_32x32x16_bf16(mk8(lds64(qp), lds64(qp + 16)), sb, ao[it], 0, 0, 0);
        }
      }
    bf16x8 vb[2][2];
#pragma unroll
    for (int it = 0; it < 2; ++it) {
      f32x16 vn;
#pragma unroll
      for (int g = 0; g < 4; ++g) {
        const uint2 u2 = uc[it * 4 + g];
        vn[4 * g] = __uint_as_float(u2.x << 16) - av[it][4 * g]; vn[4 * g + 1] = __uint_as_float(u2.x & 0xffff0000u) - av[it][4 * g + 1];
        vn[4 * g + 2] = __uint_as_float(u2.y << 16) - av[it][4 * g + 2]; vn[4 * g + 3] = __uint_as_float(u2.y & 0xffff0000u) - av[it][4 * g + 3];
      }
      vb[it][0] = pack8(vn, 0); vb[it][1] = pack8(vn, 1);
    }
    if (n + 1 < 128) U_LOAD(item + 1);
#pragma unroll
    for (int it2 = 0; it2 < 2; ++it2)
#pragma unroll
      for (int it = 0; it <= it2; ++it)
#pragma unroll
        for (int s = 0; s < 2; ++s) {
          const char* ap = ATl + (32 * it2 + r32) * 136 + (32 * it + 16 * s + 4 * hi) * 2;
          ao[it2] = __builtin_amdgcn_mfma_f32_32x32x16_bf16(mk8(lds64(ap), lds64(ap + 16)), vb[it][s], ao[it2], 0, 0, 0);
        }
    {
#pragma unroll
      for (int it = 0; it < 2; ++it) {
        float* op = (float*)((it ? p.ws + OFF_GQD : p.ws + OFF_GW) + (size_t)item * 16384) + dv;
#pragma unroll
        for (int r = 0; r < 16; ++r) op[crow(r, hi) * 128] = ao[it][r];
      }
    }
    const float sd = gsd[item];
#pragma unroll
    for (int T = 0; T < 4; ++T) {
#pragma unroll
      for (int r = 0; r < 16; ++r) S[T][r] *= sd;
#pragma unroll
      for (int it = 0; it < 2; ++it)
#pragma unroll
        for (int s = 0; s < 2; ++s) {
          const char* kp = KTl + (32 * T + r32) * 136 + (32 * it + 16 * s + 4 * hi) * 2;
          S[T] = __builtin_amdgcn_mfma_f32_32x32x16_bf16(mk8(lds64(kp), lds64(kp + 16)), vb[it][s], S[T], 0, 0, 0);
        }
    }
    __syncthreads();
    if (n + 1 < 128) G_WRITE();
    __syncthreads();
  }
#undef G_LOAD
#undef G_WRITE
#undef U_LOAD
}

__device__ __forceinline__ void gdn_normgate_phase(const Params& p, int bid, int nblk) {
  const int tid = otid(), wid = tid >> 6, lane = tid & 63;
  u16* concat = (u16*)(p.ws + OFF_HN);
  const u16* proj = (const u16*)(p.ws + OFF_PROJ);
  const f32x4 hw0 = *(const f32x4*)(p.hy_head_norm_w + (lane & 15) * 8), hw1 = *(const f32x4*)(p.hy_head_norm_w + (lane & 15) * 8 + 4);
#pragma unroll 1
  for (int row = bid * 4 + wid; row < M; row += nblk * 4) {
    const int l_ = row & (SEQ - 1), item_ = (((row >> 13) * 4 + (lane >> 4)) << 7) + (l_ >> 6), i_ = l_ & 63;
    const float* og = (const float*)(((i_ & 32) ? p.ws + OFF_GQD : p.ws + OFF_GW) + (size_t)item_ * 16384) + (i_ & 31) * 128 + (lane & 15) * 8;
    const f32x4 a0 = *(const f32x4*)(og), a1 = *(const f32x4*)(og + 4);
    float zf[8]; unpack8(*(const u32x4*)(proj + (size_t)row * PJ + 1536 + lane * 8), zf);
    float ss = a0[0] * a0[0] + a0[1] * a0[1] + a0[2] * a0[2] + a0[3] * a0[3] + a1[0] * a1[0] + a1[1] * a1[1] + a1[2] * a1[2] + a1[3] * a1[3];
#pragma unroll
    for (int o = 8; o >= 1; o >>= 1) ss += __shfl_xor(ss, o);
    const float rs = rsqrtf(ss * (1.f / 128.f) + 1e-6f);
    u32x4 w;
    w[0] = pk2(a0[0] * rs * hw0[0] * silu_(zf[0]), a0[1] * rs * hw0[1] * silu_(zf[1]));
    w[1] = pk2(a0[2] * rs * hw0[2] * silu_(zf[2]), a0[3] * rs * hw0[3] * silu_(zf[3]));
    w[2] = pk2(a1[0] * rs * hw1[0] * silu_(zf[4]), a1[1] * rs * hw1[1] * silu_(zf[5]));
    w[3] = pk2(a1[2] * rs * hw1[2] * silu_(zf[6]), a1[3] * rs * hw1[3] * silu_(zf[7]));
    *(u32x4*)(concat + a_off(row, lane * 8, 32)) = w;
  }
}

using s16x4 = __attribute__((ext_vector_type(4))) short;
#define KSWZ(row, colB) ((row) * 256 + ((colB) ^ (((row) & 7) << 4)))
#define SBAR() __builtin_amdgcn_sched_barrier(0)
__device__ __forceinline__ unsigned cvtpk(float lo, float hi) { unsigned r; asm volatile("v_cvt_pk_bf16_f32 %0, %1, %2" : "=v"(r) : "v"(lo), "v"(hi)); return r; }
__device__ __forceinline__ int v_st(int k, int c) { const int kk = (k & ~0xC) | ((k & 4) << 1) | ((k & 8) >> 1); return ((kk >> 3) * 4 + (c >> 5)) * 512 + ((kk & 7) * 32 + (c & 31)) * 2; }
__device__ __forceinline__ int v_rd_base(int lane) { return ((lane & 3) << 3) | (((lane >> 2) & 3) << 6) | (((lane >> 4) & 1) << 5) | (((lane >> 5) & 1) << 8); }
constexpr int v_rd_off(int d0, int ks, int half) { return d0 * 512 + ks * 4096 + half * 2048; }
template <int OFF> __device__ __forceinline__ s16x4 tr_read(int vb) {
  s16x4 r; asm volatile("ds_read_b64_tr_b16 %0, %1 offset:%2" : "=&v"(r) : "v"(vb), "i"(OFF) : "memory"); return r;
}
template <int D0> __device__ __forceinline__ void pv_one(f32x16& od, int vb, bf16x8 pa0, bf16x8 pa1, bf16x8 pa2, bf16x8 pa3) {
  const s16x4 l0 = tr_read<v_rd_off(D0, 0, 0)>(vb), h0 = tr_read<v_rd_off(D0, 0, 1)>(vb), l1 = tr_read<v_rd_off(D0, 1, 0)>(vb), h1 = tr_read<v_rd_off(D0, 1, 1)>(vb);
  const s16x4 l2 = tr_read<v_rd_off(D0, 2, 0)>(vb), h2 = tr_read<v_rd_off(D0, 2, 1)>(vb), l3 = tr_read<v_rd_off(D0, 3, 0)>(vb), h3 = tr_read<v_rd_off(D0, 3, 1)>(vb);
  asm volatile("s_waitcnt lgkmcnt(0)" ::: "memory"); SBAR();
#define PK(L, H) (bf16x8){L[0], L[1], L[2], L[3], H[0], H[1], H[2], H[3]}
  od = __builtin_amdgcn_mfma_f32_32x32x16_bf16(pa0, PK(l0, h0), od, 0, 0, 0);
  od = __builtin_amdgcn_mfma_f32_32x32x16_bf16(pa1, PK(l1, h1), od, 0, 0, 0);
  od = __builtin_amdgcn_mfma_f32_32x32x16_bf16(pa2, PK(l2, h2), od, 0, 0, 0);
  od = __builtin_amdgcn_mfma_f32_32x32x16_bf16(pa3, PK(l3, h3), od, 0, 0, 0);
#undef PK
}
__device__ __forceinline__ float pl32_other(float a, float b, int hi) {
  auto rr = __builtin_amdgcn_permlane32_swap(__float_as_uint(a), __float_as_uint(b), false, false);
  return __uint_as_float(hi ? rr[0] : rr[1]);
}
__device__ __forceinline__ void sb_half(f32x16& pz, float& run, bool need_mask, int kb, int t, int hi) {
  constexpr float C2 = 0.08838834764831845f * 1.4426950408889634f;
  f32x16 l;
#pragma unroll
  for (int r = 0; r < 16; ++r) {
    const float e = __builtin_amdgcn_exp2f(fminf(pz[r] * C2, 60.f));
    l[r] = __builtin_amdgcn_rcpf(1.f + e);
    pz[r] = e;
  }
  if (need_mask) {
#pragma unroll
    for (int r = 0; r < 16; ++r) { if (kb + crow(r, hi) >= t) { l[r] = 1.f; pz[r] = 0.f; } }
  }
#pragma unroll
  for (int g = 0; g < 4; ++g) { l[4 * g + 2] *= l[4 * g + 3]; l[4 * g + 1] *= l[4 * g + 2]; l[4 * g] *= l[4 * g + 1]; }
  const float cs3 = l[12], cs2 = l[8] * cs3, cs1 = l[4] * cs2, cs0 = l[0] * cs1;
  const float off0 = cs1 * pl32_other(cs0, cs1, hi) * run;
  const float off1 = cs2 * pl32_other(cs1, cs2, hi) * run;
  const float off2 = cs3 * pl32_other(cs2, cs3, hi) * run;
  const float off3 = pl32_other(cs3, 1.f, hi) * run;
  float tot;
  { auto rr = __builtin_amdgcn_permlane32_swap(__float_as_uint(cs0), __float_as_uint(cs0), false, false); tot = __uint_as_float(rr[0]) * __uint_as_float(rr[1]); }
#pragma unroll
  for (int r = 0; r < 4; ++r) {
    pz[r] = pz[r] * l[r] * off0; pz[4 + r] = pz[4 + r] * l[4 + r] * off1;
    pz[8 + r] = pz[8 + r] * l[8 + r] * off2; pz[12 + r] = pz[12 + r] * l[12 + r] * off3;
  }
  run *= tot;
}

__device__ __forceinline__ void attn_phase(const Params& p, char* smem, int bid, int nblk) {
  const int tid = otid(), wid = tid >> 6, lane = tid & 63, r32 = lane & 31, hi = lane >> 5;
  char* K_lds = smem; char* V_lds = smem + 16384;
  const u16* qkv = (const u16*)(p.ws + OFF_PROJ);
  u16* ao = (u16*)(p.ws + OFF_HN);
  const int sr = tid >> 4, sc = (tid & 15) * 8;
  const int vb0 = (int)(uintptr_t)V_lds + v_rd_base(lane);
  for (int k = 0; k * nblk < 2048; ++k) {
    const int i = (k & 1) ? ((k + 1) * nblk - 1 - bid) : (k * nblk + bid);
    if (i >= 2048) continue;
    const int j = 63 - (i >> 5), bh = i & 31, b = bh >> 3, h = bh & 7;
    const int i0 = j * 128;
    const size_t rowb = (size_t)b * SEQ;
    const int t = i0 + wid * 32 + r32, tmin = i0 + wid * 32, tmax = tmin + 31;
    bf16x8 qr[8];
    {
      const u16* qp = qkv + (rowb + t) * 3072 + h * 128 + hi * 8;
#pragma unroll
      for (int d0 = 0; d0 < 8; ++d0) qr[d0] = *(const bf16x8*)(qp + d0 * 16);
    }
    f32x16 o[4];
#pragma unroll
    for (int d = 0; d < 4; ++d)
#pragma unroll
      for (int r = 0; r < 16; ++r) o[d][r] = 0.f;
    float run = 1.f;
    const u16* kbase = qkv + rowb * 3072 + 1024 + h * 128 + sc;
    u32x4 stk[4], stv[4];
#define SLOAD(KT) do { _Pragma("unroll") for (int ii = 0; ii < 4; ++ii) { const u16* kp = kbase + (size_t)((KT) * 64 + sr + 16 * ii) * 3072; \
      stk[ii] = *(const u32x4*)kp; stv[ii] = *(const u32x4*)(kp + 1024); } } while (0)
#define SWRITE() do { _Pragma("unroll") for (int ii = 0; ii < 4; ++ii) { const int row = sr + 16 * ii; \
      *(u32x4*)(K_lds + KSWZ(row, sc * 2)) = stk[ii]; *(u32x4*)(V_lds + v_st(row, sc)) = stv[ii]; } } while (0)
    const int NT = 2 * j + 2;
    SLOAD(NT - 1); SWRITE(); __syncthreads();
    for (int kt = NT - 1; kt >= 0; --kt) {
      const int k0 = kt * 64;
      if (k0 <= tmax) {
        bf16x8 pa0, pa1, pa2, pa3;
#define PK4(P, BASE, OUT) do { unsigned a0 = cvtpk(P[BASE + 0], P[BASE + 1]), a1 = cvtpk(P[BASE + 2], P[BASE + 3]); \
    unsigned b0_ = cvtpk(P[BASE + 4], P[BASE + 5]), b1_ = cvtpk(P[BASE + 6], P[BASE + 7]); \
    auto r0 = __builtin_amdgcn_permlane32_swap(a0, b0_, false, false); auto r1 = __builtin_amdgcn_permlane32_swap(a1, b1_, false, false); \
    u32x4 w = {r0[0], r1[0], r0[1], r1[1]}; OUT = *reinterpret_cast<bf16x8*>(&w); } while (0)
        if (k0 + 32 <= tmax) {
          f32x16 pz;
#pragma unroll
          for (int r = 0; r < 16; ++r) pz[r] = 0.f;
#pragma unroll
          for (int d0 = 0; d0 < 8; ++d0) {
            const bf16x8 kf = *(const bf16x8*)(K_lds + KSWZ(32 + r32, (d0 * 16 + hi * 8) * 2));
            pz = __builtin_amdgcn_mfma_f32_32x32x16_bf16(kf, qr[d0], pz, 0, 0, 0);
          }
          sb_half(pz, run, k0 + 63 >= tmin, k0 + 32, t, hi);
          PK4(pz, 0, pa2); PK4(pz, 8, pa3);
        } else {
          pa2 = bf16x8{0, 0, 0, 0, 0, 0, 0, 0}; pa3 = pa2;
        }
        {
          f32x16 pz;
#pragma unroll
          for (int r = 0; r < 16; ++r) pz[r] = 0.f;
#pragma unroll
          for (int d0 = 0; d0 < 8; ++d0) {
            const bf16x8 kf = *(const bf16x8*)(K_lds + KSWZ(r32, (d0 * 16 + hi * 8) * 2));
            pz = __builtin_amdgcn_mfma_f32_32x32x16_bf16(kf, qr[d0], pz, 0, 0, 0);
          }
          sb_half(pz, run, k0 + 31 >= tmin, k0, t, hi);
          PK4(pz, 0, pa0); PK4(pz, 8, pa1);
        }
#undef PK4
        if (kt > 0) SLOAD(kt - 1);
        pv_one<0>(o[0], vb0, pa0, pa1, pa2, pa3); pv_one<1>(o[1], vb0, pa0, pa1, pa2, pa3);
        pv_one<2>(o[2], vb0, pa0, pa1, pa2, pa3); pv_one<3>(o[3], vb0, pa0, pa1, pa2, pa3);
      } else {
        if (kt > 0) SLOAD(kt - 1);
      }
      __syncthreads();
      if (kt > 0) SWRITE();
      __syncthreads();
    }
#undef SLOAD
#undef SWRITE
    {
      const int orow0 = (int)rowb + i0 + wid * 32;
#pragma unroll
      for (int r = 0; r < 16; ++r) {
        const int orow = crow(r, hi);
#pragma unroll
        for (int d0 = 0; d0 < 4; ++d0) ao[a_off(orow0 + orow, h * 128 + d0 * 32 + r32, 32)] = f2bf(o[d0][r]);
      }
    }
  }
}

#define XB_TMO      128
#define XB_XCNT(j)  (256  + 64 * (j))
#define XB_XSUB(j)  (1280 + 64 * (j))
#define XB_XGEN(j)  (2304 + 64 * (j))
#define XB_TOP      3328
#define XB_TOPGEN   3392
#define XCD_BAR_WORDS 3456
#define XB_SPIN_CAP (1u << 23)
#define LAS __attribute__((address_space(3)))
__device__ __forceinline__ unsigned xb_ld(unsigned* p)              { return __hip_atomic_load(p, __ATOMIC_RELAXED, __HIP_MEMORY_SCOPE_AGENT); }
__device__ __forceinline__ unsigned xb_add(unsigned* p, unsigned v) { return __hip_atomic_fetch_add(p, v, __ATOMIC_RELAXED, __HIP_MEMORY_SCOPE_AGENT); }
__device__ __forceinline__ unsigned xb_xcc_id() { return (unsigned)__builtin_amdgcn_s_getreg((3 << 11) | 20) & 0xFu; }
#define XB_SPIN(cond, bar) do { unsigned _sp = 0; while (cond) { __builtin_amdgcn_s_sleep(1); \
    if ((++_sp & 255u) == 0u) { if (xb_ld(&(bar)[XB_TMO])) break; if (_sp > XB_SPIN_CAP) { atomicAdd(&(bar)[XB_TMO], 1u); break; } } } } while (0)
struct XcdBarrier { unsigned* bar; unsigned x; volatile LAS unsigned* st; };
__device__ __forceinline__ XcdBarrier xcd_barrier_post(unsigned* bar, volatile LAS unsigned* st) {
  XcdBarrier b; b.bar = bar; b.x = xb_xcc_id(); b.st = st;
  if (__builtin_amdgcn_workitem_id_x() == 0) (void)xb_add(&bar[XB_XCNT(b.x)], 1u);
  return b;
}
__device__ __forceinline__ void xcd_barrier_complete(unsigned* bar, unsigned x, unsigned& nloc, unsigned& nx) {
  const unsigned G = gridDim.x * gridDim.y * gridDim.z;
  unsigned sum, cnt, mine, sp = 0u;
  for (;;) {
    sum = 0u; cnt = 0u; mine = 0u;
#pragma unroll
    for (unsigned j = 0; j < 16; ++j) { const unsigned c = xb_ld(&bar[XB_XCNT(j)]); sum += c; cnt += (c > 0u) ? 1u : 0u; mine = (j == x) ? c : mine; }
    if (sum == G) break;
    __builtin_amdgcn_s_sleep(1);
    if ((++sp & 255u) == 0u) { if (xb_ld(&bar[XB_TMO])) break; if (sp > XB_SPIN_CAP) { atomicAdd(&bar[XB_TMO], 1u); break; } }
  }
  nloc = mine > 0u ? mine : 1u; nx = cnt > 0u ? cnt : 1u;
}
__device__ __forceinline__ void xcd_barrier(const XcdBarrier& b) {
  asm volatile("s_waitcnt vmcnt(0)" ::: "memory");
  __syncthreads();
  if (__builtin_amdgcn_workitem_id_x() == 0) {
    unsigned* bar = b.bar;
    __builtin_amdgcn_s_waitcnt(0);
    unsigned nloc = b.st[0], nx = b.st[1];
    if (nloc == 0u) { xcd_barrier_complete(bar, b.x, nloc, nx); b.st[0] = nloc; b.st[1] = nx; }
    const unsigned old = xb_add(&bar[XB_XSUB(b.x)], 1u);
    const unsigned gen = old / nloc;
    if (old + 1u == (gen + 1u) * nloc) {
      __builtin_amdgcn_fence(__ATOMIC_RELEASE, "agent");
      asm volatile("s_waitcnt vmcnt(0)" ::: "memory");
      const unsigned og = xb_add(&bar[XB_TOP], 1u);
      const unsigned tg = og / nx;
      if (og + 1u == (tg + 1u) * nx) xb_add(&bar[XB_TOPGEN], 1u);
      else XB_SPIN(xb_ld(&bar[XB_TOPGEN]) == tg, bar);
      __builtin_amdgcn_fence(__ATOMIC_ACQUIRE, "agent");
      xb_add(&bar[XB_XGEN(b.x)], 1u);
      asm volatile("s_waitcnt vmcnt(0)" ::: "memory");
    } else {
      XB_SPIN(xb_ld(&bar[XB_XGEN(b.x)]) == gen, bar);
      __builtin_amdgcn_fence(__ATOMIC_ACQUIRE, "agent");
      asm volatile("s_waitcnt vmcnt(0)" ::: "memory");
    }
  }
  __syncthreads();
}

__global__ void __launch_bounds__(256, 2) mega(Params p) {
  __shared__ __attribute__((aligned(16))) char smem[SMEM_BYTES];
  __shared__ uint4 xb_words;
  const int bid = blockIdx.x, nblk = gridDim.x;
  char* ws = p.ws;
  if (__builtin_amdgcn_workitem_id_x() == 0) xb_words = make_uint4(0u, 0u, 0u, 0u);
  __syncthreads();
  const XcdBarrier xbar = xcd_barrier_post((unsigned*)(ws + OFF_BAR), (volatile LAS unsigned*)&xb_words);
  const float* mod = (const float*)(ws + OFF_MOD);
  u16* hn = (u16*)(ws + OFF_HN);
#define PH_BEGIN(n) if (p.phase_lo <= (n) && (n) < p.phase_hi) {
#define PH_END(n) if ((n) + 1 < p.phase_hi) { if ((n) == 0) cg::this_grid().sync(); else xcd_barrier(xbar); } }
  PH_BEGIN(0) phase0(p, smem, bid, nblk); PH_END(0)
  PH_BEGIN(1) norm_phase<1>(p, p.x, p.norm_mix_w, mod, 0, 1024, smem, bid, nblk); PH_END(1)
  PH_BEGIN(2) { EpiArgs ea{}; ea.outb = (u16*)(ws + OFF_PROJ); ea.ux = (u16*)(ws + OFF_UX);
        gemm_phase<E_PROJ0>(hn, 32, 0, (const u16*)(ws + OFF_WT_HYIN), 32, 0, 1024, M / 256, PN / 128, 1, ea, smem, bid, nblk); } PH_END(2)
  PH_BEGIN(3) { EpiArgs ea{}; ea.outf = (float*)(ws + OFF_XE);
        gemm_phase<E_XE>((const u16*)(ws + OFF_UX), 20, (size_t)S5C * UXW, (const u16*)(ws + OFF_EG), 16, (size_t)128 * 512, 512, S5C / 256, 1, 32, ea, smem, bid, nblk); } PH_END(3)
  PH_BEGIN(4) { s5_carry_phase(p, bid, nblk); gdn_prep_phase(p, smem, bid, nblk); } PH_END(4)
  PH_BEGIN(5) {
        if (bid < 16) { gdn_scan_item(p, bid, smem); }
        else { EpiArgs ea{}; ea.outb = (u16*)(ws + OFF_Y5); ea.ux = (u16*)(ws + OFF_UX); ea.bias = p.s5_d;
          gemm_phase<E_S5Y>((const u16*)(ws + OFF_UX), 20, (size_t)S5C * UXW, (const u16*)(ws + OFF_MF), 20, (size_t)512 * UXW, UXW, S5C / 256, 4, 32, ea, smem, bid - 16, nblk - 16); }
      } PH_END(5)
  PH_BEGIN(6) { gdn_normgate_phase(p, bid, nblk); } PH_END(6)
  PH_BEGIN(7) { EpiArgs ea{}; ea.outb = hn; ea.y5 = (const u16*)(ws + OFF_Y5); ea.bias = p.s5_glu_b;
        gemm_phase<E_GLU>((const u16*)(ws + OFF_Y5), 16, 0, (const u16*)(ws + OFF_WT_GLU), 16, 0, 512, M / 256, 4, 1, ea, smem, bid, nblk); } PH_END(7)
  PH_BEGIN(8) { EpiArgs ea{}; ea.outf = p.out; ea.res = p.x; ea.gate = mod + 2048;
        gemm_phase<E_RESID>(hn, 32, 0, (const u16*)(ws + OFF_WT_HYOUT), 32, 0, 1024, M / 256, 8, 1, ea, smem, bid, nblk); } PH_END(8)
  PH_BEGIN(9) norm_phase<0>(p, p.out, p.norm_ffn_w, mod, 3072, 4096, smem, bid, nblk); PH_END(9)
  PH_BEGIN(10) { EpiArgs ea{}; ea.outb = (u16*)(ws + OFF_PROJ);
        gemm_phase<E_SWIGLU>(hn, 32, 0, (const u16*)(ws + OFF_WT_FFNIN), 32, 0, 1024, M / 256, 2 * FF / 128, 1, ea, smem, bid, nblk); } PH_END(10)
  PH_BEGIN(11) { EpiArgs ea{}; ea.outf = p.out; ea.res = p.out; ea.gate = mod + 5120;
        gemm_phase<E_RESID>((const u16*)(ws + OFF_PROJ), FF / 32, 0, (const u16*)(ws + OFF_WT_FFNOUT), FF / 32, 0, FF, M / 256, 8, 1, ea, smem, bid, nblk); } PH_END(11)
  PH_BEGIN(12) norm_phase<0>(p, p.out, p.norm_mix_w + 1024, mod + 4 * 6144, 0, 1024, smem, bid, nblk); PH_END(12)
  PH_BEGIN(13) { EpiArgs ea{}; ea.outb = (u16*)(ws + OFF_PROJ); ea.ldc = 3072;
        gemm_phase<E_BF16>(hn, 32, 0, (const u16*)(ws + OFF_WT_SBIN), 32, 0, 1024, M / 256, 24, 1, ea, smem, bid, nblk); } PH_END(13)
  PH_BEGIN(14) attn_phase(p, smem, bid, nblk); PH_END(14)
  PH_BEGIN(15) { EpiArgs ea{}; ea.outf = p.out; ea.res = p.out; ea.gate = mod + 4 * 6144 + 2048;
        gemm_phase<E_RESID>(hn, 32, 0, (const u16*)(ws + OFF_WT_SBOUT), 32, 0, 1024, M / 256, 8, 1, ea, smem, bid, nblk); } PH_END(15)
  PH_BEGIN(16) norm_phase<0>(p, p.out, p.norm_ffn_w + 1024, mod + 4 * 6144, 3072, 4096, smem, bid, nblk); PH_END(16)
  PH_BEGIN(17) { EpiArgs ea{}; ea.outb = (u16*)(ws + OFF_PROJ);
        gemm_phase<E_SWIGLU>(hn, 32, 0, (const u16*)(ws + OFF_WT_FFNIN + SZ_WT_FFNIN), 32, 0, 1024, M / 256, 2 * FF / 128, 1, ea, smem, bid, nblk); } PH_END(17)
  PH_BEGIN(18) { EpiArgs ea{}; ea.outf = p.out; ea.res = p.out; ea.gate = mod + 4 * 6144 + 5120;
        gemm_phase<E_RESID>((const u16*)(ws + OFF_PROJ), FF / 32, 0, (const u16*)(ws + OFF_WT_FFNOUT + SZ_WT_FFNOUT), FF / 32, 0, FF, M / 256, 8, 1, ea, smem, bid, nblk); } PH_END(18)
  PH_BEGIN(19) norm_phase<2>(p, p.out, p.final_norm_w, mod, 0, 0, smem, bid, nblk); PH_END(19)
}

extern "C" void kernel_launch(void* const* d_in, const int* in_sizes, int n_in, void* d_out, int out_size, void* d_ws, size_t ws_size,
                              hipStream_t stream) {
  static int grid_blocks = 0;
  if (!grid_blocks) {
    int dev = 0, cus = 0, per_cu = 0;
    hipGetDevice(&dev);
    hipDeviceGetAttribute(&cus, hipDeviceAttributeMultiprocessorCount, dev);
    hipOccupancyMaxActiveBlocksPerMultiprocessor(&per_cu, mega, 256, 0);
    if (per_cu > 2) per_cu = 2;
    if (per_cu < 1) per_cu = 1;
    grid_blocks = cus * per_cu;
  }
  Params p{};
  const float* const* in = (const float* const*)d_in;
  p.x = in[0]; p.c = in[1]; p.ada_w = in[2]; p.ada_b = in[3]; p.norm_mix_w = in[4]; p.norm_ffn_w = in[5]; p.ffn_w_in = in[6]; p.ffn_w_out = in[7];
  p.hy_w_in = in[8]; p.hy_conv_w = in[9]; p.hy_a_log = in[10]; p.hy_dt_bias = in[11]; p.hy_head_norm_w = in[12];
  p.s5_lam_re = in[13]; p.s5_lam_im = in[14]; p.s5_log_dt = in[15]; p.s5_b_re = in[16]; p.s5_b_im = in[17]; p.s5_c_re = in[18]; p.s5_c_im = in[19];
  p.s5_d = in[20]; p.s5_glu_w = in[21]; p.s5_glu_b = in[22]; p.hy_w_out = in[23]; p.sb_w_in = in[24]; p.sb_w_out = in[25]; p.final_norm_w = in[26];
  p.out = (float*)d_out; p.ws = (char*)d_ws;
#if ONE_LAUNCH
  p.phase_lo = 0; p.phase_hi = NPHASE;
  (void)hipMemsetAsync((char*)d_ws + OFF_BAR, 0, (size_t)XCD_BAR_WORDS_C * 4, stream);
  void* args[] = {&p};
  hipError_t e = hipLaunchCooperativeKernel((void*)mega, dim3(grid_blocks), dim3(256), args, 0, stream);
  if (e != hipSuccess) fprintf(stderr, "cooperative launch failed: %s (grid %d)\n", hipGetErrorString(e), grid_blocks);
#else
  for (int ph = 0; ph < NPHASE; ++ph) {
    p.phase_lo = ph; p.phase_hi = ph + 1;
    hipLaunchKernelGGL(mega, dim3(grid_blocks), dim3(256), 0, stream, p);
  }
#endif
}
```

```cpp
#include <hip/hip_runtime.h>
#include <hip/hip_cooperative_groups.h>
#include <stdint.h>
#include <cstdio>
namespace cg = cooperative_groups;

#ifndef ONE_LAUNCH
#define ONE_LAUNCH 1
#endif

typedef unsigned short u16;
using bf16x8 = __attribute__((ext_vector_type(8))) short;
using f32x4 = __attribute__((ext_vector_type(4))) float;
using u32x4 = __attribute__((ext_vector_type(4))) unsigned;

constexpr int D = 1024, NB = 4, SEQ = 8192, M = NB * SEQ, FF = 2816, EIN = 2568, PN = 2560, PJ = 2048;
constexpr int NPHASE = 20;
constexpr int XCD_BAR_WORDS_C = 3456;
constexpr int S5T = 32, S5C = M / S5T, UXW = 640;

constexpr size_t SZ_WT_HYIN = (size_t)PN * 1024 * 2, SZ_WT_SQ = (size_t)1024 * 1024 * 2, SZ_WT_GLU = (size_t)512 * 512 * 2;
constexpr size_t SZ_WT_FFNIN = (size_t)2 * FF * 1024 * 2, SZ_WT_FFNOUT = (size_t)1024 * FF * 2, SZ_WT_SBIN = (size_t)3072 * 1024 * 2;
constexpr size_t OFF_WT_HYIN = 0;
constexpr size_t OFF_WT_HYOUT = OFF_WT_HYIN + SZ_WT_HYIN;
constexpr size_t OFF_WT_GLU = OFF_WT_HYOUT + SZ_WT_SQ;
constexpr size_t OFF_WT_FFNIN = OFF_WT_GLU + SZ_WT_GLU;
constexpr size_t OFF_WT_FFNOUT = OFF_WT_FFNIN + 2 * SZ_WT_FFNIN;
constexpr size_t OFF_WT_SBIN = OFF_WT_FFNOUT + 2 * SZ_WT_FFNOUT;
constexpr size_t OFF_WT_SBOUT = OFF_WT_SBIN + SZ_WT_SBIN;
constexpr size_t OFF_MOD = OFF_WT_SBOUT + SZ_WT_SQ;
constexpr size_t OFF_BETA = OFF_MOD + (size_t)2 * 4 * 6144 * 4;
constexpr size_t OFF_G = OFF_BETA + (size_t)M * 4 * 4;
constexpr size_t OFF_HN = OFF_G + (size_t)M * 4 * 4;
constexpr size_t OFF_Y5 = OFF_HN + (size_t)M * 1024 * 2;
constexpr size_t OFF_UX = OFF_Y5 + (size_t)M * 512 * 2;
constexpr size_t OFF_MF = OFF_UX + (size_t)32 * S5C * UXW * 2;
constexpr size_t OFF_EG = OFF_MF + (size_t)32 * 512 * UXW * 2;
constexpr size_t OFF_XE = OFF_EG + (size_t)32 * 128 * 512 * 2;
constexpr size_t OFF_A32 = OFF_XE + (size_t)32 * S5C * 128 * 4;
constexpr size_t OFF_PROJ = OFF_A32 + (size_t)32 * 64 * 2 * 4;
constexpr size_t OFF_GW = OFF_PROJ + (size_t)M * PJ * 2;
constexpr size_t OFF_GQD = OFF_GW + (size_t)2048 * 8192 * 2;
constexpr size_t OFF_GKT = OFF_GQD + (size_t)2048 * 8192 * 2;
constexpr size_t OFF_GUT = OFF_GKT + (size_t)2048 * 8192 * 2;
constexpr size_t OFF_GAT = OFF_GUT + (size_t)2048 * 8192 * 2;
constexpr size_t OFF_GSD = OFF_GAT + (size_t)2048 * 4096 * 2;
constexpr size_t OFF_BAR = OFF_GSD + (size_t)2048 * 4;
constexpr size_t WS_TOTAL = OFF_BAR + (size_t)XCD_BAR_WORDS_C * 4;
static_assert((size_t)M * 3072 * 2 <= WS_TOTAL - OFF_PROJ, "QKV alias");
static_assert(WS_TOTAL <= (size_t)512 * 1024 * 1024, "workspace too large");

struct Params {
  const float *x, *c, *ada_w, *ada_b, *norm_mix_w, *norm_ffn_w, *ffn_w_in, *ffn_w_out;
  const float *hy_w_in, *hy_conv_w, *hy_a_log, *hy_dt_bias, *hy_head_norm_w;
  const float *s5_lam_re, *s5_lam_im, *s5_log_dt, *s5_b_re, *s5_b_im, *s5_c_re, *s5_c_im, *s5_d, *s5_glu_w, *s5_glu_b, *hy_w_out;
  const float *sb_w_in, *sb_w_out, *final_norm_w;
  float* out;
  char* ws;
  int phase_lo, phase_hi;
};

constexpr int SMEM_BYTES = 73728;

__device__ __forceinline__ int otid() { int t = __builtin_amdgcn_workitem_id_x(); asm volatile("" : "+v"(t)); return t; }
__device__ __forceinline__ u16 f2bf(float x) { unsigned u = __float_as_uint(x); u += 0x7fffu + ((u >> 16) & 1u); return (u16)(u >> 16); }
typedef __bf16 bf16v2 __attribute__((ext_vector_type(2)));
typedef float f32v2 __attribute__((ext_vector_type(2)));
__device__ __forceinline__ unsigned pk2(float a, float b) { f32v2 v = {a, b}; bf16v2 r = __builtin_convertvector(v, bf16v2); return __builtin_bit_cast(unsigned, r); }
__device__ __forceinline__ float bf2f(u16 v) { return __uint_as_float(((unsigned)v) << 16); }
__device__ __forceinline__ float sigmoid_(float x) { return 1.f / (1.f + __expf(-x)); }
__device__ __forceinline__ float silu_(float x) { return x * sigmoid_(x); }
__device__ __forceinline__ float softplus_(float x) { return fmaxf(x, 0.f) + log1pf(__expf(-fabsf(x))); }
__device__ __forceinline__ float gelu_tanh_(float y) { return 0.5f * y * (1.f + tanhf(0.7978845608028654f * (y + 0.044715f * y * y * y))); }

__device__ __forceinline__ size_t pj_idx(int row, int col) { return (size_t)(col >> 9) * ((size_t)M * 512) + (size_t)row * 512 + (col & 511); }
__device__ __forceinline__ size_t a_off(int row, int col, int nks) { return ((size_t)((row >> 8) * nks + (col >> 5)) << 13) + ((row & 255) << 5) + (col & 31); }
__device__ __forceinline__ size_t b_off(int n, int k, int nks) { return ((size_t)((n >> 7) * nks + (k >> 5)) << 12) + ((n & 127) << 5) + (k & 31); }

struct TrJob { const float* src; u16* dst; int K, Nsrc, Nd, mode; };
__device__ __forceinline__ TrJob get_job(const Params& p, int j) {
  TrJob t;
  switch (j) {
    case 0: t = {p.hy_w_in, (u16*)(p.ws + OFF_WT_HYIN), 1024, EIN, PN, 1}; break;
    case 1: t = {p.hy_w_out, (u16*)(p.ws + OFF_WT_HYOUT), 1024, 1024, 1024, 0}; break;
    case 2: t = {p.s5_glu_w, (u16*)(p.ws + OFF_WT_GLU), 512, 512, 512, 0}; break;
    case 3: t = {p.ffn_w_in, (u16*)(p.ws + OFF_WT_FFNIN), 1024, 2 * FF, 2 * FF, 2}; break;
    case 4: t = {p.ffn_w_in + (size_t)1024 * 2 * FF, (u16*)(p.ws + OFF_WT_FFNIN + SZ_WT_FFNIN), 1024, 2 * FF, 2 * FF, 2}; break;
    case 5: t = {p.ffn_w_out, (u16*)(p.ws + OFF_WT_FFNOUT), FF, 1024, 1024, 0}; break;
    case 6: t = {p.ffn_w_out + (size_t)FF * 1024, (u16*)(p.ws + OFF_WT_FFNOUT + SZ_WT_FFNOUT), FF, 1024, 1024, 0}; break;
    case 7: t = {p.sb_w_in, (u16*)(p.ws + OFF_WT_SBIN), 1024, 3072, 3072, 0}; break;
    default: t = {p.sb_w_out, (u16*)(p.ws + OFF_WT_SBOUT), 1024, 1024, 1024, 0}; break;
  }
  return t;
}
__device__ __forceinline__ int src_col(int R, int mode) {
  if (mode == 0) return R;
  if (mode == 1) return R < 2048 ? R : R + 8;
  return ((R >> 4) & 1) * FF + (R >> 5) * 16 + (R & 15);
}
constexpr int N_TR_ITEMS = 640 + 256 + 64 + 2 * 1408 + 2 * 704 + 768 + 256;
constexpr int N_MOD_ITEMS = 2 * 6144 / 16;

__device__ __forceinline__ void s5_table_item(const Params& p, int item, char* smem) {
  const int tid = otid(), g = item >> 5, tau = item & 31;
  float* pwr = (float*)smem; float* pwi = pwr + 64; float* p1r = pwi + 64; float* p1i = p1r + 64;
  float* bbr = p1i + 64; float* bbi = bbr + 1024; float* cre = bbi + 1024; float* cim = cre + 1024;
  const float dt = expf(p.s5_log_dt[g]);
  if (tid < 64) {
    const float lr = p.s5_lam_re[g * 64 + tid], li = p.s5_lam_im[g * 64 + tid];
    float sn, cs;
    float mg = expf(lr * dt * (float)tau); sincosf(li * dt * (float)tau, &sn, &cs); pwr[tid] = mg * cs; pwi[tid] = mg * sn;
    mg = expf(lr * dt * (float)(tau + 1)); sincosf(li * dt * (float)(tau + 1), &sn, &cs); p1r[tid] = mg * cs; p1i[tid] = mg * sn;
    if (tau == 31) { float* a32 = (float*)(p.ws + OFF_A32); a32[(g * 64 + tid) * 2] = mg * cs; a32[(g * 64 + tid) * 2 + 1] = mg * sn; }
  }
  {
    const int pp = tid >> 2, hq = (tid & 3) * 4;
    const float lr = p.s5_lam_re[g * 64 + pp], li = p.s5_lam_im[g * 64 + pp];
    const float mg = expf(lr * dt); float sn, cs; sincosf(li * dt, &sn, &cs);
    const float ar = mg * cs, ai = mg * sn, den = lr * lr + li * li, nr = ar - 1.f, ni = ai;
    const float fre = (nr * lr + ni * li) / den, fim = (ni * lr - nr * li) / den;
#pragma unroll
    for (int e = 0; e < 4; ++e) {
      const float br = p.s5_b_re[(size_t)(g * 64 + pp) * 16 + hq + e], bi = p.s5_b_im[(size_t)(g * 64 + pp) * 16 + hq + e];
      bbr[pp * 16 + hq + e] = fre * br - fim * bi; bbi[pp * 16 + hq + e] = fre * bi + fim * br;
    }
    for (int i = tid; i < 1024; i += 256) { cre[i] = p.s5_c_re[(size_t)g * 1024 + i]; cim[i] = p.s5_c_im[(size_t)g * 1024 + i]; }
  }
  __syncthreads();
  u16* mf = (u16*)(p.ws + OFF_MF) + (size_t)g * 512 * UXW;
  u16* eg = (u16*)(p.ws + OFF_EG) + (size_t)g * 128 * 512;
  {
    const int h = tid >> 4, hp = tid & 15;
    float kv = 0.f;
    for (int pp = 0; pp < 64; ++pp) {
      const float cr = cre[h * 64 + pp], ci = cim[h * 64 + pp], pr = pwr[pp], pi = pwi[pp];
      kv += (cr * pr - ci * pi) * bbr[pp * 16 + hp] - (cr * pi + ci * pr) * bbi[pp * 16 + hp];
    }
    const u16 kb = f2bf(kv);
    for (int s0 = 0; s0 + tau < 32; ++s0) mf[b_off((s0 + tau) * 16 + h, s0 * 16 + hp, 20)] = kb;
    for (int t0 = 0; t0 + tau + 1 < 32; ++t0) mf[b_off(t0 * 16 + h, (t0 + tau + 1) * 16 + hp, 20)] = 0;
#pragma unroll
    for (int e = 0; e < 4; ++e) {
      const int pp = hp * 4 + e;
      const float cr = cre[h * 64 + pp], ci = cim[h * 64 + pp], pr = p1r[pp], pi = p1i[pp];
      mf[b_off(tau * 16 + h, 512 + pp, 20)] = f2bf(cr * pr - ci * pi);
      mf[b_off(tau * 16 + h, 576 + pp, 20)] = f2bf(-(cr * pi + ci * pr));
    }
  }
  {
    const int pp = tid >> 2, hq = (tid & 3) * 4, s0 = 31 - tau;
#pragma unroll
    for (int e = 0; e < 4; ++e) {
      const float br = bbr[pp * 16 + hq + e], bi = bbi[pp * 16 + hq + e], pr = pwr[pp], pi = pwi[pp];
      eg[b_off(pp, s0 * 16 + hq + e, 16)] = f2bf(pr * br - pi * bi);
      eg[b_off(64 + pp, s0 * 16 + hq + e, 16)] = f2bf(pr * bi + pi * br);
    }
  }
  __syncthreads();
}

__device__ __forceinline__ void phase0(const Params& p, char* smem, int bid, int nblk) {
  const int tid = otid();
  for (int it = bid; it < N_TR_ITEMS + N_MOD_ITEMS + 1024; it += nblk) {
    if (it >= N_TR_ITEMS + N_MOD_ITEMS) { s5_table_item(p, it - N_TR_ITEMS - N_MOD_ITEMS, smem); continue; }
    if (it < N_TR_ITEMS) {
      int rem = it, j = 0; TrJob jb;
      for (;; ++j) { jb = get_job(p, j); int n = (jb.Nd >> 6) * (jb.K >> 6); if (rem < n) break; rem -= n; }
      const int nk = jb.K >> 6, R0 = (rem / nk) * 64, k0 = (rem % nk) * 64;
      u16* s = (u16*)smem;
      {
        const int r = tid & 63, kk = tid >> 6;
        const float* sp = jb.src + (size_t)k0 * jb.Nsrc + src_col(R0 + r, jb.mode);
#pragma unroll
        for (int i = 0; i < 16; ++i) { int k = kk + 4 * i; s[r * 72 + k] = f2bf(sp[(size_t)k * jb.Nsrc]); }
      }
      __syncthreads();
      {
        const int r = tid >> 2, ch = tid & 3;
#pragma unroll
        for (int i = 0; i < 2; ++i) {
          int c8 = (ch + 4 * i) * 8;
          *(u32x4*)(jb.dst + b_off(R0 + r, k0 + c8, jb.K >> 5)) = *(const u32x4*)(s + r * 72 + c8);
        }
      }
      __syncthreads();
    } else {
      const int mi = it - N_TR_ITEMS, l = mi / 384, n0 = (mi % 384) * 16;
      float* cact = (float*)smem;
      float* red = cact + 4096;
      for (int i = tid; i < 4096; i += 256) cact[i] = silu_(p.c[i]);
      __syncthreads();
      const int cl = tid & 15, ksub = tid >> 4;
      float a0 = 0, a1 = 0, a2 = 0, a3 = 0;
      const float* wp = p.ada_w + (size_t)l * 1024 * 6144 + n0 + cl;
#pragma unroll 16
      for (int k = ksub * 64; k < ksub * 64 + 64; ++k) {
        float w = wp[(size_t)k * 6144];
        a0 += cact[k] * w; a1 += cact[1024 + k] * w; a2 += cact[2048 + k] * w; a3 += cact[3072 + k] * w;
      }
      red[(ksub * 4 + 0) * 16 + cl] = a0; red[(ksub * 4 + 1) * 16 + cl] = a1;
      red[(ksub * 4 + 2) * 16 + cl] = a2; red[(ksub * 4 + 3) * 16 + cl] = a3;
      __syncthreads();
      if (tid < 64) {
        const int b = tid >> 4;
        float sum = 0.f;
#pragma unroll
        for (int q = 0; q < 16; ++q) sum += red[(q * 4 + b) * 16 + cl];
        float* mod = (float*)(p.ws + OFF_MOD);
        mod[(size_t)(l * 4 + b) * 6144 + n0 + cl] = sum + p.ada_b[l * 6144 + n0 + cl];
      }
      __syncthreads();
    }
  }
}

template <int MODE>
__device__ __forceinline__ void norm_phase(const Params& p, const float* src, const float* w, const float* modl, int sh_off, int sc_off,
                           char* smem, int bid, int nblk) {
  const int tid = otid(), wid = tid >> 6, lane = tid & 63;
  float* wba = (float*)smem;
  if (MODE == 1) {
    for (int i = tid; i < 1024 * 8; i += 256) wba[i] = p.hy_w_in[(size_t)(i >> 3) * EIN + 2048 + (i & 7)];
    __syncthreads();
  }
  u16* hn = (u16*)(p.ws + OFF_HN);
  auto process = [&](int row, f32x4 (&v)[4]) {
    float ss = 0.f;
#pragma unroll
    for (int i = 0; i < 4; ++i) ss += v[i][0] * v[i][0] + v[i][1] * v[i][1] + v[i][2] * v[i][2] + v[i][3] * v[i][3];
#pragma unroll
    for (int o = 32; o >= 1; o >>= 1) ss += __shfl_xor(ss, o);
    const float rstd = rsqrtf(ss * (1.f / 1024.f) + 1e-6f);
    const int b = row >> 13;
    float dots[8];
    if (MODE == 1) { for (int j = 0; j < 8; ++j) dots[j] = 0.f; }
#pragma unroll
    for (int i = 0; i < 4; ++i) {
      const int c0 = i * 256 + lane * 4;
      f32x4 ww = *(const f32x4*)(w + c0);
      f32x4 y;
      if (MODE == 2) {
#pragma unroll
        for (int e = 0; e < 4; ++e) y[e] = v[i][e] * rstd * ww[e];
        *(f32x4*)(p.out + (size_t)row * 1024 + c0) = y;
      } else {
        f32x4 sc = *(const f32x4*)(modl + (size_t)b * 6144 + sc_off + c0);
        f32x4 sh = *(const f32x4*)(modl + (size_t)b * 6144 + sh_off + c0);
#pragma unroll
        for (int e = 0; e < 4; ++e) y[e] = v[i][e] * rstd * ww[e] * (1.f + sc[e]) + sh[e];
        uint2 pk; pk.x = (unsigned)f2bf(y[0]) | ((unsigned)f2bf(y[1]) << 16); pk.y = (unsigned)f2bf(y[2]) | ((unsigned)f2bf(y[3]) << 16);
        *(uint2*)(hn + a_off(row, c0, 32)) = pk;
        if (MODE == 1) {
#pragma unroll
          for (int e = 0; e < 4; ++e) {
            f32x4 w0 = *(const f32x4*)(wba + (c0 + e) * 8), w1 = *(const f32x4*)(wba + (c0 + e) * 8 + 4);
#pragma unroll
            for (int j = 0; j < 4; ++j) { dots[j] += y[e] * w0[j]; dots[4 + j] += y[e] * w1[j]; }
          }
        }
      }
    }
    if (MODE == 1) {
#pragma unroll
      for (int j = 0; j < 8; ++j) {
#pragma unroll
        for (int o = 32; o >= 1; o >>= 1) dots[j] += __shfl_xor(dots[j], o);
      }
      if (lane == 0) {
        float* beta = (float*)(p.ws + OFF_BETA); float* gg = (float*)(p.ws + OFF_G);
#pragma unroll
        for (int h = 0; h < 4; ++h) {
          beta[(size_t)row * 4 + h] = sigmoid_(dots[h]);
          gg[(size_t)row * 4 + h] = -__expf(p.hy_a_log[h]) * softplus_(dots[4 + h] + p.hy_dt_bias[h]);
        }
      }
    }
  };
#pragma unroll 1
  for (int row = bid * 4 + wid; row < M; row += nblk * 8) {
    const int row1 = row + nblk * 4;
    const bool has1 = row1 < M;
    f32x4 v0[4], v1[4];
#pragma unroll
    for (int i = 0; i < 4; ++i) v0[i] = *(const f32x4*)(src + (size_t)row * 1024 + i * 256 + lane * 4);
#pragma unroll
    for (int i = 0; i < 4; ++i) v1[i] = has1 ? *(const f32x4*)(src + (size_t)row1 * 1024 + i * 256 + lane * 4) : f32x4{0.f, 0.f, 0.f, 0.f};
    process(row, v0);
    if (has1) process(row1, v1);
  }
}

enum { E_PROJ0 = 0, E_BF16 = 1, E_RESID = 2, E_GLU = 3, E_SWIGLU = 4, E_XE = 5, E_S5Y = 6 };
struct EpiArgs { float* outf; u16* outb; const float* res; const float* gate; const u16* y5; const float* bias; u16* ux; int ldc; };

template <int EPI>
__device__ __forceinline__ void gemm_phase(const u16* __restrict__ A0, int nksA, size_t sA, const u16* __restrict__ B0, int nksB, size_t sB,
                                           int K, int nM, int nN, int nbatch, const EpiArgs ea, char* smem, int bid, int nblk) {
  const int tid = otid(), wid = tid >> 6, lane = tid & 63, wr = wid >> 1, wc = wid & 1, fr = lane & 15, fq = lane >> 4;
  char* SA = smem; char* SB = smem + 49152;
  const int NR = nbatch * nM, ntiles = NR * nN;
  const int STN = (nN & 7) == 0 ? 8 : ((nN & 3) == 0 ? 4 : 1), STM = 64 / STN, nSN = nN / STN;
  const bool swz = ((nblk & 7) == 0) && (NR % STM == 0);
  const int lpx = nblk >> 3;
  int si = bid & 7, l = bid >> 3, tl = bid;
#pragma unroll 1
  for (;;) {
    int R, pn;
    if (swz) {
      if (si >= (NR / STM) * nSN) break;
      R = (si / nSN) * STM + l / STN; pn = (si % nSN) * STN + l % STN;
      l += lpx; if (l >= 64) { l = bid >> 3; si += 8; }
    } else {
      if (tl >= ntiles) break;
      R = tl / nN; pn = tl % nN; tl += nblk;
    }
    const int g = R / nM, rt = R % nM, brow = rt << 8, bcol = pn << 7;
    const char* A = (const char*)(A0 + (size_t)g * sA) + ((size_t)rt * nksA << 14) + tid * 16;
    const char* Bt = (const char*)(B0 + (size_t)g * sB) + ((size_t)pn * nksB << 13) + tid * 16;
    int nk = K >> 5, klim = nk;
    if (EPI == E_S5Y) { klim = 4 * (pn + 1); nk = klim + 4; }
    f32x4 acc[8][4];
#pragma unroll
    for (int m = 0; m < 8; ++m)
#pragma unroll
      for (int n = 0; n < 4; ++n) acc[m][n] = f32x4{0.f, 0.f, 0.f, 0.f};
#define GSTAGE(KK, BUF) do { const int kt_ = (EPI == E_S5Y && (KK) >= klim) ? (16 + (KK) - klim) : (KK); \
      _Pragma("unroll") for (int i = 0; i < 4; ++i) \
        __builtin_amdgcn_global_load_lds((const unsigned*)(A + ((size_t)kt_ << 14) + i * 4096), (__attribute__((address_space(3))) unsigned*)(SA + (BUF) * 16384 + tid * 16 + i * 4096), 16, 0, 0); \
      _Pragma("unroll") for (int i = 0; i < 2; ++i) \
        __builtin_amdgcn_global_load_lds((const unsigned*)(Bt + ((size_t)kt_ << 13) + i * 4096), (__attribute__((address_space(3))) unsigned*)(SB + (BUF) * 8192 + tid * 16 + i * 4096), 16, 0, 0); } while (0)
    asm volatile("s_waitcnt vmcnt(0)" ::: "memory");
    GSTAGE(0, 0);
    if (nk > 1) { GSTAGE(1, 1); asm volatile("s_waitcnt vmcnt(6)\n\ts_barrier" ::: "memory"); }
    else { asm volatile("s_waitcnt vmcnt(0)\n\ts_barrier" ::: "memory"); }
    int buf = 0, nbuf = 2;
#pragma unroll 1
    for (int kk = 0; kk < nk; ++kk) {
      const bool more = kk + 2 < nk;
      if (more) GSTAGE(kk + 2, nbuf);
      bf16x8 Bl[4], At[8];
#pragma unroll
      for (int n = 0; n < 4; ++n) Bl[n] = *(const bf16x8*)(SB + buf * 8192 + (wc * 64 + n * 16 + fr) * 64 + fq * 16);
#pragma unroll
      for (int m = 0; m < 8; ++m) At[m] = *(const bf16x8*)(SA + buf * 16384 + (wr * 128 + m * 16 + fr) * 64 + fq * 16);
#pragma unroll
      for (int m = 0; m < 8; ++m)
#pragma unroll
        for (int n = 0; n < 4; ++n) acc[m][n] = __builtin_amdgcn_mfma_f32_16x16x32_bf16(Bl[n], At[m], acc[m][n], 0, 0, 0);
      if (more) asm volatile("s_waitcnt vmcnt(6)\n\ts_barrier" ::: "memory");
      else asm volatile("s_waitcnt vmcnt(0)\n\ts_barrier" ::: "memory");
      buf = (buf == 2) ? 0 : buf + 1; nbuf = (nbuf == 2) ? 0 : nbuf + 1;
    }
#undef GSTAGE
#pragma unroll
    for (int m = 0; m < 8; ++m)
#pragma unroll
      for (int n = 0; n < 4; ++n) {
        const int row = brow + wr * 128 + m * 16 + fr, col = bcol + wc * 64 + n * 16 + fq * 4;
        const f32x4 v = acc[m][n];
        if (EPI == E_PROJ0) {
          const uint2 pk = uint2{pk2(v[0], v[1]), pk2(v[2], v[3])};
          if (bcol < 2048) *(uint2*)(ea.outb + pj_idx(row, col)) = pk;
          else { const int cc = col - 2048; *(uint2*)(ea.ux + (size_t)(cc >> 4) * S5C * UXW + a_off(row >> 5, (row & 31) * 16 + (cc & 15), 20)) = pk; }
        }
        if (EPI == E_BF16) *(uint2*)(ea.outb + (size_t)row * ea.ldc + col) = uint2{pk2(v[0], v[1]), pk2(v[2], v[3])};
        if (EPI == E_RESID) {
          const size_t idx = (size_t)row * 1024 + col;
          const f32x4 r4 = *(const f32x4*)(ea.res + idx), g4 = *(const f32x4*)(ea.gate + (size_t)(row >> 13) * 6144 + col);
          *(f32x4*)(ea.outf + idx) = f32x4{r4[0] + g4[0] * v[0], r4[1] + g4[1] * v[1], r4[2] + g4[2] * v[2], r4[3] + g4[3] * v[3]};
        }
        if (EPI == E_GLU) {
          const uint2 yy = *(const uint2*)(ea.y5 + a_off(row, col, 16));
          const f32x4 b4 = *(const f32x4*)(ea.bias + col);
          const float y0 = __uint_as_float(yy.x << 16), y1 = __uint_as_float(yy.x & 0xffff0000u), y2 = __uint_as_float(yy.y << 16), y3 = __uint_as_float(yy.y & 0xffff0000u);
          *(uint2*)(ea.outb + a_off(row, 512 + col, 32)) = uint2{pk2(y0 * sigmoid_(v[0] + b4[0]), y1 * sigmoid_(v[1] + b4[1])), pk2(y2 * sigmoid_(v[2] + b4[2]), y3 * sigmoid_(v[3] + b4[3]))};
        }
        if (EPI == E_SWIGLU) {
          if ((n & 1) == 0) {
            const f32x4 u = acc[m][n | 1];
            const int co = (bcol >> 1) + wc * 32 + (n >> 1) * 16 + fq * 4;
            *(uint2*)(ea.outb + a_off(row, co, FF / 32)) = uint2{pk2(silu_(v[0]) * u[0], silu_(v[1]) * u[1]), pk2(silu_(v[2]) * u[2], silu_(v[3]) * u[3])};
          }
        }
        if (EPI == E_XE) *(f32x4*)(ea.outf + ((size_t)g * S5C + row) * 128 + col) = v;
        if (EPI == E_S5Y) {
          const uint2 uu = *(const uint2*)(ea.ux + (size_t)g * S5C * UXW + a_off(row, col, 20));
          const f32x4 d4 = *(const f32x4*)(ea.bias + g * 16 + (col & 15));
          const float u0 = __uint_as_float(uu.x << 16), u1 = __uint_as_float(uu.x & 0xffff0000u), u2 = __uint_as_float(uu.y << 16), u3 = __uint_as_float(uu.y & 0xffff0000u);
          *(uint2*)(ea.outb + a_off(row * 32 + (col >> 4), g * 16 + (col & 15), 16)) =
              uint2{pk2(gelu_tanh_(v[0] + d4[0] * u0), gelu_tanh_(v[1] + d4[1] * u1)), pk2(gelu_tanh_(v[2] + d4[2] * u2), gelu_tanh_(v[3] + d4[3] * u3))};
        }
      }
  }
}

__device__ __forceinline__ void s5_carry_phase(const Params& p, int bid, int nblk) {
  const float* xe = (const float*)(p.ws + OFF_XE); const float* a32 = (const float*)(p.ws + OFF_A32);
  u16* ux = (u16*)(p.ws + OFF_UX);
  for (int it = bid; it < 32; it += nblk) {
    const int idx = it * 256 + otid(), pp = idx & 63, g = (idx >> 6) & 31, b = idx >> 11;
    const float ar = a32[(g * 64 + pp) * 2], ai = a32[(g * 64 + pp) * 2 + 1];
    float xr = 0.f, xi = 0.f;
    const size_t cbase = (size_t)g * S5C + b * 256, gbase = (size_t)g * S5C * UXW;
    for (int n = 0; n < 256; n += 8) {
      float er[8], ei[8];
#pragma unroll
      for (int e = 0; e < 8; ++e) { er[e] = xe[(cbase + n + e) * 128 + pp]; ei[e] = xe[(cbase + n + e) * 128 + 64 + pp]; }
#pragma unroll
      for (int e = 0; e < 8; ++e) {
        ux[gbase + a_off(b * 256 + n + e, 512 + pp, 20)] = f2bf(xr); ux[gbase + a_off(b * 256 + n + e, 576 + pp, 20)] = f2bf(xi);
        const float nr = ar * xr - ai * xi + er[e], ni = ar * xi + ai * xr + ei[e];
        xr = nr; xi = ni;
      }
    }
  }
}

__device__ __forceinline__ int crow(int r, int hi) { return (r & 3) + 8 * (r >> 2) + 4 * hi; }
using f32x16 = __attribute__((ext_vector_type(16))) float;
__device__ __forceinline__ void unpack8(const u32x4 w, float* f) {
#pragma unroll
  for (int e = 0; e < 4; ++e) { f[2 * e] = __uint_as_float(w[e] << 16); f[2 * e + 1] = __uint_as_float(w[e] & 0xffff0000u); }
}
__device__ __forceinline__ void gdn_prep_phase(const Params& p, char* smem, int bid, int nblk) {
  const int tid = otid(), wid = tid >> 6, lane = tid & 63, fr = lane & 15, fq = lane >> 4;
  u16* qs = (u16*)smem;
  u16* ks = qs + 64 * 136;
  float* Lm = (float*)(ks + 64 * 136);
  float* gcs = Lm + 4096; float* bts = gcs + 64; float* egs = bts + 64;
  const u16* proj = (const u16*)(p.ws + OFF_PROJ);
  const float* beta = (const float*)(p.ws + OFF_BETA); const float* gg = (const float*)(p.ws + OFF_G);
#pragma unroll 1
  for (int it = bid; it < 2048; it += nblk) {
    const int n = it & 127, bh = it >> 7, b = bh >> 2, h = bh & 3;
    const size_t row0 = (size_t)b * SEQ + n * 64;
    if (wid == 0) {
      float c = gg[(row0 + lane) * 4 + h];
#pragma unroll
      for (int o = 1; o < 64; o <<= 1) { const float tt = __shfl_up(c, o); if (lane >= o) c += tt; }
      gcs[lane] = c; egs[lane] = __expf(c); bts[lane] = beta[(row0 + lane) * 4 + h];
    }
    {
      const int tok = tid >> 2, part = tid & 3, l = n * 64 + tok;
      float qo[32], ko[32]; float sq = 0.f, sk = 0.f;
#pragma unroll
      for (int cb = 0; cb < 4; ++cb) {
        const int colq = h * 128 + part * 32 + cb * 8, colk = 512 + colq;
        const size_t kblk = (size_t)M * 512 - 512;
        float aq[8], ak[8];
#pragma unroll
        for (int e = 0; e < 8; ++e) { aq[e] = 0.f; ak[e] = 0.f; }
#pragma unroll
        for (int j = 0; j < 4; ++j) {
          const int lt = l - 3 + j;
          if (lt >= 0) {
            const u16* rp = proj + ((size_t)b * SEQ + lt) * 512;
            float xq[8], xk[8];
            unpack8(*(const u32x4*)(rp + colq), xq); unpack8(*(const u32x4*)(rp + kblk + colk), xk);
            const f32x4 wq0 = *(const f32x4*)(p.hy_conv_w + j * 1536 + colq), wq1 = *(const f32x4*)(p.hy_conv_w + j * 1536 + colq + 4);
            const f32x4 wk0 = *(const f32x4*)(p.hy_conv_w + j * 1536 + colk), wk1 = *(const f32x4*)(p.hy_conv_w + j * 1536 + colk + 4);
#pragma unroll
            for (int e = 0; e < 4; ++e) { aq[e] += wq0[e] * xq[e]; aq[4 + e] += wq1[e] * xq[4 + e]; ak[e] += wk0[e] * xk[e]; ak[4 + e] += wk1[e] * xk[4 + e]; }
          }
        }
#pragma unroll
        for (int e = 0; e < 8; ++e) { const float a = silu_(aq[e]), k = silu_(ak[e]); qo[cb * 8 + e] = a; ko[cb * 8 + e] = k; sq += a * a; sk += k * k; }
      }
      sq += __shfl_xor(sq, 1); sq += __shfl_xor(sq, 2); sk += __shfl_xor(sk, 1); sk += __shfl_xor(sk, 2);
      const float rq = rsqrtf(sq + 1e-6f) * 0.08838834764831845f, rk = rsqrtf(sk + 1e-6f);
#pragma unroll
      for (int cb = 0; cb < 4; ++cb) {
        u32x4 wq, wk;
#pragma unroll
        for (int e = 0; e < 4; ++e) { wq[e] = pk2(qo[cb * 8 + 2 * e] * rq, qo[cb * 8 + 2 * e + 1] * rq); wk[e] = pk2(ko[cb * 8 + 2 * e] * rk, ko[cb * 8 + 2 * e + 1] * rk); }
        *(u32x4*)(qs + tok * 136 + part * 32 + cb * 8) = wq; *(u32x4*)(ks + tok * 136 + part * 32 + cb * 8) = wk;
      }
    }
    __syncthreads();
    {
      f32x4 akk[4], aqk[4];
#pragma unroll
      for (int nb = 0; nb < 4; ++nb) { akk[nb] = f32x4{0.f, 0.f, 0.f, 0.f}; aqk[nb] = f32x4{0.f, 0.f, 0.f, 0.f}; }
#pragma unroll
      for (int kk = 0; kk < 4; ++kk) {
        const bf16x8 ak = *(const bf16x8*)(ks + (16 * wid + fr) * 136 + kk * 32 + fq * 8);
        const bf16x8 aq = *(const bf16x8*)(qs + (16 * wid + fr) * 136 + kk * 32 + fq * 8);
#pragma unroll
        for (int nb = 0; nb < 4; ++nb) {
          const bf16x8 bk = *(const bf16x8*)(ks + (16 * nb + fr) * 136 + kk * 32 + fq * 8);
          akk[nb] = __builtin_amdgcn_mfma_f32_16x16x32_bf16(ak, bk, akk[nb], 0, 0, 0);
          aqk[nb] = __builtin_amdgcn_mfma_f32_16x16x32_bf16(aq, bk, aqk[nb], 0, 0, 0);
        }
      }
      u16* att = (u16*)(p.ws + OFF_GAT) + (size_t)it * 4096;
#pragma unroll
      for (int nb = 0; nb < 4; ++nb)
#pragma unroll
        for (int r = 0; r < 4; ++r) {
          const int i = 16 * wid + fq * 4 + r, j = 16 * nb + fr;
          const float dec = __expf(fminf(gcs[i] - gcs[j], 0.f));
          Lm[i * 64 + j] = (i > j) ? bts[i] * akk[nb][r] * dec : 0.f;
          att[i * 64 + j] = f2bf((i >= j) ? aqk[nb][r] * dec : 0.f);
        }
    }
    __syncthreads();
    {
      float x[64];
      if (tid < 128) {
        const int col = 1024 + h * 128 + tid;
        const u16* vp = proj + (size_t)2 * M * 512 + h * 128 + tid;
        const float w0 = p.hy_conv_w[col], w1 = p.hy_conv_w[1536 + col], w2 = p.hy_conv_w[2 * 1536 + col], w3 = p.hy_conv_w[3 * 1536 + col];
        float x1 = 0.f, x2 = 0.f, x3 = 0.f;
        if (n > 0) { x3 = bf2f(vp[(row0 - 3) * 512]); x2 = bf2f(vp[(row0 - 2) * 512]); x1 = bf2f(vp[(row0 - 1) * 512]); }
#pragma unroll
        for (int i = 0; i < 64; ++i) {
          const float xv = bf2f(vp[(row0 + i) * 512]);
          x[i] = silu_(w0 * x3 + w1 * x2 + w2 * x1 + w3 * xv) * bts[i];
          x3 = x2; x2 = x1; x1 = xv;
        }
      } else {
#pragma unroll
        for (int i = 0; i < 64; ++i) x[i] = bf2f(ks[i * 136 + tid - 128]) * bts[i] * egs[i];
      }
#pragma unroll
      for (int i = 1; i < 64; ++i) {
        float acc = x[i];
#pragma unroll
        for (int j4 = 0; j4 < (i + 3) / 4; ++j4) {
          const f32x4 l4 = *(const f32x4*)(Lm + i * 64 + j4 * 4);
#pragma unroll
          for (int e = 0; e < 4; ++e) if (j4 * 4 + e < i) acc -= l4[e] * x[j4 * 4 + e];
        }
        x[i] = acc;
      }
      if (tid < 128) {
        u16* ut = (u16*)(p.ws + OFF_GUT) + (size_t)it * 8192 + tid * 64;
#pragma unroll
        for (int c8 = 0; c8 < 8; ++c8) {
          u32x4 w;
#pragma unroll
          for (int e = 0; e < 4; ++e) w[e] = pk2(x[c8 * 8 + 2 * e], x[c8 * 8 + 2 * e + 1]);
          *(u32x4*)(ut + c8 * 8) = w;
        }
      } else {
        u16* wg = (u16*)(p.ws + OFF_GW) + (size_t)it * 8192 + (tid - 128);
#pragma unroll
        for (int i = 0; i < 64; ++i) wg[i * 128] = f2bf(x[i]);
      }
    }
    {
      u16* qd = (u16*)(p.ws + OFF_GQD) + (size_t)it * 8192;
#pragma unroll
      for (int k = 0; k < 4; ++k) {
        const int piece = tid + 256 * k, i = piece >> 4, d0 = (piece & 15) * 8;
        float f[8]; unpack8(*(const u32x4*)(qs + i * 136 + d0), f);
        const float e = egs[i];
        u32x4 w;
#pragma unroll
        for (int e2 = 0; e2 < 4; ++e2) w[e2] = pk2(f[2 * e2] * e, f[2 * e2 + 1] * e);
        *(u32x4*)(qd + i * 128 + d0) = w;
      }
      u16* kt = (u16*)(p.ws + OFF_GKT) + (size_t)it * 8192;
      const int dk = tid & 127, half = tid >> 7;
      const float gl = gcs[63];
#pragma unroll
      for (int c8 = 0; c8 < 4; ++c8) {
        u32x4 w;
#pragma unroll
        for (int e = 0; e < 4; ++e) {
          const int i0 = half * 32 + c8 * 8 + 2 * e;
          w[e] = pk2(bf2f(ks[i0 * 136 + dk]) * __expf(gl - gcs[i0]), bf2f(ks[(i0 + 1) * 136 + dk]) * __expf(gl - gcs[i0 + 1]));
        }
        *(u32x4*)(kt + dk * 64 + half * 32 + c8 * 8) = w;
      }
      if (tid == 0) ((float*)(p.ws + OFF_GSD))[it] = egs[63];
    }
    __syncthreads();
  }
}

__device__ __forceinline__ uint2 lds64(const char* p) { return *(const uint2*)p; }
__device__ __forceinline__ bf16x8 mk8(uint2 a, uint2 b) { u32x4 w = {a.x, a.y, b.x, b.y}; return __builtin_bit_cast(bf16x8, w); }
__device__ __forceinline__ bf16x8 pack8(const f32x16& x, int s) {
  u32x4 w = {pk2(x[8 * s], x[8 * s + 1]), pk2(x[8 * s + 2], x[8 * s + 3]), pk2(x[8 * s + 4], x[8 * s + 5]), pk2(x[8 * s + 6], x[8 * s + 7])};
  return __builtin_bit_cast(bf16x8, w);
}
__device__ __forceinline__ void gdn_scan_item(const Params& p, int bh, char* smem) {
  const int tid = otid(), wid = tid >> 6, lane = tid & 63, r32 = lane & 31, hi = lane >> 5;
  char* Wl = smem; char* KTl = smem + 16896;
  const char* gw = p.ws + OFF_GW; const char* gkt = p.ws + OFF_GKT;
  const u16* gut = (const u16*)(p.ws + OFF_GUT);
  const float* gsd = (const float*)(p.ws + OFF_GSD);
  u32x4* sbg = (u32x4*)(p.ws + OFF_PROJ); u32x4* vbg = (u32x4*)(p.ws + OFF_PROJ + (size_t)2048 * 32768);
  f32x16 S[4];
#pragma unroll
  for (int T = 0; T < 4; ++T)
#pragma unroll
    for (int r = 0; r < 16; ++r) S[T][r] = 0.f;
  u32x4 sa[8], sb_[8]; uint2 uc[8];
  const int dv = wid * 32 + r32;
#define G_LOAD(ST, IT) do { const size_t o16 = (size_t)(IT) * 16384; \
    _Pragma("unroll") for (int k = 0; k < 4; ++k) { ST[k] = *(const u32x4*)(gw + o16 + (tid + 256 * k) * 16); ST[4 + k] = *(const u32x4*)(gkt + o16 + (tid + 256 * k) * 16); } } while (0)
#define U_LOAD(IT) do { _Pragma("unroll") for (int k = 0; k < 8; ++k) uc[k] = *(const uint2*)(gut + (size_t)(IT) * 8192 + dv * 64 + 32 * (k >> 2) + 8 * (k & 3) + 4 * hi); } while (0)
#define G_WRITE(ST) do { \
    _Pragma("unroll") for (int k = 0; k < 4; ++k) { const int pc = tid + 256 * k; \
      { char* d = Wl + (pc >> 4) * 264 + (pc & 15) * 16; *(uint2*)d = uint2{ST[k][0], ST[k][1]}; *(uint2*)(d + 8) = uint2{ST[k][2], ST[k][3]}; } \
      { char* d = KTl + (pc >> 3) * 136 + (pc & 7) * 16; *(uint2*)d = uint2{ST[4 + k][0], ST[4 + k][1]}; *(uint2*)(d + 8) = uint2{ST[4 + k][2], ST[4 + k][3]}; } } } while (0)
#define SCAN_STEP(N, NXT, FAR) do { const int n = (N); const int item = bh * 128 + n; \
    const float sd_nxt = gsd[item + (n + 1 < 128 ? 1 : 0)]; \
    if (n + 2 < 128) G_LOAD(FAR, item + 2); \
    f32x16 av[2]; \
    _Pragma("unroll") for (int r = 0; r < 16; ++r) { av[0][r] = 0.f; av[1][r] = 0.f; } \
    _Pragma("unroll") for (int T = 0; T < 4; ++T) \
      _Pragma("unroll") for (int s = 0; s < 2; ++s) { \
        const bf16x8 sb = pack8(S[T], s); \
        sbg[((size_t)(item * 4 + wid) * 8 + T * 2 + s) * 64 + lane] = __builtin_bit_cast(u32x4, sb); \
        const int cb = (32 * T + 16 * s + 4 * hi) * 2; \
        _Pragma("unroll") for (int it = 0; it < 2; ++it) { \
          const char* wp = Wl + (32 * it + r32) * 264 + cb; \
          av[it] = __builtin_amdgcn_mfma_f32_32x32x16_bf16(mk8(lds64(wp), lds64(wp + 16)), sb, av[it], 0, 0, 0); } } \
    bf16x8 vb[2][2]; \
    _Pragma("unroll") for (int it = 0; it < 2; ++it) { \
      f32x16 vn; \
      _Pragma("unroll") for (int g = 0; g < 4; ++g) { const uint2 u2 = uc[it * 4 + g]; \
        vn[4 * g] = __uint_as_float(u2.x << 16) - av[it][4 * g]; vn[4 * g + 1] = __uint_as_float(u2.x & 0xffff0000u) - av[it][4 * g + 1]; \
        vn[4 * g + 2] = __uint_as_float(u2.y << 16) - av[it][4 * g + 2]; vn[4 * g + 3] = __uint_as_float(u2.y & 0xffff0000u) - av[it][4 * g + 3]; } \
      vb[it][0] = pack8(vn, 0); vb[it][1] = pack8(vn, 1); \
      vbg[((size_t)(item * 4 + wid) * 4 + it * 2) * 64 + lane] = __builtin_bit_cast(u32x4, vb[it][0]); \
      vbg[((size_t)(item * 4 + wid) * 4 + it * 2 + 1) * 64 + lane] = __builtin_bit_cast(u32x4, vb[it][1]); } \
    if (n + 1 < 128) U_LOAD(item + 1); \
    _Pragma("unroll") for (int T = 0; T < 4; ++T) { \
      _Pragma("unroll") for (int r = 0; r < 16; ++r) S[T][r] *= sd_cur; \
      _Pragma("unroll") for (int it = 0; it < 2; ++it) \
        _Pragma("unroll") for (int s = 0; s < 2; ++s) { \
          const char* kp = KTl + (32 * T + r32) * 136 + (32 * it + 16 * s + 4 * hi) * 2; \
          S[T] = __builtin_amdgcn_mfma_f32_32x32x16_bf16(mk8(lds64(kp), lds64(kp + 16)), vb[it][s], S[T], 0, 0, 0); } } \
    sd_cur = sd_nxt; \
    __syncthreads(); \
    if (n + 1 < 128) G_WRITE(NXT); \
    __syncthreads(); } while (0)
  float sd_cur = gsd[bh * 128];
  G_LOAD(sa, bh * 128); U_LOAD(bh * 128); G_WRITE(sa);
  G_LOAD(sb_, bh * 128 + 1);
  __syncthreads();
#pragma unroll 1
  for (int n2 = 0; n2 < 128; n2 += 2) {
    SCAN_STEP(n2, sb_, sa);
    SCAN_STEP(n2 + 1, sa, sb_);
  }
#undef SCAN_STEP
#undef G_LOAD
#undef G_WRITE
#undef U_LOAD
}

__device__ __forceinline__ void gdn_out_phase(const Params& p, char* smem, int bid, int nblk) {
  const int tid = otid(), wid = tid >> 6, lane = tid & 63, r32 = lane & 31, hi = lane >> 5;
  char* QDl = smem; char* ATl = smem + 16896; float* Ol = (float*)(smem + 16896 + 8704);
  const char* gqd = p.ws + OFF_GQD; const char* gat = p.ws + OFF_GAT;
  const u32x4* sbg = (const u32x4*)(p.ws + OFF_PROJ); const u32x4* vbg = (const u32x4*)(p.ws + OFF_PROJ + (size_t)2048 * 32768);
  const u16* zb = (const u16*)(p.ws + OFF_PROJ) + (size_t)3 * M * 512;
  u16* concat = (u16*)(p.ws + OFF_HN);
#pragma unroll 1
  for (int item = bid; item < 2048; item += nblk) {
    const int n = item & 127, bh = item >> 7, b = bh >> 2, h = bh & 3;
    {
      u32x4 st[6];
#pragma unroll
      for (int k = 0; k < 4; ++k) st[k] = *(const u32x4*)(gqd + (size_t)item * 16384 + (tid + 256 * k) * 16);
#pragma unroll
      for (int k = 0; k < 2; ++k) st[4 + k] = *(const u32x4*)(gat + (size_t)item * 8192 + (tid + 256 * k) * 16);
#pragma unroll
      for (int k = 0; k < 4; ++k) { const int pc = tid + 256 * k; char* d = QDl + (pc >> 4) * 264 + (pc & 15) * 16;
        *(uint2*)d = uint2{st[k][0], st[k][1]}; *(uint2*)(d + 8) = uint2{st[k][2], st[k][3]}; }
#pragma unroll
      for (int k = 0; k < 2; ++k) { const int pc = tid + 256 * k; char* d = ATl + (pc >> 3) * 136 + (pc & 7) * 16;
        *(uint2*)d = uint2{st[4 + k][0], st[4 + k][1]}; *(uint2*)(d + 8) = uint2{st[4 + k][2], st[4 + k][3]}; }
    }
    bf16x8 sb[8], vb[4];
#pragma unroll
    for (int f = 0; f < 8; ++f) sb[f] = __builtin_bit_cast(bf16x8, sbg[((size_t)(item * 4 + wid) * 8 + f) * 64 + lane]);
#pragma unroll
    for (int f = 0; f < 4; ++f) vb[f] = __builtin_bit_cast(bf16x8, vbg[((size_t)(item * 4 + wid) * 4 + f) * 64 + lane]);
    __syncthreads();
    f32x16 ao[2];
#pragma unroll
    for (int r = 0; r < 16; ++r) { ao[0][r] = 0.f; ao[1][r] = 0.f; }
#pragma unroll
    for (int T = 0; T < 4; ++T)
#pragma unroll
      for (int s = 0; s < 2; ++s) {
        const int cb = (32 * T + 16 * s + 4 * hi) * 2;
#pragma unroll
        for (int it = 0; it < 2; ++it) {
          const char* qp = QDl + (32 * it + r32) * 264 + cb;
          ao[it] = __builtin_amdgcn_mfma_f32_32x32x16_bf16(mk8(lds64(qp), lds64(qp + 16)), sb[T * 2 + s], ao[it], 0, 0, 0);
        }
      }
#pragma unroll
    for (int it2 = 0; it2 < 2; ++it2)
#pragma unroll
      for (int it = 0; it <= it2; ++it)
#pragma unroll
        for (int s = 0; s < 2; ++s) {
          const char* ap = ATl + (32 * it2 + r32) * 136 + (32 * it + 16 * s + 4 * hi) * 2;
          ao[it2] = __builtin_amdgcn_mfma_f32_32x32x16_bf16(mk8(lds64(ap), lds64(ap + 16)), vb[it * 2 + s], ao[it2], 0, 0, 0);
        }
#pragma unroll
    for (int it = 0; it < 2; ++it)
#pragma unroll
      for (int r = 0; r < 16; ++r) Ol[(32 * it + crow(r, hi)) * 132 + wid * 32 + r32] = ao[it][r];
    __syncthreads();
    {
      const int tok = tid >> 2, part = tid & 3;
      const int row = b * SEQ + n * 64 + tok;
      f32x4 a[8]; float ss = 0.f;
#pragma unroll
      for (int k = 0; k < 8; ++k) { a[k] = *(const f32x4*)(Ol + tok * 132 + part * 32 + k * 4); ss += a[k][0] * a[k][0] + a[k][1] * a[k][1] + a[k][2] * a[k][2] + a[k][3] * a[k][3]; }
      ss += __shfl_xor(ss, 1); ss += __shfl_xor(ss, 2);
      const float rs = rsqrtf(ss * (1.f / 128.f) + 1e-6f);
      const u16* zp = zb + (size_t)row * 512 + h * 128 + part * 32;
      const float* hw = p.hy_head_norm_w + part * 32;
      u16* cp = concat + a_off(row, h * 128 + part * 32, 32);
#pragma unroll
      for (int k = 0; k < 4; ++k) {
        float zf[8]; unpack8(*(const u32x4*)(zp + k * 8), zf);
        const f32x4 h0 = *(const f32x4*)(hw + k * 8), h1 = *(const f32x4*)(hw + k * 8 + 4);
        const f32x4 x0 = a[2 * k], x1 = a[2 * k + 1];
        u32x4 w;
        w[0] = pk2(x0[0] * rs * h0[0] * silu_(zf[0]), x0[1] * rs * h0[1] * silu_(zf[1]));
        w[1] = pk2(x0[2] * rs * h0[2] * silu_(zf[2]), x0[3] * rs * h0[3] * silu_(zf[3]));
        w[2] = pk2(x1[0] * rs * h1[0] * silu_(zf[4]), x1[1] * rs * h1[1] * silu_(zf[5]));
        w[3] = pk2(x1[2] * rs * h1[2] * silu_(zf[6]), x1[3] * rs * h1[3] * silu_(zf[7]));
        *(u32x4*)(cp + k * 8) = w;
      }
    }
    __syncthreads();
  }
}

using s16x4 = __attribute__((ext_vector_type(4))) short;
#define KSWZ(row, colB) ((row) * 256 + ((colB) ^ (((row) & 7) << 4)))
#define SBAR() __builtin_amdgcn_sched_barrier(0)
__device__ __forceinline__ unsigned cvtpk(float lo, float hi) { unsigned r; asm volatile("v_cvt_pk_bf16_f32 %0, %1, %2" : "=v"(r) : "v"(lo), "v"(hi)); return r; }
__device__ __forceinline__ int v_st(int k, int c) { const int kk = (k & ~0xC) | ((k & 4) << 1) | ((k & 8) >> 1); return ((kk >> 3) * 4 + (c >> 5)) * 512 + ((kk & 7) * 32 + (c & 31)) * 2; }
__device__ __forceinline__ int v_rd_base(int lane) { return ((lane & 3) << 3) | (((lane >> 2) & 3) << 6) | (((lane >> 4) & 1) << 5) | (((lane >> 5) & 1) << 8); }
constexpr int v_rd_off(int d0, int ks, int half) { return d0 * 512 + ks * 4096 + half * 2048; }
template <int OFF> __device__ __forceinline__ s16x4 tr_read(int vb) {
  s16x4 r; asm volatile("ds_read_b64_tr_b16 %0, %1 offset:%2" : "=&v"(r) : "v"(vb), "i"(OFF) : "memory"); return r;
}
template <int D0> __device__ __forceinline__ void pv_one(f32x16& od, int vb, bf16x8 pa0, bf16x8 pa1, bf16x8 pa2, bf16x8 pa3) {
  const s16x4 l0 = tr_read<v_rd_off(D0, 0, 0)>(vb), h0 = tr_read<v_rd_off(D0, 0, 1)>(vb), l1 = tr_read<v_rd_off(D0, 1, 0)>(vb), h1 = tr_read<v_rd_off(D0, 1, 1)>(vb);
  const s16x4 l2 = tr_read<v_rd_off(D0, 2, 0)>(vb), h2 = tr_read<v_rd_off(D0, 2, 1)>(vb), l3 = tr_read<v_rd_off(D0, 3, 0)>(vb), h3 = tr_read<v_rd_off(D0, 3, 1)>(vb);
  asm volatile("s_waitcnt lgkmcnt(0)" ::: "memory"); SBAR();
#define PK(L, H) (bf16x8){L[0], L[1], L[2], L[3], H[0], H[1], H[2], H[3]}
  od = __builtin_amdgcn_mfma_f32_32x32x16_bf16(pa0, PK(l0, h0), od, 0, 0, 0);
  od = __builtin_amdgcn_mfma_f32_32x32x16_bf16(pa1, PK(l1, h1), od, 0, 0, 0);
  od = __builtin_amdgcn_mfma_f32_32x32x16_bf16(pa2, PK(l2, h2), od, 0, 0, 0);
  od = __builtin_amdgcn_mfma_f32_32x32x16_bf16(pa3, PK(l3, h3), od, 0, 0, 0);
#undef PK
}
__device__ __forceinline__ float pl32_other(float a, float b, int hi) {
  auto rr = __builtin_amdgcn_permlane32_swap(__float_as_uint(a), __float_as_uint(b), false, false);
  return __uint_as_float(hi ? rr[0] : rr[1]);
}
__device__ __forceinline__ void sb_half(f32x16& pz, float& run, bool need_mask, int kb, int t, int hi) {
  constexpr float C2 = 0.08838834764831845f * 1.4426950408889634f;
  f32x16 l;
#pragma unroll
  for (int r = 0; r < 16; ++r) {
    const float e = __builtin_amdgcn_exp2f(fminf(pz[r] * C2, 60.f));
    l[r] = __builtin_amdgcn_rcpf(1.f + e);
    pz[r] = e;
  }
  if (need_mask) {
#pragma unroll
    for (int r = 0; r < 16; ++r) { if (kb + crow(r, hi) >= t) { l[r] = 1.f; pz[r] = 0.f; } }
  }
#pragma unroll
  for (int g = 0; g < 4; ++g) { l[4 * g + 2] *= l[4 * g + 3]; l[4 * g + 1] *= l[4 * g + 2]; l[4 * g] *= l[4 * g + 1]; }
  const float cs3 = l[12], cs2 = l[8] * cs3, cs1 = l[4] * cs2, cs0 = l[0] * cs1;
  const float off0 = cs1 * pl32_other(cs0, cs1, hi) * run;
  const float off1 = cs2 * pl32_other(cs1, cs2, hi) * run;
  const float off2 = cs3 * pl32_other(cs2, cs3, hi) * run;
  const float off3 = pl32_other(cs3, 1.f, hi) * run;
  float tot;
  { auto rr = __builtin_amdgcn_permlane32_swap(__float_as_uint(cs0), __float_as_uint(cs0), false, false); tot = __uint_as_float(rr[0]) * __uint_as_float(rr[1]); }
#pragma unroll
  for (int r = 0; r < 4; ++r) {
    pz[r] = pz[r] * l[r] * off0; pz[4 + r] = pz[4 + r] * l[4 + r] * off1;
    pz[8 + r] = pz[8 + r] * l[8 + r] * off2; pz[12 + r] = pz[12 + r] * l[12 + r] * off3;
  }
  run *= tot;
}

__device__ __forceinline__ void attn_phase(const Params& p, char* smem, int bid, int nblk) {
  const int tid = otid(), wid = tid >> 6, lane = tid & 63, r32 = lane & 31, hi = lane >> 5;
  char* K_lds = smem; char* V_lds = smem + 16384;
  const u16* qkv = (const u16*)(p.ws + OFF_PROJ);
  u16* ao = (u16*)(p.ws + OFF_HN);
  const int sr = tid >> 4, sc = (tid & 15) * 8;
  const int vb0 = (int)(uintptr_t)V_lds + v_rd_base(lane);
  for (int k = 0; k * nblk < 2048; ++k) {
    const int i = (k & 1) ? ((k + 1) * nblk - 1 - bid) : (k * nblk + bid);
    if (i >= 2048) continue;
    const int j = 63 - (i >> 5), bh = i & 31, b = bh >> 3, h = bh & 7;
    const int i0 = j * 128;
    const size_t rowb = (size_t)b * SEQ;
    const int t = i0 + wid * 32 + r32, tmin = i0 + wid * 32, tmax = tmin + 31;
    bf16x8 qr[8];
    {
      const u16* qp = qkv + (rowb + t) * 3072 + h * 128 + hi * 8;
#pragma unroll
      for (int d0 = 0; d0 < 8; ++d0) qr[d0] = *(const bf16x8*)(qp + d0 * 16);
    }
    f32x16 o[4];
#pragma unroll
    for (int d = 0; d < 4; ++d)
#pragma unroll
      for (int r = 0; r < 16; ++r) o[d][r] = 0.f;
    float run = 1.f;
    const u16* kbase = qkv + rowb * 3072 + 1024 + h * 128 + sc;
    u32x4 stk[4], stv[4];
#define SLOAD(KT) do { _Pragma("unroll") for (int ii = 0; ii < 4; ++ii) { const u16* kp = kbase + (size_t)((KT) * 64 + sr + 16 * ii) * 3072; \
      stk[ii] = *(const u32x4*)kp; stv[ii] = *(const u32x4*)(kp + 1024); } } while (0)
#define SWRITE() do { _Pragma("unroll") for (int ii = 0; ii < 4; ++ii) { const int row = sr + 16 * ii; \
      *(u32x4*)(K_lds + KSWZ(row, sc * 2)) = stk[ii]; *(u32x4*)(V_lds + v_st(row, sc)) = stv[ii]; } } while (0)
    const int NT = 2 * j + 2;
    SLOAD(NT - 1); SWRITE(); __syncthreads();
    for (int kt = NT - 1; kt >= 0; --kt) {
      const int k0 = kt * 64;
      if (k0 <= tmax) {
        bf16x8 pa0, pa1, pa2, pa3;
#define PK4(P, BASE, OUT) do { unsigned a0 = cvtpk(P[BASE + 0], P[BASE + 1]), a1 = cvtpk(P[BASE + 2], P[BASE + 3]); \
    unsigned b0_ = cvtpk(P[BASE + 4], P[BASE + 5]), b1_ = cvtpk(P[BASE + 6], P[BASE + 7]); \
    auto r0 = __builtin_amdgcn_permlane32_swap(a0, b0_, false, false); auto r1 = __builtin_amdgcn_permlane32_swap(a1, b1_, false, false); \
    u32x4 w = {r0[0], r1[0], r0[1], r1[1]}; OUT = *reinterpret_cast<bf16x8*>(&w); } while (0)
        if (k0 + 32 <= tmax) {
          f32x16 pz;
#pragma unroll
          for (int r = 0; r < 16; ++r) pz[r] = 0.f;
#pragma unroll
          for (int d0 = 0; d0 < 8; ++d0) {
            const bf16x8 kf = *(const bf16x8*)(K_lds + KSWZ(32 + r32, (d0 * 16 + hi * 8) * 2));
            pz = __builtin_amdgcn_mfma_f32_32x32x16_bf16(kf, qr[d0], pz, 0, 0, 0);
          }
          sb_half(pz, run, k0 + 63 >= tmin, k0 + 32, t, hi);
          PK4(pz, 0, pa2); PK4(pz, 8, pa3);
        } else {
          pa2 = bf16x8{0, 0, 0, 0, 0, 0, 0, 0}; pa3 = pa2;
        }
        {
          f32x16 pz;
#pragma unroll
          for (int r = 0; r < 16; ++r) pz[r] = 0.f;
#pragma unroll
          for (int d0 = 0; d0 < 8; ++d0) {
            const bf16x8 kf = *(const bf16x8*)(K_lds + KSWZ(r32, (d0 * 16 + hi * 8) * 2));
            pz = __builtin_amdgcn_mfma_f32_32x32x16_bf16(kf, qr[d0], pz, 0, 0, 0);
          }
          sb_half(pz, run, k0 + 31 >= tmin, k0, t, hi);
          PK4(pz, 0, pa0); PK4(pz, 8, pa1);
        }
#undef PK4
        if (kt > 0) SLOAD(kt - 1);
        pv_one<0>(o[0], vb0, pa0, pa1, pa2, pa3); pv_one<1>(o[1], vb0, pa0, pa1, pa2, pa3);
        pv_one<2>(o[2], vb0, pa0, pa1, pa2, pa3); pv_one<3>(o[3], vb0, pa0, pa1, pa2, pa3);
      } else {
        if (kt > 0) SLOAD(kt - 1);
      }
      __syncthreads();
      if (kt > 0) SWRITE();
      __syncthreads();
    }
#undef SLOAD
#undef SWRITE
    {
      const int orow0 = (int)rowb + i0 + wid * 32;
#pragma unroll
      for (int r = 0; r < 16; ++r) {
        const int orow = crow(r, hi);
#pragma unroll
        for (int d0 = 0; d0 < 4; ++d0) ao[a_off(orow0 + orow, h * 128 + d0 * 32 + r32, 32)] = f2bf(o[d0][r]);
      }
    }
  }
}

#define XB_TMO      128
#define XB_XCNT(j)  (256  + 64 * (j))
#define XB_XSUB(j)  (1280 + 64 * (j))
#define XB_XGEN(j)  (2304 + 64 * (j))
#define XB_TOP      3328
#define XB_TOPGEN   3392
#define XCD_BAR_WORDS 3456
#define XB_SPIN_CAP (1u << 23)
#define LAS __attribute__((address_space(3)))
__device__ __forceinline__ unsigned xb_ld(unsigned* p)              { return __hip_atomic_load(p, __ATOMIC_RELAXED, __HIP_MEMORY_SCOPE_AGENT); }
__device__ __forceinline__ unsigned xb_add(unsigned* p, unsigned v) { return __hip_atomic_fetch_add(p, v, __ATOMIC_RELAXED, __HIP_MEMORY_SCOPE_AGENT); }
__device__ __forceinline__ unsigned xb_xcc_id() { return (unsigned)__builtin_amdgcn_s_getreg((3 << 11) | 20) & 0xFu; }
#define XB_SPIN(cond, bar) do { unsigned _sp = 0; while (cond) { __builtin_amdgcn_s_sleep(1); \
    if ((++_sp & 255u) == 0u) { if (xb_ld(&(bar)[XB_TMO])) break; if (_sp > XB_SPIN_CAP) { atomicAdd(&(bar)[XB_TMO], 1u); break; } } } } while (0)
struct XcdBarrier { unsigned* bar; unsigned x; volatile LAS unsigned* st; };
__device__ __forceinline__ XcdBarrier xcd_barrier_post(unsigned* bar, volatile LAS unsigned* st) {
  XcdBarrier b; b.bar = bar; b.x = xb_xcc_id(); b.st = st;
  if (__builtin_amdgcn_workitem_id_x() == 0) (void)xb_add(&bar[XB_XCNT(b.x)], 1u);
  return b;
}
__device__ __forceinline__ void xcd_barrier_complete(unsigned* bar, unsigned x, unsigned& nloc, unsigned& nx) {
  const unsigned G = gridDim.x * gridDim.y * gridDim.z;
  unsigned sum, cnt, mine, sp = 0u;
  for (;;) {
    sum = 0u; cnt = 0u; mine = 0u;
#pragma unroll
    for (unsigned j = 0; j < 16; ++j) { const unsigned c = xb_ld(&bar[XB_XCNT(j)]); sum += c; cnt += (c > 0u) ? 1u : 0u; mine = (j == x) ? c : mine; }
    if (sum == G) break;
    __builtin_amdgcn_s_sleep(1);
    if ((++sp & 255u) == 0u) { if (xb_ld(&bar[XB_TMO])) break; if (sp > XB_SPIN_CAP) { atomicAdd(&bar[XB_TMO], 1u); break; } }
  }
  nloc = mine > 0u ? mine : 1u; nx = cnt > 0u ? cnt : 1u;
}
__device__ __forceinline__ void xcd_barrier(const XcdBarrier& b) {
  asm volatile("s_waitcnt vmcnt(0)" ::: "memory");
  __syncthreads();
  if (__builtin_amdgcn_workitem_id_x() == 0) {
    unsigned* bar = b.bar;
    __builtin_amdgcn_s_waitcnt(0);
    unsigned nloc = b.st[0], nx = b.st[1];
    if (nloc == 0u) { xcd_barrier_complete(bar, b.x, nloc, nx); b.st[0] = nloc; b.st[1] = nx; }
    const unsigned old = xb_add(&bar[XB_XSUB(b.x)], 1u);
    const unsigned gen = old / nloc;
    if (old + 1u == (gen + 1u) * nloc) {
      __builtin_amdgcn_fence(__ATOMIC_RELEASE, "agent");
      asm volatile("s_waitcnt vmcnt(0)" ::: "memory");
      const unsigned og = xb_add(&bar[XB_TOP], 1u);
      const unsigned tg = og / nx;
      if (og + 1u == (tg + 1u) * nx) xb_add(&bar[XB_TOPGEN], 1u);
      else XB_SPIN(xb_ld(&bar[XB_TOPGEN]) == tg, bar);
      __builtin_amdgcn_fence(__ATOMIC_ACQUIRE, "agent");
      xb_add(&bar[XB_XGEN(b.x)], 1u);
      asm volatile("s_waitcnt vmcnt(0)" ::: "memory");
    } else {
      XB_SPIN(xb_ld(&bar[XB_XGEN(b.x)]) == gen, bar);
      __builtin_amdgcn_fence(__ATOMIC_ACQUIRE, "agent");
      asm volatile("s_waitcnt vmcnt(0)" ::: "memory");
    }
  }
  __syncthreads();
}

__global__ void __launch_bounds__(256, 2) mega(Params p) {
  __shared__ __attribute__((aligned(16))) char smem[SMEM_BYTES];
  __shared__ uint4 xb_words;
  const int bid = blockIdx.x, nblk = gridDim.x;
  char* ws = p.ws;
  if (__builtin_amdgcn_workitem_id_x() == 0) xb_words = make_uint4(0u, 0u, 0u, 0u);
  __syncthreads();
  const XcdBarrier xbar = xcd_barrier_post((unsigned*)(ws + OFF_BAR), (volatile LAS unsigned*)&xb_words);
  const float* mod = (const float*)(ws + OFF_MOD);
  u16* hn = (u16*)(ws + OFF_HN);
#define PH_BEGIN(n) if (p.phase_lo <= (n) && (n) < p.phase_hi) {
#define PH_END(n) if ((n) + 1 < p.phase_hi) { if ((n) == 0) cg::this_grid().sync(); else xcd_barrier(xbar); } }
  PH_BEGIN(0) phase0(p, smem, bid, nblk); PH_END(0)
  PH_BEGIN(1) norm_phase<1>(p, p.x, p.norm_mix_w, mod, 0, 1024, smem, bid, nblk); PH_END(1)
  PH_BEGIN(2) { EpiArgs ea{}; ea.outb = (u16*)(ws + OFF_PROJ); ea.ux = (u16*)(ws + OFF_UX);
        gemm_phase<E_PROJ0>(hn, 32, 0, (const u16*)(ws + OFF_WT_HYIN), 32, 0, 1024, M / 256, PN / 128, 1, ea, smem, bid, nblk); } PH_END(2)
  PH_BEGIN(3) { EpiArgs ea{}; ea.outf = (float*)(ws + OFF_XE);
        gemm_phase<E_XE>((const u16*)(ws + OFF_UX), 20, (size_t)S5C * UXW, (const u16*)(ws + OFF_EG), 16, (size_t)128 * 512, 512, S5C / 256, 1, 32, ea, smem, bid, nblk); } PH_END(3)
  PH_BEGIN(4) { s5_carry_phase(p, bid, nblk); gdn_prep_phase(p, smem, bid, nblk); } PH_END(4)
  PH_BEGIN(5) {
        if (bid < 16) { gdn_scan_item(p, bid, smem); }
        else { EpiArgs ea{}; ea.outb = (u16*)(ws + OFF_Y5); ea.ux = (u16*)(ws + OFF_UX); ea.bias = p.s5_d;
          gemm_phase<E_S5Y>((const u16*)(ws + OFF_UX), 20, (size_t)S5C * UXW, (const u16*)(ws + OFF_MF), 20, (size_t)512 * UXW, UXW, S5C / 256, 4, 32, ea, smem, bid - 16, nblk - 16); }
      } PH_END(5)
  PH_BEGIN(6) { gdn_out_phase(p, smem, bid, nblk); } PH_END(6)
  PH_BEGIN(7) { EpiArgs ea{}; ea.outb = hn; ea.y5 = (const u16*)(ws + OFF_Y5); ea.bias = p.s5_glu_b;
        gemm_phase<E_GLU>((const u16*)(ws + OFF_Y5), 16, 0, (const u16*)(ws + OFF_WT_GLU), 16, 0, 512, M / 256, 4, 1, ea, smem, bid, nblk); } PH_END(7)
  PH_BEGIN(8) { EpiArgs ea{}; ea.outf = p.out; ea.res = p.x; ea.gate = mod + 2048;
        gemm_phase<E_RESID>(hn, 32, 0, (const u16*)(ws + OFF_WT_HYOUT), 32, 0, 1024, M / 256, 8, 1, ea, smem, bid, nblk); } PH_END(8)
  PH_BEGIN(9) norm_phase<0>(p, p.out, p.norm_ffn_w, mod, 3072, 4096, smem, bid, nblk); PH_END(9)
  PH_BEGIN(10) { EpiArgs ea{}; ea.outb = (u16*)(ws + OFF_PROJ);
        gemm_phase<E_SWIGLU>(hn, 32, 0, (const u16*)(ws + OFF_WT_FFNIN), 32, 0, 1024, M / 256, 2 * FF / 128, 1, ea, smem, bid, nblk); } PH_END(10)
  PH_BEGIN(11) { EpiArgs ea{}; ea.outf = p.out; ea.res = p.out; ea.gate = mod + 5120;
        gemm_phase<E_RESID>((const u16*)(ws + OFF_PROJ), FF / 32, 0, (const u16*)(ws + OFF_WT_FFNOUT), FF / 32, 0, FF, M / 256, 8, 1, ea, smem, bid, nblk); } PH_END(11)
  PH_BEGIN(12) norm_phase<0>(p, p.out, p.norm_mix_w + 1024, mod + 4 * 6144, 0, 1024, smem, bid, nblk); PH_END(12)
  PH_BEGIN(13) { EpiArgs ea{}; ea.outb = (u16*)(ws + OFF_PROJ); ea.ldc = 3072;
        gemm_phase<E_BF16>(hn, 32, 0, (const u16*)(ws + OFF_WT_SBIN), 32, 0, 1024, M / 256, 24, 1, ea, smem, bid, nblk); } PH_END(13)
  PH_BEGIN(14) attn_phase(p, smem, bid, nblk); PH_END(14)
  PH_BEGIN(15) { EpiArgs ea{}; ea.outf = p.out; ea.res = p.out; ea.gate = mod + 4 * 6144 + 2048;
        gemm_phase<E_RESID>(hn, 32, 0, (const u16*)(ws + OFF_WT_SBOUT), 32, 0, 1024, M / 256, 8, 1, ea, smem, bid, nblk); } PH_END(15)
  PH_BEGIN(16) norm_phase<0>(p, p.out, p.norm_ffn_w + 1024, mod + 4 * 6144, 3072, 4096, smem, bid, nblk); PH_END(16)
  PH_BEGIN(17) { EpiArgs ea{}; ea.outb = (u16*)(ws + OFF_PROJ);
        gemm_phase<E_SWIGLU>(hn, 32, 0, (const u16*)(ws + OFF_WT_FFNIN + SZ_WT_FFNIN), 32, 0, 1024, M / 256, 2 * FF / 128, 1, ea, smem, bid, nblk); } PH_END(17)
  PH_BEGIN(18) { EpiArgs ea{}; ea.outf = p.out; ea.res = p.out; ea.gate = mod + 4 * 6144 + 5120;
        gemm_phase<E_RESID>((const u16*)(ws + OFF_PROJ), FF / 32, 0, (const u16*)(ws + OFF_WT_FFNOUT + SZ_WT_FFNOUT), FF / 32, 0, FF, M / 256, 8, 1, ea, smem, bid, nblk); } PH_END(18)
  PH_BEGIN(19) norm_phase<2>(p, p.out, p.final_norm_w, mod, 0, 0, smem, bid, nblk); PH_END(19)
}

extern "C" void kernel_launch(void* const* d_in, const int* in_sizes, int n_in, void* d_out, int out_size, void* d_ws, size_t ws_size,
                              hipStream_t stream) {
  static int grid_blocks = 0;
  if (!grid_blocks) {
    int dev = 0, cus = 0, per_cu = 0;
    hipGetDevice(&dev);
    hipDeviceGetAttribute(&cus, hipDeviceAttributeMultiprocessorCount, dev);
    hipOccupancyMaxActiveBlocksPerMultiprocessor(&per_cu, mega, 256, 0);
    if (per_cu > 2) per_cu = 2;
    if (per_cu < 1) per_cu = 1;
    grid_blocks = cus * per_cu;
  }
  Params p{};
  const float* const* in = (const float* const*)d_in;
  p.x = in[0]; p.c = in[1]; p.ada_w = in[2]; p.ada_b = in[3]; p.norm_mix_w = in[4]; p.norm_ffn_w = in[5]; p.ffn_w_in = in[6]; p.ffn_w_out = in[7];
  p.hy_w_in = in[8]; p.hy_conv_w = in[9]; p.hy_a_log = in[10]; p.hy_dt_bias = in[11]; p.hy_head_norm_w = in[12];
  p.s5_lam_re = in[13]; p.s5_lam_im = in[14]; p.s5_log_dt = in[15]; p.s5_b_re = in[16]; p.s5_b_im = in[17]; p.s5_c_re = in[18]; p.s5_c_im = in[19];
  p.s5_d = in[20]; p.s5_glu_w = in[21]; p.s5_glu_b = in[22]; p.hy_w_out = in[23]; p.sb_w_in = in[24]; p.sb_w_out = in[25]; p.final_norm_w = in[26];
  p.out = (float*)d_out; p.ws = (char*)d_ws;
#if ONE_LAUNCH
  p.phase_lo = 0; p.phase_hi = NPHASE;
  (void)hipMemsetAsync((char*)d_ws + OFF_BAR, 0, (size_t)XCD_BAR_WORDS_C * 4, stream);
  void* args[] = {&p};
  hipError_t e = hipLaunchCooperativeKernel((void*)mega, dim3(grid_blocks), dim3(256), args, 0, stream);
  if (e != hipSuccess) fprintf(stderr, "cooperative launch failed: %s (grid %d)\n", hipGetErrorString(e), grid_blocks);
#else
  for (int ph = 0; ph < NPHASE; ++ph) {
    p.phase_lo = ph; p.phase_hi = ph + 1;
    hipLaunchKernelGGL(mega, dim3(grid_blocks), dim3(256), 0, stream, p);
  }
#endif
}
```

```cpp
#include <hip/hip_runtime.h>
#include <hip/hip_cooperative_groups.h>
#include <stdint.h>
#include <cstdio>
namespace cg = cooperative_groups;

#ifndef ONE_LAUNCH
#define ONE_LAUNCH 1
#endif

typedef unsigned short u16;
using bf16x8 = __attribute__((ext_vector_type(8))) short;
using f32x4 = __attribute__((ext_vector_type(4))) float;
using u32x4 = __attribute__((ext_vector_type(4))) unsigned;

constexpr int D = 1024, NB = 4, SEQ = 8192, M = NB * SEQ, FF = 2816, EIN = 2568, PN = 2560, PJ = 2048;
constexpr int NPHASE = 20;
constexpr int XCD_BAR_WORDS_C = 3456;
constexpr int S5T = 32, S5C = M / S5T, UXW = 640;

constexpr size_t SZ_WT_HYIN = (size_t)PN * 1024 * 2, SZ_WT_SQ = (size_t)1024 * 1024 * 2, SZ_WT_GLU = (size_t)512 * 512 * 2;
constexpr size_t SZ_WT_FFNIN = (size_t)2 * FF * 1024 * 2, SZ_WT_FFNOUT = (size_t)1024 * FF * 2, SZ_WT_SBIN = (size_t)3072 * 1024 * 2;
constexpr size_t OFF_WT_HYIN = 0;
constexpr size_t OFF_WT_HYOUT = OFF_WT_HYIN + SZ_WT_HYIN;
constexpr size_t OFF_WT_GLU = OFF_WT_HYOUT + SZ_WT_SQ;
constexpr size_t OFF_WT_FFNIN = OFF_WT_GLU + SZ_WT_GLU;
constexpr size_t OFF_WT_FFNOUT = OFF_WT_FFNIN + 2 * SZ_WT_FFNIN;
constexpr size_t OFF_WT_SBIN = OFF_WT_FFNOUT + 2 * SZ_WT_FFNOUT;
constexpr size_t OFF_WT_SBOUT = OFF_WT_SBIN + SZ_WT_SBIN;
constexpr size_t OFF_MOD = OFF_WT_SBOUT + SZ_WT_SQ;
constexpr size_t OFF_BETA = OFF_MOD + (size_t)2 * 4 * 6144 * 4;
constexpr size_t OFF_G = OFF_BETA + (size_t)M * 4 * 4;
constexpr size_t OFF_HN = OFF_G + (size_t)M * 4 * 4;
constexpr size_t OFF_Y5 = OFF_HN + (size_t)M * 1024 * 2;
constexpr size_t OFF_UX = OFF_Y5 + (size_t)M * 512 * 2;
constexpr size_t OFF_MF = OFF_UX + (size_t)32 * S5C * UXW * 2;
constexpr size_t OFF_EG = OFF_MF + (size_t)32 * 512 * UXW * 2;
constexpr size_t OFF_XE = OFF_EG + (size_t)32 * 128 * 512 * 2;
constexpr size_t OFF_A32 = OFF_XE + (size_t)32 * S5C * 128 * 4;
constexpr size_t OFF_PROJ = OFF_A32 + (size_t)32 * 64 * 2 * 4;
constexpr size_t OFF_GW = OFF_PROJ + (size_t)M * PJ * 2;
constexpr size_t OFF_GQD = OFF_GW + (size_t)2048 * 8192 * 2;
constexpr size_t OFF_GKT = OFF_GQD + (size_t)2048 * 8192 * 2;
constexpr size_t OFF_GUT = OFF_GKT + (size_t)2048 * 8192 * 2;
constexpr size_t OFF_GAT = OFF_GUT + (size_t)2048 * 8192 * 2;
constexpr size_t OFF_GSD = OFF_GAT + (size_t)2048 * 4096 * 2;
constexpr size_t OFF_BAR = OFF_GSD + (size_t)2048 * 4;
constexpr size_t WS_TOTAL = OFF_BAR + (size_t)XCD_BAR_WORDS_C * 4;
static_assert((size_t)M * 3072 * 2 <= WS_TOTAL - OFF_PROJ, "QKV alias");
static_assert(WS_TOTAL <= (size_t)512 * 1024 * 1024, "workspace too large");

struct Params {
  const float *x, *c, *ada_w, *ada_b, *norm_mix_w, *norm_ffn_w, *ffn_w_in, *ffn_w_out;
  const float *hy_w_in, *hy_conv_w, *hy_a_log, *hy_dt_bias, *hy_head_norm_w;
  const float *s5_lam_re, *s5_lam_im, *s5_log_dt, *s5_b_re, *s5_b_im, *s5_c_re, *s5_c_im, *s5_d, *s5_glu_w, *s5_glu_b, *hy_w_out;
  const float *sb_w_in, *sb_w_out, *final_norm_w;
  float* out;
  char* ws;
  int phase_lo, phase_hi;
};

constexpr int SMEM_BYTES = 73728;

__device__ __forceinline__ int otid() { int t = __builtin_amdgcn_workitem_id_x(); asm volatile("" : "+v"(t)); return t; }
__device__ __forceinline__ u16 f2bf(float x) { unsigned u = __float_as_uint(x); u += 0x7fffu + ((u >> 16) & 1u); return (u16)(u >> 16); }
typedef __bf16 bf16v2 __attribute__((ext_vector_type(2)));
typedef float f32v2 __attribute__((ext_vector_type(2)));
__device__ __forceinline__ unsigned pk2(float a, float b) { f32v2 v = {a, b}; bf16v2 r = __builtin_convertvector(v, bf16v2); return __builtin_bit_cast(unsigned, r); }
__device__ __forceinline__ float bf2f(u16 v) { return __uint_as_float(((unsigned)v) << 16); }
__device__ __forceinline__ float sigmoid_(float x) { return 1.f / (1.f + __expf(-x)); }
__device__ __forceinline__ float silu_(float x) { return x * sigmoid_(x); }
__device__ __forceinline__ float softplus_(float x) { return fmaxf(x, 0.f) + log1pf(__expf(-fabsf(x))); }
__device__ __forceinline__ float gelu_tanh_(float y) { return 0.5f * y * (1.f + tanhf(0.7978845608028654f * (y + 0.044715f * y * y * y))); }

__device__ __forceinline__ size_t pj_idx(int row, int col) { return (size_t)(col >> 9) * ((size_t)M * 512) + (size_t)row * 512 + (col & 511); }
__device__ __forceinline__ size_t a_off(int row, int col, int nks) { return ((size_t)((row >> 8) * nks + (col >> 5)) << 13) + ((row & 255) << 5) + (col & 31); }
__device__ __forceinline__ size_t b_off(int n, int k, int nks) { return ((size_t)((n >> 7) * nks + (k >> 5)) << 12) + ((n & 127) << 5) + (k & 31); }

struct TrJob { const float* src; u16* dst; int K, Nsrc, Nd, mode; };
__device__ __forceinline__ TrJob get_job(const Params& p, int j) {
  TrJob t;
  switch (j) {
    case 0: t = {p.hy_w_in, (u16*)(p.ws + OFF_WT_HYIN), 1024, EIN, PN, 1}; break;
    case 1: t = {p.hy_w_out, (u16*)(p.ws + OFF_WT_HYOUT), 1024, 1024, 1024, 0}; break;
    case 2: t = {p.s5_glu_w, (u16*)(p.ws + OFF_WT_GLU), 512, 512, 512, 0}; break;
    case 3: t = {p.ffn_w_in, (u16*)(p.ws + OFF_WT_FFNIN), 1024, 2 * FF, 2 * FF, 2}; break;
    case 4: t = {p.ffn_w_in + (size_t)1024 * 2 * FF, (u16*)(p.ws + OFF_WT_FFNIN + SZ_WT_FFNIN), 1024, 2 * FF, 2 * FF, 2}; break;
    case 5: t = {p.ffn_w_out, (u16*)(p.ws + OFF_WT_FFNOUT), FF, 1024, 1024, 0}; break;
    case 6: t = {p.ffn_w_out + (size_t)FF * 1024, (u16*)(p.ws + OFF_WT_FFNOUT + SZ_WT_FFNOUT), FF, 1024, 1024, 0}; break;
    case 7: t = {p.sb_w_in, (u16*)(p.ws + OFF_WT_SBIN), 1024, 3072, 3072, 0}; break;
    default: t = {p.sb_w_out, (u16*)(p.ws + OFF_WT_SBOUT), 1024, 1024, 1024, 0}; break;
  }
  return t;
}
__device__ __forceinline__ int src_col(int R, int mode) {
  if (mode == 0) return R;
  if (mode == 1) return R < 2048 ? R : R + 8;
  return ((R >> 4) & 1) * FF + (R >> 5) * 16 + (R & 15);
}
constexpr int N_TR_ITEMS = 640 + 256 + 64 + 2 * 1408 + 2 * 704 + 768 + 256;
constexpr int N_MOD_ITEMS = 2 * 6144 / 16;

__device__ __forceinline__ void s5_table_item(const Params& p, int item, char* smem) {
  const int tid = otid(), g = item >> 5, tau = item & 31;
  float* pwr = (float*)smem; float* pwi = pwr + 64; float* p1r = pwi + 64; float* p1i = p1r + 64;
  float* bbr = p1i + 64; float* bbi = bbr + 1024; float* cre = bbi + 1024; float* cim = cre + 1024;
  const float dt = expf(p.s5_log_dt[g]);
  if (tid < 64) {
    const float lr = p.s5_lam_re[g * 64 + tid], li = p.s5_lam_im[g * 64 + tid];
    float sn, cs;
    float mg = expf(lr * dt * (float)tau); sincosf(li * dt * (float)tau, &sn, &cs); pwr[tid] = mg * cs; pwi[tid] = mg * sn;
    mg = expf(lr * dt * (float)(tau + 1)); sincosf(li * dt * (float)(tau + 1), &sn, &cs); p1r[tid] = mg * cs; p1i[tid] = mg * sn;
    if (tau == 31) { float* a32 = (float*)(p.ws + OFF_A32); a32[(g * 64 + tid) * 2] = mg * cs; a32[(g * 64 + tid) * 2 + 1] = mg * sn; }
  }
  {
    const int pp = tid >> 2, hq = (tid & 3) * 4;
    const float lr = p.s5_lam_re[g * 64 + pp], li = p.s5_lam_im[g * 64 + pp];
    const float mg = expf(lr * dt); float sn, cs; sincosf(li * dt, &sn, &cs);
    const float ar = mg * cs, ai = mg * sn, den = lr * lr + li * li, nr = ar - 1.f, ni = ai;
    const float fre = (nr * lr + ni * li) / den, fim = (ni * lr - nr * li) / den;
#pragma unroll
    for (int e = 0; e < 4; ++e) {
      const float br = p.s5_b_re[(size_t)(g * 64 + pp) * 16 + hq + e], bi = p.s5_b_im[(size_t)(g * 64 + pp) * 16 + hq + e];
      bbr[pp * 16 + hq + e] = fre * br - fim * bi; bbi[pp * 16 + hq + e] = fre * bi + fim * br;
    }
    for (int i = tid; i < 1024; i += 256) { cre[i] = p.s5_c_re[(size_t)g * 1024 + i]; cim[i] = p.s5_c_im[(size_t)g * 1024 + i]; }
  }
  __syncthreads();
  u16* mf = (u16*)(p.ws + OFF_MF) + (size_t)g * 512 * UXW;
  u16* eg = (u16*)(p.ws + OFF_EG) + (size_t)g * 128 * 512;
  {
    const int h = tid >> 4, hp = tid & 15;
    float kv = 0.f;
    for (int pp = 0; pp < 64; ++pp) {
      const float cr = cre[h * 64 + pp], ci = cim[h * 64 + pp], pr = pwr[pp], pi = pwi[pp];
      kv += (cr * pr - ci * pi) * bbr[pp * 16 + hp] - (cr * pi + ci * pr) * bbi[pp * 16 + hp];
    }
    const u16 kb = f2bf(kv);
    for (int s0 = 0; s0 + tau < 32; ++s0) mf[b_off((s0 + tau) * 16 + h, s0 * 16 + hp, 20)] = kb;
    for (int t0 = 0; t0 + tau + 1 < 32; ++t0) mf[b_off(t0 * 16 + h, (t0 + tau + 1) * 16 + hp, 20)] = 0;
#pragma unroll
    for (int e = 0; e < 4; ++e) {
      const int pp = hp * 4 + e;
      const float cr = cre[h * 64 + pp], ci = cim[h * 64 + pp], pr = p1r[pp], pi = p1i[pp];
      mf[b_off(tau * 16 + h, 512 + pp, 20)] = f2bf(cr * pr - ci * pi);
      mf[b_off(tau * 16 + h, 576 + pp, 20)] = f2bf(-(cr * pi + ci * pr));
    }
  }
  {
    const int pp = tid >> 2, hq = (tid & 3) * 4, s0 = 31 - tau;
#pragma unroll
    for (int e = 0; e < 4; ++e) {
      const float br = bbr[pp * 16 + hq + e], bi = bbi[pp * 16 + hq + e], pr = pwr[pp], pi = pwi[pp];
      eg[b_off(pp, s0 * 16 + hq + e, 16)] = f2bf(pr * br - pi * bi);
      eg[b_off(64 + pp, s0 * 16 + hq + e, 16)] = f2bf(pr * bi + pi * br);
    }
  }
  __syncthreads();
}

__device__ __forceinline__ void phase0(const Params& p, char* smem, int bid, int nblk) {
  const int tid = otid();
  for (int it = bid; it < N_TR_ITEMS + N_MOD_ITEMS + 1024; it += nblk) {
    if (it >= N_TR_ITEMS + N_MOD_ITEMS) { s5_table_item(p, it - N_TR_ITEMS - N_MOD_ITEMS, smem); continue; }
    if (it < N_TR_ITEMS) {
      int rem = it, j = 0; TrJob jb;
      for (;; ++j) { jb = get_job(p, j); int n = (jb.Nd >> 6) * (jb.K >> 6); if (rem < n) break; rem -= n; }
      const int nk = jb.K >> 6, R0 = (rem / nk) * 64, k0 = (rem % nk) * 64;
      u16* s = (u16*)smem;
      {
        const int r = tid & 63, kk = tid >> 6;
        const float* sp = jb.src + (size_t)k0 * jb.Nsrc + src_col(R0 + r, jb.mode);
#pragma unroll
        for (int i = 0; i < 16; ++i) { int k = kk + 4 * i; s[r * 72 + k] = f2bf(sp[(size_t)k * jb.Nsrc]); }
      }
      __syncthreads();
      {
        const int r = tid >> 2, ch = tid & 3;
#pragma unroll
        for (int i = 0; i < 2; ++i) {
          int c8 = (ch + 4 * i) * 8;
          *(u32x4*)(jb.dst + b_off(R0 + r, k0 + c8, jb.K >> 5)) = *(const u32x4*)(s + r * 72 + c8);
        }
      }
      __syncthreads();
    } else {
      const int mi = it - N_TR_ITEMS, l = mi / 384, n0 = (mi % 384) * 16;
      float* cact = (float*)smem;
      float* red = cact + 4096;
      for (int i = tid; i < 4096; i += 256) cact[i] = silu_(p.c[i]);
      __syncthreads();
      const int cl = tid & 15, ksub = tid >> 4;
      float a0 = 0, a1 = 0, a2 = 0, a3 = 0;
      const float* wp = p.ada_w + (size_t)l * 1024 * 6144 + n0 + cl;
#pragma unroll 16
      for (int k = ksub * 64; k < ksub * 64 + 64; ++k) {
        float w = wp[(size_t)k * 6144];
        a0 += cact[k] * w; a1 += cact[1024 + k] * w; a2 += cact[2048 + k] * w; a3 += cact[3072 + k] * w;
      }
      red[(ksub * 4 + 0) * 16 + cl] = a0; red[(ksub * 4 + 1) * 16 + cl] = a1;
      red[(ksub * 4 + 2) * 16 + cl] = a2; red[(ksub * 4 + 3) * 16 + cl] = a3;
      __syncthreads();
      if (tid < 64) {
        const int b = tid >> 4;
        float sum = 0.f;
#pragma unroll
        for (int q = 0; q < 16; ++q) sum += red[(q * 4 + b) * 16 + cl];
        float* mod = (float*)(p.ws + OFF_MOD);
        mod[(size_t)(l * 4 + b) * 6144 + n0 + cl] = sum + p.ada_b[l * 6144 + n0 + cl];
      }
      __syncthreads();
    }
  }
}

template <int MODE>
__device__ __forceinline__ void norm_phase(const Params& p, const float* src, const float* w, const float* modl, int sh_off, int sc_off,
                           char* smem, int bid, int nblk) {
  const int tid = otid(), wid = tid >> 6, lane = tid & 63;
  float* wba = (float*)smem;
  if (MODE == 1) {
    for (int i = tid; i < 1024 * 8; i += 256) wba[i] = p.hy_w_in[(size_t)(i >> 3) * EIN + 2048 + (i & 7)];
    __syncthreads();
  }
  u16* hn = (u16*)(p.ws + OFF_HN);
  auto process = [&](int row, f32x4 (&v)[4]) {
    float ss = 0.f;
#pragma unroll
    for (int i = 0; i < 4; ++i) ss += v[i][0] * v[i][0] + v[i][1] * v[i][1] + v[i][2] * v[i][2] + v[i][3] * v[i][3];
#pragma unroll
    for (int o = 32; o >= 1; o >>= 1) ss += __shfl_xor(ss, o);
    const float rstd = rsqrtf(ss * (1.f / 1024.f) + 1e-6f);
    const int b = row >> 13;
    float dots[8];
    if (MODE == 1) { for (int j = 0; j < 8; ++j) dots[j] = 0.f; }
#pragma unroll
    for (int i = 0; i < 4; ++i) {
      const int c0 = i * 256 + lane * 4;
      f32x4 ww = *(const f32x4*)(w + c0);
      f32x4 y;
      if (MODE == 2) {
#pragma unroll
        for (int e = 0; e < 4; ++e) y[e] = v[i][e] * rstd * ww[e];
        *(f32x4*)(p.out + (size_t)row * 1024 + c0) = y;
      } else {
        f32x4 sc = *(const f32x4*)(modl + (size_t)b * 6144 + sc_off + c0);
        f32x4 sh = *(const f32x4*)(modl + (size_t)b * 6144 + sh_off + c0);
#pragma unroll
        for (int e = 0; e < 4; ++e) y[e] = v[i][e] * rstd * ww[e] * (1.f + sc[e]) + sh[e];
        uint2 pk; pk.x = (unsigned)f2bf(y[0]) | ((unsigned)f2bf(y[1]) << 16); pk.y = (unsigned)f2bf(y[2]) | ((unsigned)f2bf(y[3]) << 16);
        *(uint2*)(hn + a_off(row, c0, 32)) = pk;
        if (MODE == 1) {
#pragma unroll
          for (int e = 0; e < 4; ++e) {
            f32x4 w0 = *(const f32x4*)(wba + (c0 + e) * 8), w1 = *(const f32x4*)(wba + (c0 + e) * 8 + 4);
#pragma unroll
            for (int j = 0; j < 4; ++j) { dots[j] += y[e] * w0[j]; dots[4 + j] += y[e] * w1[j]; }
          }
        }
      }
    }
    if (MODE == 1) {
#pragma unroll
      for (int j = 0; j < 8; ++j) {
#pragma unroll
        for (int o = 32; o >= 1; o >>= 1) dots[j] += __shfl_xor(dots[j], o);
      }
      if (lane == 0) {
        float* beta = (float*)(p.ws + OFF_BETA); float* gg = (float*)(p.ws + OFF_G);
#pragma unroll
        for (int h = 0; h < 4; ++h) {
          beta[(size_t)row * 4 + h] = sigmoid_(dots[h]);
          gg[(size_t)row * 4 + h] = -__expf(p.hy_a_log[h]) * softplus_(dots[4 + h] + p.hy_dt_bias[h]);
        }
      }
    }
  };
#pragma unroll 1
  for (int row = bid * 4 + wid; row < M; row += nblk * 8) {
    const int row1 = row + nblk * 4;
    const bool has1 = row1 < M;
    f32x4 v0[4], v1[4];
#pragma unroll
    for (int i = 0; i < 4; ++i) v0[i] = *(const f32x4*)(src + (size_t)row * 1024 + i * 256 + lane * 4);
#pragma unroll
    for (int i = 0; i < 4; ++i) v1[i] = has1 ? *(const f32x4*)(src + (size_t)row1 * 1024 + i * 256 + lane * 4) : f32x4{0.f, 0.f, 0.f, 0.f};
    process(row, v0);
    if (has1) process(row1, v1);
  }
}

enum { E_PROJ0 = 0, E_BF16 = 1, E_RESID = 2, E_GLU = 3, E_SWIGLU = 4, E_XE = 5, E_S5Y = 6 };
struct EpiArgs { float* outf; u16* outb; const float* res; const float* gate; const u16* y5; const float* bias; u16* ux; int ldc; };

template <int EPI>
__device__ __forceinline__ void gemm_phase(const u16* __restrict__ A0, int nksA, size_t sA, const u16* __restrict__ B0, int nksB, size_t sB,
                                           int K, int nM, int nN, int nbatch, const EpiArgs ea, char* smem, int bid, int nblk) {
  const int tid = otid(), wid = tid >> 6, lane = tid & 63, wr = wid >> 1, wc = wid & 1, fr = lane & 15, fq = lane >> 4;
  char* SA = smem; char* SB = smem + 49152;
  const int NR = nbatch * nM, ntiles = NR * nN;
  const int STN = (nN & 7) == 0 ? 8 : ((nN & 3) == 0 ? 4 : 1), STM = 64 / STN, nSN = nN / STN;
  const bool swz = ((nblk & 7) == 0) && (NR % STM == 0);
  const int lpx = nblk >> 3;
  int si = bid & 7, l = bid >> 3, tl = bid;
#pragma unroll 1
  for (;;) {
    int R, pn;
    if (swz) {
      if (si >= (NR / STM) * nSN) break;
      R = (si / nSN) * STM + l / STN; pn = (si % nSN) * STN + l % STN;
      l += lpx; if (l >= 64) { l = bid >> 3; si += 8; }
    } else {
      if (tl >= ntiles) break;
      R = tl / nN; pn = tl % nN; tl += nblk;
    }
    const int g = R / nM, rt = R % nM, brow = rt << 8, bcol = pn << 7;
    const char* A = (const char*)(A0 + (size_t)g * sA) + ((size_t)rt * nksA << 14) + tid * 16;
    const char* Bt = (const char*)(B0 + (size_t)g * sB) + ((size_t)pn * nksB << 13) + tid * 16;
    int nk = K >> 5, klim = nk;
    if (EPI == E_S5Y) { klim = 4 * (pn + 1); nk = klim + 4; }
    f32x4 acc[8][4];
#pragma unroll
    for (int m = 0; m < 8; ++m)
#pragma unroll
      for (int n = 0; n < 4; ++n) acc[m][n] = f32x4{0.f, 0.f, 0.f, 0.f};
#define GSTAGE(KK, BUF) do { const int kt_ = (EPI == E_S5Y && (KK) >= klim) ? (16 + (KK) - klim) : (KK); \
      _Pragma("unroll") for (int i = 0; i < 4; ++i) \
        __builtin_amdgcn_global_load_lds((const unsigned*)(A + ((size_t)kt_ << 14) + i * 4096), (__attribute__((address_space(3))) unsigned*)(SA + (BUF) * 16384 + tid * 16 + i * 4096), 16, 0, 0); \
      _Pragma("unroll") for (int i = 0; i < 2; ++i) \
        __builtin_amdgcn_global_load_lds((const unsigned*)(Bt + ((size_t)kt_ << 13) + i * 4096), (__attribute__((address_space(3))) unsigned*)(SB + (BUF) * 8192 + tid * 16 + i * 4096), 16, 0, 0); } while (0)
    asm volatile("s_waitcnt vmcnt(0)" ::: "memory");
    GSTAGE(0, 0);
    if (nk > 1) { GSTAGE(1, 1); asm volatile("s_waitcnt vmcnt(6)\n\ts_barrier" ::: "memory"); }
    else { asm volatile("s_waitcnt vmcnt(0)\n\ts_barrier" ::: "memory"); }
    int buf = 0, nbuf = 2;
#pragma unroll 1
    for (int kk = 0; kk < nk; ++kk) {
      const bool more = kk + 2 < nk;
      if (more) GSTAGE(kk + 2, nbuf);
      bf16x8 Bl[4], At[8];
#pragma unroll
      for (int n = 0; n < 4; ++n) Bl[n] = *(const bf16x8*)(SB + buf * 8192 + (wc * 64 + n * 16 + fr) * 64 + fq * 16);
#pragma unroll
      for (int m = 0; m < 8; ++m) At[m] = *(const bf16x8*)(SA + buf * 16384 + (wr * 128 + m * 16 + fr) * 64 + fq * 16);
      __builtin_amdgcn_s_setprio(1);
#pragma unroll
      for (int m = 0; m < 8; ++m)
#pragma unroll
        for (int n = 0; n < 4; ++n) acc[m][n] = __builtin_amdgcn_mfma_f32_16x16x32_bf16(Bl[n], At[m], acc[m][n], 0, 0, 0);
      __builtin_amdgcn_s_setprio(0);
      if (more) asm volatile("s_waitcnt vmcnt(6)\n\ts_barrier" ::: "memory");
      else asm volatile("s_waitcnt vmcnt(0)\n\ts_barrier" ::: "memory");
      buf = (buf == 2) ? 0 : buf + 1; nbuf = (nbuf == 2) ? 0 : nbuf + 1;
    }
#undef GSTAGE
#pragma unroll
    for (int m = 0; m < 8; ++m)
#pragma unroll
      for (int n = 0; n < 4; ++n) {
        const int row = brow + wr * 128 + m * 16 + fr, col = bcol + wc * 64 + n * 16 + fq * 4;
        const f32x4 v = acc[m][n];
        if (EPI == E_PROJ0) {
          const uint2 pk = uint2{pk2(v[0], v[1]), pk2(v[2], v[3])};
          if (bcol < 2048) *(uint2*)(ea.outb + pj_idx(row, col)) = pk;
          else { const int cc = col - 2048; *(uint2*)(ea.ux + (size_t)(cc >> 4) * S5C * UXW + a_off(row >> 5, (row & 31) * 16 + (cc & 15), 20)) = pk; }
        }
        if (EPI == E_BF16) *(uint2*)(ea.outb + (size_t)row * ea.ldc + col) = uint2{pk2(v[0], v[1]), pk2(v[2], v[3])};
        if (EPI == E_RESID) {
          const size_t idx = (size_t)row * 1024 + col;
          const f32x4 r4 = *(const f32x4*)(ea.res + idx), g4 = *(const f32x4*)(ea.gate + (size_t)(row >> 13) * 6144 + col);
          *(f32x4*)(ea.outf + idx) = f32x4{r4[0] + g4[0] * v[0], r4[1] + g4[1] * v[1], r4[2] + g4[2] * v[2], r4[3] + g4[3] * v[3]};
        }
        if (EPI == E_GLU) {
          const uint2 yy = *(const uint2*)(ea.y5 + a_off(row, col, 16));
          const f32x4 b4 = *(const f32x4*)(ea.bias + col);
          const float y0 = __uint_as_float(yy.x << 16), y1 = __uint_as_float(yy.x & 0xffff0000u), y2 = __uint_as_float(yy.y << 16), y3 = __uint_as_float(yy.y & 0xffff0000u);
          *(uint2*)(ea.outb + a_off(row, 512 + col, 32)) = uint2{pk2(y0 * sigmoid_(v[0] + b4[0]), y1 * sigmoid_(v[1] + b4[1])), pk2(y2 * sigmoid_(v[2] + b4[2]), y3 * sigmoid_(v[3] + b4[3]))};
        }
        if (EPI == E_SWIGLU) {
          if ((n & 1) == 0) {
            const f32x4 u = acc[m][n | 1];
            const int co = (bcol >> 1) + wc * 32 + (n >> 1) * 16 + fq * 4;
            *(uint2*)(ea.outb + a_off(row, co, FF / 32)) = uint2{pk2(silu_(v[0]) * u[0], silu_(v[1]) * u[1]), pk2(silu_(v[2]) * u[2], silu_(v[3]) * u[3])};
          }
        }
        if (EPI == E_XE) *(f32x4*)(ea.outf + ((size_t)g * S5C + row) * 128 + col) = v;
        if (EPI == E_S5Y) {
          const uint2 uu = *(const uint2*)(ea.ux + (size_t)g * S5C * UXW + a_off(row, col, 20));
          const f32x4 d4 = *(const f32x4*)(ea.bias + g * 16 + (col & 15));
          const float u0 = __uint_as_float(uu.x << 16), u1 = __uint_as_float(uu.x & 0xffff0000u), u2 = __uint_as_float(uu.y << 16), u3 = __uint_as_float(uu.y & 0xffff0000u);
          *(uint2*)(ea.outb + a_off(row * 32 + (col >> 4), g * 16 + (col & 15), 16)) =
              uint2{pk2(gelu_tanh_(v[0] + d4[0] * u0), gelu_tanh_(v[1] + d4[1] * u1)), pk2(gelu_tanh_(v[2] + d4[2] * u2), gelu_tanh_(v[3] + d4[3] * u3))};
        }
      }
  }
}

__device__ __forceinline__ void s5_carry_phase(const Params& p, int bid, int nblk) {
  const float* xe = (const float*)(p.ws + OFF_XE); const float* a32 = (const float*)(p.ws + OFF_A32);
  u16* ux = (u16*)(p.ws + OFF_UX);
  for (int it = bid; it < 32; it += nblk) {
    const int idx = it * 256 + otid(), pp = idx & 63, g = (idx >> 6) & 31, b = idx >> 11;
    const float ar = a32[(g * 64 + pp) * 2], ai = a32[(g * 64 + pp) * 2 + 1];
    float xr = 0.f, xi = 0.f;
    const size_t cbase = (size_t)g * S5C + b * 256, gbase = (size_t)g * S5C * UXW;
    for (int n = 0; n < 256; n += 8) {
      float er[8], ei[8];
#pragma unroll
      for (int e = 0; e < 8; ++e) { er[e] = xe[(cbase + n + e) * 128 + pp]; ei[e] = xe[(cbase + n + e) * 128 + 64 + pp]; }
#pragma unroll
      for (int e = 0; e < 8; ++e) {
        ux[gbase + a_off(b * 256 + n + e, 512 + pp, 20)] = f2bf(xr); ux[gbase + a_off(b * 256 + n + e, 576 + pp, 20)] = f2bf(xi);
        const float nr = ar * xr - ai * xi + er[e], ni = ar * xi + ai * xr + ei[e];
        xr = nr; xi = ni;
      }
    }
  }
}

__device__ __forceinline__ int crow(int r, int hi) { return (r & 3) + 8 * (r >> 2) + 4 * hi; }
using f32x16 = __attribute__((ext_vector_type(16))) float;
__device__ __forceinline__ void unpack8(const u32x4 w, float* f) {
#pragma unroll
  for (int e = 0; e < 4; ++e) { f[2 * e] = __uint_as_float(w[e] << 16); f[2 * e + 1] = __uint_as_float(w[e] & 0xffff0000u); }
}
__device__ __forceinline__ void gdn_prep_phase(const Params& p, char* smem, int bid, int nblk) {
  const int tid = otid(), wid = tid >> 6, lane = tid & 63, fr = lane & 15, fq = lane >> 4;
  u16* qs = (u16*)smem;
  u16* ks = qs + 64 * 136;
  float* Lm = (float*)(ks + 64 * 136);
  float* gcs = Lm + 4096; float* bts = gcs + 64; float* egs = bts + 64;
  const u16* proj = (const u16*)(p.ws + OFF_PROJ);
  const float* beta = (const float*)(p.ws + OFF_BETA); const float* gg = (const float*)(p.ws + OFF_G);
#pragma unroll 1
  for (int it = bid; it < 2048; it += nblk) {
    const int n = it & 127, bh = it >> 7, b = bh >> 2, h = bh & 3;
    const size_t row0 = (size_t)b * SEQ + n * 64;
    if (wid == 0) {
      float c = gg[(row0 + lane) * 4 + h];
#pragma unroll
      for (int o = 1; o < 64; o <<= 1) { const float tt = __shfl_up(c, o); if (lane >= o) c += tt; }
      gcs[lane] = c; egs[lane] = __expf(c); bts[lane] = beta[(row0 + lane) * 4 + h];
    }
    {
      const int tok = tid >> 2, part = tid & 3, l = n * 64 + tok;
      float qo[32], ko[32]; float sq = 0.f, sk = 0.f;
#pragma unroll
      for (int cb = 0; cb < 4; ++cb) {
        const int colq = h * 128 + part * 32 + cb * 8, colk = 512 + colq;
        const size_t kblk = (size_t)M * 512 - 512;
        float aq[8], ak[8];
#pragma unroll
        for (int e = 0; e < 8; ++e) { aq[e] = 0.f; ak[e] = 0.f; }
#pragma unroll
        for (int j = 0; j < 4; ++j) {
          const int lt = l - 3 + j;
          if (lt >= 0) {
            const u16* rp = proj + ((size_t)b * SEQ + lt) * 512;
            float xq[8], xk[8];
            unpack8(*(const u32x4*)(rp + colq), xq); unpack8(*(const u32x4*)(rp + kblk + colk), xk);
            const f32x4 wq0 = *(const f32x4*)(p.hy_conv_w + j * 1536 + colq), wq1 = *(const f32x4*)(p.hy_conv_w + j * 1536 + colq + 4);
            const f32x4 wk0 = *(const f32x4*)(p.hy_conv_w + j * 1536 + colk), wk1 = *(const f32x4*)(p.hy_conv_w + j * 1536 + colk + 4);
#pragma unroll
            for (int e = 0; e < 4; ++e) { aq[e] += wq0[e] * xq[e]; aq[4 + e] += wq1[e] * xq[4 + e]; ak[e] += wk0[e] * xk[e]; ak[4 + e] += wk1[e] * xk[4 + e]; }
          }
        }
#pragma unroll
        for (int e = 0; e < 8; ++e) { const float a = silu_(aq[e]), k = silu_(ak[e]); qo[cb * 8 + e] = a; ko[cb * 8 + e] = k; sq += a * a; sk += k * k; }
      }
      sq += __shfl_xor(sq, 1); sq += __shfl_xor(sq, 2); sk += __shfl_xor(sk, 1); sk += __shfl_xor(sk, 2);
      const float rq = rsqrtf(sq + 1e-6f) * 0.08838834764831845f, rk = rsqrtf(sk + 1e-6f);
#pragma unroll
      for (int cb = 0; cb < 4; ++cb) {
        u32x4 wq, wk;
#pragma unroll
        for (int e = 0; e < 4; ++e) { wq[e] = pk2(qo[cb * 8 + 2 * e] * rq, qo[cb * 8 + 2 * e + 1] * rq); wk[e] = pk2(ko[cb * 8 + 2 * e] * rk, ko[cb * 8 + 2 * e + 1] * rk); }
        *(u32x4*)(qs + tok * 136 + part * 32 + cb * 8) = wq; *(u32x4*)(ks + tok * 136 + part * 32 + cb * 8) = wk;
      }
    }
    __syncthreads();
    {
      f32x4 akk[4], aqk[4];
#pragma unroll
      for (int nb = 0; nb < 4; ++nb) { akk[nb] = f32x4{0.f, 0.f, 0.f, 0.f}; aqk[nb] = f32x4{0.f, 0.f, 0.f, 0.f}; }
#pragma unroll
      for (int kk = 0; kk < 4; ++kk) {
        const bf16x8 ak = *(const bf16x8*)(ks + (16 * wid + fr) * 136 + kk * 32 + fq * 8);
        const bf16x8 aq = *(const bf16x8*)(qs + (16 * wid + fr) * 136 + kk * 32 + fq * 8);
#pragma unroll
        for (int nb = 0; nb < 4; ++nb) {
          const bf16x8 bk = *(const bf16x8*)(ks + (16 * nb + fr) * 136 + kk * 32 + fq * 8);
          akk[nb] = __builtin_amdgcn_mfma_f32_16x16x32_bf16(ak, bk, akk[nb], 0, 0, 0);
          aqk[nb] = __builtin_amdgcn_mfma_f32_16x16x32_bf16(aq, bk, aqk[nb], 0, 0, 0);
        }
      }
      u16* att = (u16*)(p.ws + OFF_GAT) + (size_t)it * 4096;
#pragma unroll
      for (int nb = 0; nb < 4; ++nb)
#pragma unroll
        for (int r = 0; r < 4; ++r) {
          const int i = 16 * wid + fq * 4 + r, j = 16 * nb + fr;
          const float dec = __expf(fminf(gcs[i] - gcs[j], 0.f));
          Lm[i * 64 + j] = (i > j) ? bts[i] * akk[nb][r] * dec : 0.f;
          att[i * 64 + j] = f2bf((i >= j) ? aqk[nb][r] * dec : 0.f);
        }
    }
    __syncthreads();
    {
      float x[64];
      if (tid < 128) {
        const int col = 1024 + h * 128 + tid;
        const u16* vp = proj + (size_t)2 * M * 512 + h * 128 + tid;
        const float w0 = p.hy_conv_w[col], w1 = p.hy_conv_w[1536 + col], w2 = p.hy_conv_w[2 * 1536 + col], w3 = p.hy_conv_w[3 * 1536 + col];
        float x1 = 0.f, x2 = 0.f, x3 = 0.f;
        if (n > 0) { x3 = bf2f(vp[(row0 - 3) * 512]); x2 = bf2f(vp[(row0 - 2) * 512]); x1 = bf2f(vp[(row0 - 1) * 512]); }
#pragma unroll
        for (int i = 0; i < 64; ++i) {
          const float xv = bf2f(vp[(row0 + i) * 512]);
          x[i] = silu_(w0 * x3 + w1 * x2 + w2 * x1 + w3 * xv) * bts[i];
          x3 = x2; x2 = x1; x1 = xv;
        }
      } else {
#pragma unroll
        for (int i = 0; i < 64; ++i) x[i] = bf2f(ks[i * 136 + tid - 128]) * bts[i] * egs[i];
      }
#pragma unroll
      for (int i = 1; i < 64; ++i) {
        float acc = x[i];
#pragma unroll
        for (int j4 = 0; j4 < (i + 3) / 4; ++j4) {
          const f32x4 l4 = *(const f32x4*)(Lm + i * 64 + j4 * 4);
#pragma unroll
          for (int e = 0; e < 4; ++e) if (j4 * 4 + e < i) acc -= l4[e] * x[j4 * 4 + e];
        }
        x[i] = acc;
      }
      if (tid < 128) {
        u16* ut = (u16*)(p.ws + OFF_GUT) + (size_t)it * 8192 + tid * 64;
#pragma unroll
        for (int c8 = 0; c8 < 8; ++c8) {
          u32x4 w;
#pragma unroll
          for (int e = 0; e < 4; ++e) w[e] = pk2(x[c8 * 8 + 2 * e], x[c8 * 8 + 2 * e + 1]);
          *(u32x4*)(ut + c8 * 8) = w;
        }
      } else {
        u16* wg = (u16*)(p.ws + OFF_GW) + (size_t)it * 8192 + (tid - 128);
#pragma unroll
        for (int i = 0; i < 64; ++i) wg[i * 128] = f2bf(x[i]);
      }
    }
    {
      u16* qd = (u16*)(p.ws + OFF_GQD) + (size_t)it * 8192;
#pragma unroll
      for (int k = 0; k < 4; ++k) {
        const int piece = tid + 256 * k, i = piece >> 4, d0 = (piece & 15) * 8;
        float f[8]; unpack8(*(const u32x4*)(qs + i * 136 + d0), f);
        const float e = egs[i];
        u32x4 w;
#pragma unroll
        for (int e2 = 0; e2 < 4; ++e2) w[e2] = pk2(f[2 * e2] * e, f[2 * e2 + 1] * e);
        *(u32x4*)(qd + i * 128 + d0) = w;
      }
      u16* kt = (u16*)(p.ws + OFF_GKT) + (size_t)it * 8192;
      const int dk = tid & 127, half = tid >> 7;
      const float gl = gcs[63];
#pragma unroll
      for (int c8 = 0; c8 < 4; ++c8) {
        u32x4 w;
#pragma unroll
        for (int e = 0; e < 4; ++e) {
          const int i0 = half * 32 + c8 * 8 + 2 * e;
          w[e] = pk2(bf2f(ks[i0 * 136 + dk]) * __expf(gl - gcs[i0]), bf2f(ks[(i0 + 1) * 136 + dk]) * __expf(gl - gcs[i0 + 1]));
        }
        *(u32x4*)(kt + dk * 64 + half * 32 + c8 * 8) = w;
      }
      if (tid == 0) ((float*)(p.ws + OFF_GSD))[it] = egs[63];
    }
    __syncthreads();
  }
}

__device__ __forceinline__ uint2 lds64(const char* p) { return *(const uint2*)p; }
__device__ __forceinline__ bf16x8 mk8(uint2 a, uint2 b) { u32x4 w = {a.x, a.y, b.x, b.y}; return __builtin_bit_cast(bf16x8, w); }
__device__ __forceinline__ bf16x8 pack8(const f32x16& x, int s) {
  u32x4 w = {pk2(x[8 * s], x[8 * s + 1]), pk2(x[8 * s + 2], x[8 * s + 3]), pk2(x[8 * s + 4], x[8 * s + 5]), pk2(x[8 * s + 6], x[8 * s + 7])};
  return __builtin_bit_cast(bf16x8, w);
}
__device__ __forceinline__ void gdn_scan_item(const Params& p, int bh, char* smem) {
  const int tid = otid(), wid = tid >> 6, lane = tid & 63, r32 = lane & 31, hi = lane >> 5;
  char* Wl = smem; char* KTl = smem + 16896;
  const char* gw = p.ws + OFF_GW; const char* gkt = p.ws + OFF_GKT;
  const u16* gut = (const u16*)(p.ws + OFF_GUT);
  const float* gsd = (const float*)(p.ws + OFF_GSD);
  u32x4* sbg = (u32x4*)(p.ws + OFF_PROJ); u32x4* vbg = (u32x4*)(p.ws + OFF_PROJ + (size_t)2048 * 32768);
  f32x16 S[4];
#pragma unroll
  for (int T = 0; T < 4; ++T)
#pragma unroll
    for (int r = 0; r < 16; ++r) S[T][r] = 0.f;
  u32x4 sa[8], sb_[8]; uint2 uc[8];
  const int dv = wid * 32 + r32;
#define G_LOAD(ST, IT) do { const size_t o16 = (size_t)(IT) * 16384; \
    _Pragma("unroll") for (int k = 0; k < 4; ++k) { ST[k] = *(const u32x4*)(gw + o16 + (tid + 256 * k) * 16); ST[4 + k] = *(const u32x4*)(gkt + o16 + (tid + 256 * k) * 16); } } while (0)
#define U_LOAD(IT) do { _Pragma("unroll") for (int k = 0; k < 8; ++k) uc[k] = *(const uint2*)(gut + (size_t)(IT) * 8192 + dv * 64 + 32 * (k >> 2) + 8 * (k & 3) + 4 * hi); } while (0)
#define G_WRITE(ST) do { \
    _Pragma("unroll") for (int k = 0; k < 4; ++k) { const int pc = tid + 256 * k; \
      { char* d = Wl + (pc >> 4) * 264 + (pc & 15) * 16; *(uint2*)d = uint2{ST[k][0], ST[k][1]}; *(uint2*)(d + 8) = uint2{ST[k][2], ST[k][3]}; } \
      { char* d = KTl + (pc >> 3) * 136 + (pc & 7) * 16; *(uint2*)d = uint2{ST[4 + k][0], ST[4 + k][1]}; *(uint2*)(d + 8) = uint2{ST[4 + k][2], ST[4 + k][3]}; } } } while (0)
#define SCAN_STEP(N, NXT, FAR) do { const int n = (N); const int item = bh * 128 + n; \
    const float sd_nxt = gsd[item + (n + 1 < 128 ? 1 : 0)]; \
    if (n + 2 < 128) G_LOAD(FAR, item + 2); \
    f32x16 av[2]; \
    _Pragma("unroll") for (int r = 0; r < 16; ++r) { av[0][r] = 0.f; av[1][r] = 0.f; } \
    _Pragma("unroll") for (int T = 0; T < 4; ++T) \
      _Pragma("unroll") for (int s = 0; s < 2; ++s) { \
        const bf16x8 sb = pack8(S[T], s); \
        sbg[((size_t)(item * 4 + wid) * 8 + T * 2 + s) * 64 + lane] = __builtin_bit_cast(u32x4, sb); \
        const int cb = (32 * T + 16 * s + 4 * hi) * 2; \
        _Pragma("unroll") for (int it = 0; it < 2; ++it) { \
          const char* wp = Wl + (32 * it + r32) * 264 + cb; \
          av[it] = __builtin_amdgcn_mfma_f32_32x32x16_bf16(mk8(lds64(wp), lds64(wp + 16)), sb, av[it], 0, 0, 0); } } \
    bf16x8 vb[2][2]; \
    _Pragma("unroll") for (int it = 0; it < 2; ++it) { \
      f32x16 vn; \
      _Pragma("unroll") for (int g = 0; g < 4; ++g) { const uint2 u2 = uc[it * 4 + g]; \
        vn[4 * g] = __uint_as_float(u2.x << 16) - av[it][4 * g]; vn[4 * g + 1] = __uint_as_float(u2.x & 0xffff0000u) - av[it][4 * g + 1]; \
        vn[4 * g + 2] = __uint_as_float(u2.y << 16) - av[it][4 * g + 2]; vn[4 * g + 3] = __uint_as_float(u2.y & 0xffff0000u) - av[it][4 * g + 3]; } \
      vb[it][0] = pack8(vn, 0); vb[it][1] = pack8(vn, 1); \
      vbg[((size_t)(item * 4 + wid) * 4 + it * 2) * 64 + lane] = __builtin_bit_cast(u32x4, vb[it][0]); \
      vbg[((size_t)(item * 4 + wid) * 4 + it * 2 + 1) * 64 + lane] = __builtin_bit_cast(u32x4, vb[it][1]); } \
    if (n + 1 < 128) U_LOAD(item + 1); \
    _Pragma("unroll") for (int T = 0; T < 4; ++T) { \
      _Pragma("unroll") for (int r = 0; r < 16; ++r) S[T][r] *= sd_cur; \
      _Pragma("unroll") for (int it = 0; it < 2; ++it) \
        _Pragma("unroll") for (int s = 0; s < 2; ++s) { \
          const char* kp = KTl + (32 * T + r32) * 136 + (32 * it + 16 * s + 4 * hi) * 2; \
          S[T] = __builtin_amdgcn_mfma_f32_32x32x16_bf16(mk8(lds64(kp), lds64(kp + 16)), vb[it][s], S[T], 0, 0, 0); } } \
    sd_cur = sd_nxt; \
    __syncthreads(); \
    if (n + 1 < 128) G_WRITE(NXT); \
    __syncthreads(); } while (0)
  float sd_cur = gsd[bh * 128];
  G_LOAD(sa, bh * 128); U_LOAD(bh * 128); G_WRITE(sa);
  G_LOAD(sb_, bh * 128 + 1);
  __syncthreads();
#pragma unroll 1
  for (int n2 = 0; n2 < 128; n2 += 2) {
    SCAN_STEP(n2, sb_, sa);
    SCAN_STEP(n2 + 1, sa, sb_);
  }
#undef SCAN_STEP
#undef G_LOAD
#undef G_WRITE
#undef U_LOAD
}

__device__ __forceinline__ void gdn_out_phase(const Params& p, char* smem, int bid, int nblk) {
  const int tid = otid(), wid = tid >> 6, lane = tid & 63, r32 = lane & 31, hi = lane >> 5;
  char* QDl = smem; char* ATl = smem + 16896; float* Ol = (float*)(smem + 16896 + 8704);
  const char* gqd = p.ws + OFF_GQD; const char* gat = p.ws + OFF_GAT;
  const u32x4* sbg = (const u32x4*)(p.ws + OFF_PROJ); const u32x4* vbg = (const u32x4*)(p.ws + OFF_PROJ + (size_t)2048 * 32768);
  const u16* zb = (const u16*)(p.ws + OFF_PROJ) + (size_t)3 * M * 512;
  u16* concat = (u16*)(p.ws + OFF_HN);
#pragma unroll 1
  for (int item = bid; item < 2048; item += nblk) {
    const int n = item & 127, bh = item >> 7, b = bh >> 2, h = bh & 3;
    {
      u32x4 st[6];
#pragma unroll
      for (int k = 0; k < 4; ++k) st[k] = *(const u32x4*)(gqd + (size_t)item * 16384 + (tid + 256 * k) * 16);
#pragma unroll
      for (int k = 0; k < 2; ++k) st[4 + k] = *(const u32x4*)(gat + (size_t)item * 8192 + (tid + 256 * k) * 16);
#pragma unroll
      for (int k = 0; k < 4; ++k) { const int pc = tid + 256 * k; char* d = QDl + (pc >> 4) * 264 + (pc & 15) * 16;
        *(uint2*)d = uint2{st[k][0], st[k][1]}; *(uint2*)(d + 8) = uint2{st[k][2], st[k][3]}; }
#pragma unroll
      for (int k = 0; k < 2; ++k) { const int pc = tid + 256 * k; char* d = ATl + (pc >> 3) * 136 + (pc & 7) * 16;
        *(uint2*)d = uint2{st[4 + k][0], st[4 + k][1]}; *(uint2*)(d + 8) = uint2{st[4 + k][2], st[4 + k][3]}; }
    }
    bf16x8 sb[8], vb[4];
#pragma unroll
    for (int f = 0; f < 8; ++f) sb[f] = __builtin_bit_cast(bf16x8, sbg[((size_t)(item * 4 + wid) * 8 + f) * 64 + lane]);
#pragma unroll
    for (int f = 0; f < 4; ++f) vb[f] = __builtin_bit_cast(bf16x8, vbg[((size_t)(item * 4 + wid) * 4 + f) * 64 + lane]);
    __syncthreads();
    f32x16 ao[2];
#pragma unroll
    for (int r = 0; r < 16; ++r) { ao[0][r] = 0.f; ao[1][r] = 0.f; }
#pragma unroll
    for (int T = 0; T < 4; ++T)
#pragma unroll
      for (int s = 0; s < 2; ++s) {
        const int cb = (32 * T + 16 * s + 4 * hi) * 2;
#pragma unroll
        for (int it = 0; it < 2; ++it) {
          const char* qp = QDl + (32 * it + r32) * 264 + cb;
          ao[it] = __builtin_amdgcn_mfma_f32_32x32x16_bf16(mk8(lds64(qp), lds64(qp + 16)), sb[T * 2 + s], ao[it], 0, 0, 0);
        }
      }
#pragma unroll
    for (int it2 = 0; it2 < 2; ++it2)
#pragma unroll
      for (int it = 0; it <= it2; ++it)
#pragma unroll
        for (int s = 0; s < 2; ++s) {
          const char* ap = ATl + (32 * it2 + r32) * 136 + (32 * it + 16 * s + 4 * hi) * 2;
          ao[it2] = __builtin_amdgcn_mfma_f32_32x32x16_bf16(mk8(lds64(ap), lds64(ap + 16)), vb[it * 2 + s], ao[it2], 0, 0, 0);
        }
#pragma unroll
    for (int it = 0; it < 2; ++it)
#pragma unroll
      for (int r = 0; r < 16; ++r) Ol[(32 * it + crow(r, hi)) * 132 + wid * 32 + r32] = ao[it][r];
    __syncthreads();
    {
      const int tok = tid >> 2, part = tid & 3;
      const int row = b * SEQ + n * 64 + tok;
      f32x4 a[8]; float ss = 0.f;
#pragma unroll
      for (int k = 0; k < 8; ++k) { a[k] = *(const f32x4*)(Ol + tok * 132 + part * 32 + k * 4); ss += a[k][0] * a[k][0] + a[k][1] * a[k][1] + a[k][2] * a[k][2] + a[k][3] * a[k][3]; }
      ss += __shfl_xor(ss, 1); ss += __shfl_xor(ss, 2);
      const float rs = rsqrtf(ss * (1.f / 128.f) + 1e-6f);
      const u16* zp = zb + (size_t)row * 512 + h * 128 + part * 32;
      const float* hw = p.hy_head_norm_w + part * 32;
      u16* cp = concat + a_off(row, h * 128 + part * 32, 32);
#pragma unroll
      for (int k = 0; k < 4; ++k) {
        float zf[8]; unpack8(*(const u32x4*)(zp + k * 8), zf);
        const f32x4 h0 = *(const f32x4*)(hw + k * 8), h1 = *(const f32x4*)(hw + k * 8 + 4);
        const f32x4 x0 = a[2 * k], x1 = a[2 * k + 1];
        u32x4 w;
        w[0] = pk2(x0[0] * rs * h0[0] * silu_(zf[0]), x0[1] * rs * h0[1] * silu_(zf[1]));
        w[1] = pk2(x0[2] * rs * h0[2] * silu_(zf[2]), x0[3] * rs * h0[3] * silu_(zf[3]));
        w[2] = pk2(x1[0] * rs * h1[0] * silu_(zf[4]), x1[1] * rs * h1[1] * silu_(zf[5]));
        w[3] = pk2(x1[2] * rs * h1[2] * silu_(zf[6]), x1[3] * rs * h1[3] * silu_(zf[7]));
        *(u32x4*)(cp + k * 8) = w;
      }
    }
    __syncthreads();
  }
}

using s16x4 = __attribute__((ext_vector_type(4))) short;
#define KSWZ(row, colB) ((row) * 256 + ((colB) ^ (((row) & 7) << 4)))
#define SBAR() __builtin_amdgcn_sched_barrier(0)
__device__ __forceinline__ unsigned cvtpk(float lo, float hi) { unsigned r; asm volatile("v_cvt_pk_bf16_f32 %0, %1, %2" : "=v"(r) : "v"(lo), "v"(hi)); return r; }
__device__ __forceinline__ int v_st(int k, int c) { const int kk = (k & ~0xC) | ((k & 4) << 1) | ((k & 8) >> 1); return ((kk >> 3) * 4 + (c >> 5)) * 512 + ((kk & 7) * 32 + (c & 31)) * 2; }
__device__ __forceinline__ int v_rd_base(int lane) { return ((lane & 3) << 3) | (((lane >> 2) & 3) << 6) | (((lane >> 4) & 1) << 5) | (((lane >> 5) & 1) << 8); }
constexpr int v_rd_off(int d0, int ks, int half) { return d0 * 512 + ks * 4096 + half * 2048; }
template <int OFF> __device__ __forceinline__ s16x4 tr_read(int vb) {
  s16x4 r; asm volatile("ds_read_b64_tr_b16 %0, %1 offset:%2" : "=&v"(r) : "v"(vb), "i"(OFF) : "memory"); return r;
}
template <int D0> __device__ __forceinline__ void pv_one(f32x16& od, int vb, bf16x8 pa0, bf16x8 pa1, bf16x8 pa2, bf16x8 pa3) {
  const s16x4 l0 = tr_read<v_rd_off(D0, 0, 0)>(vb), h0 = tr_read<v_rd_off(D0, 0, 1)>(vb), l1 = tr_read<v_rd_off(D0, 1, 0)>(vb), h1 = tr_read<v_rd_off(D0, 1, 1)>(vb);
  const s16x4 l2 = tr_read<v_rd_off(D0, 2, 0)>(vb), h2 = tr_read<v_rd_off(D0, 2, 1)>(vb), l3 = tr_read<v_rd_off(D0, 3, 0)>(vb), h3 = tr_read<v_rd_off(D0, 3, 1)>(vb);
  asm volatile("s_waitcnt lgkmcnt(0)" ::: "memory"); SBAR();
#define PK(L, H) (bf16x8){L[0], L[1], L[2], L[3], H[0], H[1], H[2], H[3]}
  od = __builtin_amdgcn_mfma_f32_32x32x16_bf16(pa0, PK(l0, h0), od, 0, 0, 0);
  od = __builtin_amdgcn_mfma_f32_32x32x16_bf16(pa1, PK(l1, h1), od, 0, 0, 0);
  od = __builtin_amdgcn_mfma_f32_32x32x16_bf16(pa2, PK(l2, h2), od, 0, 0, 0);
  od = __builtin_amdgcn_mfma_f32_32x32x16_bf16(pa3, PK(l3, h3), od, 0, 0, 0);
#undef PK
}
__device__ __forceinline__ float pl32_other(float a, float b, int hi) {
  auto rr = __builtin_amdgcn_permlane32_swap(__float_as_uint(a), __float_as_uint(b), false, false);
  return __uint_as_float(hi ? rr[0] : rr[1]);
}
__device__ __forceinline__ void sb_half(f32x16& pz, float& run, bool need_mask, int kb, int t, int hi) {
  constexpr float C2 = 0.08838834764831845f * 1.4426950408889634f;
  f32x16 l;
#pragma unroll
  for (int r = 0; r < 16; ++r) {
    const float e = __builtin_amdgcn_exp2f(fminf(pz[r] * C2, 60.f));
    l[r] = __builtin_amdgcn_rcpf(1.f + e);
    pz[r] = e;
  }
  if (need_mask) {
#pragma unroll
    for (int r = 0; r < 16; ++r) { if (kb + crow(r, hi) >= t) { l[r] = 1.f; pz[r] = 0.f; } }
  }
#pragma unroll
  for (int g = 0; g < 4; ++g) { l[4 * g + 2] *= l[4 * g + 3]; l[4 * g + 1] *= l[4 * g + 2]; l[4 * g] *= l[4 * g + 1]; }
  const float cs3 = l[12], cs2 = l[8] * cs3, cs1 = l[4] * cs2, cs0 = l[0] * cs1;
  const float off0 = cs1 * pl32_other(cs0, cs1, hi) * run;
  const float off1 = cs2 * pl32_other(cs1, cs2, hi) * run;
  const float off2 = cs3 * pl32_other(cs2, cs3, hi) * run;
  const float off3 = pl32_other(cs3, 1.f, hi) * run;
  float tot;
  { auto rr = __builtin_amdgcn_permlane32_swap(__float_as_uint(cs0), __float_as_uint(cs0), false, false); tot = __uint_as_float(rr[0]) * __uint_as_float(rr[1]); }
#pragma unroll
  for (int r = 0; r < 4; ++r) {
    pz[r] = pz[r] * l[r] * off0; pz[4 + r] = pz[4 + r] * l[4 + r] * off1;
    pz[8 + r] = pz[8 + r] * l[8 + r] * off2; pz[12 + r] = pz[12 + r] * l[12 + r] * off3;
  }
  run *= tot;
}

__device__ __forceinline__ void attn_phase(const Params& p, char* smem, int bid, int nblk) {
  const int tid = otid(), wid = tid >> 6, lane = tid & 63, r32 = lane & 31, hi = lane >> 5;
  char* K_lds = smem; char* V_lds = smem + 16384;
  const u16* qkv = (const u16*)(p.ws + OFF_PROJ);
  u16* ao = (u16*)(p.ws + OFF_HN);
  const int sr = tid >> 4, sc = (tid & 15) * 8;
  const int vb0 = (int)(uintptr_t)V_lds + v_rd_base(lane);
  for (int k = 0; k * nblk < 2048; ++k) {
    const int i = (k & 1) ? ((k + 1) * nblk - 1 - bid) : (k * nblk + bid);
    if (i >= 2048) continue;
    const int j = 63 - (i >> 5), bh = i & 31, b = bh >> 3, h = bh & 7;
    const int i0 = j * 128;
    const size_t rowb = (size_t)b * SEQ;
    const int t = i0 + wid * 32 + r32, tmin = i0 + wid * 32, tmax = tmin + 31;
    bf16x8 qr[8];
    {
      const u16* qp = qkv + (rowb + t) * 3072 + h * 128 + hi * 8;
#pragma unroll
      for (int d0 = 0; d0 < 8; ++d0) qr[d0] = *(const bf16x8*)(qp + d0 * 16);
    }
    f32x16 o[4];
#pragma unroll
    for (int d = 0; d < 4; ++d)
#pragma unroll
      for (int r = 0; r < 16; ++r) o[d][r] = 0.f;
    float run = 1.f;
    const u16* kbase = qkv + rowb * 3072 + 1024 + h * 128 + sc;
    u32x4 stk[4], stv[4];
#define SLOAD(KT) do { _Pragma("unroll") for (int ii = 0; ii < 4; ++ii) { const u16* kp = kbase + (size_t)((KT) * 64 + sr + 16 * ii) * 3072; \
      stk[ii] = *(const u32x4*)kp; stv[ii] = *(const u32x4*)(kp + 1024); } } while (0)
#define SWRITE() do { _Pragma("unroll") for (int ii = 0; ii < 4; ++ii) { const int row = sr + 16 * ii; \
      *(u32x4*)(K_lds + KSWZ(row, sc * 2)) = stk[ii]; *(u32x4*)(V_lds + v_st(row, sc)) = stv[ii]; } } while (0)
    const int NT = 2 * j + 2;
    SLOAD(NT - 1); SWRITE(); __syncthreads();
    for (int kt = NT - 1; kt >= 0; --kt) {
      const int k0 = kt * 64;
      if (kt > 0) SLOAD(kt - 1);
      if (k0 <= tmax) {
        bf16x8 pa0, pa1, pa2, pa3;
#define PK4(P, BASE, OUT) do { unsigned a0 = cvtpk(P[BASE + 0], P[BASE + 1]), a1 = cvtpk(P[BASE + 2], P[BASE + 3]); \
    unsigned b0_ = cvtpk(P[BASE + 4], P[BASE + 5]), b1_ = cvtpk(P[BASE + 6], P[BASE + 7]); \
    auto r0 = __builtin_amdgcn_permlane32_swap(a0, b0_, false, false); auto r1 = __builtin_amdgcn_permlane32_swap(a1, b1_, false, false); \
    u32x4 w = {r0[0], r1[0], r0[1], r1[1]}; OUT = *reinterpret_cast<bf16x8*>(&w); } while (0)
        if (k0 + 32 <= tmax) {
          f32x16 pz;
#pragma unroll
          for (int r = 0; r < 16; ++r) pz[r] = 0.f;
#pragma unroll
          for (int d0 = 0; d0 < 8; ++d0) {
            const bf16x8 kf = *(const bf16x8*)(K_lds + KSWZ(32 + r32, (d0 * 16 + hi * 8) * 2));
            pz = __builtin_amdgcn_mfma_f32_32x32x16_bf16(kf, qr[d0], pz, 0, 0, 0);
          }
          sb_half(pz, run, k0 + 63 >= tmin, k0 + 32, t, hi);
          PK4(pz, 0, pa2); PK4(pz, 8, pa3);
        } else {
          pa2 = bf16x8{0, 0, 0, 0, 0, 0, 0, 0}; pa3 = pa2;
        }
        {
          f32x16 pz;
#pragma unroll
          for (int r = 0; r < 16; ++r) pz[r] = 0.f;
#pragma unroll
          for (int d0 = 0; d0 < 8; ++d0) {
            const bf16x8 kf = *(const bf16x8*)(K_lds + KSWZ(r32, (d0 * 16 + hi * 8) * 2));
            pz = __builtin_amdgcn_mfma_f32_32x32x16_bf16(kf, qr[d0], pz, 0, 0, 0);
          }
          sb_half(pz, run, k0 + 31 >= tmin, k0, t, hi);
          PK4(pz, 0, pa0); PK4(pz, 8, pa1);
        }
#undef PK4
        pv_one<0>(o[0], vb0, pa0, pa1, pa2, pa3); pv_one<1>(o[1], vb0, pa0, pa1, pa2, pa3);
        pv_one<2>(o[2], vb0, pa0, pa1, pa2, pa3); pv_one<3>(o[3], vb0, pa0, pa1, pa2, pa3);
      }
      __syncthreads();
      if (kt > 0) SWRITE();
      __syncthreads();
    }
#undef SLOAD
#undef SWRITE
    {
      const int orow0 = (int)rowb + i0 + wid * 32;
#pragma unroll
      for (int r = 0; r < 16; ++r) {
        const int orow = crow(r, hi);
#pragma unroll
        for (int d0 = 0; d0 < 4; ++d0) ao[a_off(orow0 + orow, h * 128 + d0 * 32 + r32, 32)] = f2bf(o[d0][r]);
      }
    }
  }
}

#define XB_TMO      128
#define XB_XCNT(j)  (256  + 64 * (j))
#define XB_XSUB(j)  (1280 + 64 * (j))
#define XB_XGEN(j)  (2304 + 64 * (j))
#define XB_TOP      3328
#define XB_TOPGEN   3392
#define XCD_BAR_WORDS 3456
#define XB_SPIN_CAP (1u << 23)
#define LAS __attribute__((address_space(3)))
__device__ __forceinline__ unsigned xb_ld(unsigned* p)              { return __hip_atomic_load(p, __ATOMIC_RELAXED, __HIP_MEMORY_SCOPE_AGENT); }
__device__ __forceinline__ unsigned xb_add(unsigned* p, unsigned v) { return __hip_atomic_fetch_add(p, v, __ATOMIC_RELAXED, __HIP_MEMORY_SCOPE_AGENT); }
__device__ __forceinline__ unsigned xb_xcc_id() { return (unsigned)__builtin_amdgcn_s_getreg((3 << 11) | 20) & 0xFu; }
#define XB_SPIN(cond, bar) do { unsigned _sp = 0; while (cond) { __builtin_amdgcn_s_sleep(1); \
    if ((++_sp & 255u) == 0u) { if (xb_ld(&(bar)[XB_TMO])) break; if (_sp > XB_SPIN_CAP) { atomicAdd(&(bar)[XB_TMO], 1u); break; } } } } while (0)
struct XcdBarrier { unsigned* bar; unsigned x; volatile LAS unsigned* st; };
__device__ __forceinline__ XcdBarrier xcd_barrier_post(unsigned* bar, volatile LAS unsigned* st) {
  XcdBarrier b; b.bar = bar; b.x = xb_xcc_id(); b.st = st;
  if (__builtin_amdgcn_workitem_id_x() == 0) (void)xb_add(&bar[XB_XCNT(b.x)], 1u);
  return b;
}
__device__ __forceinline__ void xcd_barrier_complete(unsigned* bar, unsigned x, unsigned& nloc, unsigned& nx) {
  const unsigned G = gridDim.x * gridDim.y * gridDim.z;
  unsigned sum, cnt, mine, sp = 0u;
  for (;;) {
    sum = 0u; cnt = 0u; mine = 0u;
#pragma unroll
    for (unsigned j = 0; j < 16; ++j) { const unsigned c = xb_ld(&bar[XB_XCNT(j)]); sum += c; cnt += (c > 0u) ? 1u : 0u; mine = (j == x) ? c : mine; }
    if (sum == G) break;
    __builtin_amdgcn_s_sleep(1);
    if ((++sp & 255u) == 0u) { if (xb_ld(&bar[XB_TMO])) break; if (sp > XB_SPIN_CAP) { atomicAdd(&bar[XB_TMO], 1u); break; } }
  }
  nloc = mine > 0u ? mine : 1u; nx = cnt > 0u ? cnt : 1u;
}
__device__ __forceinline__ void xcd_barrier(const XcdBarrier& b) {
  asm volatile("s_waitcnt vmcnt(0)" ::: "memory");
  __syncthreads();
  if (__builtin_amdgcn_workitem_id_x() == 0) {
    unsigned* bar = b.bar;
    __builtin_amdgcn_s_waitcnt(0);
    unsigned nloc = b.st[0], nx = b.st[1];
    if (nloc == 0u) { xcd_barrier_complete(bar, b.x, nloc, nx); b.st[0] = nloc; b.st[1] = nx; }
    const unsigned old = xb_add(&bar[XB_XSUB(b.x)], 1u);
    const unsigned gen = old / nloc;
    if (old + 1u == (gen + 1u) * nloc) {
      __builtin_amdgcn_fence(__ATOMIC_RELEASE, "agent");
      asm volatile("s_waitcnt vmcnt(0)" ::: "memory");
      const unsigned og = xb_add(&bar[XB_TOP], 1u);
      const unsigned tg = og / nx;
      if (og + 1u == (tg + 1u) * nx) xb_add(&bar[XB_TOPGEN], 1u);
      else XB_SPIN(xb_ld(&bar[XB_TOPGEN]) == tg, bar);
      __builtin_amdgcn_fence(__ATOMIC_ACQUIRE, "agent");
      xb_add(&bar[XB_XGEN(b.x)], 1u);
      asm volatile("s_waitcnt vmcnt(0)" ::: "memory");
    } else {
      XB_SPIN(xb_ld(&bar[XB_XGEN(b.x)]) == gen, bar);
      __builtin_amdgcn_fence(__ATOMIC_ACQUIRE, "agent");
      asm volatile("s_waitcnt vmcnt(0)" ::: "memory");
    }
  }
  __syncthreads();
}

__global__ void __launch_bounds__(256, 2) mega(Params p) {
  __shared__ __attribute__((aligned(16))) char smem[SMEM_BYTES];
  __shared__ uint4 xb_words;
  const int bid = blockIdx.x, nblk = gridDim.x;
  char* ws = p.ws;
  if (__builtin_amdgcn_workitem_id_x() == 0) xb_words = make_uint4(0u, 0u, 0u, 0u);
  __syncthreads();
  const XcdBarrier xbar = xcd_barrier_post((unsigned*)(ws + OFF_BAR), (volatile LAS unsigned*)&xb_words);
  const float* mod = (const float*)(ws + OFF_MOD);
  u16* hn = (u16*)(ws + OFF_HN);
#define PH_BEGIN(n) if (p.phase_lo <= (n) && (n) < p.phase_hi) {
#define PH_END(n) if ((n) + 1 < p.phase_hi) { if ((n) == 0) cg::this_grid().sync(); else xcd_barrier(xbar); } }
  PH_BEGIN(0) phase0(p, smem, bid, nblk); PH_END(0)
  PH_BEGIN(1) norm_phase<1>(p, p.x, p.norm_mix_w, mod, 0, 1024, smem, bid, nblk); PH_END(1)
  PH_BEGIN(2) { EpiArgs ea{}; ea.outb = (u16*)(ws + OFF_PROJ); ea.ux = (u16*)(ws + OFF_UX);
        gemm_phase<E_PROJ0>(hn, 32, 0, (const u16*)(ws + OFF_WT_HYIN), 32, 0, 1024, M / 256, PN / 128, 1, ea, smem, bid, nblk); } PH_END(2)
  PH_BEGIN(3) { EpiArgs ea{}; ea.outf = (float*)(ws + OFF_XE);
        gemm_phase<E_XE>((const u16*)(ws + OFF_UX), 20, (size_t)S5C * UXW, (const u16*)(ws + OFF_EG), 16, (size_t)128 * 512, 512, S5C / 256, 1, 32, ea, smem, bid, nblk); } PH_END(3)
  PH_BEGIN(4) { s5_carry_phase(p, bid, nblk); gdn_prep_phase(p, smem, bid, nblk); } PH_END(4)
  PH_BEGIN(5) {
        if (bid < 16) { gdn_scan_item(p, bid, smem); }
        else { EpiArgs ea{}; ea.outb = (u16*)(ws + OFF_Y5); ea.ux = (u16*)(ws + OFF_UX); ea.bias = p.s5_d;
          gemm_phase<E_S5Y>((const u16*)(ws + OFF_UX), 20, (size_t)S5C * UXW, (const u16*)(ws + OFF_MF), 20, (size_t)512 * UXW, UXW, S5C / 256, 4, 32, ea, smem, bid - 16, nblk - 16); }
      } PH_END(5)
  PH_BEGIN(6) { gdn_out_phase(p, smem, bid, nblk); __syncthreads();
 EpiArgs ea{}; ea.outb = hn; ea.y5 = (const u16*)(ws + OFF_Y5); ea.bias = p.s5_glu_b;
        gemm_phase<E_GLU>((const u16*)(ws + OFF_Y5), 16, 0, (const u16*)(ws + OFF_WT_GLU), 16, 0, 512, M / 256, 4, 1, ea, smem, bid, nblk); } PH_END(6)
  PH_BEGIN(8) { EpiArgs ea{}; ea.outf = p.out; ea.res = p.x; ea.gate = mod + 2048;
        gemm_phase<E_RESID>(hn, 32, 0, (const u16*)(ws + OFF_WT_HYOUT), 32, 0, 1024, M / 256, 8, 1, ea, smem, bid, nblk); } PH_END(8)
  PH_BEGIN(9) norm_phase<0>(p, p.out, p.norm_ffn_w, mod, 3072, 4096, smem, bid, nblk); PH_END(9)
  PH_BEGIN(10) { EpiArgs ea{}; ea.outb = (u16*)(ws + OFF_PROJ);
        gemm_phase<E_SWIGLU>(hn, 32, 0, (const u16*)(ws + OFF_WT_FFNIN), 32, 0, 1024, M / 256, 2 * FF / 128, 1, ea, smem, bid, nblk); } PH_END(10)
  PH_BEGIN(11) { EpiArgs ea{}; ea.outf = p.out; ea.res = p.out; ea.gate = mod + 5120;
        gemm_phase<E_RESID>((const u16*)(ws + OFF_PROJ), FF / 32, 0, (const u16*)(ws + OFF_WT_FFNOUT), FF / 32, 0, FF, M / 256, 8, 1, ea, smem, bid, nblk); } PH_END(11)
  PH_BEGIN(12) norm_phase<0>(p, p.out, p.norm_mix_w + 1024, mod + 4 * 6144, 0, 1024, smem, bid, nblk); PH_END(12)
  PH_BEGIN(13) { EpiArgs ea{}; ea.outb = (u16*)(ws + OFF_PROJ); ea.ldc = 3072;
        gemm_phase<E_BF16>(hn, 32, 0, (const u16*)(ws + OFF_WT_SBIN), 32, 0, 1024, M / 256, 24, 1, ea, smem, bid, nblk); } PH_END(13)
  PH_BEGIN(14) attn_phase(p, smem, bid, nblk); PH_END(14)
  PH_BEGIN(15) { EpiArgs ea{}; ea.outf = p.out; ea.res = p.out; ea.gate = mod + 4 * 6144 + 2048;
        gemm_phase<E_RESID>(hn, 32, 0, (const u16*)(ws + OFF_WT_SBOUT), 32, 0, 1024, M / 256, 8, 1, ea, smem, bid, nblk); } PH_END(15)
  PH_BEGIN(16) norm_phase<0>(p, p.out, p.norm_ffn_w + 1024, mod + 4 * 6144, 3072, 4096, smem, bid, nblk); PH_END(16)
  PH_BEGIN(17) { EpiArgs ea{}; ea.outb = (u16*)(ws + OFF_PROJ);
        gemm_phase<E_SWIGLU>(hn, 32, 0, (const u16*)(ws + OFF_WT_FFNIN + SZ_WT_FFNIN), 32, 0, 1024, M / 256, 2 * FF / 128, 1, ea, smem, bid, nblk); } PH_END(17)
  PH_BEGIN(18) { EpiArgs ea{}; ea.outf = p.out; ea.res = p.out; ea.gate = mod + 4 * 6144 + 5120;
        gemm_phase<E_RESID>((const u16*)(ws + OFF_PROJ), FF / 32, 0, (const u16*)(ws + OFF_WT_FFNOUT + SZ_WT_FFNOUT), FF / 32, 0, FF, M / 256, 8, 1, ea, smem, bid, nblk); } PH_END(18)
  PH_BEGIN(19) norm_phase<2>(p, p.out, p.final_norm_w, mod, 0, 0, smem, bid, nblk); PH_END(19)
}

extern "C" void kernel_launch(void* const* d_in, const int* in_sizes, int n_in, void* d_out, int out_size, void* d_ws, size_t ws_size,
                              hipStream_t stream) {
  static int grid_blocks = 0;
  if (!grid_blocks) {
    int dev = 0, cus = 0, per_cu = 0;
    hipGetDevice(&dev);
    hipDeviceGetAttribute(&cus, hipDeviceAttributeMultiprocessorCount, dev);
    hipOccupancyMaxActiveBlocksPerMultiprocessor(&per_cu, mega, 256, 0);
    if (per_cu > 2) per_cu = 2;
    if (per_cu < 1) per_cu = 1;
    grid_blocks = cus * per_cu;
  }
  Params p{};
  const float* const* in = (const float* const*)d_in;
  p.x = in[0]; p.c = in[1]; p.ada_w = in[2]; p.ada_b = in[3]; p.norm_mix_w = in[4]; p.norm_ffn_w = in[5]; p.ffn_w_in = in[6]; p.ffn_w_out = in[7];
  p.hy_w_in = in[8]; p.hy_conv_w = in[9]; p.hy_a_log = in[10]; p.hy_dt_bias = in[11]; p.hy_head_norm_w = in[12];
  p.s5_lam_re = in[13]; p.s5_lam_im = in[14]; p.s5_log_dt = in[15]; p.s5_b_re = in[16]; p.s5_b_im = in[17]; p.s5_c_re = in[18]; p.s5_c_im = in[19];
  p.s5_d = in[20]; p.s5_glu_w = in[21]; p.s5_glu_b = in[22]; p.hy_w_out = in[23]; p.sb_w_in = in[24]; p.sb_w_out = in[25]; p.final_norm_w = in[26];
  p.out = (float*)d_out; p.ws = (char*)d_ws;
#if ONE_LAUNCH
  p.phase_lo = 0; p.phase_hi = NPHASE;
  (void)hipMemsetAsync((char*)d_ws + OFF_BAR, 0, (size_t)XCD_BAR_WORDS_C * 4, stream);
  void* args[] = {&p};
  hipError_t e = hipLaunchCooperativeKernel((void*)mega, dim3(grid_blocks), dim3(256), args, 0, stream);
  if (e != hipSuccess) fprintf(stderr, "cooperative launch failed: %s (grid %d)\n", hipGetErrorString(e), grid_blocks);
#else
  for (int ph = 0; ph < NPHASE; ++ph) {
    p.phase_lo = ph; p.phase_hi = ph + 1;
    hipLaunchKernelGGL(mega, dim3(grid_blocks), dim3(256), 0, stream, p);
  }
#endif
}
```

```cpp
#include <hip/hip_runtime.h>
#include <hip/hip_cooperative_groups.h>
#include <stdint.h>
#include <cstdio>
namespace cg = cooperative_groups;

#ifndef ONE_LAUNCH
#define ONE_LAUNCH 1
#endif

typedef unsigned short u16;
using bf16x8 = __attribute__((ext_vector_type(8))) short;
using f32x4 = __attribute__((ext_vector_type(4))) float;
using u32x4 = __attribute__((ext_vector_type(4))) unsigned;

constexpr int D = 1024, NB = 4, SEQ = 8192, M = NB * SEQ, FF = 2816, EIN = 2568, PN = 2560, PJ = 2048;
constexpr int NPHASE = 20;
constexpr int XCD_BAR_WORDS_C = 3456;
constexpr int S5T = 32, S5C = M / S5T, UXW = 640;

constexpr size_t SZ_WT_HYIN = (size_t)PN * 1024 * 2, SZ_WT_SQ = (size_t)1024 * 1024 * 2, SZ_WT_GLU = (size_t)512 * 512 * 2;
constexpr size_t SZ_WT_FFNIN = (size_t)2 * FF * 1024 * 2, SZ_WT_FFNOUT = (size_t)1024 * FF * 2, SZ_WT_SBIN = (size_t)3072 * 1024 * 2;
constexpr size_t OFF_WT_HYIN = 0;
constexpr size_t OFF_WT_HYOUT = OFF_WT_HYIN + SZ_WT_HYIN;
constexpr size_t OFF_WT_GLU = OFF_WT_HYOUT + SZ_WT_SQ;
constexpr size_t OFF_WT_FFNIN = OFF_WT_GLU + SZ_WT_GLU;
constexpr size_t OFF_WT_FFNOUT = OFF_WT_FFNIN + 2 * SZ_WT_FFNIN;
constexpr size_t OFF_WT_SBIN = OFF_WT_FFNOUT + 2 * SZ_WT_FFNOUT;
constexpr size_t OFF_WT_SBOUT = OFF_WT_SBIN + SZ_WT_SBIN;
constexpr size_t OFF_MOD = OFF_WT_SBOUT + SZ_WT_SQ;
constexpr size_t OFF_BETA = OFF_MOD + (size_t)2 * 4 * 6144 * 4;
constexpr size_t OFF_G = OFF_BETA + (size_t)M * 4 * 4;
constexpr size_t OFF_HN = OFF_G + (size_t)M * 4 * 4;
constexpr size_t OFF_Y5 = OFF_HN + (size_t)M * 1024 * 2;
constexpr size_t OFF_UX = OFF_Y5 + (size_t)M * 512 * 2;
constexpr size_t OFF_MF = OFF_UX + (size_t)32 * S5C * UXW * 2;
constexpr size_t OFF_EG = OFF_MF + (size_t)32 * 512 * UXW * 2;
constexpr size_t OFF_XE = OFF_EG + (size_t)32 * 128 * 512 * 2;
constexpr size_t OFF_A32 = OFF_XE + (size_t)32 * S5C * 128 * 4;
constexpr size_t OFF_PROJ = OFF_A32 + (size_t)32 * 64 * 2 * 4;
constexpr size_t OFF_GW = OFF_PROJ + (size_t)M * PJ * 2;
constexpr size_t OFF_GQD = OFF_GW + (size_t)2048 * 8192 * 2;
constexpr size_t OFF_GKT = OFF_GQD + (size_t)2048 * 8192 * 2;
constexpr size_t OFF_GUT = OFF_GKT + (size_t)2048 * 8192 * 2;
constexpr size_t OFF_GAT = OFF_GUT + (size_t)2048 * 8192 * 2;
constexpr size_t OFF_GSD = OFF_GAT + (size_t)2048 * 4096 * 2;
constexpr size_t OFF_BAR = OFF_GSD + (size_t)2048 * 4;
constexpr size_t WS_TOTAL = OFF_BAR + (size_t)XCD_BAR_WORDS_C * 4;
static_assert((size_t)M * 3072 * 2 <= WS_TOTAL - OFF_PROJ, "QKV alias");
static_assert(WS_TOTAL <= (size_t)512 * 1024 * 1024, "workspace too large");

struct Params {
  const float *x, *c, *ada_w, *ada_b, *norm_mix_w, *norm_ffn_w, *ffn_w_in, *ffn_w_out;
  const float *hy_w_in, *hy_conv_w, *hy_a_log, *hy_dt_bias, *hy_head_norm_w;
  const float *s5_lam_re, *s5_lam_im, *s5_log_dt, *s5_b_re, *s5_b_im, *s5_c_re, *s5_c_im, *s5_d, *s5_glu_w, *s5_glu_b, *hy_w_out;
  const float *sb_w_in, *sb_w_out, *final_norm_w;
  float* out;
  char* ws;
  int phase_lo, phase_hi;
};

constexpr int SMEM_BYTES = 73728;

__device__ __forceinline__ int otid() { int t = __builtin_amdgcn_workitem_id_x(); asm volatile("" : "+v"(t)); return t; }
__device__ __forceinline__ u16 f2bf(float x) { unsigned u = __float_as_uint(x); u += 0x7fffu + ((u >> 16) & 1u); return (u16)(u >> 16); }
typedef __bf16 bf16v2 __attribute__((ext_vector_type(2)));
typedef float f32v2 __attribute__((ext_vector_type(2)));
__device__ __forceinline__ unsigned pk2(float a, float b) { f32v2 v = {a, b}; bf16v2 r = __builtin_convertvector(v, bf16v2); return __builtin_bit_cast(unsigned, r); }
__device__ __forceinline__ float bf2f(u16 v) { return __uint_as_float(((unsigned)v) << 16); }
__device__ __forceinline__ float sigmoid_(float x) { return 1.f / (1.f + __expf(-x)); }
__device__ __forceinline__ float silu_(float x) { return x * sigmoid_(x); }
__device__ __forceinline__ float softplus_(float x) { return fmaxf(x, 0.f) + log1pf(__expf(-fabsf(x))); }
__device__ __forceinline__ float gelu_tanh_(float y) { return 0.5f * y * (1.f + tanhf(0.7978845608028654f * (y + 0.044715f * y * y * y))); }

__device__ __forceinline__ size_t pj_idx(int row, int col) { return (size_t)(col >> 9) * ((size_t)M * 512) + (size_t)row * 512 + (col & 511); }
__device__ __forceinline__ size_t a_off(int row, int col, int nks) { return ((size_t)((row >> 8) * nks + (col >> 5)) << 13) + ((row & 255) << 5) + (col & 31); }
__device__ __forceinline__ size_t b_off(int n, int k, int nks) { return ((size_t)((n >> 7) * nks + (k >> 5)) << 12) + ((n & 127) << 5) + (k & 31); }

struct TrJob { const float* src; u16* dst; int K, Nsrc, Nd, mode; };
__device__ __forceinline__ TrJob get_job(const Params& p, int j) {
  TrJob t;
  switch (j) {
    case 0: t = {p.hy_w_in, (u16*)(p.ws + OFF_WT_HYIN), 1024, EIN, PN, 1}; break;
    case 1: t = {p.hy_w_out, (u16*)(p.ws + OFF_WT_HYOUT), 1024, 1024, 1024, 0}; break;
    case 2: t = {p.s5_glu_w, (u16*)(p.ws + OFF_WT_GLU), 512, 512, 512, 0}; break;
    case 3: t = {p.ffn_w_in, (u16*)(p.ws + OFF_WT_FFNIN), 1024, 2 * FF, 2 * FF, 2}; break;
    case 4: t = {p.ffn_w_in + (size_t)1024 * 2 * FF, (u16*)(p.ws + OFF_WT_FFNIN + SZ_WT_FFNIN), 1024, 2 * FF, 2 * FF, 2}; break;
    case 5: t = {p.ffn_w_out, (u16*)(p.ws + OFF_WT_FFNOUT), FF, 1024, 1024, 0}; break;
    case 6: t = {p.ffn_w_out + (size_t)FF * 1024, (u16*)(p.ws + OFF_WT_FFNOUT + SZ_WT_FFNOUT), FF, 1024, 1024, 0}; break;
    case 7: t = {p.sb_w_in, (u16*)(p.ws + OFF_WT_SBIN), 1024, 3072, 3072, 0}; break;
    default: t = {p.sb_w_out, (u16*)(p.ws + OFF_WT_SBOUT), 1024, 1024, 1024, 0}; break;
  }
  return t;
}
__device__ __forceinline__ int src_col(int R, int mode) {
  if (mode == 0) return R;
  if (mode == 1) return R < 2048 ? R : R + 8;
  return ((R >> 4) & 1) * FF + (R >> 5) * 16 + (R & 15);
}
constexpr int N_TR_ITEMS = 640 + 256 + 64 + 2 * 1408 + 2 * 704 + 768 + 256;
constexpr int N_MOD_ITEMS = 2 * 6144 / 16;

__device__ __forceinline__ void s5_table_item(const Params& p, int item, char* smem) {
  const int tid = otid(), g = item >> 5, tau = item & 31;
  float* pwr = (float*)smem; float* pwi = pwr + 64; float* p1r = pwi + 64; float* p1i = p1r + 64;
  float* bbr = p1i + 64; float* bbi = bbr + 1024; float* cre = bbi + 1024; float* cim = cre + 1024;
  const float dt = expf(p.s5_log_dt[g]);
  if (tid < 64) {
    const float lr = p.s5_lam_re[g * 64 + tid], li = p.s5_lam_im[g * 64 + tid];
    float sn, cs;
    float mg = expf(lr * dt * (float)tau); sincosf(li * dt * (float)tau, &sn, &cs); pwr[tid] = mg * cs; pwi[tid] = mg * sn;
    mg = expf(lr * dt * (float)(tau + 1)); sincosf(li * dt * (float)(tau + 1), &sn, &cs); p1r[tid] = mg * cs; p1i[tid] = mg * sn;
    if (tau == 31) { float* a32 = (float*)(p.ws + OFF_A32); a32[(g * 64 + tid) * 2] = mg * cs; a32[(g * 64 + tid) * 2 + 1] = mg * sn; }
  }
  {
    const int pp = tid >> 2, hq = (tid & 3) * 4;
    const float lr = p.s5_lam_re[g * 64 + pp], li = p.s5_lam_im[g * 64 + pp];
    const float mg = expf(lr * dt); float sn, cs; sincosf(li * dt, &sn, &cs);
    const float ar = mg * cs, ai = mg * sn, den = lr * lr + li * li, nr = ar - 1.f, ni = ai;
    const float fre = (nr * lr + ni * li) / den, fim = (ni * lr - nr * li) / den;
#pragma unroll
    for (int e = 0; e < 4; ++e) {
      const float br = p.s5_b_re[(size_t)(g * 64 + pp) * 16 + hq + e], bi = p.s5_b_im[(size_t)(g * 64 + pp) * 16 + hq + e];
      bbr[pp * 16 + hq + e] = fre * br - fim * bi; bbi[pp * 16 + hq + e] = fre * bi + fim * br;
    }
    for (int i = tid; i < 1024; i += 256) { cre[i] = p.s5_c_re[(size_t)g * 1024 + i]; cim[i] = p.s5_c_im[(size_t)g * 1024 + i]; }
  }
  __syncthreads();
  u16* mf = (u16*)(p.ws + OFF_MF) + (size_t)g * 512 * UXW;
  u16* eg = (u16*)(p.ws + OFF_EG) + (size_t)g * 128 * 512;
  {
    const int h = tid >> 4, hp = tid & 15;
    float kv = 0.f;
    for (int pp = 0; pp < 64; ++pp) {
      const float cr = cre[h * 64 + pp], ci = cim[h * 64 + pp], pr = pwr[pp], pi = pwi[pp];
      kv += (cr * pr - ci * pi) * bbr[pp * 16 + hp] - (cr * pi + ci * pr) * bbi[pp * 16 + hp];
    }
    const u16 kb = f2bf(kv);
    for (int s0 = 0; s0 + tau < 32; ++s0) mf[b_off((s0 + tau) * 16 + h, s0 * 16 + hp, 20)] = kb;
    for (int t0 = 0; t0 + tau + 1 < 32; ++t0) mf[b_off(t0 * 16 + h, (t0 + tau + 1) * 16 + hp, 20)] = 0;
#pragma unroll
    for (int e = 0; e < 4; ++e) {
      const int pp = hp * 4 + e;
      const float cr = cre[h * 64 + pp], ci = cim[h * 64 + pp], pr = p1r[pp], pi = p1i[pp];
      mf[b_off(tau * 16 + h, 512 + pp, 20)] = f2bf(cr * pr - ci * pi);
      mf[b_off(tau * 16 + h, 576 + pp, 20)] = f2bf(-(cr * pi + ci * pr));
    }
  }
  {
    const int pp = tid >> 2, hq = (tid & 3) * 4, s0 = 31 - tau;
#pragma unroll
    for (int e = 0; e < 4; ++e) {
      const float br = bbr[pp * 16 + hq + e], bi = bbi[pp * 16 + hq + e], pr = pwr[pp], pi = pwi[pp];
      eg[b_off(pp, s0 * 16 + hq + e, 16)] = f2bf(pr * br - pi * bi);
      eg[b_off(64 + pp, s0 * 16 + hq + e, 16)] = f2bf(pr * bi + pi * br);
    }
  }
  __syncthreads();
}

__device__ __forceinline__ void phase0(const Params& p, char* smem, int bid, int nblk) {
  const int tid = otid();
  for (int it = bid; it < N_TR_ITEMS + N_MOD_ITEMS + 1024; it += nblk) {
    if (it >= N_TR_ITEMS + N_MOD_ITEMS) { s5_table_item(p, it - N_TR_ITEMS - N_MOD_ITEMS, smem); continue; }
    if (it < N_TR_ITEMS) {
      int rem = it, j = 0; TrJob jb;
      for (;; ++j) { jb = get_job(p, j); int n = (jb.Nd >> 6) * (jb.K >> 6); if (rem < n) break; rem -= n; }
      const int nk = jb.K >> 6, R0 = (rem / nk) * 64, k0 = (rem % nk) * 64;
      u16* s = (u16*)smem;
      {
        const int r = tid & 63, kk = tid >> 6;
        const float* sp = jb.src + (size_t)k0 * jb.Nsrc + src_col(R0 + r, jb.mode);
#pragma unroll
        for (int i = 0; i < 16; ++i) { int k = kk + 4 * i; s[r * 72 + k] = f2bf(sp[(size_t)k * jb.Nsrc]); }
      }
      __syncthreads();
      {
        const int r = tid >> 2, ch = tid & 3;
#pragma unroll
        for (int i = 0; i < 2; ++i) {
          int c8 = (ch + 4 * i) * 8;
          *(u32x4*)(jb.dst + b_off(R0 + r, k0 + c8, jb.K >> 5)) = *(const u32x4*)(s + r * 72 + c8);
        }
      }
      __syncthreads();
    } else {
      const int mi = it - N_TR_ITEMS, l = mi / 384, n0 = (mi % 384) * 16;
      float* cact = (float*)smem;
      float* red = cact + 4096;
      for (int i = tid; i < 4096; i += 256) cact[i] = silu_(p.c[i]);
      __syncthreads();
      const int cl = tid & 15, ksub = tid >> 4;
      float a0 = 0, a1 = 0, a2 = 0, a3 = 0;
      const float* wp = p.ada_w + (size_t)l * 1024 * 6144 + n0 + cl;
#pragma unroll 16
      for (int k = ksub * 64; k < ksub * 64 + 64; ++k) {
        float w = wp[(size_t)k * 6144];
        a0 += cact[k] * w; a1 += cact[1024 + k] * w; a2 += cact[2048 + k] * w; a3 += cact[3072 + k] * w;
      }
      red[(ksub * 4 + 0) * 16 + cl] = a0; red[(ksub * 4 + 1) * 16 + cl] = a1;
      red[(ksub * 4 + 2) * 16 + cl] = a2; red[(ksub * 4 + 3) * 16 + cl] = a3;
      __syncthreads();
      if (tid < 64) {
        const int b = tid >> 4;
        float sum = 0.f;
#pragma unroll
        for (int q = 0; q < 16; ++q) sum += red[(q * 4 + b) * 16 + cl];
        float* mod = (float*)(p.ws + OFF_MOD);
        mod[(size_t)(l * 4 + b) * 6144 + n0 + cl] = sum + p.ada_b[l * 6144 + n0 + cl];
      }
      __syncthreads();
    }
  }
}

template <int MODE>
__device__ __forceinline__ void norm_phase(const Params& p, const float* src, const float* w, const float* modl, int sh_off, int sc_off,
                           char* smem, int bid, int nblk) {
  const int tid = otid(), wid = tid >> 6, lane = tid & 63;
  float* wba = (float*)smem;
  if (MODE == 1) {
    for (int i = tid; i < 1024 * 8; i += 256) wba[i] = p.hy_w_in[(size_t)(i >> 3) * EIN + 2048 + (i & 7)];
    __syncthreads();
  }
  u16* hn = (u16*)(p.ws + OFF_HN);
  auto process = [&](int row, f32x4 (&v)[4]) {
    float ss = 0.f;
#pragma unroll
    for (int i = 0; i < 4; ++i) ss += v[i][0] * v[i][0] + v[i][1] * v[i][1] + v[i][2] * v[i][2] + v[i][3] * v[i][3];
#pragma unroll
    for (int o = 32; o >= 1; o >>= 1) ss += __shfl_xor(ss, o);
    const float rstd = rsqrtf(ss * (1.f / 1024.f) + 1e-6f);
    const int b = row >> 13;
    float dots[8];
    if (MODE == 1) { for (int j = 0; j < 8; ++j) dots[j] = 0.f; }
#pragma unroll
    for (int i = 0; i < 4; ++i) {
      const int c0 = i * 256 + lane * 4;
      f32x4 ww = *(const f32x4*)(w + c0);
      f32x4 y;
      if (MODE == 2) {
#pragma unroll
        for (int e = 0; e < 4; ++e) y[e] = v[i][e] * rstd * ww[e];
        *(f32x4*)(p.out + (size_t)row * 1024 + c0) = y;
      } else {
        f32x4 sc = *(const f32x4*)(modl + (size_t)b * 6144 + sc_off + c0);
        f32x4 sh = *(const f32x4*)(modl + (size_t)b * 6144 + sh_off + c0);
#pragma unroll
        for (int e = 0; e < 4; ++e) y[e] = v[i][e] * rstd * ww[e] * (1.f + sc[e]) + sh[e];
        uint2 pk; pk.x = (unsigned)f2bf(y[0]) | ((unsigned)f2bf(y[1]) << 16); pk.y = (unsigned)f2bf(y[2]) | ((unsigned)f2bf(y[3]) << 16);
        *(uint2*)(hn + a_off(row, c0, 32)) = pk;
        if (MODE == 1) {
#pragma unroll
          for (int e = 0; e < 4; ++e) {
            f32x4 w0 = *(const f32x4*)(wba + (c0 + e) * 8), w1 = *(const f32x4*)(wba + (c0 + e) * 8 + 4);
#pragma unroll
            for (int j = 0; j < 4; ++j) { dots[j] += y[e] * w0[j]; dots[4 + j] += y[e] * w1[j]; }
          }
        }
      }
    }
    if (MODE == 1) {
#pragma unroll
      for (int j = 0; j < 8; ++j) {
#pragma unroll
        for (int o = 32; o >= 1; o >>= 1) dots[j] += __shfl_xor(dots[j], o);
      }
      if (lane == 0) {
        float* beta = (float*)(p.ws + OFF_BETA); float* gg = (float*)(p.ws + OFF_G);
#pragma unroll
        for (int h = 0; h < 4; ++h) {
          beta[(size_t)row * 4 + h] = sigmoid_(dots[h]);
          gg[(size_t)row * 4 + h] = -__expf(p.hy_a_log[h]) * softplus_(dots[4 + h] + p.hy_dt_bias[h]);
        }
      }
    }
  };
#pragma unroll 1
  for (int row = bid * 4 + wid; row < M; row += nblk * 8) {
    const int row1 = row + nblk * 4;
    const bool has1 = row1 < M;
    f32x4 v0[4], v1[4];
#pragma unroll
    for (int i = 0; i < 4; ++i) v0[i] = *(const f32x4*)(src + (size_t)row * 1024 + i * 256 + lane * 4);
#pragma unroll
    for (int i = 0; i < 4; ++i) v1[i] = has1 ? *(const f32x4*)(src + (size_t)row1 * 1024 + i * 256 + lane * 4) : f32x4{0.f, 0.f, 0.f, 0.f};
    process(row, v0);
    if (has1) process(row1, v1);
  }
}

enum { E_PROJ0 = 0, E_BF16 = 1, E_RESID = 2, E_GLU = 3, E_SWIGLU = 4, E_XE = 5, E_S5Y = 6 };
struct EpiArgs { float* outf; u16* outb; const float* res; const float* gate; const u16* y5; const float* bias; u16* ux; int ldc; };

template <int EPI>
__device__ __forceinline__ void gemm_phase(const u16* __restrict__ A0, int nksA, size_t sA, const u16* __restrict__ B0, int nksB, size_t sB,
                                           int K, int nM, int nN, int nbatch, const EpiArgs ea, char* smem, int bid, int nblk) {
  const int tid = otid(), wid = tid >> 6, lane = tid & 63, wr = wid >> 1, wc = wid & 1, fr = lane & 15, fq = lane >> 4;
  char* SA = smem; char* SB = smem + 49152;
  const int sa0 = (int)(uintptr_t)SA + (wr * 128 + fr) * 64 + fq * 16, sb0 = (int)(uintptr_t)SB + (wc * 64 + fr) * 64 + fq * 16;
  const int NR = nbatch * nM, ntiles = NR * nN;
  const int STN = (nN & 7) == 0 ? 8 : ((nN & 3) == 0 ? 4 : 1), STM = 64 / STN, nSN = nN / STN;
  const bool swz = ((nblk & 7) == 0) && (NR % STM == 0);
  const int lpx = nblk >> 3;
  int si = bid & 7, l = bid >> 3, tl = bid;
#pragma unroll 1
  for (;;) {
    int R, pn;
    if (swz) {
      if (si >= (NR / STM) * nSN) break;
      R = (si / nSN) * STM + l / STN; pn = (si % nSN) * STN + l % STN;
      l += lpx; if (l >= 64) { l = bid >> 3; si += 8; }
    } else {
      if (tl >= ntiles) break;
      R = tl / nN; pn = tl % nN; tl += nblk;
    }
    const int g = R / nM, rt = R % nM, brow = rt << 8, bcol = pn << 7;
    const char* A = (const char*)(A0 + (size_t)g * sA) + ((size_t)rt * nksA << 14) + tid * 16;
    const char* Bt = (const char*)(B0 + (size_t)g * sB) + ((size_t)pn * nksB << 13) + tid * 16;
    int nk = K >> 5, klim = nk;
    if (EPI == E_S5Y) { klim = 4 * (pn + 1); nk = klim + 4; }
    f32x4 acc[8][4];
#pragma unroll
    for (int m = 0; m < 8; ++m)
#pragma unroll
      for (int n = 0; n < 4; ++n) acc[m][n] = f32x4{0.f, 0.f, 0.f, 0.f};
#define GSTAGE(KK, BUF) do { const int kt_ = (EPI == E_S5Y && (KK) >= klim) ? (16 + (KK) - klim) : (KK); \
      _Pragma("unroll") for (int i = 0; i < 4; ++i) \
        __builtin_amdgcn_global_load_lds((const unsigned*)(A + ((size_t)kt_ << 14) + i * 4096), (__attribute__((address_space(3))) unsigned*)(SA + (BUF) * 16384 + tid * 16 + i * 4096), 16, 0, 0); \
      _Pragma("unroll") for (int i = 0; i < 2; ++i) \
        __builtin_amdgcn_global_load_lds((const unsigned*)(Bt + ((size_t)kt_ << 13) + i * 4096), (__attribute__((address_space(3))) unsigned*)(SB + (BUF) * 8192 + tid * 16 + i * 4096), 16, 0, 0); } while (0)
    asm volatile("s_waitcnt vmcnt(0)" ::: "memory");
    GSTAGE(0, 0);
    if (nk > 1) { GSTAGE(1, 1); asm volatile("s_waitcnt vmcnt(6)\n\ts_barrier" ::: "memory"); }
    else { asm volatile("s_waitcnt vmcnt(0)\n\ts_barrier" ::: "memory"); }
    int buf = 0, nbuf = 2;
#pragma unroll 1
    for (int kk = 0; kk < nk; ++kk) {
      const bool more = kk + 2 < nk;
      if (more) GSTAGE(kk + 2, nbuf);
      bf16x8 Bl[4], At[8];
      {
        const int bb = sb0 + buf * 8192, ab = sa0 + buf * 16384;
        asm volatile(
            "ds_read_b128 %0, %12\n\tds_read_b128 %1, %12 offset:1024\n\tds_read_b128 %2, %12 offset:2048\n\tds_read_b128 %3, %12 offset:3072\n\t"
            "ds_read_b128 %4, %13\n\tds_read_b128 %5, %13 offset:1024\n\tds_read_b128 %6, %13 offset:2048\n\tds_read_b128 %7, %13 offset:3072\n\t"
            "ds_read_b128 %8, %13 offset:4096\n\tds_read_b128 %9, %13 offset:5120\n\tds_read_b128 %10, %13 offset:6144\n\tds_read_b128 %11, %13 offset:7168\n\t"
            "s_waitcnt lgkmcnt(0)"
            : "=&v"(Bl[0]), "=&v"(Bl[1]), "=&v"(Bl[2]), "=&v"(Bl[3]), "=&v"(At[0]), "=&v"(At[1]), "=&v"(At[2]), "=&v"(At[3]),
              "=&v"(At[4]), "=&v"(At[5]), "=&v"(At[6]), "=&v"(At[7])
            : "v"(bb), "v"(ab)
            : "memory");
      }
      __builtin_amdgcn_s_setprio(1);
#pragma unroll
      for (int m = 0; m < 8; ++m)
#pragma unroll
        for (int n = 0; n < 4; ++n) acc[m][n] = __builtin_amdgcn_mfma_f32_16x16x32_bf16(Bl[n], At[m], acc[m][n], 0, 0, 0);
      __builtin_amdgcn_s_setprio(0);
      if (more) asm volatile("s_waitcnt vmcnt(6)\n\ts_barrier" ::: "memory");
      else asm volatile("s_waitcnt vmcnt(0)\n\ts_barrier" ::: "memory");
      buf = (buf == 2) ? 0 : buf + 1; nbuf = (nbuf == 2) ? 0 : nbuf + 1;
    }
#undef GSTAGE
#pragma unroll
    for (int m = 0; m < 8; ++m)
#pragma unroll
      for (int n = 0; n < 4; ++n) {
        const int row = brow + wr * 128 + m * 16 + fr, col = bcol + wc * 64 + n * 16 + fq * 4;
        const f32x4 v = acc[m][n];
        if (EPI == E_PROJ0) {
          const uint2 pk = uint2{pk2(v[0], v[1]), pk2(v[2], v[3])};
          if (bcol < 2048) *(uint2*)(ea.outb + pj_idx(row, col)) = pk;
          else { const int cc = col - 2048; *(uint2*)(ea.ux + (size_t)(cc >> 4) * S5C * UXW + a_off(row >> 5, (row & 31) * 16 + (cc & 15), 20)) = pk; }
        }
        if (EPI == E_BF16) *(uint2*)(ea.outb + (size_t)row * ea.ldc + col) = uint2{pk2(v[0], v[1]), pk2(v[2], v[3])};
        if (EPI == E_RESID) {
          const size_t idx = (size_t)row * 1024 + col;
          const f32x4 r4 = *(const f32x4*)(ea.res + idx), g4 = *(const f32x4*)(ea.gate + (size_t)(row >> 13) * 6144 + col);
          *(f32x4*)(ea.outf + idx) = f32x4{r4[0] + g4[0] * v[0], r4[1] + g4[1] * v[1], r4[2] + g4[2] * v[2], r4[3] + g4[3] * v[3]};
        }
        if (EPI == E_GLU) {
          const uint2 yy = *(const uint2*)(ea.y5 + a_off(row, col, 16));
          const f32x4 b4 = *(const f32x4*)(ea.bias + col);
          const float y0 = __uint_as_float(yy.x << 16), y1 = __uint_as_float(yy.x & 0xffff0000u), y2 = __uint_as_float(yy.y << 16), y3 = __uint_as_float(yy.y & 0xffff0000u);
          *(uint2*)(ea.outb + a_off(row, 512 + col, 32)) = uint2{pk2(y0 * sigmoid_(v[0] + b4[0]), y1 * sigmoid_(v[1] + b4[1])), pk2(y2 * sigmoid_(v[2] + b4[2]), y3 * sigmoid_(v[3] + b4[3]))};
        }
        if (EPI == E_SWIGLU) {
          if ((n & 1) == 0) {
            const f32x4 u = acc[m][n | 1];
            const int co = (bcol >> 1) + wc * 32 + (n >> 1) * 16 + fq * 4;
            *(uint2*)(ea.outb + a_off(row, co, FF / 32)) = uint2{pk2(silu_(v[0]) * u[0], silu_(v[1]) * u[1]), pk2(silu_(v[2]) * u[2], silu_(v[3]) * u[3])};
          }
        }
        if (EPI == E_XE) *(f32x4*)(ea.outf + ((size_t)g * S5C + row) * 128 + col) = v;
        if (EPI == E_S5Y) {
          const uint2 uu = *(const uint2*)(ea.ux + (size_t)g * S5C * UXW + a_off(row, col, 20));
          const f32x4 d4 = *(const f32x4*)(ea.bias + g * 16 + (col & 15));
          const float u0 = __uint_as_float(uu.x << 16), u1 = __uint_as_float(uu.x & 0xffff0000u), u2 = __uint_as_float(uu.y << 16), u3 = __uint_as_float(uu.y & 0xffff0000u);
          *(uint2*)(ea.outb + a_off(row * 32 + (col >> 4), g * 16 + (col & 15), 16)) =
              uint2{pk2(gelu_tanh_(v[0] + d4[0] * u0), gelu_tanh_(v[1] + d4[1] * u1)), pk2(gelu_tanh_(v[2] + d4[2] * u2), gelu_tanh_(v[3] + d4[3] * u3))};
        }
      }
  }
}

__device__ __forceinline__ void s5_carry_phase(const Params& p, int bid, int nblk) {
  const float* xe = (const float*)(p.ws + OFF_XE); const float* a32 = (const float*)(p.ws + OFF_A32);
  u16* ux = (u16*)(p.ws + OFF_UX);
  for (int it = bid; it < 32; it += nblk) {
    const int idx = it * 256 + otid(), pp = idx & 63, g = (idx >> 6) & 31, b = idx >> 11;
    const float ar = a32[(g * 64 + pp) * 2], ai = a32[(g * 64 + pp) * 2 + 1];
    float xr = 0.f, xi = 0.f;
    const size_t cbase = (size_t)g * S5C + b * 256, gbase = (size_t)g * S5C * UXW;
    for (int n = 0; n < 256; n += 8) {
      float er[8], ei[8];
#pragma unroll
      for (int e = 0; e < 8; ++e) { er[e] = xe[(cbase + n + e) * 128 + pp]; ei[e] = xe[(cbase + n + e) * 128 + 64 + pp]; }
#pragma unroll
      for (int e = 0; e < 8; ++e) {
        ux[gbase + a_off(b * 256 + n + e, 512 + pp, 20)] = f2bf(xr); ux[gbase + a_off(b * 256 + n + e, 576 + pp, 20)] = f2bf(xi);
        const float nr = ar * xr - ai * xi + er[e], ni = ar * xi + ai * xr + ei[e];
        xr = nr; xi = ni;
      }
    }
  }
}

__device__ __forceinline__ int crow(int r, int hi) { return (r & 3) + 8 * (r >> 2) + 4 * hi; }
using f32x16 = __attribute__((ext_vector_type(16))) float;
__device__ __forceinline__ void unpack8(const u32x4 w, float* f) {
#pragma unroll
  for (int e = 0; e < 4; ++e) { f[2 * e] = __uint_as_float(w[e] << 16); f[2 * e + 1] = __uint_as_float(w[e] & 0xffff0000u); }
}
__device__ __forceinline__ void gdn_prep_phase(const Params& p, char* smem, int bid, int nblk) {
  const int tid = otid(), wid = tid >> 6, lane = tid & 63, fr = lane & 15, fq = lane >> 4;
  u16* qs = (u16*)smem;
  u16* ks = qs + 64 * 136;
  float* Lm = (float*)(ks + 64 * 136);
  float* gcs = Lm + 4096; float* bts = gcs + 64; float* egs = bts + 64;
  const u16* proj = (const u16*)(p.ws + OFF_PROJ);
  const float* beta = (const float*)(p.ws + OFF_BETA); const float* gg = (const float*)(p.ws + OFF_G);
#pragma unroll 1
  for (int it = bid; it < 2048; it += nblk) {
    const int n = it & 127, bh = it >> 7, b = bh >> 2, h = bh & 3;
    const size_t row0 = (size_t)b * SEQ + n * 64;
    if (wid == 0) {
      float c = gg[(row0 + lane) * 4 + h];
#pragma unroll
      for (int o = 1; o < 64; o <<= 1) { const float tt = __shfl_up(c, o); if (lane >= o) c += tt; }
      gcs[lane] = c; egs[lane] = __expf(c); bts[lane] = beta[(row0 + lane) * 4 + h];
    }
    {
      const int tok = tid >> 2, part = tid & 3, l = n * 64 + tok;
      float qo[32], ko[32]; float sq = 0.f, sk = 0.f;
#pragma unroll
      for (int cb = 0; cb < 4; ++cb) {
        const int colq = h * 128 + part * 32 + cb * 8, colk = 512 + colq;
        const size_t kblk = (size_t)M * 512 - 512;
        float aq[8], ak[8];
#pragma unroll
        for (int e = 0; e < 8; ++e) { aq[e] = 0.f; ak[e] = 0.f; }
#pragma unroll
        for (int j = 0; j < 4; ++j) {
          const int lt = l - 3 + j;
          if (lt >= 0) {
            const u16* rp = proj + ((size_t)b * SEQ + lt) * 512;
            float xq[8], xk[8];
            unpack8(*(const u32x4*)(rp + colq), xq); unpack8(*(const u32x4*)(rp + kblk + colk), xk);
            const f32x4 wq0 = *(const f32x4*)(p.hy_conv_w + j * 1536 + colq), wq1 = *(const f32x4*)(p.hy_conv_w + j * 1536 + colq + 4);
            const f32x4 wk0 = *(const f32x4*)(p.hy_conv_w + j * 1536 + colk), wk1 = *(const f32x4*)(p.hy_conv_w + j * 1536 + colk + 4);
#pragma unroll
            for (int e = 0; e < 4; ++e) { aq[e] += wq0[e] * xq[e]; aq[4 + e] += wq1[e] * xq[4 + e]; ak[e] += wk0[e] * xk[e]; ak[4 + e] += wk1[e] * xk[4 + e]; }
          }
        }
#pragma unroll
        for (int e = 0; e < 8; ++e) { const float a = silu_(aq[e]), k = silu_(ak[e]); qo[cb * 8 + e] = a; ko[cb * 8 + e] = k; sq += a * a; sk += k * k; }
      }
      sq += __shfl_xor(sq, 1); sq += __shfl_xor(sq, 2); sk += __shfl_xor(sk, 1); sk += __shfl_xor(sk, 2);
      const float rq = rsqrtf(sq + 1e-6f) * 0.08838834764831845f, rk = rsqrtf(sk + 1e-6f);
#pragma unroll
      for (int cb = 0; cb < 4; ++cb) {
        u32x4 wq, wk;
#pragma unroll
        for (int e = 0; e < 4; ++e) { wq[e] = pk2(qo[cb * 8 + 2 * e] * rq, qo[cb * 8 + 2 * e + 1] * rq); wk[e] = pk2(ko[cb * 8 + 2 * e] * rk, ko[cb * 8 + 2 * e + 1] * rk); }
        *(u32x4*)(qs + tok * 136 + part * 32 + cb * 8) = wq; *(u32x4*)(ks + tok * 136 + part * 32 + cb * 8) = wk;
      }
    }
    __syncthreads();
    {
      f32x4 akk[4], aqk[4];
#pragma unroll
      for (int nb = 0; nb < 4; ++nb) { akk[nb] = f32x4{0.f, 0.f, 0.f, 0.f}; aqk[nb] = f32x4{0.f, 0.f, 0.f, 0.f}; }
#pragma unroll
      for (int kk = 0; kk < 4; ++kk) {
        const bf16x8 ak = *(const bf16x8*)(ks + (16 * wid + fr) * 136 + kk * 32 + fq * 8);
        const bf16x8 aq = *(const bf16x8*)(qs + (16 * wid + fr) * 136 + kk * 32 + fq * 8);
#pragma unroll
        for (int nb = 0; nb < 4; ++nb) {
          const bf16x8 bk = *(const bf16x8*)(ks + (16 * nb + fr) * 136 + kk * 32 + fq * 8);
          akk[nb] = __builtin_amdgcn_mfma_f32_16x16x32_bf16(ak, bk, akk[nb], 0, 0, 0);
          aqk[nb] = __builtin_amdgcn_mfma_f32_16x16x32_bf16(aq, bk, aqk[nb], 0, 0, 0);
        }
      }
      u16* att = (u16*)(p.ws + OFF_GAT) + (size_t)it * 4096;
#pragma unroll
      for (int nb = 0; nb < 4; ++nb)
#pragma unroll
        for (int r = 0; r < 4; ++r) {
          const int i = 16 * wid + fq * 4 + r, j = 16 * nb + fr;
          const float dec = __expf(fminf(gcs[i] - gcs[j], 0.f));
          Lm[i * 64 + j] = (i > j) ? bts[i] * akk[nb][r] * dec : 0.f;
          att[i * 64 + j] = f2bf((i >= j) ? aqk[nb][r] * dec : 0.f);
        }
    }
    __syncthreads();
    {
      float x[64];
      if (tid < 128) {
        const int col = 1024 + h * 128 + tid;
        const u16* vp = proj + (size_t)2 * M * 512 + h * 128 + tid;
        const float w0 = p.hy_conv_w[col], w1 = p.hy_conv_w[1536 + col], w2 = p.hy_conv_w[2 * 1536 + col], w3 = p.hy_conv_w[3 * 1536 + col];
        float x1 = 0.f, x2 = 0.f, x3 = 0.f;
        if (n > 0) { x3 = bf2f(vp[(row0 - 3) * 512]); x2 = bf2f(vp[(row0 - 2) * 512]); x1 = bf2f(vp[(row0 - 1) * 512]); }
#pragma unroll
        for (int i = 0; i < 64; ++i) {
          const float xv = bf2f(vp[(row0 + i) * 512]);
          x[i] = silu_(w0 * x3 + w1 * x2 + w2 * x1 + w3 * xv) * bts[i];
          x3 = x2; x2 = x1; x1 = xv;
        }
      } else {
#pragma unroll
        for (int i = 0; i < 64; ++i) x[i] = bf2f(ks[i * 136 + tid - 128]) * bts[i] * egs[i];
      }
#pragma unroll
      for (int i = 1; i < 64; ++i) {
        float acc = x[i];
#pragma unroll
        for (int j4 = 0; j4 < (i + 3) / 4; ++j4) {
          const f32x4 l4 = *(const f32x4*)(Lm + i * 64 + j4 * 4);
#pragma unroll
          for (int e = 0; e < 4; ++e) if (j4 * 4 + e < i) acc -= l4[e] * x[j4 * 4 + e];
        }
        x[i] = acc;
      }
      if (tid < 128) {
        u16* ut = (u16*)(p.ws + OFF_GUT) + (size_t)it * 8192 + tid * 64;
#pragma unroll
        for (int c8 = 0; c8 < 8; ++c8) {
          u32x4 w;
#pragma unroll
          for (int e = 0; e < 4; ++e) w[e] = pk2(x[c8 * 8 + 2 * e], x[c8 * 8 + 2 * e + 1]);
          *(u32x4*)(ut + c8 * 8) = w;
        }
      } else {
        u16* wg = (u16*)(p.ws + OFF_GW) + (size_t)it * 8192 + (tid - 128);
#pragma unroll
        for (int i = 0; i < 64; ++i) wg[i * 128] = f2bf(x[i]);
      }
    }
    {
      u16* qd = (u16*)(p.ws + OFF_GQD) + (size_t)it * 8192;
#pragma unroll
      for (int k = 0; k < 4; ++k) {
        const int piece = tid + 256 * k, i = piece >> 4, d0 = (piece & 15) * 8;
        float f[8]; unpack8(*(const u32x4*)(qs + i * 136 + d0), f);
        const float e = egs[i];
        u32x4 w;
#pragma unroll
        for (int e2 = 0; e2 < 4; ++e2) w[e2] = pk2(f[2 * e2] * e, f[2 * e2 + 1] * e);
        *(u32x4*)(qd + i * 128 + d0) = w;
      }
      u16* kt = (u16*)(p.ws + OFF_GKT) + (size_t)it * 8192;
      const int dk = tid & 127, half = tid >> 7;
      const float gl = gcs[63];
#pragma unroll
      for (int c8 = 0; c8 < 4; ++c8) {
        u32x4 w;
#pragma unroll
        for (int e = 0; e < 4; ++e) {
          const int i0 = half * 32 + c8 * 8 + 2 * e;
          w[e] = pk2(bf2f(ks[i0 * 136 + dk]) * __expf(gl - gcs[i0]), bf2f(ks[(i0 + 1) * 136 + dk]) * __expf(gl - gcs[i0 + 1]));
        }
        *(u32x4*)(kt + dk * 64 + half * 32 + c8 * 8) = w;
      }
      if (tid == 0) ((float*)(p.ws + OFF_GSD))[it] = egs[63];
    }
    __syncthreads();
  }
}

__device__ __forceinline__ uint2 lds64(const char* p) { return *(const uint2*)p; }
__device__ __forceinline__ bf16x8 mk8(uint2 a, uint2 b) { u32x4 w = {a.x, a.y, b.x, b.y}; return __builtin_bit_cast(bf16x8, w); }
__device__ __forceinline__ bf16x8 pack8(const f32x16& x, int s) {
  u32x4 w = {pk2(x[8 * s], x[8 * s + 1]), pk2(x[8 * s + 2], x[8 * s + 3]), pk2(x[8 * s + 4], x[8 * s + 5]), pk2(x[8 * s + 6], x[8 * s + 7])};
  return __builtin_bit_cast(bf16x8, w);
}
__device__ __forceinline__ void gdn_scan_item(const Params& p, int bh, char* smem) {
  const int tid = otid(), wid = tid >> 6, lane = tid & 63, r32 = lane & 31, hi = lane >> 5;
  char* Wl = smem; char* KTl = smem + 16896;
  const char* gw = p.ws + OFF_GW; const char* gkt = p.ws + OFF_GKT;
  const u16* gut = (const u16*)(p.ws + OFF_GUT);
  const float* gsd = (const float*)(p.ws + OFF_GSD);
  u32x4* sbg = (u32x4*)(p.ws + OFF_PROJ); u32x4* vbg = (u32x4*)(p.ws + OFF_PROJ + (size_t)2048 * 32768);
  f32x16 S[4];
#pragma unroll
  for (int T = 0; T < 4; ++T)
#pragma unroll
    for (int r = 0; r < 16; ++r) S[T][r] = 0.f;
  u32x4 sa[8], sb_[8]; uint2 uc[8];
  const int dv = wid * 32 + r32;
#define G_LOAD(ST, IT) do { const size_t o16 = (size_t)(IT) * 16384; \
    _Pragma("unroll") for (int k = 0; k < 4; ++k) { ST[k] = *(const u32x4*)(gw + o16 + (tid + 256 * k) * 16); ST[4 + k] = *(const u32x4*)(gkt + o16 + (tid + 256 * k) * 16); } } while (0)
#define U_LOAD(IT) do { _Pragma("unroll") for (int k = 0; k < 8; ++k) uc[k] = *(const uint2*)(gut + (size_t)(IT) * 8192 + dv * 64 + 32 * (k >> 2) + 8 * (k & 3) + 4 * hi); } while (0)
#define G_WRITE(ST) do { \
    _Pragma("unroll") for (int k = 0; k < 4; ++k) { const int pc = tid + 256 * k; \
      { char* d = Wl + (pc >> 4) * 264 + (pc & 15) * 16; *(uint2*)d = uint2{ST[k][0], ST[k][1]}; *(uint2*)(d + 8) = uint2{ST[k][2], ST[k][3]}; } \
      { char* d = KTl + (pc >> 3) * 136 + (pc & 7) * 16; *(uint2*)d = uint2{ST[4 + k][0], ST[4 + k][1]}; *(uint2*)(d + 8) = uint2{ST[4 + k][2], ST[4 + k][3]}; } } } while (0)
#define SCAN_STEP(N, NXT, FAR) do { const int n = (N); const int item = bh * 128 + n; \
    const float sd_nxt = gsd[item + (n + 1 < 128 ? 1 : 0)]; \
    if (n + 2 < 128) G_LOAD(FAR, item + 2); \
    f32x16 av[2]; \
    _Pragma("unroll") for (int r = 0; r < 16; ++r) { av[0][r] = 0.f; av[1][r] = 0.f; } \
    _Pragma("unroll") for (int T = 0; T < 4; ++T) \
      _Pragma("unroll") for (int s = 0; s < 2; ++s) { \
        const bf16x8 sb = pack8(S[T], s); \
        sbg[((size_t)(item * 4 + wid) * 8 + T * 2 + s) * 64 + lane] = __builtin_bit_cast(u32x4, sb); \
        const int cb = (32 * T + 16 * s + 4 * hi) * 2; \
        _Pragma("unroll") for (int it = 0; it < 2; ++it) { \
          const char* wp = Wl + (32 * it + r32) * 264 + cb; \
          av[it] = __builtin_amdgcn_mfma_f32_32x32x16_bf16(mk8(lds64(wp), lds64(wp + 16)), sb, av[it], 0, 0, 0); } } \
    bf16x8 vb[2][2]; \
    _Pragma("unroll") for (int it = 0; it < 2; ++it) { \
      f32x16 vn; \
      _Pragma("unroll") for (int g = 0; g < 4; ++g) { const uint2 u2 = uc[it * 4 + g]; \
        vn[4 * g] = __uint_as_float(u2.x << 16) - av[it][4 * g]; vn[4 * g + 1] = __uint_as_float(u2.x & 0xffff0000u) - av[it][4 * g + 1]; \
        vn[4 * g + 2] = __uint_as_float(u2.y << 16) - av[it][4 * g + 2]; vn[4 * g + 3] = __uint_as_float(u2.y & 0xffff0000u) - av[it][4 * g + 3]; } \
      vb[it][0] = pack8(vn, 0); vb[it][1] = pack8(vn, 1); \
      vbg[((size_t)(item * 4 + wid) * 4 + it * 2) * 64 + lane] = __builtin_bit_cast(u32x4, vb[it][0]); \
      vbg[((size_t)(item * 4 + wid) * 4 + it * 2 + 1) * 64 + lane] = __builtin_bit_cast(u32x4, vb[it][1]); } \
    if (n + 1 < 128) U_LOAD(item + 1); \
    _Pragma("unroll") for (int T = 0; T < 4; ++T) { \
      _Pragma("unroll") for (int r = 0; r < 16; ++r) S[T][r] *= sd_cur; \
      _Pragma("unroll") for (int it = 0; it < 2; ++it) \
        _Pragma("unroll") for (int s = 0; s < 2; ++s) { \
          const char* kp = KTl + (32 * T + r32) * 136 + (32 * it + 16 * s + 4 * hi) * 2; \
          S[T] = __builtin_amdgcn_mfma_f32_32x32x16_bf16(mk8(lds64(kp), lds64(kp + 16)), vb[it][s], S[T], 0, 0, 0); } } \
    sd_cur = sd_nxt; \
    __syncthreads(); \
    if (n + 1 < 128) G_WRITE(NXT); \
    __syncthreads(); } while (0)
  float sd_cur = gsd[bh * 128];
  G_LOAD(sa, bh * 128); U_LOAD(bh * 128); G_WRITE(sa);
  G_LOAD(sb_, bh * 128 + 1);
  __syncthreads();
#pragma unroll 1
  for (int n2 = 0; n2 < 128; n2 += 2) {
    SCAN_STEP(n2, sb_, sa);
    SCAN_STEP(n2 + 1, sa, sb_);
  }
#undef SCAN_STEP
#undef G_LOAD
#undef G_WRITE
#undef U_LOAD
}

__device__ __forceinline__ void gdn_out_phase(const Params& p, char* smem, int bid, int nblk) {
  const int tid = otid(), wid = tid >> 6, lane = tid & 63, r32 = lane & 31, hi = lane >> 5;
  char* QDl = smem; char* ATl = smem + 16896; float* Ol = (float*)(smem + 16896 + 8704);
  const char* gqd = p.ws + OFF_GQD; const char* gat = p.ws + OFF_GAT;
  const u32x4* sbg = (const u32x4*)(p.ws + OFF_PROJ); const u32x4* vbg = (const u32x4*)(p.ws + OFF_PROJ + (size_t)2048 * 32768);
  const u16* zb = (const u16*)(p.ws + OFF_PROJ) + (size_t)3 * M * 512;
  u16* concat = (u16*)(p.ws + OFF_HN);
#pragma unroll 1
  for (int item = bid; item < 2048; item += nblk) {
    const int n = item & 127, bh = item >> 7, b = bh >> 2, h = bh & 3;
    {
      u32x4 st[6];
#pragma unroll
      for (int k = 0; k < 4; ++k) st[k] = *(const u32x4*)(gqd + (size_t)item * 16384 + (tid + 256 * k) * 16);
#pragma unroll
      for (int k = 0; k < 2; ++k) st[4 + k] = *(const u32x4*)(gat + (size_t)item * 8192 + (tid + 256 * k) * 16);
#pragma unroll
      for (int k = 0; k < 4; ++k) { const int pc = tid + 256 * k; char* d = QDl + (pc >> 4) * 264 + (pc & 15) * 16;
        *(uint2*)d = uint2{st[k][0], st[k][1]}; *(uint2*)(d + 8) = uint2{st[k][2], st[k][3]}; }
#pragma unroll
      for (int k = 0; k < 2; ++k) { const int pc = tid + 256 * k; char* d = ATl + (pc >> 3) * 136 + (pc & 7) * 16;
        *(uint2*)d = uint2{st[4 + k][0], st[4 + k][1]}; *(uint2*)(d + 8) = uint2{st[4 + k][2], st[4 + k][3]}; }
    }
    bf16x8 sb[8], vb[4];
#pragma unroll
    for (int f = 0; f < 8; ++f) sb[f] = __builtin_bit_cast(bf16x8, sbg[((size_t)(item * 4 + wid) * 8 + f) * 64 + lane]);
#pragma unroll
    for (int f = 0; f < 4; ++f) vb[f] = __builtin_bit_cast(bf16x8, vbg[((size_t)(item * 4 + wid) * 4 + f) * 64 + lane]);
    __syncthreads();
    f32x16 ao[2];
#pragma unroll
    for (int r = 0; r < 16; ++r) { ao[0][r] = 0.f; ao[1][r] = 0.f; }
#pragma unroll
    for (int T = 0; T < 4; ++T)
#pragma unroll
      for (int s = 0; s < 2; ++s) {
        const int cb = (32 * T + 16 * s + 4 * hi) * 2;
#pragma unroll
        for (int it = 0; it < 2; ++it) {
          const char* qp = QDl + (32 * it + r32) * 264 + cb;
          ao[it] = __builtin_amdgcn_mfma_f32_32x32x16_bf16(mk8(lds64(qp), lds64(qp + 16)), sb[T * 2 + s], ao[it], 0, 0, 0);
        }
      }
#pragma unroll
    for (int it2 = 0; it2 < 2; ++it2)
#pragma unroll
      for (int it = 0; it <= it2; ++it)
#pragma unroll
        for (int s = 0; s < 2; ++s) {
          const char* ap = ATl + (32 * it2 + r32) * 136 + (32 * it + 16 * s + 4 * hi) * 2;
          ao[it2] = __builtin_amdgcn_mfma_f32_32x32x16_bf16(mk8(lds64(ap), lds64(ap + 16)), vb[it * 2 + s], ao[it2], 0, 0, 0);
        }
#pragma unroll
    for (int it = 0; it < 2; ++it)
#pragma unroll
      for (int r = 0; r < 16; ++r) Ol[(32 * it + crow(r, hi)) * 132 + wid * 32 + r32] = ao[it][r];
    __syncthreads();
    {
      const int tok = tid >> 2, part = tid & 3;
      const int row = b * SEQ + n * 64 + tok;
      f32x4 a[8]; float ss = 0.f;
#pragma unroll
      for (int k = 0; k < 8; ++k) { a[k] = *(const f32x4*)(Ol + tok * 132 + part * 32 + k * 4); ss += a[k][0] * a[k][0] + a[k][1] * a[k][1] + a[k][2] * a[k][2] + a[k][3] * a[k][3]; }
      ss += __shfl_xor(ss, 1); ss += __shfl_xor(ss, 2);
      const float rs = rsqrtf(ss * (1.f / 128.f) + 1e-6f);
      const u16* zp = zb + (size_t)row * 512 + h * 128 + part * 32;
      const float* hw = p.hy_head_norm_w + part * 32;
      u16* cp = concat + a_off(row, h * 128 + part * 32, 32);
#pragma unroll
      for (int k = 0; k < 4; ++k) {
        float zf[8]; unpack8(*(const u32x4*)(zp + k * 8), zf);
        const f32x4 h0 = *(const f32x4*)(hw + k * 8), h1 = *(const f32x4*)(hw + k * 8 + 4);
        const f32x4 x0 = a[2 * k], x1 = a[2 * k + 1];
        u32x4 w;
        w[0] = pk2(x0[0] * rs * h0[0] * silu_(zf[0]), x0[1] * rs * h0[1] * silu_(zf[1]));
        w[1] = pk2(x0[2] * rs * h0[2] * silu_(zf[2]), x0[3] * rs * h0[3] * silu_(zf[3]));
        w[2] = pk2(x1[0] * rs * h1[0] * silu_(zf[4]), x1[1] * rs * h1[1] * silu_(zf[5]));
        w[3] = pk2(x1[2] * rs * h1[2] * silu_(zf[6]), x1[3] * rs * h1[3] * silu_(zf[7]));
        *(u32x4*)(cp + k * 8) = w;
      }
    }
    __syncthreads();
  }
}

using s16x4 = __attribute__((ext_vector_type(4))) short;
#define KSWZ(row, colB) ((row) * 256 + ((colB) ^ (((row) & 7) << 4)))
#define SBAR() __builtin_amdgcn_sched_barrier(0)
__device__ __forceinline__ unsigned cvtpk(float lo, float hi) { unsigned r; asm volatile("v_cvt_pk_bf16_f32 %0, %1, %2" : "=v"(r) : "v"(lo), "v"(hi)); return r; }
__device__ __forceinline__ int v_st(int k, int c) { const int kk = (k & ~0xC) | ((k & 4) << 1) | ((k & 8) >> 1); return ((kk >> 3) * 4 + (c >> 5)) * 512 + ((kk & 7) * 32 + (c & 31)) * 2; }
__device__ __forceinline__ int v_rd_base(int lane) { return ((lane & 3) << 3) | (((lane >> 2) & 3) << 6) | (((lane >> 4) & 1) << 5) | (((lane >> 5) & 1) << 8); }
constexpr int v_rd_off(int d0, int ks, int half) { return d0 * 512 + ks * 4096 + half * 2048; }
template <int OFF> __device__ __forceinline__ s16x4 tr_read(int vb) {
  s16x4 r; asm volatile("ds_read_b64_tr_b16 %0, %1 offset:%2" : "=&v"(r) : "v"(vb), "i"(OFF) : "memory"); return r;
}
template <int D0> __device__ __forceinline__ void pv_one(f32x16& od, int vb, bf16x8 pa0, bf16x8 pa1, bf16x8 pa2, bf16x8 pa3) {
  const s16x4 l0 = tr_read<v_rd_off(D0, 0, 0)>(vb), h0 = tr_read<v_rd_off(D0, 0, 1)>(vb), l1 = tr_read<v_rd_off(D0, 1, 0)>(vb), h1 = tr_read<v_rd_off(D0, 1, 1)>(vb);
  const s16x4 l2 = tr_read<v_rd_off(D0, 2, 0)>(vb), h2 = tr_read<v_rd_off(D0, 2, 1)>(vb), l3 = tr_read<v_rd_off(D0, 3, 0)>(vb), h3 = tr_read<v_rd_off(D0, 3, 1)>(vb);
  asm volatile("s_waitcnt lgkmcnt(0)" ::: "memory"); SBAR();
#define PK(L, H) (bf16x8){L[0], L[1], L[2], L[3], H[0], H[1], H[2], H[3]}
  od = __builtin_amdgcn_mfma_f32_32x32x16_bf16(pa0, PK(l0, h0), od, 0, 0, 0);
  od = __builtin_amdgcn_mfma_f32_32x32x16_bf16(pa1, PK(l1, h1), od, 0, 0, 0);
  od = __builtin_amdgcn_mfma_f32_32x32x16_bf16(pa2, PK(l2, h2), od, 0, 0, 0);
  od = __builtin_amdgcn_mfma_f32_32x32x16_bf16(pa3, PK(l3, h3), od, 0, 0, 0);
#undef PK
}
__device__ __forceinline__ float pl32_other(float a, float b, int hi) {
  auto rr = __builtin_amdgcn_permlane32_swap(__float_as_uint(a), __float_as_uint(b), false, false);
  return __uint_as_float(hi ? rr[0] : rr[1]);
}
__device__ __forceinline__ void sb_half(f32x16& pz, float& run, bool need_mask, int kb, int t, int hi) {
  constexpr float C2 = 0.08838834764831845f * 1.4426950408889634f;
  f32x16 l;
#pragma unroll
  for (int r = 0; r < 16; ++r) {
    const float e = __builtin_amdgcn_exp2f(fminf(pz[r] * C2, 60.f));
    l[r] = __builtin_amdgcn_rcpf(1.f + e);
    pz[r] = e;
  }
  if (need_mask) {
#pragma unroll
    for (int r = 0; r < 16; ++r) { if (kb + crow(r, hi) >= t) { l[r] = 1.f; pz[r] = 0.f; } }
  }
#pragma unroll
  for (int g = 0; g < 4; ++g) { l[4 * g + 2] *= l[4 * g + 3]; l[4 * g + 1] *= l[4 * g + 2]; l[4 * g] *= l[4 * g + 1]; }
  const float cs3 = l[12], cs2 = l[8] * cs3, cs1 = l[4] * cs2, cs0 = l[0] * cs1;
  const float off0 = cs1 * pl32_other(cs0, cs1, hi) * run;
  const float off1 = cs2 * pl32_other(cs1, cs2, hi) * run;
  const float off2 = cs3 * pl32_other(cs2, cs3, hi) * run;
  const float off3 = pl32_other(cs3, 1.f, hi) * run;
  float tot;
  { auto rr = __builtin_amdgcn_permlane32_swap(__float_as_uint(cs0), __float_as_uint(cs0), false, false); tot = __uint_as_float(rr[0]) * __uint_as_float(rr[1]); }
#pragma unroll
  for (int r = 0; r < 4; ++r) {
    pz[r] = pz[r] * l[r] * off0; pz[4 + r] = pz[4 + r] * l[4 + r] * off1;
    pz[8 + r] = pz[8 + r] * l[8 + r] * off2; pz[12 + r] = pz[12 + r] * l[12 + r] * off3;
  }
  run *= tot;
}

__device__ __forceinline__ void attn_phase(const Params& p, char* smem, int bid, int nblk) {
  const int tid = otid(), wid = tid >> 6, lane = tid & 63, r32 = lane & 31, hi = lane >> 5;
  char* K_lds = smem; char* V_lds = smem + 16384;
  const u16* qkv = (const u16*)(p.ws + OFF_PROJ);
  u16* ao = (u16*)(p.ws + OFF_HN);
  const int sr = tid >> 4, sc = (tid & 15) * 8;
  const int vb0 = (int)(uintptr_t)V_lds + v_rd_base(lane);
  for (int k = 0; k * nblk < 2048; ++k) {
    const int i = (k & 1) ? ((k + 1) * nblk - 1 - bid) : (k * nblk + bid);
    if (i >= 2048) continue;
    const int j = 63 - (i >> 5), bh = i & 31, b = bh >> 3, h = bh & 7;
    const int i0 = j * 128;
    const size_t rowb = (size_t)b * SEQ;
    const int t = i0 + wid * 32 + r32, tmin = i0 + wid * 32, tmax = tmin + 31;
    bf16x8 qr[8];
    {
      const u16* qp = qkv + (rowb + t) * 3072 + h * 128 + hi * 8;
#pragma unroll
      for (int d0 = 0; d0 < 8; ++d0) qr[d0] = *(const bf16x8*)(qp + d0 * 16);
    }
    f32x16 o[4];
#pragma unroll
    for (int d = 0; d < 4; ++d)
#pragma unroll
      for (int r = 0; r < 16; ++r) o[d][r] = 0.f;
    float run = 1.f;
    const u16* kbase = qkv + rowb * 3072 + 1024 + h * 128 + sc;
    u32x4 stk[4], stv[4];
#define SLOAD(KT) do { _Pragma("unroll") for (int ii = 0; ii < 4; ++ii) { const u16* kp = kbase + (size_t)((KT) * 64 + sr + 16 * ii) * 3072; \
      stk[ii] = *(const u32x4*)kp; stv[ii] = *(const u32x4*)(kp + 1024); } } while (0)
#define SWRITE() do { _Pragma("unroll") for (int ii = 0; ii < 4; ++ii) { const int row = sr + 16 * ii; \
      *(u32x4*)(K_lds + KSWZ(row, sc * 2)) = stk[ii]; *(u32x4*)(V_lds + v_st(row, sc)) = stv[ii]; } } while (0)
    const int NT = 2 * j + 2;
    SLOAD(NT - 1); SWRITE(); __syncthreads();
    for (int kt = NT - 1; kt >= 0; --kt) {
      const int k0 = kt * 64;
      if (kt > 0) SLOAD(kt - 1);
      if (k0 <= tmax) {
        bf16x8 pa0, pa1, pa2, pa3;
#define PK4(P, BASE, OUT) do { unsigned a0 = cvtpk(P[BASE + 0], P[BASE + 1]), a1 = cvtpk(P[BASE + 2], P[BASE + 3]); \
    unsigned b0_ = cvtpk(P[BASE + 4], P[BASE + 5]), b1_ = cvtpk(P[BASE + 6], P[BASE + 7]); \
    auto r0 = __builtin_amdgcn_permlane32_swap(a0, b0_, false, false); auto r1 = __builtin_amdgcn_permlane32_swap(a1, b1_, false, false); \
    u32x4 w = {r0[0], r1[0], r0[1], r1[1]}; OUT = *reinterpret_cast<bf16x8*>(&w); } while (0)
        if (k0 + 32 <= tmax) {
          f32x16 pz;
#pragma unroll
          for (int r = 0; r < 16; ++r) pz[r] = 0.f;
#pragma unroll
          for (int d0 = 0; d0 < 8; ++d0) {
            const bf16x8 kf = *(const bf16x8*)(K_lds + KSWZ(32 + r32, (d0 * 16 + hi * 8) * 2));
            pz = __builtin_amdgcn_mfma_f32_32x32x16_bf16(kf, qr[d0], pz, 0, 0, 0);
          }
          sb_half(pz, run, k0 + 63 >= tmin, k0 + 32, t, hi);
          PK4(pz, 0, pa2); PK4(pz, 8, pa3);
        } else {
          pa2 = bf16x8{0, 0, 0, 0, 0, 0, 0, 0}; pa3 = pa2;
        }
        {
          f32x16 pz;
#pragma unroll
          for (int r = 0; r < 16; ++r) pz[r] = 0.f;
#pragma unroll
          for (int d0 = 0; d0 < 8; ++d0) {
            const bf16x8 kf = *(const bf16x8*)(K_lds + KSWZ(r32, (d0 * 16 + hi * 8) * 2));
            pz = __builtin_amdgcn_mfma_f32_32x32x16_bf16(kf, qr[d0], pz, 0, 0, 0);
          }
          sb_half(pz, run, k0 + 31 >= tmin, k0, t, hi);
          PK4(pz, 0, pa0); PK4(pz, 8, pa1);
        }
#undef PK4
        pv_one<0>(o[0], vb0, pa0, pa1, pa2, pa3); pv_one<1>(o[1], vb0, pa0, pa1, pa2, pa3);
        pv_one<2>(o[2], vb0, pa0, pa1, pa2, pa3); pv_one<3>(o[3], vb0, pa0, pa1, pa2, pa3);
      }
      __syncthreads();
      if (kt > 0) SWRITE();
      __syncthreads();
    }
#undef SLOAD
#undef SWRITE
    {
      const int orow0 = (int)rowb + i0 + wid * 32;
#pragma unroll
      for (int r = 0; r < 16; ++r) {
        const int orow = crow(r, hi);
#pragma unroll
        for (int d0 = 0; d0 < 4; ++d0) ao[a_off(orow0 + orow, h * 128 + d0 * 32 + r32, 32)] = f2bf(o[d0][r]);
      }
    }
  }
}

#define XB_TMO      128
#define XB_XCNT(j)  (256  + 64 * (j))
#define XB_XSUB(j)  (1280 + 64 * (j))
#define XB_XGEN(j)  (2304 + 64 * (j))
#define XB_TOP      3328
#define XB_TOPGEN   3392
#define XCD_BAR_WORDS 3456
#define XB_SPIN_CAP (1u << 23)
#define LAS __attribute__((address_space(3)))
__device__ __forceinline__ unsigned xb_ld(unsigned* p)              { return __hip_atomic_load(p, __ATOMIC_RELAXED, __HIP_MEMORY_SCOPE_AGENT); }
__device__ __forceinline__ unsigned xb_add(unsigned* p, unsigned v) { return __hip_atomic_fetch_add(p, v, __ATOMIC_RELAXED, __HIP_MEMORY_SCOPE_AGENT); }
__device__ __forceinline__ unsigned xb_xcc_id() { return (unsigned)__builtin_amdgcn_s_getreg((3 << 11) | 20) & 0xFu; }
#define XB_SPIN(cond, bar) do { unsigned _sp = 0; while (cond) { __builtin_amdgcn_s_sleep(1); \
    if ((++_sp & 255u) == 0u) { if (xb_ld(&(bar)[XB_TMO])) break; if (_sp > XB_SPIN_CAP) { atomicAdd(&(bar)[XB_TMO], 1u); break; } } } } while (0)
struct XcdBarrier { unsigned* bar; unsigned x; volatile LAS unsigned* st; };
__device__ __forceinline__ XcdBarrier xcd_barrier_post(unsigned* bar, volatile LAS unsigned* st) {
  XcdBarrier b; b.bar = bar; b.x = xb_xcc_id(); b.st = st;
  if (__builtin_amdgcn_workitem_id_x() == 0) (void)xb_add(&bar[XB_XCNT(b.x)], 1u);
  return b;
}
__device__ __forceinline__ void xcd_barrier_complete(unsigned* bar, unsigned x, unsigned& nloc, unsigned& nx) {
  const unsigned G = gridDim.x * gridDim.y * gridDim.z;
  unsigned sum, cnt, mine, sp = 0u;
  for (;;) {
    sum = 0u; cnt = 0u; mine = 0u;
#pragma unroll
    for (unsigned j = 0; j < 16; ++j) { const unsigned c = xb_ld(&bar[XB_XCNT(j)]); sum += c; cnt += (c > 0u) ? 1u : 0u; mine = (j == x) ? c : mine; }
    if (sum == G) break;
    __builtin_amdgcn_s_sleep(1);
    if ((++sp & 255u) == 0u) { if (xb_ld(&bar[XB_TMO])) break; if (sp > XB_SPIN_CAP) { atomicAdd(&bar[XB_TMO], 1u); break; } }
  }
  nloc = mine > 0u ? mine : 1u; nx = cnt > 0u ? cnt : 1u;
}
__device__ __forceinline__ void xcd_barrier(const XcdBarrier& b) {
  asm volatile("s_waitcnt vmcnt(0)" ::: "memory");
  __syncthreads();
  if (__builtin_amdgcn_workitem_id_x() == 0) {
    unsigned* bar = b.bar;
    __builtin_amdgcn_s_waitcnt(0);
    unsigned nloc = b.st[0], nx = b.st[1];
    if (nloc == 0u) { xcd_barrier_complete(bar, b.x, nloc, nx); b.st[0] = nloc; b.st[1] = nx; }
    const unsigned old = xb_add(&bar[XB_XSUB(b.x)], 1u);
    const unsigned gen = old / nloc;
    if (old + 1u == (gen + 1u) * nloc) {
      __builtin_amdgcn_fence(__ATOMIC_RELEASE, "agent");
      asm volatile("s_waitcnt vmcnt(0)" ::: "memory");
      const unsigned og = xb_add(&bar[XB_TOP], 1u);
      const unsigned tg = og / nx;
      if (og + 1u == (tg + 1u) * nx) xb_add(&bar[XB_TOPGEN], 1u);
      else XB_SPIN(xb_ld(&bar[XB_TOPGEN]) == tg, bar);
      __builtin_amdgcn_fence(__ATOMIC_ACQUIRE, "agent");
      xb_add(&bar[XB_XGEN(b.x)], 1u);
      asm volatile("s_waitcnt vmcnt(0)" ::: "memory");
    } else {
      XB_SPIN(xb_ld(&bar[XB_XGEN(b.x)]) == gen, bar);
      __builtin_amdgcn_fence(__ATOMIC_ACQUIRE, "agent");
      asm volatile("s_waitcnt vmcnt(0)" ::: "memory");
    }
  }
  __syncthreads();
}

__global__ void __launch_bounds__(256, 2) mega(Params p) {
  __shared__ __attribute__((aligned(16))) char smem[SMEM_BYTES];
  __shared__ uint4 xb_words;
  const int bid = blockIdx.x, nblk = gridDim.x;
  char* ws = p.ws;
  if (__builtin_amdgcn_workitem_id_x() == 0) xb_words = make_uint4(0u, 0u, 0u, 0u);
  __syncthreads();
  const XcdBarrier xbar = xcd_barrier_post((unsigned*)(ws + OFF_BAR), (volatile LAS unsigned*)&xb_words);
  const float* mod = (const float*)(ws + OFF_MOD);
  u16* hn = (u16*)(ws + OFF_HN);
#define PH_BEGIN(n) if (p.phase_lo <= (n) && (n) < p.phase_hi) {
#define PH_END(n) if ((n) + 1 < p.phase_hi) { if ((n) == 0) cg::this_grid().sync(); else xcd_barrier(xbar); } }
  PH_BEGIN(0) phase0(p, smem, bid, nblk); PH_END(0)
  PH_BEGIN(1) norm_phase<1>(p, p.x, p.norm_mix_w, mod, 0, 1024, smem, bid, nblk); PH_END(1)
  PH_BEGIN(2) { EpiArgs ea{}; ea.outb = (u16*)(ws + OFF_PROJ); ea.ux = (u16*)(ws + OFF_UX);
        gemm_phase<E_PROJ0>(hn, 32, 0, (const u16*)(ws + OFF_WT_HYIN), 32, 0, 1024, M / 256, PN / 128, 1, ea, smem, bid, nblk); } PH_END(2)
  PH_BEGIN(3) { EpiArgs ea{}; ea.outf = (float*)(ws + OFF_XE);
        gemm_phase<E_XE>((const u16*)(ws + OFF_UX), 20, (size_t)S5C * UXW, (const u16*)(ws + OFF_EG), 16, (size_t)128 * 512, 512, S5C / 256, 1, 32, ea, smem, bid, nblk); } PH_END(3)
  PH_BEGIN(4) { s5_carry_phase(p, bid, nblk); gdn_prep_phase(p, smem, bid, nblk); } PH_END(4)
  PH_BEGIN(5) {
        if (bid < 16) { gdn_scan_item(p, bid, smem); }
        else { EpiArgs ea{}; ea.outb = (u16*)(ws + OFF_Y5); ea.ux = (u16*)(ws + OFF_UX); ea.bias = p.s5_d;
          gemm_phase<E_S5Y>((const u16*)(ws + OFF_UX), 20, (size_t)S5C * UXW, (const u16*)(ws + OFF_MF), 20, (size_t)512 * UXW, UXW, S5C / 256, 4, 32, ea, smem, bid - 16, nblk - 16); }
      } PH_END(5)
  PH_BEGIN(6) { gdn_out_phase(p, smem, bid, nblk); __syncthreads();
 EpiArgs ea{}; ea.outb = hn; ea.y5 = (const u16*)(ws + OFF_Y5); ea.bias = p.s5_glu_b;
        gemm_phase<E_GLU>((const u16*)(ws + OFF_Y5), 16, 0, (const u16*)(ws + OFF_WT_GLU), 16, 0, 512, M / 256, 4, 1, ea, smem, bid, nblk); } PH_END(6)
  PH_BEGIN(8) { EpiArgs ea{}; ea.outf = p.out; ea.res = p.x; ea.gate = mod + 2048;
        gemm_phase<E_RESID>(hn, 32, 0, (const u16*)(ws + OFF_WT_HYOUT), 32, 0, 1024, M / 256, 8, 1, ea, smem, bid, nblk); } PH_END(8)
  PH_BEGIN(9) norm_phase<0>(p, p.out, p.norm_ffn_w, mod, 3072, 4096, smem, bid, nblk); PH_END(9)
  PH_BEGIN(10) { EpiArgs ea{}; ea.outb = (u16*)(ws + OFF_PROJ);
        gemm_phase<E_SWIGLU>(hn, 32, 0, (const u16*)(ws + OFF_WT_FFNIN), 32, 0, 1024, M / 256, 2 * FF / 128, 1, ea, smem, bid, nblk); } PH_END(10)
  PH_BEGIN(11) { EpiArgs ea{}; ea.outf = p.out; ea.res = p.out; ea.gate = mod + 5120;
        gemm_phase<E_RESID>((const u16*)(ws + OFF_PROJ), FF / 32, 0, (const u16*)(ws + OFF_WT_FFNOUT), FF / 32, 0, FF, M / 256, 8, 1, ea, smem, bid, nblk); } PH_END(11)
  PH_BEGIN(12) norm_phase<0>(p, p.out, p.norm_mix_w + 1024, mod + 4 * 6144, 0, 1024, smem, bid, nblk); PH_END(12)
  PH_BEGIN(13) { EpiArgs ea{}; ea.outb = (u16*)(ws + OFF_PROJ); ea.ldc = 3072;
        gemm_phase<E_BF16>(hn, 32, 0, (const u16*)(ws + OFF_WT_SBIN), 32, 0, 1024, M / 256, 24, 1, ea, smem, bid, nblk); } PH_END(13)
  PH_BEGIN(14) attn_phase(p, smem, bid, nblk); PH_END(14)
  PH_BEGIN(15) { EpiArgs ea{}; ea.outf = p.out; ea.res = p.out; ea.gate = mod + 4 * 6144 + 2048;
        gemm_phase<E_RESID>(hn, 32, 0, (const u16*)(ws + OFF_WT_SBOUT), 32, 0, 1024, M / 256, 8, 1, ea, smem, bid, nblk); } PH_END(15)
  PH_BEGIN(16) norm_phase<0>(p, p.out, p.norm_ffn_w + 1024, mod + 4 * 6144, 3072, 4096, smem, bid, nblk); PH_END(16)
  PH_BEGIN(17) { EpiArgs ea{}; ea.outb = (u16*)(ws + OFF_PROJ);
        gemm_phase<E_SWIGLU>(hn, 32, 0, (const u16*)(ws + OFF_WT_FFNIN + SZ_WT_FFNIN), 32, 0, 1024, M / 256, 2 * FF / 128, 1, ea, smem, bid, nblk); } PH_END(17)
  PH_BEGIN(18) { EpiArgs ea{}; ea.outf = p.out; ea.res = p.out; ea.gate = mod + 4 * 6144 + 5120;
        gemm_phase<E_RESID>((const u16*)(ws + OFF_PROJ), FF / 32, 0, (const u16*)(ws + OFF_WT_FFNOUT + SZ_WT_FFNOUT), FF / 32, 0, FF, M / 256, 8, 1, ea, smem, bid, nblk); } PH_END(18)
  PH_BEGIN(19) norm_phase<2>(p, p.out, p.final_norm_w, mod, 0, 0, smem, bid, nblk); PH_END(19)
}

extern "C" void kernel_launch(void* const* d_in, const int* in_sizes, int n_in, void* d_out, int out_size, void* d_ws, size_t ws_size,
                              hipStream_t stream) {
  static int grid_blocks = 0;
  if (!grid_blocks) {
    int dev = 0, cus = 0, per_cu = 0;
    hipGetDevice(&dev);
    hipDeviceGetAttribute(&cus, hipDeviceAttributeMultiprocessorCount, dev);
    hipOccupancyMaxActiveBlocksPerMultiprocessor(&per_cu, mega, 256, 0);
    if (per_cu > 2) per_cu = 2;
    if (per_cu < 1) per_cu = 1;
    grid_blocks = cus * per_cu;
  }
  Params p{};
  const float* const* in = (const float* const*)d_in;
  p.x = in[0]; p.c = in[1]; p.ada_w = in[2]; p.ada_b = in[3]; p.norm_mix_w = in[4]; p.norm_ffn_w = in[5]; p.ffn_w_in = in[6]; p.ffn_w_out = in[7];
  p.hy_w_in = in[8]; p.hy_conv_w = in[9]; p.hy_a_log = in[10]; p.hy_dt_bias = in[11]; p.hy_head_norm_w = in[12];
  p.s5_lam_re = in[13]; p.s5_lam_im = in[14]; p.s5_log_dt = in[15]; p.s5_b_re = in[16]; p.s5_b_im = in[17]; p.s5_c_re = in[18]; p.s5_c_im = in[19];
  p.s5_d = in[20]; p.s5_glu_w = in[21]; p.s5_glu_b = in[22]; p.hy_w_out = in[23]; p.sb_w_in = in[24]; p.sb_w_out = in[25]; p.final_norm_w = in[26];
  p.out = (float*)d_out; p.ws = (char*)d_ws;
#if ONE_LAUNCH
  p.phase_lo = 0; p.phase_hi = NPHASE;
  (void)hipMemsetAsync((char*)d_ws + OFF_BAR, 0, (size_t)XCD_BAR_WORDS_C * 4, stream);
  void* args[] = {&p};
  hipError_t e = hipLaunchCooperativeKernel((void*)mega, dim3(grid_blocks), dim3(256), args, 0, stream);
  if (e != hipSuccess) fprintf(stderr, "cooperative launch failed: %s (grid %d)\n", hipGetErrorString(e), grid_blocks);
#else
  for (int ph = 0; ph < NPHASE; ++ph) {
    p.phase_lo = ph; p.phase_hi = ph + 1;
    hipLaunchKernelGGL(mega, dim3(grid_blocks), dim3(256), 0, stream, p);
  }
#endif
}
```

```cpp
#include <hip/hip_runtime.h>
#include <hip/hip_cooperative_groups.h>
#include <stdint.h>
#include <cstdio>
namespace cg = cooperative_groups;

#ifndef ONE_LAUNCH
#define ONE_LAUNCH 1
#endif

typedef unsigned short u16;
using bf16x8 = __attribute__((ext_vector_type(8))) short;
using f32x4 = __attribute__((ext_vector_type(4))) float;
using u32x4 = __attribute__((ext_vector_type(4))) unsigned;

constexpr int D = 1024, NB = 4, SEQ = 8192, M = NB * SEQ, FF = 2816, EIN = 2568, PN = 2560, PJ = 2048;
constexpr int NPHASE = 20;
constexpr int XCD_BAR_WORDS_C = 3456;
constexpr int S5T = 32, S5C = M / S5T, UXW = 640;

constexpr size_t SZ_WT_HYIN = (size_t)PN * 1024 * 2, SZ_WT_SQ = (size_t)1024 * 1024 * 2, SZ_WT_GLU = (size_t)512 * 512 * 2;
constexpr size_t SZ_WT_FFNIN = (size_t)2 * FF * 1024 * 2, SZ_WT_FFNOUT = (size_t)1024 * FF * 2, SZ_WT_SBIN = (size_t)3072 * 1024 * 2;
constexpr size_t OFF_WT_HYIN = 0;
constexpr size_t OFF_WT_HYOUT = OFF_WT_HYIN + SZ_WT_HYIN;
constexpr size_t OFF_WT_GLU = OFF_WT_HYOUT + SZ_WT_SQ;
constexpr size_t OFF_WT_FFNIN = OFF_WT_GLU + SZ_WT_GLU;
constexpr size_t OFF_WT_FFNOUT = OFF_WT_FFNIN + 2 * SZ_WT_FFNIN;
constexpr size_t OFF_WT_SBIN = OFF_WT_FFNOUT + 2 * SZ_WT_FFNOUT;
constexpr size_t OFF_WT_SBOUT = OFF_WT_SBIN + SZ_WT_SBIN;
constexpr size_t OFF_MOD = OFF_WT_SBOUT + SZ_WT_SQ;
constexpr size_t OFF_BETA = OFF_MOD + (size_t)2 * 4 * 6144 * 4;
constexpr size_t OFF_G = OFF_BETA + (size_t)M * 4 * 4;
constexpr size_t OFF_HN = OFF_G + (size_t)M * 4 * 4;
constexpr size_t OFF_Y5 = OFF_HN + (size_t)M * 1024 * 2;
constexpr size_t OFF_UX = OFF_Y5 + (size_t)M * 512 * 2;
constexpr size_t OFF_MF = OFF_UX + (size_t)32 * S5C * UXW * 2;
constexpr size_t OFF_EG = OFF_MF + (size_t)32 * 512 * UXW * 2;
constexpr size_t OFF_XE = OFF_EG + (size_t)32 * 128 * 512 * 2;
constexpr size_t OFF_A32 = OFF_XE + (size_t)32 * S5C * 128 * 4;
constexpr size_t OFF_PROJ = OFF_A32 + (size_t)32 * 64 * 2 * 4;
constexpr size_t OFF_GW = OFF_PROJ + (size_t)M * PJ * 2;
constexpr size_t OFF_GQD = OFF_GW + (size_t)2048 * 8192 * 2;
constexpr size_t OFF_GKT = OFF_GQD + (size_t)2048 * 8192 * 2;
constexpr size_t OFF_GUT = OFF_GKT + (size_t)2048 * 8192 * 2;
constexpr size_t OFF_GAT = OFF_GUT + (size_t)2048 * 8192 * 2;
constexpr size_t OFF_GSD = OFF_GAT + (size_t)2048 * 4096 * 2;
constexpr size_t OFF_BAR = OFF_GSD + (size_t)2048 * 4;
constexpr size_t WS_TOTAL = OFF_BAR + (size_t)XCD_BAR_WORDS_C * 4;
static_assert((size_t)M * 3072 * 2 <= WS_TOTAL - OFF_PROJ, "QKV alias");
static_assert(WS_TOTAL <= (size_t)512 * 1024 * 1024, "workspace too large");

struct Params {
  const float *x, *c, *ada_w, *ada_b, *norm_mix_w, *norm_ffn_w, *ffn_w_in, *ffn_w_out;
  const float *hy_w_in, *hy_conv_w, *hy_a_log, *hy_dt_bias, *hy_head_norm_w;
  const float *s5_lam_re, *s5_lam_im, *s5_log_dt, *s5_b_re, *s5_b_im, *s5_c_re, *s5_c_im, *s5_d, *s5_glu_w, *s5_glu_b, *hy_w_out;
  const float *sb_w_in, *sb_w_out, *final_norm_w;
  float* out;
  char* ws;
  int phase_lo, phase_hi;
};

constexpr int SMEM_BYTES = 73728;

__device__ __forceinline__ int otid() { int t = __builtin_amdgcn_workitem_id_x(); asm volatile("" : "+v"(t)); return t; }
__device__ __forceinline__ u16 f2bf(float x) { unsigned u = __float_as_uint(x); u += 0x7fffu + ((u >> 16) & 1u); return (u16)(u >> 16); }
typedef __bf16 bf16v2 __attribute__((ext_vector_type(2)));
typedef float f32v2 __attribute__((ext_vector_type(2)));
__device__ __forceinline__ unsigned pk2(float a, float b) { f32v2 v = {a, b}; bf16v2 r = __builtin_convertvector(v, bf16v2); return __builtin_bit_cast(unsigned, r); }
__device__ __forceinline__ float bf2f(u16 v) { return __uint_as_float(((unsigned)v) << 16); }
__device__ __forceinline__ float sigmoid_(float x) { return 1.f / (1.f + __expf(-x)); }
__device__ __forceinline__ float silu_(float x) { return x * sigmoid_(x); }
__device__ __forceinline__ float softplus_(float x) { return fmaxf(x, 0.f) + log1pf(__expf(-fabsf(x))); }
__device__ __forceinline__ float gelu_tanh_(float y) { return 0.5f * y * (1.f + tanhf(0.7978845608028654f * (y + 0.044715f * y * y * y))); }

__device__ __forceinline__ size_t pj_idx(int row, int col) { return (size_t)(col >> 9) * ((size_t)M * 512) + (size_t)row * 512 + (col & 511); }
__device__ __forceinline__ size_t a_off(int row, int col, int nks) { return ((size_t)((row >> 8) * nks + (col >> 5)) << 13) + ((row & 255) << 5) + (col & 31); }
__device__ __forceinline__ size_t b_off(int n, int k, int nks) { return ((size_t)((n >> 7) * nks + (k >> 5)) << 12) + ((n & 127) << 5) + (k & 31); }

struct TrJob { const float* src; u16* dst; int K, Nsrc, Nd, mode; };
__device__ __forceinline__ TrJob get_job(const Params& p, int j) {
  TrJob t;
  switch (j) {
    case 0: t = {p.hy_w_in, (u16*)(p.ws + OFF_WT_HYIN), 1024, EIN, PN, 1}; break;
    case 1: t = {p.hy_w_out, (u16*)(p.ws + OFF_WT_HYOUT), 1024, 1024, 1024, 0}; break;
    case 2: t = {p.s5_glu_w, (u16*)(p.ws + OFF_WT_GLU), 512, 512, 512, 0}; break;
    case 3: t = {p.ffn_w_in, (u16*)(p.ws + OFF_WT_FFNIN), 1024, 2 * FF, 2 * FF, 2}; break;
    case 4: t = {p.ffn_w_in + (size_t)1024 * 2 * FF, (u16*)(p.ws + OFF_WT_FFNIN + SZ_WT_FFNIN), 1024, 2 * FF, 2 * FF, 2}; break;
    case 5: t = {p.ffn_w_out, (u16*)(p.ws + OFF_WT_FFNOUT), FF, 1024, 1024, 0}; break;
    case 6: t = {p.ffn_w_out + (size_t)FF * 1024, (u16*)(p.ws + OFF_WT_FFNOUT + SZ_WT_FFNOUT), FF, 1024, 1024, 0}; break;
    case 7: t = {p.sb_w_in, (u16*)(p.ws + OFF_WT_SBIN), 1024, 3072, 3072, 0}; break;
    default: t = {p.sb_w_out, (u16*)(p.ws + OFF_WT_SBOUT), 1024, 1024, 1024, 0}; break;
  }
  return t;
}
__device__ __forceinline__ int src_col(int R, int mode) {
  if (mode == 0) return R;
  if (mode == 1) return R < 2048 ? R : R + 8;
  return ((R >> 4) & 1) * FF + (R >> 5) * 16 + (R & 15);
}
constexpr int N_TR_ITEMS = 640 + 256 + 64 + 2 * 1408 + 2 * 704 + 768 + 256;
constexpr int N_MOD_ITEMS = 2 * 6144 / 16;

__device__ __forceinline__ void s5_table_item(const Params& p, int item, char* smem) {
  const int tid = otid(), g = item >> 5, tau = item & 31;
  float* pwr = (float*)smem; float* pwi = pwr + 64; float* p1r = pwi + 64; float* p1i = p1r + 64;
  float* bbr = p1i + 64; float* bbi = bbr + 1024; float* cre = bbi + 1024; float* cim = cre + 1024;
  const float dt = expf(p.s5_log_dt[g]);
  if (tid < 64) {
    const float lr = p.s5_lam_re[g * 64 + tid], li = p.s5_lam_im[g * 64 + tid];
    float sn, cs;
    float mg = expf(lr * dt * (float)tau); sincosf(li * dt * (float)tau, &sn, &cs); pwr[tid] = mg * cs; pwi[tid] = mg * sn;
    mg = expf(lr * dt * (float)(tau + 1)); sincosf(li * dt * (float)(tau + 1), &sn, &cs); p1r[tid] = mg * cs; p1i[tid] = mg * sn;
    if (tau == 31) { float* a32 = (float*)(p.ws + OFF_A32); a32[(g * 64 + tid) * 2] = mg * cs; a32[(g * 64 + tid) * 2 + 1] = mg * sn; }
  }
  {
    const int pp = tid >> 2, hq = (tid & 3) * 4;
    const float lr = p.s5_lam_re[g * 64 + pp], li = p.s5_lam_im[g * 64 + pp];
    const float mg = expf(lr * dt); float sn, cs; sincosf(li * dt, &sn, &cs);
    const float ar = mg * cs, ai = mg * sn, den = lr * lr + li * li, nr = ar - 1.f, ni = ai;
    const float fre = (nr * lr + ni * li) / den, fim = (ni * lr - nr * li) / den;
#pragma unroll
    for (int e = 0; e < 4; ++e) {
      const float br = p.s5_b_re[(size_t)(g * 64 + pp) * 16 + hq + e], bi = p.s5_b_im[(size_t)(g * 64 + pp) * 16 + hq + e];
      bbr[pp * 16 + hq + e] = fre * br - fim * bi; bbi[pp * 16 + hq + e] = fre * bi + fim * br;
    }
    for (int i = tid; i < 1024; i += 256) { cre[i] = p.s5_c_re[(size_t)g * 1024 + i]; cim[i] = p.s5_c_im[(size_t)g * 1024 + i]; }
  }
  __syncthreads();
  u16* mf = (u16*)(p.ws + OFF_MF) + (size_t)g * 512 * UXW;
  u16* eg = (u16*)(p.ws + OFF_EG) + (size_t)g * 128 * 512;
  {
    const int h = tid >> 4, hp = tid & 15;
    float kv = 0.f;
    for (int pp = 0; pp < 64; ++pp) {
      const float cr = cre[h * 64 + pp], ci = cim[h * 64 + pp], pr = pwr[pp], pi = pwi[pp];
      kv += (cr * pr - ci * pi) * bbr[pp * 16 + hp] - (cr * pi + ci * pr) * bbi[pp * 16 + hp];
    }
    const u16 kb = f2bf(kv);
    for (int s0 = 0; s0 + tau < 32; ++s0) mf[b_off((s0 + tau) * 16 + h, s0 * 16 + hp, 20)] = kb;
    for (int t0 = 0; t0 + tau + 1 < 32; ++t0) mf[b_off(t0 * 16 + h, (t0 + tau + 1) * 16 + hp, 20)] = 0;
#pragma unroll
    for (int e = 0; e < 4; ++e) {
      const int pp = hp * 4 + e;
      const float cr = cre[h * 64 + pp], ci = cim[h * 64 + pp], pr = p1r[pp], pi = p1i[pp];
      mf[b_off(tau * 16 + h, 512 + pp, 20)] = f2bf(cr * pr - ci * pi);
      mf[b_off(tau * 16 + h, 576 + pp, 20)] = f2bf(-(cr * pi + ci * pr));
    }
  }
  {
    const int pp = tid >> 2, hq = (tid & 3) * 4, s0 = 31 - tau;
#pragma unroll
    for (int e = 0; e < 4; ++e) {
      const float br = bbr[pp * 16 + hq + e], bi = bbi[pp * 16 + hq + e], pr = pwr[pp], pi = pwi[pp];
      eg[b_off(pp, s0 * 16 + hq + e, 16)] = f2bf(pr * br - pi * bi);
      eg[b_off(64 + pp, s0 * 16 + hq + e, 16)] = f2bf(pr * bi + pi * br);
    }
  }
  __syncthreads();
}

__device__ __forceinline__ void phase0(const Params& p, char* smem, int bid, int nblk) {
  const int tid = otid();
  for (int it = bid; it < N_TR_ITEMS + N_MOD_ITEMS + 1024; it += nblk) {
    if (it >= N_TR_ITEMS + N_MOD_ITEMS) { s5_table_item(p, it - N_TR_ITEMS - N_MOD_ITEMS, smem); continue; }
    if (it < N_TR_ITEMS) {
      int rem = it, j = 0; TrJob jb;
      for (;; ++j) { jb = get_job(p, j); int n = (jb.Nd >> 6) * (jb.K >> 6); if (rem < n) break; rem -= n; }
      const int nk = jb.K >> 6, R0 = (rem / nk) * 64, k0 = (rem % nk) * 64;
      u16* s = (u16*)smem;
      {
        const int r = tid & 63, kk = tid >> 6;
        const float* sp = jb.src + (size_t)k0 * jb.Nsrc + src_col(R0 + r, jb.mode);
#pragma unroll
        for (int i = 0; i < 16; ++i) { int k = kk + 4 * i; s[r * 72 + k] = f2bf(sp[(size_t)k * jb.Nsrc]); }
      }
      __syncthreads();
      {
        const int r = tid >> 2, ch = tid & 3;
#pragma unroll
        for (int i = 0; i < 2; ++i) {
          int c8 = (ch + 4 * i) * 8;
          *(u32x4*)(jb.dst + b_off(R0 + r, k0 + c8, jb.K >> 5)) = *(const u32x4*)(s + r * 72 + c8);
        }
      }
      __syncthreads();
    } else {
      const int mi = it - N_TR_ITEMS, l = mi / 384, n0 = (mi % 384) * 16;
      float* cact = (float*)smem;
      float* red = cact + 4096;
      for (int i = tid; i < 4096; i += 256) cact[i] = silu_(p.c[i]);
      __syncthreads();
      const int cl = tid & 15, ksub = tid >> 4;
      float a0 = 0, a1 = 0, a2 = 0, a3 = 0;
      const float* wp = p.ada_w + (size_t)l * 1024 * 6144 + n0 + cl;
#pragma unroll 16
      for (int k = ksub * 64; k < ksub * 64 + 64; ++k) {
        float w = wp[(size_t)k * 6144];
        a0 += cact[k] * w; a1 += cact[1024 + k] * w; a2 += cact[2048 + k] * w; a3 += cact[3072 + k] * w;
      }
      red[(ksub * 4 + 0) * 16 + cl] = a0; red[(ksub * 4 + 1) * 16 + cl] = a1;
      red[(ksub * 4 + 2) * 16 + cl] = a2; red[(ksub * 4 + 3) * 16 + cl] = a3;
      __syncthreads();
      if (tid < 64) {
        const int b = tid >> 4;
        float sum = 0.f;
#pragma unroll
        for (int q = 0; q < 16; ++q) sum += red[(q * 4 + b) * 16 + cl];
        float* mod = (float*)(p.ws + OFF_MOD);
        mod[(size_t)(l * 4 + b) * 6144 + n0 + cl] = sum + p.ada_b[l * 6144 + n0 + cl];
      }
      __syncthreads();
    }
  }
}

template <int MODE>
__device__ __forceinline__ void norm_phase(const Params& p, const float* src, const float* w, const float* modl, int sh_off, int sc_off,
                           char* smem, int bid, int nblk) {
  const int tid = otid(), wid = tid >> 6, lane = tid & 63;
  float* wba = (float*)smem;
  if (MODE == 1) {
    for (int i = tid; i < 1024 * 8; i += 256) wba[i] = p.hy_w_in[(size_t)(i >> 3) * EIN + 2048 + (i & 7)];
    __syncthreads();
  }
  u16* hn = (u16*)(p.ws + OFF_HN);
  auto process = [&](int row, f32x4 (&v)[4]) {
    float ss = 0.f;
#pragma unroll
    for (int i = 0; i < 4; ++i) ss += v[i][0] * v[i][0] + v[i][1] * v[i][1] + v[i][2] * v[i][2] + v[i][3] * v[i][3];
#pragma unroll
    for (int o = 32; o >= 1; o >>= 1) ss += __shfl_xor(ss, o);
    const float rstd = rsqrtf(ss * (1.f / 1024.f) + 1e-6f);
    const int b = row >> 13;
    float dots[8];
    if (MODE == 1) { for (int j = 0; j < 8; ++j) dots[j] = 0.f; }
#pragma unroll
    for (int i = 0; i < 4; ++i) {
      const int c0 = i * 256 + lane * 4;
      f32x4 ww = *(const f32x4*)(w + c0);
      f32x4 y;
      if (MODE == 2) {
#pragma unroll
        for (int e = 0; e < 4; ++e) y[e] = v[i][e] * rstd * ww[e];
        *(f32x4*)(p.out + (size_t)row * 1024 + c0) = y;
      } else {
        f32x4 sc = *(const f32x4*)(modl + (size_t)b * 6144 + sc_off + c0);
        f32x4 sh = *(const f32x4*)(modl + (size_t)b * 6144 + sh_off + c0);
#pragma unroll
        for (int e = 0; e < 4; ++e) y[e] = v[i][e] * rstd * ww[e] * (1.f + sc[e]) + sh[e];
        uint2 pk; pk.x = (unsigned)f2bf(y[0]) | ((unsigned)f2bf(y[1]) << 16); pk.y = (unsigned)f2bf(y[2]) | ((unsigned)f2bf(y[3]) << 16);
        *(uint2*)(hn + a_off(row, c0, 32)) = pk;
        if (MODE == 1) {
#pragma unroll
          for (int e = 0; e < 4; ++e) {
            f32x4 w0 = *(const f32x4*)(wba + (c0 + e) * 8), w1 = *(const f32x4*)(wba + (c0 + e) * 8 + 4);
#pragma unroll
            for (int j = 0; j < 4; ++j) { dots[j] += y[e] * w0[j]; dots[4 + j] += y[e] * w1[j]; }
          }
        }
      }
    }
    if (MODE == 1) {
#pragma unroll
      for (int j = 0; j < 8; ++j) {
#pragma unroll
        for (int o = 32; o >= 1; o >>= 1) dots[j] += __shfl_xor(dots[j], o);
      }
      if (lane == 0) {
        float* beta = (float*)(p.ws + OFF_BETA); float* gg = (float*)(p.ws + OFF_G);
#pragma unroll
        for (int h = 0; h < 4; ++h) {
          beta[(size_t)row * 4 + h] = sigmoid_(dots[h]);
          gg[(size_t)row * 4 + h] = -__expf(p.hy_a_log[h]) * softplus_(dots[4 + h] + p.hy_dt_bias[h]);
        }
      }
    }
  };
#pragma unroll 1
  for (int row = bid * 4 + wid; row < M; row += nblk * 8) {
    const int row1 = row + nblk * 4;
    const bool has1 = row1 < M;
    f32x4 v0[4], v1[4];
#pragma unroll
    for (int i = 0; i < 4; ++i) v0[i] = *(const f32x4*)(src + (size_t)row * 1024 + i * 256 + lane * 4);
#pragma unroll
    for (int i = 0; i < 4; ++i) v1[i] = has1 ? *(const f32x4*)(src + (size_t)row1 * 1024 + i * 256 + lane * 4) : f32x4{0.f, 0.f, 0.f, 0.f};
    process(row, v0);
    if (has1) process(row1, v1);
  }
}

enum { E_PROJ0 = 0, E_BF16 = 1, E_RESID = 2, E_GLU = 3, E_SWIGLU = 4, E_XE = 5, E_S5Y = 6 };
struct EpiArgs { float* outf; u16* outb; const float* res; const float* gate; const u16* y5; const float* bias; u16* ux; int ldc; };

template <int EPI>
__device__ __forceinline__ void gemm_phase(const u16* __restrict__ A0, int nksA, size_t sA, const u16* __restrict__ B0, int nksB, size_t sB,
                                           int K, int nM, int nN, int nbatch, const EpiArgs ea, char* smem, int bid, int nblk) {
  const int tid = otid(), wid = tid >> 6, lane = tid & 63, wr = wid >> 1, wc = wid & 1, fr = lane & 15, fq = lane >> 4;
  char* SA = smem; char* SB = smem + 49152;
  const int sa0 = (int)(uintptr_t)SA + (wr * 128 + fr) * 64 + fq * 16, sb0 = (int)(uintptr_t)SB + (wc * 64 + fr) * 64 + fq * 16;
  const int NR = nbatch * nM, ntiles = NR * nN;
  const int STN = (nN & 7) == 0 ? 8 : ((nN & 3) == 0 ? 4 : 1), STM = 64 / STN, nSN = nN / STN;
  const bool swz = ((nblk & 7) == 0) && (NR % STM == 0);
  const int lpx = nblk >> 3;
  int si = bid & 7, l = bid >> 3, tl = bid;
#pragma unroll 1
  for (;;) {
    int R, pn;
    if (swz) {
      if (si >= (NR / STM) * nSN) break;
      R = (si / nSN) * STM + l / STN; pn = (si % nSN) * STN + l % STN;
      l += lpx; if (l >= 64) { l = bid >> 3; si += 8; }
    } else {
      if (tl >= ntiles) break;
      R = tl / nN; pn = tl % nN; tl += nblk;
    }
    const int g = R / nM, rt = R % nM, brow = rt << 8, bcol = pn << 7;
    const char* A = (const char*)(A0 + (size_t)g * sA) + ((size_t)rt * nksA << 14) + tid * 16;
    const char* Bt = (const char*)(B0 + (size_t)g * sB) + ((size_t)pn * nksB << 13) + tid * 16;
    int nk = K >> 5, klim = nk;
    if (EPI == E_S5Y) { klim = 4 * (pn + 1); nk = klim + 4; }
    f32x4 acc[8][4];
#pragma unroll
    for (int m = 0; m < 8; ++m)
#pragma unroll
      for (int n = 0; n < 4; ++n) acc[m][n] = f32x4{0.f, 0.f, 0.f, 0.f};
#define GSTAGE(KK, BUF) do { const int kt_ = (EPI == E_S5Y && (KK) >= klim) ? (16 + (KK) - klim) : (KK); \
      _Pragma("unroll") for (int i = 0; i < 4; ++i) \
        __builtin_amdgcn_global_load_lds((const unsigned*)(A + ((size_t)kt_ << 14) + i * 4096), (__attribute__((address_space(3))) unsigned*)(SA + (BUF) * 16384 + tid * 16 + i * 4096), 16, 0, 0); \
      _Pragma("unroll") for (int i = 0; i < 2; ++i) \
        __builtin_amdgcn_global_load_lds((const unsigned*)(Bt + ((size_t)kt_ << 13) + i * 4096), (__attribute__((address_space(3))) unsigned*)(SB + (BUF) * 8192 + tid * 16 + i * 4096), 16, 0, 0); } while (0)
    asm volatile("s_waitcnt vmcnt(0)" ::: "memory");
    GSTAGE(0, 0);
    if (nk > 1) { GSTAGE(1, 1); asm volatile("s_waitcnt vmcnt(6)\n\ts_barrier" ::: "memory"); }
    else { asm volatile("s_waitcnt vmcnt(0)\n\ts_barrier" ::: "memory"); }
    int buf = 0, nbuf = 2;
#pragma unroll 1
    for (int kk = 0; kk < nk; ++kk) {
      const bool more = kk + 2 < nk;
      if (more) GSTAGE(kk + 2, nbuf);
      bf16x8 Bl[4], At[8];
      {
        const int bb = sb0 + buf * 8192, ab = sa0 + buf * 16384;
        asm volatile(
            "ds_read_b128 %0, %12\n\tds_read_b128 %1, %12 offset:1024\n\tds_read_b128 %2, %12 offset:2048\n\tds_read_b128 %3, %12 offset:3072\n\t"
            "ds_read_b128 %4, %13\n\tds_read_b128 %5, %13 offset:1024\n\tds_read_b128 %6, %13 offset:2048\n\tds_read_b128 %7, %13 offset:3072\n\t"
            "ds_read_b128 %8, %13 offset:4096\n\tds_read_b128 %9, %13 offset:5120\n\tds_read_b128 %10, %13 offset:6144\n\tds_read_b128 %11, %13 offset:7168\n\t"
            "s_waitcnt lgkmcnt(4)"
            : "=&v"(Bl[0]), "=&v"(Bl[1]), "=&v"(Bl[2]), "=&v"(Bl[3]), "=&v"(At[0]), "=&v"(At[1]), "=&v"(At[2]), "=&v"(At[3]),
              "=&v"(At[4]), "=&v"(At[5]), "=&v"(At[6]), "=&v"(At[7])
            : "v"(bb), "v"(ab)
            : "memory");
      }
      __builtin_amdgcn_s_setprio(1);
#pragma unroll
      for (int m = 0; m < 4; ++m)
#pragma unroll
        for (int n = 0; n < 4; ++n) acc[m][n] = __builtin_amdgcn_mfma_f32_16x16x32_bf16(Bl[n], At[m], acc[m][n], 0, 0, 0);
      __builtin_amdgcn_sched_barrier(0);
      asm volatile("s_waitcnt lgkmcnt(0)" : "+v"(At[4]), "+v"(At[5]), "+v"(At[6]), "+v"(At[7]) :: "memory");
      __builtin_amdgcn_sched_barrier(0);
#pragma unroll
      for (int m = 4; m < 8; ++m)
#pragma unroll
        for (int n = 0; n < 4; ++n) acc[m][n] = __builtin_amdgcn_mfma_f32_16x16x32_bf16(Bl[n], At[m], acc[m][n], 0, 0, 0);
      __builtin_amdgcn_s_setprio(0);
      if (more) asm volatile("s_waitcnt vmcnt(6)\n\ts_barrier" ::: "memory");
      else asm volatile("s_waitcnt vmcnt(0)\n\ts_barrier" ::: "memory");
      buf = (buf == 2) ? 0 : buf + 1; nbuf = (nbuf == 2) ? 0 : nbuf + 1;
    }
#undef GSTAGE
#pragma unroll
    for (int m = 0; m < 8; ++m)
#pragma unroll
      for (int n = 0; n < 4; ++n) {
        const int row = brow + wr * 128 + m * 16 + fr, col = bcol + wc * 64 + n * 16 + fq * 4;
        const f32x4 v = acc[m][n];
        if (EPI == E_PROJ0) {
          const uint2 pk = uint2{pk2(v[0], v[1]), pk2(v[2], v[3])};
          if (bcol < 2048) *(uint2*)(ea.outb + pj_idx(row, col)) = pk;
          else { const int cc = col - 2048; *(uint2*)(ea.ux + (size_t)(cc >> 4) * S5C * UXW + a_off(row >> 5, (row & 31) * 16 + (cc & 15), 20)) = pk; }
        }
        if (EPI == E_BF16) *(uint2*)(ea.outb + (size_t)row * ea.ldc + col) = uint2{pk2(v[0], v[1]), pk2(v[2], v[3])};
        if (EPI == E_RESID) {
          const size_t idx = (size_t)row * 1024 + col;
          const f32x4 r4 = *(const f32x4*)(ea.res + idx), g4 = *(const f32x4*)(ea.gate + (size_t)(row >> 13) * 6144 + col);
          *(f32x4*)(ea.outf + idx) = f32x4{r4[0] + g4[0] * v[0], r4[1] + g4[1] * v[1], r4[2] + g4[2] * v[2], r4[3] + g4[3] * v[3]};
        }
        if (EPI == E_GLU) {
          const uint2 yy = *(const uint2*)(ea.y5 + a_off(row, col, 16));
          const f32x4 b4 = *(const f32x4*)(ea.bias + col);
          const float y0 = __uint_as_float(yy.x << 16), y1 = __uint_as_float(yy.x & 0xffff0000u), y2 = __uint_as_float(yy.y << 16), y3 = __uint_as_float(yy.y & 0xffff0000u);
          *(uint2*)(ea.outb + a_off(row, 512 + col, 32)) = uint2{pk2(y0 * sigmoid_(v[0] + b4[0]), y1 * sigmoid_(v[1] + b4[1])), pk2(y2 * sigmoid_(v[2] + b4[2]), y3 * sigmoid_(v[3] + b4[3]))};
        }
        if (EPI == E_SWIGLU) {
          if ((n & 1) == 0) {
            const f32x4 u = acc[m][n | 1];
            const int co = (bcol >> 1) + wc * 32 + (n >> 1) * 16 + fq * 4;
            *(uint2*)(ea.outb + a_off(row, co, FF / 32)) = uint2{pk2(silu_(v[0]) * u[0], silu_(v[1]) * u[1]), pk2(silu_(v[2]) * u[2], silu_(v[3]) * u[3])};
          }
        }
        if (EPI == E_XE) *(f32x4*)(ea.outf + ((size_t)g * S5C + row) * 128 + col) = v;
        if (EPI == E_S5Y) {
          const uint2 uu = *(const uint2*)(ea.ux + (size_t)g * S5C * UXW + a_off(row, col, 20));
          const f32x4 d4 = *(const f32x4*)(ea.bias + g * 16 + (col & 15));
          const float u0 = __uint_as_float(uu.x << 16), u1 = __uint_as_float(uu.x & 0xffff0000u), u2 = __uint_as_float(uu.y << 16), u3 = __uint_as_float(uu.y & 0xffff0000u);
          *(uint2*)(ea.outb + a_off(row * 32 + (col >> 4), g * 16 + (col & 15), 16)) =
              uint2{pk2(gelu_tanh_(v[0] + d4[0] * u0), gelu_tanh_(v[1] + d4[1] * u1)), pk2(gelu_tanh_(v[2] + d4[2] * u2), gelu_tanh_(v[3] + d4[3] * u3))};
        }
      }
  }
}

__device__ __forceinline__ void s5_carry_phase(const Params& p, int bid, int nblk) {
  const float* xe = (const float*)(p.ws + OFF_XE); const float* a32 = (const float*)(p.ws + OFF_A32);
  u16* ux = (u16*)(p.ws + OFF_UX);
  for (int it = bid; it < 32; it += nblk) {
    const int idx = it * 256 + otid(), pp = idx & 63, g = (idx >> 6) & 31, b = idx >> 11;
    const float ar = a32[(g * 64 + pp) * 2], ai = a32[(g * 64 + pp) * 2 + 1];
    float xr = 0.f, xi = 0.f;
    const size_t cbase = (size_t)g * S5C + b * 256, gbase = (size_t)g * S5C * UXW;
    for (int n = 0; n < 256; n += 8) {
      float er[8], ei[8];
#pragma unroll
      for (int e = 0; e < 8; ++e) { er[e] = xe[(cbase + n + e) * 128 + pp]; ei[e] = xe[(cbase + n + e) * 128 + 64 + pp]; }
#pragma unroll
      for (int e = 0; e < 8; ++e) {
        ux[gbase + a_off(b * 256 + n + e, 512 + pp, 20)] = f2bf(xr); ux[gbase + a_off(b * 256 + n + e, 576 + pp, 20)] = f2bf(xi);
        const float nr = ar * xr - ai * xi + er[e], ni = ar * xi + ai * xr + ei[e];
        xr = nr; xi = ni;
      }
    }
  }
}

__device__ __forceinline__ int crow(int r, int hi) { return (r & 3) + 8 * (r >> 2) + 4 * hi; }
using f32x16 = __attribute__((ext_vector_type(16))) float;
__device__ __forceinline__ void unpack8(const u32x4 w, float* f) {
#pragma unroll
  for (int e = 0; e < 4; ++e) { f[2 * e] = __uint_as_float(w[e] << 16); f[2 * e + 1] = __uint_as_float(w[e] & 0xffff0000u); }
}
__device__ __forceinline__ void gdn_prep_phase(const Params& p, char* smem, int bid, int nblk) {
  const int tid = otid(), wid = tid >> 6, lane = tid & 63, fr = lane & 15, fq = lane >> 4;
  u16* qs = (u16*)smem;
  u16* ks = qs + 64 * 136;
  float* Lm = (float*)(ks + 64 * 136);
  float* gcs = Lm + 4096; float* bts = gcs + 64; float* egs = bts + 64;
  const u16* proj = (const u16*)(p.ws + OFF_PROJ);
  const float* beta = (const float*)(p.ws + OFF_BETA); const float* gg = (const float*)(p.ws + OFF_G);
#pragma unroll 1
  for (int it = bid; it < 2048; it += nblk) {
    const int n = it & 127, bh = it >> 7, b = bh >> 2, h = bh & 3;
    const size_t row0 = (size_t)b * SEQ + n * 64;
    if (wid == 0) {
      float c = gg[(row0 + lane) * 4 + h];
#pragma unroll
      for (int o = 1; o < 64; o <<= 1) { const float tt = __shfl_up(c, o); if (lane >= o) c += tt; }
      gcs[lane] = c; egs[lane] = __expf(c); bts[lane] = beta[(row0 + lane) * 4 + h];
    }
    {
      const int tok = tid >> 2, part = tid & 3, l = n * 64 + tok;
      float qo[32], ko[32]; float sq = 0.f, sk = 0.f;
#pragma unroll
      for (int cb = 0; cb < 4; ++cb) {
        const int colq = h * 128 + part * 32 + cb * 8, colk = 512 + colq;
        const size_t kblk = (size_t)M * 512 - 512;
        float aq[8], ak[8];
#pragma unroll
        for (int e = 0; e < 8; ++e) { aq[e] = 0.f; ak[e] = 0.f; }
#pragma unroll
        for (int j = 0; j < 4; ++j) {
          const int lt = l - 3 + j;
          if (lt >= 0) {
            const u16* rp = proj + ((size_t)b * SEQ + lt) * 512;
            float xq[8], xk[8];
            unpack8(*(const u32x4*)(rp + colq), xq); unpack8(*(const u32x4*)(rp + kblk + colk), xk);
            const f32x4 wq0 = *(const f32x4*)(p.hy_conv_w + j * 1536 + colq), wq1 = *(const f32x4*)(p.hy_conv_w + j * 1536 + colq + 4);
            const f32x4 wk0 = *(const f32x4*)(p.hy_conv_w + j * 1536 + colk), wk1 = *(const f32x4*)(p.hy_conv_w + j * 1536 + colk + 4);
#pragma unroll
            for (int e = 0; e < 4; ++e) { aq[e] += wq0[e] * xq[e]; aq[4 + e] += wq1[e] * xq[4 + e]; ak[e] += wk0[e] * xk[e]; ak[4 + e] += wk1[e] * xk[4 + e]; }
          }
        }
#pragma unroll
        for (int e = 0; e < 8; ++e) { const float a = silu_(aq[e]), k = silu_(ak[e]); qo[cb * 8 + e] = a; ko[cb * 8 + e] = k; sq += a * a; sk += k * k; }
      }
      sq += __shfl_xor(sq, 1); sq += __shfl_xor(sq, 2); sk += __shfl_xor(sk, 1); sk += __shfl_xor(sk, 2);
      const float rq = rsqrtf(sq + 1e-6f) * 0.08838834764831845f, rk = rsqrtf(sk + 1e-6f);
#pragma unroll
      for (int cb = 0; cb < 4; ++cb) {
        u32x4 wq, wk;
#pragma unroll
        for (int e = 0; e < 4; ++e) { wq[e] = pk2(qo[cb * 8 + 2 * e] * rq, qo[cb * 8 + 2 * e + 1] * rq); wk[e] = pk2(ko[cb * 8 + 2 * e] * rk, ko[cb * 8 + 2 * e + 1] * rk); }
        *(u32x4*)(qs + tok * 136 + part * 32 + cb * 8) = wq; *(u32x4*)(ks + tok * 136 + part * 32 + cb * 8) = wk;
      }
    }
    __syncthreads();
    {
      f32x4 akk[4], aqk[4];
#pragma unroll
      for (int nb = 0; nb < 4; ++nb) { akk[nb] = f32x4{0.f, 0.f, 0.f, 0.f}; aqk[nb] = f32x4{0.f, 0.f, 0.f, 0.f}; }
#pragma unroll
      for (int kk = 0; kk < 4; ++kk) {
        const bf16x8 ak = *(const bf16x8*)(ks + (16 * wid + fr) * 136 + kk * 32 + fq * 8);
        const bf16x8 aq = *(const bf16x8*)(qs + (16 * wid + fr) * 136 + kk * 32 + fq * 8);
#pragma unroll
        for (int nb = 0; nb < 4; ++nb) {
          const bf16x8 bk = *(const bf16x8*)(ks + (16 * nb + fr) * 136 + kk * 32 + fq * 8);
          akk[nb] = __builtin_amdgcn_mfma_f32_16x16x32_bf16(ak, bk, akk[nb], 0, 0, 0);
          aqk[nb] = __builtin_amdgcn_mfma_f32_16x16x32_bf16(aq, bk, aqk[nb], 0, 0, 0);
        }
      }
      u16* att = (u16*)(p.ws + OFF_GAT) + (size_t)it * 4096;
#pragma unroll
      for (int nb = 0; nb < 4; ++nb)
#pragma unroll
        for (int r = 0; r < 4; ++r) {
          const int i = 16 * wid + fq * 4 + r, j = 16 * nb + fr;
          const float dec = __expf(fminf(gcs[i] - gcs[j], 0.f));
          Lm[i * 64 + j] = (i > j) ? bts[i] * akk[nb][r] * dec : 0.f;
          att[i * 64 + j] = f2bf((i >= j) ? aqk[nb][r] * dec : 0.f);
        }
    }
    __syncthreads();
    {
      float x[64];
      if (tid < 128) {
        const int col = 1024 + h * 128 + tid;
        const u16* vp = proj + (size_t)2 * M * 512 + h * 128 + tid;
        const float w0 = p.hy_conv_w[col], w1 = p.hy_conv_w[1536 + col], w2 = p.hy_conv_w[2 * 1536 + col], w3 = p.hy_conv_w[3 * 1536 + col];
        float x1 = 0.f, x2 = 0.f, x3 = 0.f;
        if (n > 0) { x3 = bf2f(vp[(row0 - 3) * 512]); x2 = bf2f(vp[(row0 - 2) * 512]); x1 = bf2f(vp[(row0 - 1) * 512]); }
#pragma unroll
        for (int i = 0; i < 64; ++i) {
          const float xv = bf2f(vp[(row0 + i) * 512]);
          x[i] = silu_(w0 * x3 + w1 * x2 + w2 * x1 + w3 * xv) * bts[i];
          x3 = x2; x2 = x1; x1 = xv;
        }
      } else {
#pragma unroll
        for (int i = 0; i < 64; ++i) x[i] = bf2f(ks[i * 136 + tid - 128]) * bts[i] * egs[i];
      }
#pragma unroll
      for (int i = 1; i < 64; ++i) {
        float acc = x[i];
#pragma unroll
        for (int j4 = 0; j4 < (i + 3) / 4; ++j4) {
          const f32x4 l4 = *(const f32x4*)(Lm + i * 64 + j4 * 4);
#pragma unroll
          for (int e = 0; e < 4; ++e) if (j4 * 4 + e < i) acc -= l4[e] * x[j4 * 4 + e];
        }
        x[i] = acc;
      }
      if (tid < 128) {
        u16* ut = (u16*)(p.ws + OFF_GUT) + (size_t)it * 8192 + tid * 64;
#pragma unroll
        for (int c8 = 0; c8 < 8; ++c8) {
          u32x4 w;
#pragma unroll
          for (int e = 0; e < 4; ++e) w[e] = pk2(x[c8 * 8 + 2 * e], x[c8 * 8 + 2 * e + 1]);
          *(u32x4*)(ut + c8 * 8) = w;
        }
      } else {
        u16* wg = (u16*)(p.ws + OFF_GW) + (size_t)it * 8192 + (tid - 128);
#pragma unroll
        for (int i = 0; i < 64; ++i) wg[i * 128] = f2bf(x[i]);
      }
    }
    {
      u16* qd = (u16*)(p.ws + OFF_GQD) + (size_t)it * 8192;
#pragma unroll
      for (int k = 0; k < 4; ++k) {
        const int piece = tid + 256 * k, i = piece >> 4, d0 = (piece & 15) * 8;
        float f[8]; unpack8(*(const u32x4*)(qs + i * 136 + d0), f);
        const float e = egs[i];
        u32x4 w;
#pragma unroll
        for (int e2 = 0; e2 < 4; ++e2) w[e2] = pk2(f[2 * e2] * e, f[2 * e2 + 1] * e);
        *(u32x4*)(qd + i * 128 + d0) = w;
      }
      u16* kt = (u16*)(p.ws + OFF_GKT) + (size_t)it * 8192;
      const int dk = tid & 127, half = tid >> 7;
      const float gl = gcs[63];
#pragma unroll
      for (int c8 = 0; c8 < 4; ++c8) {
        u32x4 w;
#pragma unroll
        for (int e = 0; e < 4; ++e) {
          const int i0 = half * 32 + c8 * 8 + 2 * e;
          w[e] = pk2(bf2f(ks[i0 * 136 + dk]) * __expf(gl - gcs[i0]), bf2f(ks[(i0 + 1) * 136 + dk]) * __expf(gl - gcs[i0 + 1]));
        }
        *(u32x4*)(kt + dk * 64 + half * 32 + c8 * 8) = w;
      }
      if (tid == 0) ((float*)(p.ws + OFF_GSD))[it] = egs[63];
    }
    __syncthreads();
  }
}

__device__ __forceinline__ uint2 lds64(const char* p) { return *(const uint2*)p; }
__device__ __forceinline__ bf16x8 mk8(uint2 a, uint2 b) { u32x4 w = {a.x, a.y, b.x, b.y}; return __builtin_bit_cast(bf16x8, w); }
__device__ __forceinline__ bf16x8 pack8(const f32x16& x, int s) {
  u32x4 w = {pk2(x[8 * s], x[8 * s + 1]), pk2(x[8 * s + 2], x[8 * s + 3]), pk2(x[8 * s + 4], x[8 * s + 5]), pk2(x[8 * s + 6], x[8 * s + 7])};
  return __builtin_bit_cast(bf16x8, w);
}
__device__ __forceinline__ void gdn_scan_item(const Params& p, int bh, char* smem) {
  const int tid = otid(), wid = tid >> 6, lane = tid & 63, r32 = lane & 31, hi = lane >> 5;
  char* Wl = smem; char* KTl = smem + 16896;
  const char* gw = p.ws + OFF_GW; const char* gkt = p.ws + OFF_GKT;
  const u16* gut = (const u16*)(p.ws + OFF_GUT);
  const float* gsd = (const float*)(p.ws + OFF_GSD);
  u32x4* sbg = (u32x4*)(p.ws + OFF_PROJ); u32x4* vbg = (u32x4*)(p.ws + OFF_PROJ + (size_t)2048 * 32768);
  f32x16 S[4];
#pragma unroll
  for (int T = 0; T < 4; ++T)
#pragma unroll
    for (int r = 0; r < 16; ++r) S[T][r] = 0.f;
  u32x4 sa[8], sb_[8]; uint2 uc[8];
  const int dv = wid * 32 + r32;
#define G_LOAD(ST, IT) do { const size_t o16 = (size_t)(IT) * 16384; \
    _Pragma("unroll") for (int k = 0; k < 4; ++k) { ST[k] = *(const u32x4*)(gw + o16 + (tid + 256 * k) * 16); ST[4 + k] = *(const u32x4*)(gkt + o16 + (tid + 256 * k) * 16); } } while (0)
#define U_LOAD(IT) do { _Pragma("unroll") for (int k = 0; k < 8; ++k) uc[k] = *(const uint2*)(gut + (size_t)(IT) * 8192 + dv * 64 + 32 * (k >> 2) + 8 * (k & 3) + 4 * hi); } while (0)
#define G_WRITE(ST) do { \
    _Pragma("unroll") for (int k = 0; k < 4; ++k) { const int pc = tid + 256 * k; \
      { char* d = Wl + (pc >> 4) * 264 + (pc & 15) * 16; *(uint2*)d = uint2{ST[k][0], ST[k][1]}; *(uint2*)(d + 8) = uint2{ST[k][2], ST[k][3]}; } \
      { char* d = KTl + (pc >> 3) * 136 + (pc & 7) * 16; *(uint2*)d = uint2{ST[4 + k][0], ST[4 + k][1]}; *(uint2*)(d + 8) = uint2{ST[4 + k][2], ST[4 + k][3]}; } } } while (0)
#define SCAN_STEP(N, NXT, FAR) do { const int n = (N); const int item = bh * 128 + n; \
    const float sd_nxt = gsd[item + (n + 1 < 128 ? 1 : 0)]; \
    if (n + 2 < 128) G_LOAD(FAR, item + 2); \
    f32x16 av[2]; \
    _Pragma("unroll") for (int r = 0; r < 16; ++r) { av[0][r] = 0.f; av[1][r] = 0.f; } \
    _Pragma("unroll") for (int T = 0; T < 4; ++T) \
      _Pragma("unroll") for (int s = 0; s < 2; ++s) { \
        const bf16x8 sb = pack8(S[T], s); \
        sbg[((size_t)(item * 4 + wid) * 8 + T * 2 + s) * 64 + lane] = __builtin_bit_cast(u32x4, sb); \
        const int cb = (32 * T + 16 * s + 4 * hi) * 2; \
        _Pragma("unroll") for (int it = 0; it < 2; ++it) { \
          const char* wp = Wl + (32 * it + r32) * 264 + cb; \
          av[it] = __builtin_amdgcn_mfma_f32_32x32x16_bf16(mk8(lds64(wp), lds64(wp + 16)), sb, av[it], 0, 0, 0); } } \
    bf16x8 vb[2][2]; \
    _Pragma("unroll") for (int it = 0; it < 2; ++it) { \
      f32x16 vn; \
      _Pragma("unroll") for (int g = 0; g < 4; ++g) { const uint2 u2 = uc[it * 4 + g]; \
        vn[4 * g] = __uint_as_float(u2.x << 16) - av[it][4 * g]; vn[4 * g + 1] = __uint_as_float(u2.x & 0xffff0000u) - av[it][4 * g + 1]; \
        vn[4 * g + 2] = __uint_as_float(u2.y << 16) - av[it][4 * g + 2]; vn[4 * g + 3] = __uint_as_float(u2.y & 0xffff0000u) - av[it][4 * g + 3]; } \
      vb[it][0] = pack8(vn, 0); vb[it][1] = pack8(vn, 1); \
      vbg[((size_t)(item * 4 + wid) * 4 + it * 2) * 64 + lane] = __builtin_bit_cast(u32x4, vb[it][0]); \
      vbg[((size_t)(item * 4 + wid) * 4 + it * 2 + 1) * 64 + lane] = __builtin_bit_cast(u32x4, vb[it][1]); } \
    if (n + 1 < 128) U_LOAD(item + 1); \
    _Pragma("unroll") for (int T = 0; T < 4; ++T) { \
      _Pragma("unroll") for (int r = 0; r < 16; ++r) S[T][r] *= sd_cur; \
      _Pragma("unroll") for (int it = 0; it < 2; ++it) \
        _Pragma("unroll") for (int s = 0; s < 2; ++s) { \
          const char* kp = KTl + (32 * T + r32) * 136 + (32 * it + 16 * s + 4 * hi) * 2; \
          S[T] = __builtin_amdgcn_mfma_f32_32x32x16_bf16(mk8(lds64(kp), lds64(kp + 16)), vb[it][s], S[T], 0, 0, 0); } } \
    sd_cur = sd_nxt; \
    __syncthreads(); \
    if (n + 1 < 128) G_WRITE(NXT); \
    __syncthreads(); } while (0)
  float sd_cur = gsd[bh * 128];
  G_LOAD(sa, bh * 128); U_LOAD(bh * 128); G_WRITE(sa);
  G_LOAD(sb_, bh * 128 + 1);
  __syncthreads();
#pragma unroll 1
  for (int n2 = 0; n2 < 128; n2 += 2) {
    SCAN_STEP(n2, sb_, sa);
    SCAN_STEP(n2 + 1, sa, sb_);
  }
#undef SCAN_STEP
#undef G_LOAD
#undef G_WRITE
#undef U_LOAD
}

__device__ __forceinline__ void gdn_out_phase(const Params& p, char* smem, int bid, int nblk) {
  const int tid = otid(), wid = tid >> 6, lane = tid & 63, r32 = lane & 31, hi = lane >> 5;
  char* QDl = smem; char* ATl = smem + 16896; float* Ol = (float*)(smem + 16896 + 8704);
  const char* gqd = p.ws + OFF_GQD; const char* gat = p.ws + OFF_GAT;
  const u32x4* sbg = (const u32x4*)(p.ws + OFF_PROJ); const u32x4* vbg = (const u32x4*)(p.ws + OFF_PROJ + (size_t)2048 * 32768);
  const u16* zb = (const u16*)(p.ws + OFF_PROJ) + (size_t)3 * M * 512;
  u16* concat = (u16*)(p.ws + OFF_HN);
#pragma unroll 1
  for (int item = bid; item < 2048; item += nblk) {
    const int n = item & 127, bh = item >> 7, b = bh >> 2, h = bh & 3;
    {
      u32x4 st[6];
#pragma unroll
      for (int k = 0; k < 4; ++k) st[k] = *(const u32x4*)(gqd + (size_t)item * 16384 + (tid + 256 * k) * 16);
#pragma unroll
      for (int k = 0; k < 2; ++k) st[4 + k] = *(const u32x4*)(gat + (size_t)item * 8192 + (tid + 256 * k) * 16);
#pragma unroll
      for (int k = 0; k < 4; ++k) { const int pc = tid + 256 * k; char* d = QDl + (pc >> 4) * 264 + (pc & 15) * 16;
        *(uint2*)d = uint2{st[k][0], st[k][1]}; *(uint2*)(d + 8) = uint2{st[k][2], st[k][3]}; }
#pragma unroll
      for (int k = 0; k < 2; ++k) { const int pc = tid + 256 * k; char* d = ATl + (pc >> 3) * 136 + (pc & 7) * 16;
        *(uint2*)d = uint2{st[4 + k][0], st[4 + k][1]}; *(uint2*)(d + 8) = uint2{st[4 + k][2], st[4 + k][3]}; }
    }
    bf16x8 sb[8], vb[4];
#pragma unroll
    for (int f = 0; f < 8; ++f) sb[f] = __builtin_bit_cast(bf16x8, sbg[((size_t)(item * 4 + wid) * 8 + f) * 64 + lane]);
#pragma unroll
    for (int f = 0; f < 4; ++f) vb[f] = __builtin_bit_cast(bf16x8, vbg[((size_t)(item * 4 + wid) * 4 + f) * 64 + lane]);
    __syncthreads();
    f32x16 ao[2];
#pragma unroll
    for (int r = 0; r < 16; ++r) { ao[0][r] = 0.f; ao[1][r] = 0.f; }
#pragma unroll
    for (int T = 0; T < 4; ++T)
#pragma unroll
      for (int s = 0; s < 2; ++s) {
        const int cb = (32 * T + 16 * s + 4 * hi) * 2;
#pragma unroll
        for (int it = 0; it < 2; ++it) {
          const char* qp = QDl + (32 * it + r32) * 264 + cb;
          ao[it] = __builtin_amdgcn_mfma_f32_32x32x16_bf16(mk8(lds64(qp), lds64(qp + 16)), sb[T * 2 + s], ao[it], 0, 0, 0);
        }
      }
#pragma unroll
    for (int it2 = 0; it2 < 2; ++it2)
#pragma unroll
      for (int it = 0; it <= it2; ++it)
#pragma unroll
        for (int s = 0; s < 2; ++s) {
          const char* ap = ATl + (32 * it2 + r32) * 136 + (32 * it + 16 * s + 4 * hi) * 2;
          ao[it2] = __builtin_amdgcn_mfma_f32_32x32x16_bf16(mk8(lds64(ap), lds64(ap + 16)), vb[it * 2 + s], ao[it2], 0, 0, 0);
        }
#pragma unroll
    for (int it = 0; it < 2; ++it)
#pragma unroll
      for (int r = 0; r < 16; ++r) Ol[(32 * it + crow(r, hi)) * 132 + wid * 32 + r32] = ao[it][r];
    __syncthreads();
    {
      const int tok = tid >> 2, part = tid & 3;
      const int row = b * SEQ + n * 64 + tok;
      f32x4 a[8]; float ss = 0.f;
#pragma unroll
      for (int k = 0; k < 8; ++k) { a[k] = *(const f32x4*)(Ol + tok * 132 + part * 32 + k * 4); ss += a[k][0] * a[k][0] + a[k][1] * a[k][1] + a[k][2] * a[k][2] + a[k][3] * a[k][3]; }
      ss += __shfl_xor(ss, 1); ss += __shfl_xor(ss, 2);
      const float rs = rsqrtf(ss * (1.f / 128.f) + 1e-6f);
      const u16* zp = zb + (size_t)row * 512 + h * 128 + part * 32;
      const float* hw = p.hy_head_norm_w + part * 32;
      u16* cp = concat + a_off(row, h * 128 + part * 32, 32);
#pragma unroll
      for (int k = 0; k < 4; ++k) {
        float zf[8]; unpack8(*(const u32x4*)(zp + k * 8), zf);
        const f32x4 h0 = *(const f32x4*)(hw + k * 8), h1 = *(const f32x4*)(hw + k * 8 + 4);
        const f32x4 x0 = a[2 * k], x1 = a[2 * k + 1];
        u32x4 w;
        w[0] = pk2(x0[0] * rs * h0[0] * silu_(zf[0]), x0[1] * rs * h0[1] * silu_(zf[1]));
        w[1] = pk2(x0[2] * rs * h0[2] * silu_(zf[2]), x0[3] * rs * h0[3] * silu_(zf[3]));
        w[2] = pk2(x1[0] * rs * h1[0] * silu_(zf[4]), x1[1] * rs * h1[1] * silu_(zf[5]));
        w[3] = pk2(x1[2] * rs * h1[2] * silu_(zf[6]), x1[3] * rs * h1[3] * silu_(zf[7]));
        *(u32x4*)(cp + k * 8) = w;
      }
    }
    __syncthreads();
  }
}

using s16x4 = __attribute__((ext_vector_type(4))) short;
#define KSWZ(row, colB) ((row) * 256 + ((colB) ^ (((row) & 7) << 4)))
#define SBAR() __builtin_amdgcn_sched_barrier(0)
__device__ __forceinline__ unsigned cvtpk(float lo, float hi) { unsigned r; asm volatile("v_cvt_pk_bf16_f32 %0, %1, %2" : "=v"(r) : "v"(lo), "v"(hi)); return r; }
__device__ __forceinline__ int v_st(int k, int c) { const int kk = (k & ~0xC) | ((k & 4) << 1) | ((k & 8) >> 1); return ((kk >> 3) * 4 + (c >> 5)) * 512 + ((kk & 7) * 32 + (c & 31)) * 2; }
__device__ __forceinline__ int v_rd_base(int lane) { return ((lane & 3) << 3) | (((lane >> 2) & 3) << 6) | (((lane >> 4) & 1) << 5) | (((lane >> 5) & 1) << 8); }
constexpr int v_rd_off(int d0, int ks, int half) { return d0 * 512 + ks * 4096 + half * 2048; }
template <int OFF> __device__ __forceinline__ s16x4 tr_read(int vb) {
  s16x4 r; asm volatile("ds_read_b64_tr_b16 %0, %1 offset:%2" : "=&v"(r) : "v"(vb), "i"(OFF) : "memory"); return r;
}
template <int D0> __device__ __forceinline__ void pv_one(f32x16& od, int vb, bf16x8 pa0, bf16x8 pa1, bf16x8 pa2, bf16x8 pa3) {
  const s16x4 l0 = tr_read<v_rd_off(D0, 0, 0)>(vb), h0 = tr_read<v_rd_off(D0, 0, 1)>(vb), l1 = tr_read<v_rd_off(D0, 1, 0)>(vb), h1 = tr_read<v_rd_off(D0, 1, 1)>(vb);
  const s16x4 l2 = tr_read<v_rd_off(D0, 2, 0)>(vb), h2 = tr_read<v_rd_off(D0, 2, 1)>(vb), l3 = tr_read<v_rd_off(D0, 3, 0)>(vb), h3 = tr_read<v_rd_off(D0, 3, 1)>(vb);
  asm volatile("s_waitcnt lgkmcnt(0)" ::: "memory"); SBAR();
#define PK(L, H) (bf16x8){L[0], L[1], L[2], L[3], H[0], H[1], H[2], H[3]}
  od = __builtin_amdgcn_mfma_f32_32x32x16_bf16(pa0, PK(l0, h0), od, 0, 0, 0);
  od = __builtin_amdgcn_mfma_f32_32x32x16_bf16(pa1, PK(l1, h1), od, 0, 0, 0);
  od = __builtin_amdgcn_mfma_f32_32x32x16_bf16(pa2, PK(l2, h2), od, 0, 0, 0);
  od = __builtin_amdgcn_mfma_f32_32x32x16_bf16(pa3, PK(l3, h3), od, 0, 0, 0);
#undef PK
}
__device__ __forceinline__ float pl32_other(float a, float b, int hi) {
  auto rr = __builtin_amdgcn_permlane32_swap(__float_as_uint(a), __float_as_uint(b), false, false);
  return __uint_as_float(hi ? rr[0] : rr[1]);
}
__device__ __forceinline__ void sb_half(f32x16& pz, float& run, bool need_mask, int kb, int t, int hi) {
  constexpr float C2 = 0.08838834764831845f * 1.4426950408889634f;
  f32x16 l;
#pragma unroll
  for (int r = 0; r < 16; ++r) {
    const float e = __builtin_amdgcn_exp2f(fminf(pz[r] * C2, 60.f));
    l[r] = __builtin_amdgcn_rcpf(1.f + e);
    pz[r] = e;
  }
  if (need_mask) {
#pragma unroll
    for (int r = 0; r < 16; ++r) { if (kb + crow(r, hi) >= t) { l[r] = 1.f; pz[r] = 0.f; } }
  }
#pragma unroll
  for (int g = 0; g < 4; ++g) { l[4 * g + 2] *= l[4 * g + 3]; l[4 * g + 1] *= l[4 * g + 2]; l[4 * g] *= l[4 * g + 1]; }
  const float cs3 = l[12], cs2 = l[8] * cs3, cs1 = l[4] * cs2, cs0 = l[0] * cs1;
  const float off0 = cs1 * pl32_other(cs0, cs1, hi) * run;
  const float off1 = cs2 * pl32_other(cs1, cs2, hi) * run;
  const float off2 = cs3 * pl32_other(cs2, cs3, hi) * run;
  const float off3 = pl32_other(cs3, 1.f, hi) * run;
  float tot;
  { auto rr = __builtin_amdgcn_permlane32_swap(__float_as_uint(cs0), __float_as_uint(cs0), false, false); tot = __uint_as_float(rr[0]) * __uint_as_float(rr[1]); }
#pragma unroll
  for (int r = 0; r < 4; ++r) {
    pz[r] = pz[r] * l[r] * off0; pz[4 + r] = pz[4 + r] * l[4 + r] * off1;
    pz[8 + r] = pz[8 + r] * l[8 + r] * off2; pz[12 + r] = pz[12 + r] * l[12 + r] * off3;
  }
  run *= tot;
}

__device__ __forceinline__ void attn_phase(const Params& p, char* smem, int bid, int nblk) {
  const int tid = otid(), wid = tid >> 6, lane = tid & 63, r32 = lane & 31, hi = lane >> 5;
  char* K_lds = smem; char* V_lds = smem + 16384;
  const u16* qkv = (const u16*)(p.ws + OFF_PROJ);
  u16* ao = (u16*)(p.ws + OFF_HN);
  const int sr = tid >> 4, sc = (tid & 15) * 8;
  const int vb0 = (int)(uintptr_t)V_lds + v_rd_base(lane);
  for (int k = 0; k * nblk < 2048; ++k) {
    const int i = (k & 1) ? ((k + 1) * nblk - 1 - bid) : (k * nblk + bid);
    if (i >= 2048) continue;
    const int j = 63 - (i >> 5), bh = i & 31, b = bh >> 3, h = bh & 7;
    const int i0 = j * 128;
    const size_t rowb = (size_t)b * SEQ;
    const int t = i0 + wid * 32 + r32, tmin = i0 + wid * 32, tmax = tmin + 31;
    bf16x8 qr[8];
    {
      const u16* qp = qkv + (rowb + t) * 3072 + h * 128 + hi * 8;
#pragma unroll
      for (int d0 = 0; d0 < 8; ++d0) qr[d0] = *(const bf16x8*)(qp + d0 * 16);
    }
    f32x16 o[4];
#pragma unroll
    for (int d = 0; d < 4; ++d)
#pragma unroll
      for (int r = 0; r < 16; ++r) o[d][r] = 0.f;
    float run = 1.f;
    const u16* kbase = qkv + rowb * 3072 + 1024 + h * 128 + sc;
    u32x4 stk[4], stv[4];
#define SLOAD(KT) do { _Pragma("unroll") for (int ii = 0; ii < 4; ++ii) { const u16* kp = kbase + (size_t)((KT) * 64 + sr + 16 * ii) * 3072; \
      stk[ii] = *(const u32x4*)kp; stv[ii] = *(const u32x4*)(kp + 1024); } } while (0)
#define SWRITE() do { _Pragma("unroll") for (int ii = 0; ii < 4; ++ii) { const int row = sr + 16 * ii; \
      *(u32x4*)(K_lds + KSWZ(row, sc * 2)) = stk[ii]; *(u32x4*)(V_lds + v_st(row, sc)) = stv[ii]; } } while (0)
    const int NT = 2 * j + 2;
    SLOAD(NT - 1); SWRITE(); __syncthreads();
    for (int kt = NT - 1; kt >= 0; --kt) {
      const int k0 = kt * 64;
      if (kt > 0) SLOAD(kt - 1);
      if (k0 <= tmax) {
        bf16x8 pa0, pa1, pa2, pa3;
#define PK4(P, BASE, OUT) do { unsigned a0 = cvtpk(P[BASE + 0], P[BASE + 1]), a1 = cvtpk(P[BASE + 2], P[BASE + 3]); \
    unsigned b0_ = cvtpk(P[BASE + 4], P[BASE + 5]), b1_ = cvtpk(P[BASE + 6], P[BASE + 7]); \
    auto r0 = __builtin_amdgcn_permlane32_swap(a0, b0_, false, false); auto r1 = __builtin_amdgcn_permlane32_swap(a1, b1_, false, false); \
    u32x4 w = {r0[0], r1[0], r0[1], r1[1]}; OUT = *reinterpret_cast<bf16x8*>(&w); } while (0)
        if (k0 + 32 <= tmax) {
          f32x16 pz;
#pragma unroll
          for (int r = 0; r < 16; ++r) pz[r] = 0.f;
#pragma unroll
          for (int d0 = 0; d0 < 8; ++d0) {
            const bf16x8 kf = *(const bf16x8*)(K_lds + KSWZ(32 + r32, (d0 * 16 + hi * 8) * 2));
            pz = __builtin_amdgcn_mfma_f32_32x32x16_bf16(kf, qr[d0], pz, 0, 0, 0);
          }
          sb_half(pz, run, k0 + 63 >= tmin, k0 + 32, t, hi);
          PK4(pz, 0, pa2); PK4(pz, 8, pa3);
        } else {
          pa2 = bf16x8{0, 0, 0, 0, 0, 0, 0, 0}; pa3 = pa2;
        }
        {
          f32x16 pz;
#pragma unroll
          for (int r = 0; r < 16; ++r) pz[r] = 0.f;
#pragma unroll
          for (int d0 = 0; d0 < 8; ++d0) {
            const bf16x8 kf = *(const bf16x8*)(K_lds + KSWZ(r32, (d0 * 16 + hi * 8) * 2));
            pz = __builtin_amdgcn_mfma_f32_32x32x16_bf16(kf, qr[d0], pz, 0, 0, 0);
          }
          sb_half(pz, run, k0 + 31 >= tmin, k0, t, hi);
          PK4(pz, 0, pa0); PK4(pz, 8, pa1);
        }
#undef PK4
        pv_one<0>(o[0], vb0, pa0, pa1, pa2, pa3); pv_one<1>(o[1], vb0, pa0, pa1, pa2, pa3);
        pv_one<2>(o[2], vb0, pa0, pa1, pa2, pa3); pv_one<3>(o[3], vb0, pa0, pa1, pa2, pa3);
      }
      __syncthreads();
      if (kt > 0) SWRITE();
      __syncthreads();
    }
#undef SLOAD
#undef SWRITE
    {
      const int orow0 = (int)rowb + i0 + wid * 32;
#pragma unroll
      for (int r = 0; r < 16; ++r) {
        const int orow = crow(r, hi);
#pragma unroll
        for (int d0 = 0; d0 < 4; ++d0) ao[a_off(orow0 + orow, h * 128 + d0 * 32 + r32, 32)] = f2bf(o[d0][r]);
      }
    }
  }
}

#define XB_TMO      128
#define XB_XCNT(j)  (256  + 64 * (j))
#define XB_XSUB(j)  (1280 + 64 * (j))
#define XB_XGEN(j)  (2304 + 64 * (j))
#define XB_TOP      3328
#define XB_TOPGEN   3392
#define XCD_BAR_WORDS 3456
#define XB_SPIN_CAP (1u << 23)
#define LAS __attribute__((address_space(3)))
__device__ __forceinline__ unsigned xb_ld(unsigned* p)              { return __hip_atomic_load(p, __ATOMIC_RELAXED, __HIP_MEMORY_SCOPE_AGENT); }
__device__ __forceinline__ unsigned xb_add(unsigned* p, unsigned v) { return __hip_atomic_fetch_add(p, v, __ATOMIC_RELAXED, __HIP_MEMORY_SCOPE_AGENT); }
__device__ __forceinline__ unsigned xb_xcc_id() { return (unsigned)__builtin_amdgcn_s_getreg((3 << 11) | 20) & 0xFu; }
#define XB_SPIN(cond, bar) do { unsigned _sp = 0; while (cond) { __builtin_amdgcn_s_sleep(1); \
    if ((++_sp & 255u) == 0u) { if (xb_ld(&(bar)[XB_TMO])) break; if (_sp > XB_SPIN_CAP) { atomicAdd(&(bar)[XB_TMO], 1u); break; } } } } while (0)
struct XcdBarrier { unsigned* bar; unsigned x; volatile LAS unsigned* st; };
__device__ __forceinline__ XcdBarrier xcd_barrier_post(unsigned* bar, volatile LAS unsigned* st) {
  XcdBarrier b; b.bar = bar; b.x = xb_xcc_id(); b.st = st;
  if (__builtin_amdgcn_workitem_id_x() == 0) (void)xb_add(&bar[XB_XCNT(b.x)], 1u);
  return b;
}
__device__ __forceinline__ void xcd_barrier_complete(unsigned* bar, unsigned x, unsigned& nloc, unsigned& nx) {
  const unsigned G = gridDim.x * gridDim.y * gridDim.z;
  unsigned sum, cnt, mine, sp = 0u;
  for (;;) {
    sum = 0u; cnt = 0u; mine = 0u;
#pragma unroll
    for (unsigned j = 0; j < 16; ++j) { const unsigned c = xb_ld(&bar[XB_XCNT(j)]); sum += c; cnt += (c > 0u) ? 1u : 0u; mine = (j == x) ? c : mine; }
    if (sum == G) break;
    __builtin_amdgcn_s_sleep(1);
    if ((++sp & 255u) == 0u) { if (xb_ld(&bar[XB_TMO])) break; if (sp > XB_SPIN_CAP) { atomicAdd(&bar[XB_TMO], 1u); break; } }
  }
  nloc = mine > 0u ? mine : 1u; nx = cnt > 0u ? cnt : 1u;
}
__device__ __forceinline__ void xcd_barrier(const XcdBarrier& b) {
  asm volatile("s_waitcnt vmcnt(0)" ::: "memory");
  __syncthreads();
  if (__builtin_amdgcn_workitem_id_x() == 0) {
    unsigned* bar = b.bar;
    __builtin_amdgcn_s_waitcnt(0);
    unsigned nloc = b.st[0], nx = b.st[1];
    if (nloc == 0u) { xcd_barrier_complete(bar, b.x, nloc, nx); b.st[0] = nloc; b.st[1] = nx; }
    const unsigned old = xb_add(&bar[XB_XSUB(b.x)], 1u);
    const unsigned gen = old / nloc;
    if (old + 1u == (gen + 1u) * nloc) {
      __builtin_amdgcn_fence(__ATOMIC_RELEASE, "agent");
      asm volatile("s_waitcnt vmcnt(0)" ::: "memory");
      const unsigned og = xb_add(&bar[XB_TOP], 1u);
      const unsigned tg = og / nx;
      if (og + 1u == (tg + 1u) * nx) xb_add(&bar[XB_TOPGEN], 1u);
      else XB_SPIN(xb_ld(&bar[XB_TOPGEN]) == tg, bar);
      __builtin_amdgcn_fence(__ATOMIC_ACQUIRE, "agent");
      xb_add(&bar[XB_XGEN(b.x)], 1u);
      asm volatile("s_waitcnt vmcnt(0)" ::: "memory");
    } else {
      XB_SPIN(xb_ld(&bar[XB_XGEN(b.x)]) == gen, bar);
      __builtin_amdgcn_fence(__ATOMIC_ACQUIRE, "agent");
      asm volatile("s_waitcnt vmcnt(0)" ::: "memory");
    }
  }
  __syncthreads();
}

__global__ void __launch_bounds__(256, 2) mega(Params p) {
  __shared__ __attribute__((aligned(16))) char smem[SMEM_BYTES];
  __shared__ uint4 xb_words;
  const int bid = blockIdx.x, nblk = gridDim.x;
  char* ws = p.ws;
  if (__builtin_amdgcn_workitem_id_x() == 0) xb_words = make_uint4(0u, 0u, 0u, 0u);
  __syncthreads();
  const XcdBarrier xbar = xcd_barrier_post((unsigned*)(ws + OFF_BAR), (volatile LAS unsigned*)&xb_words);
  const float* mod = (const float*)(ws + OFF_MOD);
  u16* hn = (u16*)(ws + OFF_HN);
#define PH_BEGIN(n) if (p.phase_lo <= (n) && (n) < p.phase_hi) {
#define PH_END(n) if ((n) + 1 < p.phase_hi) { if ((n) == 0) cg::this_grid().sync(); else xcd_barrier(xbar); } }
  PH_BEGIN(0) phase0(p, smem, bid, nblk); PH_END(0)
  PH_BEGIN(1) norm_phase<1>(p, p.x, p.norm_mix_w, mod, 0, 1024, smem, bid, nblk); PH_END(1)
  PH_BEGIN(2) { EpiArgs ea{}; ea.outb = (u16*)(ws + OFF_PROJ); ea.ux = (u16*)(ws + OFF_UX);
        gemm_phase<E_PROJ0>(hn, 32, 0, (const u16*)(ws + OFF_WT_HYIN), 32, 0, 1024, M / 256, PN / 128, 1, ea, smem, bid, nblk); } PH_END(2)
  PH_BEGIN(3) { EpiArgs ea{}; ea.outf = (float*)(ws + OFF_XE);
        gemm_phase<E_XE>((const u16*)(ws + OFF_UX), 20, (size_t)S5C * UXW, (const u16*)(ws + OFF_EG), 16, (size_t)128 * 512, 512, S5C / 256, 1, 32, ea, smem, bid, nblk); } PH_END(3)
  PH_BEGIN(4) { s5_carry_phase(p, bid, nblk); gdn_prep_phase(p, smem, bid, nblk); } PH_END(4)
  PH_BEGIN(5) {
        if (bid < 16) { gdn_scan_item(p, bid, smem); }
        else { EpiArgs ea{}; ea.outb = (u16*)(ws + OFF_Y5); ea.ux = (u16*)(ws + OFF_UX); ea.bias = p.s5_d;
          gemm_phase<E_S5Y>((const u16*)(ws + OFF_UX), 20, (size_t)S5C * UXW, (const u16*)(ws + OFF_MF), 20, (size_t)512 * UXW, UXW, S5C / 256, 4, 32, ea, smem, bid - 16, nblk - 16); }
      } PH_END(5)
  PH_BEGIN(6) { gdn_out_phase(p, smem, bid, nblk); __syncthreads();
 EpiArgs ea{}; ea.outb = hn; ea.y5 = (const u16*)(ws + OFF_Y5); ea.bias = p.s5_glu_b;
        gemm_phase<E_GLU>((const u16*)(ws + OFF_Y5), 16, 0, (const u16*)(ws + OFF_WT_GLU), 16, 0, 512, M / 256, 4, 1, ea, smem, bid, nblk); } PH_END(6)
  PH_BEGIN(8) { EpiArgs ea{}; ea.outf = p.out; ea.res = p.x; ea.gate = mod + 2048;
        gemm_phase<E_RESID>(hn, 32, 0, (const u16*)(ws + OFF_WT_HYOUT), 32, 0, 1024, M / 256, 8, 1, ea, smem, bid, nblk); } PH_END(8)
  PH_BEGIN(9) norm_phase<0>(p, p.out, p.norm_ffn_w, mod, 3072, 4096, smem, bid, nblk); PH_END(9)
  PH_BEGIN(10) { EpiArgs ea{}; ea.outb = (u16*)(ws + OFF_PROJ);
        gemm_phase<E_SWIGLU>(hn, 32, 0, (const u16*)(ws + OFF_WT_FFNIN), 32, 0, 1024, M / 256, 2 * FF / 128, 1, ea, smem, bid, nblk); } PH_END(10)
  PH_BEGIN(11) { EpiArgs ea{}; ea.outf = p.out; ea.res = p.out; ea.gate = mod + 5120;
        gemm_phase<E_RESID>((const u16*)(ws + OFF_PROJ), FF / 32, 0, (const u16*)(ws + OFF_WT_FFNOUT), FF / 32, 0, FF, M / 256, 8, 1, ea, smem, bid, nblk); } PH_END(11)
  PH_BEGIN(12) norm_phase<0>(p, p.out, p.norm_mix_w + 1024, mod + 4 * 6144, 0, 1024, smem, bid, nblk); PH_END(12)
  PH_BEGIN(13) { EpiArgs ea{}; ea.outb = (u16*)(ws + OFF_PROJ); ea.ldc = 3072;
        gemm_phase<E_BF16>(hn, 32, 0, (const u16*)(ws + OFF_WT_SBIN), 32, 0, 1024, M / 256, 24, 1, ea, smem, bid, nblk); } PH_END(13)
  PH_BEGIN(14) attn_phase(p, smem, bid, nblk); PH_END(14)
  PH_BEGIN(15) { EpiArgs ea{}; ea.outf = p.out; ea.res = p.out; ea.gate = mod + 4 * 6144 + 2048;
        gemm_phase<E_RESID>(hn, 32, 0, (const u16*)(ws + OFF_WT_SBOUT), 32, 0, 1024, M / 256, 8, 1, ea, smem, bid, nblk); } PH_END(15)
  PH_BEGIN(16) norm_phase<0>(p, p.out, p.norm_ffn_w + 1024, mod + 4 * 6144, 3072, 4096, smem, bid, nblk); PH_END(16)
  PH_BEGIN(17) { EpiArgs ea{}; ea.outb = (u16*)(ws + OFF_PROJ);
        gemm_phase<E_SWIGLU>(hn, 32, 0, (const u16*)(ws + OFF_WT_FFNIN + SZ_WT_FFNIN), 32, 0, 1024, M / 256, 2 * FF / 128, 1, ea, smem, bid, nblk); } PH_END(17)
  PH_BEGIN(18) { EpiArgs ea{}; ea.outf = p.out; ea.res = p.out; ea.gate = mod + 4 * 6144 + 5120;
        gemm_phase<E_RESID>((const u16*)(ws + OFF_PROJ), FF / 32, 0, (const u16*)(ws + OFF_WT_FFNOUT + SZ_WT_FFNOUT), FF / 32, 0, FF, M / 256, 8, 1, ea, smem, bid, nblk); } PH_END(18)
  PH_BEGIN(19) norm_phase<2>(p, p.out, p.final_norm_w, mod, 0, 0, smem, bid, nblk); PH_END(19)
}

extern "C" void kernel_launch(void* const* d_in, const int* in_sizes, int n_in, void* d_out, int out_size, void* d_ws, size_t ws_size,
                              hipStream_t stream) {
  static int grid_blocks = 0;
  if (!grid_blocks) {
    int dev = 0, cus = 0, per_cu = 0;
    hipGetDevice(&dev);
    hipDeviceGetAttribute(&cus, hipDeviceAttributeMultiprocessorCount, dev);
    hipOccupancyMaxActiveBlocksPerMultiprocessor(&per_cu, mega, 256, 0);
    if (per_cu > 2) per_cu = 2;
    if (per_cu < 1) per_cu = 1;
    grid_blocks = cus * per_cu;
  }
  Params p{};
  const float* const* in = (const float* const*)d_in;
  p.x = in[0]; p.c = in[1]; p.ada_w = in[2]; p.ada_b = in[3]; p.norm_mix_w = in[4]; p.norm_ffn_w = in[5]; p.ffn_w_in = in[6]; p.ffn_w_out = in[7];
  p.hy_w_in = in[8]; p.hy_conv_w = in[9]; p.hy_a_log = in[10]; p.hy_dt_bias = in[11]; p.hy_head_norm_w = in[12];
  p.s5_lam_re = in[13]; p.s5_lam_im = in[14]; p.s5_log_dt = in[15]; p.s5_b_re = in[16]; p.s5_b_im = in[17]; p.s5_c_re = in[18]; p.s5_c_im = in[19];
  p.s5_d = in[20]; p.s5_glu_w = in[21]; p.s5_glu_b = in[22]; p.hy_w_out = in[23]; p.sb_w_in = in[24]; p.sb_w_out = in[25]; p.final_norm_w = in[26];
  p.out = (float*)d_out; p.ws = (char*)d_ws;
#if ONE_LAUNCH
  p.phase_lo = 0; p.phase_hi = NPHASE;
  (void)hipMemsetAsync((char*)d_ws + OFF_BAR, 0, (size_t)XCD_BAR_WORDS_C * 4, stream);
  void* args[] = {&p};
  hipError_t e = hipLaunchCooperativeKernel((void*)mega, dim3(grid_blocks), dim3(256), args, 0, stream);
  if (e != hipSuccess) fprintf(stderr, "cooperative launch failed: %s (grid %d)\n", hipGetErrorString(e), grid_blocks);
#else
  for (int ph = 0; ph < NPHASE; ++ph) {
    p.phase_lo = ph; p.phase_hi = ph + 1;
    hipLaunchKernelGGL(mega, dim3(grid_blocks), dim3(256), 0, stream, p);
  }
#endif
}
```

```cpp
#include <hip/hip_runtime.h>
#include <hip/hip_cooperative_groups.h>
#include <stdint.h>
#include <cstdio>
namespace cg = cooperative_groups;

#ifndef ONE_LAUNCH
#define ONE_LAUNCH 1
#endif

typedef unsigned short u16;
using bf16x8 = __attribute__((ext_vector_type(8))) short;
using f32x4 = __attribute__((ext_vector_type(4))) float;
using u32x4 = __attribute__((ext_vector_type(4))) unsigned;

constexpr int D = 1024, NB = 4, SEQ = 8192, M = NB * SEQ, FF = 2816, EIN = 2568, PN = 2560, PJ = 2048;
constexpr int NPHASE = 20;
constexpr int XCD_BAR_WORDS_C = 3456;
constexpr int S5T = 32, S5C = M / S5T, UXW = 640;

constexpr size_t SZ_WT_HYIN = (size_t)PN * 1024 * 2, SZ_WT_SQ = (size_t)1024 * 1024 * 2, SZ_WT_GLU = (size_t)512 * 512 * 2;
constexpr size_t SZ_WT_FFNIN = (size_t)2 * FF * 1024 * 2, SZ_WT_FFNOUT = (size_t)1024 * FF * 2, SZ_WT_SBIN = (size_t)3072 * 1024 * 2;
constexpr size_t OFF_WT_HYIN = 0;
constexpr size_t OFF_WT_HYOUT = OFF_WT_HYIN + SZ_WT_HYIN;
constexpr size_t OFF_WT_GLU = OFF_WT_HYOUT + SZ_WT_SQ;
constexpr size_t OFF_WT_FFNIN = OFF_WT_GLU + SZ_WT_GLU;
constexpr size_t OFF_WT_FFNOUT = OFF_WT_FFNIN + 2 * SZ_WT_FFNIN;
constexpr size_t OFF_WT_SBIN = OFF_WT_FFNOUT + 2 * SZ_WT_FFNOUT;
constexpr size_t OFF_WT_SBOUT = OFF_WT_SBIN + SZ_WT_SBIN;
constexpr size_t OFF_MOD = OFF_WT_SBOUT + SZ_WT_SQ;
constexpr size_t OFF_BETA = OFF_MOD + (size_t)2 * 4 * 6144 * 4;
constexpr size_t OFF_G = OFF_BETA + (size_t)M * 4 * 4;
constexpr size_t OFF_HN = OFF_G + (size_t)M * 4 * 4;
constexpr size_t OFF_Y5 = OFF_HN + (size_t)M * 1024 * 2;
constexpr size_t OFF_UX = OFF_Y5 + (size_t)M * 512 * 2;
constexpr size_t OFF_MF = OFF_UX + (size_t)32 * S5C * UXW * 2;
constexpr size_t OFF_EG = OFF_MF + (size_t)32 * 512 * UXW * 2;
constexpr size_t OFF_XE = OFF_EG + (size_t)32 * 128 * 512 * 2;
constexpr size_t OFF_A32 = OFF_XE + (size_t)32 * S5C * 128 * 4;
constexpr size_t OFF_PROJ = OFF_A32 + (size_t)32 * 64 * 2 * 4;
constexpr size_t OFF_GW = OFF_PROJ + (size_t)M * PJ * 2;
constexpr size_t OFF_GQD = OFF_GW + (size_t)2048 * 8192 * 2;
constexpr size_t OFF_GKT = OFF_GQD + (size_t)2048 * 8192 * 2;
constexpr size_t OFF_GUT = OFF_GKT + (size_t)2048 * 8192 * 2;
constexpr size_t OFF_GAT = OFF_GUT + (size_t)2048 * 8192 * 2;
constexpr size_t OFF_GSD = OFF_GAT + (size_t)2048 * 4096 * 2;
constexpr size_t OFF_BAR = OFF_GSD + (size_t)2048 * 4;
constexpr size_t WS_TOTAL = OFF_BAR + (size_t)XCD_BAR_WORDS_C * 4;
static_assert((size_t)M * 3072 * 2 <= WS_TOTAL - OFF_PROJ, "QKV alias");
static_assert(WS_TOTAL <= (size_t)512 * 1024 * 1024, "workspace too large");

struct Params {
  const float *x, *c, *ada_w, *ada_b, *norm_mix_w, *norm_ffn_w, *ffn_w_in, *ffn_w_out;
  const float *hy_w_in, *hy_conv_w, *hy_a_log, *hy_dt_bias, *hy_head_norm_w;
  const float *s5_lam_re, *s5_lam_im, *s5_log_dt, *s5_b_re, *s5_b_im, *s5_c_re, *s5_c_im, *s5_d, *s5_glu_w, *s5_glu_b, *hy_w_out;
  const float *sb_w_in, *sb_w_out, *final_norm_w;
  float* out;
  char* ws;
  int phase_lo, phase_hi;
};

constexpr int SMEM_BYTES = 73728;

__device__ __forceinline__ int otid() { int t = __builtin_amdgcn_workitem_id_x(); asm volatile("" : "+v"(t)); return t; }
__device__ __forceinline__ u16 f2bf(float x) { unsigned u = __float_as_uint(x); u += 0x7fffu + ((u >> 16) & 1u); return (u16)(u >> 16); }
typedef __bf16 bf16v2 __attribute__((ext_vector_type(2)));
typedef float f32v2 __attribute__((ext_vector_type(2)));
__device__ __forceinline__ unsigned pk2(float a, float b) { f32v2 v = {a, b}; bf16v2 r = __builtin_convertvector(v, bf16v2); return __builtin_bit_cast(unsigned, r); }
__device__ __forceinline__ float bf2f(u16 v) { return __uint_as_float(((unsigned)v) << 16); }
__device__ __forceinline__ float sigmoid_(float x) { return __builtin_amdgcn_rcpf(1.f + __expf(-x)); }
__device__ __forceinline__ float silu_(float x) { return x * sigmoid_(x); }
__device__ __forceinline__ float softplus_(float x) { return fmaxf(x, 0.f) + log1pf(__expf(-fabsf(x))); }
__device__ __forceinline__ float gelu_tanh_(float y) { return 0.5f * y * (1.f + tanhf(0.7978845608028654f * (y + 0.044715f * y * y * y))); }

__device__ __forceinline__ size_t pj_idx(int row, int col) { return (size_t)(col >> 9) * ((size_t)M * 512) + (size_t)row * 512 + (col & 511); }
__device__ __forceinline__ size_t a_off(int row, int col, int nks) { return ((size_t)((row >> 8) * nks + (col >> 5)) << 13) + ((row & 255) << 5) + (col & 31); }
__device__ __forceinline__ size_t b_off(int n, int k, int nks) { return ((size_t)((n >> 7) * nks + (k >> 5)) << 12) + ((n & 127) << 5) + (k & 31); }

struct TrJob { const float* src; u16* dst; int K, Nsrc, Nd, mode; };
__device__ __forceinline__ TrJob get_job(const Params& p, int j) {
  TrJob t;
  switch (j) {
    case 0: t = {p.hy_w_in, (u16*)(p.ws + OFF_WT_HYIN), 1024, EIN, PN, 1}; break;
    case 1: t = {p.hy_w_out, (u16*)(p.ws + OFF_WT_HYOUT), 1024, 1024, 1024, 0}; break;
    case 2: t = {p.s5_glu_w, (u16*)(p.ws + OFF_WT_GLU), 512, 512, 512, 0}; break;
    case 3: t = {p.ffn_w_in, (u16*)(p.ws + OFF_WT_FFNIN), 1024, 2 * FF, 2 * FF, 2}; break;
    case 4: t = {p.ffn_w_in + (size_t)1024 * 2 * FF, (u16*)(p.ws + OFF_WT_FFNIN + SZ_WT_FFNIN), 1024, 2 * FF, 2 * FF, 2}; break;
    case 5: t = {p.ffn_w_out, (u16*)(p.ws + OFF_WT_FFNOUT), FF, 1024, 1024, 0}; break;
    case 6: t = {p.ffn_w_out + (size_t)FF * 1024, (u16*)(p.ws + OFF_WT_FFNOUT + SZ_WT_FFNOUT), FF, 1024, 1024, 0}; break;
    case 7: t = {p.sb_w_in, (u16*)(p.ws + OFF_WT_SBIN), 1024, 3072, 3072, 0}; break;
    default: t = {p.sb_w_out, (u16*)(p.ws + OFF_WT_SBOUT), 1024, 1024, 1024, 0}; break;
  }
  return t;
}
__device__ __forceinline__ int src_col(int R, int mode) {
  if (mode == 0) return R;
  if (mode == 1) return R < 2048 ? R : R + 8;
  return ((R >> 4) & 1) * FF + (R >> 5) * 16 + (R & 15);
}
constexpr int N_TR_ITEMS = 640 + 256 + 64 + 2 * 1408 + 2 * 704 + 768 + 256;
constexpr int N_MOD_ITEMS = 2 * 6144 / 16;

__device__ __forceinline__ void s5_table_item(const Params& p, int item, char* smem) {
  const int tid = otid(), g = item >> 5, tau = item & 31;
  float* pwr = (float*)smem; float* pwi = pwr + 64; float* p1r = pwi + 64; float* p1i = p1r + 64;
  float* bbr = p1i + 64; float* bbi = bbr + 1024; float* cre = bbi + 1024; float* cim = cre + 1024;
  const float dt = expf(p.s5_log_dt[g]);
  if (tid < 64) {
    const float lr = p.s5_lam_re[g * 64 + tid], li = p.s5_lam_im[g * 64 + tid];
    float sn, cs;
    float mg = expf(lr * dt * (float)tau); sincosf(li * dt * (float)tau, &sn, &cs); pwr[tid] = mg * cs; pwi[tid] = mg * sn;
    mg = expf(lr * dt * (float)(tau + 1)); sincosf(li * dt * (float)(tau + 1), &sn, &cs); p1r[tid] = mg * cs; p1i[tid] = mg * sn;
    if (tau == 31) { float* a32 = (float*)(p.ws + OFF_A32); a32[(g * 64 + tid) * 2] = mg * cs; a32[(g * 64 + tid) * 2 + 1] = mg * sn; }
  }
  {
    const int pp = tid >> 2, hq = (tid & 3) * 4;
    const float lr = p.s5_lam_re[g * 64 + pp], li = p.s5_lam_im[g * 64 + pp];
    const float mg = expf(lr * dt); float sn, cs; sincosf(li * dt, &sn, &cs);
    const float ar = mg * cs, ai = mg * sn, den = lr * lr + li * li, nr = ar - 1.f, ni = ai;
    const float fre = (nr * lr + ni * li) / den, fim = (ni * lr - nr * li) / den;
#pragma unroll
    for (int e = 0; e < 4; ++e) {
      const float br = p.s5_b_re[(size_t)(g * 64 + pp) * 16 + hq + e], bi = p.s5_b_im[(size_t)(g * 64 + pp) * 16 + hq + e];
      bbr[pp * 16 + hq + e] = fre * br - fim * bi; bbi[pp * 16 + hq + e] = fre * bi + fim * br;
    }
    for (int i = tid; i < 1024; i += 256) { cre[i] = p.s5_c_re[(size_t)g * 1024 + i]; cim[i] = p.s5_c_im[(size_t)g * 1024 + i]; }
  }
  __syncthreads();
  u16* mf = (u16*)(p.ws + OFF_MF) + (size_t)g * 512 * UXW;
  u16* eg = (u16*)(p.ws + OFF_EG) + (size_t)g * 128 * 512;
  {
    const int h = tid >> 4, hp = tid & 15;
    float kv = 0.f;
    for (int pp = 0; pp < 64; ++pp) {
      const float cr = cre[h * 64 + pp], ci = cim[h * 64 + pp], pr = pwr[pp], pi = pwi[pp];
      kv += (cr * pr - ci * pi) * bbr[pp * 16 + hp] - (cr * pi + ci * pr) * bbi[pp * 16 + hp];
    }
    const u16 kb = f2bf(kv);
    for (int s0 = 0; s0 + tau < 32; ++s0) mf[b_off((s0 + tau) * 16 + h, s0 * 16 + hp, 20)] = kb;
    for (int t0 = 0; t0 + tau + 1 < 32; ++t0) mf[b_off(t0 * 16 + h, (t0 + tau + 1) * 16 + hp, 20)] = 0;
#pragma unroll
    for (int e = 0; e < 4; ++e) {
      const int pp = hp * 4 + e;
      const float cr = cre[h * 64 + pp], ci = cim[h * 64 + pp], pr = p1r[pp], pi = p1i[pp];
      mf[b_off(tau * 16 + h, 512 + pp, 20)] = f2bf(cr * pr - ci * pi);
      mf[b_off(tau * 16 + h, 576 + pp, 20)] = f2bf(-(cr * pi + ci * pr));
    }
  }
  {
    const int pp = tid >> 2, hq = (tid & 3) * 4, s0 = 31 - tau;
#pragma unroll
    for (int e = 0; e < 4; ++e) {
      const float br = bbr[pp * 16 + hq + e], bi = bbi[pp * 16 + hq + e], pr = pwr[pp], pi = pwi[pp];
      eg[b_off(pp, s0 * 16 + hq + e, 16)] = f2bf(pr * br - pi * bi);
      eg[b_off(64 + pp, s0 * 16 + hq + e, 16)] = f2bf(pr * bi + pi * br);
    }
  }
  __syncthreads();
}

__device__ __forceinline__ void phase0(const Params& p, char* smem, int bid, int nblk) {
  const int tid = otid();
  for (int it = bid; it < N_TR_ITEMS + N_MOD_ITEMS + 1024; it += nblk) {
    if (it >= N_TR_ITEMS + N_MOD_ITEMS) { s5_table_item(p, it - N_TR_ITEMS - N_MOD_ITEMS, smem); continue; }
    if (it < N_TR_ITEMS) {
      int rem = it, j = 0; TrJob jb;
      for (;; ++j) { jb = get_job(p, j); int n = (jb.Nd >> 6) * (jb.K >> 6); if (rem < n) break; rem -= n; }
      const int nk = jb.K >> 6, R0 = (rem / nk) * 64, k0 = (rem % nk) * 64;
      u16* s = (u16*)smem;
      {
        const int r = tid & 63, kk = tid >> 6;
        const float* sp = jb.src + (size_t)k0 * jb.Nsrc + src_col(R0 + r, jb.mode);
#pragma unroll
        for (int i = 0; i < 16; ++i) { int k = kk + 4 * i; s[r * 72 + k] = f2bf(sp[(size_t)k * jb.Nsrc]); }
      }
      __syncthreads();
      {
        const int r = tid >> 2, ch = tid & 3;
#pragma unroll
        for (int i = 0; i < 2; ++i) {
          int c8 = (ch + 4 * i) * 8;
          *(u32x4*)(jb.dst + b_off(R0 + r, k0 + c8, jb.K >> 5)) = *(const u32x4*)(s + r * 72 + c8);
        }
      }
      __syncthreads();
    } else {
      const int mi = it - N_TR_ITEMS, l = mi / 384, n0 = (mi % 384) * 16;
      float* cact = (float*)smem;
      float* red = cact + 4096;
      for (int i = tid; i < 4096; i += 256) cact[i] = silu_(p.c[i]);
      __syncthreads();
      const int cl = tid & 15, ksub = tid >> 4;
      float a0 = 0, a1 = 0, a2 = 0, a3 = 0;
      const float* wp = p.ada_w + (size_t)l * 1024 * 6144 + n0 + cl;
#pragma unroll 16
      for (int k = ksub * 64; k < ksub * 64 + 64; ++k) {
        float w = wp[(size_t)k * 6144];
        a0 += cact[k] * w; a1 += cact[1024 + k] * w; a2 += cact[2048 + k] * w; a3 += cact[3072 + k] * w;
      }
      red[(ksub * 4 + 0) * 16 + cl] = a0; red[(ksub * 4 + 1) * 16 + cl] = a1;
      red[(ksub * 4 + 2) * 16 + cl] = a2; red[(ksub * 4 + 3) * 16 + cl] = a3;
      __syncthreads();
      if (tid < 64) {
        const int b = tid >> 4;
        float sum = 0.f;
#pragma unroll
        for (int q = 0; q < 16; ++q) sum += red[(q * 4 + b) * 16 + cl];
        float* mod = (float*)(p.ws + OFF_MOD);
        mod[(size_t)(l * 4 + b) * 6144 + n0 + cl] = sum + p.ada_b[l * 6144 + n0 + cl];
      }
      __syncthreads();
    }
  }
}

template <int MODE>
__device__ __forceinline__ void norm_phase(const Params& p, const float* src, const float* w, const float* modl, int sh_off, int sc_off,
                           char* smem, int bid, int nblk) {
  const int tid = otid(), wid = tid >> 6, lane = tid & 63;
  float* wba = (float*)smem;
  if (MODE == 1) {
    for (int i = tid; i < 1024 * 8; i += 256) wba[i] = p.hy_w_in[(size_t)(i >> 3) * EIN + 2048 + (i & 7)];
    __syncthreads();
  }
  u16* hn = (u16*)(p.ws + OFF_HN);
  auto process = [&](int row, f32x4 (&v)[4]) {
    float ss = 0.f;
#pragma unroll
    for (int i = 0; i < 4; ++i) ss += v[i][0] * v[i][0] + v[i][1] * v[i][1] + v[i][2] * v[i][2] + v[i][3] * v[i][3];
#pragma unroll
    for (int o = 32; o >= 1; o >>= 1) ss += __shfl_xor(ss, o);
    const float rstd = rsqrtf(ss * (1.f / 1024.f) + 1e-6f);
    const int b = row >> 13;
    float dots[8];
    if (MODE == 1) { for (int j = 0; j < 8; ++j) dots[j] = 0.f; }
#pragma unroll
    for (int i = 0; i < 4; ++i) {
      const int c0 = i * 256 + lane * 4;
      f32x4 ww = *(const f32x4*)(w + c0);
      f32x4 y;
      if (MODE == 2) {
#pragma unroll
        for (int e = 0; e < 4; ++e) y[e] = v[i][e] * rstd * ww[e];
        *(f32x4*)(p.out + (size_t)row * 1024 + c0) = y;
      } else {
        f32x4 sc = *(const f32x4*)(modl + (size_t)b * 6144 + sc_off + c0);
        f32x4 sh = *(const f32x4*)(modl + (size_t)b * 6144 + sh_off + c0);
#pragma unroll
        for (int e = 0; e < 4; ++e) y[e] = v[i][e] * rstd * ww[e] * (1.f + sc[e]) + sh[e];
        uint2 pk; pk.x = (unsigned)f2bf(y[0]) | ((unsigned)f2bf(y[1]) << 16); pk.y = (unsigned)f2bf(y[2]) | ((unsigned)f2bf(y[3]) << 16);
        *(uint2*)(hn + a_off(row, c0, 32)) = pk;
        if (MODE == 1) {
#pragma unroll
          for (int e = 0; e < 4; ++e) {
            f32x4 w0 = *(const f32x4*)(wba + (c0 + e) * 8), w1 = *(const f32x4*)(wba + (c0 + e) * 8 + 4);
#pragma unroll
            for (int j = 0; j < 4; ++j) { dots[j] += y[e] * w0[j]; dots[4 + j] += y[e] * w1[j]; }
          }
        }
      }
    }
    if (MODE == 1) {
#pragma unroll
      for (int j = 0; j < 8; ++j) {
#pragma unroll
        for (int o = 32; o >= 1; o >>= 1) dots[j] += __shfl_xor(dots[j], o);
      }
      if (lane == 0) {
        float* beta = (float*)(p.ws + OFF_BETA); float* gg = (float*)(p.ws + OFF_G);
#pragma unroll
        for (int h = 0; h < 4; ++h) {
          beta[(size_t)row * 4 + h] = sigmoid_(dots[h]);
          gg[(size_t)row * 4 + h] = -__expf(p.hy_a_log[h]) * softplus_(dots[4 + h] + p.hy_dt_bias[h]);
        }
      }
    }
  };
#pragma unroll 1
  for (int row = bid * 4 + wid; row < M; row += nblk * 8) {
    const int row1 = row + nblk * 4;
    const bool has1 = row1 < M;
    f32x4 v0[4], v1[4];
#pragma unroll
    for (int i = 0; i < 4; ++i) v0[i] = *(const f32x4*)(src + (size_t)row * 1024 + i * 256 + lane * 4);
#pragma unroll
    for (int i = 0; i < 4; ++i) v1[i] = has1 ? *(const f32x4*)(src + (size_t)row1 * 1024 + i * 256 + lane * 4) : f32x4{0.f, 0.f, 0.f, 0.f};
    process(row, v0);
    if (has1) process(row1, v1);
  }
}

enum { E_PROJ0 = 0, E_BF16 = 1, E_RESID = 2, E_GLU = 3, E_SWIGLU = 4, E_XE = 5, E_S5Y = 6 };
struct EpiArgs { float* outf; u16* outb; const float* res; const float* gate; const u16* y5; const float* bias; u16* ux; int ldc; };

template <int EPI>
__device__ __forceinline__ void gemm_phase(const u16* __restrict__ A0, int nksA, size_t sA, const u16* __restrict__ B0, int nksB, size_t sB,
                                           int K, int nM, int nN, int nbatch, const EpiArgs ea, char* smem, int bid, int nblk) {
  const int tid = otid(), wid = tid >> 6, lane = tid & 63, wr = wid >> 1, wc = wid & 1, fr = lane & 15, fq = lane >> 4;
  char* SA = smem; char* SB = smem + 49152;
  const int sa0 = (int)(uintptr_t)SA + (wr * 128 + fr) * 64 + fq * 16, sb0 = (int)(uintptr_t)SB + (wc * 64 + fr) * 64 + fq * 16;
  const int NR = nbatch * nM, ntiles = NR * nN;
  const int STN = (nN & 7) == 0 ? 8 : ((nN & 3) == 0 ? 4 : 1), STM = 64 / STN, nSN = nN / STN;
  const bool swz = ((nblk & 7) == 0) && (NR % STM == 0);
  const int lpx = nblk >> 3;
  int si = bid & 7, l = bid >> 3, tl = bid;
#pragma unroll 1
  for (;;) {
    int R, pn;
    if (swz) {
      if (si >= (NR / STM) * nSN) break;
      R = (si / nSN) * STM + l / STN; pn = (si % nSN) * STN + l % STN;
      l += lpx; if (l >= 64) { l = bid >> 3; si += 8; }
    } else {
      if (tl >= ntiles) break;
      R = tl / nN; pn = tl % nN; tl += nblk;
    }
    const int g = R / nM, rt = R % nM, brow = rt << 8, bcol = pn << 7;
    const char* A = (const char*)(A0 + (size_t)g * sA) + ((size_t)rt * nksA << 14) + tid * 16;
    const char* Bt = (const char*)(B0 + (size_t)g * sB) + ((size_t)pn * nksB << 13) + tid * 16;
    int nk = K >> 5, klim = nk;
    if (EPI == E_S5Y) { klim = 4 * (pn + 1); nk = klim + 4; }
    f32x4 acc[8][4];
#pragma unroll
    for (int m = 0; m < 8; ++m)
#pragma unroll
      for (int n = 0; n < 4; ++n) acc[m][n] = f32x4{0.f, 0.f, 0.f, 0.f};
#define GSTAGE(KK, BUF) do { const int kt_ = (EPI == E_S5Y && (KK) >= klim) ? (16 + (KK) - klim) : (KK); \
      _Pragma("unroll") for (int i = 0; i < 4; ++i) \
        __builtin_amdgcn_global_load_lds((const unsigned*)(A + ((size_t)kt_ << 14) + i * 4096), (__attribute__((address_space(3))) unsigned*)(SA + (BUF) * 16384 + tid * 16 + i * 4096), 16, 0, 0); \
      _Pragma("unroll") for (int i = 0; i < 2; ++i) \
        __builtin_amdgcn_global_load_lds((const unsigned*)(Bt + ((size_t)kt_ << 13) + i * 4096), (__attribute__((address_space(3))) unsigned*)(SB + (BUF) * 8192 + tid * 16 + i * 4096), 16, 0, 0); } while (0)
    asm volatile("s_waitcnt vmcnt(0)" ::: "memory");
    GSTAGE(0, 0);
    if (nk > 1) { GSTAGE(1, 1); asm volatile("s_waitcnt vmcnt(6)\n\ts_barrier" ::: "memory"); }
    else { asm volatile("s_waitcnt vmcnt(0)\n\ts_barrier" ::: "memory"); }
    int buf = 0, nbuf = 2;
#pragma unroll 1
    for (int kk = 0; kk < nk; ++kk) {
      const bool more = kk + 2 < nk;
      if (more) GSTAGE(kk + 2, nbuf);
      bf16x8 Bl[4], At[8];
      {
        const int bb = sb0 + buf * 8192, ab = sa0 + buf * 16384;
        asm volatile(
            "ds_read_b128 %0, %12\n\tds_read_b128 %1, %12 offset:1024\n\tds_read_b128 %2, %12 offset:2048\n\tds_read_b128 %3, %12 offset:3072\n\t"
            "ds_read_b128 %4, %13\n\tds_read_b128 %5, %13 offset:1024\n\tds_read_b128 %6, %13 offset:2048\n\tds_read_b128 %7, %13 offset:3072\n\t"
            "ds_read_b128 %8, %13 offset:4096\n\tds_read_b128 %9, %13 offset:5120\n\tds_read_b128 %10, %13 offset:6144\n\tds_read_b128 %11, %13 offset:7168\n\t"
            "s_waitcnt lgkmcnt(4)"
            : "=&v"(Bl[0]), "=&v"(Bl[1]), "=&v"(Bl[2]), "=&v"(Bl[3]), "=&v"(At[0]), "=&v"(At[1]), "=&v"(At[2]), "=&v"(At[3]),
              "=&v"(At[4]), "=&v"(At[5]), "=&v"(At[6]), "=&v"(At[7])
            : "v"(bb), "v"(ab)
            : "memory");
      }
      __builtin_amdgcn_s_setprio(1);
#pragma unroll
      for (int m = 0; m < 4; ++m)
#pragma unroll
        for (int n = 0; n < 4; ++n) acc[m][n] = __builtin_amdgcn_mfma_f32_16x16x32_bf16(Bl[n], At[m], acc[m][n], 0, 0, 0);
      __builtin_amdgcn_sched_barrier(0);
      asm volatile("s_waitcnt lgkmcnt(0)" : "+v"(At[4]), "+v"(At[5]), "+v"(At[6]), "+v"(At[7]) :: "memory");
      __builtin_amdgcn_sched_barrier(0);
#pragma unroll
      for (int m = 4; m < 8; ++m)
#pragma unroll
        for (int n = 0; n < 4; ++n) acc[m][n] = __builtin_amdgcn_mfma_f32_16x16x32_bf16(Bl[n], At[m], acc[m][n], 0, 0, 0);
      __builtin_amdgcn_s_setprio(0);
      if (more) asm volatile("s_waitcnt vmcnt(6)\n\ts_barrier" ::: "memory");
      else asm volatile("s_waitcnt vmcnt(0)\n\ts_barrier" ::: "memory");
      buf = (buf == 2) ? 0 : buf + 1; nbuf = (nbuf == 2) ? 0 : nbuf + 1;
    }
#undef GSTAGE
#pragma unroll
    for (int m = 0; m < 8; ++m)
#pragma unroll
      for (int n = 0; n < 4; ++n) {
        const int row = brow + wr * 128 + m * 16 + fr, col = bcol + wc * 64 + n * 16 + fq * 4;
        const f32x4 v = acc[m][n];
        if (EPI == E_PROJ0) {
          const uint2 pk = uint2{pk2(v[0], v[1]), pk2(v[2], v[3])};
          if (bcol < 2048) *(uint2*)(ea.outb + pj_idx(row, col)) = pk;
          else { const int cc = col - 2048; *(uint2*)(ea.ux + (size_t)(cc >> 4) * S5C * UXW + a_off(row >> 5, (row & 31) * 16 + (cc & 15), 20)) = pk; }
        }
        if (EPI == E_BF16) *(uint2*)(ea.outb + (size_t)row * ea.ldc + col) = uint2{pk2(v[0], v[1]), pk2(v[2], v[3])};
        if (EPI == E_RESID) {
          const size_t idx = (size_t)row * 1024 + col;
          const f32x4 r4 = *(const f32x4*)(ea.res + idx), g4 = *(const f32x4*)(ea.gate + (size_t)(row >> 13) * 6144 + col);
          *(f32x4*)(ea.outf + idx) = f32x4{r4[0] + g4[0] * v[0], r4[1] + g4[1] * v[1], r4[2] + g4[2] * v[2], r4[3] + g4[3] * v[3]};
        }
        if (EPI == E_GLU) {
          const uint2 yy = *(const uint2*)(ea.y5 + a_off(row, col, 16));
          const f32x4 b4 = *(const f32x4*)(ea.bias + col);
          const float y0 = __uint_as_float(yy.x << 16), y1 = __uint_as_float(yy.x & 0xffff0000u), y2 = __uint_as_float(yy.y << 16), y3 = __uint_as_float(yy.y & 0xffff0000u);
          *(uint2*)(ea.outb + a_off(row, 512 + col, 32)) = uint2{pk2(y0 * sigmoid_(v[0] + b4[0]), y1 * sigmoid_(v[1] + b4[1])), pk2(y2 * sigmoid_(v[2] + b4[2]), y3 * sigmoid_(v[3] + b4[3]))};
        }
        if (EPI == E_SWIGLU) {
          if ((n & 1) == 0) {
            const f32x4 u = acc[m][n | 1];
            const int co = (bcol >> 1) + wc * 32 + (n >> 1) * 16 + fq * 4;
            *(uint2*)(ea.outb + a_off(row, co, FF / 32)) = uint2{pk2(silu_(v[0]) * u[0], silu_(v[1]) * u[1]), pk2(silu_(v[2]) * u[2], silu_(v[3]) * u[3])};
          }
        }
        if (EPI == E_XE) *(f32x4*)(ea.outf + ((size_t)g * S5C + row) * 128 + col) = v;
        if (EPI == E_S5Y) {
          const uint2 uu = *(const uint2*)(ea.ux + (size_t)g * S5C * UXW + a_off(row, col, 20));
          const f32x4 d4 = *(const f32x4*)(ea.bias + g * 16 + (col & 15));
          const float u0 = __uint_as_float(uu.x << 16), u1 = __uint_as_float(uu.x & 0xffff0000u), u2 = __uint_as_float(uu.y << 16), u3 = __uint_as_float(uu.y & 0xffff0000u);
          *(uint2*)(ea.outb + a_off(row * 32 + (col >> 4), g * 16 + (col & 15), 16)) =
              uint2{pk2(gelu_tanh_(v[0] + d4[0] * u0), gelu_tanh_(v[1] + d4[1] * u1)), pk2(gelu_tanh_(v[2] + d4[2] * u2), gelu_tanh_(v[3] + d4[3] * u3))};
        }
      }
  }
}

__device__ __forceinline__ void s5_carry_phase(const Params& p, int bid, int nblk) {
  const float* xe = (const float*)(p.ws + OFF_XE); const float* a32 = (const float*)(p.ws + OFF_A32);
  u16* ux = (u16*)(p.ws + OFF_UX);
  for (int it = bid; it < 32; it += nblk) {
    const int idx = it * 256 + otid(), pp = idx & 63, g = (idx >> 6) & 31, b = idx >> 11;
    const float ar = a32[(g * 64 + pp) * 2], ai = a32[(g * 64 + pp) * 2 + 1];
    float xr = 0.f, xi = 0.f;
    const size_t cbase = (size_t)g * S5C + b * 256, gbase = (size_t)g * S5C * UXW;
    for (int n = 0; n < 256; n += 8) {
      float er[8], ei[8];
#pragma unroll
      for (int e = 0; e < 8; ++e) { er[e] = xe[(cbase + n + e) * 128 + pp]; ei[e] = xe[(cbase + n + e) * 128 + 64 + pp]; }
#pragma unroll
      for (int e = 0; e < 8; ++e) {
        ux[gbase + a_off(b * 256 + n + e, 512 + pp, 20)] = f2bf(xr); ux[gbase + a_off(b * 256 + n + e, 576 + pp, 20)] = f2bf(xi);
        const float nr = ar * xr - ai * xi + er[e], ni = ar * xi + ai * xr + ei[e];
        xr = nr; xi = ni;
      }
    }
  }
}

__device__ __forceinline__ int crow(int r, int hi) { return (r & 3) + 8 * (r >> 2) + 4 * hi; }
using f32x16 = __attribute__((ext_vector_type(16))) float;
__device__ __forceinline__ void unpack8(const u32x4 w, float* f) {
#pragma unroll
  for (int e = 0; e < 4; ++e) { f[2 * e] = __uint_as_float(w[e] << 16); f[2 * e + 1] = __uint_as_float(w[e] & 0xffff0000u); }
}
__device__ __forceinline__ void gdn_prep_phase(const Params& p, char* smem, int bid, int nblk) {
  const int tid = otid(), wid = tid >> 6, lane = tid & 63, fr = lane & 15, fq = lane >> 4;
  u16* qs = (u16*)smem;
  u16* ks = qs + 64 * 136;
  float* Lm = (float*)(ks + 64 * 136);
  float* gcs = Lm + 4096; float* bts = gcs + 64; float* egs = bts + 64;
  const u16* proj = (const u16*)(p.ws + OFF_PROJ);
  const float* beta = (const float*)(p.ws + OFF_BETA); const float* gg = (const float*)(p.ws + OFF_G);
#pragma unroll 1
  for (int it = bid; it < 2048; it += nblk) {
    const int n = it & 127, bh = it >> 7, b = bh >> 2, h = bh & 3;
    const size_t row0 = (size_t)b * SEQ + n * 64;
    if (wid == 0) {
      float c = gg[(row0 + lane) * 4 + h];
#pragma unroll
      for (int o = 1; o < 64; o <<= 1) { const float tt = __shfl_up(c, o); if (lane >= o) c += tt; }
      gcs[lane] = c; egs[lane] = __expf(c); bts[lane] = beta[(row0 + lane) * 4 + h];
    }
    {
      const int tok = tid >> 2, part = tid & 3, l = n * 64 + tok;
      float qo[32], ko[32]; float sq = 0.f, sk = 0.f;
#pragma unroll
      for (int cb = 0; cb < 4; ++cb) {
        const int colq = h * 128 + part * 32 + cb * 8, colk = 512 + colq;
        const size_t kblk = (size_t)M * 512 - 512;
        float aq[8], ak[8];
#pragma unroll
        for (int e = 0; e < 8; ++e) { aq[e] = 0.f; ak[e] = 0.f; }
#pragma unroll
        for (int j = 0; j < 4; ++j) {
          const int lt = l - 3 + j;
          if (lt >= 0) {
            const u16* rp = proj + ((size_t)b * SEQ + lt) * 512;
            float xq[8], xk[8];
            unpack8(*(const u32x4*)(rp + colq), xq); unpack8(*(const u32x4*)(rp + kblk + colk), xk);
            const f32x4 wq0 = *(const f32x4*)(p.hy_conv_w + j * 1536 + colq), wq1 = *(const f32x4*)(p.hy_conv_w + j * 1536 + colq + 4);
            const f32x4 wk0 = *(const f32x4*)(p.hy_conv_w + j * 1536 + colk), wk1 = *(const f32x4*)(p.hy_conv_w + j * 1536 + colk + 4);
#pragma unroll
            for (int e = 0; e < 4; ++e) { aq[e] += wq0[e] * xq[e]; aq[4 + e] += wq1[e] * xq[4 + e]; ak[e] += wk0[e] * xk[e]; ak[4 + e] += wk1[e] * xk[4 + e]; }
          }
        }
#pragma unroll
        for (int e = 0; e < 8; ++e) { const float a = silu_(aq[e]), k = silu_(ak[e]); qo[cb * 8 + e] = a; ko[cb * 8 + e] = k; sq += a * a; sk += k * k; }
      }
      sq += __shfl_xor(sq, 1); sq += __shfl_xor(sq, 2); sk += __shfl_xor(sk, 1); sk += __shfl_xor(sk, 2);
      const float rq = rsqrtf(sq + 1e-6f) * 0.08838834764831845f, rk = rsqrtf(sk + 1e-6f);
#pragma unroll
      for (int cb = 0; cb < 4; ++cb) {
        u32x4 wq, wk;
#pragma unroll
        for (int e = 0; e < 4; ++e) { wq[e] = pk2(qo[cb * 8 + 2 * e] * rq, qo[cb * 8 + 2 * e + 1] * rq); wk[e] = pk2(ko[cb * 8 + 2 * e] * rk, ko[cb * 8 + 2 * e + 1] * rk); }
        *(u32x4*)(qs + tok * 136 + part * 32 + cb * 8) = wq; *(u32x4*)(ks + tok * 136 + part * 32 + cb * 8) = wk;
      }
    }
    __syncthreads();
    {
      f32x4 akk[4], aqk[4];
#pragma unroll
      for (int nb = 0; nb < 4; ++nb) { akk[nb] = f32x4{0.f, 0.f, 0.f, 0.f}; aqk[nb] = f32x4{0.f, 0.f, 0.f, 0.f}; }
#pragma unroll
      for (int kk = 0; kk < 4; ++kk) {
        const bf16x8 ak = *(const bf16x8*)(ks + (16 * wid + fr) * 136 + kk * 32 + fq * 8);
        const bf16x8 aq = *(const bf16x8*)(qs + (16 * wid + fr) * 136 + kk * 32 + fq * 8);
#pragma unroll
        for (int nb = 0; nb < 4; ++nb) {
          const bf16x8 bk = *(const bf16x8*)(ks + (16 * nb + fr) * 136 + kk * 32 + fq * 8);
          akk[nb] = __builtin_amdgcn_mfma_f32_16x16x32_bf16(ak, bk, akk[nb], 0, 0, 0);
          aqk[nb] = __builtin_amdgcn_mfma_f32_16x16x32_bf16(aq, bk, aqk[nb], 0, 0, 0);
        }
      }
      u16* att = (u16*)(p.ws + OFF_GAT) + (size_t)it * 4096;
#pragma unroll
      for (int nb = 0; nb < 4; ++nb)
#pragma unroll
        for (int r = 0; r < 4; ++r) {
          const int i = 16 * wid + fq * 4 + r, j = 16 * nb + fr;
          const float dec = __expf(fminf(gcs[i] - gcs[j], 0.f));
          Lm[i * 64 + j] = (i > j) ? bts[i] * akk[nb][r] * dec : 0.f;
          att[i * 64 + j] = f2bf((i >= j) ? aqk[nb][r] * dec : 0.f);
        }
    }
    __syncthreads();
    {
      float x[64];
      if (tid < 128) {
        const int col = 1024 + h * 128 + tid;
        const u16* vp = proj + (size_t)2 * M * 512 + h * 128 + tid;
        const float w0 = p.hy_conv_w[col], w1 = p.hy_conv_w[1536 + col], w2 = p.hy_conv_w[2 * 1536 + col], w3 = p.hy_conv_w[3 * 1536 + col];
        float x1 = 0.f, x2 = 0.f, x3 = 0.f;
        if (n > 0) { x3 = bf2f(vp[(row0 - 3) * 512]); x2 = bf2f(vp[(row0 - 2) * 512]); x1 = bf2f(vp[(row0 - 1) * 512]); }
#pragma unroll
        for (int i = 0; i < 64; ++i) {
          const float xv = bf2f(vp[(row0 + i) * 512]);
          x[i] = silu_(w0 * x3 + w1 * x2 + w2 * x1 + w3 * xv) * bts[i];
          x3 = x2; x2 = x1; x1 = xv;
        }
      } else {
#pragma unroll
        for (int i = 0; i < 64; ++i) x[i] = bf2f(ks[i * 136 + tid - 128]) * bts[i] * egs[i];
      }
#pragma unroll
      for (int i = 1; i < 64; ++i) {
        float acc = x[i];
#pragma unroll
        for (int j4 = 0; j4 < (i + 3) / 4; ++j4) {
          const f32x4 l4 = *(const f32x4*)(Lm + i * 64 + j4 * 4);
#pragma unroll
          for (int e = 0; e < 4; ++e) if (j4 * 4 + e < i) acc -= l4[e] * x[j4 * 4 + e];
        }
        x[i] = acc;
      }
      if (tid < 128) {
        u16* ut = (u16*)(p.ws + OFF_GUT) + (size_t)it * 8192 + tid * 64;
#pragma unroll
        for (int c8 = 0; c8 < 8; ++c8) {
          u32x4 w;
#pragma unroll
          for (int e = 0; e < 4; ++e) w[e] = pk2(x[c8 * 8 + 2 * e], x[c8 * 8 + 2 * e + 1]);
          *(u32x4*)(ut + c8 * 8) = w;
        }
      } else {
        u16* wg = (u16*)(p.ws + OFF_GW) + (size_t)it * 8192 + (tid - 128);
#pragma unroll
        for (int i = 0; i < 64; ++i) wg[i * 128] = f2bf(x[i]);
      }
    }
    {
      u16* qd = (u16*)(p.ws + OFF_GQD) + (size_t)it * 8192;
#pragma unroll
      for (int k = 0; k < 4; ++k) {
        const int piece = tid + 256 * k, i = piece >> 4, d0 = (piece & 15) * 8;
        float f[8]; unpack8(*(const u32x4*)(qs + i * 136 + d0), f);
        const float e = egs[i];
        u32x4 w;
#pragma unroll
        for (int e2 = 0; e2 < 4; ++e2) w[e2] = pk2(f[2 * e2] * e, f[2 * e2 + 1] * e);
        *(u32x4*)(qd + i * 128 + d0) = w;
      }
      u16* kt = (u16*)(p.ws + OFF_GKT) + (size_t)it * 8192;
      const int dk = tid & 127, half = tid >> 7;
      const float gl = gcs[63];
#pragma unroll
      for (int c8 = 0; c8 < 4; ++c8) {
        u32x4 w;
#pragma unroll
        for (int e = 0; e < 4; ++e) {
          const int i0 = half * 32 + c8 * 8 + 2 * e;
          w[e] = pk2(bf2f(ks[i0 * 136 + dk]) * __expf(gl - gcs[i0]), bf2f(ks[(i0 + 1) * 136 + dk]) * __expf(gl - gcs[i0 + 1]));
        }
        *(u32x4*)(kt + dk * 64 + half * 32 + c8 * 8) = w;
      }
      if (tid == 0) ((float*)(p.ws + OFF_GSD))[it] = egs[63];
    }
    __syncthreads();
  }
}

__device__ __forceinline__ uint2 lds64(const char* p) { return *(const uint2*)p; }
__device__ __forceinline__ bf16x8 mk8(uint2 a, uint2 b) { u32x4 w = {a.x, a.y, b.x, b.y}; return __builtin_bit_cast(bf16x8, w); }
__device__ __forceinline__ bf16x8 pack8(const f32x16& x, int s) {
  u32x4 w = {pk2(x[8 * s], x[8 * s + 1]), pk2(x[8 * s + 2], x[8 * s + 3]), pk2(x[8 * s + 4], x[8 * s + 5]), pk2(x[8 * s + 6], x[8 * s + 7])};
  return __builtin_bit_cast(bf16x8, w);
}
__device__ __forceinline__ void gdn_scan_item(const Params& p, int bh, char* smem) {
  const int tid = otid(), wid = tid >> 6, lane = tid & 63, r32 = lane & 31, hi = lane >> 5;
  char* Wl = smem; char* KTl = smem + 16896;
  const char* gw = p.ws + OFF_GW; const char* gkt = p.ws + OFF_GKT;
  const u16* gut = (const u16*)(p.ws + OFF_GUT);
  const float* gsd = (const float*)(p.ws + OFF_GSD);
  u32x4* sbg = (u32x4*)(p.ws + OFF_PROJ); u32x4* vbg = (u32x4*)(p.ws + OFF_PROJ + (size_t)2048 * 32768);
  f32x16 S[4];
#pragma unroll
  for (int T = 0; T < 4; ++T)
#pragma unroll
    for (int r = 0; r < 16; ++r) S[T][r] = 0.f;
  u32x4 sa[8], sb_[8]; uint2 uc[8];
  const int dv = wid * 32 + r32;
#define G_LOAD(ST, IT) do { const size_t o16 = (size_t)(IT) * 16384; \
    _Pragma("unroll") for (int k = 0; k < 4; ++k) { ST[k] = *(const u32x4*)(gw + o16 + (tid + 256 * k) * 16); ST[4 + k] = *(const u32x4*)(gkt + o16 + (tid + 256 * k) * 16); } } while (0)
#define U_LOAD(IT) do { _Pragma("unroll") for (int k = 0; k < 8; ++k) uc[k] = *(const uint2*)(gut + (size_t)(IT) * 8192 + dv * 64 + 32 * (k >> 2) + 8 * (k & 3) + 4 * hi); } while (0)
#define G_WRITE(ST) do { \
    _Pragma("unroll") for (int k = 0; k < 4; ++k) { const int pc = tid + 256 * k; \
      { char* d = Wl + (pc >> 4) * 264 + (pc & 15) * 16; *(uint2*)d = uint2{ST[k][0], ST[k][1]}; *(uint2*)(d + 8) = uint2{ST[k][2], ST[k][3]}; } \
      { char* d = KTl + (pc >> 3) * 136 + (pc & 7) * 16; *(uint2*)d = uint2{ST[4 + k][0], ST[4 + k][1]}; *(uint2*)(d + 8) = uint2{ST[4 + k][2], ST[4 + k][3]}; } } } while (0)
#define SCAN_STEP(N, NXT, FAR) do { const int n = (N); const int item = bh * 128 + n; \
    const float sd_nxt = gsd[item + (n + 1 < 128 ? 1 : 0)]; \
    if (n + 2 < 128) G_LOAD(FAR, item + 2); \
    f32x16 av[2]; \
    _Pragma("unroll") for (int r = 0; r < 16; ++r) { av[0][r] = 0.f; av[1][r] = 0.f; } \
    _Pragma("unroll") for (int T = 0; T < 4; ++T) \
      _Pragma("unroll") for (int s = 0; s < 2; ++s) { \
        const bf16x8 sb = pack8(S[T], s); \
        sbg[((size_t)(item * 4 + wid) * 8 + T * 2 + s) * 64 + lane] = __builtin_bit_cast(u32x4, sb); \
        const int cb = (32 * T + 16 * s + 4 * hi) * 2; \
        _Pragma("unroll") for (int it = 0; it < 2; ++it) { \
          const char* wp = Wl + (32 * it + r32) * 264 + cb; \
          av[it] = __builtin_amdgcn_mfma_f32_32x32x16_bf16(mk8(lds64(wp), lds64(wp + 16)), sb, av[it], 0, 0, 0); } } \
    bf16x8 vb[2][2]; \
    _Pragma("unroll") for (int it = 0; it < 2; ++it) { \
      f32x16 vn; \
      _Pragma("unroll") for (int g = 0; g < 4; ++g) { const uint2 u2 = uc[it * 4 + g]; \
        vn[4 * g] = __uint_as_float(u2.x << 16) - av[it][4 * g]; vn[4 * g + 1] = __uint_as_float(u2.x & 0xffff0000u) - av[it][4 * g + 1]; \
        vn[4 * g + 2] = __uint_as_float(u2.y << 16) - av[it][4 * g + 2]; vn[4 * g + 3] = __uint_as_float(u2.y & 0xffff0000u) - av[it][4 * g + 3]; } \
      vb[it][0] = pack8(vn, 0); vb[it][1] = pack8(vn, 1); \
      vbg[((size_t)(item * 4 + wid) * 4 + it * 2) * 64 + lane] = __builtin_bit_cast(u32x4, vb[it][0]); \
      vbg[((size_t)(item * 4 + wid) * 4 + it * 2 + 1) * 64 + lane] = __builtin_bit_cast(u32x4, vb[it][1]); } \
    if (n + 1 < 128) U_LOAD(item + 1); \
    _Pragma("unroll") for (int T = 0; T < 4; ++T) { \
      _Pragma("unroll") for (int r = 0; r < 16; ++r) S[T][r] *= sd_cur; \
      _Pragma("unroll") for (int it = 0; it < 2; ++it) \
        _Pragma("unroll") for (int s = 0; s < 2; ++s) { \
          const char* kp = KTl + (32 * T + r32) * 136 + (32 * it + 16 * s + 4 * hi) * 2; \
          S[T] = __builtin_amdgcn_mfma_f32_32x32x16_bf16(mk8(lds64(kp), lds64(kp + 16)), vb[it][s], S[T], 0, 0, 0); } } \
    sd_cur = sd_nxt; \
    __syncthreads(); \
    if (n + 1 < 128) G_WRITE(NXT); \
    __syncthreads(); } while (0)
  float sd_cur = gsd[bh * 128];
  G_LOAD(sa, bh * 128); U_LOAD(bh * 128); G_WRITE(sa);
  G_LOAD(sb_, bh * 128 + 1);
  __syncthreads();
#pragma unroll 1
  for (int n2 = 0; n2 < 128; n2 += 2) {
    SCAN_STEP(n2, sb_, sa);
    SCAN_STEP(n2 + 1, sa, sb_);
  }
#undef SCAN_STEP
#undef G_LOAD
#undef G_WRITE
#undef U_LOAD
}

__device__ __forceinline__ void gdn_out_phase(const Params& p, char* smem, int bid, int nblk) {
  const int tid = otid(), wid = tid >> 6, lane = tid & 63, r32 = lane & 31, hi = lane >> 5;
  char* QDl = smem; char* ATl = smem + 16896; float* Ol = (float*)(smem + 16896 + 8704);
  const char* gqd = p.ws + OFF_GQD; const char* gat = p.ws + OFF_GAT;
  const u32x4* sbg = (const u32x4*)(p.ws + OFF_PROJ); const u32x4* vbg = (const u32x4*)(p.ws + OFF_PROJ + (size_t)2048 * 32768);
  const u16* zb = (const u16*)(p.ws + OFF_PROJ) + (size_t)3 * M * 512;
  u16* concat = (u16*)(p.ws + OFF_HN);
#pragma unroll 1
  for (int item = bid; item < 2048; item += nblk) {
    const int n = item & 127, bh = item >> 7, b = bh >> 2, h = bh & 3;
    {
      u32x4 st[6];
#pragma unroll
      for (int k = 0; k < 4; ++k) st[k] = *(const u32x4*)(gqd + (size_t)item * 16384 + (tid + 256 * k) * 16);
#pragma unroll
      for (int k = 0; k < 2; ++k) st[4 + k] = *(const u32x4*)(gat + (size_t)item * 8192 + (tid + 256 * k) * 16);
#pragma unroll
      for (int k = 0; k < 4; ++k) { const int pc = tid + 256 * k; char* d = QDl + (pc >> 4) * 264 + (pc & 15) * 16;
        *(uint2*)d = uint2{st[k][0], st[k][1]}; *(uint2*)(d + 8) = uint2{st[k][2], st[k][3]}; }
#pragma unroll
      for (int k = 0; k < 2; ++k) { const int pc = tid + 256 * k; char* d = ATl + (pc >> 3) * 136 + (pc & 7) * 16;
        *(uint2*)d = uint2{st[4 + k][0], st[4 + k][1]}; *(uint2*)(d + 8) = uint2{st[4 + k][2], st[4 + k][3]}; }
    }
    bf16x8 sb[8], vb[4];
#pragma unroll
    for (int f = 0; f < 8; ++f) sb[f] = __builtin_bit_cast(bf16x8, sbg[((size_t)(item * 4 + wid) * 8 + f) * 64 + lane]);
#pragma unroll
    for (int f = 0; f < 4; ++f) vb[f] = __builtin_bit_cast(bf16x8, vbg[((size_t)(item * 4 + wid) * 4 + f) * 64 + lane]);
    __syncthreads();
    f32x16 ao[2];
#pragma unroll
    for (int r = 0; r < 16; ++r) { ao[0][r] = 0.f; ao[1][r] = 0.f; }
#pragma unroll
    for (int T = 0; T < 4; ++T)
#pragma unroll
      for (int s = 0; s < 2; ++s) {
        const int cb = (32 * T + 16 * s + 4 * hi) * 2;
#pragma unroll
        for (int it = 0; it < 2; ++it) {
          const char* qp = QDl + (32 * it + r32) * 264 + cb;
          ao[it] = __builtin_amdgcn_mfma_f32_32x32x16_bf16(mk8(lds64(qp), lds64(qp + 16)), sb[T * 2 + s], ao[it], 0, 0, 0);
        }
      }
#pragma unroll
    for (int it2 = 0; it2 < 2; ++it2)
#pragma unroll
      for (int it = 0; it <= it2; ++it)
#pragma unroll
        for (int s = 0; s < 2; ++s) {
          const char* ap = ATl + (32 * it2 + r32) * 136 + (32 * it + 16 * s + 4 * hi) * 2;
          ao[it2] = __builtin_amdgcn_mfma_f32_32x32x16_bf16(mk8(lds64(ap), lds64(ap + 16)), vb[it * 2 + s], ao[it2], 0, 0, 0);
        }
#pragma unroll
    for (int it = 0; it < 2; ++it)
#pragma unroll
      for (int r = 0; r < 16; ++r) Ol[(32 * it + crow(r, hi)) * 132 + wid * 32 + r32] = ao[it][r];
    __syncthreads();
    {
      const int tok = tid >> 2, part = tid & 3;
      const int row = b * SEQ + n * 64 + tok;
      f32x4 a[8]; float ss = 0.f;
#pragma unroll
      for (int k = 0; k < 8; ++k) { a[k] = *(const f32x4*)(Ol + tok * 132 + part * 32 + k * 4); ss += a[k][0] * a[k][0] + a[k][1] * a[k][1] + a[k][2] * a[k][2] + a[k][3] * a[k][3]; }
      ss += __shfl_xor(ss, 1); ss += __shfl_xor(ss, 2);
      const float rs = rsqrtf(ss * (1.f / 128.f) + 1e-6f);
      const u16* zp = zb + (size_t)row * 512 + h * 128 + part * 32;
      const float* hw = p.hy_head_norm_w + part * 32;
      u16* cp = concat + a_off(row, h * 128 + part * 32, 32);
#pragma unroll
      for (int k = 0; k < 4; ++k) {
        float zf[8]; unpack8(*(const u32x4*)(zp + k * 8), zf);
        const f32x4 h0 = *(const f32x4*)(hw + k * 8), h1 = *(const f32x4*)(hw + k * 8 + 4);
        const f32x4 x0 = a[2 * k], x1 = a[2 * k + 1];
        u32x4 w;
        w[0] = pk2(x0[0] * rs * h0[0] * silu_(zf[0]), x0[1] * rs * h0[1] * silu_(zf[1]));
        w[1] = pk2(x0[2] * rs * h0[2] * silu_(zf[2]), x0[3] * rs * h0[3] * silu_(zf[3]));
        w[2] = pk2(x1[0] * rs * h1[0] * silu_(zf[4]), x1[1] * rs * h1[1] * silu_(zf[5]));
        w[3] = pk2(x1[2] * rs * h1[2] * silu_(zf[6]), x1[3] * rs * h1[3] * silu_(zf[7]));
        *(u32x4*)(cp + k * 8) = w;
      }
    }
    __syncthreads();
  }
}

using s16x4 = __attribute__((ext_vector_type(4))) short;
#define KSWZ(row, colB) ((row) * 256 + ((colB) ^ (((row) & 7) << 4)))
#define SBAR() __builtin_amdgcn_sched_barrier(0)
__device__ __forceinline__ unsigned cvtpk(float lo, float hi) { unsigned r; asm volatile("v_cvt_pk_bf16_f32 %0, %1, %2" : "=v"(r) : "v"(lo), "v"(hi)); return r; }
__device__ __forceinline__ int v_st(int k, int c) { const int kk = (k & ~0xC) | ((k & 4) << 1) | ((k & 8) >> 1); return ((kk >> 3) * 4 + (c >> 5)) * 512 + ((kk & 7) * 32 + (c & 31)) * 2; }
__device__ __forceinline__ int v_rd_base(int lane) { return ((lane & 3) << 3) | (((lane >> 2) & 3) << 6) | (((lane >> 4) & 1) << 5) | (((lane >> 5) & 1) << 8); }
constexpr int v_rd_off(int d0, int ks, int half) { return d0 * 512 + ks * 4096 + half * 2048; }
template <int OFF> __device__ __forceinline__ s16x4 tr_read(int vb) {
  s16x4 r; asm volatile("ds_read_b64_tr_b16 %0, %1 offset:%2" : "=&v"(r) : "v"(vb), "i"(OFF) : "memory"); return r;
}
template <int D0> __device__ __forceinline__ void pv_one(f32x16& od, int vb, bf16x8 pa0, bf16x8 pa1, bf16x8 pa2, bf16x8 pa3) {
  const s16x4 l0 = tr_read<v_rd_off(D0, 0, 0)>(vb), h0 = tr_read<v_rd_off(D0, 0, 1)>(vb), l1 = tr_read<v_rd_off(D0, 1, 0)>(vb), h1 = tr_read<v_rd_off(D0, 1, 1)>(vb);
  const s16x4 l2 = tr_read<v_rd_off(D0, 2, 0)>(vb), h2 = tr_read<v_rd_off(D0, 2, 1)>(vb), l3 = tr_read<v_rd_off(D0, 3, 0)>(vb), h3 = tr_read<v_rd_off(D0, 3, 1)>(vb);
  asm volatile("s_waitcnt lgkmcnt(0)" ::: "memory"); SBAR();
#define PK(L, H) (bf16x8){L[0], L[1], L[2], L[3], H[0], H[1], H[2], H[3]}
  od = __builtin_amdgcn_mfma_f32_32x32x16_bf16(pa0, PK(l0, h0), od, 0, 0, 0);
  od = __builtin_amdgcn_mfma_f32_32x32x16_bf16(pa1, PK(l1, h1), od, 0, 0, 0);
  od = __builtin_amdgcn_mfma_f32_32x32x16_bf16(pa2, PK(l2, h2), od, 0, 0, 0);
  od = __builtin_amdgcn_mfma_f32_32x32x16_bf16(pa3, PK(l3, h3), od, 0, 0, 0);
#undef PK
}
__device__ __forceinline__ float pl32_other(float a, float b, int hi) {
  auto rr = __builtin_amdgcn_permlane32_swap(__float_as_uint(a), __float_as_uint(b), false, false);
  return __uint_as_float(hi ? rr[0] : rr[1]);
}
__device__ __forceinline__ void sb_half(f32x16& pz, float& run, bool need_mask, int kb, int t, int hi) {
  constexpr float C2 = 0.08838834764831845f * 1.4426950408889634f;
  f32x16 l;
#pragma unroll
  for (int r = 0; r < 16; ++r) {
    const float e = __builtin_amdgcn_exp2f(fminf(pz[r] * C2, 60.f));
    l[r] = __builtin_amdgcn_rcpf(1.f + e);
    pz[r] = e;
  }
  if (need_mask) {
#pragma unroll
    for (int r = 0; r < 16; ++r) { if (kb + crow(r, hi) >= t) { l[r] = 1.f; pz[r] = 0.f; } }
  }
#pragma unroll
  for (int g = 0; g < 4; ++g) { l[4 * g + 2] *= l[4 * g + 3]; l[4 * g + 1] *= l[4 * g + 2]; l[4 * g] *= l[4 * g + 1]; }
  const float cs3 = l[12], cs2 = l[8] * cs3, cs1 = l[4] * cs2, cs0 = l[0] * cs1;
  const float off0 = cs1 * pl32_other(cs0, cs1, hi) * run;
  const float off1 = cs2 * pl32_other(cs1, cs2, hi) * run;
  const float off2 = cs3 * pl32_other(cs2, cs3, hi) * run;
  const float off3 = pl32_other(cs3, 1.f, hi) * run;
  float tot;
  { auto rr = __builtin_amdgcn_permlane32_swap(__float_as_uint(cs0), __float_as_uint(cs0), false, false); tot = __uint_as_float(rr[0]) * __uint_as_float(rr[1]); }
#pragma unroll
  for (int r = 0; r < 4; ++r) {
    pz[r] = pz[r] * l[r] * off0; pz[4 + r] = pz[4 + r] * l[4 + r] * off1;
    pz[8 + r] = pz[8 + r] * l[8 + r] * off2; pz[12 + r] = pz[12 + r] * l[12 + r] * off3;
  }
  run *= tot;
}

__device__ __forceinline__ void attn_phase(const Params& p, char* smem, int bid, int nblk) {
  const int tid = otid(), wid = tid >> 6, lane = tid & 63, r32 = lane & 31, hi = lane >> 5;
  char* K_lds = smem; char* V_lds = smem + 16384;
  const u16* qkv = (const u16*)(p.ws + OFF_PROJ);
  u16* ao = (u16*)(p.ws + OFF_HN);
  const int sr = tid >> 4, sc = (tid & 15) * 8;
  const int vb0 = (int)(uintptr_t)V_lds + v_rd_base(lane);
  for (int k = 0; k * nblk < 2048; ++k) {
    const int i = (k & 1) ? ((k + 1) * nblk - 1 - bid) : (k * nblk + bid);
    if (i >= 2048) continue;
    const int j = 63 - (i >> 5), bh = i & 31, b = bh >> 3, h = bh & 7;
    const int i0 = j * 128;
    const size_t rowb = (size_t)b * SEQ;
    const int t = i0 + wid * 32 + r32, tmin = i0 + wid * 32, tmax = tmin + 31;
    bf16x8 qr[8];
    {
      const u16* qp = qkv + (rowb + t) * 3072 + h * 128 + hi * 8;
#pragma unroll
      for (int d0 = 0; d0 < 8; ++d0) qr[d0] = *(const bf16x8*)(qp + d0 * 16);
    }
    f32x16 o[4];
#pragma unroll
    for (int d = 0; d < 4; ++d)
#pragma unroll
      for (int r = 0; r < 16; ++r) o[d][r] = 0.f;
    float run = 1.f;
    const u16* kbase = qkv + rowb * 3072 + 1024 + h * 128 + sc;
    u32x4 stk[4], stv[4];
#define SLOAD(KT) do { _Pragma("unroll") for (int ii = 0; ii < 4; ++ii) { const u16* kp = kbase + (size_t)((KT) * 64 + sr + 16 * ii) * 3072; \
      stk[ii] = *(const u32x4*)kp; stv[ii] = *(const u32x4*)(kp + 1024); } } while (0)
#define SWRITE() do { _Pragma("unroll") for (int ii = 0; ii < 4; ++ii) { const int row = sr + 16 * ii; \
      *(u32x4*)(K_lds + KSWZ(row, sc * 2)) = stk[ii]; *(u32x4*)(V_lds + v_st(row, sc)) = stv[ii]; } } while (0)
    const int NT = 2 * j + 2;
    SLOAD(NT - 1); SWRITE(); __syncthreads();
    for (int kt = NT - 1; kt >= 0; --kt) {
      const int k0 = kt * 64;
      if (kt > 0) SLOAD(kt - 1);
      if (k0 <= tmax) {
        bf16x8 pa0, pa1, pa2, pa3;
#define PK4(P, BASE, OUT) do { unsigned a0 = cvtpk(P[BASE + 0], P[BASE + 1]), a1 = cvtpk(P[BASE + 2], P[BASE + 3]); \
    unsigned b0_ = cvtpk(P[BASE + 4], P[BASE + 5]), b1_ = cvtpk(P[BASE + 6], P[BASE + 7]); \
    auto r0 = __builtin_amdgcn_permlane32_swap(a0, b0_, false, false); auto r1 = __builtin_amdgcn_permlane32_swap(a1, b1_, false, false); \
    u32x4 w = {r0[0], r1[0], r0[1], r1[1]}; OUT = *reinterpret_cast<bf16x8*>(&w); } while (0)
        if (k0 + 32 <= tmax) {
          f32x16 pz;
#pragma unroll
          for (int r = 0; r < 16; ++r) pz[r] = 0.f;
#pragma unroll
          for (int d0 = 0; d0 < 8; ++d0) {
            const bf16x8 kf = *(const bf16x8*)(K_lds + KSWZ(32 + r32, (d0 * 16 + hi * 8) * 2));
            pz = __builtin_amdgcn_mfma_f32_32x32x16_bf16(kf, qr[d0], pz, 0, 0, 0);
          }
          sb_half(pz, run, k0 + 63 >= tmin, k0 + 32, t, hi);
          PK4(pz, 0, pa2); PK4(pz, 8, pa3);
        } else {
          pa2 = bf16x8{0, 0, 0, 0, 0, 0, 0, 0}; pa3 = pa2;
        }
        {
          f32x16 pz;
#pragma unroll
          for (int r = 0; r < 16; ++r) pz[r] = 0.f;
#pragma unroll
          for (int d0 = 0; d0 < 8; ++d0) {
            const bf16x8 kf = *(const bf16x8*)(K_lds + KSWZ(r32, (d0 * 16 + hi * 8) * 2));
            pz = __builtin_amdgcn_mfma_f32_32x32x16_bf16(kf, qr[d0], pz, 0, 0, 0);
          }
          sb_half(pz, run, k0 + 31 >= tmin, k0, t, hi);
          PK4(pz, 0, pa0); PK4(pz, 8, pa1);
        }
#undef PK4
        pv_one<0>(o[0], vb0, pa0, pa1, pa2, pa3); pv_one<1>(o[1], vb0, pa0, pa1, pa2, pa3);
        pv_one<2>(o[2], vb0, pa0, pa1, pa2, pa3); pv_one<3>(o[3], vb0, pa0, pa1, pa2, pa3);
      }
      __syncthreads();
      if (kt > 0) SWRITE();
      __syncthreads();
    }
#undef SLOAD
#undef SWRITE
    {
      const int orow0 = (int)rowb + i0 + wid * 32;
#pragma unroll
      for (int r = 0; r < 16; ++r) {
        const int orow = crow(r, hi);
#pragma unroll
        for (int d0 = 0; d0 < 4; ++d0) ao[a_off(orow0 + orow, h * 128 + d0 * 32 + r32, 32)] = f2bf(o[d0][r]);
      }
    }
  }
}

#define XB_TMO      128
#define XB_XCNT(j)  (256  + 64 * (j))
#define XB_XSUB(j)  (1280 + 64 * (j))
#define XB_XGEN(j)  (2304 + 64 * (j))
#define XB_TOP      3328
#define XB_TOPGEN   3392
#define XCD_BAR_WORDS 3456
#define XB_SPIN_CAP (1u << 23)
#define LAS __attribute__((address_space(3)))
__device__ __forceinline__ unsigned xb_ld(unsigned* p)              { return __hip_atomic_load(p, __ATOMIC_RELAXED, __HIP_MEMORY_SCOPE_AGENT); }
__device__ __forceinline__ unsigned xb_add(unsigned* p, unsigned v) { return __hip_atomic_fetch_add(p, v, __ATOMIC_RELAXED, __HIP_MEMORY_SCOPE_AGENT); }
__device__ __forceinline__ unsigned xb_xcc_id() { return (unsigned)__builtin_amdgcn_s_getreg((3 << 11) | 20) & 0xFu; }
#define XB_SPIN(cond, bar) do { unsigned _sp = 0; while (cond) { __builtin_amdgcn_s_sleep(1); \
    if ((++_sp & 255u) == 0u) { if (xb_ld(&(bar)[XB_TMO])) break; if (_sp > XB_SPIN_CAP) { atomicAdd(&(bar)[XB_TMO], 1u); break; } } } } while (0)
struct XcdBarrier { unsigned* bar; unsigned x; volatile LAS unsigned* st; };
__device__ __forceinline__ XcdBarrier xcd_barrier_post(unsigned* bar, volatile LAS unsigned* st) {
  XcdBarrier b; b.bar = bar; b.x = xb_xcc_id(); b.st = st;
  if (__builtin_amdgcn_workitem_id_x() == 0) (void)xb_add(&bar[XB_XCNT(b.x)], 1u);
  return b;
}
__device__ __forceinline__ void xcd_barrier_complete(unsigned* bar, unsigned x, unsigned& nloc, unsigned& nx) {
  const unsigned G = gridDim.x * gridDim.y * gridDim.z;
  unsigned sum, cnt, mine, sp = 0u;
  for (;;) {
    sum = 0u; cnt = 0u; mine = 0u;
#pragma unroll
    for (unsigned j = 0; j < 16; ++j) { const unsigned c = xb_ld(&bar[XB_XCNT(j)]); sum += c; cnt += (c > 0u) ? 1u : 0u; mine = (j == x) ? c : mine; }
    if (sum == G) break;
    __builtin_amdgcn_s_sleep(1);
    if ((++sp & 255u) == 0u) { if (xb_ld(&bar[XB_TMO])) break; if (sp > XB_SPIN_CAP) { atomicAdd(&bar[XB_TMO], 1u); break; } }
  }
  nloc = mine > 0u ? mine : 1u; nx = cnt > 0u ? cnt : 1u;
}
__device__ __forceinline__ void xcd_barrier(const XcdBarrier& b) {
  asm volatile("s_waitcnt vmcnt(0)" ::: "memory");
  __syncthreads();
  if (__builtin_amdgcn_workitem_id_x() == 0) {
    unsigned* bar = b.bar;
    __builtin_amdgcn_s_waitcnt(0);
    unsigned nloc = b.st[0], nx = b.st[1];
    if (nloc == 0u) { xcd_barrier_complete(bar, b.x, nloc, nx); b.st[0] = nloc; b.st[1] = nx; }
    const unsigned old = xb_add(&bar[XB_XSUB(b.x)], 1u);
    const unsigned gen = old / nloc;
    if (old + 1u == (gen + 1u) * nloc) {
      __builtin_amdgcn_fence(__ATOMIC_RELEASE, "agent");
      asm volatile("s_waitcnt vmcnt(0)" ::: "memory");
      const unsigned og = xb_add(&bar[XB_TOP], 1u);
      const unsigned tg = og / nx;
      if (og + 1u == (tg + 1u) * nx) xb_add(&bar[XB_TOPGEN], 1u);
      else XB_SPIN(xb_ld(&bar[XB_TOPGEN]) == tg, bar);
      __builtin_amdgcn_fence(__ATOMIC_ACQUIRE, "agent");
      xb_add(&bar[XB_XGEN(b.x)], 1u);
      asm volatile("s_waitcnt vmcnt(0)" ::: "memory");
    } else {
      XB_SPIN(xb_ld(&bar[XB_XGEN(b.x)]) == gen, bar);
      __builtin_amdgcn_fence(__ATOMIC_ACQUIRE, "agent");
      asm volatile("s_waitcnt vmcnt(0)" ::: "memory");
    }
  }
  __syncthreads();
}

__global__ void __launch_bounds__(256, 2) mega(Params p) {
  __shared__ __attribute__((aligned(16))) char smem[SMEM_BYTES];
  __shared__ uint4 xb_words;
  const int bid = blockIdx.x, nblk = gridDim.x;
  char* ws = p.ws;
  if (__builtin_amdgcn_workitem_id_x() == 0) xb_words = make_uint4(0u, 0u, 0u, 0u);
  __syncthreads();
  const XcdBarrier xbar = xcd_barrier_post((unsigned*)(ws + OFF_BAR), (volatile LAS unsigned*)&xb_words);
  const float* mod = (const float*)(ws + OFF_MOD);
  u16* hn = (u16*)(ws + OFF_HN);
#define PH_BEGIN(n) if (p.phase_lo <= (n) && (n) < p.phase_hi) {
#define PH_END(n) if ((n) + 1 < p.phase_hi) { if ((n) == 0) cg::this_grid().sync(); else xcd_barrier(xbar); } }
  PH_BEGIN(0) phase0(p, smem, bid, nblk); PH_END(0)
  PH_BEGIN(1) norm_phase<1>(p, p.x, p.norm_mix_w, mod, 0, 1024, smem, bid, nblk); PH_END(1)
  PH_BEGIN(2) { EpiArgs ea{}; ea.outb = (u16*)(ws + OFF_PROJ); ea.ux = (u16*)(ws + OFF_UX);
        gemm_phase<E_PROJ0>(hn, 32, 0, (const u16*)(ws + OFF_WT_HYIN), 32, 0, 1024, M / 256, PN / 128, 1, ea, smem, bid, nblk); } PH_END(2)
  PH_BEGIN(3) { EpiArgs ea{}; ea.outf = (float*)(ws + OFF_XE);
        gemm_phase<E_XE>((const u16*)(ws + OFF_UX), 20, (size_t)S5C * UXW, (const u16*)(ws + OFF_EG), 16, (size_t)128 * 512, 512, S5C / 256, 1, 32, ea, smem, bid, nblk); } PH_END(3)
  PH_BEGIN(4) { s5_carry_phase(p, bid, nblk); gdn_prep_phase(p, smem, bid, nblk); } PH_END(4)
  PH_BEGIN(5) {
        if (bid < 16) { gdn_scan_item(p, bid, smem); }
        else { EpiArgs ea{}; ea.outb = (u16*)(ws + OFF_Y5); ea.ux = (u16*)(ws + OFF_UX); ea.bias = p.s5_d;
          gemm_phase<E_S5Y>((const u16*)(ws + OFF_UX), 20, (size_t)S5C * UXW, (const u16*)(ws + OFF_MF), 20, (size_t)512 * UXW, UXW, S5C / 256, 4, 32, ea, smem, bid - 16, nblk - 16); }
      } PH_END(5)
  PH_BEGIN(6) { gdn_out_phase(p, smem, bid, nblk); __syncthreads();
 EpiArgs ea{}; ea.outb = hn; ea.y5 = (const u16*)(ws + OFF_Y5); ea.bias = p.s5_glu_b;
        gemm_phase<E_GLU>((const u16*)(ws + OFF_Y5), 16, 0, (const u16*)(ws + OFF_WT_GLU), 16, 0, 512, M / 256, 4, 1, ea, smem, bid, nblk); } PH_END(6)
  PH_BEGIN(8) { EpiArgs ea{}; ea.outf = p.out; ea.res = p.x; ea.gate = mod + 2048;
        gemm_phase<E_RESID>(hn, 32, 0, (const u16*)(ws + OFF_WT_HYOUT), 32, 0, 1024, M / 256, 8, 1, ea, smem, bid, nblk); } PH_END(8)
  PH_BEGIN(9) norm_phase<0>(p, p.out, p.norm_ffn_w, mod, 3072, 4096, smem, bid, nblk); PH_END(9)
  PH_BEGIN(10) { EpiArgs ea{}; ea.outb = (u16*)(ws + OFF_PROJ);
        gemm_phase<E_SWIGLU>(hn, 32, 0, (const u16*)(ws + OFF_WT_FFNIN), 32, 0, 1024, M / 256, 2 * FF / 128, 1, ea, smem, bid, nblk); } PH_END(10)
  PH_BEGIN(11) { EpiArgs ea{}; ea.outf = p.out; ea.res = p.out; ea.gate = mod + 5120;
        gemm_phase<E_RESID>((const u16*)(ws + OFF_PROJ), FF / 32, 0, (const u16*)(ws + OFF_WT_FFNOUT), FF / 32, 0, FF, M / 256, 8, 1, ea, smem, bid, nblk); } PH_END(11)
  PH_BEGIN(12) norm_phase<0>(p, p.out, p.norm_mix_w + 1024, mod + 4 * 6144, 0, 1024, smem, bid, nblk); PH_END(12)
  PH_BEGIN(13) { EpiArgs ea{}; ea.outb = (u16*)(ws + OFF_PROJ); ea.ldc = 3072;
        gemm_phase<E_BF16>(hn, 32, 0, (const u16*)(ws + OFF_WT_SBIN), 32, 0, 1024, M / 256, 24, 1, ea, smem, bid, nblk); } PH_END(13)
  PH_BEGIN(14) attn_phase(p, smem, bid, nblk); PH_END(14)
  PH_BEGIN(15) { EpiArgs ea{}; ea.outf = p.out; ea.res = p.out; ea.gate = mod + 4 * 6144 + 2048;
        gemm_phase<E_RESID>(hn, 32, 0, (const u16*)(ws + OFF_WT_SBOUT), 32, 0, 1024, M / 256, 8, 1, ea, smem, bid, nblk); } PH_END(15)
  PH_BEGIN(16) norm_phase<0>(p, p.out, p.norm_ffn_w + 1024, mod + 4 * 6144, 3072, 4096, smem, bid, nblk); PH_END(16)
  PH_BEGIN(17) { EpiArgs ea{}; ea.outb = (u16*)(ws + OFF_PROJ);
        gemm_phase<E_SWIGLU>(hn, 32, 0, (const u16*)(ws + OFF_WT_FFNIN + SZ_WT_FFNIN), 32, 0, 1024, M / 256, 2 * FF / 128, 1, ea, smem, bid, nblk); } PH_END(17)
  PH_BEGIN(18) { EpiArgs ea{}; ea.outf = p.out; ea.res = p.out; ea.gate = mod + 4 * 6144 + 5120;
        gemm_phase<E_RESID>((const u16*)(ws + OFF_PROJ), FF / 32, 0, (const u16*)(ws + OFF_WT_FFNOUT + SZ_WT_FFNOUT), FF / 32, 0, FF, M / 256, 8, 1, ea, smem, bid, nblk); } PH_END(18)
  PH_BEGIN(19) norm_phase<2>(p, p.out, p.final_norm_w, mod, 0, 0, smem, bid, nblk); PH_END(19)
}

extern "C" void kernel_launch(void* const* d_in, const int* in_sizes, int n_in, void* d_out, int out_size, void* d_ws, size_t ws_size,
                              hipStream_t stream) {
  static int grid_blocks = 0;
  if (!grid_blocks) {
    int dev = 0, cus = 0, per_cu = 0;
    hipGetDevice(&dev);
    hipDeviceGetAttribute(&cus, hipDeviceAttributeMultiprocessorCount, dev);
    hipOccupancyMaxActiveBlocksPerMultiprocessor(&per_cu, mega, 256, 0);
    if (per_cu > 2) per_cu = 2;
    if (per_cu < 1) per_cu = 1;
    grid_blocks = cus * per_cu;
  }
  Params p{};
  const float* const* in = (const float* const*)d_in;
  p.x = in[0]; p.c = in[1]; p.ada_w = in[2]; p.ada_b = in[3]; p.norm_mix_w = in[4]; p.norm_ffn_w = in[5]; p.ffn_w_in = in[6]; p.ffn_w_out = in[7];
  p.hy_w_in = in[8]; p.hy_conv_w = in[9]; p.hy_a_log = in[10]; p.hy_dt_bias = in[11]; p.hy_head_norm_w = in[12];
  p.s5_lam_re = in[13]; p.s5_lam_im = in[14]; p.s5_log_dt = in[15]; p.s5_b_re = in[16]; p.s5_b_im = in[17]; p.s5_c_re = in[18]; p.s5_c_im = in[19];
  p.s5_d = in[20]; p.s5_glu_w = in[21]; p.s5_glu_b = in[22]; p.hy_w_out = in[23]; p.sb_w_in = in[24]; p.sb_w_out = in[25]; p.final_norm_w = in[26];
  p.out = (float*)d_out; p.ws = (char*)d_ws;
#if ONE_LAUNCH
  p.phase_lo = 0; p.phase_hi = NPHASE;
  (void)hipMemsetAsync((char*)d_ws + OFF_BAR, 0, (size_t)XCD_BAR_WORDS_C * 4, stream);
  void* args[] = {&p};
  hipError_t e = hipLaunchCooperativeKernel((void*)mega, dim3(grid_blocks), dim3(256), args, 0, stream);
  if (e != hipSuccess) fprintf(stderr, "cooperative launch failed: %s (grid %d)\n", hipGetErrorString(e), grid_blocks);
#else
  for (int ph = 0; ph < NPHASE; ++ph) {
    p.phase_lo = ph; p.phase_hi = ph + 1;
    hipLaunchKernelGGL(mega, dim3(grid_blocks), dim3(256), 0, stream, p);
  }
#endif
}
```

```cpp
#include <hip/hip_runtime.h>
#include <hip/hip_cooperative_groups.h>
#include <stdint.h>
#include <cstdio>
namespace cg = cooperative_groups;

#ifndef ONE_LAUNCH
#define ONE_LAUNCH 1
#endif

typedef unsigned short u16;
using bf16x8 = __attribute__((ext_vector_type(8))) short;
using f32x4 = __attribute__((ext_vector_type(4))) float;
using u32x4 = __attribute__((ext_vector_type(4))) unsigned;

constexpr int D = 1024, NB = 4, SEQ = 8192, M = NB * SEQ, FF = 2816, EIN = 2568, PN = 2560, PJ = 2048;
constexpr int NPHASE = 20;
constexpr int XCD_BAR_WORDS_C = 3456;
constexpr int S5T = 32, S5C = M / S5T, UXW = 640;

constexpr size_t SZ_WT_HYIN = (size_t)PN * 1024 * 2, SZ_WT_SQ = (size_t)1024 * 1024 * 2, SZ_WT_GLU = (size_t)512 * 512 * 2;
constexpr size_t SZ_WT_FFNIN = (size_t)2 * FF * 1024 * 2, SZ_WT_FFNOUT = (size_t)1024 * FF * 2, SZ_WT_SBIN = (size_t)3072 * 1024 * 2;
constexpr size_t OFF_WT_HYIN = 0;
constexpr size_t OFF_WT_HYOUT = OFF_WT_HYIN + SZ_WT_HYIN;
constexpr size_t OFF_WT_GLU = OFF_WT_HYOUT + SZ_WT_SQ;
constexpr size_t OFF_WT_FFNIN = OFF_WT_GLU + SZ_WT_GLU;
constexpr size_t OFF_WT_FFNOUT = OFF_WT_FFNIN + 2 * SZ_WT_FFNIN;
constexpr size_t OFF_WT_SBIN = OFF_WT_FFNOUT + 2 * SZ_WT_FFNOUT;
constexpr size_t OFF_WT_SBOUT = OFF_WT_SBIN + SZ_WT_SBIN;
constexpr size_t OFF_MOD = OFF_WT_SBOUT + SZ_WT_SQ;
constexpr size_t OFF_BETA = OFF_MOD + (size_t)2 * 4 * 6144 * 4;
constexpr size_t OFF_G = OFF_BETA + (size_t)M * 4 * 4;
constexpr size_t OFF_HN = OFF_G + (size_t)M * 4 * 4;
constexpr size_t OFF_Y5 = OFF_HN + (size_t)M * 1024 * 2;
constexpr size_t OFF_UX = OFF_Y5 + (size_t)M * 512 * 2;
constexpr size_t OFF_MF = OFF_UX + (size_t)32 * S5C * UXW * 2;
constexpr size_t OFF_EG = OFF_MF + (size_t)32 * 512 * UXW * 2;
constexpr size_t OFF_XE = OFF_EG + (size_t)32 * 128 * 512 * 2;
constexpr size_t OFF_A32 = OFF_XE + (size_t)32 * S5C * 128 * 4;
constexpr size_t OFF_PROJ = OFF_A32 + (size_t)32 * 64 * 2 * 4;
constexpr size_t OFF_GW = OFF_PROJ + (size_t)M * PJ * 2;
constexpr size_t OFF_GQD = OFF_GW + (size_t)2048 * 8192 * 2;
constexpr size_t OFF_GKT = OFF_GQD + (size_t)2048 * 8192 * 2;
constexpr size_t OFF_GUT = OFF_GKT + (size_t)2048 * 8192 * 2;
constexpr size_t OFF_GAT = OFF_GUT + (size_t)2048 * 8192 * 2;
constexpr size_t OFF_GSD = OFF_GAT + (size_t)2048 * 4096 * 2;
constexpr size_t OFF_BAR = OFF_GSD + (size_t)2048 * 4;
constexpr size_t WS_TOTAL = OFF_BAR + (size_t)XCD_BAR_WORDS_C * 4;
static_assert((size_t)M * 3072 * 2 <= WS_TOTAL - OFF_PROJ, "QKV alias");
static_assert(WS_TOTAL <= (size_t)512 * 1024 * 1024, "workspace too large");

struct Params {
  const float *x, *c, *ada_w, *ada_b, *norm_mix_w, *norm_ffn_w, *ffn_w_in, *ffn_w_out;
  const float *hy_w_in, *hy_conv_w, *hy_a_log, *hy_dt_bias, *hy_head_norm_w;
  const float *s5_lam_re, *s5_lam_im, *s5_log_dt, *s5_b_re, *s5_b_im, *s5_c_re, *s5_c_im, *s5_d, *s5_glu_w, *s5_glu_b, *hy_w_out;
  const float *sb_w_in, *sb_w_out, *final_norm_w;
  float* out;
  char* ws;
  int phase_lo, phase_hi;
};

constexpr int SMEM_BYTES = 73728;

__device__ __forceinline__ int otid() { int t = __builtin_amdgcn_workitem_id_x(); asm volatile("" : "+v"(t)); return t; }
__device__ __forceinline__ u16 f2bf(float x) { unsigned u = __float_as_uint(x); u += 0x7fffu + ((u >> 16) & 1u); return (u16)(u >> 16); }
typedef __bf16 bf16v2 __attribute__((ext_vector_type(2)));
typedef float f32v2 __attribute__((ext_vector_type(2)));
__device__ __forceinline__ unsigned pk2(float a, float b) { f32v2 v = {a, b}; bf16v2 r = __builtin_convertvector(v, bf16v2); return __builtin_bit_cast(unsigned, r); }
__device__ __forceinline__ float bf2f(u16 v) { return __uint_as_float(((unsigned)v) << 16); }
__device__ __forceinline__ float sigmoid_(float x) { return __builtin_amdgcn_rcpf(1.f + __expf(-x)); }
__device__ __forceinline__ float silu_(float x) { return x * sigmoid_(x); }
__device__ __forceinline__ float softplus_(float x) { return fmaxf(x, 0.f) + log1pf(__expf(-fabsf(x))); }
__device__ __forceinline__ float gelu_tanh_(float y) { return 0.5f * y * (1.f + tanhf(0.7978845608028654f * (y + 0.044715f * y * y * y))); }

__device__ __forceinline__ size_t pj_idx(int row, int col) { return (size_t)(col >> 9) * ((size_t)M * 512) + (size_t)row * 512 + (col & 511); }
__device__ __forceinline__ size_t a_off(int row, int col, int nks) { return ((size_t)((row >> 8) * nks + (col >> 5)) << 13) + ((row & 255) << 5) + (col & 31); }
__device__ __forceinline__ size_t b_off(int n, int k, int nks) { return ((size_t)((n >> 7) * nks + (k >> 5)) << 12) + ((n & 127) << 5) + (k & 31); }

struct TrJob { const float* src; u16* dst; int K, Nsrc, Nd, mode; };
__device__ __forceinline__ TrJob get_job(const Params& p, int j) {
  TrJob t;
  switch (j) {
    case 0: t = {p.hy_w_in, (u16*)(p.ws + OFF_WT_HYIN), 1024, EIN, PN, 1}; break;
    case 1: t = {p.hy_w_out, (u16*)(p.ws + OFF_WT_HYOUT), 1024, 1024, 1024, 0}; break;
    case 2: t = {p.s5_glu_w, (u16*)(p.ws + OFF_WT_GLU), 512, 512, 512, 0}; break;
    case 3: t = {p.ffn_w_in, (u16*)(p.ws + OFF_WT_FFNIN), 1024, 2 * FF, 2 * FF, 2}; break;
    case 4: t = {p.ffn_w_in + (size_t)1024 * 2 * FF, (u16*)(p.ws + OFF_WT_FFNIN + SZ_WT_FFNIN), 1024, 2 * FF, 2 * FF, 2}; break;
    case 5: t = {p.ffn_w_out, (u16*)(p.ws + OFF_WT_FFNOUT), FF, 1024, 1024, 0}; break;
    case 6: t = {p.ffn_w_out + (size_t)FF * 1024, (u16*)(p.ws + OFF_WT_FFNOUT + SZ_WT_FFNOUT), FF, 1024, 1024, 0}; break;
    case 7: t = {p.sb_w_in, (u16*)(p.ws + OFF_WT_SBIN), 1024, 3072, 3072, 0}; break;
    default: t = {p.sb_w_out, (u16*)(p.ws + OFF_WT_SBOUT), 1024, 1024, 1024, 0}; break;
  }
  return t;
}
__device__ __forceinline__ int src_col(int R, int mode) {
  if (mode == 0) return R;
  if (mode == 1) return R < 2048 ? R : R + 8;
  return ((R >> 4) & 1) * FF + (R >> 5) * 16 + (R & 15);
}
constexpr int N_TR_ITEMS = 640 + 256 + 64 + 2 * 1408 + 2 * 704 + 768 + 256;
constexpr int N_MOD_ITEMS = 2 * 6144 / 16;

__device__ __forceinline__ void s5_table_item(const Params& p, int item, char* smem) {
  const int tid = otid(), g = item >> 5, tau = item & 31;
  float* pwr = (float*)smem; float* pwi = pwr + 64; float* p1r = pwi + 64; float* p1i = p1r + 64;
  float* bbr = p1i + 64; float* bbi = bbr + 1024; float* cre = bbi + 1024; float* cim = cre + 1024;
  const float dt = expf(p.s5_log_dt[g]);
  if (tid < 64) {
    const float lr = p.s5_lam_re[g * 64 + tid], li = p.s5_lam_im[g * 64 + tid];
    float sn, cs;
    float mg = expf(lr * dt * (float)tau); sincosf(li * dt * (float)tau, &sn, &cs); pwr[tid] = mg * cs; pwi[tid] = mg * sn;
    mg = expf(lr * dt * (float)(tau + 1)); sincosf(li * dt * (float)(tau + 1), &sn, &cs); p1r[tid] = mg * cs; p1i[tid] = mg * sn;
    if (tau == 31) { float* a32 = (float*)(p.ws + OFF_A32); a32[(g * 64 + tid) * 2] = mg * cs; a32[(g * 64 + tid) * 2 + 1] = mg * sn; }
  }
  {
    const int pp = tid >> 2, hq = (tid & 3) * 4;
    const float lr = p.s5_lam_re[g * 64 + pp], li = p.s5_lam_im[g * 64 + pp];
    const float mg = expf(lr * dt); float sn, cs; sincosf(li * dt, &sn, &cs);
    const float ar = mg * cs, ai = mg * sn, den = lr * lr + li * li, nr = ar - 1.f, ni = ai;
    const float fre = (nr * lr + ni * li) / den, fim = (ni * lr - nr * li) / den;
#pragma unroll
    for (int e = 0; e < 4; ++e) {
      const float br = p.s5_b_re[(size_t)(g * 64 + pp) * 16 + hq + e], bi = p.s5_b_im[(size_t)(g * 64 + pp) * 16 + hq + e];
      bbr[pp * 16 + hq + e] = fre * br - fim * bi; bbi[pp * 16 + hq + e] = fre * bi + fim * br;
    }
    for (int i = tid; i < 1024; i += 256) { cre[i] = p.s5_c_re[(size_t)g * 1024 + i]; cim[i] = p.s5_c_im[(size_t)g * 1024 + i]; }
  }
  __syncthreads();
  u16* mf = (u16*)(p.ws + OFF_MF) + (size_t)g * 512 * UXW;
  u16* eg = (u16*)(p.ws + OFF_EG) + (size_t)g * 128 * 512;
  {
    const int h = tid >> 4, hp = tid & 15;
    float kv = 0.f;
    for (int pp = 0; pp < 64; ++pp) {
      const float cr = cre[h * 64 + pp], ci = cim[h * 64 + pp], pr = pwr[pp], pi = pwi[pp];
      kv += (cr * pr - ci * pi) * bbr[pp * 16 + hp] - (cr * pi + ci * pr) * bbi[pp * 16 + hp];
    }
    const u16 kb = f2bf(kv);
    for (int s0 = 0; s0 + tau < 32; ++s0) mf[b_off((s0 + tau) * 16 + h, s0 * 16 + hp, 20)] = kb;
    for (int t0 = 0; t0 + tau + 1 < 32; ++t0) mf[b_off(t0 * 16 + h, (t0 + tau + 1) * 16 + hp, 20)] = 0;
#pragma unroll
    for (int e = 0; e < 4; ++e) {
      const int pp = hp * 4 + e;
      const float cr = cre[h * 64 + pp], ci = cim[h * 64 + pp], pr = p1r[pp], pi = p1i[pp];
      mf[b_off(tau * 16 + h, 512 + pp, 20)] = f2bf(cr * pr - ci * pi);
      mf[b_off(tau * 16 + h, 576 + pp, 20)] = f2bf(-(cr * pi + ci * pr));
    }
  }
  {
    const int pp = tid >> 2, hq = (tid & 3) * 4, s0 = 31 - tau;
#pragma unroll
    for (int e = 0; e < 4; ++e) {
      const float br = bbr[pp * 16 + hq + e], bi = bbi[pp * 16 + hq + e], pr = pwr[pp], pi = pwi[pp];
      eg[b_off(pp, s0 * 16 + hq + e, 16)] = f2bf(pr * br - pi * bi);
      eg[b_off(64 + pp, s0 * 16 + hq + e, 16)] = f2bf(pr * bi + pi * br);
    }
  }
  __syncthreads();
}

__device__ __forceinline__ void phase0(const Params& p, char* smem, int bid, int nblk) {
  const int tid = otid();
  for (int it = bid; it < N_TR_ITEMS + N_MOD_ITEMS + 1024; it += nblk) {
    if (it >= N_TR_ITEMS + N_MOD_ITEMS) { s5_table_item(p, it - N_TR_ITEMS - N_MOD_ITEMS, smem); continue; }
    if (it < N_TR_ITEMS) {
      int rem = it, j = 0; TrJob jb;
      for (;; ++j) { jb = get_job(p, j); int n = (jb.Nd >> 6) * (jb.K >> 6); if (rem < n) break; rem -= n; }
      const int nk = jb.K >> 6, R0 = (rem / nk) * 64, k0 = (rem % nk) * 64;
      u16* s = (u16*)smem;
      {
        const int r = tid & 63, kk = tid >> 6;
        const float* sp = jb.src + (size_t)k0 * jb.Nsrc + src_col(R0 + r, jb.mode);
#pragma unroll
        for (int i = 0; i < 16; ++i) { int k = kk + 4 * i; s[r * 72 + k] = f2bf(sp[(size_t)k * jb.Nsrc]); }
      }
      __syncthreads();
      {
        const int r = tid >> 2, ch = tid & 3;
#pragma unroll
        for (int i = 0; i < 2; ++i) {
          int c8 = (ch + 4 * i) * 8;
          *(u32x4*)(jb.dst + b_off(R0 + r, k0 + c8, jb.K >> 5)) = *(const u32x4*)(s + r * 72 + c8);
        }
      }
      __syncthreads();
    } else {
      const int mi = it - N_TR_ITEMS, l = mi / 384, n0 = (mi % 384) * 16;
      float* cact = (float*)smem;
      float* red = cact + 4096;
      for (int i = tid; i < 4096; i += 256) cact[i] = silu_(p.c[i]);
      __syncthreads();
      const int cl = tid & 15, ksub = tid >> 4;
      float a0 = 0, a1 = 0, a2 = 0, a3 = 0;
      const float* wp = p.ada_w + (size_t)l * 1024 * 6144 + n0 + cl;
#pragma unroll 16
      for (int k = ksub * 64; k < ksub * 64 + 64; ++k) {
        float w = wp[(size_t)k * 6144];
        a0 += cact[k] * w; a1 += cact[1024 + k] * w; a2 += cact[2048 + k] * w; a3 += cact[3072 + k] * w;
      }
      red[(ksub * 4 + 0) * 16 + cl] = a0; red[(ksub * 4 + 1) * 16 + cl] = a1;
      red[(ksub * 4 + 2) * 16 + cl] = a2; red[(ksub * 4 + 3) * 16 + cl] = a3;
      __syncthreads();
      if (tid < 64) {
        const int b = tid >> 4;
        float sum = 0.f;
#pragma unroll
        for (int q = 0; q < 16; ++q) sum += red[(q * 4 + b) * 16 + cl];
        float* mod = (float*)(p.ws + OFF_MOD);
        mod[(size_t)(l * 4 + b) * 6144 + n0 + cl] = sum + p.ada_b[l * 6144 + n0 + cl];
      }
      __syncthreads();
    }
  }
}

template <int MODE>
__device__ __forceinline__ void norm_phase(const Params& p, const float* src, const float* w, const float* modl, int sh_off, int sc_off,
                           char* smem, int bid, int nblk) {
  const int tid = otid(), wid = tid >> 6, lane = tid & 63;
  float* wba = (float*)smem;
  if (MODE == 1) {
    for (int i = tid; i < 1024 * 8; i += 256) wba[i] = p.hy_w_in[(size_t)(i >> 3) * EIN + 2048 + (i & 7)];
    __syncthreads();
  }
  u16* hn = (u16*)(p.ws + OFF_HN);
  auto process = [&](int row, f32x4 (&v)[4]) {
    float ss = 0.f;
#pragma unroll
    for (int i = 0; i < 4; ++i) ss += v[i][0] * v[i][0] + v[i][1] * v[i][1] + v[i][2] * v[i][2] + v[i][3] * v[i][3];
#pragma unroll
    for (int o = 32; o >= 1; o >>= 1) ss += __shfl_xor(ss, o);
    const float rstd = rsqrtf(ss * (1.f / 1024.f) + 1e-6f);
    const int b = row >> 13;
    float dots[8];
    if (MODE == 1) { for (int j = 0; j < 8; ++j) dots[j] = 0.f; }
#pragma unroll
    for (int i = 0; i < 4; ++i) {
      const int c0 = i * 256 + lane * 4;
      f32x4 ww = *(const f32x4*)(w + c0);
      f32x4 y;
      if (MODE == 2) {
#pragma unroll
        for (int e = 0; e < 4; ++e) y[e] = v[i][e] * rstd * ww[e];
        *(f32x4*)(p.out + (size_t)row * 1024 + c0) = y;
      } else {
        f32x4 sc = *(const f32x4*)(modl + (size_t)b * 6144 + sc_off + c0);
        f32x4 sh = *(const f32x4*)(modl + (size_t)b * 6144 + sh_off + c0);
#pragma unroll
        for (int e = 0; e < 4; ++e) y[e] = v[i][e] * rstd * ww[e] * (1.f + sc[e]) + sh[e];
        uint2 pk; pk.x = (unsigned)f2bf(y[0]) | ((unsigned)f2bf(y[1]) << 16); pk.y = (unsigned)f2bf(y[2]) | ((unsigned)f2bf(y[3]) << 16);
        *(uint2*)(hn + a_off(row, c0, 32)) = pk;
        if (MODE == 1) {
#pragma unroll
          for (int e = 0; e < 4; ++e) {
            f32x4 w0 = *(const f32x4*)(wba + (c0 + e) * 8), w1 = *(const f32x4*)(wba + (c0 + e) * 8 + 4);
#pragma unroll
            for (int j = 0; j < 4; ++j) { dots[j] += y[e] * w0[j]; dots[4 + j] += y[e] * w1[j]; }
          }
        }
      }
    }
    if (MODE == 1) {
#pragma unroll
      for (int j = 0; j < 8; ++j) {
#pragma unroll
        for (int o = 32; o >= 1; o >>= 1) dots[j] += __shfl_xor(dots[j], o);
      }
      if (lane == 0) {
        float* beta = (float*)(p.ws + OFF_BETA); float* gg = (float*)(p.ws + OFF_G);
#pragma unroll
        for (int h = 0; h < 4; ++h) {
          beta[(size_t)row * 4 + h] = sigmoid_(dots[h]);
          gg[(size_t)row * 4 + h] = -__expf(p.hy_a_log[h]) * softplus_(dots[4 + h] + p.hy_dt_bias[h]);
        }
      }
    }
  };
#pragma unroll 1
  for (int row = bid * 4 + wid; row < M; row += nblk * 8) {
    const int row1 = row + nblk * 4;
    const bool has1 = row1 < M;
    f32x4 v0[4], v1[4];
#pragma unroll
    for (int i = 0; i < 4; ++i) v0[i] = *(const f32x4*)(src + (size_t)row * 1024 + i * 256 + lane * 4);
#pragma unroll
    for (int i = 0; i < 4; ++i) v1[i] = has1 ? *(const f32x4*)(src + (size_t)row1 * 1024 + i * 256 + lane * 4) : f32x4{0.f, 0.f, 0.f, 0.f};
    process(row, v0);
    if (has1) process(row1, v1);
  }
}

enum { E_PROJ0 = 0, E_BF16 = 1, E_RESID = 2, E_GLU = 3, E_SWIGLU = 4, E_XE = 5, E_S5Y = 6 };
struct EpiArgs { float* outf; u16* outb; const float* res; const float* gate; const u16* y5; const float* bias; u16* ux; int ldc; };

template <int EPI>
__device__ __forceinline__ void gemm_phase(const u16* __restrict__ A0, int nksA, size_t sA, const u16* __restrict__ B0, int nksB, size_t sB,
                                           int K, int nM, int nN, int nbatch, const EpiArgs ea, char* smem, int bid, int nblk) {
  const int tid = otid(), wid = tid >> 6, lane = tid & 63, wr = wid >> 1, wc = wid & 1, fr = lane & 15, fq = lane >> 4;
  char* SA = smem; char* SB = smem + 49152;
  const int sa0 = (int)(uintptr_t)SA + (wr * 128 + fr) * 64 + fq * 16, sb0 = (int)(uintptr_t)SB + (wc * 64 + fr) * 64 + fq * 16;
  const int NR = nbatch * nM, ntiles = NR * nN;
  const int STN = (nN & 7) == 0 ? 8 : ((nN & 3) == 0 ? 4 : 1), STM = 64 / STN, nSN = nN / STN;
  const bool swz = ((nblk & 7) == 0) && (NR % STM == 0);
  const int lpx = nblk >> 3;
  int si = bid & 7, l = bid >> 3, tl = bid;
#pragma unroll 1
  for (;;) {
    int R, pn;
    if (swz) {
      if (si >= (NR / STM) * nSN) break;
      R = (si / nSN) * STM + l / STN; pn = (si % nSN) * STN + l % STN;
      l += lpx; if (l >= 64) { l = bid >> 3; si += 8; }
    } else {
      if (tl >= ntiles) break;
      R = tl / nN; pn = tl % nN; tl += nblk;
    }
    const int g = R / nM, rt = R % nM, brow = rt << 8, bcol = pn << 7;
    const char* A = (const char*)(A0 + (size_t)g * sA) + ((size_t)rt * nksA << 14) + tid * 16;
    const char* Bt = (const char*)(B0 + (size_t)g * sB) + ((size_t)pn * nksB << 13) + tid * 16;
    int nk = K >> 5, klim = nk;
    if (EPI == E_S5Y) { klim = 4 * (pn + 1); nk = klim + 4; }
    f32x4 acc[8][4];
#pragma unroll
    for (int m = 0; m < 8; ++m)
#pragma unroll
      for (int n = 0; n < 4; ++n) acc[m][n] = f32x4{0.f, 0.f, 0.f, 0.f};
#define GSTAGE(KK, BUF) do { const int kt_ = (EPI == E_S5Y && (KK) >= klim) ? (16 + (KK) - klim) : (KK); \
      _Pragma("unroll") for (int i = 0; i < 4; ++i) \
        __builtin_amdgcn_global_load_lds((const unsigned*)(A + ((size_t)kt_ << 14) + i * 4096), (__attribute__((address_space(3))) unsigned*)(SA + (BUF) * 16384 + tid * 16 + i * 4096), 16, 0, 0); \
      _Pragma("unroll") for (int i = 0; i < 2; ++i) \
        __builtin_amdgcn_global_load_lds((const unsigned*)(Bt + ((size_t)kt_ << 13) + i * 4096), (__attribute__((address_space(3))) unsigned*)(SB + (BUF) * 8192 + tid * 16 + i * 4096), 16, 0, 0); } while (0)
    asm volatile("s_waitcnt vmcnt(0)" ::: "memory");
    GSTAGE(0, 0);
    if (nk > 1) { GSTAGE(1, 1); asm volatile("s_waitcnt vmcnt(6)\n\ts_barrier" ::: "memory"); }
    else { asm volatile("s_waitcnt vmcnt(0)\n\ts_barrier" ::: "memory"); }
    int buf = 0, nbuf = 2;
#pragma unroll 1
    for (int kk = 0; kk < nk; ++kk) {
      const bool more = kk + 2 < nk;
      if (more) GSTAGE(kk + 2, nbuf);
      bf16x8 Bl[4], At[8];
      {
        const int bb = sb0 + buf * 8192, ab = sa0 + buf * 16384;
        asm volatile(
            "ds_read_b128 %0, %12\n\tds_read_b128 %1, %12 offset:1024\n\tds_read_b128 %2, %12 offset:2048\n\tds_read_b128 %3, %12 offset:3072\n\t"
            "ds_read_b128 %4, %13\n\tds_read_b128 %5, %13 offset:1024\n\tds_read_b128 %6, %13 offset:2048\n\tds_read_b128 %7, %13 offset:3072\n\t"
            "ds_read_b128 %8, %13 offset:4096\n\tds_read_b128 %9, %13 offset:5120\n\tds_read_b128 %10, %13 offset:6144\n\tds_read_b128 %11, %13 offset:7168\n\t"
            "s_waitcnt lgkmcnt(4)"
            : "=&v"(Bl[0]), "=&v"(Bl[1]), "=&v"(Bl[2]), "=&v"(Bl[3]), "=&v"(At[0]), "=&v"(At[1]), "=&v"(At[2]), "=&v"(At[3]),
              "=&v"(At[4]), "=&v"(At[5]), "=&v"(At[6]), "=&v"(At[7])
            : "v"(bb), "v"(ab)
            : "memory");
      }
      __builtin_amdgcn_s_setprio(1);
#pragma unroll
      for (int m = 0; m < 4; ++m)
#pragma unroll
        for (int n = 0; n < 4; ++n) acc[m][n] = __builtin_amdgcn_mfma_f32_16x16x32_bf16(Bl[n], At[m], acc[m][n], 0, 0, 0);
      __builtin_amdgcn_sched_barrier(0);
      asm volatile("s_waitcnt lgkmcnt(0)" : "+v"(At[4]), "+v"(At[5]), "+v"(At[6]), "+v"(At[7]) :: "memory");
      __builtin_amdgcn_sched_barrier(0);
#pragma unroll
      for (int m = 4; m < 8; ++m)
#pragma unroll
        for (int n = 0; n < 4; ++n) acc[m][n] = __builtin_amdgcn_mfma_f32_16x16x32_bf16(Bl[n], At[m], acc[m][n], 0, 0, 0);
      __builtin_amdgcn_s_setprio(0);
      if (more) asm volatile("s_waitcnt vmcnt(6)\n\ts_barrier" ::: "memory");
      else asm volatile("s_waitcnt vmcnt(0)\n\ts_barrier" ::: "memory");
      buf = (buf == 2) ? 0 : buf + 1; nbuf = (nbuf == 2) ? 0 : nbuf + 1;
    }
#undef GSTAGE
#pragma unroll
    for (int m = 0; m < 8; ++m)
#pragma unroll
      for (int n = 0; n < 4; ++n) {
        const int row = brow + wr * 128 + m * 16 + fr, col = bcol + wc * 64 + n * 16 + fq * 4;
        const f32x4 v = acc[m][n];
        if (EPI == E_PROJ0) {
          const uint2 pk = uint2{pk2(v[0], v[1]), pk2(v[2], v[3])};
          if (bcol < 2048) *(uint2*)(ea.outb + pj_idx(row, col)) = pk;
          else { const int cc = col - 2048; *(uint2*)(ea.ux + (size_t)(cc >> 4) * S5C * UXW + a_off(row >> 5, (row & 31) * 16 + (cc & 15), 20)) = pk; }
        }
        if (EPI == E_BF16) *(uint2*)(ea.outb + (size_t)row * ea.ldc + col) = uint2{pk2(v[0], v[1]), pk2(v[2], v[3])};
        if (EPI == E_RESID) {
          const size_t idx = (size_t)row * 1024 + col;
          const f32x4 r4 = *(const f32x4*)(ea.res + idx), g4 = *(const f32x4*)(ea.gate + (size_t)(row >> 13) * 6144 + col);
          *(f32x4*)(ea.outf + idx) = f32x4{r4[0] + g4[0] * v[0], r4[1] + g4[1] * v[1], r4[2] + g4[2] * v[2], r4[3] + g4[3] * v[3]};
        }
        if (EPI == E_GLU) {
          const uint2 yy = *(const uint2*)(ea.y5 + a_off(row, col, 16));
          const f32x4 b4 = *(const f32x4*)(ea.bias + col);
          const float y0 = __uint_as_float(yy.x << 16), y1 = __uint_as_float(yy.x & 0xffff0000u), y2 = __uint_as_float(yy.y << 16), y3 = __uint_as_float(yy.y & 0xffff0000u);
          *(uint2*)(ea.outb + a_off(row, 512 + col, 32)) = uint2{pk2(y0 * sigmoid_(v[0] + b4[0]), y1 * sigmoid_(v[1] + b4[1])), pk2(y2 * sigmoid_(v[2] + b4[2]), y3 * sigmoid_(v[3] + b4[3]))};
        }
        if (EPI == E_SWIGLU) {
          if ((n & 1) == 0) {
            const f32x4 u = acc[m][n | 1];
            const int co = (bcol >> 1) + wc * 32 + (n >> 1) * 16 + fq * 4;
            *(uint2*)(ea.outb + a_off(row, co, FF / 32)) = uint2{pk2(silu_(v[0]) * u[0], silu_(v[1]) * u[1]), pk2(silu_(v[2]) * u[2], silu_(v[3]) * u[3])};
          }
        }
        if (EPI == E_XE) *(f32x4*)(ea.outf + ((size_t)g * S5C + row) * 128 + col) = v;
        if (EPI == E_S5Y) {
          const uint2 uu = *(const uint2*)(ea.ux + (size_t)g * S5C * UXW + a_off(row, col, 20));
          const f32x4 d4 = *(const f32x4*)(ea.bias + g * 16 + (col & 15));
          const float u0 = __uint_as_float(uu.x << 16), u1 = __uint_as_float(uu.x & 0xffff0000u), u2 = __uint_as_float(uu.y << 16), u3 = __uint_as_float(uu.y & 0xffff0000u);
          *(uint2*)(ea.outb + a_off(row * 32 + (col >> 4), g * 16 + (col & 15), 16)) =
              uint2{pk2(gelu_tanh_(v[0] + d4[0] * u0), gelu_tanh_(v[1] + d4[1] * u1)), pk2(gelu_tanh_(v[2] + d4[2] * u2), gelu_tanh_(v[3] + d4[3] * u3))};
        }
      }
  }
}

__device__ __forceinline__ void s5_carry_phase(const Params& p, int bid, int nblk) {
  const float* xe = (const float*)(p.ws + OFF_XE); const float* a32 = (const float*)(p.ws + OFF_A32);
  u16* ux = (u16*)(p.ws + OFF_UX);
  for (int it = bid; it < 32; it += nblk) {
    const int idx = it * 256 + otid(), pp = idx & 63, g = (idx >> 6) & 31, b = idx >> 11;
    const float ar = a32[(g * 64 + pp) * 2], ai = a32[(g * 64 + pp) * 2 + 1];
    float xr = 0.f, xi = 0.f;
    const size_t cbase = (size_t)g * S5C + b * 256, gbase = (size_t)g * S5C * UXW;
    for (int n = 0; n < 256; n += 8) {
      float er[8], ei[8];
#pragma unroll
      for (int e = 0; e < 8; ++e) { er[e] = xe[(cbase + n + e) * 128 + pp]; ei[e] = xe[(cbase + n + e) * 128 + 64 + pp]; }
#pragma unroll
      for (int e = 0; e < 8; ++e) {
        ux[gbase + a_off(b * 256 + n + e, 512 + pp, 20)] = f2bf(xr); ux[gbase + a_off(b * 256 + n + e, 576 + pp, 20)] = f2bf(xi);
        const float nr = ar * xr - ai * xi + er[e], ni = ar * xi + ai * xr + ei[e];
        xr = nr; xi = ni;
      }
    }
  }
}

__device__ __forceinline__ int crow(int r, int hi) { return (r & 3) + 8 * (r >> 2) + 4 * hi; }
using f32x16 = __attribute__((ext_vector_type(16))) float;
__device__ __forceinline__ void unpack8(const u32x4 w, float* f) {
#pragma unroll
  for (int e = 0; e < 4; ++e) { f[2 * e] = __uint_as_float(w[e] << 16); f[2 * e + 1] = __uint_as_float(w[e] & 0xffff0000u); }
}
__device__ __forceinline__ void gdn_prep_phase(const Params& p, char* smem, int bid, int nblk) {
  const int tid = otid(), wid = tid >> 6, lane = tid & 63, fr = lane & 15, fq = lane >> 4;
  u16* qs = (u16*)smem;
  u16* ks = qs + 64 * 136;
  float* Lm = (float*)(ks + 64 * 136);
  float* gcs = Lm + 4096; float* bts = gcs + 64; float* egs = bts + 64;
  const u16* proj = (const u16*)(p.ws + OFF_PROJ);
  const float* beta = (const float*)(p.ws + OFF_BETA); const float* gg = (const float*)(p.ws + OFF_G);
#pragma unroll 1
  for (int it = bid; it < 2048; it += nblk) {
    const int n = it & 127, bh = it >> 7, b = bh >> 2, h = bh & 3;
    const size_t row0 = (size_t)b * SEQ + n * 64;
    if (wid == 0) {
      float c = gg[(row0 + lane) * 4 + h];
#pragma unroll
      for (int o = 1; o < 64; o <<= 1) { const float tt = __shfl_up(c, o); if (lane >= o) c += tt; }
      gcs[lane] = c; egs[lane] = __expf(c); bts[lane] = beta[(row0 + lane) * 4 + h];
    }
    {
      const int tok = tid >> 2, part = tid & 3, l = n * 64 + tok;
      float qo[32], ko[32]; float sq = 0.f, sk = 0.f;
#pragma unroll
      for (int cb = 0; cb < 4; ++cb) {
        const int colq = h * 128 + part * 32 + cb * 8, colk = 512 + colq;
        const size_t kblk = (size_t)M * 512 - 512;
        float aq[8], ak[8];
#pragma unroll
        for (int e = 0; e < 8; ++e) { aq[e] = 0.f; ak[e] = 0.f; }
#pragma unroll
        for (int j = 0; j < 4; ++j) {
          const int lt = l - 3 + j;
          if (lt >= 0) {
            const u16* rp = proj + ((size_t)b * SEQ + lt) * 512;
            float xq[8], xk[8];
            unpack8(*(const u32x4*)(rp + colq), xq); unpack8(*(const u32x4*)(rp + kblk + colk), xk);
            const f32x4 wq0 = *(const f32x4*)(p.hy_conv_w + j * 1536 + colq), wq1 = *(const f32x4*)(p.hy_conv_w + j * 1536 + colq + 4);
            const f32x4 wk0 = *(const f32x4*)(p.hy_conv_w + j * 1536 + colk), wk1 = *(const f32x4*)(p.hy_conv_w + j * 1536 + colk + 4);
#pragma unroll
            for (int e = 0; e < 4; ++e) { aq[e] += wq0[e] * xq[e]; aq[4 + e] += wq1[e] * xq[4 + e]; ak[e] += wk0[e] * xk[e]; ak[4 + e] += wk1[e] * xk[4 + e]; }
          }
        }
#pragma unroll
        for (int e = 0; e < 8; ++e) { const float a = silu_(aq[e]), k = silu_(ak[e]); qo[cb * 8 + e] = a; ko[cb * 8 + e] = k; sq += a * a; sk += k * k; }
      }
      sq += __shfl_xor(sq, 1); sq += __shfl_xor(sq, 2); sk += __shfl_xor(sk, 1); sk += __shfl_xor(sk, 2);
      const float rq = rsqrtf(sq + 1e-6f) * 0.08838834764831845f, rk = rsqrtf(sk + 1e-6f);
#pragma unroll
      for (int cb = 0; cb < 4; ++cb) {
        u32x4 wq, wk;
#pragma unroll
        for (int e = 0; e < 4; ++e) { wq[e] = pk2(qo[cb * 8 + 2 * e] * rq, qo[cb * 8 + 2 * e + 1] * rq); wk[e] = pk2(ko[cb * 8 + 2 * e] * rk, ko[cb * 8 + 2 * e + 1] * rk); }
        *(u32x4*)(qs + tok * 136 + part * 32 + cb * 8) = wq; *(u32x4*)(ks + tok * 136 + part * 32 + cb * 8) = wk;
      }
    }
    __syncthreads();
    {
      f32x4 akk[4], aqk[4];
#pragma unroll
      for (int nb = 0; nb < 4; ++nb) { akk[nb] = f32x4{0.f, 0.f, 0.f, 0.f}; aqk[nb] = f32x4{0.f, 0.f, 0.f, 0.f}; }
#pragma unroll
      for (int kk = 0; kk < 4; ++kk) {
        const bf16x8 ak = *(const bf16x8*)(ks + (16 * wid + fr) * 136 + kk * 32 + fq * 8);
        const bf16x8 aq = *(const bf16x8*)(qs + (16 * wid + fr) * 136 + kk * 32 + fq * 8);
#pragma unroll
        for (int nb = 0; nb < 4; ++nb) {
          const bf16x8 bk = *(const bf16x8*)(ks + (16 * nb + fr) * 136 + kk * 32 + fq * 8);
          akk[nb] = __builtin_amdgcn_mfma_f32_16x16x32_bf16(ak, bk, akk[nb], 0, 0, 0);
          aqk[nb] = __builtin_amdgcn_mfma_f32_16x16x32_bf16(aq, bk, aqk[nb], 0, 0, 0);
        }
      }
      u16* att = (u16*)(p.ws + OFF_GAT) + (size_t)it * 4096;
#pragma unroll
      for (int nb = 0; nb < 4; ++nb)
#pragma unroll
        for (int r = 0; r < 4; ++r) {
          const int i = 16 * wid + fq * 4 + r, j = 16 * nb + fr;
          const float dec = __expf(fminf(gcs[i] - gcs[j], 0.f));
          Lm[i * 64 + j] = (i > j) ? bts[i] * akk[nb][r] * dec : 0.f;
          att[i * 64 + j] = f2bf((i >= j) ? aqk[nb][r] * dec : 0.f);
        }
    }
    __syncthreads();
    {
      float x[64];
      if (tid < 128) {
        const int col = 1024 + h * 128 + tid;
        const u16* vp = proj + (size_t)2 * M * 512 + h * 128 + tid;
        const float w0 = p.hy_conv_w[col], w1 = p.hy_conv_w[1536 + col], w2 = p.hy_conv_w[2 * 1536 + col], w3 = p.hy_conv_w[3 * 1536 + col];
        float x1 = 0.f, x2 = 0.f, x3 = 0.f;
        if (n > 0) { x3 = bf2f(vp[(row0 - 3) * 512]); x2 = bf2f(vp[(row0 - 2) * 512]); x1 = bf2f(vp[(row0 - 1) * 512]); }
#pragma unroll
        for (int i = 0; i < 64; ++i) {
          const float xv = bf2f(vp[(row0 + i) * 512]);
          x[i] = silu_(w0 * x3 + w1 * x2 + w2 * x1 + w3 * xv) * bts[i];
          x3 = x2; x2 = x1; x1 = xv;
        }
      } else {
#pragma unroll
        for (int i = 0; i < 64; ++i) x[i] = bf2f(ks[i * 136 + tid - 128]) * bts[i] * egs[i];
      }
#pragma unroll
      for (int i = 1; i < 64; ++i) {
        float acc = x[i];
#pragma unroll
        for (int j4 = 0; j4 < (i + 3) / 4; ++j4) {
          const f32x4 l4 = *(const f32x4*)(Lm + i * 64 + j4 * 4);
#pragma unroll
          for (int e = 0; e < 4; ++e) if (j4 * 4 + e < i) acc -= l4[e] * x[j4 * 4 + e];
        }
        x[i] = acc;
      }
      if (tid < 128) {
        u16* ut = (u16*)(p.ws + OFF_GUT) + (size_t)it * 8192 + tid * 64;
#pragma unroll
        for (int c8 = 0; c8 < 8; ++c8) {
          u32x4 w;
#pragma unroll
          for (int e = 0; e < 4; ++e) w[e] = pk2(x[c8 * 8 + 2 * e], x[c8 * 8 + 2 * e + 1]);
          *(u32x4*)(ut + c8 * 8) = w;
        }
      } else {
        u16* wg = (u16*)(p.ws + OFF_GW) + (size_t)it * 8192 + (tid - 128);
#pragma unroll
        for (int i = 0; i < 64; ++i) wg[i * 128] = f2bf(x[i]);
      }
    }
    {
      u16* qd = (u16*)(p.ws + OFF_GQD) + (size_t)it * 8192;
#pragma unroll
      for (int k = 0; k < 4; ++k) {
        const int piece = tid + 256 * k, i = piece >> 4, d0 = (piece & 15) * 8;
        float f[8]; unpack8(*(const u32x4*)(qs + i * 136 + d0), f);
        const float e = egs[i];
        u32x4 w;
#pragma unroll
        for (int e2 = 0; e2 < 4; ++e2) w[e2] = pk2(f[2 * e2] * e, f[2 * e2 + 1] * e);
        *(u32x4*)(qd + i * 128 + d0) = w;
      }
      u16* kt = (u16*)(p.ws + OFF_GKT) + (size_t)it * 8192;
      const int dk = tid & 127, half = tid >> 7;
      const float gl = gcs[63];
#pragma unroll
      for (int c8 = 0; c8 < 4; ++c8) {
        u32x4 w;
#pragma unroll
        for (int e = 0; e < 4; ++e) {
          const int i0 = half * 32 + c8 * 8 + 2 * e;
          w[e] = pk2(bf2f(ks[i0 * 136 + dk]) * __expf(gl - gcs[i0]), bf2f(ks[(i0 + 1) * 136 + dk]) * __expf(gl - gcs[i0 + 1]));
        }
        *(u32x4*)(kt + dk * 64 + half * 32 + c8 * 8) = w;
      }
      if (tid == 0) ((float*)(p.ws + OFF_GSD))[it] = egs[63];
    }
    __syncthreads();
  }
}

__device__ __forceinline__ uint2 lds64(const char* p) { return *(const uint2*)p; }
__device__ __forceinline__ bf16x8 mk8(uint2 a, uint2 b) { u32x4 w = {a.x, a.y, b.x, b.y}; return __builtin_bit_cast(bf16x8, w); }
__device__ __forceinline__ bf16x8 pack8(const f32x16& x, int s) {
  u32x4 w = {pk2(x[8 * s], x[8 * s + 1]), pk2(x[8 * s + 2], x[8 * s + 3]), pk2(x[8 * s + 4], x[8 * s + 5]), pk2(x[8 * s + 6], x[8 * s + 7])};
  return __builtin_bit_cast(bf16x8, w);
}
__device__ __forceinline__ void gdn_scan_item(const Params& p, int bh, char* smem) {
  const int tid = otid(), wid = tid >> 6, lane = tid & 63, r32 = lane & 31, hi = lane >> 5;
  char* Wl = smem; char* KTl = smem + 16896;
  const char* gw = p.ws + OFF_GW; const char* gkt = p.ws + OFF_GKT;
  const u16* gut = (const u16*)(p.ws + OFF_GUT);
  const float* gsd = (const float*)(p.ws + OFF_GSD);
  u32x4* sbg = (u32x4*)(p.ws + OFF_PROJ); u32x4* vbg = (u32x4*)(p.ws + OFF_PROJ + (size_t)2048 * 32768);
  f32x16 S[4];
#pragma unroll
  for (int T = 0; T < 4; ++T)
#pragma unroll
    for (int r = 0; r < 16; ++r) S[T][r] = 0.f;
  u32x4 sa[8], sb_[8]; uint2 uc[8];
  const int dv = wid * 32 + r32;
#define G_LOAD(ST, IT) do { const size_t o16 = (size_t)(IT) * 16384; \
    _Pragma("unroll") for (int k = 0; k < 4; ++k) { ST[k] = *(const u32x4*)(gw + o16 + (tid + 256 * k) * 16); ST[4 + k] = *(const u32x4*)(gkt + o16 + (tid + 256 * k) * 16); } } while (0)
#define U_LOAD(IT) do { _Pragma("unroll") for (int k = 0; k < 8; ++k) uc[k] = *(const uint2*)(gut + (size_t)(IT) * 8192 + dv * 64 + 32 * (k >> 2) + 8 * (k & 3) + 4 * hi); } while (0)
#define G_WRITE(ST) do { \
    _Pragma("unroll") for (int k = 0; k < 4; ++k) { const int pc = tid + 256 * k; \
      { char* d = Wl + (pc >> 4) * 264 + (pc & 15) * 16; *(uint2*)d = uint2{ST[k][0], ST[k][1]}; *(uint2*)(d + 8) = uint2{ST[k][2], ST[k][3]}; } \
      { char* d = KTl + (pc >> 3) * 136 + (pc & 7) * 16; *(uint2*)d = uint2{ST[4 + k][0], ST[4 + k][1]}; *(uint2*)(d + 8) = uint2{ST[4 + k][2], ST[4 + k][3]}; } } } while (0)
#define SCAN_STEP(N, NXT, FAR) do { const int n = (N); const int item = bh * 128 + n; \
    const float sd_nxt = gsd[item + (n + 1 < 128 ? 1 : 0)]; \
    if (n + 2 < 128) G_LOAD(FAR, item + 2); \
    f32x16 av[2]; \
    _Pragma("unroll") for (int r = 0; r < 16; ++r) { av[0][r] = 0.f; av[1][r] = 0.f; } \
    _Pragma("unroll") for (int T = 0; T < 4; ++T) \
      _Pragma("unroll") for (int s = 0; s < 2; ++s) { \
        const bf16x8 sb = pack8(S[T], s); \
        sbg[((size_t)(item * 4 + wid) * 8 + T * 2 + s) * 64 + lane] = __builtin_bit_cast(u32x4, sb); \
        const int cb = (32 * T + 16 * s + 4 * hi) * 2; \
        _Pragma("unroll") for (int it = 0; it < 2; ++it) { \
          const char* wp = Wl + (32 * it + r32) * 264 + cb; \
          av[it] = __builtin_amdgcn_mfma_f32_32x32x16_bf16(mk8(lds64(wp), lds64(wp + 16)), sb, av[it], 0, 0, 0); } } \
    bf16x8 vb[2][2]; \
    _Pragma("unroll") for (int it = 0; it < 2; ++it) { \
      f32x16 vn; \
      _Pragma("unroll") for (int g = 0; g < 4; ++g) { const uint2 u2 = uc[it * 4 + g]; \
        vn[4 * g] = __uint_as_float(u2.x << 16) - av[it][4 * g]; vn[4 * g + 1] = __uint_as_float(u2.x & 0xffff0000u) - av[it][4 * g + 1]; \
        vn[4 * g + 2] = __uint_as_float(u2.y << 16) - av[it][4 * g + 2]; vn[4 * g + 3] = __uint_as_float(u2.y & 0xffff0000u) - av[it][4 * g + 3]; } \
      vb[it][0] = pack8(vn, 0); vb[it][1] = pack8(vn, 1); \
      vbg[((size_t)(item * 4 + wid) * 4 + it * 2) * 64 + lane] = __builtin_bit_cast(u32x4, vb[it][0]); \
      vbg[((size_t)(item * 4 + wid) * 4 + it * 2 + 1) * 64 + lane] = __builtin_bit_cast(u32x4, vb[it][1]); } \
    if (n + 1 < 128) U_LOAD(item + 1); \
    _Pragma("unroll") for (int T = 0; T < 4; ++T) { \
      _Pragma("unroll") for (int r = 0; r < 16; ++r) S[T][r] *= sd_cur; \
      _Pragma("unroll") for (int it = 0; it < 2; ++it) \
        _Pragma("unroll") for (int s = 0; s < 2; ++s) { \
          const char* kp = KTl + (32 * T + r32) * 136 + (32 * it + 16 * s + 4 * hi) * 2; \
          S[T] = __builtin_amdgcn_mfma_f32_32x32x16_bf16(mk8(lds64(kp), lds64(kp + 16)), vb[it][s], S[T], 0, 0, 0); } } \
    sd_cur = sd_nxt; \
    __syncthreads(); \
    if (n + 1 < 128) G_WRITE(NXT); \
    __syncthreads(); } while (0)
  float sd_cur = gsd[bh * 128];
  G_LOAD(sa, bh * 128); U_LOAD(bh * 128); G_WRITE(sa);
  G_LOAD(sb_, bh * 128 + 1);
  __syncthreads();
#pragma unroll 1
  for (int n2 = 0; n2 < 128; n2 += 2) {
    SCAN_STEP(n2, sb_, sa);
    SCAN_STEP(n2 + 1, sa, sb_);
  }
#undef SCAN_STEP
#undef G_LOAD
#undef G_WRITE
#undef U_LOAD
}

__device__ __forceinline__ void gdn_out_phase(const Params& p, char* smem, int bid, int nblk) {
  const int tid = otid(), wid = tid >> 6, lane = tid & 63, r32 = lane & 31, hi = lane >> 5;
  char* QDl = smem; char* ATl = smem + 16896; float* Ol = (float*)(smem + 16896 + 8704);
  const char* gqd = p.ws + OFF_GQD; const char* gat = p.ws + OFF_GAT;
  const u32x4* sbg = (const u32x4*)(p.ws + OFF_PROJ); const u32x4* vbg = (const u32x4*)(p.ws + OFF_PROJ + (size_t)2048 * 32768);
  const u16* zb = (const u16*)(p.ws + OFF_PROJ) + (size_t)3 * M * 512;
  u16* concat = (u16*)(p.ws + OFF_HN);
#pragma unroll 1
  for (int item = bid; item < 2048; item += nblk) {
    const int n = item & 127, bh = item >> 7, b = bh >> 2, h = bh & 3;
    {
      u32x4 st[6];
#pragma unroll
      for (int k = 0; k < 4; ++k) st[k] = *(const u32x4*)(gqd + (size_t)item * 16384 + (tid + 256 * k) * 16);
#pragma unroll
      for (int k = 0; k < 2; ++k) st[4 + k] = *(const u32x4*)(gat + (size_t)item * 8192 + (tid + 256 * k) * 16);
#pragma unroll
      for (int k = 0; k < 4; ++k) { const int pc = tid + 256 * k; char* d = QDl + (pc >> 4) * 264 + (pc & 15) * 16;
        *(uint2*)d = uint2{st[k][0], st[k][1]}; *(uint2*)(d + 8) = uint2{st[k][2], st[k][3]}; }
#pragma unroll
      for (int k = 0; k < 2; ++k) { const int pc = tid + 256 * k; char* d = ATl + (pc >> 3) * 136 + (pc & 7) * 16;
        *(uint2*)d = uint2{st[4 + k][0], st[4 + k][1]}; *(uint2*)(d + 8) = uint2{st[4 + k][2], st[4 + k][3]}; }
    }
    bf16x8 sb[8], vb[4];
#pragma unroll
    for (int f = 0; f < 8; ++f) sb[f] = __builtin_bit_cast(bf16x8, sbg[((size_t)(item * 4 + wid) * 8 + f) * 64 + lane]);
#pragma unroll
    for (int f = 0; f < 4; ++f) vb[f] = __builtin_bit_cast(bf16x8, vbg[((size_t)(item * 4 + wid) * 4 + f) * 64 + lane]);
    __syncthreads();
    f32x16 ao[2];
#pragma unroll
    for (int r = 0; r < 16; ++r) { ao[0][r] = 0.f; ao[1][r] = 0.f; }
#pragma unroll
    for (int T = 0; T < 4; ++T)
#pragma unroll
      for (int s = 0; s < 2; ++s) {
        const int cb = (32 * T + 16 * s + 4 * hi) * 2;
#pragma unroll
        for (int it = 0; it < 2; ++it) {
          const char* qp = QDl + (32 * it + r32) * 264 + cb;
          ao[it] = __builtin_amdgcn_mfma_f32_32x32x16_bf16(mk8(lds64(qp), lds64(qp + 16)), sb[T * 2 + s], ao[it], 0, 0, 0);
        }
      }
#pragma unroll
    for (int it2 = 0; it2 < 2; ++it2)
#pragma unroll
      for (int it = 0; it <= it2; ++it)
#pragma unroll
        for (int s = 0; s < 2; ++s) {
          const char* ap = ATl + (32 * it2 + r32) * 136 + (32 * it + 16 * s + 4 * hi) * 2;
          ao[it2] = __builtin_amdgcn_mfma_f32_32x32x16_bf16(mk8(lds64(ap), lds64(ap + 16)), vb[it * 2 + s], ao[it2], 0, 0, 0);
        }
#pragma unroll
    for (int it = 0; it < 2; ++it)
#pragma unroll
      for (int r = 0; r < 16; ++r) Ol[(32 * it + crow(r, hi)) * 132 + wid * 32 + r32] = ao[it][r];
    __syncthreads();
    {
      const int tok = tid >> 2, part = tid & 3;
      const int row = b * SEQ + n * 64 + tok;
      f32x4 a[8]; float ss = 0.f;
#pragma unroll
      for (int k = 0; k < 8; ++k) { a[k] = *(const f32x4*)(Ol + tok * 132 + part * 32 + k * 4); ss += a[k][0] * a[k][0] + a[k][1] * a[k][1] + a[k][2] * a[k][2] + a[k][3] * a[k][3]; }
      ss += __shfl_xor(ss, 1); ss += __shfl_xor(ss, 2);
      const float rs = rsqrtf(ss * (1.f / 128.f) + 1e-6f);
      const u16* zp = zb + (size_t)row * 512 + h * 128 + part * 32;
      const float* hw = p.hy_head_norm_w + part * 32;
      u16* cp = concat + a_off(row, h * 128 + part * 32, 32);
#pragma unroll
      for (int k = 0; k < 4; ++k) {
        float zf[8]; unpack8(*(const u32x4*)(zp + k * 8), zf);
        const f32x4 h0 = *(const f32x4*)(hw + k * 8), h1 = *(const f32x4*)(hw + k * 8 + 4);
        const f32x4 x0 = a[2 * k], x1 = a[2 * k + 1];
        u32x4 w;
        w[0] = pk2(x0[0] * rs * h0[0] * silu_(zf[0]), x0[1] * rs * h0[1] * silu_(zf[1]));
        w[1] = pk2(x0[2] * rs * h0[2] * silu_(zf[2]), x0[3] * rs * h0[3] * silu_(zf[3]));
        w[2] = pk2(x1[0] * rs * h1[0] * silu_(zf[4]), x1[1] * rs * h1[1] * silu_(zf[5]));
        w[3] = pk2(x1[2] * rs * h1[2] * silu_(zf[6]), x1[3] * rs * h1[3] * silu_(zf[7]));
        *(u32x4*)(cp + k * 8) = w;
      }
    }
    __syncthreads();
  }
}

using s16x4 = __attribute__((ext_vector_type(4))) short;
#define KSWZ(row, colB) ((row) * 256 + ((colB) ^ (((row) & 7) << 4)))
#define SBAR() __builtin_amdgcn_sched_barrier(0)
__device__ __forceinline__ unsigned cvtpk(float lo, float hi) { unsigned r; asm volatile("v_cvt_pk_bf16_f32 %0, %1, %2" : "=v"(r) : "v"(lo), "v"(hi)); return r; }
__device__ __forceinline__ int v_st(int k, int c) { const int kk = (k & ~0xC) | ((k & 4) << 1) | ((k & 8) >> 1); return ((kk >> 3) * 4 + (c >> 5)) * 512 + ((kk & 7) * 32 + (c & 31)) * 2; }
__device__ __forceinline__ int v_rd_base(int lane) { return ((lane & 3) << 3) | (((lane >> 2) & 3) << 6) | (((lane >> 4) & 1) << 5) | (((lane >> 5) & 1) << 8); }
constexpr int v_rd_off(int d0, int ks, int half) { return d0 * 512 + ks * 4096 + half * 2048; }
template <int OFF> __device__ __forceinline__ s16x4 tr_read(int vb) {
  s16x4 r; asm volatile("ds_read_b64_tr_b16 %0, %1 offset:%2" : "=&v"(r) : "v"(vb), "i"(OFF) : "memory"); return r;
}
template <int D0> __device__ __forceinline__ void pv_one(f32x16& od, int vb, bf16x8 pa0, bf16x8 pa1, bf16x8 pa2, bf16x8 pa3) {
  const s16x4 l0 = tr_read<v_rd_off(D0, 0, 0)>(vb), h0 = tr_read<v_rd_off(D0, 0, 1)>(vb), l1 = tr_read<v_rd_off(D0, 1, 0)>(vb), h1 = tr_read<v_rd_off(D0, 1, 1)>(vb);
  const s16x4 l2 = tr_read<v_rd_off(D0, 2, 0)>(vb), h2 = tr_read<v_rd_off(D0, 2, 1)>(vb), l3 = tr_read<v_rd_off(D0, 3, 0)>(vb), h3 = tr_read<v_rd_off(D0, 3, 1)>(vb);
  asm volatile("s_waitcnt lgkmcnt(0)" ::: "memory"); SBAR();
#define PK(L, H) (bf16x8){L[0], L[1], L[2], L[3], H[0], H[1], H[2], H[3]}
  od = __builtin_amdgcn_mfma_f32_32x32x16_bf16(pa0, PK(l0, h0), od, 0, 0, 0);
  od = __builtin_amdgcn_mfma_f32_32x32x16_bf16(pa1, PK(l1, h1), od, 0, 0, 0);
  od = __builtin_amdgcn_mfma_f32_32x32x16_bf16(pa2, PK(l2, h2), od, 0, 0, 0);
  od = __builtin_amdgcn_mfma_f32_32x32x16_bf16(pa3, PK(l3, h3), od, 0, 0, 0);
#undef PK
}
__device__ __forceinline__ float pl32_other(float a, float b, int hi) {
  auto rr = __builtin_amdgcn_permlane32_swap(__float_as_uint(a), __float_as_uint(b), false, false);
  return __uint_as_float(hi ? rr[0] : rr[1]);
}
__device__ __forceinline__ void sb_half(f32x16& pz, float& run, bool need_mask, int kb, int t, int hi) {
  constexpr float C2 = 0.08838834764831845f * 1.4426950408889634f;
  f32x16 l;
#pragma unroll
  for (int r = 0; r < 16; ++r) {
    const float e = __builtin_amdgcn_exp2f(fminf(pz[r] * C2, 60.f));
    l[r] = __builtin_amdgcn_rcpf(1.f + e);
    pz[r] = e;
  }
  if (need_mask) {
#pragma unroll
    for (int r = 0; r < 16; ++r) { if (kb + crow(r, hi) >= t) { l[r] = 1.f; pz[r] = 0.f; } }
  }
#pragma unroll
  for (int g = 0; g < 4; ++g) { l[4 * g + 2] *= l[4 * g + 3]; l[4 * g + 1] *= l[4 * g + 2]; l[4 * g] *= l[4 * g + 1]; }
  const float cs3 = l[12], cs2 = l[8] * cs3, cs1 = l[4] * cs2, cs0 = l[0] * cs1;
  const float off0 = cs1 * pl32_other(cs0, cs1, hi) * run;
  const float off1 = cs2 * pl32_other(cs1, cs2, hi) * run;
  const float off2 = cs3 * pl32_other(cs2, cs3, hi) * run;
  const float off3 = pl32_other(cs3, 1.f, hi) * run;
  float tot;
  { auto rr = __builtin_amdgcn_permlane32_swap(__float_as_uint(cs0), __float_as_uint(cs0), false, false); tot = __uint_as_float(rr[0]) * __uint_as_float(rr[1]); }
#pragma unroll
  for (int r = 0; r < 4; ++r) {
    pz[r] = pz[r] * l[r] * off0; pz[4 + r] = pz[4 + r] * l[4 + r] * off1;
    pz[8 + r] = pz[8 + r] * l[8 + r] * off2; pz[12 + r] = pz[12 + r] * l[12 + r] * off3;
  }
  run *= tot;
}

__device__ __forceinline__ void attn_phase(const Params& p, char* smem, int bid, int nblk) {
  const int tid = otid(), wid = tid >> 6, lane = tid & 63, r32 = lane & 31, hi = lane >> 5;
  char* K_lds0 = smem; char* V_lds0 = smem + 16384;
  const u16* qkv = (const u16*)(p.ws + OFF_PROJ);
  u16* ao = (u16*)(p.ws + OFF_HN);
  const int sr = tid >> 4, sc = (tid & 15) * 8;
  const int vb00 = (int)(uintptr_t)V_lds0 + v_rd_base(lane);
  for (int k = 0; k * nblk < 2048; ++k) {
    const int i = (k & 1) ? ((k + 1) * nblk - 1 - bid) : (k * nblk + bid);
    if (i >= 2048) continue;
    const int j = 63 - (i >> 5), bh = i & 31, b = bh >> 3, h = bh & 7;
    const int i0 = j * 128;
    const size_t rowb = (size_t)b * SEQ;
    const int t = i0 + wid * 32 + r32, tmin = i0 + wid * 32, tmax = tmin + 31;
    bf16x8 qr[8];
    {
      const u16* qp = qkv + (rowb + t) * 3072 + h * 128 + hi * 8;
#pragma unroll
      for (int d0 = 0; d0 < 8; ++d0) qr[d0] = *(const bf16x8*)(qp + d0 * 16);
    }
    f32x16 o[4];
#pragma unroll
    for (int d = 0; d < 4; ++d)
#pragma unroll
      for (int r = 0; r < 16; ++r) o[d][r] = 0.f;
    float run = 1.f;
    const u16* kbase = qkv + rowb * 3072 + 1024 + h * 128 + sc;
    u32x4 stk[4], stv[4];
#define SLOAD(KT) do { _Pragma("unroll") for (int ii = 0; ii < 4; ++ii) { const u16* kp = kbase + (size_t)((KT) * 64 + sr + 16 * ii) * 3072; \
      stk[ii] = *(const u32x4*)kp; stv[ii] = *(const u32x4*)(kp + 1024); } } while (0)
#define SWRITE(B) do { _Pragma("unroll") for (int ii = 0; ii < 4; ++ii) { const int row = sr + 16 * ii; \
      *(u32x4*)(K_lds0 + (B) * 32768 + KSWZ(row, sc * 2)) = stk[ii]; *(u32x4*)(V_lds0 + (B) * 32768 + v_st(row, sc)) = stv[ii]; } } while (0)
    const int NT = 2 * j + 2;
    __syncthreads();
    SLOAD(NT - 1); SWRITE(0); __syncthreads();
    int cur = 0;
    for (int kt = NT - 1; kt >= 0; --kt) {
      const int k0 = kt * 64;
      const char* K_lds = K_lds0 + cur * 32768; const int vb0 = vb00 + cur * 32768;
      if (kt > 0) SLOAD(kt - 1);
      if (k0 <= tmax) {
        bf16x8 pa0, pa1, pa2, pa3;
#define PK4(P, BASE, OUT) do { unsigned a0 = cvtpk(P[BASE + 0], P[BASE + 1]), a1 = cvtpk(P[BASE + 2], P[BASE + 3]); \
    unsigned b0_ = cvtpk(P[BASE + 4], P[BASE + 5]), b1_ = cvtpk(P[BASE + 6], P[BASE + 7]); \
    auto r0 = __builtin_amdgcn_permlane32_swap(a0, b0_, false, false); auto r1 = __builtin_amdgcn_permlane32_swap(a1, b1_, false, false); \
    u32x4 w = {r0[0], r1[0], r0[1], r1[1]}; OUT = *reinterpret_cast<bf16x8*>(&w); } while (0)
        if (k0 + 32 <= tmax) {
          f32x16 pz;
#pragma unroll
          for (int r = 0; r < 16; ++r) pz[r] = 0.f;
#pragma unroll
          for (int d0 = 0; d0 < 8; ++d0) {
            const bf16x8 kf = *(const bf16x8*)(K_lds + KSWZ(32 + r32, (d0 * 16 + hi * 8) * 2));
            pz = __builtin_amdgcn_mfma_f32_32x32x16_bf16(kf, qr[d0], pz, 0, 0, 0);
          }
          sb_half(pz, run, k0 + 63 >= tmin, k0 + 32, t, hi);
          PK4(pz, 0, pa2); PK4(pz, 8, pa3);
        } else {
          pa2 = bf16x8{0, 0, 0, 0, 0, 0, 0, 0}; pa3 = pa2;
        }
        {
          f32x16 pz;
#pragma unroll
          for (int r = 0; r < 16; ++r) pz[r] = 0.f;
#pragma unroll
          for (int d0 = 0; d0 < 8; ++d0) {
            const bf16x8 kf = *(const bf16x8*)(K_lds + KSWZ(r32, (d0 * 16 + hi * 8) * 2));
            pz = __builtin_amdgcn_mfma_f32_32x32x16_bf16(kf, qr[d0], pz, 0, 0, 0);
          }
          sb_half(pz, run, k0 + 31 >= tmin, k0, t, hi);
          PK4(pz, 0, pa0); PK4(pz, 8, pa1);
        }
#undef PK4
        pv_one<0>(o[0], vb0, pa0, pa1, pa2, pa3); pv_one<1>(o[1], vb0, pa0, pa1, pa2, pa3);
        pv_one<2>(o[2], vb0, pa0, pa1, pa2, pa3); pv_one<3>(o[3], vb0, pa0, pa1, pa2, pa3);
      }
      if (kt > 0) SWRITE(cur ^ 1);
      __syncthreads();
      cur ^= 1;
    }
#undef SLOAD
#undef SWRITE
    {
      const int orow0 = (int)rowb + i0 + wid * 32;
#pragma unroll
      for (int r = 0; r < 16; ++r) {
        const int orow = crow(r, hi);
#pragma unroll
        for (int d0 = 0; d0 < 4; ++d0) ao[a_off(orow0 + orow, h * 128 + d0 * 32 + r32, 32)] = f2bf(o[d0][r]);
      }
    }
  }
}

#define XB_TMO      128
#define XB_XCNT(j)  (256  + 64 * (j))
#define XB_XSUB(j)  (1280 + 64 * (j))
#define XB_XGEN(j)  (2304 + 64 * (j))
#define XB_TOP      3328
#define XB_TOPGEN   3392
#define XCD_BAR_WORDS 3456
#define XB_SPIN_CAP (1u << 23)
#define LAS __attribute__((address_space(3)))
__device__ __forceinline__ unsigned xb_ld(unsigned* p)              { return __hip_atomic_load(p, __ATOMIC_RELAXED, __HIP_MEMORY_SCOPE_AGENT); }
__device__ __forceinline__ unsigned xb_add(unsigned* p, unsigned v) { return __hip_atomic_fetch_add(p, v, __ATOMIC_RELAXED, __HIP_MEMORY_SCOPE_AGENT); }
__device__ __forceinline__ unsigned xb_xcc_id() { return (unsigned)__builtin_amdgcn_s_getreg((3 << 11) | 20) & 0xFu; }
#define XB_SPIN(cond, bar) do { unsigned _sp = 0; while (cond) { __builtin_amdgcn_s_sleep(1); \
    if ((++_sp & 255u) == 0u) { if (xb_ld(&(bar)[XB_TMO])) break; if (_sp > XB_SPIN_CAP) { atomicAdd(&(bar)[XB_TMO], 1u); break; } } } } while (0)
struct XcdBarrier { unsigned* bar; unsigned x; volatile LAS unsigned* st; };
__device__ __forceinline__ XcdBarrier xcd_barrier_post(unsigned* bar, volatile LAS unsigned* st) {
  XcdBarrier b; b.bar = bar; b.x = xb_xcc_id(); b.st = st;
  if (__builtin_amdgcn_workitem_id_x() == 0) (void)xb_add(&bar[XB_XCNT(b.x)], 1u);
  return b;
}
__device__ __forceinline__ void xcd_barrier_complete(unsigned* bar, unsigned x, unsigned& nloc, unsigned& nx) {
  const unsigned G = gridDim.x * gridDim.y * gridDim.z;
  unsigned sum, cnt, mine, sp = 0u;
  for (;;) {
    sum = 0u; cnt = 0u; mine = 0u;
#pragma unroll
    for (unsigned j = 0; j < 16; ++j) { const unsigned c = xb_ld(&bar[XB_XCNT(j)]); sum += c; cnt += (c > 0u) ? 1u : 0u; mine = (j == x) ? c : mine; }
    if (sum == G) break;
    __builtin_amdgcn_s_sleep(1);
    if ((++sp & 255u) == 0u) { if (xb_ld(&bar[XB_TMO])) break; if (sp > XB_SPIN_CAP) { atomicAdd(&bar[XB_TMO], 1u); break; } }
  }
  nloc = mine > 0u ? mine : 1u; nx = cnt > 0u ? cnt : 1u;
}
__device__ __forceinline__ void xcd_barrier(const XcdBarrier& b) {
  asm volatile("s_waitcnt vmcnt(0)" ::: "memory");
  __syncthreads();
  if (__builtin_amdgcn_workitem_id_x() == 0) {
    unsigned* bar = b.bar;
    __builtin_amdgcn_s_waitcnt(0);
    unsigned nloc = b.st[0], nx = b.st[1];
    if (nloc == 0u) { xcd_barrier_complete(bar, b.x, nloc, nx); b.st[0] = nloc; b.st[1] = nx; }
    const unsigned old = xb_add(&bar[XB_XSUB(b.x)], 1u);
    const unsigned gen = old / nloc;
    if (old + 1u == (gen + 1u) * nloc) {
      __builtin_amdgcn_fence(__ATOMIC_RELEASE, "agent");
      asm volatile("s_waitcnt vmcnt(0)" ::: "memory");
      const unsigned og = xb_add(&bar[XB_TOP], 1u);
      const unsigned tg = og / nx;
      if (og + 1u == (tg + 1u) * nx) xb_add(&bar[XB_TOPGEN], 1u);
      else XB_SPIN(xb_ld(&bar[XB_TOPGEN]) == tg, bar);
      __builtin_amdgcn_fence(__ATOMIC_ACQUIRE, "agent");
      xb_add(&bar[XB_XGEN(b.x)], 1u);
      asm volatile("s_waitcnt vmcnt(0)" ::: "memory");
    } else {
      XB_SPIN(xb_ld(&bar[XB_XGEN(b.x)]) == gen, bar);
      __builtin_amdgcn_fence(__ATOMIC_ACQUIRE, "agent");
      asm volatile("s_waitcnt vmcnt(0)" ::: "memory");
    }
  }
  __syncthreads();
}

__global__ void __launch_bounds__(256, 2) mega(Params p) {
  __shared__ __attribute__((aligned(16))) char smem[SMEM_BYTES];
  __shared__ uint4 xb_words;
  const int bid = blockIdx.x, nblk = gridDim.x;
  char* ws = p.ws;
  if (__builtin_amdgcn_workitem_id_x() == 0) xb_words = make_uint4(0u, 0u, 0u, 0u);
  __syncthreads();
  const XcdBarrier xbar = xcd_barrier_post((unsigned*)(ws + OFF_BAR), (volatile LAS unsigned*)&xb_words);
  const float* mod = (const float*)(ws + OFF_MOD);
  u16* hn = (u16*)(ws + OFF_HN);
#define PH_BEGIN(n) if (p.phase_lo <= (n) && (n) < p.phase_hi) {
#define PH_END(n) if ((n) + 1 < p.phase_hi) { if ((n) == 0) cg::this_grid().sync(); else xcd_barrier(xbar); } }
  PH_BEGIN(0) phase0(p, smem, bid, nblk); PH_END(0)
  PH_BEGIN(1) norm_phase<1>(p, p.x, p.norm_mix_w, mod, 0, 1024, smem, bid, nblk); PH_END(1)
  PH_BEGIN(2) { EpiArgs ea{}; ea.outb = (u16*)(ws + OFF_PROJ); ea.ux = (u16*)(ws + OFF_UX);
        gemm_phase<E_PROJ0>(hn, 32, 0, (const u16*)(ws + OFF_WT_HYIN), 32, 0, 1024, M / 256, PN / 128, 1, ea, smem, bid, nblk); } PH_END(2)
  PH_BEGIN(3) { EpiArgs ea{}; ea.outf = (float*)(ws + OFF_XE);
        gemm_phase<E_XE>((const u16*)(ws + OFF_UX), 20, (size_t)S5C * UXW, (const u16*)(ws + OFF_EG), 16, (size_t)128 * 512, 512, S5C / 256, 1, 32, ea, smem, bid, nblk); } PH_END(3)
  PH_BEGIN(4) { s5_carry_phase(p, bid, nblk); gdn_prep_phase(p, smem, bid, nblk); } PH_END(4)
  PH_BEGIN(5) {
        if (bid < 16) { gdn_scan_item(p, bid, smem); }
        else { EpiArgs ea{}; ea.outb = (u16*)(ws + OFF_Y5); ea.ux = (u16*)(ws + OFF_UX); ea.bias = p.s5_d;
          gemm_phase<E_S5Y>((const u16*)(ws + OFF_UX), 20, (size_t)S5C * UXW, (const u16*)(ws + OFF_MF), 20, (size_t)512 * UXW, UXW, S5C / 256, 4, 32, ea, smem, bid - 16, nblk - 16); }
      } PH_END(5)
  PH_BEGIN(6) { gdn_out_phase(p, smem, bid, nblk); __syncthreads();
 EpiArgs ea{}; ea.outb = hn; ea.y5 = (const u16*)(ws + OFF_Y5); ea.bias = p.s5_glu_b;
        gemm_phase<E_GLU>((const u16*)(ws + OFF_Y5), 16, 0, (const u16*)(ws + OFF_WT_GLU), 16, 0, 512, M / 256, 4, 1, ea, smem, bid, nblk); } PH_END(6)
  PH_BEGIN(8) { EpiArgs ea{}; ea.outf = p.out; ea.res = p.x; ea.gate = mod + 2048;
        gemm_phase<E_RESID>(hn, 32, 0, (const u16*)(ws + OFF_WT_HYOUT), 32, 0, 1024, M / 256, 8, 1, ea, smem, bid, nblk); } PH_END(8)
  PH_BEGIN(9) norm_phase<0>(p, p.out, p.norm_ffn_w, mod, 3072, 4096, smem, bid, nblk); PH_END(9)
  PH_BEGIN(10) { EpiArgs ea{}; ea.outb = (u16*)(ws + OFF_PROJ);
        gemm_phase<E_SWIGLU>(hn, 32, 0, (const u16*)(ws + OFF_WT_FFNIN), 32, 0, 1024, M / 256, 2 * FF / 128, 1, ea, smem, bid, nblk); } PH_END(10)
  PH_BEGIN(11) { EpiArgs ea{}; ea.outf = p.out; ea.res = p.out; ea.gate = mod + 5120;
        gemm_phase<E_RESID>((const u16*)(ws + OFF_PROJ), FF / 32, 0, (const u16*)(ws + OFF_WT_FFNOUT), FF / 32, 0, FF, M / 256, 8, 1, ea, smem, bid, nblk); } PH_END(11)
  PH_BEGIN(12) norm_phase<0>(p, p.out, p.norm_mix_w + 1024, mod + 4 * 6144, 0, 1024, smem, bid, nblk); PH_END(12)
  PH_BEGIN(13) { EpiArgs ea{}; ea.outb = (u16*)(ws + OFF_PROJ); ea.ldc = 3072;
        gemm_phase<E_BF16>(hn, 32, 0, (const u16*)(ws + OFF_WT_SBIN), 32, 0, 1024, M / 256, 24, 1, ea, smem, bid, nblk); } PH_END(13)
  PH_BEGIN(14) attn_phase(p, smem, bid, nblk); PH_END(14)
  PH_BEGIN(15) { EpiArgs ea{}; ea.outf = p.out; ea.res = p.out; ea.gate = mod + 4 * 6144 + 2048;
        gemm_phase<E_RESID>(hn, 32, 0, (const u16*)(ws + OFF_WT_SBOUT), 32, 0, 1024, M / 256, 8, 1, ea, smem, bid, nblk); } PH_END(15)
  PH_BEGIN(16) norm_phase<0>(p, p.out, p.norm_ffn_w + 1024, mod + 4 * 6144, 3072, 4096, smem, bid, nblk); PH_END(16)
  PH_BEGIN(17) { EpiArgs ea{}; ea.outb = (u16*)(ws + OFF_PROJ);
        gemm_phase<E_SWIGLU>(hn, 32, 0, (const u16*)(ws + OFF_WT_FFNIN + SZ_WT_FFNIN), 32, 0, 1024, M / 256, 2 * FF / 128, 1, ea, smem, bid, nblk); } PH_END(17)
  PH_BEGIN(18) { EpiArgs ea{}; ea.outf = p.out; ea.res = p.out; ea.gate = mod + 4 * 6144 + 5120;
        gemm_phase<E_RESID>((const u16*)(ws + OFF_PROJ), FF / 32, 0, (const u16*)(ws + OFF_WT_FFNOUT + SZ_WT_FFNOUT), FF / 32, 0, FF, M / 256, 8, 1, ea, smem, bid, nblk); } PH_END(18)
  PH_BEGIN(19) norm_phase<2>(p, p.out, p.final_norm_w, mod, 0, 0, smem, bid, nblk); PH_END(19)
}

extern "C" void kernel_launch(void* const* d_in, const int* in_sizes, int n_in, void* d_out, int out_size, void* d_ws, size_t ws_size,
                              hipStream_t stream) {
  static int grid_blocks = 0;
  if (!grid_blocks) {
    int dev = 0, cus = 0, per_cu = 0;
    hipGetDevice(&dev);
    hipDeviceGetAttribute(&cus, hipDeviceAttributeMultiprocessorCount, dev);
    hipOccupancyMaxActiveBlocksPerMultiprocessor(&per_cu, mega, 256, 0);
    if (per_cu > 2) per_cu = 2;
    if (per_cu < 1) per_cu = 1;
    grid_blocks = cus * per_cu;
  }
  Params p{};
  const float* const* in = (const float* const*)d_in;
  p.x = in[0]; p.c = in[1]; p.ada_w = in[2]; p.ada_b = in[3]; p.norm_mix_w = in[4]; p.norm_ffn_w = in[5]; p.ffn_w_in = in[6]; p.ffn_w_out = in[7];
  p.hy_w_in = in[8]; p.hy_conv_w = in[9]; p.hy_a_log = in[10]; p.hy_dt_bias = in[11]; p.hy_head_norm_w = in[12];
  p.s5_lam_re = in[13]; p.s5_lam_im = in[14]; p.s5_log_dt = in[15]; p.s5_b_re = in[16]; p.s5_b_im = in[17]; p.s5_c_re = in[18]; p.s5_c_im = in[19];
  p.s5_d = in[20]; p.s5_glu_w = in[21]; p.s5_glu_b = in[22]; p.hy_w_out = in[23]; p.sb_w_in = in[24]; p.sb_w_out = in[25]; p.final_norm_w = in[26];
  p.out = (float*)d_out; p.ws = (char*)d_ws;
#if ONE_LAUNCH
  p.phase_lo = 0; p.phase_hi = NPHASE;
  (void)hipMemsetAsync((char*)d_ws + OFF_BAR, 0, (size_t)XCD_BAR_WORDS_C * 4, stream);
  void* args[] = {&p};
  hipError_t e = hipLaunchCooperativeKernel((void*)mega, dim3(grid_blocks), dim3(256), args, 0, stream);
  if (e != hipSuccess) fprintf(stderr, "cooperative launch failed: %s (grid %d)\n", hipGetErrorString(e), grid_blocks);
#else
  for (int ph = 0; ph < NPHASE; ++ph) {
    p.phase_lo = ph; p.phase_hi = ph + 1;
    hipLaunchKernelGGL(mega, dim3(grid_blocks), dim3(256), 0, stream, p);
  }
#endif
}
```

```cpp
#include <hip/hip_runtime.h>
#include <hip/hip_cooperative_groups.h>
#include <stdint.h>
#include <cstdio>
namespace cg = cooperative_groups;

#ifndef ONE_LAUNCH
#define ONE_LAUNCH 1
#endif

typedef unsigned short u16;
using bf16x8 = __attribute__((ext_vector_type(8))) short;
using f32x4 = __attribute__((ext_vector_type(4))) float;
using u32x4 = __attribute__((ext_vector_type(4))) unsigned;

constexpr int D = 1024, NB = 4, SEQ = 8192, M = NB * SEQ, FF = 2816, EIN = 2568, PN = 2560, PJ = 2048;
constexpr int NPHASE = 20;
constexpr int XCD_BAR_WORDS_C = 3456;
constexpr int S5T = 32, S5C = M / S5T, UXW = 640;

constexpr size_t SZ_WT_HYIN = (size_t)PN * 1024 * 2, SZ_WT_SQ = (size_t)1024 * 1024 * 2, SZ_WT_GLU = (size_t)512 * 512 * 2;
constexpr size_t SZ_WT_FFNIN = (size_t)2 * FF * 1024 * 2, SZ_WT_FFNOUT = (size_t)1024 * FF * 2, SZ_WT_SBIN = (size_t)3072 * 1024 * 2;
constexpr size_t OFF_WT_HYIN = 0;
constexpr size_t OFF_WT_HYOUT = OFF_WT_HYIN + SZ_WT_HYIN;
constexpr size_t OFF_WT_GLU = OFF_WT_HYOUT + SZ_WT_SQ;
constexpr size_t OFF_WT_FFNIN = OFF_WT_GLU + SZ_WT_GLU;
constexpr size_t OFF_WT_FFNOUT = OFF_WT_FFNIN + 2 * SZ_WT_FFNIN;
constexpr size_t OFF_WT_SBIN = OFF_WT_FFNOUT + 2 * SZ_WT_FFNOUT;
constexpr size_t OFF_WT_SBOUT = OFF_WT_SBIN + SZ_WT_SBIN;
constexpr size_t OFF_MOD = OFF_WT_SBOUT + SZ_WT_SQ;
constexpr size_t OFF_BETA = OFF_MOD + (size_t)2 * 4 * 6144 * 4;
constexpr size_t OFF_G = OFF_BETA + (size_t)M * 4 * 4;
constexpr size_t OFF_HN = OFF_G + (size_t)M * 4 * 4;
constexpr size_t OFF_Y5 = OFF_HN + (size_t)M * 1024 * 2;
constexpr size_t OFF_UX = OFF_Y5 + (size_t)M * 512 * 2;
constexpr size_t OFF_MF = OFF_UX + (size_t)32 * S5C * UXW * 2;
constexpr size_t OFF_EG = OFF_MF + (size_t)32 * 512 * UXW * 2;
constexpr size_t OFF_XE = OFF_EG + (size_t)32 * 128 * 512 * 2;
constexpr size_t OFF_A32 = OFF_XE + (size_t)32 * S5C * 128 * 4;
constexpr size_t OFF_PROJ = OFF_A32 + (size_t)32 * 64 * 2 * 4;
constexpr size_t OFF_GW = OFF_PROJ + (size_t)M * PJ * 2;
constexpr size_t OFF_GQD = OFF_GW + (size_t)2048 * 8192 * 2;
constexpr size_t OFF_GKT = OFF_GQD + (size_t)2048 * 8192 * 2;
constexpr size_t OFF_GUT = OFF_GKT + (size_t)2048 * 8192 * 2;
constexpr size_t OFF_GAT = OFF_GUT + (size_t)2048 * 8192 * 2;
constexpr size_t OFF_GSD = OFF_GAT + (size_t)2048 * 4096 * 2;
constexpr size_t OFF_BAR = OFF_GSD + (size_t)2048 * 4;
constexpr size_t WS_TOTAL = OFF_BAR + (size_t)XCD_BAR_WORDS_C * 4;
static_assert((size_t)M * 3072 * 2 <= WS_TOTAL - OFF_PROJ, "QKV alias");
static_assert(WS_TOTAL <= (size_t)512 * 1024 * 1024, "workspace too large");

struct Params {
  const float *x, *c, *ada_w, *ada_b, *norm_mix_w, *norm_ffn_w, *ffn_w_in, *ffn_w_out;
  const float *hy_w_in, *hy_conv_w, *hy_a_log, *hy_dt_bias, *hy_head_norm_w;
  const float *s5_lam_re, *s5_lam_im, *s5_log_dt, *s5_b_re, *s5_b_im, *s5_c_re, *s5_c_im, *s5_d, *s5_glu_w, *s5_glu_b, *hy_w_out;
  const float *sb_w_in, *sb_w_out, *final_norm_w;
  float* out;
  char* ws;
  int phase_lo, phase_hi;
};

constexpr int SMEM_BYTES = 73728;

__device__ __forceinline__ int otid() { int t = __builtin_amdgcn_workitem_id_x(); asm volatile("" : "+v"(t)); return t; }
__device__ __forceinline__ u16 f2bf(float x) { unsigned u = __float_as_uint(x); u += 0x7fffu + ((u >> 16) & 1u); return (u16)(u >> 16); }
typedef __bf16 bf16v2 __attribute__((ext_vector_type(2)));
typedef float f32v2 __attribute__((ext_vector_type(2)));
__device__ __forceinline__ unsigned pk2(float a, float b) { f32v2 v = {a, b}; bf16v2 r = __builtin_convertvector(v, bf16v2); return __builtin_bit_cast(unsigned, r); }
__device__ __forceinline__ float bf2f(u16 v) { return __uint_as_float(((unsigned)v) << 16); }
__device__ __forceinline__ float sigmoid_(float x) { return __builtin_amdgcn_rcpf(1.f + __expf(-x)); }
__device__ __forceinline__ float silu_(float x) { return x * sigmoid_(x); }
__device__ __forceinline__ float softplus_(float x) { return fmaxf(x, 0.f) + log1pf(__expf(-fabsf(x))); }
__device__ __forceinline__ float gelu_tanh_(float y) { return 0.5f * y * (1.f + tanhf(0.7978845608028654f * (y + 0.044715f * y * y * y))); }

__device__ __forceinline__ size_t pj_idx(int row, int col) { return (size_t)(col >> 9) * ((size_t)M * 512) + (size_t)row * 512 + (col & 511); }
__device__ __forceinline__ size_t a_off(int row, int col, int nks) { return ((size_t)((row >> 8) * nks + (col >> 5)) << 13) + ((row & 255) << 5) + (col & 31); }
__device__ __forceinline__ size_t b_off(int n, int k, int nks) { return ((size_t)((n >> 7) * nks + (k >> 5)) << 12) + ((n & 127) << 5) + (k & 31); }

struct TrJob { const float* src; u16* dst; int K, Nsrc, Nd, mode; };
__device__ __forceinline__ TrJob get_job(const Params& p, int j) {
  TrJob t;
  switch (j) {
    case 0: t = {p.hy_w_in, (u16*)(p.ws + OFF_WT_HYIN), 1024, EIN, PN, 1}; break;
    case 1: t = {p.hy_w_out, (u16*)(p.ws + OFF_WT_HYOUT), 1024, 1024, 1024, 0}; break;
    case 2: t = {p.s5_glu_w, (u16*)(p.ws + OFF_WT_GLU), 512, 512, 512, 0}; break;
    case 3: t = {p.ffn_w_in, (u16*)(p.ws + OFF_WT_FFNIN), 1024, 2 * FF, 2 * FF, 2}; break;
    case 4: t = {p.ffn_w_in + (size_t)1024 * 2 * FF, (u16*)(p.ws + OFF_WT_FFNIN + SZ_WT_FFNIN), 1024, 2 * FF, 2 * FF, 2}; break;
    case 5: t = {p.ffn_w_out, (u16*)(p.ws + OFF_WT_FFNOUT), FF, 1024, 1024, 0}; break;
    case 6: t = {p.ffn_w_out + (size_t)FF * 1024, (u16*)(p.ws + OFF_WT_FFNOUT + SZ_WT_FFNOUT), FF, 1024, 1024, 0}; break;
    case 7: t = {p.sb_w_in, (u16*)(p.ws + OFF_WT_SBIN), 1024, 3072, 3072, 0}; break;
    default: t = {p.sb_w_out, (u16*)(p.ws + OFF_WT_SBOUT), 1024, 1024, 1024, 0}; break;
  }
  return t;
}
__device__ __forceinline__ int src_col(int R, int mode) {
  if (mode == 0) return R;
  if (mode == 1) return R < 2048 ? R : R + 8;
  return ((R >> 4) & 1) * FF + (R >> 5) * 16 + (R & 15);
}
constexpr int N_TR_ITEMS = 640 + 256 + 64 + 2 * 1408 + 2 * 704 + 768 + 256;
constexpr int N_MOD_ITEMS = 2 * 6144 / 16;

__device__ __forceinline__ void s5_table_item(const Params& p, int item, char* smem) {
  const int tid = otid(), g = item >> 5, tau = item & 31;
  float* pwr = (float*)smem; float* pwi = pwr + 64; float* p1r = pwi + 64; float* p1i = p1r + 64;
  float* bbr = p1i + 64; float* bbi = bbr + 1024; float* cre = bbi + 1024; float* cim = cre + 1024;
  const float dt = expf(p.s5_log_dt[g]);
  if (tid < 64) {
    const float lr = p.s5_lam_re[g * 64 + tid], li = p.s5_lam_im[g * 64 + tid];
    float sn, cs;
    float mg = expf(lr * dt * (float)tau); sincosf(li * dt * (float)tau, &sn, &cs); pwr[tid] = mg * cs; pwi[tid] = mg * sn;
    mg = expf(lr * dt * (float)(tau + 1)); sincosf(li * dt * (float)(tau + 1), &sn, &cs); p1r[tid] = mg * cs; p1i[tid] = mg * sn;
    if (tau == 31) { float* a32 = (float*)(p.ws + OFF_A32); a32[(g * 64 + tid) * 2] = mg * cs; a32[(g * 64 + tid) * 2 + 1] = mg * sn; }
  }
  {
    const int pp = tid >> 2, hq = (tid & 3) * 4;
    const float lr = p.s5_lam_re[g * 64 + pp], li = p.s5_lam_im[g * 64 + pp];
    const float mg = expf(lr * dt); float sn, cs; sincosf(li * dt, &sn, &cs);
    const float ar = mg * cs, ai = mg * sn, den = lr * lr + li * li, nr = ar - 1.f, ni = ai;
    const float fre = (nr * lr + ni * li) / den, fim = (ni * lr - nr * li) / den;
#pragma unroll
    for (int e = 0; e < 4; ++e) {
      const float br = p.s5_b_re[(size_t)(g * 64 + pp) * 16 + hq + e], bi = p.s5_b_im[(size_t)(g * 64 + pp) * 16 + hq + e];
      bbr[pp * 16 + hq + e] = fre * br - fim * bi; bbi[pp * 16 + hq + e] = fre * bi + fim * br;
    }
    for (int i = tid; i < 1024; i += 256) { cre[i] = p.s5_c_re[(size_t)g * 1024 + i]; cim[i] = p.s5_c_im[(size_t)g * 1024 + i]; }
  }
  __syncthreads();
  u16* mf = (u16*)(p.ws + OFF_MF) + (size_t)g * 512 * UXW;
  u16* eg = (u16*)(p.ws + OFF_EG) + (size_t)g * 128 * 512;
  {
    const int h = tid >> 4, hp = tid & 15;
    float kv = 0.f;
    for (int pp = 0; pp < 64; ++pp) {
      const float cr = cre[h * 64 + pp], ci = cim[h * 64 + pp], pr = pwr[pp], pi = pwi[pp];
      kv += (cr * pr - ci * pi) * bbr[pp * 16 + hp] - (cr * pi + ci * pr) * bbi[pp * 16 + hp];
    }
    const u16 kb = f2bf(kv);
    for (int s0 = 0; s0 + tau < 32; ++s0) mf[b_off((s0 + tau) * 16 + h, s0 * 16 + hp, 20)] = kb;
    for (int t0 = 0; t0 + tau + 1 < 32; ++t0) mf[b_off(t0 * 16 + h, (t0 + tau + 1) * 16 + hp, 20)] = 0;
#pragma unroll
    for (int e = 0; e < 4; ++e) {
      const int pp = hp * 4 + e;
      const float cr = cre[h * 64 + pp], ci = cim[h * 64 + pp], pr = p1r[pp], pi = p1i[pp];
      mf[b_off(tau * 16 + h, 512 + pp, 20)] = f2bf(cr * pr - ci * pi);
      mf[b_off(tau * 16 + h, 576 + pp, 20)] = f2bf(-(cr * pi + ci * pr));
    }
  }
  {
    const int pp = tid >> 2, hq = (tid & 3) * 4, s0 = 31 - tau;
#pragma unroll
    for (int e = 0; e < 4; ++e) {
      const float br = bbr[pp * 16 + hq + e], bi = bbi[pp * 16 + hq + e], pr = pwr[pp], pi = pwi[pp];
      eg[b_off(pp, s0 * 16 + hq + e, 16)] = f2bf(pr * br - pi * bi);
      eg[b_off(64 + pp, s0 * 16 + hq + e, 16)] = f2bf(pr * bi + pi * br);
    }
  }
  __syncthreads();
}

__device__ __forceinline__ void phase0(const Params& p, char* smem, int bid, int nblk) {
  const int tid = otid();
  for (int it = bid; it < N_TR_ITEMS + N_MOD_ITEMS + 1024; it += nblk) {
    if (it >= N_TR_ITEMS + N_MOD_ITEMS) { s5_table_item(p, it - N_TR_ITEMS - N_MOD_ITEMS, smem); continue; }
    if (it < N_TR_ITEMS) {
      int rem = it, j = 0; TrJob jb;
      for (;; ++j) { jb = get_job(p, j); int n = (jb.Nd >> 6) * (jb.K >> 6); if (rem < n) break; rem -= n; }
      const int nk = jb.K >> 6, R0 = (rem / nk) * 64, k0 = (rem % nk) * 64;
      u16* s = (u16*)smem;
      {
        const int r = tid & 63, kk = tid >> 6;
        const float* sp = jb.src + (size_t)k0 * jb.Nsrc + src_col(R0 + r, jb.mode);
#pragma unroll
        for (int i = 0; i < 16; ++i) { int k = kk + 4 * i; s[r * 72 + k] = f2bf(sp[(size_t)k * jb.Nsrc]); }
      }
      __syncthreads();
      {
        const int r = tid >> 2, ch = tid & 3;
#pragma unroll
        for (int i = 0; i < 2; ++i) {
          int c8 = (ch + 4 * i) * 8;
          *(u32x4*)(jb.dst + b_off(R0 + r, k0 + c8, jb.K >> 5)) = *(const u32x4*)(s + r * 72 + c8);
        }
      }
      __syncthreads();
    } else {
      const int mi = it - N_TR_ITEMS, l = mi / 384, n0 = (mi % 384) * 16;
      float* cact = (float*)smem;
      float* red = cact + 4096;
      for (int i = tid; i < 4096; i += 256) cact[i] = silu_(p.c[i]);
      __syncthreads();
      const int cl = tid & 15, ksub = tid >> 4;
      float a0 = 0, a1 = 0, a2 = 0, a3 = 0;
      const float* wp = p.ada_w + (size_t)l * 1024 * 6144 + n0 + cl;
#pragma unroll 16
      for (int k = ksub * 64; k < ksub * 64 + 64; ++k) {
        float w = wp[(size_t)k * 6144];
        a0 += cact[k] * w; a1 += cact[1024 + k] * w; a2 += cact[2048 + k] * w; a3 += cact[3072 + k] * w;
      }
      red[(ksub * 4 + 0) * 16 + cl] = a0; red[(ksub * 4 + 1) * 16 + cl] = a1;
      red[(ksub * 4 + 2) * 16 + cl] = a2; red[(ksub * 4 + 3) * 16 + cl] = a3;
      __syncthreads();
      if (tid < 64) {
        const int b = tid >> 4;
        float sum = 0.f;
#pragma unroll
        for (int q = 0; q < 16; ++q) sum += red[(q * 4 + b) * 16 + cl];
        float* mod = (float*)(p.ws + OFF_MOD);
        mod[(size_t)(l * 4 + b) * 6144 + n0 + cl] = sum + p.ada_b[l * 6144 + n0 + cl];
      }
      __syncthreads();
    }
  }
}

template <int MODE>
__device__ __forceinline__ void norm_phase(const Params& p, const float* src, const float* w, const float* modl, int sh_off, int sc_off,
                           char* smem, int bid, int nblk) {
  const int tid = otid(), wid = tid >> 6, lane = tid & 63;
  float* wba = (float*)smem;
  if (MODE == 1) {
    for (int i = tid; i < 1024 * 8; i += 256) wba[i] = p.hy_w_in[(size_t)(i >> 3) * EIN + 2048 + (i & 7)];
    __syncthreads();
  }
  u16* hn = (u16*)(p.ws + OFF_HN);
  auto process = [&](int row, f32x4 (&v)[4]) {
    float ss = 0.f;
#pragma unroll
    for (int i = 0; i < 4; ++i) ss += v[i][0] * v[i][0] + v[i][1] * v[i][1] + v[i][2] * v[i][2] + v[i][3] * v[i][3];
#pragma unroll
    for (int o = 32; o >= 1; o >>= 1) ss += __shfl_xor(ss, o);
    const float rstd = rsqrtf(ss * (1.f / 1024.f) + 1e-6f);
    const int b = row >> 13;
    float dots[8];
    if (MODE == 1) { for (int j = 0; j < 8; ++j) dots[j] = 0.f; }
#pragma unroll
    for (int i = 0; i < 4; ++i) {
      const int c0 = i * 256 + lane * 4;
      f32x4 ww = *(const f32x4*)(w + c0);
      f32x4 y;
      if (MODE == 2) {
#pragma unroll
        for (int e = 0; e < 4; ++e) y[e] = v[i][e] * rstd * ww[e];
        *(f32x4*)(p.out + (size_t)row * 1024 + c0) = y;
      } else {
        f32x4 sc = *(const f32x4*)(modl + (size_t)b * 6144 + sc_off + c0);
        f32x4 sh = *(const f32x4*)(modl + (size_t)b * 6144 + sh_off + c0);
#pragma unroll
        for (int e = 0; e < 4; ++e) y[e] = v[i][e] * rstd * ww[e] * (1.f + sc[e]) + sh[e];
        uint2 pk; pk.x = (unsigned)f2bf(y[0]) | ((unsigned)f2bf(y[1]) << 16); pk.y = (unsigned)f2bf(y[2]) | ((unsigned)f2bf(y[3]) << 16);
        *(uint2*)(hn + a_off(row, c0, 32)) = pk;
        if (MODE == 1) {
#pragma unroll
          for (int e = 0; e < 4; ++e) {
            f32x4 w0 = *(const f32x4*)(wba + (c0 + e) * 8), w1 = *(const f32x4*)(wba + (c0 + e) * 8 + 4);
#pragma unroll
            for (int j = 0; j < 4; ++j) { dots[j] += y[e] * w0[j]; dots[4 + j] += y[e] * w1[j]; }
          }
        }
      }
    }
    if (MODE == 1) {
#pragma unroll
      for (int j = 0; j < 8; ++j) {
#pragma unroll
        for (int o = 32; o >= 1; o >>= 1) dots[j] += __shfl_xor(dots[j], o);
      }
      if (lane == 0) {
        float* beta = (float*)(p.ws + OFF_BETA); float* gg = (float*)(p.ws + OFF_G);
#pragma unroll
        for (int h = 0; h < 4; ++h) {
          beta[(size_t)row * 4 + h] = sigmoid_(dots[h]);
          gg[(size_t)row * 4 + h] = -__expf(p.hy_a_log[h]) * softplus_(dots[4 + h] + p.hy_dt_bias[h]);
        }
      }
    }
  };
#pragma unroll 1
  for (int row = bid * 4 + wid; row < M; row += nblk * 8) {
    const int row1 = row + nblk * 4;
    const bool has1 = row1 < M;
    f32x4 v0[4], v1[4];
#pragma unroll
    for (int i = 0; i < 4; ++i) v0[i] = *(const f32x4*)(src + (size_t)row * 1024 + i * 256 + lane * 4);
#pragma unroll
    for (int i = 0; i < 4; ++i) v1[i] = has1 ? *(const f32x4*)(src + (size_t)row1 * 1024 + i * 256 + lane * 4) : f32x4{0.f, 0.f, 0.f, 0.f};
    process(row, v0);
    if (has1) process(row1, v1);
  }
}

enum { E_PROJ0 = 0, E_BF16 = 1, E_RESID = 2, E_GLU = 3, E_SWIGLU = 4, E_XE = 5, E_S5Y = 6 };
struct EpiArgs { float* outf; u16* outb; const float* res; const float* gate; const u16* y5; const float* bias; u16* ux; int ldc; };

template <int EPI>
__device__ __forceinline__ void gemm_phase(const u16* __restrict__ A0, int nksA, size_t sA, const u16* __restrict__ B0, int nksB, size_t sB,
                                           int K, int nM, int nN, int nbatch, const EpiArgs ea, char* smem, int bid, int nblk) {
  const int tid = otid(), wid = tid >> 6, lane = tid & 63, wr = wid >> 1, wc = wid & 1, fr = lane & 15, fq = lane >> 4;
  char* SA = smem; char* SB = smem + 49152;
  const int sa0 = (int)(uintptr_t)SA + (wr * 128 + fr) * 64 + fq * 16, sb0 = (int)(uintptr_t)SB + (wc * 64 + fr) * 64 + fq * 16;
  const int NR = nbatch * nM, ntiles = NR * nN;
  const int STN = (nN & 7) == 0 ? 8 : ((nN & 3) == 0 ? 4 : 1), STM = 64 / STN, nSN = nN / STN;
  const bool swz = ((nblk & 7) == 0) && (NR % STM == 0);
  const int lpx = nblk >> 3;
  int si = bid & 7, l = bid >> 3, tl = bid;
#pragma unroll 1
  for (;;) {
    int R, pn;
    if (swz) {
      if (si >= (NR / STM) * nSN) break;
      R = (si / nSN) * STM + l / STN; pn = (si % nSN) * STN + l % STN;
      l += lpx; if (l >= 64) { l = bid >> 3; si += 8; }
    } else {
      if (tl >= ntiles) break;
      R = tl / nN; pn = tl % nN; tl += nblk;
    }
    const int g = R / nM, rt = R % nM, brow = rt << 8, bcol = pn << 7;
    const char* A = (const char*)(A0 + (size_t)g * sA) + ((size_t)rt * nksA << 14) + tid * 16;
    const char* Bt = (const char*)(B0 + (size_t)g * sB) + ((size_t)pn * nksB << 13) + tid * 16;
    int nk = K >> 5, klim = nk;
    if (EPI == E_S5Y) { klim = 4 * (pn + 1); nk = klim + 4; }
    f32x4 acc[8][4];
#pragma unroll
    for (int m = 0; m < 8; ++m)
#pragma unroll
      for (int n = 0; n < 4; ++n) acc[m][n] = f32x4{0.f, 0.f, 0.f, 0.f};
#define GSTAGE(KK, BUF) do { const int kt_ = (EPI == E_S5Y && (KK) >= klim) ? (16 + (KK) - klim) : (KK); \
      _Pragma("unroll") for (int i = 0; i < 4; ++i) \
        __builtin_amdgcn_global_load_lds((const unsigned*)(A + ((size_t)kt_ << 14) + i * 4096), (__attribute__((address_space(3))) unsigned*)(SA + (BUF) * 16384 + tid * 16 + i * 4096), 16, 0, 0); \
      _Pragma("unroll") for (int i = 0; i < 2; ++i) \
        __builtin_amdgcn_global_load_lds((const unsigned*)(Bt + ((size_t)kt_ << 13) + i * 4096), (__attribute__((address_space(3))) unsigned*)(SB + (BUF) * 8192 + tid * 16 + i * 4096), 16, 0, 0); } while (0)
    asm volatile("s_waitcnt vmcnt(0)" ::: "memory");
    GSTAGE(0, 0);
    if (nk > 1) { GSTAGE(1, 1); asm volatile("s_waitcnt vmcnt(6)\n\ts_barrier" ::: "memory"); }
    else { asm volatile("s_waitcnt vmcnt(0)\n\ts_barrier" ::: "memory"); }
    int buf = 0, nbuf = 2;
#pragma unroll 1
    for (int kk = 0; kk < nk; ++kk) {
      const bool more = kk + 2 < nk;
      if (more) GSTAGE(kk + 2, nbuf);
      bf16x8 Bl[4], At[8];
      {
        const int bb = sb0 + buf * 8192, ab = sa0 + buf * 16384;
        asm volatile(
            "ds_read_b128 %0, %12\n\tds_read_b128 %1, %12 offset:1024\n\tds_read_b128 %2, %12 offset:2048\n\tds_read_b128 %3, %12 offset:3072\n\t"
            "ds_read_b128 %4, %13\n\tds_read_b128 %5, %13 offset:1024\n\tds_read_b128 %6, %13 offset:2048\n\tds_read_b128 %7, %13 offset:3072\n\t"
            "ds_read_b128 %8, %13 offset:4096\n\tds_read_b128 %9, %13 offset:5120\n\tds_read_b128 %10, %13 offset:6144\n\tds_read_b128 %11, %13 offset:7168\n\t"
            "s_waitcnt lgkmcnt(4)"
            : "=&v"(Bl[0]), "=&v"(Bl[1]), "=&v"(Bl[2]), "=&v"(Bl[3]), "=&v"(At[0]), "=&v"(At[1]), "=&v"(At[2]), "=&v"(At[3]),
              "=&v"(At[4]), "=&v"(At[5]), "=&v"(At[6]), "=&v"(At[7])
            : "v"(bb), "v"(ab)
            : "memory");
      }
      __builtin_amdgcn_s_setprio(1);
#pragma unroll
      for (int m = 0; m < 4; ++m)
#pragma unroll
        for (int n = 0; n < 4; ++n) acc[m][n] = __builtin_amdgcn_mfma_f32_16x16x32_bf16(Bl[n], At[m], acc[m][n], 0, 0, 0);
      __builtin_amdgcn_sched_barrier(0);
      asm volatile("s_waitcnt lgkmcnt(0)" : "+v"(At[4]), "+v"(At[5]), "+v"(At[6]), "+v"(At[7]) :: "memory");
      __builtin_amdgcn_sched_barrier(0);
#pragma unroll
      for (int m = 4; m < 8; ++m)
#pragma unroll
        for (int n = 0; n < 4; ++n) acc[m][n] = __builtin_amdgcn_mfma_f32_16x16x32_bf16(Bl[n], At[m], acc[m][n], 0, 0, 0);
      __builtin_amdgcn_s_setprio(0);
      if (more) asm volatile("s_waitcnt vmcnt(6)\n\ts_barrier" ::: "memory");
      else asm volatile("s_waitcnt vmcnt(0)\n\ts_barrier" ::: "memory");
      buf = (buf == 2) ? 0 : buf + 1; nbuf = (nbuf == 2) ? 0 : nbuf + 1;
    }
#undef GSTAGE
#pragma unroll
    for (int m = 0; m < 8; ++m)
#pragma unroll
      for (int n = 0; n < 4; ++n) {
        const int row = brow + wr * 128 + m * 16 + fr, col = bcol + wc * 64 + n * 16 + fq * 4;
        const f32x4 v = acc[m][n];
        if (EPI == E_PROJ0) {
          const uint2 pk = uint2{pk2(v[0], v[1]), pk2(v[2], v[3])};
          if (bcol < 2048) *(uint2*)(ea.outb + pj_idx(row, col)) = pk;
          else { const int cc = col - 2048; *(uint2*)(ea.ux + (size_t)(cc >> 4) * S5C * UXW + a_off(row >> 5, (row & 31) * 16 + (cc & 15), 20)) = pk; }
        }
        if (EPI == E_BF16) *(uint2*)(ea.outb + (size_t)row * ea.ldc + col) = uint2{pk2(v[0], v[1]), pk2(v[2], v[3])};
        if (EPI == E_RESID) {
          const size_t idx = (size_t)row * 1024 + col;
          const f32x4 r4 = *(const f32x4*)(ea.res + idx), g4 = *(const f32x4*)(ea.gate + (size_t)(row >> 13) * 6144 + col);
          *(f32x4*)(ea.outf + idx) = f32x4{r4[0] + g4[0] * v[0], r4[1] + g4[1] * v[1], r4[2] + g4[2] * v[2], r4[3] + g4[3] * v[3]};
        }
        if (EPI == E_GLU) {
          const uint2 yy = *(const uint2*)(ea.y5 + a_off(row, col, 16));
          const f32x4 b4 = *(const f32x4*)(ea.bias + col);
          const float y0 = __uint_as_float(yy.x << 16), y1 = __uint_as_float(yy.x & 0xffff0000u), y2 = __uint_as_float(yy.y << 16), y3 = __uint_as_float(yy.y & 0xffff0000u);
          *(uint2*)(ea.outb + a_off(row, 512 + col, 32)) = uint2{pk2(y0 * sigmoid_(v[0] + b4[0]), y1 * sigmoid_(v[1] + b4[1])), pk2(y2 * sigmoid_(v[2] + b4[2]), y3 * sigmoid_(v[3] + b4[3]))};
        }
        if (EPI == E_SWIGLU) {
          if ((n & 1) == 0) {
            const f32x4 u = acc[m][n | 1];
            const int co = (bcol >> 1) + wc * 32 + (n >> 1) * 16 + fq * 4;
            *(uint2*)(ea.outb + a_off(row, co, FF / 32)) = uint2{pk2(silu_(v[0]) * u[0], silu_(v[1]) * u[1]), pk2(silu_(v[2]) * u[2], silu_(v[3]) * u[3])};
          }
        }
        if (EPI == E_XE) *(f32x4*)(ea.outf + ((size_t)g * S5C + row) * 128 + col) = v;
        if (EPI == E_S5Y) {
          const uint2 uu = *(const uint2*)(ea.ux + (size_t)g * S5C * UXW + a_off(row, col, 20));
          const f32x4 d4 = *(const f32x4*)(ea.bias + g * 16 + (col & 15));
          const float u0 = __uint_as_float(uu.x << 16), u1 = __uint_as_float(uu.x & 0xffff0000u), u2 = __uint_as_float(uu.y << 16), u3 = __uint_as_float(uu.y & 0xffff0000u);
          *(uint2*)(ea.outb + a_off(row * 32 + (col >> 4), g * 16 + (col & 15), 16)) =
              uint2{pk2(gelu_tanh_(v[0] + d4[0] * u0), gelu_tanh_(v[1] + d4[1] * u1)), pk2(gelu_tanh_(v[2] + d4[2] * u2), gelu_tanh_(v[3] + d4[3] * u3))};
        }
      }
  }
}

__device__ __forceinline__ void s5_carry_phase(const Params& p, int bid, int nblk) {
  const float* xe = (const float*)(p.ws + OFF_XE); const float* a32 = (const float*)(p.ws + OFF_A32);
  u16* ux = (u16*)(p.ws + OFF_UX);
  for (int it = bid; it < 32; it += nblk) {
    const int idx = it * 256 + otid(), pp = idx & 63, g = (idx >> 6) & 31, b = idx >> 11;
    const float ar = a32[(g * 64 + pp) * 2], ai = a32[(g * 64 + pp) * 2 + 1];
    float xr = 0.f, xi = 0.f;
    const size_t cbase = (size_t)g * S5C + b * 256, gbase = (size_t)g * S5C * UXW;
    for (int n = 0; n < 256; n += 8) {
      float er[8], ei[8];
#pragma unroll
      for (int e = 0; e < 8; ++e) { er[e] = xe[(cbase + n + e) * 128 + pp]; ei[e] = xe[(cbase + n + e) * 128 + 64 + pp]; }
#pragma unroll
      for (int e = 0; e < 8; ++e) {
        ux[gbase + a_off(b * 256 + n + e, 512 + pp, 20)] = f2bf(xr); ux[gbase + a_off(b * 256 + n + e, 576 + pp, 20)] = f2bf(xi);
        const float nr = ar * xr - ai * xi + er[e], ni = ar * xi + ai * xr + ei[e];
        xr = nr; xi = ni;
      }
    }
  }
}

__device__ __forceinline__ int crow(int r, int hi) { return (r & 3) + 8 * (r >> 2) + 4 * hi; }
using f32x16 = __attribute__((ext_vector_type(16))) float;
__device__ __forceinline__ void unpack8(const u32x4 w, float* f) {
#pragma unroll
  for (int e = 0; e < 4; ++e) { f[2 * e] = __uint_as_float(w[e] << 16); f[2 * e + 1] = __uint_as_float(w[e] & 0xffff0000u); }
}
__device__ __forceinline__ void gdn_prep_phase(const Params& p, char* smem, int bid, int nblk) {
  const int tid = otid(), wid = tid >> 6, lane = tid & 63, fr = lane & 15, fq = lane >> 4;
  u16* qs = (u16*)smem;
  u16* ks = qs + 64 * 136;
  float* Lm = (float*)(ks + 64 * 136);
  float* gcs = Lm + 4096; float* bts = gcs + 64; float* egs = bts + 64;
  const u16* proj = (const u16*)(p.ws + OFF_PROJ);
  const float* beta = (const float*)(p.ws + OFF_BETA); const float* gg = (const float*)(p.ws + OFF_G);
#pragma unroll 1
  for (int it = bid; it < 2048; it += nblk) {
    const int n = it & 127, bh = it >> 7, b = bh >> 2, h = bh & 3;
    const size_t row0 = (size_t)b * SEQ + n * 64;
    if (wid == 0) {
      float c = gg[(row0 + lane) * 4 + h];
#pragma unroll
      for (int o = 1; o < 64; o <<= 1) { const float tt = __shfl_up(c, o); if (lane >= o) c += tt; }
      gcs[lane] = c; egs[lane] = __expf(c); bts[lane] = beta[(row0 + lane) * 4 + h];
    }
    {
      const int tok = tid >> 2, part = tid & 3, l = n * 64 + tok;
      float qo[32], ko[32]; float sq = 0.f, sk = 0.f;
#pragma unroll
      for (int cb = 0; cb < 4; ++cb) {
        const int colq = h * 128 + part * 32 + cb * 8, colk = 512 + colq;
        const size_t kblk = (size_t)M * 512 - 512;
        float aq[8], ak[8];
#pragma unroll
        for (int e = 0; e < 8; ++e) { aq[e] = 0.f; ak[e] = 0.f; }
#pragma unroll
        for (int j = 0; j < 4; ++j) {
          const int lt = l - 3 + j;
          if (lt >= 0) {
            const u16* rp = proj + ((size_t)b * SEQ + lt) * 512;
            float xq[8], xk[8];
            unpack8(*(const u32x4*)(rp + colq), xq); unpack8(*(const u32x4*)(rp + kblk + colk), xk);
            const f32x4 wq0 = *(const f32x4*)(p.hy_conv_w + j * 1536 + colq), wq1 = *(const f32x4*)(p.hy_conv_w + j * 1536 + colq + 4);
            const f32x4 wk0 = *(const f32x4*)(p.hy_conv_w + j * 1536 + colk), wk1 = *(const f32x4*)(p.hy_conv_w + j * 1536 + colk + 4);
#pragma unroll
            for (int e = 0; e < 4; ++e) { aq[e] += wq0[e] * xq[e]; aq[4 + e] += wq1[e] * xq[4 + e]; ak[e] += wk0[e] * xk[e]; ak[4 + e] += wk1[e] * xk[4 + e]; }
          }
        }
#pragma unroll
        for (int e = 0; e < 8; ++e) { const float a = silu_(aq[e]), k = silu_(ak[e]); qo[cb * 8 + e] = a; ko[cb * 8 + e] = k; sq += a * a; sk += k * k; }
      }
      sq += __shfl_xor(sq, 1); sq += __shfl_xor(sq, 2); sk += __shfl_xor(sk, 1); sk += __shfl_xor(sk, 2);
      const float rq = rsqrtf(sq + 1e-6f) * 0.08838834764831845f, rk = rsqrtf(sk + 1e-6f);
#pragma unroll
      for (int cb = 0; cb < 4; ++cb) {
        u32x4 wq, wk;
#pragma unroll
        for (int e = 0; e < 4; ++e) { wq[e] = pk2(qo[cb * 8 + 2 * e] * rq, qo[cb * 8 + 2 * e + 1] * rq); wk[e] = pk2(ko[cb * 8 + 2 * e] * rk, ko[cb * 8 + 2 * e + 1] * rk); }
        *(u32x4*)(qs + tok * 136 + part * 32 + cb * 8) = wq; *(u32x4*)(ks + tok * 136 + part * 32 + cb * 8) = wk;
      }
    }
    __syncthreads();
    {
      f32x4 akk[4], aqk[4];
#pragma unroll
      for (int nb = 0; nb < 4; ++nb) { akk[nb] = f32x4{0.f, 0.f, 0.f, 0.f}; aqk[nb] = f32x4{0.f, 0.f, 0.f, 0.f}; }
#pragma unroll
      for (int kk = 0; kk < 4; ++kk) {
        const bf16x8 ak = *(const bf16x8*)(ks + (16 * wid + fr) * 136 + kk * 32 + fq * 8);
        const bf16x8 aq = *(const bf16x8*)(qs + (16 * wid + fr) * 136 + kk * 32 + fq * 8);
#pragma unroll
        for (int nb = 0; nb < 4; ++nb) {
          const bf16x8 bk = *(const bf16x8*)(ks + (16 * nb + fr) * 136 + kk * 32 + fq * 8);
          akk[nb] = __builtin_amdgcn_mfma_f32_16x16x32_bf16(ak, bk, akk[nb], 0, 0, 0);
          aqk[nb] = __builtin_amdgcn_mfma_f32_16x16x32_bf16(aq, bk, aqk[nb], 0, 0, 0);
        }
      }
      u16* att = (u16*)(p.ws + OFF_GAT) + (size_t)it * 4096;
#pragma unroll
      for (int nb = 0; nb < 4; ++nb)
#pragma unroll
        for (int r = 0; r < 4; ++r) {
          const int i = 16 * wid + fq * 4 + r, j = 16 * nb + fr;
          const float dec = __expf(fminf(gcs[i] - gcs[j], 0.f));
          Lm[i * 64 + j] = (i > j) ? bts[i] * akk[nb][r] * dec : 0.f;
          att[i * 64 + j] = f2bf((i >= j) ? aqk[nb][r] * dec : 0.f);
        }
    }
    __syncthreads();
    {
      float x[64];
      if (tid < 128) {
        const int col = 1024 + h * 128 + tid;
        const u16* vp = proj + (size_t)2 * M * 512 + h * 128 + tid;
        const float w0 = p.hy_conv_w[col], w1 = p.hy_conv_w[1536 + col], w2 = p.hy_conv_w[2 * 1536 + col], w3 = p.hy_conv_w[3 * 1536 + col];
        float x1 = 0.f, x2 = 0.f, x3 = 0.f;
        if (n > 0) { x3 = bf2f(vp[(row0 - 3) * 512]); x2 = bf2f(vp[(row0 - 2) * 512]); x1 = bf2f(vp[(row0 - 1) * 512]); }
#pragma unroll
        for (int i = 0; i < 64; ++i) {
          const float xv = bf2f(vp[(row0 + i) * 512]);
          x[i] = silu_(w0 * x3 + w1 * x2 + w2 * x1 + w3 * xv) * bts[i];
          x3 = x2; x2 = x1; x1 = xv;
        }
      } else {
#pragma unroll
        for (int i = 0; i < 64; ++i) x[i] = bf2f(ks[i * 136 + tid - 128]) * bts[i] * egs[i];
      }
#pragma unroll
      for (int i = 1; i < 64; ++i) {
        float acc = x[i];
#pragma unroll
        for (int j4 = 0; j4 < (i + 3) / 4; ++j4) {
          const f32x4 l4 = *(const f32x4*)(Lm + i * 64 + j4 * 4);
#pragma unroll
          for (int e = 0; e < 4; ++e) if (j4 * 4 + e < i) acc -= l4[e] * x[j4 * 4 + e];
        }
        x[i] = acc;
      }
      if (tid < 128) {
        u16* ut = (u16*)(p.ws + OFF_GUT) + (size_t)it * 8192 + tid * 64;
#pragma unroll
        for (int c8 = 0; c8 < 8; ++c8) {
          u32x4 w;
#pragma unroll
          for (int e = 0; e < 4; ++e) w[e] = pk2(x[c8 * 8 + 2 * e], x[c8 * 8 + 2 * e + 1]);
          *(u32x4*)(ut + c8 * 8) = w;
        }
      } else {
        u16* wg = (u16*)(p.ws + OFF_GW) + (size_t)it * 8192 + (tid - 128);
#pragma unroll
        for (int i = 0; i < 64; ++i) wg[i * 128] = f2bf(x[i]);
      }
    }
    {
      u16* qd = (u16*)(p.ws + OFF_GQD) + (size_t)it * 8192;
#pragma unroll
      for (int k = 0; k < 4; ++k) {
        const int piece = tid + 256 * k, i = piece >> 4, d0 = (piece & 15) * 8;
        float f[8]; unpack8(*(const u32x4*)(qs + i * 136 + d0), f);
        const float e = egs[i];
        u32x4 w;
#pragma unroll
        for (int e2 = 0; e2 < 4; ++e2) w[e2] = pk2(f[2 * e2] * e, f[2 * e2 + 1] * e);
        *(u32x4*)(qd + i * 128 + d0) = w;
      }
      u16* kt = (u16*)(p.ws + OFF_GKT) + (size_t)it * 8192;
      const int dk = tid & 127, half = tid >> 7;
      const float gl = gcs[63];
#pragma unroll
      for (int c8 = 0; c8 < 4; ++c8) {
        u32x4 w;
#pragma unroll
        for (int e = 0; e < 4; ++e) {
          const int i0 = half * 32 + c8 * 8 + 2 * e;
          w[e] = pk2(bf2f(ks[i0 * 136 + dk]) * __expf(gl - gcs[i0]), bf2f(ks[(i0 + 1) * 136 + dk]) * __expf(gl - gcs[i0 + 1]));
        }
        *(u32x4*)(kt + dk * 64 + half * 32 + c8 * 8) = w;
      }
      if (tid == 0) ((float*)(p.ws + OFF_GSD))[it] = egs[63];
    }
    __syncthreads();
  }
}

__device__ __forceinline__ uint2 lds64(const char* p) { return *(const uint2*)p; }
__device__ __forceinline__ bf16x8 mk8(uint2 a, uint2 b) { u32x4 w = {a.x, a.y, b.x, b.y}; return __builtin_bit_cast(bf16x8, w); }
__device__ __forceinline__ bf16x8 pack8(const f32x16& x, int s) {
  u32x4 w = {pk2(x[8 * s], x[8 * s + 1]), pk2(x[8 * s + 2], x[8 * s + 3]), pk2(x[8 * s + 4], x[8 * s + 5]), pk2(x[8 * s + 6], x[8 * s + 7])};
  return __builtin_bit_cast(bf16x8, w);
}
__device__ __forceinline__ void gdn_scan_item(const Params& p, int bh, char* smem) {
  const int tid = otid(), wid = tid >> 6, lane = tid & 63, r32 = lane & 31, hi = lane >> 5;
  char* Wl = smem; char* KTl = smem + 16896;
  const char* gw = p.ws + OFF_GW; const char* gkt = p.ws + OFF_GKT;
  const u16* gut = (const u16*)(p.ws + OFF_GUT);
  const float* gsd = (const float*)(p.ws + OFF_GSD);
  u32x4* sbg = (u32x4*)(p.ws + OFF_PROJ); u32x4* vbg = (u32x4*)(p.ws + OFF_PROJ + (size_t)2048 * 32768);
  f32x16 S[4];
#pragma unroll
  for (int T = 0; T < 4; ++T)
#pragma unroll
    for (int r = 0; r < 16; ++r) S[T][r] = 0.f;
  u32x4 sa[8], sb_[8]; uint2 uc[8];
  const int dv = wid * 32 + r32;
#define G_LOAD(ST, IT) do { const size_t o16 = (size_t)(IT) * 16384; \
    _Pragma("unroll") for (int k = 0; k < 4; ++k) { ST[k] = *(const u32x4*)(gw + o16 + (tid + 256 * k) * 16); ST[4 + k] = *(const u32x4*)(gkt + o16 + (tid + 256 * k) * 16); } } while (0)
#define U_LOAD(IT) do { _Pragma("unroll") for (int k = 0; k < 8; ++k) uc[k] = *(const uint2*)(gut + (size_t)(IT) * 8192 + dv * 64 + 32 * (k >> 2) + 8 * (k & 3) + 4 * hi); } while (0)
#define G_WRITE(ST) do { \
    _Pragma("unroll") for (int k = 0; k < 4; ++k) { const int pc = tid + 256 * k; \
      { char* d = Wl + (pc >> 4) * 264 + (pc & 15) * 16; *(uint2*)d = uint2{ST[k][0], ST[k][1]}; *(uint2*)(d + 8) = uint2{ST[k][2], ST[k][3]}; } \
      { char* d = KTl + (pc >> 3) * 136 + (pc & 7) * 16; *(uint2*)d = uint2{ST[4 + k][0], ST[4 + k][1]}; *(uint2*)(d + 8) = uint2{ST[4 + k][2], ST[4 + k][3]}; } } } while (0)
#define SCAN_STEP(N, NXT, FAR) do { const int n = (N); const int item = bh * 128 + n; \
    const float sd_nxt = gsd[item + (n + 1 < 128 ? 1 : 0)]; \
    if (n + 2 < 128) G_LOAD(FAR, item + 2); \
    f32x16 av[2]; \
    _Pragma("unroll") for (int r = 0; r < 16; ++r) { av[0][r] = 0.f; av[1][r] = 0.f; } \
    _Pragma("unroll") for (int T = 0; T < 4; ++T) {     \
      bf16x8 wf[4]; \
      _Pragma("unroll") for (int q = 0; q < 4; ++q) { const int s = q >> 1, it = q & 1; \
        const char* wp = Wl + (32 * it + r32) * 264 + (32 * T + 16 * s + 4 * hi) * 2; wf[q] = mk8(lds64(wp), lds64(wp + 16)); } \
      __builtin_amdgcn_sched_barrier(0); \
      _Pragma("unroll") for (int s = 0; s < 2; ++s) { \
        const bf16x8 sb = pack8(S[T], s); \
        sbg[((size_t)(item * 4 + wid) * 8 + T * 2 + s) * 64 + lane] = __builtin_bit_cast(u32x4, sb); \
        av[0] = __builtin_amdgcn_mfma_f32_32x32x16_bf16(wf[s * 2], sb, av[0], 0, 0, 0); \
        av[1] = __builtin_amdgcn_mfma_f32_32x32x16_bf16(wf[s * 2 + 1], sb, av[1], 0, 0, 0); } } \
    bf16x8 vb[2][2]; \
    _Pragma("unroll") for (int it = 0; it < 2; ++it) { \
      f32x16 vn; \
      _Pragma("unroll") for (int g = 0; g < 4; ++g) { const uint2 u2 = uc[it * 4 + g]; \
        vn[4 * g] = __uint_as_float(u2.x << 16) - av[it][4 * g]; vn[4 * g + 1] = __uint_as_float(u2.x & 0xffff0000u) - av[it][4 * g + 1]; \
        vn[4 * g + 2] = __uint_as_float(u2.y << 16) - av[it][4 * g + 2]; vn[4 * g + 3] = __uint_as_float(u2.y & 0xffff0000u) - av[it][4 * g + 3]; } \
      vb[it][0] = pack8(vn, 0); vb[it][1] = pack8(vn, 1); \
      vbg[((size_t)(item * 4 + wid) * 4 + it * 2) * 64 + lane] = __builtin_bit_cast(u32x4, vb[it][0]); \
      vbg[((size_t)(item * 4 + wid) * 4 + it * 2 + 1) * 64 + lane] = __builtin_bit_cast(u32x4, vb[it][1]); } \
    if (n + 1 < 128) U_LOAD(item + 1); \
    _Pragma("unroll") for (int T = 0; T < 4; ++T) { \
      bf16x8 kf[4]; \
      _Pragma("unroll") for (int q = 0; q < 4; ++q) { const int it = q >> 1, s = q & 1; \
        const char* kp = KTl + (32 * T + r32) * 136 + (32 * it + 16 * s + 4 * hi) * 2; kf[q] = mk8(lds64(kp), lds64(kp + 16)); } \
      __builtin_amdgcn_sched_barrier(0); \
      _Pragma("unroll") for (int r = 0; r < 16; ++r) S[T][r] *= sd_cur; \
      _Pragma("unroll") for (int q3 = 0; q3 < 4; ++q3) \
        S[T] = __builtin_amdgcn_mfma_f32_32x32x16_bf16(kf[q3], vb[q3 >> 1][q3 & 1], S[T], 0, 0, 0); } \
    sd_cur = sd_nxt; \
    __syncthreads(); \
    if (n + 1 < 128) G_WRITE(NXT); \
    __syncthreads(); } while (0)
  float sd_cur = gsd[bh * 128];
  G_LOAD(sa, bh * 128); U_LOAD(bh * 128); G_WRITE(sa);
  G_LOAD(sb_, bh * 128 + 1);
  __syncthreads();
#pragma unroll 1
  for (int n2 = 0; n2 < 128; n2 += 2) {
    SCAN_STEP(n2, sb_, sa);
    SCAN_STEP(n2 + 1, sa, sb_);
  }
#undef SCAN_STEP
#undef G_LOAD
#undef G_WRITE
#undef U_LOAD
}

__device__ __forceinline__ void gdn_out_phase(const Params& p, char* smem, int bid, int nblk) {
  const int tid = otid(), wid = tid >> 6, lane = tid & 63, r32 = lane & 31, hi = lane >> 5;
  char* QDl = smem; char* ATl = smem + 16896; float* Ol = (float*)(smem + 16896 + 8704);
  const char* gqd = p.ws + OFF_GQD; const char* gat = p.ws + OFF_GAT;
  const u32x4* sbg = (const u32x4*)(p.ws + OFF_PROJ); const u32x4* vbg = (const u32x4*)(p.ws + OFF_PROJ + (size_t)2048 * 32768);
  const u16* zb = (const u16*)(p.ws + OFF_PROJ) + (size_t)3 * M * 512;
  u16* concat = (u16*)(p.ws + OFF_HN);
#pragma unroll 1
  for (int item = bid; item < 2048; item += nblk) {
    const int n = item & 127, bh = item >> 7, b = bh >> 2, h = bh & 3;
    {
      u32x4 st[6];
#pragma unroll
      for (int k = 0; k < 4; ++k) st[k] = *(const u32x4*)(gqd + (size_t)item * 16384 + (tid + 256 * k) * 16);
#pragma unroll
      for (int k = 0; k < 2; ++k) st[4 + k] = *(const u32x4*)(gat + (size_t)item * 8192 + (tid + 256 * k) * 16);
#pragma unroll
      for (int k = 0; k < 4; ++k) { const int pc = tid + 256 * k; char* d = QDl + (pc >> 4) * 264 + (pc & 15) * 16;
        *(uint2*)d = uint2{st[k][0], st[k][1]}; *(uint2*)(d + 8) = uint2{st[k][2], st[k][3]}; }
#pragma unroll
      for (int k = 0; k < 2; ++k) { const int pc = tid + 256 * k; char* d = ATl + (pc >> 3) * 136 + (pc & 7) * 16;
        *(uint2*)d = uint2{st[4 + k][0], st[4 + k][1]}; *(uint2*)(d + 8) = uint2{st[4 + k][2], st[4 + k][3]}; }
    }
    bf16x8 sb[8], vb[4];
#pragma unroll
    for (int f = 0; f < 8; ++f) sb[f] = __builtin_bit_cast(bf16x8, sbg[((size_t)(item * 4 + wid) * 8 + f) * 64 + lane]);
#pragma unroll
    for (int f = 0; f < 4; ++f) vb[f] = __builtin_bit_cast(bf16x8, vbg[((size_t)(item * 4 + wid) * 4 + f) * 64 + lane]);
    __syncthreads();
    f32x16 ao[2];
#pragma unroll
    for (int r = 0; r < 16; ++r) { ao[0][r] = 0.f; ao[1][r] = 0.f; }
#pragma unroll
    for (int T = 0; T < 4; ++T)
#pragma unroll
      for (int s = 0; s < 2; ++s) {
        const int cb = (32 * T + 16 * s + 4 * hi) * 2;
#pragma unroll
        for (int it = 0; it < 2; ++it) {
          const char* qp = QDl + (32 * it + r32) * 264 + cb;
          ao[it] = __builtin_amdgcn_mfma_f32_32x32x16_bf16(mk8(lds64(qp), lds64(qp + 16)), sb[T * 2 + s], ao[it], 0, 0, 0);
        }
      }
#pragma unroll
    for (int it2 = 0; it2 < 2; ++it2)
#pragma unroll
      for (int it = 0; it <= it2; ++it)
#pragma unroll
        for (int s = 0; s < 2; ++s) {
          const char* ap = ATl + (32 * it2 + r32) * 136 + (32 * it + 16 * s + 4 * hi) * 2;
          ao[it2] = __builtin_amdgcn_mfma_f32_32x32x16_bf16(mk8(lds64(ap), lds64(ap + 16)), vb[it * 2 + s], ao[it2], 0, 0, 0);
        }
#pragma unroll
    for (int it = 0; it < 2; ++it)
#pragma unroll
      for (int r = 0; r < 16; ++r) Ol[(32 * it + crow(r, hi)) * 132 + wid * 32 + r32] = ao[it][r];
    __syncthreads();
    {
      const int tok = tid >> 2, part = tid & 3;
      const int row = b * SEQ + n * 64 + tok;
      f32x4 a[8]; float ss = 0.f;
#pragma unroll
      for (int k = 0; k < 8; ++k) { a[k] = *(const f32x4*)(Ol + tok * 132 + part * 32 + k * 4); ss += a[k][0] * a[k][0] + a[k][1] * a[k][1] + a[k][2] * a[k][2] + a[k][3] * a[k][3]; }
      ss += __shfl_xor(ss, 1); ss += __shfl_xor(ss, 2);
      const float rs = rsqrtf(ss * (1.f / 128.f) + 1e-6f);
      const u16* zp = zb + (size_t)row * 512 + h * 128 + part * 32;
      const float* hw = p.hy_head_norm_w + part * 32;
      u16* cp = concat + a_off(row, h * 128 + part * 32, 32);
#pragma unroll
      for (int k = 0; k < 4; ++k) {
        float zf[8]; unpack8(*(const u32x4*)(zp + k * 8), zf);
        const f32x4 h0 = *(const f32x4*)(hw + k * 8), h1 = *(const f32x4*)(hw + k * 8 + 4);
        const f32x4 x0 = a[2 * k], x1 = a[2 * k + 1];
        u32x4 w;
        w[0] = pk2(x0[0] * rs * h0[0] * silu_(zf[0]), x0[1] * rs * h0[1] * silu_(zf[1]));
        w[1] = pk2(x0[2] * rs * h0[2] * silu_(zf[2]), x0[3] * rs * h0[3] * silu_(zf[3]));
        w[2] = pk2(x1[0] * rs * h1[0] * silu_(zf[4]), x1[1] * rs * h1[1] * silu_(zf[5]));
        w[3] = pk2(x1[2] * rs * h1[2] * silu_(zf[6]), x1[3] * rs * h1[3] * silu_(zf[7]));
        *(u32x4*)(cp + k * 8) = w;
      }
    }
    __syncthreads();
  }
}

using s16x4 = __attribute__((ext_vector_type(4))) short;
#define KSWZ(row, colB) ((row) * 256 + ((colB) ^ (((row) & 7) << 4)))
#define SBAR() __builtin_amdgcn_sched_barrier(0)
__device__ __forceinline__ unsigned cvtpk(float lo, float hi) { unsigned r; asm volatile("v_cvt_pk_bf16_f32 %0, %1, %2" : "=v"(r) : "v"(lo), "v"(hi)); return r; }
__device__ __forceinline__ int v_st(int k, int c) { const int kk = (k & ~0xC) | ((k & 4) << 1) | ((k & 8) >> 1); return ((kk >> 3) * 4 + (c >> 5)) * 512 + ((kk & 7) * 32 + (c & 31)) * 2; }
__device__ __forceinline__ int v_rd_base(int lane) { return ((lane & 3) << 3) | (((lane >> 2) & 3) << 6) | (((lane >> 4) & 1) << 5) | (((lane >> 5) & 1) << 8); }
constexpr int v_rd_off(int d0, int ks, int half) { return d0 * 512 + ks * 4096 + half * 2048; }
template <int OFF> __device__ __forceinline__ s16x4 tr_read(int vb) {
  s16x4 r; asm volatile("ds_read_b64_tr_b16 %0, %1 offset:%2" : "=&v"(r) : "v"(vb), "i"(OFF) : "memory"); return r;
}
template <int D0> __device__ __forceinline__ void pv_one(f32x16& od, int vb, bf16x8 pa0, bf16x8 pa1, bf16x8 pa2, bf16x8 pa3) {
  const s16x4 l0 = tr_read<v_rd_off(D0, 0, 0)>(vb), h0 = tr_read<v_rd_off(D0, 0, 1)>(vb), l1 = tr_read<v_rd_off(D0, 1, 0)>(vb), h1 = tr_read<v_rd_off(D0, 1, 1)>(vb);
  const s16x4 l2 = tr_read<v_rd_off(D0, 2, 0)>(vb), h2 = tr_read<v_rd_off(D0, 2, 1)>(vb), l3 = tr_read<v_rd_off(D0, 3, 0)>(vb), h3 = tr_read<v_rd_off(D0, 3, 1)>(vb);
  asm volatile("s_waitcnt lgkmcnt(0)" ::: "memory"); SBAR();
#define PK(L, H) (bf16x8){L[0], L[1], L[2], L[3], H[0], H[1], H[2], H[3]}
  od = __builtin_amdgcn_mfma_f32_32x32x16_bf16(pa0, PK(l0, h0), od, 0, 0, 0);
  od = __builtin_amdgcn_mfma_f32_32x32x16_bf16(pa1, PK(l1, h1), od, 0, 0, 0);
  od = __builtin_amdgcn_mfma_f32_32x32x16_bf16(pa2, PK(l2, h2), od, 0, 0, 0);
  od = __builtin_amdgcn_mfma_f32_32x32x16_bf16(pa3, PK(l3, h3), od, 0, 0, 0);
#undef PK
}
__device__ __forceinline__ float pl32_other(float a, float b, int hi) {
  auto rr = __builtin_amdgcn_permlane32_swap(__float_as_uint(a), __float_as_uint(b), false, false);
  return __uint_as_float(hi ? rr[0] : rr[1]);
}
__device__ __forceinline__ void sb_half(f32x16& pz, float& run, bool need_mask, int kb, int t, int hi) {
  constexpr float C2 = 0.08838834764831845f * 1.4426950408889634f;
  f32x16 l;
#pragma unroll
  for (int r = 0; r < 16; ++r) {
    const float e = __builtin_amdgcn_exp2f(fminf(pz[r] * C2, 60.f));
    l[r] = __builtin_amdgcn_rcpf(1.f + e);
    pz[r] = e;
  }
  if (need_mask) {
#pragma unroll
    for (int r = 0; r < 16; ++r) { if (kb + crow(r, hi) >= t) { l[r] = 1.f; pz[r] = 0.f; } }
  }
#pragma unroll
  for (int g = 0; g < 4; ++g) { l[4 * g + 2] *= l[4 * g + 3]; l[4 * g + 1] *= l[4 * g + 2]; l[4 * g] *= l[4 * g + 1]; }
  const float cs3 = l[12], cs2 = l[8] * cs3, cs1 = l[4] * cs2, cs0 = l[0] * cs1;
  const float off0 = cs1 * pl32_other(cs0, cs1, hi) * run;
  const float off1 = cs2 * pl32_other(cs1, cs2, hi) * run;
  const float off2 = cs3 * pl32_other(cs2, cs3, hi) * run;
  const float off3 = pl32_other(cs3, 1.f, hi) * run;
  float tot;
  { auto rr = __builtin_amdgcn_permlane32_swap(__float_as_uint(cs0), __float_as_uint(cs0), false, false); tot = __uint_as_float(rr[0]) * __uint_as_float(rr[1]); }
#pragma unroll
  for (int r = 0; r < 4; ++r) {
    pz[r] = pz[r] * l[r] * off0; pz[4 + r] = pz[4 + r] * l[4 + r] * off1;
    pz[8 + r] = pz[8 + r] * l[8 + r] * off2; pz[12 + r] = pz[12 + r] * l[12 + r] * off3;
  }
  run *= tot;
}

__device__ __forceinline__ void attn_phase(const Params& p, char* smem, int bid, int nblk) {
  const int tid = otid(), wid = tid >> 6, lane = tid & 63, r32 = lane & 31, hi = lane >> 5;
  char* K_lds0 = smem; char* V_lds0 = smem + 16384;
  const u16* qkv = (const u16*)(p.ws + OFF_PROJ);
  u16* ao = (u16*)(p.ws + OFF_HN);
  const int sr = tid >> 4, sc = (tid & 15) * 8;
  const int vb00 = (int)(uintptr_t)V_lds0 + v_rd_base(lane);
  for (int k = 0; k * nblk < 2048; ++k) {
    const int i = (k & 1) ? ((k + 1) * nblk - 1 - bid) : (k * nblk + bid);
    if (i >= 2048) continue;
    const int j = 63 - (i >> 5), bh = i & 31, b = bh >> 3, h = bh & 7;
    const int i0 = j * 128;
    const size_t rowb = (size_t)b * SEQ;
    const int t = i0 + wid * 32 + r32, tmin = i0 + wid * 32, tmax = tmin + 31;
    bf16x8 qr[8];
    {
      const u16* qp = qkv + (rowb + t) * 3072 + h * 128 + hi * 8;
#pragma unroll
      for (int d0 = 0; d0 < 8; ++d0) qr[d0] = *(const bf16x8*)(qp + d0 * 16);
    }
    f32x16 o[4];
#pragma unroll
    for (int d = 0; d < 4; ++d)
#pragma unroll
      for (int r = 0; r < 16; ++r) o[d][r] = 0.f;
    float run = 1.f;
    const u16* kbase = qkv + rowb * 3072 + 1024 + h * 128 + sc;
    u32x4 stk[4], stv[4];
#define SLOAD(KT) do { _Pragma("unroll") for (int ii = 0; ii < 4; ++ii) { const u16* kp = kbase + (size_t)((KT) * 64 + sr + 16 * ii) * 3072; \
      stk[ii] = *(const u32x4*)kp; stv[ii] = *(const u32x4*)(kp + 1024); } } while (0)
#define SWRITE(B) do { _Pragma("unroll") for (int ii = 0; ii < 4; ++ii) { const int row = sr + 16 * ii; \
      *(u32x4*)(K_lds0 + (B) * 32768 + KSWZ(row, sc * 2)) = stk[ii]; *(u32x4*)(V_lds0 + (B) * 32768 + v_st(row, sc)) = stv[ii]; } } while (0)
    const int NT = 2 * j + 2;
    __syncthreads();
    SLOAD(NT - 1); SWRITE(0); __syncthreads();
    int cur = 0;
    for (int kt = NT - 1; kt >= 0; --kt) {
      const int k0 = kt * 64;
      const char* K_lds = K_lds0 + cur * 32768; const int vb0 = vb00 + cur * 32768;
      if (kt > 0) SLOAD(kt - 1);
      if (k0 <= tmax) {
        bf16x8 pa0, pa1, pa2, pa3;
#define PK4(P, BASE, OUT) do { unsigned a0 = cvtpk(P[BASE + 0], P[BASE + 1]), a1 = cvtpk(P[BASE + 2], P[BASE + 3]); \
    unsigned b0_ = cvtpk(P[BASE + 4], P[BASE + 5]), b1_ = cvtpk(P[BASE + 6], P[BASE + 7]); \
    auto r0 = __builtin_amdgcn_permlane32_swap(a0, b0_, false, false); auto r1 = __builtin_amdgcn_permlane32_swap(a1, b1_, false, false); \
    u32x4 w = {r0[0], r1[0], r0[1], r1[1]}; OUT = *reinterpret_cast<bf16x8*>(&w); } while (0)
        if (k0 + 32 <= tmax) {
          f32x16 pz;
#pragma unroll
          for (int r = 0; r < 16; ++r) pz[r] = 0.f;
#pragma unroll
          for (int d0 = 0; d0 < 8; ++d0) {
            const bf16x8 kf = *(const bf16x8*)(K_lds + KSWZ(32 + r32, (d0 * 16 + hi * 8) * 2));
            pz = __builtin_amdgcn_mfma_f32_32x32x16_bf16(kf, qr[d0], pz, 0, 0, 0);
          }
          sb_half(pz, run, k0 + 63 >= tmin, k0 + 32, t, hi);
          PK4(pz, 0, pa2); PK4(pz, 8, pa3);
        } else {
          pa2 = bf16x8{0, 0, 0, 0, 0, 0, 0, 0}; pa3 = pa2;
        }
        {
          f32x16 pz;
#pragma unroll
          for (int r = 0; r < 16; ++r) pz[r] = 0.f;
#pragma unroll
          for (int d0 = 0; d0 < 8; ++d0) {
            const bf16x8 kf = *(const bf16x8*)(K_lds + KSWZ(r32, (d0 * 16 + hi * 8) * 2));
            pz = __builtin_amdgcn_mfma_f32_32x32x16_bf16(kf, qr[d0], pz, 0, 0, 0);
          }
          sb_half(pz, run, k0 + 31 >= tmin, k0, t, hi);
          PK4(pz, 0, pa0); PK4(pz, 8, pa1);
        }
#undef PK4
        pv_one<0>(o[0], vb0, pa0, pa1, pa2, pa3); pv_one<1>(o[1], vb0, pa0, pa1, pa2, pa3);
        pv_one<2>(o[2], vb0, pa0, pa1, pa2, pa3); pv_one<3>(o[3], vb0, pa0, pa1, pa2, pa3);
      }
      if (kt > 0) SWRITE(cur ^ 1);
      __syncthreads();
      cur ^= 1;
    }
#undef SLOAD
#undef SWRITE
    {
      const int orow0 = (int)rowb + i0 + wid * 32;
#pragma unroll
      for (int r = 0; r < 16; ++r) {
        const int orow = crow(r, hi);
#pragma unroll
        for (int d0 = 0; d0 < 4; ++d0) ao[a_off(orow0 + orow, h * 128 + d0 * 32 + r32, 32)] = f2bf(o[d0][r]);
      }
    }
  }
}

#define XB_TMO      128
#define XB_XCNT(j)  (256  + 64 * (j))
#define XB_XSUB(j)  (1280 + 64 * (j))
#define XB_XGEN(j)  (2304 + 64 * (j))
#define XB_TOP      3328
#define XB_TOPGEN   3392
#define XCD_BAR_WORDS 3456
#define XB_SPIN_CAP (1u << 23)
#define LAS __attribute__((address_space(3)))
__device__ __forceinline__ unsigned xb_ld(unsigned* p)              { return __hip_atomic_load(p, __ATOMIC_RELAXED, __HIP_MEMORY_SCOPE_AGENT); }
__device__ __forceinline__ unsigned xb_add(unsigned* p, unsigned v) { return __hip_atomic_fetch_add(p, v, __ATOMIC_RELAXED, __HIP_MEMORY_SCOPE_AGENT); }
__device__ __forceinline__ unsigned xb_xcc_id() { return (unsigned)__builtin_amdgcn_s_getreg((3 << 11) | 20) & 0xFu; }
#define XB_SPIN(cond, bar) do { unsigned _sp = 0; while (cond) { __builtin_amdgcn_s_sleep(1); \
    if ((++_sp & 255u) == 0u) { if (xb_ld(&(bar)[XB_TMO])) break; if (_sp > XB_SPIN_CAP) { atomicAdd(&(bar)[XB_TMO], 1u); break; } } } } while (0)
struct XcdBarrier { unsigned* bar; unsigned x; volatile LAS unsigned* st; };
__device__ __forceinline__ XcdBarrier xcd_barrier_post(unsigned* bar, volatile LAS unsigned* st) {
  XcdBarrier b; b.bar = bar; b.x = xb_xcc_id(); b.st = st;
  if (__builtin_amdgcn_workitem_id_x() == 0) (void)xb_add(&bar[XB_XCNT(b.x)], 1u);
  return b;
}
__device__ __forceinline__ void xcd_barrier_complete(unsigned* bar, unsigned x, unsigned& nloc, unsigned& nx) {
  const unsigned G = gridDim.x * gridDim.y * gridDim.z;
  unsigned sum, cnt, mine, sp = 0u;
  for (;;) {
    sum = 0u; cnt = 0u; mine = 0u;
#pragma unroll
    for (unsigned j = 0; j < 16; ++j) { const unsigned c = xb_ld(&bar[XB_XCNT(j)]); sum += c; cnt += (c > 0u) ? 1u : 0u; mine = (j == x) ? c : mine; }
    if (sum == G) break;
    __builtin_amdgcn_s_sleep(1);
    if ((++sp & 255u) == 0u) { if (xb_ld(&bar[XB_TMO])) break; if (sp > XB_SPIN_CAP) { atomicAdd(&bar[XB_TMO], 1u); break; } }
  }
  nloc = mine > 0u ? mine : 1u; nx = cnt > 0u ? cnt : 1u;
}
__device__ __forceinline__ void xcd_barrier(const XcdBarrier& b) {
  asm volatile("s_waitcnt vmcnt(0)" ::: "memory");
  __syncthreads();
  if (__builtin_amdgcn_workitem_id_x() == 0) {
    unsigned* bar = b.bar;
    __builtin_amdgcn_s_waitcnt(0);
    unsigned nloc = b.st[0], nx = b.st[1];
    if (nloc == 0u) { xcd_barrier_complete(bar, b.x, nloc, nx); b.st[0] = nloc; b.st[1] = nx; }
    const unsigned old = xb_add(&bar[XB_XSUB(b.x)], 1u);
    const unsigned gen = old / nloc;
    if (old + 1u == (gen + 1u) * nloc) {
      __builtin_amdgcn_fence(__ATOMIC_RELEASE, "agent");
      asm volatile("s_waitcnt vmcnt(0)" ::: "memory");
      const unsigned og = xb_add(&bar[XB_TOP], 1u);
      const unsigned tg = og / nx;
      if (og + 1u == (tg + 1u) * nx) xb_add(&bar[XB_TOPGEN], 1u);
      else XB_SPIN(xb_ld(&bar[XB_TOPGEN]) == tg, bar);
      __builtin_amdgcn_fence(__ATOMIC_ACQUIRE, "agent");
      xb_add(&bar[XB_XGEN(b.x)], 1u);
      asm volatile("s_waitcnt vmcnt(0)" ::: "memory");
    } else {
      XB_SPIN(xb_ld(&bar[XB_XGEN(b.x)]) == gen, bar);
      __builtin_amdgcn_fence(__ATOMIC_ACQUIRE, "agent");
      asm volatile("s_waitcnt vmcnt(0)" ::: "memory");
    }
  }
  __syncthreads();
}

__global__ void __launch_bounds__(256, 2) mega(Params p) {
  __shared__ __attribute__((aligned(16))) char smem[SMEM_BYTES];
  __shared__ uint4 xb_words;
  const int bid = blockIdx.x, nblk = gridDim.x;
  char* ws = p.ws;
  if (__builtin_amdgcn_workitem_id_x() == 0) xb_words = make_uint4(0u, 0u, 0u, 0u);
  __syncthreads();
  const XcdBarrier xbar = xcd_barrier_post((unsigned*)(ws + OFF_BAR), (volatile LAS unsigned*)&xb_words);
  const float* mod = (const float*)(ws + OFF_MOD);
  u16* hn = (u16*)(ws + OFF_HN);
#define PH_BEGIN(n) if (p.phase_lo <= (n) && (n) < p.phase_hi) {
#define PH_END(n) if ((n) + 1 < p.phase_hi) { if ((n) == 0) cg::this_grid().sync(); else xcd_barrier(xbar); } }
  PH_BEGIN(0) phase0(p, smem, bid, nblk); PH_END(0)
  PH_BEGIN(1) norm_phase<1>(p, p.x, p.norm_mix_w, mod, 0, 1024, smem, bid, nblk); PH_END(1)
  PH_BEGIN(2) { EpiArgs ea{}; ea.outb = (u16*)(ws + OFF_PROJ); ea.ux = (u16*)(ws + OFF_UX);
        gemm_phase<E_PROJ0>(hn, 32, 0, (const u16*)(ws + OFF_WT_HYIN), 32, 0, 1024, M / 256, PN / 128, 1, ea, smem, bid, nblk); } PH_END(2)
  PH_BEGIN(3) { EpiArgs ea{}; ea.outf = (float*)(ws + OFF_XE);
        gemm_phase<E_XE>((const u16*)(ws + OFF_UX), 20, (size_t)S5C * UXW, (const u16*)(ws + OFF_EG), 16, (size_t)128 * 512, 512, S5C / 256, 1, 32, ea, smem, bid, nblk); } PH_END(3)
  PH_BEGIN(4) { s5_carry_phase(p, bid, nblk); gdn_prep_phase(p, smem, bid, nblk); } PH_END(4)
  PH_BEGIN(5) {
        if (bid < 16) { gdn_scan_item(p, bid, smem); }
        else { EpiArgs ea{}; ea.outb = (u16*)(ws + OFF_Y5); ea.ux = (u16*)(ws + OFF_UX); ea.bias = p.s5_d;
          gemm_phase<E_S5Y>((const u16*)(ws + OFF_UX), 20, (size_t)S5C * UXW, (const u16*)(ws + OFF_MF), 20, (size_t)512 * UXW, UXW, S5C / 256, 4, 32, ea, smem, bid - 16, nblk - 16); }
      } PH_END(5)
  PH_BEGIN(6) { gdn_out_phase(p, smem, bid, nblk); __syncthreads();
 EpiArgs ea{}; ea.outb = hn; ea.y5 = (const u16*)(ws + OFF_Y5); ea.bias = p.s5_glu_b;
        gemm_phase<E_GLU>((const u16*)(ws + OFF_Y5), 16, 0, (const u16*)(ws + OFF_WT_GLU), 16, 0, 512, M / 256, 4, 1, ea, smem, bid, nblk); } PH_END(6)
  PH_BEGIN(8) { EpiArgs ea{}; ea.outf = p.out; ea.res = p.x; ea.gate = mod + 2048;
        gemm_phase<E_RESID>(hn, 32, 0, (const u16*)(ws + OFF_WT_HYOUT), 32, 0, 1024, M / 256, 8, 1, ea, smem, bid, nblk); } PH_END(8)
  PH_BEGIN(9) norm_phase<0>(p, p.out, p.norm_ffn_w, mod, 3072, 4096, smem, bid, nblk); PH_END(9)
  PH_BEGIN(10) { EpiArgs ea{}; ea.outb = (u16*)(ws + OFF_PROJ);
        gemm_phase<E_SWIGLU>(hn, 32, 0, (const u16*)(ws + OFF_WT_FFNIN), 32, 0, 1024, M / 256, 2 * FF / 128, 1, ea, smem, bid, nblk); } PH_END(10)
  PH_BEGIN(11) { EpiArgs ea{}; ea.outf = p.out; ea.res = p.out; ea.gate = mod + 5120;
        gemm_phase<E_RESID>((const u16*)(ws + OFF_PROJ), FF / 32, 0, (const u16*)(ws + OFF_WT_FFNOUT), FF / 32, 0, FF, M / 256, 8, 1, ea, smem, bid, nblk); } PH_END(11)
  PH_BEGIN(12) norm_phase<0>(p, p.out, p.norm_mix_w + 1024, mod + 4 * 6144, 0, 1024, smem, bid, nblk); PH_END(12)
  PH_BEGIN(13) { EpiArgs ea{}; ea.outb = (u16*)(ws + OFF_PROJ); ea.ldc = 3072;
        gemm_phase<E_BF16>(hn, 32, 0, (const u16*)(ws + OFF_WT_SBIN), 32, 0, 1024, M / 256, 24, 1, ea, smem, bid, nblk); } PH_END(13)
  PH_BEGIN(14) attn_phase(p, smem, bid, nblk); PH_END(14)
  PH_BEGIN(15) { EpiArgs ea{}; ea.outf = p.out; ea.res = p.out; ea.gate = mod + 4 * 6144 + 2048;
        gemm_phase<E_RESID>(hn, 32, 0, (const u16*)(ws + OFF_WT_SBOUT), 32, 0, 1024, M / 256, 8, 1, ea, smem, bid, nblk); } PH_END(15)
  PH_BEGIN(16) norm_phase<0>(p, p.out, p.norm_ffn_w + 1024, mod + 4 * 6144, 3072, 4096, smem, bid, nblk); PH_END(16)
  PH_BEGIN(17) { EpiArgs ea{}; ea.outb = (u16*)(ws + OFF_PROJ);
        gemm_phase<E_SWIGLU>(hn, 32, 0, (const u16*)(ws + OFF_WT_FFNIN + SZ_WT_FFNIN), 32, 0, 1024, M / 256, 2 * FF / 128, 1, ea, smem, bid, nblk); } PH_END(17)
  PH_BEGIN(18) { EpiArgs ea{}; ea.outf = p.out; ea.res = p.out; ea.gate = mod + 4 * 6144 + 5120;
        gemm_phase<E_RESID>((const u16*)(ws + OFF_PROJ), FF / 32, 0, (const u16*)(ws + OFF_WT_FFNOUT + SZ_WT_FFNOUT), FF / 32, 0, FF, M / 256, 8, 1, ea, smem, bid, nblk); } PH_END(18)
  PH_BEGIN(19) norm_phase<2>(p, p.out, p.final_norm_w, mod, 0, 0, smem, bid, nblk); PH_END(19)
}

extern "C" void kernel_launch(void* const* d_in, const int* in_sizes, int n_in, void* d_out, int out_size, void* d_ws, size_t ws_size,
                              hipStream_t stream) {
  static int grid_blocks = 0;
  if (!grid_blocks) {
    int dev = 0, cus = 0, per_cu = 0;
    hipGetDevice(&dev);
    hipDeviceGetAttribute(&cus, hipDeviceAttributeMultiprocessorCount, dev);
    hipOccupancyMaxActiveBlocksPerMultiprocessor(&per_cu, mega, 256, 0);
    if (per_cu > 2) per_cu = 2;
    if (per_cu < 1) per_cu = 1;
    grid_blocks = cus * per_cu;
  }
  Params p{};
  const float* const* in = (const float* const*)d_in;
  p.x = in[0]; p.c = in[1]; p.ada_w = in[2]; p.ada_b = in[3]; p.norm_mix_w = in[4]; p.norm_ffn_w = in[5]; p.ffn_w_in = in[6]; p.ffn_w_out = in[7];
  p.hy_w_in = in[8]; p.hy_conv_w = in[9]; p.hy_a_log = in[10]; p.hy_dt_bias = in[11]; p.hy_head_norm_w = in[12];
  p.s5_lam_re = in[13]; p.s5_lam_im = in[14]; p.s5_log_dt = in[15]; p.s5_b_re = in[16]; p.s5_b_im = in[17]; p.s5_c_re = in[18]; p.s5_c_im = in[19];
  p.s5_d = in[20]; p.s5_glu_w = in[21]; p.s5_glu_b = in[22]; p.hy_w_out = in[23]; p.sb_w_in = in[24]; p.sb_w_out = in[25]; p.final_norm_w = in[26];
  p.out = (float*)d_out; p.ws = (char*)d_ws;
#if ONE_LAUNCH
  p.phase_lo = 0; p.phase_hi = NPHASE;
  (void)hipMemsetAsync((char*)d_ws + OFF_BAR, 0, (size_t)XCD_BAR_WORDS_C * 4, stream);
  void* args[] = {&p};
  hipError_t e = hipLaunchCooperativeKernel((void*)mega, dim3(grid_blocks), dim3(256), args, 0, stream);
  if (e != hipSuccess) fprintf(stderr, "cooperative launch failed: %s (grid %d)\n", hipGetErrorString(e), grid_blocks);
#else
  for (int ph = 0; ph < NPHASE; ++ph) {
    p.phase_lo = ph; p.phase_hi = ph + 1;
    hipLaunchKernelGGL(mega, dim3(grid_blocks), dim3(256), 0, stream, p);
  }
#endif
}
```

```cpp
#include <hip/hip_runtime.h>
#include <hip/hip_cooperative_groups.h>
#include <stdint.h>
#include <cstdio>
namespace cg = cooperative_groups;

#ifndef ONE_LAUNCH
#define ONE_LAUNCH 1
#endif

typedef unsigned short u16;
using bf16x8 = __attribute__((ext_vector_type(8))) short;
using f32x4 = __attribute__((ext_vector_type(4))) float;
using u32x4 = __attribute__((ext_vector_type(4))) unsigned;

constexpr int D = 1024, NB = 4, SEQ = 8192, M = NB * SEQ, FF = 2816, EIN = 2568, PN = 2560, PJ = 2048;
constexpr int NPHASE = 20;
constexpr int XCD_BAR_WORDS_C = 3456;
constexpr int S5T = 32, S5C = M / S5T, UXW = 640;

constexpr size_t SZ_WT_HYIN = (size_t)PN * 1024 * 2, SZ_WT_SQ = (size_t)1024 * 1024 * 2, SZ_WT_GLU = (size_t)512 * 512 * 2;
constexpr size_t SZ_WT_FFNIN = (size_t)2 * FF * 1024 * 2, SZ_WT_FFNOUT = (size_t)1024 * FF * 2, SZ_WT_SBIN = (size_t)3072 * 1024 * 2;
constexpr size_t OFF_WT_HYIN = 0;
constexpr size_t OFF_WT_HYOUT = OFF_WT_HYIN + SZ_WT_HYIN;
constexpr size_t OFF_WT_GLU = OFF_WT_HYOUT + SZ_WT_SQ;
constexpr size_t OFF_WT_FFNIN = OFF_WT_GLU + SZ_WT_GLU;
constexpr size_t OFF_WT_FFNOUT = OFF_WT_FFNIN + 2 * SZ_WT_FFNIN;
constexpr size_t OFF_WT_SBIN = OFF_WT_FFNOUT + 2 * SZ_WT_FFNOUT;
constexpr size_t OFF_WT_SBOUT = OFF_WT_SBIN + SZ_WT_SBIN;
constexpr size_t OFF_MOD = OFF_WT_SBOUT + SZ_WT_SQ;
constexpr size_t OFF_BETA = OFF_MOD + (size_t)2 * 4 * 6144 * 4;
constexpr size_t OFF_G = OFF_BETA + (size_t)M * 4 * 4;
constexpr size_t OFF_HN = OFF_G + (size_t)M * 4 * 4;
constexpr size_t OFF_Y5 = OFF_HN + (size_t)M * 1024 * 2;
constexpr size_t OFF_UX = OFF_Y5 + (size_t)M * 512 * 2;
constexpr size_t OFF_MF = OFF_UX + (size_t)32 * S5C * UXW * 2;
constexpr size_t OFF_EG = OFF_MF + (size_t)32 * 512 * UXW * 2;
constexpr size_t OFF_XE = OFF_EG + (size_t)32 * 128 * 512 * 2;
constexpr size_t OFF_A32 = OFF_XE + (size_t)32 * S5C * 128 * 4;
constexpr size_t OFF_PROJ = OFF_A32 + (size_t)32 * 64 * 2 * 4;
constexpr size_t OFF_GW = OFF_PROJ + (size_t)M * PJ * 2;
constexpr size_t OFF_GQD = OFF_GW + (size_t)2048 * 8192 * 2;
constexpr size_t OFF_GKT = OFF_GQD + (size_t)2048 * 8192 * 2;
constexpr size_t OFF_GUT = OFF_GKT + (size_t)2048 * 8192 * 2;
constexpr size_t OFF_GAT = OFF_GUT + (size_t)2048 * 8192 * 2;
constexpr size_t OFF_GSD = OFF_GAT + (size_t)2048 * 4096 * 2;
constexpr size_t OFF_BAR = OFF_GSD + (size_t)2048 * 4;
constexpr size_t WS_TOTAL = OFF_BAR + (size_t)XCD_BAR_WORDS_C * 4;
static_assert((size_t)M * 3072 * 2 <= WS_TOTAL - OFF_PROJ, "QKV alias");
static_assert(WS_TOTAL <= (size_t)512 * 1024 * 1024, "workspace too large");

struct Params {
  const float *x, *c, *ada_w, *ada_b, *norm_mix_w, *norm_ffn_w, *ffn_w_in, *ffn_w_out;
  const float *hy_w_in, *hy_conv_w, *hy_a_log, *hy_dt_bias, *hy_head_norm_w;
  const float *s5_lam_re, *s5_lam_im, *s5_log_dt, *s5_b_re, *s5_b_im, *s5_c_re, *s5_c_im, *s5_d, *s5_glu_w, *s5_glu_b, *hy_w_out;
  const float *sb_w_in, *sb_w_out, *final_norm_w;
  float* out;
  char* ws;
  int phase_lo, phase_hi;
};

constexpr int SMEM_BYTES = 73728;

__device__ __forceinline__ int otid() { int t = __builtin_amdgcn_workitem_id_x(); asm volatile("" : "+v"(t)); return t; }
__device__ __forceinline__ u16 f2bf(float x) { unsigned u = __float_as_uint(x); u += 0x7fffu + ((u >> 16) & 1u); return (u16)(u >> 16); }
typedef __bf16 bf16v2 __attribute__((ext_vector_type(2)));
typedef float f32v2 __attribute__((ext_vector_type(2)));
__device__ __forceinline__ unsigned pk2(float a, float b) { f32v2 v = {a, b}; bf16v2 r = __builtin_convertvector(v, bf16v2); return __builtin_bit_cast(unsigned, r); }
__device__ __forceinline__ float bf2f(u16 v) { return __uint_as_float(((unsigned)v) << 16); }
__device__ __forceinline__ float sigmoid_(float x) { return __builtin_amdgcn_rcpf(1.f + __expf(-x)); }
__device__ __forceinline__ float silu_(float x) { return x * sigmoid_(x); }
__device__ __forceinline__ float softplus_(float x) { return fmaxf(x, 0.f) + log1pf(__expf(-fabsf(x))); }
__device__ __forceinline__ float gelu_tanh_(float y) { return 0.5f * y * (1.f + tanhf(0.7978845608028654f * (y + 0.044715f * y * y * y))); }

__device__ __forceinline__ size_t pj_idx(int row, int col) { return (size_t)(col >> 9) * ((size_t)M * 512) + (size_t)row * 512 + (col & 511); }
__device__ __forceinline__ size_t a_off(int row, int col, int nks) { return ((size_t)((row >> 8) * nks + (col >> 5)) << 13) + ((row & 255) << 5) + (col & 31); }
__device__ __forceinline__ size_t b_off(int n, int k, int nks) { return ((size_t)((n >> 7) * nks + (k >> 5)) << 12) + ((n & 127) << 5) + (k & 31); }

struct TrJob { const float* src; u16* dst; int K, Nsrc, Nd, mode; };
__device__ __forceinline__ TrJob get_job(const Params& p, int j) {
  TrJob t;
  switch (j) {
    case 0: t = {p.hy_w_in, (u16*)(p.ws + OFF_WT_HYIN), 1024, EIN, PN, 1}; break;
    case 1: t = {p.hy_w_out, (u16*)(p.ws + OFF_WT_HYOUT), 1024, 1024, 1024, 0}; break;
    case 2: t = {p.s5_glu_w, (u16*)(p.ws + OFF_WT_GLU), 512, 512, 512, 0}; break;
    case 3: t = {p.ffn_w_in, (u16*)(p.ws + OFF_WT_FFNIN), 1024, 2 * FF, 2 * FF, 2}; break;
    case 4: t = {p.ffn_w_in + (size_t)1024 * 2 * FF, (u16*)(p.ws + OFF_WT_FFNIN + SZ_WT_FFNIN), 1024, 2 * FF, 2 * FF, 2}; break;
    case 5: t = {p.ffn_w_out, (u16*)(p.ws + OFF_WT_FFNOUT), FF, 1024, 1024, 0}; break;
    case 6: t = {p.ffn_w_out + (size_t)FF * 1024, (u16*)(p.ws + OFF_WT_FFNOUT + SZ_WT_FFNOUT), FF, 1024, 1024, 0}; break;
    case 7: t = {p.sb_w_in, (u16*)(p.ws + OFF_WT_SBIN), 1024, 3072, 3072, 0}; break;
    default: t = {p.sb_w_out, (u16*)(p.ws + OFF_WT_SBOUT), 1024, 1024, 1024, 0}; break;
  }
  return t;
}
__device__ __forceinline__ int src_col(int R, int mode) {
  if (mode == 0) return R;
  if (mode == 1) return R < 2048 ? R : R + 8;
  return ((R >> 4) & 1) * FF + (R >> 5) * 16 + (R & 15);
}
constexpr int N_TR_ITEMS = (640 + 256 + 64 + 2 * 1408 + 2 * 704 + 768 + 256) / 4;
constexpr int N_MOD_ITEMS = 2 * 6144 / 16;

__device__ __forceinline__ void s5_table_item(const Params& p, int item, char* smem) {
  const int tid = otid(), g = item >> 5, tau = item & 31;
  float* pwr = (float*)smem; float* pwi = pwr + 64; float* p1r = pwi + 64; float* p1i = p1r + 64;
  float* bbr = p1i + 64; float* bbi = bbr + 1024; float* cre = bbi + 1024; float* cim = cre + 1024;
  const float dt = expf(p.s5_log_dt[g]);
  if (tid < 64) {
    const float lr = p.s5_lam_re[g * 64 + tid], li = p.s5_lam_im[g * 64 + tid];
    float sn, cs;
    float mg = expf(lr * dt * (float)tau); sincosf(li * dt * (float)tau, &sn, &cs); pwr[tid] = mg * cs; pwi[tid] = mg * sn;
    mg = expf(lr * dt * (float)(tau + 1)); sincosf(li * dt * (float)(tau + 1), &sn, &cs); p1r[tid] = mg * cs; p1i[tid] = mg * sn;
    if (tau == 31) { float* a32 = (float*)(p.ws + OFF_A32); a32[(g * 64 + tid) * 2] = mg * cs; a32[(g * 64 + tid) * 2 + 1] = mg * sn; }
  }
  {
    const int pp = tid >> 2, hq = (tid & 3) * 4;
    const float lr = p.s5_lam_re[g * 64 + pp], li = p.s5_lam_im[g * 64 + pp];
    const float mg = expf(lr * dt); float sn, cs; sincosf(li * dt, &sn, &cs);
    const float ar = mg * cs, ai = mg * sn, den = lr * lr + li * li, nr = ar - 1.f, ni = ai;
    const float fre = (nr * lr + ni * li) / den, fim = (ni * lr - nr * li) / den;
#pragma unroll
    for (int e = 0; e < 4; ++e) {
      const float br = p.s5_b_re[(size_t)(g * 64 + pp) * 16 + hq + e], bi = p.s5_b_im[(size_t)(g * 64 + pp) * 16 + hq + e];
      bbr[pp * 16 + hq + e] = fre * br - fim * bi; bbi[pp * 16 + hq + e] = fre * bi + fim * br;
    }
    for (int i = tid; i < 1024; i += 256) { cre[i] = p.s5_c_re[(size_t)g * 1024 + i]; cim[i] = p.s5_c_im[(size_t)g * 1024 + i]; }
  }
  __syncthreads();
  u16* mf = (u16*)(p.ws + OFF_MF) + (size_t)g * 512 * UXW;
  u16* eg = (u16*)(p.ws + OFF_EG) + (size_t)g * 128 * 512;
  {
    const int h = tid >> 4, hp = tid & 15;
    float kv = 0.f;
    for (int pp = 0; pp < 64; ++pp) {
      const float cr = cre[h * 64 + pp], ci = cim[h * 64 + pp], pr = pwr[pp], pi = pwi[pp];
      kv += (cr * pr - ci * pi) * bbr[pp * 16 + hp] - (cr * pi + ci * pr) * bbi[pp * 16 + hp];
    }
    const u16 kb = f2bf(kv);
    for (int s0 = 0; s0 + tau < 32; ++s0) mf[b_off((s0 + tau) * 16 + h, s0 * 16 + hp, 20)] = kb;
    for (int t0 = 0; t0 + tau + 1 < 32; ++t0) mf[b_off(t0 * 16 + h, (t0 + tau + 1) * 16 + hp, 20)] = 0;
#pragma unroll
    for (int e = 0; e < 4; ++e) {
      const int pp = hp * 4 + e;
      const float cr = cre[h * 64 + pp], ci = cim[h * 64 + pp], pr = p1r[pp], pi = p1i[pp];
      mf[b_off(tau * 16 + h, 512 + pp, 20)] = f2bf(cr * pr - ci * pi);
      mf[b_off(tau * 16 + h, 576 + pp, 20)] = f2bf(-(cr * pi + ci * pr));
    }
  }
  {
    const int pp = tid >> 2, hq = (tid & 3) * 4, s0 = 31 - tau;
#pragma unroll
    for (int e = 0; e < 4; ++e) {
      const float br = bbr[pp * 16 + hq + e], bi = bbi[pp * 16 + hq + e], pr = pwr[pp], pi = pwi[pp];
      eg[b_off(pp, s0 * 16 + hq + e, 16)] = f2bf(pr * br - pi * bi);
      eg[b_off(64 + pp, s0 * 16 + hq + e, 16)] = f2bf(pr * bi + pi * br);
    }
  }
  __syncthreads();
}

__device__ __forceinline__ void phase0(const Params& p, char* smem, int bid, int nblk) {
  const int tid = otid();
  for (int it = bid; it < N_TR_ITEMS + N_MOD_ITEMS + 1024; it += nblk) {
    if (it >= N_TR_ITEMS + N_MOD_ITEMS) { s5_table_item(p, it - N_TR_ITEMS - N_MOD_ITEMS, smem); continue; }
    if (it < N_TR_ITEMS) {
      int rem = it * 4, j = 0; TrJob jb;
      for (;; ++j) { jb = get_job(p, j); int n = (jb.Nd >> 6) * (jb.K >> 6); if (rem < n) break; rem -= n; }
      const int nk = jb.K >> 6;
      u16* s = (u16*)smem;
      {
        const int r = tid & 63, kk = tid >> 6;
#pragma unroll
        for (int q = 0; q < 4; ++q) {
          const int R0 = ((rem + q) / nk) * 64, k0 = ((rem + q) % nk) * 64;
          const float* sp = jb.src + (size_t)k0 * jb.Nsrc + src_col(R0 + r, jb.mode);
#pragma unroll
          for (int i = 0; i < 16; ++i) { int k = kk + 4 * i; s[q * 4608 + r * 72 + k] = f2bf(sp[(size_t)k * jb.Nsrc]); }
        }
      }
      __syncthreads();
      {
        const int r = tid >> 2, ch = tid & 3;
#pragma unroll
        for (int q = 0; q < 4; ++q) {
          const int R0 = ((rem + q) / nk) * 64, k0 = ((rem + q) % nk) * 64;
#pragma unroll
          for (int i = 0; i < 2; ++i) {
            int c8 = (ch + 4 * i) * 8;
            *(u32x4*)(jb.dst + b_off(R0 + r, k0 + c8, jb.K >> 5)) = *(const u32x4*)(s + q * 4608 + r * 72 + c8);
          }
        }
      }
      __syncthreads();
    } else {
      const int mi = it - N_TR_ITEMS, l = mi / 384, n0 = (mi % 384) * 16;
      float* cact = (float*)smem;
      float* red = cact + 4096;
      for (int i = tid; i < 4096; i += 256) cact[i] = silu_(p.c[i]);
      __syncthreads();
      const int cl = tid & 15, ksub = tid >> 4;
      float a0 = 0, a1 = 0, a2 = 0, a3 = 0;
      const float* wp = p.ada_w + (size_t)l * 1024 * 6144 + n0 + cl;
#pragma unroll 16
      for (int k = ksub * 64; k < ksub * 64 + 64; ++k) {
        float w = wp[(size_t)k * 6144];
        a0 += cact[k] * w; a1 += cact[1024 + k] * w; a2 += cact[2048 + k] * w; a3 += cact[3072 + k] * w;
      }
      red[(ksub * 4 + 0) * 16 + cl] = a0; red[(ksub * 4 + 1) * 16 + cl] = a1;
      red[(ksub * 4 + 2) * 16 + cl] = a2; red[(ksub * 4 + 3) * 16 + cl] = a3;
      __syncthreads();
      if (tid < 64) {
        const int b = tid >> 4;
        float sum = 0.f;
#pragma unroll
        for (int q = 0; q < 16; ++q) sum += red[(q * 4 + b) * 16 + cl];
        float* mod = (float*)(p.ws + OFF_MOD);
        mod[(size_t)(l * 4 + b) * 6144 + n0 + cl] = sum + p.ada_b[l * 6144 + n0 + cl];
      }
      __syncthreads();
    }
  }
}

template <int MODE>
__device__ __forceinline__ void norm_phase(const Params& p, const float* src, const float* w, const float* modl, int sh_off, int sc_off,
                           char* smem, int bid, int nblk) {
  const int tid = otid(), wid = tid >> 6, lane = tid & 63;
  float* wba = (float*)smem;
  if (MODE == 1) {
    for (int i = tid; i < 1024 * 8; i += 256) wba[i] = p.hy_w_in[(size_t)(i >> 3) * EIN + 2048 + (i & 7)];
    __syncthreads();
  }
  u16* hn = (u16*)(p.ws + OFF_HN);
  auto process = [&](int row, f32x4 (&v)[4]) {
    float ss = 0.f;
#pragma unroll
    for (int i = 0; i < 4; ++i) ss += v[i][0] * v[i][0] + v[i][1] * v[i][1] + v[i][2] * v[i][2] + v[i][3] * v[i][3];
#pragma unroll
    for (int o = 32; o >= 1; o >>= 1) ss += __shfl_xor(ss, o);
    const float rstd = rsqrtf(ss * (1.f / 1024.f) + 1e-6f);
    const int b = row >> 13;
    float dots[8];
    if (MODE == 1) { for (int j = 0; j < 8; ++j) dots[j] = 0.f; }
#pragma unroll
    for (int i = 0; i < 4; ++i) {
      const int c0 = i * 256 + lane * 4;
      f32x4 ww = *(const f32x4*)(w + c0);
      f32x4 y;
      if (MODE == 2) {
#pragma unroll
        for (int e = 0; e < 4; ++e) y[e] = v[i][e] * rstd * ww[e];
        *(f32x4*)(p.out + (size_t)row * 1024 + c0) = y;
      } else {
        f32x4 sc = *(const f32x4*)(modl + (size_t)b * 6144 + sc_off + c0);
        f32x4 sh = *(const f32x4*)(modl + (size_t)b * 6144 + sh_off + c0);
#pragma unroll
        for (int e = 0; e < 4; ++e) y[e] = v[i][e] * rstd * ww[e] * (1.f + sc[e]) + sh[e];
        uint2 pk; pk.x = (unsigned)f2bf(y[0]) | ((unsigned)f2bf(y[1]) << 16); pk.y = (unsigned)f2bf(y[2]) | ((unsigned)f2bf(y[3]) << 16);
        *(uint2*)(hn + a_off(row, c0, 32)) = pk;
        if (MODE == 1) {
#pragma unroll
          for (int e = 0; e < 4; ++e) {
            f32x4 w0 = *(const f32x4*)(wba + (c0 + e) * 8), w1 = *(const f32x4*)(wba + (c0 + e) * 8 + 4);
#pragma unroll
            for (int j = 0; j < 4; ++j) { dots[j] += y[e] * w0[j]; dots[4 + j] += y[e] * w1[j]; }
          }
        }
      }
    }
    if (MODE == 1) {
#pragma unroll
      for (int j = 0; j < 8; ++j) {
#pragma unroll
        for (int o = 32; o >= 1; o >>= 1) dots[j] += __shfl_xor(dots[j], o);
      }
      if (lane == 0) {
        float* beta = (float*)(p.ws + OFF_BETA); float* gg = (float*)(p.ws + OFF_G);
#pragma unroll
        for (int h = 0; h < 4; ++h) {
          beta[(size_t)row * 4 + h] = sigmoid_(dots[h]);
          gg[(size_t)row * 4 + h] = -__expf(p.hy_a_log[h]) * softplus_(dots[4 + h] + p.hy_dt_bias[h]);
        }
      }
    }
  };
#pragma unroll 1
  for (int row = bid * 4 + wid; row < M; row += nblk * 8) {
    const int row1 = row + nblk * 4;
    const bool has1 = row1 < M;
    f32x4 v0[4], v1[4];
#pragma unroll
    for (int i = 0; i < 4; ++i) v0[i] = *(const f32x4*)(src + (size_t)row * 1024 + i * 256 + lane * 4);
#pragma unroll
    for (int i = 0; i < 4; ++i) v1[i] = has1 ? *(const f32x4*)(src + (size_t)row1 * 1024 + i * 256 + lane * 4) : f32x4{0.f, 0.f, 0.f, 0.f};
    process(row, v0);
    if (has1) process(row1, v1);
  }
}

enum { E_PROJ0 = 0, E_BF16 = 1, E_RESID = 2, E_GLU = 3, E_SWIGLU = 4, E_XE = 5, E_S5Y = 6 };
struct EpiArgs { float* outf; u16* outb; const float* res; const float* gate; const u16* y5; const float* bias; u16* ux; int ldc; };

template <int EPI>
__device__ __forceinline__ void gemm_phase(const u16* __restrict__ A0, int nksA, size_t sA, const u16* __restrict__ B0, int nksB, size_t sB,
                                           int K, int nM, int nN, int nbatch, const EpiArgs ea, char* smem, int bid, int nblk) {
  const int tid = otid(), wid = tid >> 6, lane = tid & 63, wr = wid >> 1, wc = wid & 1, fr = lane & 15, fq = lane >> 4;
  char* SA = smem; char* SB = smem + 49152;
  const int sa0 = (int)(uintptr_t)SA + (wr * 128 + fr) * 64 + fq * 16, sb0 = (int)(uintptr_t)SB + (wc * 64 + fr) * 64 + fq * 16;
  const int NR = nbatch * nM, ntiles = NR * nN;
  const int STN = (nN & 7) == 0 ? 8 : ((nN & 3) == 0 ? 4 : 1), STM = 64 / STN, nSN = nN / STN;
  const bool swz = ((nblk & 7) == 0) && (NR % STM == 0);
  const int lpx = nblk >> 3;
  int si = bid & 7, l = bid >> 3, tl = bid;
#pragma unroll 1
  for (;;) {
    int R, pn;
    if (swz) {
      if (si >= (NR / STM) * nSN) break;
      R = (si / nSN) * STM + l / STN; pn = (si % nSN) * STN + l % STN;
      l += lpx; if (l >= 64) { l = bid >> 3; si += 8; }
    } else {
      if (tl >= ntiles) break;
      R = tl / nN; pn = tl % nN; tl += nblk;
    }
    const int g = R / nM, rt = R % nM, brow = rt << 8, bcol = pn << 7;
    const char* A = (const char*)(A0 + (size_t)g * sA) + ((size_t)rt * nksA << 14) + tid * 16;
    const char* Bt = (const char*)(B0 + (size_t)g * sB) + ((size_t)pn * nksB << 13) + tid * 16;
    int nk = K >> 5, klim = nk;
    if (EPI == E_S5Y) { klim = 4 * (pn + 1); nk = klim + 4; }
    f32x4 acc[8][4];
#pragma unroll
    for (int m = 0; m < 8; ++m)
#pragma unroll
      for (int n = 0; n < 4; ++n) acc[m][n] = f32x4{0.f, 0.f, 0.f, 0.f};
#define GSTAGE(KK, BUF) do { const int kt_ = (EPI == E_S5Y && (KK) >= klim) ? (16 + (KK) - klim) : (KK); \
      _Pragma("unroll") for (int i = 0; i < 4; ++i) \
        __builtin_amdgcn_global_load_lds((const unsigned*)(A + ((size_t)kt_ << 14) + i * 4096), (__attribute__((address_space(3))) unsigned*)(SA + (BUF) * 16384 + tid * 16 + i * 4096), 16, 0, 0); \
      _Pragma("unroll") for (int i = 0; i < 2; ++i) \
        __builtin_amdgcn_global_load_lds((const unsigned*)(Bt + ((size_t)kt_ << 13) + i * 4096), (__attribute__((address_space(3))) unsigned*)(SB + (BUF) * 8192 + tid * 16 + i * 4096), 16, 0, 0); } while (0)
    asm volatile("s_waitcnt vmcnt(0)" ::: "memory");
    GSTAGE(0, 0);
    if (nk > 1) { GSTAGE(1, 1); asm volatile("s_waitcnt vmcnt(6)\n\ts_barrier" ::: "memory"); }
    else { asm volatile("s_waitcnt vmcnt(0)\n\ts_barrier" ::: "memory"); }
    int buf = 0, nbuf = 2;
#pragma unroll 1
    for (int kk = 0; kk < nk; ++kk) {
      const bool more = kk + 2 < nk;
      if (more) GSTAGE(kk + 2, nbuf);
      bf16x8 Bl[4], At[8];
      {
        const int bb = sb0 + buf * 8192, ab = sa0 + buf * 16384;
        asm volatile(
            "ds_read_b128 %0, %12\n\tds_read_b128 %1, %12 offset:1024\n\tds_read_b128 %2, %12 offset:2048\n\tds_read_b128 %3, %12 offset:3072\n\t"
            "ds_read_b128 %4, %13\n\tds_read_b128 %5, %13 offset:1024\n\tds_read_b128 %6, %13 offset:2048\n\tds_read_b128 %7, %13 offset:3072\n\t"
            "ds_read_b128 %8, %13 offset:4096\n\tds_read_b128 %9, %13 offset:5120\n\tds_read_b128 %10, %13 offset:6144\n\tds_read_b128 %11, %13 offset:7168\n\t"
            "s_waitcnt lgkmcnt(4)"
            : "=&v"(Bl[0]), "=&v"(Bl[1]), "=&v"(Bl[2]), "=&v"(Bl[3]), "=&v"(At[0]), "=&v"(At[1]), "=&v"(At[2]), "=&v"(At[3]),
              "=&v"(At[4]), "=&v"(At[5]), "=&v"(At[6]), "=&v"(At[7])
            : "v"(bb), "v"(ab)
            : "memory");
      }
      __builtin_amdgcn_s_setprio(1);
#pragma unroll
      for (int m = 0; m < 4; ++m)
#pragma unroll
        for (int n = 0; n < 4; ++n) acc[m][n] = __builtin_amdgcn_mfma_f32_16x16x32_bf16(Bl[n], At[m], acc[m][n], 0, 0, 0);
      __builtin_amdgcn_sched_barrier(0);
      asm volatile("s_waitcnt lgkmcnt(0)" : "+v"(At[4]), "+v"(At[5]), "+v"(At[6]), "+v"(At[7]) :: "memory");
      __builtin_amdgcn_sched_barrier(0);
#pragma unroll
      for (int m = 4; m < 8; ++m)
#pragma unroll
        for (int n = 0; n < 4; ++n) acc[m][n] = __builtin_amdgcn_mfma_f32_16x16x32_bf16(Bl[n], At[m], acc[m][n], 0, 0, 0);
      __builtin_amdgcn_s_setprio(0);
      if (more) asm volatile("s_waitcnt vmcnt(6)\n\ts_barrier" ::: "memory");
      else asm volatile("s_waitcnt vmcnt(0)\n\ts_barrier" ::: "memory");
      buf = (buf == 2) ? 0 : buf + 1; nbuf = (nbuf == 2) ? 0 : nbuf + 1;
    }
#undef GSTAGE
#pragma unroll
    for (int m = 0; m < 8; ++m)
#pragma unroll
      for (int n = 0; n < 4; ++n) {
        const int row = brow + wr * 128 + m * 16 + fr, col = bcol + wc * 64 + n * 16 + fq * 4;
        const f32x4 v = acc[m][n];
        if (EPI == E_PROJ0) {
          const uint2 pk = uint2{pk2(v[0], v[1]), pk2(v[2], v[3])};
          if (bcol < 2048) *(uint2*)(ea.outb + pj_idx(row, col)) = pk;
          else { const int cc = col - 2048; *(uint2*)(ea.ux + (size_t)(cc >> 4) * S5C * UXW + a_off(row >> 5, (row & 31) * 16 + (cc & 15), 20)) = pk; }
        }
        if (EPI == E_BF16) *(uint2*)(ea.outb + (size_t)row * ea.ldc + col) = uint2{pk2(v[0], v[1]), pk2(v[2], v[3])};
        if (EPI == E_RESID) {
          const size_t idx = (size_t)row * 1024 + col;
          const f32x4 r4 = *(const f32x4*)(ea.res + idx), g4 = *(const f32x4*)(ea.gate + (size_t)(row >> 13) * 6144 + col);
          *(f32x4*)(ea.outf + idx) = f32x4{r4[0] + g4[0] * v[0], r4[1] + g4[1] * v[1], r4[2] + g4[2] * v[2], r4[3] + g4[3] * v[3]};
        }
        if (EPI == E_GLU) {
          const uint2 yy = *(const uint2*)(ea.y5 + a_off(row, col, 16));
          const f32x4 b4 = *(const f32x4*)(ea.bias + col);
          const float y0 = __uint_as_float(yy.x << 16), y1 = __uint_as_float(yy.x & 0xffff0000u), y2 = __uint_as_float(yy.y << 16), y3 = __uint_as_float(yy.y & 0xffff0000u);
          *(uint2*)(ea.outb + a_off(row, 512 + col, 32)) = uint2{pk2(y0 * sigmoid_(v[0] + b4[0]), y1 * sigmoid_(v[1] + b4[1])), pk2(y2 * sigmoid_(v[2] + b4[2]), y3 * sigmoid_(v[3] + b4[3]))};
        }
        if (EPI == E_SWIGLU) {
          if ((n & 1) == 0) {
            const f32x4 u = acc[m][n | 1];
            const int co = (bcol >> 1) + wc * 32 + (n >> 1) * 16 + fq * 4;
            *(uint2*)(ea.outb + a_off(row, co, FF / 32)) = uint2{pk2(silu_(v[0]) * u[0], silu_(v[1]) * u[1]), pk2(silu_(v[2]) * u[2], silu_(v[3]) * u[3])};
          }
        }
        if (EPI == E_XE) *(f32x4*)(ea.outf + ((size_t)g * S5C + row) * 128 + col) = v;
        if (EPI == E_S5Y) {
          const uint2 uu = *(const uint2*)(ea.ux + (size_t)g * S5C * UXW + a_off(row, col, 20));
          const f32x4 d4 = *(const f32x4*)(ea.bias + g * 16 + (col & 15));
          const float u0 = __uint_as_float(uu.x << 16), u1 = __uint_as_float(uu.x & 0xffff0000u), u2 = __uint_as_float(uu.y << 16), u3 = __uint_as_float(uu.y & 0xffff0000u);
          *(uint2*)(ea.outb + a_off(row * 32 + (col >> 4), g * 16 + (col & 15), 16)) =
              uint2{pk2(gelu_tanh_(v[0] + d4[0] * u0), gelu_tanh_(v[1] + d4[1] * u1)), pk2(gelu_tanh_(v[2] + d4[2] * u2), gelu_tanh_(v[3] + d4[3] * u3))};
        }
      }
  }
}

__device__ __forceinline__ void s5_carry_phase(const Params& p, int bid, int nblk) {
  const float* xe = (const float*)(p.ws + OFF_XE); const float* a32 = (const float*)(p.ws + OFF_A32);
  u16* ux = (u16*)(p.ws + OFF_UX);
  for (int it = bid; it < 32; it += nblk) {
    const int idx = it * 256 + otid(), pp = idx & 63, g = (idx >> 6) & 31, b = idx >> 11;
    const float ar = a32[(g * 64 + pp) * 2], ai = a32[(g * 64 + pp) * 2 + 1];
    float xr = 0.f, xi = 0.f;
    const size_t cbase = (size_t)g * S5C + b * 256, gbase = (size_t)g * S5C * UXW;
    for (int n = 0; n < 256; n += 8) {
      float er[8], ei[8];
#pragma unroll
      for (int e = 0; e < 8; ++e) { er[e] = xe[(cbase + n + e) * 128 + pp]; ei[e] = xe[(cbase + n + e) * 128 + 64 + pp]; }
#pragma unroll
      for (int e = 0; e < 8; ++e) {
        ux[gbase + a_off(b * 256 + n + e, 512 + pp, 20)] = f2bf(xr); ux[gbase + a_off(b * 256 + n + e, 576 + pp, 20)] = f2bf(xi);
        const float nr = ar * xr - ai * xi + er[e], ni = ar * xi + ai * xr + ei[e];
        xr = nr; xi = ni;
      }
    }
  }
}

__device__ __forceinline__ int crow(int r, int hi) { return (r & 3) + 8 * (r >> 2) + 4 * hi; }
using f32x16 = __attribute__((ext_vector_type(16))) float;
__device__ __forceinline__ void unpack8(const u32x4 w, float* f) {
#pragma unroll
  for (int e = 0; e < 4; ++e) { f[2 * e] = __uint_as_float(w[e] << 16); f[2 * e + 1] = __uint_as_float(w[e] & 0xffff0000u); }
}
__device__ __forceinline__ void gdn_prep_phase(const Params& p, char* smem, int bid, int nblk) {
  const int tid = otid(), wid = tid >> 6, lane = tid & 63, fr = lane & 15, fq = lane >> 4;
  u16* qs = (u16*)smem;
  u16* ks = qs + 64 * 136;
  float* Lm = (float*)(ks + 64 * 136);
  float* gcs = Lm + 4096; float* bts = gcs + 64; float* egs = bts + 64;
  const u16* proj = (const u16*)(p.ws + OFF_PROJ);
  const float* beta = (const float*)(p.ws + OFF_BETA); const float* gg = (const float*)(p.ws + OFF_G);
#pragma unroll 1
  for (int it = bid; it < 2048; it += nblk) {
    const int n = it & 127, bh = it >> 7, b = bh >> 2, h = bh & 3;
    const size_t row0 = (size_t)b * SEQ + n * 64;
    if (wid == 0) {
      float c = gg[(row0 + lane) * 4 + h];
#pragma unroll
      for (int o = 1; o < 64; o <<= 1) { const float tt = __shfl_up(c, o); if (lane >= o) c += tt; }
      gcs[lane] = c; egs[lane] = __expf(c); bts[lane] = beta[(row0 + lane) * 4 + h];
    }
    {
      const int tok = tid >> 2, part = tid & 3, l = n * 64 + tok;
      float qo[32], ko[32]; float sq = 0.f, sk = 0.f;
#pragma unroll
      for (int cb = 0; cb < 4; ++cb) {
        const int colq = h * 128 + part * 32 + cb * 8, colk = 512 + colq;
        const size_t kblk = (size_t)M * 512 - 512;
        float aq[8], ak[8];
#pragma unroll
        for (int e = 0; e < 8; ++e) { aq[e] = 0.f; ak[e] = 0.f; }
#pragma unroll
        for (int j = 0; j < 4; ++j) {
          const int lt = l - 3 + j;
          if (lt >= 0) {
            const u16* rp = proj + ((size_t)b * SEQ + lt) * 512;
            float xq[8], xk[8];
            unpack8(*(const u32x4*)(rp + colq), xq); unpack8(*(const u32x4*)(rp + kblk + colk), xk);
            const f32x4 wq0 = *(const f32x4*)(p.hy_conv_w + j * 1536 + colq), wq1 = *(const f32x4*)(p.hy_conv_w + j * 1536 + colq + 4);
            const f32x4 wk0 = *(const f32x4*)(p.hy_conv_w + j * 1536 + colk), wk1 = *(const f32x4*)(p.hy_conv_w + j * 1536 + colk + 4);
#pragma unroll
            for (int e = 0; e < 4; ++e) { aq[e] += wq0[e] * xq[e]; aq[4 + e] += wq1[e] * xq[4 + e]; ak[e] += wk0[e] * xk[e]; ak[4 + e] += wk1[e] * xk[4 + e]; }
          }
        }
#pragma unroll
        for (int e = 0; e < 8; ++e) { const float a = silu_(aq[e]), k = silu_(ak[e]); qo[cb * 8 + e] = a; ko[cb * 8 + e] = k; sq += a * a; sk += k * k; }
      }
      sq += __shfl_xor(sq, 1); sq += __shfl_xor(sq, 2); sk += __shfl_xor(sk, 1); sk += __shfl_xor(sk, 2);
      const float rq = rsqrtf(sq + 1e-6f) * 0.08838834764831845f, rk = rsqrtf(sk + 1e-6f);
#pragma unroll
      for (int cb = 0; cb < 4; ++cb) {
        u32x4 wq, wk;
#pragma unroll
        for (int e = 0; e < 4; ++e) { wq[e] = pk2(qo[cb * 8 + 2 * e] * rq, qo[cb * 8 + 2 * e + 1] * rq); wk[e] = pk2(ko[cb * 8 + 2 * e] * rk, ko[cb * 8 + 2 * e + 1] * rk); }
        *(u32x4*)(qs + tok * 136 + part * 32 + cb * 8) = wq; *(u32x4*)(ks + tok * 136 + part * 32 + cb * 8) = wk;
      }
    }
    __syncthreads();
    {
      f32x4 akk[4], aqk[4];
#pragma unroll
      for (int nb = 0; nb < 4; ++nb) { akk[nb] = f32x4{0.f, 0.f, 0.f, 0.f}; aqk[nb] = f32x4{0.f, 0.f, 0.f, 0.f}; }
#pragma unroll
      for (int kk = 0; kk < 4; ++kk) {
        const bf16x8 ak = *(const bf16x8*)(ks + (16 * wid + fr) * 136 + kk * 32 + fq * 8);
        const bf16x8 aq = *(const bf16x8*)(qs + (16 * wid + fr) * 136 + kk * 32 + fq * 8);
#pragma unroll
        for (int nb = 0; nb < 4; ++nb) {
          const bf16x8 bk = *(const bf16x8*)(ks + (16 * nb + fr) * 136 + kk * 32 + fq * 8);
          akk[nb] = __builtin_amdgcn_mfma_f32_16x16x32_bf16(ak, bk, akk[nb], 0, 0, 0);
          aqk[nb] = __builtin_amdgcn_mfma_f32_16x16x32_bf16(aq, bk, aqk[nb], 0, 0, 0);
        }
      }
      u16* att = (u16*)(p.ws + OFF_GAT) + (size_t)it * 4096;
#pragma unroll
      for (int nb = 0; nb < 4; ++nb)
#pragma unroll
        for (int r = 0; r < 4; ++r) {
          const int i = 16 * wid + fq * 4 + r, j = 16 * nb + fr;
          const float dec = __expf(fminf(gcs[i] - gcs[j], 0.f));
          Lm[i * 64 + j] = (i > j) ? bts[i] * akk[nb][r] * dec : 0.f;
          att[i * 64 + j] = f2bf((i >= j) ? aqk[nb][r] * dec : 0.f);
        }
    }
    __syncthreads();
    {
      float x[64];
      if (tid < 128) {
        const int col = 1024 + h * 128 + tid;
        const u16* vp = proj + (size_t)2 * M * 512 + h * 128 + tid;
        const float w0 = p.hy_conv_w[col], w1 = p.hy_conv_w[1536 + col], w2 = p.hy_conv_w[2 * 1536 + col], w3 = p.hy_conv_w[3 * 1536 + col];
        float x1 = 0.f, x2 = 0.f, x3 = 0.f;
        if (n > 0) { x3 = bf2f(vp[(row0 - 3) * 512]); x2 = bf2f(vp[(row0 - 2) * 512]); x1 = bf2f(vp[(row0 - 1) * 512]); }
#pragma unroll
        for (int i = 0; i < 64; ++i) {
          const float xv = bf2f(vp[(row0 + i) * 512]);
          x[i] = silu_(w0 * x3 + w1 * x2 + w2 * x1 + w3 * xv) * bts[i];
          x3 = x2; x2 = x1; x1 = xv;
        }
      } else {
#pragma unroll
        for (int i = 0; i < 64; ++i) x[i] = bf2f(ks[i * 136 + tid - 128]) * bts[i] * egs[i];
      }
#pragma unroll
      for (int i = 1; i < 64; ++i) {
        float acc = x[i];
#pragma unroll
        for (int j4 = 0; j4 < (i + 3) / 4; ++j4) {
          const f32x4 l4 = *(const f32x4*)(Lm + i * 64 + j4 * 4);
#pragma unroll
          for (int e = 0; e < 4; ++e) if (j4 * 4 + e < i) acc -= l4[e] * x[j4 * 4 + e];
        }
        x[i] = acc;
      }
      if (tid < 128) {
        u16* ut = (u16*)(p.ws + OFF_GUT) + (size_t)it * 8192 + tid * 64;
#pragma unroll
        for (int c8 = 0; c8 < 8; ++c8) {
          u32x4 w;
#pragma unroll
          for (int e = 0; e < 4; ++e) w[e] = pk2(x[c8 * 8 + 2 * e], x[c8 * 8 + 2 * e + 1]);
          *(u32x4*)(ut + c8 * 8) = w;
        }
      } else {
        u16* wg = (u16*)(p.ws + OFF_GW) + (size_t)it * 8192 + (tid - 128);
#pragma unroll
        for (int i = 0; i < 64; ++i) wg[i * 128] = f2bf(x[i]);
      }
    }
    {
      u16* qd = (u16*)(p.ws + OFF_GQD) + (size_t)it * 8192;
#pragma unroll
      for (int k = 0; k < 4; ++k) {
        const int piece = tid + 256 * k, i = piece >> 4, d0 = (piece & 15) * 8;
        float f[8]; unpack8(*(const u32x4*)(qs + i * 136 + d0), f);
        const float e = egs[i];
        u32x4 w;
#pragma unroll
        for (int e2 = 0; e2 < 4; ++e2) w[e2] = pk2(f[2 * e2] * e, f[2 * e2 + 1] * e);
        *(u32x4*)(qd + i * 128 + d0) = w;
      }
      u16* kt = (u16*)(p.ws + OFF_GKT) + (size_t)it * 8192;
      const int dk = tid & 127, half = tid >> 7;
      const float gl = gcs[63];
#pragma unroll
      for (int c8 = 0; c8 < 4; ++c8) {
        u32x4 w;
#pragma unroll
        for (int e = 0; e < 4; ++e) {
          const int i0 = half * 32 + c8 * 8 + 2 * e;
          w[e] = pk2(bf2f(ks[i0 * 136 + dk]) * __expf(gl - gcs[i0]), bf2f(ks[(i0 + 1) * 136 + dk]) * __expf(gl - gcs[i0 + 1]));
        }
        *(u32x4*)(kt + dk * 64 + half * 32 + c8 * 8) = w;
      }
      if (tid == 0) ((float*)(p.ws + OFF_GSD))[it] = egs[63];
    }
    __syncthreads();
  }
}

__device__ __forceinline__ uint2 lds64(const char* p) { return *(const uint2*)p; }
__device__ __forceinline__ bf16x8 mk8(uint2 a, uint2 b) { u32x4 w = {a.x, a.y, b.x, b.y}; return __builtin_bit_cast(bf16x8, w); }
__device__ __forceinline__ bf16x8 pack8(const f32x16& x, int s) {
  u32x4 w = {pk2(x[8 * s], x[8 * s + 1]), pk2(x[8 * s + 2], x[8 * s + 3]), pk2(x[8 * s + 4], x[8 * s + 5]), pk2(x[8 * s + 6], x[8 * s + 7])};
  return __builtin_bit_cast(bf16x8, w);
}
__device__ __forceinline__ void gdn_scan_item(const Params& p, int bh, char* smem) {
  const int tid = otid(), wid = tid >> 6, lane = tid & 63, r32 = lane & 31, hi = lane >> 5;
  char* Wl = smem; char* KTl = smem + 16896;
  const char* gw = p.ws + OFF_GW; const char* gkt = p.ws + OFF_GKT;
  const u16* gut = (const u16*)(p.ws + OFF_GUT);
  const float* gsd = (const float*)(p.ws + OFF_GSD);
  u32x4* sbg = (u32x4*)(p.ws + OFF_PROJ); u32x4* vbg = (u32x4*)(p.ws + OFF_PROJ + (size_t)2048 * 32768);
  f32x16 S[4];
#pragma unroll
  for (int T = 0; T < 4; ++T)
#pragma unroll
    for (int r = 0; r < 16; ++r) S[T][r] = 0.f;
  u32x4 sa[8], sb_[8]; uint2 uc[8];
  const int dv = wid * 32 + r32;
#define G_LOAD(ST, IT) do { const size_t o16 = (size_t)(IT) * 16384; \
    _Pragma("unroll") for (int k = 0; k < 4; ++k) { ST[k] = *(const u32x4*)(gw + o16 + (tid + 256 * k) * 16); ST[4 + k] = *(const u32x4*)(gkt + o16 + (tid + 256 * k) * 16); } } while (0)
#define U_LOAD(IT) do { _Pragma("unroll") for (int k = 0; k < 8; ++k) uc[k] = *(const uint2*)(gut + (size_t)(IT) * 8192 + dv * 64 + 32 * (k >> 2) + 8 * (k & 3) + 4 * hi); } while (0)
#define G_WRITE(ST) do { \
    _Pragma("unroll") for (int k = 0; k < 4; ++k) { const int pc = tid + 256 * k; \
      { char* d = Wl + (pc >> 4) * 264 + (pc & 15) * 16; *(uint2*)d = uint2{ST[k][0], ST[k][1]}; *(uint2*)(d + 8) = uint2{ST[k][2], ST[k][3]}; } \
      { char* d = KTl + (pc >> 3) * 136 + (pc & 7) * 16; *(uint2*)d = uint2{ST[4 + k][0], ST[4 + k][1]}; *(uint2*)(d + 8) = uint2{ST[4 + k][2], ST[4 + k][3]}; } } } while (0)
#define SCAN_STEP(N, NXT, FAR) do { const int n = (N); const int item = bh * 128 + n; \
    const float sd_nxt = gsd[item + (n + 1 < 128 ? 1 : 0)]; \
    if (n + 2 < 128) G_LOAD(FAR, item + 2); \
    f32x16 av[2]; \
    _Pragma("unroll") for (int r = 0; r < 16; ++r) { av[0][r] = 0.f; av[1][r] = 0.f; } \
    _Pragma("unroll") for (int T = 0; T < 4; ++T) {     \
      bf16x8 wf[4]; \
      _Pragma("unroll") for (int q = 0; q < 4; ++q) { const int s = q >> 1, it = q & 1; \
        const char* wp = Wl + (32 * it + r32) * 264 + (32 * T + 16 * s + 4 * hi) * 2; wf[q] = mk8(lds64(wp), lds64(wp + 16)); } \
      __builtin_amdgcn_sched_barrier(0); \
      _Pragma("unroll") for (int s = 0; s < 2; ++s) { \
        const bf16x8 sb = pack8(S[T], s); \
        sbg[((size_t)(item * 4 + wid) * 8 + T * 2 + s) * 64 + lane] = __builtin_bit_cast(u32x4, sb); \
        av[0] = __builtin_amdgcn_mfma_f32_32x32x16_bf16(wf[s * 2], sb, av[0], 0, 0, 0); \
        av[1] = __builtin_amdgcn_mfma_f32_32x32x16_bf16(wf[s * 2 + 1], sb, av[1], 0, 0, 0); } } \
    bf16x8 vb[2][2]; \
    _Pragma("unroll") for (int it = 0; it < 2; ++it) { \
      f32x16 vn; \
      _Pragma("unroll") for (int g = 0; g < 4; ++g) { const uint2 u2 = uc[it * 4 + g]; \
        vn[4 * g] = __uint_as_float(u2.x << 16) - av[it][4 * g]; vn[4 * g + 1] = __uint_as_float(u2.x & 0xffff0000u) - av[it][4 * g + 1]; \
        vn[4 * g + 2] = __uint_as_float(u2.y << 16) - av[it][4 * g + 2]; vn[4 * g + 3] = __uint_as_float(u2.y & 0xffff0000u) - av[it][4 * g + 3]; } \
      vb[it][0] = pack8(vn, 0); vb[it][1] = pack8(vn, 1); \
      vbg[((size_t)(item * 4 + wid) * 4 + it * 2) * 64 + lane] = __builtin_bit_cast(u32x4, vb[it][0]); \
      vbg[((size_t)(item * 4 + wid) * 4 + it * 2 + 1) * 64 + lane] = __builtin_bit_cast(u32x4, vb[it][1]); } \
    if (n + 1 < 128) U_LOAD(item + 1); \
    _Pragma("unroll") for (int T = 0; T < 4; ++T) { \
      bf16x8 kf[4]; \
      _Pragma("unroll") for (int q = 0; q < 4; ++q) { const int it = q >> 1, s = q & 1; \
        const char* kp = KTl + (32 * T + r32) * 136 + (32 * it + 16 * s + 4 * hi) * 2; kf[q] = mk8(lds64(kp), lds64(kp + 16)); } \
      __builtin_amdgcn_sched_barrier(0); \
      _Pragma("unroll") for (int r = 0; r < 16; ++r) S[T][r] *= sd_cur; \
      _Pragma("unroll") for (int q3 = 0; q3 < 4; ++q3) \
        S[T] = __builtin_amdgcn_mfma_f32_32x32x16_bf16(kf[q3], vb[q3 >> 1][q3 & 1], S[T], 0, 0, 0); } \
    sd_cur = sd_nxt; \
    __syncthreads(); \
    if (n + 1 < 128) G_WRITE(NXT); \
    __syncthreads(); } while (0)
  float sd_cur = gsd[bh * 128];
  G_LOAD(sa, bh * 128); U_LOAD(bh * 128); G_WRITE(sa);
  G_LOAD(sb_, bh * 128 + 1);
  __syncthreads();
#pragma unroll 1
  for (int n2 = 0; n2 < 128; n2 += 2) {
    SCAN_STEP(n2, sb_, sa);
    SCAN_STEP(n2 + 1, sa, sb_);
  }
#undef SCAN_STEP
#undef G_LOAD
#undef G_WRITE
#undef U_LOAD
}

__device__ __forceinline__ void gdn_out_phase(const Params& p, char* smem, int bid, int nblk) {
  const int tid = otid(), wid = tid >> 6, lane = tid & 63, r32 = lane & 31, hi = lane >> 5;
  char* QDl = smem; char* ATl = smem + 16896; float* Ol = (float*)(smem + 16896 + 8704);
  const char* gqd = p.ws + OFF_GQD; const char* gat = p.ws + OFF_GAT;
  const u32x4* sbg = (const u32x4*)(p.ws + OFF_PROJ); const u32x4* vbg = (const u32x4*)(p.ws + OFF_PROJ + (size_t)2048 * 32768);
  const u16* zb = (const u16*)(p.ws + OFF_PROJ) + (size_t)3 * M * 512;
  u16* concat = (u16*)(p.ws + OFF_HN);
#pragma unroll 1
  for (int item = bid; item < 2048; item += nblk) {
    const int n = item & 127, bh = item >> 7, b = bh >> 2, h = bh & 3;
    {
      u32x4 st[6];
#pragma unroll
      for (int k = 0; k < 4; ++k) st[k] = *(const u32x4*)(gqd + (size_t)item * 16384 + (tid + 256 * k) * 16);
#pragma unroll
      for (int k = 0; k < 2; ++k) st[4 + k] = *(const u32x4*)(gat + (size_t)item * 8192 + (tid + 256 * k) * 16);
#pragma unroll
      for (int k = 0; k < 4; ++k) { const int pc = tid + 256 * k; char* d = QDl + (pc >> 4) * 264 + (pc & 15) * 16;
        *(uint2*)d = uint2{st[k][0], st[k][1]}; *(uint2*)(d + 8) = uint2{st[k][2], st[k][3]}; }
#pragma unroll
      for (int k = 0; k < 2; ++k) { const int pc = tid + 256 * k; char* d = ATl + (pc >> 3) * 136 + (pc & 7) * 16;
        *(uint2*)d = uint2{st[4 + k][0], st[4 + k][1]}; *(uint2*)(d + 8) = uint2{st[4 + k][2], st[4 + k][3]}; }
    }
    bf16x8 sb[8], vb[4];
#pragma unroll
    for (int f = 0; f < 8; ++f) sb[f] = __builtin_bit_cast(bf16x8, sbg[((size_t)(item * 4 + wid) * 8 + f) * 64 + lane]);
#pragma unroll
    for (int f = 0; f < 4; ++f) vb[f] = __builtin_bit_cast(bf16x8, vbg[((size_t)(item * 4 + wid) * 4 + f) * 64 + lane]);
    __syncthreads();
    f32x16 ao[2];
#pragma unroll
    for (int r = 0; r < 16; ++r) { ao[0][r] = 0.f; ao[1][r] = 0.f; }
#pragma unroll
    for (int T = 0; T < 4; ++T)
#pragma unroll
      for (int s = 0; s < 2; ++s) {
        const int cb = (32 * T + 16 * s + 4 * hi) * 2;
#pragma unroll
        for (int it = 0; it < 2; ++it) {
          const char* qp = QDl + (32 * it + r32) * 264 + cb;
          ao[it] = __builtin_amdgcn_mfma_f32_32x32x16_bf16(mk8(lds64(qp), lds64(qp + 16)), sb[T * 2 + s], ao[it], 0, 0, 0);
        }
      }
#pragma unroll
    for (int it2 = 0; it2 < 2; ++it2)
#pragma unroll
      for (int it = 0; it <= it2; ++it)
#pragma unroll
        for (int s = 0; s < 2; ++s) {
          const char* ap = ATl + (32 * it2 + r32) * 136 + (32 * it + 16 * s + 4 * hi) * 2;
          ao[it2] = __builtin_amdgcn_mfma_f32_32x32x16_bf16(mk8(lds64(ap), lds64(ap + 16)), vb[it * 2 + s], ao[it2], 0, 0, 0);
        }
#pragma unroll
    for (int it = 0; it < 2; ++it)
#pragma unroll
      for (int r = 0; r < 16; ++r) Ol[(32 * it + crow(r, hi)) * 132 + wid * 32 + r32] = ao[it][r];
    __syncthreads();
    {
      const int tok = tid >> 2, part = tid & 3;
      const int row = b * SEQ + n * 64 + tok;
      f32x4 a[8]; float ss = 0.f;
#pragma unroll
      for (int k = 0; k < 8; ++k) { a[k] = *(const f32x4*)(Ol + tok * 132 + part * 32 + k * 4); ss += a[k][0] * a[k][0] + a[k][1] * a[k][1] + a[k][2] * a[k][2] + a[k][3] * a[k][3]; }
      ss += __shfl_xor(ss, 1); ss += __shfl_xor(ss, 2);
      const float rs = rsqrtf(ss * (1.f / 128.f) + 1e-6f);
      const u16* zp = zb + (size_t)row * 512 + h * 128 + part * 32;
      const float* hw = p.hy_head_norm_w + part * 32;
      u16* cp = concat + a_off(row, h * 128 + part * 32, 32);
#pragma unroll
      for (int k = 0; k < 4; ++k) {
        float zf[8]; unpack8(*(const u32x4*)(zp + k * 8), zf);
        const f32x4 h0 = *(const f32x4*)(hw + k * 8), h1 = *(const f32x4*)(hw + k * 8 + 4);
        const f32x4 x0 = a[2 * k], x1 = a[2 * k + 1];
        u32x4 w;
        w[0] = pk2(x0[0] * rs * h0[0] * silu_(zf[0]), x0[1] * rs * h0[1] * silu_(zf[1]));
        w[1] = pk2(x0[2] * rs * h0[2] * silu_(zf[2]), x0[3] * rs * h0[3] * silu_(zf[3]));
        w[2] = pk2(x1[0] * rs * h1[0] * silu_(zf[4]), x1[1] * rs * h1[1] * silu_(zf[5]));
        w[3] = pk2(x1[2] * rs * h1[2] * silu_(zf[6]), x1[3] * rs * h1[3] * silu_(zf[7]));
        *(u32x4*)(cp + k * 8) = w;
      }
    }
    __syncthreads();
  }
}

using s16x4 = __attribute__((ext_vector_type(4))) short;
#define KSWZ(row, colB) ((row) * 256 + ((colB) ^ (((row) & 7) << 4)))
#define SBAR() __builtin_amdgcn_sched_barrier(0)
__device__ __forceinline__ unsigned cvtpk(float lo, float hi) { unsigned r; asm volatile("v_cvt_pk_bf16_f32 %0, %1, %2" : "=v"(r) : "v"(lo), "v"(hi)); return r; }
__device__ __forceinline__ int v_st(int k, int c) { const int kk = (k & ~0xC) | ((k & 4) << 1) | ((k & 8) >> 1); return ((kk >> 3) * 4 + (c >> 5)) * 512 + ((kk & 7) * 32 + (c & 31)) * 2; }
__device__ __forceinline__ int v_rd_base(int lane) { return ((lane & 3) << 3) | (((lane >> 2) & 3) << 6) | (((lane >> 4) & 1) << 5) | (((lane >> 5) & 1) << 8); }
constexpr int v_rd_off(int d0, int ks, int half) { return d0 * 512 + ks * 4096 + half * 2048; }
template <int OFF> __device__ __forceinline__ s16x4 tr_read(int vb) {
  s16x4 r; asm volatile("ds_read_b64_tr_b16 %0, %1 offset:%2" : "=&v"(r) : "v"(vb), "i"(OFF) : "memory"); return r;
}
template <int D0> __device__ __forceinline__ void pv_one(f32x16& od, int vb, bf16x8 pa0, bf16x8 pa1, bf16x8 pa2, bf16x8 pa3) {
  const s16x4 l0 = tr_read<v_rd_off(D0, 0, 0)>(vb), h0 = tr_read<v_rd_off(D0, 0, 1)>(vb), l1 = tr_read<v_rd_off(D0, 1, 0)>(vb), h1 = tr_read<v_rd_off(D0, 1, 1)>(vb);
  const s16x4 l2 = tr_read<v_rd_off(D0, 2, 0)>(vb), h2 = tr_read<v_rd_off(D0, 2, 1)>(vb), l3 = tr_read<v_rd_off(D0, 3, 0)>(vb), h3 = tr_read<v_rd_off(D0, 3, 1)>(vb);
  asm volatile("s_waitcnt lgkmcnt(0)" ::: "memory"); SBAR();
#define PK(L, H) (bf16x8){L[0], L[1], L[2], L[3], H[0], H[1], H[2], H[3]}
  od = __builtin_amdgcn_mfma_f32_32x32x16_bf16(pa0, PK(l0, h0), od, 0, 0, 0);
  od = __builtin_amdgcn_mfma_f32_32x32x16_bf16(pa1, PK(l1, h1), od, 0, 0, 0);
  od = __builtin_amdgcn_mfma_f32_32x32x16_bf16(pa2, PK(l2, h2), od, 0, 0, 0);
  od = __builtin_amdgcn_mfma_f32_32x32x16_bf16(pa3, PK(l3, h3), od, 0, 0, 0);
#undef PK
}
__device__ __forceinline__ float pl32_other(float a, float b, int hi) {
  auto rr = __builtin_amdgcn_permlane32_swap(__float_as_uint(a), __float_as_uint(b), false, false);
  return __uint_as_float(hi ? rr[0] : rr[1]);
}
__device__ __forceinline__ void sb_half(f32x16& pz, float& run, bool need_mask, int kb, int t, int hi) {
  constexpr float C2 = 0.08838834764831845f * 1.4426950408889634f;
  f32x16 l;
#pragma unroll
  for (int r = 0; r < 16; ++r) {
    const float e = __builtin_amdgcn_exp2f(fminf(pz[r] * C2, 60.f));
    l[r] = __builtin_amdgcn_rcpf(1.f + e);
    pz[r] = e;
  }
  if (need_mask) {
#pragma unroll
    for (int r = 0; r < 16; ++r) { if (kb + crow(r, hi) >= t) { l[r] = 1.f; pz[r] = 0.f; } }
  }
#pragma unroll
  for (int g = 0; g < 4; ++g) { l[4 * g + 2] *= l[4 * g + 3]; l[4 * g + 1] *= l[4 * g + 2]; l[4 * g] *= l[4 * g + 1]; }
  const float cs3 = l[12], cs2 = l[8] * cs3, cs1 = l[4] * cs2, cs0 = l[0] * cs1;
  const float off0 = cs1 * pl32_other(cs0, cs1, hi) * run;
  const float off1 = cs2 * pl32_other(cs1, cs2, hi) * run;
  const float off2 = cs3 * pl32_other(cs2, cs3, hi) * run;
  const float off3 = pl32_other(cs3, 1.f, hi) * run;
  float tot;
  { auto rr = __builtin_amdgcn_permlane32_swap(__float_as_uint(cs0), __float_as_uint(cs0), false, false); tot = __uint_as_float(rr[0]) * __uint_as_float(rr[1]); }
#pragma unroll
  for (int r = 0; r < 4; ++r) {
    pz[r] = pz[r] * l[r] * off0; pz[4 + r] = pz[4 + r] * l[4 + r] * off1;
    pz[8 + r] = pz[8 + r] * l[8 + r] * off2; pz[12 + r] = pz[12 + r] * l[12 + r] * off3;
  }
  run *= tot;
}

__device__ __forceinline__ void attn_phase(const Params& p, char* smem, int bid, int nblk) {
  const int tid = otid(), wid = tid >> 6, lane = tid & 63, r32 = lane & 31, hi = lane >> 5;
  char* K_lds0 = smem; char* V_lds0 = smem + 16384;
  const u16* qkv = (const u16*)(p.ws + OFF_PROJ);
  u16* ao = (u16*)(p.ws + OFF_HN);
  const int sr = tid >> 4, sc = (tid & 15) * 8;
  const int vb00 = (int)(uintptr_t)V_lds0 + v_rd_base(lane);
  for (int k = 0; k * nblk < 2048; ++k) {
    const int i = (k & 1) ? ((k + 1) * nblk - 1 - bid) : (k * nblk + bid);
    if (i >= 2048) continue;
    const int j = 63 - (i >> 5), bh = i & 31, b = bh >> 3, h = bh & 7;
    const int i0 = j * 128;
    const size_t rowb = (size_t)b * SEQ;
    const int t = i0 + wid * 32 + r32, tmin = i0 + wid * 32, tmax = tmin + 31;
    bf16x8 qr[8];
    {
      const u16* qp = qkv + (rowb + t) * 3072 + h * 128 + hi * 8;
#pragma unroll
      for (int d0 = 0; d0 < 8; ++d0) qr[d0] = *(const bf16x8*)(qp + d0 * 16);
    }
    f32x16 o[4];
#pragma unroll
    for (int d = 0; d < 4; ++d)
#pragma unroll
      for (int r = 0; r < 16; ++r) o[d][r] = 0.f;
    float run = 1.f;
    const u16* kbase = qkv + rowb * 3072 + 1024 + h * 128 + sc;
    u32x4 stk[4], stv[4];
#define SLOAD(KT) do { _Pragma("unroll") for (int ii = 0; ii < 4; ++ii) { const u16* kp = kbase + (size_t)((KT) * 64 + sr + 16 * ii) * 3072; \
      stk[ii] = *(const u32x4*)kp; stv[ii] = *(const u32x4*)(kp + 1024); } } while (0)
#define SWRITE(B) do { _Pragma("unroll") for (int ii = 0; ii < 4; ++ii) { const int row = sr + 16 * ii; \
      *(u32x4*)(K_lds0 + (B) * 32768 + KSWZ(row, sc * 2)) = stk[ii]; *(u32x4*)(V_lds0 + (B) * 32768 + v_st(row, sc)) = stv[ii]; } } while (0)
    const int NT = 2 * j + 2;
    __syncthreads();
    SLOAD(NT - 1); SWRITE(0); __syncthreads();
    int cur = 0;
    for (int kt = NT - 1; kt >= 0; --kt) {
      const int k0 = kt * 64;
      const char* K_lds = K_lds0 + cur * 32768; const int vb0 = vb00 + cur * 32768;
      if (kt > 0) SLOAD(kt - 1);
      if (k0 <= tmax) {
        bf16x8 pa0, pa1, pa2, pa3;
#define PK4(P, BASE, OUT) do { unsigned a0 = cvtpk(P[BASE + 0], P[BASE + 1]), a1 = cvtpk(P[BASE + 2], P[BASE + 3]); \
    unsigned b0_ = cvtpk(P[BASE + 4], P[BASE + 5]), b1_ = cvtpk(P[BASE + 6], P[BASE + 7]); \
    auto r0 = __builtin_amdgcn_permlane32_swap(a0, b0_, false, false); auto r1 = __builtin_amdgcn_permlane32_swap(a1, b1_, false, false); \
    u32x4 w = {r0[0], r1[0], r0[1], r1[1]}; OUT = *reinterpret_cast<bf16x8*>(&w); } while (0)
        if (k0 + 32 <= tmax) {
          f32x16 pz;
#pragma unroll
          for (int r = 0; r < 16; ++r) pz[r] = 0.f;
#pragma unroll
          for (int d0 = 0; d0 < 8; ++d0) {
            const bf16x8 kf = *(const bf16x8*)(K_lds + KSWZ(32 + r32, (d0 * 16 + hi * 8) * 2));
            pz = __builtin_amdgcn_mfma_f32_32x32x16_bf16(kf, qr[d0], pz, 0, 0, 0);
          }
          sb_half(pz, run, k0 + 63 >= tmin, k0 + 32, t, hi);
          PK4(pz, 0, pa2); PK4(pz, 8, pa3);
        } else {
          pa2 = bf16x8{0, 0, 0, 0, 0, 0, 0, 0}; pa3 = pa2;
        }
        {
          f32x16 pz;
#pragma unroll
          for (int r = 0; r < 16; ++r) pz[r] = 0.f;
#pragma unroll
          for (int d0 = 0; d0 < 8; ++d0) {
            const bf16x8 kf = *(const bf16x8*)(K_lds + KSWZ(r32, (d0 * 16 + hi * 8) * 2));
            pz = __builtin_amdgcn_mfma_f32_32x32x16_bf16(kf, qr[d0], pz, 0, 0, 0);
          }
          sb_half(pz, run, k0 + 31 >= tmin, k0, t, hi);
          PK4(pz, 0, pa0); PK4(pz, 8, pa1);
        }
#undef PK4
        pv_one<0>(o[0], vb0, pa0, pa1, pa2, pa3); pv_one<1>(o[1], vb0, pa0, pa1, pa2, pa3);
        pv_one<2>(o[2], vb0, pa0, pa1, pa2, pa3); pv_one<3>(o[3], vb0, pa0, pa1, pa2, pa3);
      }
      if (kt > 0) SWRITE(cur ^ 1);
      __syncthreads();
      cur ^= 1;
    }
#undef SLOAD
#undef SWRITE
    {
      const int orow0 = (int)rowb + i0 + wid * 32;
#pragma unroll
      for (int r = 0; r < 16; ++r) {
        const int orow = crow(r, hi);
#pragma unroll
        for (int d0 = 0; d0 < 4; ++d0) ao[a_off(orow0 + orow, h * 128 + d0 * 32 + r32, 32)] = f2bf(o[d0][r]);
      }
    }
  }
}

#define XB_TMO      128
#define XB_XCNT(j)  (256  + 64 * (j))
#define XB_XSUB(j)  (1280 + 64 * (j))
#define XB_XGEN(j)  (2304 + 64 * (j))
#define XB_TOP      3328
#define XB_TOPGEN   3392
#define XCD_BAR_WORDS 3456
#define XB_SPIN_CAP (1u << 23)
#define LAS __attribute__((address_space(3)))
__device__ __forceinline__ unsigned xb_ld(unsigned* p)              { return __hip_atomic_load(p, __ATOMIC_RELAXED, __HIP_MEMORY_SCOPE_AGENT); }
__device__ __forceinline__ unsigned xb_add(unsigned* p, unsigned v) { return __hip_atomic_fetch_add(p, v, __ATOMIC_RELAXED, __HIP_MEMORY_SCOPE_AGENT); }
__device__ __forceinline__ unsigned xb_xcc_id() { return (unsigned)__builtin_amdgcn_s_getreg((3 << 11) | 20) & 0xFu; }
#define XB_SPIN(cond, bar) do { unsigned _sp = 0; while (cond) { __builtin_amdgcn_s_sleep(1); \
    if ((++_sp & 255u) == 0u) { if (xb_ld(&(bar)[XB_TMO])) break; if (_sp > XB_SPIN_CAP) { atomicAdd(&(bar)[XB_TMO], 1u); break; } } } } while (0)
struct XcdBarrier { unsigned* bar; unsigned x; volatile LAS unsigned* st; };
__device__ __forceinline__ XcdBarrier xcd_barrier_post(unsigned* bar, volatile LAS unsigned* st) {
  XcdBarrier b; b.bar = bar; b.x = xb_xcc_id(); b.st = st;
  if (__builtin_amdgcn_workitem_id_x() == 0) (void)xb_add(&bar[XB_XCNT(b.x)], 1u);
  return b;
}
__device__ __forceinline__ void xcd_barrier_complete(unsigned* bar, unsigned x, unsigned& nloc, unsigned& nx) {
  const unsigned G = gridDim.x * gridDim.y * gridDim.z;
  unsigned sum, cnt, mine, sp = 0u;
  for (;;) {
    sum = 0u; cnt = 0u; mine = 0u;
#pragma unroll
    for (unsigned j = 0; j < 16; ++j) { const unsigned c = xb_ld(&bar[XB_XCNT(j)]); sum += c; cnt += (c > 0u) ? 1u : 0u; mine = (j == x) ? c : mine; }
    if (sum == G) break;
    __builtin_amdgcn_s_sleep(1);
    if ((++sp & 255u) == 0u) { if (xb_ld(&bar[XB_TMO])) break; if (sp > XB_SPIN_CAP) { atomicAdd(&bar[XB_TMO], 1u); break; } }
  }
  nloc = mine > 0u ? mine : 1u; nx = cnt > 0u ? cnt : 1u;
}
__device__ __forceinline__ void xcd_barrier(const XcdBarrier& b) {
  asm volatile("s_waitcnt vmcnt(0)" ::: "memory");
  __syncthreads();
  if (__builtin_amdgcn_workitem_id_x() == 0) {
    unsigned* bar = b.bar;
    __builtin_amdgcn_s_waitcnt(0);
    unsigned nloc = b.st[0], nx = b.st[1];
    if (nloc == 0u) { xcd_barrier_complete(bar, b.x, nloc, nx); b.st[0] = nloc; b.st[1] = nx; }
    const unsigned old = xb_add(&bar[XB_XSUB(b.x)], 1u);
    const unsigned gen = old / nloc;
    if (old + 1u == (gen + 1u) * nloc) {
      __builtin_amdgcn_fence(__ATOMIC_RELEASE, "agent");
      asm volatile("s_waitcnt vmcnt(0)" ::: "memory");
      const unsigned og = xb_add(&bar[XB_TOP], 1u);
      const unsigned tg = og / nx;
      if (og + 1u == (tg + 1u) * nx) xb_add(&bar[XB_TOPGEN], 1u);
      else XB_SPIN(xb_ld(&bar[XB_TOPGEN]) == tg, bar);
      __builtin_amdgcn_fence(__ATOMIC_ACQUIRE, "agent");
      xb_add(&bar[XB_XGEN(b.x)], 1u);
      asm volatile("s_waitcnt vmcnt(0)" ::: "memory");
    } else {
      XB_SPIN(xb_ld(&bar[XB_XGEN(b.x)]) == gen, bar);
      __builtin_amdgcn_fence(__ATOMIC_ACQUIRE, "agent");
      asm volatile("s_waitcnt vmcnt(0)" ::: "memory");
    }
  }
  __syncthreads();
}

__global__ void __launch_bounds__(256, 2) mega(Params p) {
  __shared__ __attribute__((aligned(16))) char smem[SMEM_BYTES];
  __shared__ uint4 xb_words;
  const int bid = blockIdx.x, nblk = gridDim.x;
  char* ws = p.ws;
  if (__builtin_amdgcn_workitem_id_x() == 0) xb_words = make_uint4(0u, 0u, 0u, 0u);
  __syncthreads();
  const XcdBarrier xbar = xcd_barrier_post((unsigned*)(ws + OFF_BAR), (volatile LAS unsigned*)&xb_words);
  const float* mod = (const float*)(ws + OFF_MOD);
  u16* hn = (u16*)(ws + OFF_HN);
#define PH_BEGIN(n) if (p.phase_lo <= (n) && (n) < p.phase_hi) {
#define PH_END(n) if ((n) + 1 < p.phase_hi) { if ((n) == 0) cg::this_grid().sync(); else xcd_barrier(xbar); } }
  PH_BEGIN(0) phase0(p, smem, bid, nblk); PH_END(0)
  PH_BEGIN(1) norm_phase<1>(p, p.x, p.norm_mix_w, mod, 0, 1024, smem, bid, nblk); PH_END(1)
  PH_BEGIN(2) { EpiArgs ea{}; ea.outb = (u16*)(ws + OFF_PROJ); ea.ux = (u16*)(ws + OFF_UX);
        gemm_phase<E_PROJ0>(hn, 32, 0, (const u16*)(ws + OFF_WT_HYIN), 32, 0, 1024, M / 256, PN / 128, 1, ea, smem, bid, nblk); } PH_END(2)
  PH_BEGIN(3) { EpiArgs ea{}; ea.outf = (float*)(ws + OFF_XE);
        gemm_phase<E_XE>((const u16*)(ws + OFF_UX), 20, (size_t)S5C * UXW, (const u16*)(ws + OFF_EG), 16, (size_t)128 * 512, 512, S5C / 256, 1, 32, ea, smem, bid, nblk); } PH_END(3)
  PH_BEGIN(4) { s5_carry_phase(p, bid, nblk); gdn_prep_phase(p, smem, bid, nblk); } PH_END(4)
  PH_BEGIN(5) {
        if (bid < 16) { gdn_scan_item(p, bid, smem); }
        else { EpiArgs ea{}; ea.outb = (u16*)(ws + OFF_Y5); ea.ux = (u16*)(ws + OFF_UX); ea.bias = p.s5_d;
          gemm_phase<E_S5Y>((const u16*)(ws + OFF_UX), 20, (size_t)S5C * UXW, (const u16*)(ws + OFF_MF), 20, (size_t)512 * UXW, UXW, S5C / 256, 4, 32, ea, smem, bid - 16, nblk - 16); }
      } PH_END(5)
  PH_BEGIN(6) { gdn_out_phase(p, smem, bid, nblk); __syncthreads();
 EpiArgs ea{}; ea.outb = hn; ea.y5 = (const u16*)(ws + OFF_Y5); ea.bias = p.s5_glu_b;
        gemm_phase<E_GLU>((const u16*)(ws + OFF_Y5), 16, 0, (const u16*)(ws + OFF_WT_GLU), 16, 0, 512, M / 256, 4, 1, ea, smem, bid, nblk); } PH_END(6)
  PH_BEGIN(8) { EpiArgs ea{}; ea.outf = p.out; ea.res = p.x; ea.gate = mod + 2048;
        gemm_phase<E_RESID>(hn, 32, 0, (const u16*)(ws + OFF_WT_HYOUT), 32, 0, 1024, M / 256, 8, 1, ea, smem, bid, nblk); } PH_END(8)
  PH_BEGIN(9) norm_phase<0>(p, p.out, p.norm_ffn_w, mod, 3072, 4096, smem, bid, nblk); PH_END(9)
  PH_BEGIN(10) { EpiArgs ea{}; ea.outb = (u16*)(ws + OFF_PROJ);
        gemm_phase<E_SWIGLU>(hn, 32, 0, (const u16*)(ws + OFF_WT_FFNIN), 32, 0, 1024, M / 256, 2 * FF / 128, 1, ea, smem, bid, nblk); } PH_END(10)
  PH_BEGIN(11) { EpiArgs ea{}; ea.outf = p.out; ea.res = p.out; ea.gate = mod + 5120;
        gemm_phase<E_RESID>((const u16*)(ws + OFF_PROJ), FF / 32, 0, (const u16*)(ws + OFF_WT_FFNOUT), FF / 32, 0, FF, M / 256, 8, 1, ea, smem, bid, nblk); } PH_END(11)
  PH_BEGIN(12) norm_phase<0>(p, p.out, p.norm_mix_w + 1024, mod + 4 * 6144, 0, 1024, smem, bid, nblk); PH_END(12)
  PH_BEGIN(13) { EpiArgs ea{}; ea.outb = (u16*)(ws + OFF_PROJ); ea.ldc = 3072;
        gemm_phase<E_BF16>(hn, 32, 0, (const u16*)(ws + OFF_WT_SBIN), 32, 0, 1024, M / 256, 24, 1, ea, smem, bid, nblk); } PH_END(13)
  PH_BEGIN(14) attn_phase(p, smem, bid, nblk); PH_END(14)
  PH_BEGIN(15) { EpiArgs ea{}; ea.outf = p.out; ea.res = p.out; ea.gate = mod + 4 * 6144 + 2048;
        gemm_phase<E_RESID>(hn, 32, 0, (const u16*)(ws + OFF_WT_SBOUT), 32, 0, 1024, M / 256, 8, 1, ea, smem, bid, nblk); } PH_END(15)
  PH_BEGIN(16) norm_phase<0>(p, p.out, p.norm_ffn_w + 1024, mod + 4 * 6144, 3072, 4096, smem, bid, nblk); PH_END(16)
  PH_BEGIN(17) { EpiArgs ea{}; ea.outb = (u16*)(ws + OFF_PROJ);
        gemm_phase<E_SWIGLU>(hn, 32, 0, (const u16*)(ws + OFF_WT_FFNIN + SZ_WT_FFNIN), 32, 0, 1024, M / 256, 2 * FF / 128, 1, ea, smem, bid, nblk); } PH_END(17)
  PH_BEGIN(18) { EpiArgs ea{}; ea.outf = p.out; ea.res = p.out; ea.gate = mod + 4 * 6144 + 5120;
        gemm_phase<E_RESID>((const u16*)(ws + OFF_PROJ), FF / 32, 0, (const u16*)(ws + OFF_WT_FFNOUT + SZ_WT_FFNOUT), FF / 32, 0, FF, M / 256, 8, 1, ea, smem, bid, nblk); } PH_END(18)
  PH_BEGIN(19) norm_phase<2>(p, p.out, p.final_norm_w, mod, 0, 0, smem, bid, nblk); PH_END(19)
}

extern "C" void kernel_launch(void* const* d_in, const int* in_sizes, int n_in, void* d_out, int out_size, void* d_ws, size_t ws_size,
                              hipStream_t stream) {
  static int grid_blocks = 0;
  if (!grid_blocks) {
    int dev = 0, cus = 0, per_cu = 0;
    hipGetDevice(&dev);
    hipDeviceGetAttribute(&cus, hipDeviceAttributeMultiprocessorCount, dev);
    hipOccupancyMaxActiveBlocksPerMultiprocessor(&per_cu, mega, 256, 0);
    if (per_cu > 2) per_cu = 2;
    if (per_cu < 1) per_cu = 1;
    grid_blocks = cus * per_cu;
  }
  Params p{};
  const float* const* in = (const float* const*)d_in;
  p.x = in[0]; p.c = in[1]; p.ada_w = in[2]; p.ada_b = in[3]; p.norm_mix_w = in[4]; p.norm_ffn_w = in[5]; p.ffn_w_in = in[6]; p.ffn_w_out = in[7];
  p.hy_w_in = in[8]; p.hy_conv_w = in[9]; p.hy_a_log = in[10]; p.hy_dt_bias = in[11]; p.hy_head_norm_w = in[12];
  p.s5_lam_re = in[13]; p.s5_lam_im = in[14]; p.s5_log_dt = in[15]; p.s5_b_re = in[16]; p.s5_b_im = in[17]; p.s5_c_re = in[18]; p.s5_c_im = in[19];
  p.s5_d = in[20]; p.s5_glu_w = in[21]; p.s5_glu_b = in[22]; p.hy_w_out = in[23]; p.sb_w_in = in[24]; p.sb_w_out = in[25]; p.final_norm_w = in[26];
  p.out = (float*)d_out; p.ws = (char*)d_ws;
#if ONE_LAUNCH
  p.phase_lo = 0; p.phase_hi = NPHASE;
  (void)hipMemsetAsync((char*)d_ws + OFF_BAR, 0, (size_t)XCD_BAR_WORDS_C * 4, stream);
  void* args[] = {&p};
  hipError_t e = hipLaunchCooperativeKernel((void*)mega, dim3(grid_blocks), dim3(256), args, 0, stream);
  if (e != hipSuccess) fprintf(stderr, "cooperative launch failed: %s (grid %d)\n", hipGetErrorString(e), grid_blocks);
#else
  for (int ph = 0; ph < NPHASE; ++ph) {
    p.phase_lo = ph; p.phase_hi = ph + 1;
    hipLaunchKernelGGL(mega, dim3(grid_blocks), dim3(256), 0, stream, p);
  }
#endif
}
```

```cpp
#include <hip/hip_runtime.h>
#include <hip/hip_cooperative_groups.h>
#include <stdint.h>
#include <cstdio>
namespace cg = cooperative_groups;

#ifndef ONE_LAUNCH
#define ONE_LAUNCH 1
#endif

typedef unsigned short u16;
using bf16x8 = __attribute__((ext_vector_type(8))) short;
using f32x4 = __attribute__((ext_vector_type(4))) float;
using u32x4 = __attribute__((ext_vector_type(4))) unsigned;

constexpr int D = 1024, NB = 4, SEQ = 8192, M = NB * SEQ, FF = 2816, EIN = 2568, PN = 2560, PJ = 2048;
constexpr int NPHASE = 20;
constexpr int XCD_BAR_WORDS_C = 3456;
constexpr int S5T = 32, S5C = M / S5T, UXW = 640;

constexpr size_t SZ_WT_HYIN = (size_t)PN * 1024 * 2, SZ_WT_SQ = (size_t)1024 * 1024 * 2, SZ_WT_GLU = (size_t)512 * 512 * 2;
constexpr size_t SZ_WT_FFNIN = (size_t)2 * FF * 1024 * 2, SZ_WT_FFNOUT = (size_t)1024 * FF * 2, SZ_WT_SBIN = (size_t)3072 * 1024 * 2;
constexpr size_t OFF_WT_HYIN = 0;
constexpr size_t OFF_WT_HYOUT = OFF_WT_HYIN + SZ_WT_HYIN;
constexpr size_t OFF_WT_GLU = OFF_WT_HYOUT + SZ_WT_SQ;
constexpr size_t OFF_WT_FFNIN = OFF_WT_GLU + SZ_WT_GLU;
constexpr size_t OFF_WT_FFNOUT = OFF_WT_FFNIN + 2 * SZ_WT_FFNIN;
constexpr size_t OFF_WT_SBIN = OFF_WT_FFNOUT + 2 * SZ_WT_FFNOUT;
constexpr size_t OFF_WT_SBOUT = OFF_WT_SBIN + SZ_WT_SBIN;
constexpr size_t OFF_MOD = OFF_WT_SBOUT + SZ_WT_SQ;
constexpr size_t OFF_BETA = OFF_MOD + (size_t)2 * 4 * 6144 * 4;
constexpr size_t OFF_G = OFF_BETA + (size_t)M * 4 * 4;
constexpr size_t OFF_HN = OFF_G + (size_t)M * 4 * 4;
constexpr size_t OFF_Y5 = OFF_HN + (size_t)M * 1024 * 2;
constexpr size_t OFF_UX = OFF_Y5 + (size_t)M * 512 * 2;
constexpr size_t OFF_MF = OFF_UX + (size_t)32 * S5C * UXW * 2;
constexpr size_t OFF_EG = OFF_MF + (size_t)32 * 512 * UXW * 2;
constexpr size_t OFF_XE = OFF_EG + (size_t)32 * 128 * 512 * 2;
constexpr size_t OFF_A32 = OFF_XE + (size_t)32 * S5C * 128 * 4;
constexpr size_t OFF_PROJ = OFF_A32 + (size_t)32 * 64 * 2 * 4;
constexpr size_t OFF_GW = OFF_PROJ + (size_t)M * PJ * 2;
constexpr size_t OFF_GQD = OFF_GW + (size_t)2048 * 8192 * 2;
constexpr size_t OFF_GKT = OFF_GQD + (size_t)2048 * 8192 * 2;
constexpr size_t OFF_GUT = OFF_GKT + (size_t)2048 * 8192 * 2;
constexpr size_t OFF_GAT = OFF_GUT + (size_t)2048 * 8192 * 2;
constexpr size_t OFF_GSD = OFF_GAT + (size_t)2048 * 4096 * 2;
constexpr size_t OFF_BAR = OFF_GSD + (size_t)2048 * 4;
constexpr size_t WS_TOTAL = OFF_BAR + (size_t)XCD_BAR_WORDS_C * 4;
static_assert((size_t)M * 3072 * 2 <= WS_TOTAL - OFF_PROJ, "QKV alias");
static_assert(WS_TOTAL <= (size_t)512 * 1024 * 1024, "workspace too large");

struct Params {
  const float *x, *c, *ada_w, *ada_b, *norm_mix_w, *norm_ffn_w, *ffn_w_in, *ffn_w_out;
  const float *hy_w_in, *hy_conv_w, *hy_a_log, *hy_dt_bias, *hy_head_norm_w;
  const float *s5_lam_re, *s5_lam_im, *s5_log_dt, *s5_b_re, *s5_b_im, *s5_c_re, *s5_c_im, *s5_d, *s5_glu_w, *s5_glu_b, *hy_w_out;
  const float *sb_w_in, *sb_w_out, *final_norm_w;
  float* out;
  char* ws;
  int phase_lo, phase_hi;
};

constexpr int SMEM_BYTES = 73728;

__device__ __forceinline__ int otid() { int t = __builtin_amdgcn_workitem_id_x(); asm volatile("" : "+v"(t)); return t; }
__device__ __forceinline__ u16 f2bf(float x) { unsigned u = __float_as_uint(x); u += 0x7fffu + ((u >> 16) & 1u); return (u16)(u >> 16); }
typedef __bf16 bf16v2 __attribute__((ext_vector_type(2)));
typedef float f32v2 __attribute__((ext_vector_type(2)));
__device__ __forceinline__ unsigned pk2(float a, float b) { f32v2 v = {a, b}; bf16v2 r = __builtin_convertvector(v, bf16v2); return __builtin_bit_cast(unsigned, r); }
__device__ __forceinline__ float bf2f(u16 v) { return __uint_as_float(((unsigned)v) << 16); }
__device__ __forceinline__ float sigmoid_(float x) { return __builtin_amdgcn_rcpf(1.f + __expf(-x)); }
__device__ __forceinline__ float silu_(float x) { return x * sigmoid_(x); }
__device__ __forceinline__ float softplus_(float x) { return fmaxf(x, 0.f) + log1pf(__expf(-fabsf(x))); }
__device__ __forceinline__ float gelu_tanh_(float y) { return 0.5f * y * (1.f + tanhf(0.7978845608028654f * (y + 0.044715f * y * y * y))); }

__device__ __forceinline__ size_t pj_idx(int row, int col) { return (size_t)(col >> 9) * ((size_t)M * 512) + (size_t)row * 512 + (col & 511); }
__device__ __forceinline__ int swzf(int r) { return (4 - ((r >> 2) & 3)) & 3; }
__device__ __forceinline__ int swzc(int r, int c) { return ((((c >> 3) ^ swzf(r)) << 3) | (c & 7)); }
__device__ __forceinline__ size_t a_off(int row, int col, int nks) { return ((size_t)((row >> 8) * nks + (col >> 5)) << 13) + ((row & 255) << 5) + swzc(row, col & 31); }
__device__ __forceinline__ size_t b_off(int n, int k, int nks) { return ((size_t)((n >> 7) * nks + (k >> 5)) << 12) + ((n & 127) << 5) + swzc(n, k & 31); }

struct TrJob { const float* src; u16* dst; int K, Nsrc, Nd, mode; };
__device__ __forceinline__ TrJob get_job(const Params& p, int j) {
  TrJob t;
  switch (j) {
    case 0: t = {p.hy_w_in, (u16*)(p.ws + OFF_WT_HYIN), 1024, EIN, PN, 1}; break;
    case 1: t = {p.hy_w_out, (u16*)(p.ws + OFF_WT_HYOUT), 1024, 1024, 1024, 0}; break;
    case 2: t = {p.s5_glu_w, (u16*)(p.ws + OFF_WT_GLU), 512, 512, 512, 0}; break;
    case 3: t = {p.ffn_w_in, (u16*)(p.ws + OFF_WT_FFNIN), 1024, 2 * FF, 2 * FF, 2}; break;
    case 4: t = {p.ffn_w_in + (size_t)1024 * 2 * FF, (u16*)(p.ws + OFF_WT_FFNIN + SZ_WT_FFNIN), 1024, 2 * FF, 2 * FF, 2}; break;
    case 5: t = {p.ffn_w_out, (u16*)(p.ws + OFF_WT_FFNOUT), FF, 1024, 1024, 0}; break;
    case 6: t = {p.ffn_w_out + (size_t)FF * 1024, (u16*)(p.ws + OFF_WT_FFNOUT + SZ_WT_FFNOUT), FF, 1024, 1024, 0}; break;
    case 7: t = {p.sb_w_in, (u16*)(p.ws + OFF_WT_SBIN), 1024, 3072, 3072, 0}; break;
    default: t = {p.sb_w_out, (u16*)(p.ws + OFF_WT_SBOUT), 1024, 1024, 1024, 0}; break;
  }
  return t;
}
__device__ __forceinline__ int src_col(int R, int mode) {
  if (mode == 0) return R;
  if (mode == 1) return R < 2048 ? R : R + 8;
  return ((R >> 4) & 1) * FF + (R >> 5) * 16 + (R & 15);
}
constexpr int N_TR_ITEMS = (640 + 256 + 64 + 2 * 1408 + 2 * 704 + 768 + 256) / 4;
constexpr int N_MOD_ITEMS = 2 * 6144 / 16;

__device__ __forceinline__ void s5_table_item(const Params& p, int item, char* smem) {
  const int tid = otid(), g = item >> 5, tau = item & 31;
  float* pwr = (float*)smem; float* pwi = pwr + 64; float* p1r = pwi + 64; float* p1i = p1r + 64;
  float* bbr = p1i + 64; float* bbi = bbr + 1024; float* cre = bbi + 1024; float* cim = cre + 1024;
  const float dt = expf(p.s5_log_dt[g]);
  if (tid < 64) {
    const float lr = p.s5_lam_re[g * 64 + tid], li = p.s5_lam_im[g * 64 + tid];
    float sn, cs;
    float mg = expf(lr * dt * (float)tau); sincosf(li * dt * (float)tau, &sn, &cs); pwr[tid] = mg * cs; pwi[tid] = mg * sn;
    mg = expf(lr * dt * (float)(tau + 1)); sincosf(li * dt * (float)(tau + 1), &sn, &cs); p1r[tid] = mg * cs; p1i[tid] = mg * sn;
    if (tau == 31) { float* a32 = (float*)(p.ws + OFF_A32); a32[(g * 64 + tid) * 2] = mg * cs; a32[(g * 64 + tid) * 2 + 1] = mg * sn; }
  }
  {
    const int pp = tid >> 2, hq = (tid & 3) * 4;
    const float lr = p.s5_lam_re[g * 64 + pp], li = p.s5_lam_im[g * 64 + pp];
    const float mg = expf(lr * dt); float sn, cs; sincosf(li * dt, &sn, &cs);
    const float ar = mg * cs, ai = mg * sn, den = lr * lr + li * li, nr = ar - 1.f, ni = ai;
    const float fre = (nr * lr + ni * li) / den, fim = (ni * lr - nr * li) / den;
#pragma unroll
    for (int e = 0; e < 4; ++e) {
      const float br = p.s5_b_re[(size_t)(g * 64 + pp) * 16 + hq + e], bi = p.s5_b_im[(size_t)(g * 64 + pp) * 16 + hq + e];
      bbr[pp * 16 + hq + e] = fre * br - fim * bi; bbi[pp * 16 + hq + e] = fre * bi + fim * br;
    }
    for (int i = tid; i < 1024; i += 256) { cre[i] = p.s5_c_re[(size_t)g * 1024 + i]; cim[i] = p.s5_c_im[(size_t)g * 1024 + i]; }
  }
  __syncthreads();
  u16* mf = (u16*)(p.ws + OFF_MF) + (size_t)g * 512 * UXW;
  u16* eg = (u16*)(p.ws + OFF_EG) + (size_t)g * 128 * 512;
  {
    const int h = tid >> 4, hp = tid & 15;
    float kv = 0.f;
    for (int pp = 0; pp < 64; ++pp) {
      const float cr = cre[h * 64 + pp], ci = cim[h * 64 + pp], pr = pwr[pp], pi = pwi[pp];
      kv += (cr * pr - ci * pi) * bbr[pp * 16 + hp] - (cr * pi + ci * pr) * bbi[pp * 16 + hp];
    }
    const u16 kb = f2bf(kv);
    for (int s0 = 0; s0 + tau < 32; ++s0) mf[b_off((s0 + tau) * 16 + h, s0 * 16 + hp, 20)] = kb;
    for (int t0 = 0; t0 + tau + 1 < 32; ++t0) mf[b_off(t0 * 16 + h, (t0 + tau + 1) * 16 + hp, 20)] = 0;
#pragma unroll
    for (int e = 0; e < 4; ++e) {
      const int pp = hp * 4 + e;
      const float cr = cre[h * 64 + pp], ci = cim[h * 64 + pp], pr = p1r[pp], pi = p1i[pp];
      mf[b_off(tau * 16 + h, 512 + pp, 20)] = f2bf(cr * pr - ci * pi);
      mf[b_off(tau * 16 + h, 576 + pp, 20)] = f2bf(-(cr * pi + ci * pr));
    }
  }
  {
    const int pp = tid >> 2, hq = (tid & 3) * 4, s0 = 31 - tau;
#pragma unroll
    for (int e = 0; e < 4; ++e) {
      const float br = bbr[pp * 16 + hq + e], bi = bbi[pp * 16 + hq + e], pr = pwr[pp], pi = pwi[pp];
      eg[b_off(pp, s0 * 16 + hq + e, 16)] = f2bf(pr * br - pi * bi);
      eg[b_off(64 + pp, s0 * 16 + hq + e, 16)] = f2bf(pr * bi + pi * br);
    }
  }
  __syncthreads();
}

__device__ __forceinline__ void phase0(const Params& p, char* smem, int bid, int nblk) {
  const int tid = otid();
  for (int it = bid; it < N_TR_ITEMS + N_MOD_ITEMS + 1024; it += nblk) {
    if (it >= N_TR_ITEMS + N_MOD_ITEMS) { s5_table_item(p, it - N_TR_ITEMS - N_MOD_ITEMS, smem); continue; }
    if (it < N_TR_ITEMS) {
      int rem = it * 4, j = 0; TrJob jb;
      for (;; ++j) { jb = get_job(p, j); int n = (jb.Nd >> 6) * (jb.K >> 6); if (rem < n) break; rem -= n; }
      const int nk = jb.K >> 6;
      u16* s = (u16*)smem;
      {
        const int r = tid & 63, kk = tid >> 6;
#pragma unroll
        for (int q = 0; q < 4; ++q) {
          const int R0 = ((rem + q) / nk) * 64, k0 = ((rem + q) % nk) * 64;
          const float* sp = jb.src + (size_t)k0 * jb.Nsrc + src_col(R0 + r, jb.mode);
#pragma unroll
          for (int i = 0; i < 16; ++i) { int k = kk + 4 * i; s[q * 4608 + r * 72 + k] = f2bf(sp[(size_t)k * jb.Nsrc]); }
        }
      }
      __syncthreads();
      {
        const int r = tid >> 2, ch = tid & 3;
#pragma unroll
        for (int q = 0; q < 4; ++q) {
          const int R0 = ((rem + q) / nk) * 64, k0 = ((rem + q) % nk) * 64;
#pragma unroll
          for (int i = 0; i < 2; ++i) {
            int c8 = (ch + 4 * i) * 8;
            *(u32x4*)(jb.dst + b_off(R0 + r, k0 + c8, jb.K >> 5)) = *(const u32x4*)(s + q * 4608 + r * 72 + c8);
          }
        }
      }
      __syncthreads();
    } else {
      const int mi = it - N_TR_ITEMS, l = mi / 384, n0 = (mi % 384) * 16;
      float* cact = (float*)smem;
      float* red = cact + 4096;
      for (int i = tid; i < 4096; i += 256) cact[i] = silu_(p.c[i]);
      __syncthreads();
      const int cl = tid & 15, ksub = tid >> 4;
      float a0 = 0, a1 = 0, a2 = 0, a3 = 0;
      const float* wp = p.ada_w + (size_t)l * 1024 * 6144 + n0 + cl;
#pragma unroll 16
      for (int k = ksub * 64; k < ksub * 64 + 64; ++k) {
        float w = wp[(size_t)k * 6144];
        a0 += cact[k] * w; a1 += cact[1024 + k] * w; a2 += cact[2048 + k] * w; a3 += cact[3072 + k] * w;
      }
      red[(ksub * 4 + 0) * 16 + cl] = a0; red[(ksub * 4 + 1) * 16 + cl] = a1;
      red[(ksub * 4 + 2) * 16 + cl] = a2; red[(ksub * 4 + 3) * 16 + cl] = a3;
      __syncthreads();
      if (tid < 64) {
        const int b = tid >> 4;
        float sum = 0.f;
#pragma unroll
        for (int q = 0; q < 16; ++q) sum += red[(q * 4 + b) * 16 + cl];
        float* mod = (float*)(p.ws + OFF_MOD);
        mod[(size_t)(l * 4 + b) * 6144 + n0 + cl] = sum + p.ada_b[l * 6144 + n0 + cl];
      }
      __syncthreads();
    }
  }
}

template <int MODE>
__device__ __forceinline__ void norm_phase(const Params& p, const float* src, const float* w, const float* modl, int sh_off, int sc_off,
                           char* smem, int bid, int nblk) {
  const int tid = otid(), wid = tid >> 6, lane = tid & 63;
  float* wba = (float*)smem;
  if (MODE == 1) {
    for (int i = tid; i < 1024 * 8; i += 256) wba[i] = p.hy_w_in[(size_t)(i >> 3) * EIN + 2048 + (i & 7)];
    __syncthreads();
  }
  u16* hn = (u16*)(p.ws + OFF_HN);
  auto process = [&](int row, f32x4 (&v)[4]) {
    float ss = 0.f;
#pragma unroll
    for (int i = 0; i < 4; ++i) ss += v[i][0] * v[i][0] + v[i][1] * v[i][1] + v[i][2] * v[i][2] + v[i][3] * v[i][3];
#pragma unroll
    for (int o = 32; o >= 1; o >>= 1) ss += __shfl_xor(ss, o);
    const float rstd = rsqrtf(ss * (1.f / 1024.f) + 1e-6f);
    const int b = row >> 13;
    float dots[8];
    if (MODE == 1) { for (int j = 0; j < 8; ++j) dots[j] = 0.f; }
#pragma unroll
    for (int i = 0; i < 4; ++i) {
      const int c0 = i * 256 + lane * 4;
      f32x4 ww = *(const f32x4*)(w + c0);
      f32x4 y;
      if (MODE == 2) {
#pragma unroll
        for (int e = 0; e < 4; ++e) y[e] = v[i][e] * rstd * ww[e];
        *(f32x4*)(p.out + (size_t)row * 1024 + c0) = y;
      } else {
        f32x4 sc = *(const f32x4*)(modl + (size_t)b * 6144 + sc_off + c0);
        f32x4 sh = *(const f32x4*)(modl + (size_t)b * 6144 + sh_off + c0);
#pragma unroll
        for (int e = 0; e < 4; ++e) y[e] = v[i][e] * rstd * ww[e] * (1.f + sc[e]) + sh[e];
        uint2 pk; pk.x = (unsigned)f2bf(y[0]) | ((unsigned)f2bf(y[1]) << 16); pk.y = (unsigned)f2bf(y[2]) | ((unsigned)f2bf(y[3]) << 16);
        *(uint2*)(hn + a_off(row, c0, 32)) = pk;
        if (MODE == 1) {
#pragma unroll
          for (int e = 0; e < 4; ++e) {
            f32x4 w0 = *(const f32x4*)(wba + (c0 + e) * 8), w1 = *(const f32x4*)(wba + (c0 + e) * 8 + 4);
#pragma unroll
            for (int j = 0; j < 4; ++j) { dots[j] += y[e] * w0[j]; dots[4 + j] += y[e] * w1[j]; }
          }
        }
      }
    }
    if (MODE == 1) {
#pragma unroll
      for (int j = 0; j < 8; ++j) {
#pragma unroll
        for (int o = 32; o >= 1; o >>= 1) dots[j] += __shfl_xor(dots[j], o);
      }
      if (lane == 0) {
        float* beta = (float*)(p.ws + OFF_BETA); float* gg = (float*)(p.ws + OFF_G);
#pragma unroll
        for (int h = 0; h < 4; ++h) {
          beta[(size_t)row * 4 + h] = sigmoid_(dots[h]);
          gg[(size_t)row * 4 + h] = -__expf(p.hy_a_log[h]) * softplus_(dots[4 + h] + p.hy_dt_bias[h]);
        }
      }
    }
  };
#pragma unroll 1
  for (int row = bid * 4 + wid; row < M; row += nblk * 8) {
    const int row1 = row + nblk * 4;
    const bool has1 = row1 < M;
    f32x4 v0[4], v1[4];
#pragma unroll
    for (int i = 0; i < 4; ++i) v0[i] = *(const f32x4*)(src + (size_t)row * 1024 + i * 256 + lane * 4);
#pragma unroll
    for (int i = 0; i < 4; ++i) v1[i] = has1 ? *(const f32x4*)(src + (size_t)row1 * 1024 + i * 256 + lane * 4) : f32x4{0.f, 0.f, 0.f, 0.f};
    process(row, v0);
    if (has1) process(row1, v1);
  }
}

enum { E_PROJ0 = 0, E_BF16 = 1, E_RESID = 2, E_GLU = 3, E_SWIGLU = 4, E_XE = 5, E_S5Y = 6 };
struct EpiArgs { float* outf; u16* outb; const float* res; const float* gate; const u16* y5; const float* bias; u16* ux; int ldc; };

template <int EPI>
__device__ __forceinline__ void gemm_phase(const u16* __restrict__ A0, int nksA, size_t sA, const u16* __restrict__ B0, int nksB, size_t sB,
                                           int K, int nM, int nN, int nbatch, const EpiArgs ea, char* smem, int bid, int nblk) {
  const int tid = otid(), wid = tid >> 6, lane = tid & 63, wr = wid >> 1, wc = wid & 1, fr = lane & 15, fq = lane >> 4;
  char* SA = smem; char* SB = smem + 49152;
  const int sa0 = (int)(uintptr_t)SA + (wr * 128 + fr) * 64 + (fq ^ swzf(fr)) * 16, sb0 = (int)(uintptr_t)SB + (wc * 64 + fr) * 64 + (fq ^ swzf(fr)) * 16;
  const int NR = nbatch * nM, ntiles = NR * nN;
  const int STN = (nN & 7) == 0 ? 8 : ((nN & 3) == 0 ? 4 : 1), STM = 64 / STN, nSN = nN / STN;
  const bool swz = ((nblk & 7) == 0) && (NR % STM == 0);
  const int lpx = nblk >> 3;
  int si = bid & 7, l = bid >> 3, tl = bid;
#pragma unroll 1
  for (;;) {
    int R, pn;
    if (swz) {
      if (si >= (NR / STM) * nSN) break;
      R = (si / nSN) * STM + l / STN; pn = (si % nSN) * STN + l % STN;
      l += lpx; if (l >= 64) { l = bid >> 3; si += 8; }
    } else {
      if (tl >= ntiles) break;
      R = tl / nN; pn = tl % nN; tl += nblk;
    }
    const int g = R / nM, rt = R % nM, brow = rt << 8, bcol = pn << 7;
    const char* A = (const char*)(A0 + (size_t)g * sA) + ((size_t)rt * nksA << 14) + tid * 16;
    const char* Bt = (const char*)(B0 + (size_t)g * sB) + ((size_t)pn * nksB << 13) + tid * 16;
    int nk = K >> 5, klim = nk;
    if (EPI == E_S5Y) { klim = 4 * (pn + 1); nk = klim + 4; }
    f32x4 acc[8][4];
#pragma unroll
    for (int m = 0; m < 8; ++m)
#pragma unroll
      for (int n = 0; n < 4; ++n) acc[m][n] = f32x4{0.f, 0.f, 0.f, 0.f};
#define GSTAGE(KK, BUF) do { const int kt_ = (EPI == E_S5Y && (KK) >= klim) ? (16 + (KK) - klim) : (KK); \
      _Pragma("unroll") for (int i = 0; i < 4; ++i) \
        __builtin_amdgcn_global_load_lds((const unsigned*)(A + ((size_t)kt_ << 14) + i * 4096), (__attribute__((address_space(3))) unsigned*)(SA + (BUF) * 16384 + tid * 16 + i * 4096), 16, 0, 0); \
      _Pragma("unroll") for (int i = 0; i < 2; ++i) \
        __builtin_amdgcn_global_load_lds((const unsigned*)(Bt + ((size_t)kt_ << 13) + i * 4096), (__attribute__((address_space(3))) unsigned*)(SB + (BUF) * 8192 + tid * 16 + i * 4096), 16, 0, 0); } while (0)
    asm volatile("s_waitcnt vmcnt(0)" ::: "memory");
    GSTAGE(0, 0);
    if (nk > 1) { GSTAGE(1, 1); asm volatile("s_waitcnt vmcnt(6)\n\ts_barrier" ::: "memory"); }
    else { asm volatile("s_waitcnt vmcnt(0)\n\ts_barrier" ::: "memory"); }
    int buf = 0, nbuf = 2;
#pragma unroll 1
    for (int kk = 0; kk < nk; ++kk) {
      const bool more = kk + 2 < nk;
      if (more) GSTAGE(kk + 2, nbuf);
      bf16x8 Bl[4], At[8];
      {
        const int bb = sb0 + buf * 8192, ab = sa0 + buf * 16384;
        asm volatile(
            "ds_read_b128 %0, %12\n\tds_read_b128 %1, %12 offset:1024\n\tds_read_b128 %2, %12 offset:2048\n\tds_read_b128 %3, %12 offset:3072\n\t"
            "ds_read_b128 %4, %13\n\tds_read_b128 %5, %13 offset:1024\n\tds_read_b128 %6, %13 offset:2048\n\tds_read_b128 %7, %13 offset:3072\n\t"
            "ds_read_b128 %8, %13 offset:4096\n\tds_read_b128 %9, %13 offset:5120\n\tds_read_b128 %10, %13 offset:6144\n\tds_read_b128 %11, %13 offset:7168\n\t"
            "s_waitcnt lgkmcnt(4)"
            : "=&v"(Bl[0]), "=&v"(Bl[1]), "=&v"(Bl[2]), "=&v"(Bl[3]), "=&v"(At[0]), "=&v"(At[1]), "=&v"(At[2]), "=&v"(At[3]),
              "=&v"(At[4]), "=&v"(At[5]), "=&v"(At[6]), "=&v"(At[7])
            : "v"(bb), "v"(ab)
            : "memory");
      }
      __builtin_amdgcn_s_setprio(1);
#pragma unroll
      for (int m = 0; m < 4; ++m)
#pragma unroll
        for (int n = 0; n < 4; ++n) acc[m][n] = __builtin_amdgcn_mfma_f32_16x16x32_bf16(Bl[n], At[m], acc[m][n], 0, 0, 0);
      __builtin_amdgcn_sched_barrier(0);
      asm volatile("s_waitcnt lgkmcnt(0)" : "+v"(At[4]), "+v"(At[5]), "+v"(At[6]), "+v"(At[7]) :: "memory");
      __builtin_amdgcn_sched_barrier(0);
#pragma unroll
      for (int m = 4; m < 8; ++m)
#pragma unroll
        for (int n = 0; n < 4; ++n) acc[m][n] = __builtin_amdgcn_mfma_f32_16x16x32_bf16(Bl[n], At[m], acc[m][n], 0, 0, 0);
      __builtin_amdgcn_s_setprio(0);
      if (more) asm volatile("s_waitcnt vmcnt(6)\n\ts_barrier" ::: "memory");
      else asm volatile("s_waitcnt vmcnt(0)\n\ts_barrier" ::: "memory");
      buf = (buf == 2) ? 0 : buf + 1; nbuf = (nbuf == 2) ? 0 : nbuf + 1;
    }
#undef GSTAGE
#pragma unroll
    for (int m = 0; m < 8; ++m)
#pragma unroll
      for (int n = 0; n < 4; ++n) {
        const int row = brow + wr * 128 + m * 16 + fr, col = bcol + wc * 64 + n * 16 + fq * 4;
        const f32x4 v = acc[m][n];
        if (EPI == E_PROJ0) {
          const uint2 pk = uint2{pk2(v[0], v[1]), pk2(v[2], v[3])};
          if (bcol < 2048) *(uint2*)(ea.outb + pj_idx(row, col)) = pk;
          else { const int cc = col - 2048; *(uint2*)(ea.ux + (size_t)(cc >> 4) * S5C * UXW + a_off(row >> 5, (row & 31) * 16 + (cc & 15), 20)) = pk; }
        }
        if (EPI == E_BF16) *(uint2*)(ea.outb + (size_t)row * ea.ldc + col) = uint2{pk2(v[0], v[1]), pk2(v[2], v[3])};
        if (EPI == E_RESID) {
          const size_t idx = (size_t)row * 1024 + col;
          const f32x4 r4 = *(const f32x4*)(ea.res + idx), g4 = *(const f32x4*)(ea.gate + (size_t)(row >> 13) * 6144 + col);
          *(f32x4*)(ea.outf + idx) = f32x4{r4[0] + g4[0] * v[0], r4[1] + g4[1] * v[1], r4[2] + g4[2] * v[2], r4[3] + g4[3] * v[3]};
        }
        if (EPI == E_GLU) {
          const uint2 yy = *(const uint2*)(ea.y5 + a_off(row, col, 16));
          const f32x4 b4 = *(const f32x4*)(ea.bias + col);
          const float y0 = __uint_as_float(yy.x << 16), y1 = __uint_as_float(yy.x & 0xffff0000u), y2 = __uint_as_float(yy.y << 16), y3 = __uint_as_float(yy.y & 0xffff0000u);
          *(uint2*)(ea.outb + a_off(row, 512 + col, 32)) = uint2{pk2(y0 * sigmoid_(v[0] + b4[0]), y1 * sigmoid_(v[1] + b4[1])), pk2(y2 * sigmoid_(v[2] + b4[2]), y3 * sigmoid_(v[3] + b4[3]))};
        }
        if (EPI == E_SWIGLU) {
          if ((n & 1) == 0) {
            const f32x4 u = acc[m][n | 1];
            const int co = (bcol >> 1) + wc * 32 + (n >> 1) * 16 + fq * 4;
            *(uint2*)(ea.outb + a_off(row, co, FF / 32)) = uint2{pk2(silu_(v[0]) * u[0], silu_(v[1]) * u[1]), pk2(silu_(v[2]) * u[2], silu_(v[3]) * u[3])};
          }
        }
        if (EPI == E_XE) *(f32x4*)(ea.outf + ((size_t)g * S5C + row) * 128 + col) = v;
        if (EPI == E_S5Y) {
          const uint2 uu = *(const uint2*)(ea.ux + (size_t)g * S5C * UXW + a_off(row, col, 20));
          const f32x4 d4 = *(const f32x4*)(ea.bias + g * 16 + (col & 15));
          const float u0 = __uint_as_float(uu.x << 16), u1 = __uint_as_float(uu.x & 0xffff0000u), u2 = __uint_as_float(uu.y << 16), u3 = __uint_as_float(uu.y & 0xffff0000u);
          *(uint2*)(ea.outb + a_off(row * 32 + (col >> 4), g * 16 + (col & 15), 16)) =
              uint2{pk2(gelu_tanh_(v[0] + d4[0] * u0), gelu_tanh_(v[1] + d4[1] * u1)), pk2(gelu_tanh_(v[2] + d4[2] * u2), gelu_tanh_(v[3] + d4[3] * u3))};
        }
      }
  }
}

__device__ __forceinline__ void s5_carry_phase(const Params& p, int bid, int nblk) {
  const float* xe = (const float*)(p.ws + OFF_XE); const float* a32 = (const float*)(p.ws + OFF_A32);
  u16* ux = (u16*)(p.ws + OFF_UX);
  for (int it = bid; it < 32; it += nblk) {
    const int idx = it * 256 + otid(), pp = idx & 63, g = (idx >> 6) & 31, b = idx >> 11;
    const float ar = a32[(g * 64 + pp) * 2], ai = a32[(g * 64 + pp) * 2 + 1];
    float xr = 0.f, xi = 0.f;
    const size_t cbase = (size_t)g * S5C + b * 256, gbase = (size_t)g * S5C * UXW;
    for (int n = 0; n < 256; n += 8) {
      float er[8], ei[8];
#pragma unroll
      for (int e = 0; e < 8; ++e) { er[e] = xe[(cbase + n + e) * 128 + pp]; ei[e] = xe[(cbase + n + e) * 128 + 64 + pp]; }
#pragma unroll
      for (int e = 0; e < 8; ++e) {
        ux[gbase + a_off(b * 256 + n + e, 512 + pp, 20)] = f2bf(xr); ux[gbase + a_off(b * 256 + n + e, 576 + pp, 20)] = f2bf(xi);
        const float nr = ar * xr - ai * xi + er[e], ni = ar * xi + ai * xr + ei[e];
        xr = nr; xi = ni;
      }
    }
  }
}

__device__ __forceinline__ int crow(int r, int hi) { return (r & 3) + 8 * (r >> 2) + 4 * hi; }
using f32x16 = __attribute__((ext_vector_type(16))) float;
__device__ __forceinline__ void unpack8(const u32x4 w, float* f) {
#pragma unroll
  for (int e = 0; e < 4; ++e) { f[2 * e] = __uint_as_float(w[e] << 16); f[2 * e + 1] = __uint_as_float(w[e] & 0xffff0000u); }
}
__device__ __forceinline__ void gdn_prep_phase(const Params& p, char* smem, int bid, int nblk) {
  const int tid = otid(), wid = tid >> 6, lane = tid & 63, fr = lane & 15, fq = lane >> 4;
  u16* qs = (u16*)smem;
  u16* ks = qs + 64 * 136;
  float* Lm = (float*)(ks + 64 * 136);
  float* gcs = Lm + 4096; float* bts = gcs + 64; float* egs = bts + 64;
  const u16* proj = (const u16*)(p.ws + OFF_PROJ);
  const float* beta = (const float*)(p.ws + OFF_BETA); const float* gg = (const float*)(p.ws + OFF_G);
#pragma unroll 1
  for (int it = bid; it < 2048; it += nblk) {
    const int n = it & 127, bh = it >> 7, b = bh >> 2, h = bh & 3;
    const size_t row0 = (size_t)b * SEQ + n * 64;
    if (wid == 0) {
      float c = gg[(row0 + lane) * 4 + h];
#pragma unroll
      for (int o = 1; o < 64; o <<= 1) { const float tt = __shfl_up(c, o); if (lane >= o) c += tt; }
      gcs[lane] = c; egs[lane] = __expf(c); bts[lane] = beta[(row0 + lane) * 4 + h];
    }
    {
      const int tok = tid >> 2, part = tid & 3, l = n * 64 + tok;
      float qo[32], ko[32]; float sq = 0.f, sk = 0.f;
#pragma unroll
      for (int cb = 0; cb < 4; ++cb) {
        const int colq = h * 128 + part * 32 + cb * 8, colk = 512 + colq;
        const size_t kblk = (size_t)M * 512 - 512;
        float aq[8], ak[8];
#pragma unroll
        for (int e = 0; e < 8; ++e) { aq[e] = 0.f; ak[e] = 0.f; }
#pragma unroll
        for (int j = 0; j < 4; ++j) {
          const int lt = l - 3 + j;
          if (lt >= 0) {
            const u16* rp = proj + ((size_t)b * SEQ + lt) * 512;
            float xq[8], xk[8];
            unpack8(*(const u32x4*)(rp + colq), xq); unpack8(*(const u32x4*)(rp + kblk + colk), xk);
            const f32x4 wq0 = *(const f32x4*)(p.hy_conv_w + j * 1536 + colq), wq1 = *(const f32x4*)(p.hy_conv_w + j * 1536 + colq + 4);
            const f32x4 wk0 = *(const f32x4*)(p.hy_conv_w + j * 1536 + colk), wk1 = *(const f32x4*)(p.hy_conv_w + j * 1536 + colk + 4);
#pragma unroll
            for (int e = 0; e < 4; ++e) { aq[e] += wq0[e] * xq[e]; aq[4 + e] += wq1[e] * xq[4 + e]; ak[e] += wk0[e] * xk[e]; ak[4 + e] += wk1[e] * xk[4 + e]; }
          }
        }
#pragma unroll
        for (int e = 0; e < 8; ++e) { const float a = silu_(aq[e]), k = silu_(ak[e]); qo[cb * 8 + e] = a; ko[cb * 8 + e] = k; sq += a * a; sk += k * k; }
      }
      sq += __shfl_xor(sq, 1); sq += __shfl_xor(sq, 2); sk += __shfl_xor(sk, 1); sk += __shfl_xor(sk, 2);
      const float rq = rsqrtf(sq + 1e-6f) * 0.08838834764831845f, rk = rsqrtf(sk + 1e-6f);
#pragma unroll
      for (int cb = 0; cb < 4; ++cb) {
        u32x4 wq, wk;
#pragma unroll
        for (int e = 0; e < 4; ++e) { wq[e] = pk2(qo[cb * 8 + 2 * e] * rq, qo[cb * 8 + 2 * e + 1] * rq); wk[e] = pk2(ko[cb * 8 + 2 * e] * rk, ko[cb * 8 + 2 * e + 1] * rk); }
        *(u32x4*)(qs + tok * 136 + part * 32 + cb * 8) = wq; *(u32x4*)(ks + tok * 136 + part * 32 + cb * 8) = wk;
      }
    }
    __syncthreads();
    {
      f32x4 akk[4], aqk[4];
#pragma unroll
      for (int nb = 0; nb < 4; ++nb) { akk[nb] = f32x4{0.f, 0.f, 0.f, 0.f}; aqk[nb] = f32x4{0.f, 0.f, 0.f, 0.f}; }
#pragma unroll
      for (int kk = 0; kk < 4; ++kk) {
        const bf16x8 ak = *(const bf16x8*)(ks + (16 * wid + fr) * 136 + kk * 32 + fq * 8);
        const bf16x8 aq = *(const bf16x8*)(qs + (16 * wid + fr) * 136 + kk * 32 + fq * 8);
#pragma unroll
        for (int nb = 0; nb < 4; ++nb) {
          const bf16x8 bk = *(const bf16x8*)(ks + (16 * nb + fr) * 136 + kk * 32 + fq * 8);
          akk[nb] = __builtin_amdgcn_mfma_f32_16x16x32_bf16(ak, bk, akk[nb], 0, 0, 0);
          aqk[nb] = __builtin_amdgcn_mfma_f32_16x16x32_bf16(aq, bk, aqk[nb], 0, 0, 0);
        }
      }
      u16* att = (u16*)(p.ws + OFF_GAT) + (size_t)it * 4096;
#pragma unroll
      for (int nb = 0; nb < 4; ++nb)
#pragma unroll
        for (int r = 0; r < 4; ++r) {
          const int i = 16 * wid + fq * 4 + r, j = 16 * nb + fr;
          const float dec = __expf(fminf(gcs[i] - gcs[j], 0.f));
          Lm[i * 64 + j] = (i > j) ? bts[i] * akk[nb][r] * dec : 0.f;
          att[i * 64 + j] = f2bf((i >= j) ? aqk[nb][r] * dec : 0.f);
        }
    }
    __syncthreads();
    {
      float x[64];
      if (tid < 128) {
        const int col = 1024 + h * 128 + tid;
        const u16* vp = proj + (size_t)2 * M * 512 + h * 128 + tid;
        const float w0 = p.hy_conv_w[col], w1 = p.hy_conv_w[1536 + col], w2 = p.hy_conv_w[2 * 1536 + col], w3 = p.hy_conv_w[3 * 1536 + col];
        float x1 = 0.f, x2 = 0.f, x3 = 0.f;
        if (n > 0) { x3 = bf2f(vp[(row0 - 3) * 512]); x2 = bf2f(vp[(row0 - 2) * 512]); x1 = bf2f(vp[(row0 - 1) * 512]); }
#pragma unroll
        for (int i = 0; i < 64; ++i) {
          const float xv = bf2f(vp[(row0 + i) * 512]);
          x[i] = silu_(w0 * x3 + w1 * x2 + w2 * x1 + w3 * xv) * bts[i];
          x3 = x2; x2 = x1; x1 = xv;
        }
      } else {
#pragma unroll
        for (int i = 0; i < 64; ++i) x[i] = bf2f(ks[i * 136 + tid - 128]) * bts[i] * egs[i];
      }
#pragma unroll
      for (int i = 1; i < 64; ++i) {
        float acc = x[i];
#pragma unroll
        for (int j4 = 0; j4 < (i + 3) / 4; ++j4) {
          const f32x4 l4 = *(const f32x4*)(Lm + i * 64 + j4 * 4);
#pragma unroll
          for (int e = 0; e < 4; ++e) if (j4 * 4 + e < i) acc -= l4[e] * x[j4 * 4 + e];
        }
        x[i] = acc;
      }
      if (tid < 128) {
        u16* ut = (u16*)(p.ws + OFF_GUT) + (size_t)it * 8192 + tid * 64;
#pragma unroll
        for (int c8 = 0; c8 < 8; ++c8) {
          u32x4 w;
#pragma unroll
          for (int e = 0; e < 4; ++e) w[e] = pk2(x[c8 * 8 + 2 * e], x[c8 * 8 + 2 * e + 1]);
          *(u32x4*)(ut + c8 * 8) = w;
        }
      } else {
        u16* wg = (u16*)(p.ws + OFF_GW) + (size_t)it * 8192 + (tid - 128);
#pragma unroll
        for (int i = 0; i < 64; ++i) wg[i * 128] = f2bf(x[i]);
      }
    }
    {
      u16* qd = (u16*)(p.ws + OFF_GQD) + (size_t)it * 8192;
#pragma unroll
      for (int k = 0; k < 4; ++k) {
        const int piece = tid + 256 * k, i = piece >> 4, d0 = (piece & 15) * 8;
        float f[8]; unpack8(*(const u32x4*)(qs + i * 136 + d0), f);
        const float e = egs[i];
        u32x4 w;
#pragma unroll
        for (int e2 = 0; e2 < 4; ++e2) w[e2] = pk2(f[2 * e2] * e, f[2 * e2 + 1] * e);
        *(u32x4*)(qd + i * 128 + d0) = w;
      }
      u16* kt = (u16*)(p.ws + OFF_GKT) + (size_t)it * 8192;
      const int dk = tid & 127, half = tid >> 7;
      const float gl = gcs[63];
#pragma unroll
      for (int c8 = 0; c8 < 4; ++c8) {
        u32x4 w;
#pragma unroll
        for (int e = 0; e < 4; ++e) {
          const int i0 = half * 32 + c8 * 8 + 2 * e;
          w[e] = pk2(bf2f(ks[i0 * 136 + dk]) * __expf(gl - gcs[i0]), bf2f(ks[(i0 + 1) * 136 + dk]) * __expf(gl - gcs[i0 + 1]));
        }
        *(u32x4*)(kt + dk * 64 + half * 32 + c8 * 8) = w;
      }
      if (tid == 0) ((float*)(p.ws + OFF_GSD))[it] = egs[63];
    }
    __syncthreads();
  }
}

__device__ __forceinline__ uint2 lds64(const char* p) { return *(const uint2*)p; }
__device__ __forceinline__ bf16x8 mk8(uint2 a, uint2 b) { u32x4 w = {a.x, a.y, b.x, b.y}; return __builtin_bit_cast(bf16x8, w); }
__device__ __forceinline__ bf16x8 pack8(const f32x16& x, int s) {
  u32x4 w = {pk2(x[8 * s], x[8 * s + 1]), pk2(x[8 * s + 2], x[8 * s + 3]), pk2(x[8 * s + 4], x[8 * s + 5]), pk2(x[8 * s + 6], x[8 * s + 7])};
  return __builtin_bit_cast(bf16x8, w);
}
__device__ __forceinline__ void gdn_scan_item(const Params& p, int bh, char* smem) {
  const int tid = otid(), wid = tid >> 6, lane = tid & 63, r32 = lane & 31, hi = lane >> 5;
  char* Wl = smem; char* KTl = smem + 16896;
  const char* gw = p.ws + OFF_GW; const char* gkt = p.ws + OFF_GKT;
  const u16* gut = (const u16*)(p.ws + OFF_GUT);
  const float* gsd = (const float*)(p.ws + OFF_GSD);
  u32x4* sbg = (u32x4*)(p.ws + OFF_PROJ); u32x4* vbg = (u32x4*)(p.ws + OFF_PROJ + (size_t)2048 * 32768);
  f32x16 S[4];
#pragma unroll
  for (int T = 0; T < 4; ++T)
#pragma unroll
    for (int r = 0; r < 16; ++r) S[T][r] = 0.f;
  u32x4 sa[8], sb_[8]; uint2 uc[8];
  const int dv = wid * 32 + r32;
#define G_LOAD(ST, IT) do { const size_t o16 = (size_t)(IT) * 16384; \
    _Pragma("unroll") for (int k = 0; k < 4; ++k) { ST[k] = *(const u32x4*)(gw + o16 + (tid + 256 * k) * 16); ST[4 + k] = *(const u32x4*)(gkt + o16 + (tid + 256 * k) * 16); } } while (0)
#define U_LOAD(IT) do { _Pragma("unroll") for (int k = 0; k < 8; ++k) uc[k] = *(const uint2*)(gut + (size_t)(IT) * 8192 + dv * 64 + 32 * (k >> 2) + 8 * (k & 3) + 4 * hi); } while (0)
#define G_WRITE(ST) do { \
    _Pragma("unroll") for (int k = 0; k < 4; ++k) { const int pc = tid + 256 * k; \
      { char* d = Wl + (pc >> 4) * 264 + (pc & 15) * 16; *(uint2*)d = uint2{ST[k][0], ST[k][1]}; *(uint2*)(d + 8) = uint2{ST[k][2], ST[k][3]}; } \
      { char* d = KTl + (pc >> 3) * 136 + (pc & 7) * 16; *(uint2*)d = uint2{ST[4 + k][0], ST[4 + k][1]}; *(uint2*)(d + 8) = uint2{ST[4 + k][2], ST[4 + k][3]}; } } } while (0)
#define SCAN_STEP(N, NXT, FAR) do { const int n = (N); const int item = bh * 128 + n; \
    const float sd_nxt = gsd[item + (n + 1 < 128 ? 1 : 0)]; \
    if (n + 2 < 128) G_LOAD(FAR, item + 2); \
    f32x16 av[2]; \
    _Pragma("unroll") for (int r = 0; r < 16; ++r) { av[0][r] = 0.f; av[1][r] = 0.f; } \
    _Pragma("unroll") for (int T = 0; T < 4; ++T) {     \
      bf16x8 wf[4]; \
      _Pragma("unroll") for (int q = 0; q < 4; ++q) { const int s = q >> 1, it = q & 1; \
        const char* wp = Wl + (32 * it + r32) * 264 + (32 * T + 16 * s + 4 * hi) * 2; wf[q] = mk8(lds64(wp), lds64(wp + 16)); } \
      __builtin_amdgcn_sched_barrier(0); \
      _Pragma("unroll") for (int s = 0; s < 2; ++s) { \
        const bf16x8 sb = pack8(S[T], s); \
        sbg[((size_t)(item * 4 + wid) * 8 + T * 2 + s) * 64 + lane] = __builtin_bit_cast(u32x4, sb); \
        av[0] = __builtin_amdgcn_mfma_f32_32x32x16_bf16(wf[s * 2], sb, av[0], 0, 0, 0); \
        av[1] = __builtin_amdgcn_mfma_f32_32x32x16_bf16(wf[s * 2 + 1], sb, av[1], 0, 0, 0); } } \
    bf16x8 vb[2][2]; \
    _Pragma("unroll") for (int it = 0; it < 2; ++it) { \
      f32x16 vn; \
      _Pragma("unroll") for (int g = 0; g < 4; ++g) { const uint2 u2 = uc[it * 4 + g]; \
        vn[4 * g] = __uint_as_float(u2.x << 16) - av[it][4 * g]; vn[4 * g + 1] = __uint_as_float(u2.x & 0xffff0000u) - av[it][4 * g + 1]; \
        vn[4 * g + 2] = __uint_as_float(u2.y << 16) - av[it][4 * g + 2]; vn[4 * g + 3] = __uint_as_float(u2.y & 0xffff0000u) - av[it][4 * g + 3]; } \
      vb[it][0] = pack8(vn, 0); vb[it][1] = pack8(vn, 1); \
      vbg[((size_t)(item * 4 + wid) * 4 + it * 2) * 64 + lane] = __builtin_bit_cast(u32x4, vb[it][0]); \
      vbg[((size_t)(item * 4 + wid) * 4 + it * 2 + 1) * 64 + lane] = __builtin_bit_cast(u32x4, vb[it][1]); } \
    if (n + 1 < 128) U_LOAD(item + 1); \
    _Pragma("unroll") for (int T = 0; T < 4; ++T) { \
      bf16x8 kf[4]; \
      _Pragma("unroll") for (int q = 0; q < 4; ++q) { const int it = q >> 1, s = q & 1; \
        const char* kp = KTl + (32 * T + r32) * 136 + (32 * it + 16 * s + 4 * hi) * 2; kf[q] = mk8(lds64(kp), lds64(kp + 16)); } \
      __builtin_amdgcn_sched_barrier(0); \
      _Pragma("unroll") for (int r = 0; r < 16; ++r) S[T][r] *= sd_cur; \
      _Pragma("unroll") for (int q3 = 0; q3 < 4; ++q3) \
        S[T] = __builtin_amdgcn_mfma_f32_32x32x16_bf16(kf[q3], vb[q3 >> 1][q3 & 1], S[T], 0, 0, 0); } \
    sd_cur = sd_nxt; \
    __syncthreads(); \
    if (n + 1 < 128) G_WRITE(NXT); \
    __syncthreads(); } while (0)
  float sd_cur = gsd[bh * 128];
  G_LOAD(sa, bh * 128); U_LOAD(bh * 128); G_WRITE(sa);
  G_LOAD(sb_, bh * 128 + 1);
  __syncthreads();
#pragma unroll 1
  for (int n2 = 0; n2 < 128; n2 += 2) {
    SCAN_STEP(n2, sb_, sa);
    SCAN_STEP(n2 + 1, sa, sb_);
  }
#undef SCAN_STEP
#undef G_LOAD
#undef G_WRITE
#undef U_LOAD
}

__device__ __forceinline__ void gdn_out_phase(const Params& p, char* smem, int bid, int nblk) {
  const int tid = otid(), wid = tid >> 6, lane = tid & 63, r32 = lane & 31, hi = lane >> 5;
  char* QDl = smem; char* ATl = smem + 16896; float* Ol = (float*)(smem + 16896 + 8704);
  const char* gqd = p.ws + OFF_GQD; const char* gat = p.ws + OFF_GAT;
  const u32x4* sbg = (const u32x4*)(p.ws + OFF_PROJ); const u32x4* vbg = (const u32x4*)(p.ws + OFF_PROJ + (size_t)2048 * 32768);
  const u16* zb = (const u16*)(p.ws + OFF_PROJ) + (size_t)3 * M * 512;
  u16* concat = (u16*)(p.ws + OFF_HN);
#pragma unroll 1
  for (int item = bid; item < 2048; item += nblk) {
    const int n = item & 127, bh = item >> 7, b = bh >> 2, h = bh & 3;
    {
      u32x4 st[6];
#pragma unroll
      for (int k = 0; k < 4; ++k) st[k] = *(const u32x4*)(gqd + (size_t)item * 16384 + (tid + 256 * k) * 16);
#pragma unroll
      for (int k = 0; k < 2; ++k) st[4 + k] = *(const u32x4*)(gat + (size_t)item * 8192 + (tid + 256 * k) * 16);
#pragma unroll
      for (int k = 0; k < 4; ++k) { const int pc = tid + 256 * k; char* d = QDl + (pc >> 4) * 264 + (pc & 15) * 16;
        *(uint2*)d = uint2{st[k][0], st[k][1]}; *(uint2*)(d + 8) = uint2{st[k][2], st[k][3]}; }
#pragma unroll
      for (int k = 0; k < 2; ++k) { const int pc = tid + 256 * k; char* d = ATl + (pc >> 3) * 136 + (pc & 7) * 16;
        *(uint2*)d = uint2{st[4 + k][0], st[4 + k][1]}; *(uint2*)(d + 8) = uint2{st[4 + k][2], st[4 + k][3]}; }
    }
    bf16x8 sb[8], vb[4];
#pragma unroll
    for (int f = 0; f < 8; ++f) sb[f] = __builtin_bit_cast(bf16x8, sbg[((size_t)(item * 4 + wid) * 8 + f) * 64 + lane]);
#pragma unroll
    for (int f = 0; f < 4; ++f) vb[f] = __builtin_bit_cast(bf16x8, vbg[((size_t)(item * 4 + wid) * 4 + f) * 64 + lane]);
    __syncthreads();
    f32x16 ao[2];
#pragma unroll
    for (int r = 0; r < 16; ++r) { ao[0][r] = 0.f; ao[1][r] = 0.f; }
#pragma unroll
    for (int T = 0; T < 4; ++T)
#pragma unroll
      for (int s = 0; s < 2; ++s) {
        const int cb = (32 * T + 16 * s + 4 * hi) * 2;
#pragma unroll
        for (int it = 0; it < 2; ++it) {
          const char* qp = QDl + (32 * it + r32) * 264 + cb;
          ao[it] = __builtin_amdgcn_mfma_f32_32x32x16_bf16(mk8(lds64(qp), lds64(qp + 16)), sb[T * 2 + s], ao[it], 0, 0, 0);
        }
      }
#pragma unroll
    for (int it2 = 0; it2 < 2; ++it2)
#pragma unroll
      for (int it = 0; it <= it2; ++it)
#pragma unroll
        for (int s = 0; s < 2; ++s) {
          const char* ap = ATl + (32 * it2 + r32) * 136 + (32 * it + 16 * s + 4 * hi) * 2;
          ao[it2] = __builtin_amdgcn_mfma_f32_32x32x16_bf16(mk8(lds64(ap), lds64(ap + 16)), vb[it * 2 + s], ao[it2], 0, 0, 0);
        }
#pragma unroll
    for (int it = 0; it < 2; ++it)
#pragma unroll
      for (int r = 0; r < 16; ++r) Ol[(32 * it + crow(r, hi)) * 132 + wid * 32 + r32] = ao[it][r];
    __syncthreads();
    {
      const int tok = tid >> 2, part = tid & 3;
      const int row = b * SEQ + n * 64 + tok;
      f32x4 a[8]; float ss = 0.f;
#pragma unroll
      for (int k = 0; k < 8; ++k) { a[k] = *(const f32x4*)(Ol + tok * 132 + part * 32 + k * 4); ss += a[k][0] * a[k][0] + a[k][1] * a[k][1] + a[k][2] * a[k][2] + a[k][3] * a[k][3]; }
      ss += __shfl_xor(ss, 1); ss += __shfl_xor(ss, 2);
      const float rs = rsqrtf(ss * (1.f / 128.f) + 1e-6f);
      const u16* zp = zb + (size_t)row * 512 + h * 128 + part * 32;
      const float* hw = p.hy_head_norm_w + part * 32;
      const int ccol = h * 128 + part * 32;
#pragma unroll
      for (int k = 0; k < 4; ++k) {
        float zf[8]; unpack8(*(const u32x4*)(zp + k * 8), zf);
        const f32x4 h0 = *(const f32x4*)(hw + k * 8), h1 = *(const f32x4*)(hw + k * 8 + 4);
        const f32x4 x0 = a[2 * k], x1 = a[2 * k + 1];
        u32x4 w;
        w[0] = pk2(x0[0] * rs * h0[0] * silu_(zf[0]), x0[1] * rs * h0[1] * silu_(zf[1]));
        w[1] = pk2(x0[2] * rs * h0[2] * silu_(zf[2]), x0[3] * rs * h0[3] * silu_(zf[3]));
        w[2] = pk2(x1[0] * rs * h1[0] * silu_(zf[4]), x1[1] * rs * h1[1] * silu_(zf[5]));
        w[3] = pk2(x1[2] * rs * h1[2] * silu_(zf[6]), x1[3] * rs * h1[3] * silu_(zf[7]));
        *(u32x4*)(concat + a_off(row, ccol + k * 8, 32)) = w;
      }
    }
    __syncthreads();
  }
}

using s16x4 = __attribute__((ext_vector_type(4))) short;
#define KSWZ(row, colB) ((row) * 256 + ((colB) ^ (((row) & 7) << 4)))
#define SBAR() __builtin_amdgcn_sched_barrier(0)
__device__ __forceinline__ unsigned cvtpk(float lo, float hi) { unsigned r; asm volatile("v_cvt_pk_bf16_f32 %0, %1, %2" : "=v"(r) : "v"(lo), "v"(hi)); return r; }
__device__ __forceinline__ int v_st(int k, int c) { const int kk = (k & ~0xC) | ((k & 4) << 1) | ((k & 8) >> 1); return ((kk >> 3) * 4 + (c >> 5)) * 512 + ((kk & 7) * 32 + (c & 31)) * 2; }
__device__ __forceinline__ int v_rd_base(int lane) { return ((lane & 3) << 3) | (((lane >> 2) & 3) << 6) | (((lane >> 4) & 1) << 5) | (((lane >> 5) & 1) << 8); }
constexpr int v_rd_off(int d0, int ks, int half) { return d0 * 512 + ks * 4096 + half * 2048; }
template <int OFF> __device__ __forceinline__ s16x4 tr_read(int vb) {
  s16x4 r; asm volatile("ds_read_b64_tr_b16 %0, %1 offset:%2" : "=&v"(r) : "v"(vb), "i"(OFF) : "memory"); return r;
}
template <int D0> __device__ __forceinline__ void pv_one(f32x16& od, int vb, bf16x8 pa0, bf16x8 pa1, bf16x8 pa2, bf16x8 pa3) {
  const s16x4 l0 = tr_read<v_rd_off(D0, 0, 0)>(vb), h0 = tr_read<v_rd_off(D0, 0, 1)>(vb), l1 = tr_read<v_rd_off(D0, 1, 0)>(vb), h1 = tr_read<v_rd_off(D0, 1, 1)>(vb);
  const s16x4 l2 = tr_read<v_rd_off(D0, 2, 0)>(vb), h2 = tr_read<v_rd_off(D0, 2, 1)>(vb), l3 = tr_read<v_rd_off(D0, 3, 0)>(vb), h3 = tr_read<v_rd_off(D0, 3, 1)>(vb);
  asm volatile("s_waitcnt lgkmcnt(0)" ::: "memory"); SBAR();
#define PK(L, H) (bf16x8){L[0], L[1], L[2], L[3], H[0], H[1], H[2], H[3]}
  od = __builtin_amdgcn_mfma_f32_32x32x16_bf16(pa0, PK(l0, h0), od, 0, 0, 0);
  od = __builtin_amdgcn_mfma_f32_32x32x16_bf16(pa1, PK(l1, h1), od, 0, 0, 0);
  od = __builtin_amdgcn_mfma_f32_32x32x16_bf16(pa2, PK(l2, h2), od, 0, 0, 0);
  od = __builtin_amdgcn_mfma_f32_32x32x16_bf16(pa3, PK(l3, h3), od, 0, 0, 0);
#undef PK
}
__device__ __forceinline__ float pl32_other(float a, float b, int hi) {
  auto rr = __builtin_amdgcn_permlane32_swap(__float_as_uint(a), __float_as_uint(b), false, false);
  return __uint_as_float(hi ? rr[0] : rr[1]);
}
__device__ __forceinline__ void sb_half(f32x16& pz, float& run, bool need_mask, int kb, int t, int hi) {
  constexpr float C2 = 0.08838834764831845f * 1.4426950408889634f;
  f32x16 l;
#pragma unroll
  for (int r = 0; r < 16; ++r) {
    const float e = __builtin_amdgcn_exp2f(fminf(pz[r] * C2, 60.f));
    l[r] = __builtin_amdgcn_rcpf(1.f + e);
    pz[r] = e;
  }
  if (need_mask) {
#pragma unroll
    for (int r = 0; r < 16; ++r) { if (kb + crow(r, hi) >= t) { l[r] = 1.f; pz[r] = 0.f; } }
  }
#pragma unroll
  for (int g = 0; g < 4; ++g) { l[4 * g + 2] *= l[4 * g + 3]; l[4 * g + 1] *= l[4 * g + 2]; l[4 * g] *= l[4 * g + 1]; }
  const float cs3 = l[12], cs2 = l[8] * cs3, cs1 = l[4] * cs2, cs0 = l[0] * cs1;
  const float off0 = cs1 * pl32_other(cs0, cs1, hi) * run;
  const float off1 = cs2 * pl32_other(cs1, cs2, hi) * run;
  const float off2 = cs3 * pl32_other(cs2, cs3, hi) * run;
  const float off3 = pl32_other(cs3, 1.f, hi) * run;
  float tot;
  { auto rr = __builtin_amdgcn_permlane32_swap(__float_as_uint(cs0), __float_as_uint(cs0), false, false); tot = __uint_as_float(rr[0]) * __uint_as_float(rr[1]); }
#pragma unroll
  for (int r = 0; r < 4; ++r) {
    pz[r] = pz[r] * l[r] * off0; pz[4 + r] = pz[4 + r] * l[4 + r] * off1;
    pz[8 + r] = pz[8 + r] * l[8 + r] * off2; pz[12 + r] = pz[12 + r] * l[12 + r] * off3;
  }
  run *= tot;
}

__device__ __forceinline__ void attn_phase(const Params& p, char* smem, int bid, int nblk) {
  const int tid = otid(), wid = tid >> 6, lane = tid & 63, r32 = lane & 31, hi = lane >> 5;
  char* K_lds0 = smem; char* V_lds0 = smem + 16384;
  const u16* qkv = (const u16*)(p.ws + OFF_PROJ);
  u16* ao = (u16*)(p.ws + OFF_HN);
  const int sr = tid >> 4, sc = (tid & 15) * 8;
  const int vb00 = (int)(uintptr_t)V_lds0 + v_rd_base(lane);
  for (int k = 0; k * nblk < 2048; ++k) {
    const int i = (k & 1) ? ((k + 1) * nblk - 1 - bid) : (k * nblk + bid);
    if (i >= 2048) continue;
    const int j = 63 - (i >> 5), bh = i & 31, b = bh >> 3, h = bh & 7;
    const int i0 = j * 128;
    const size_t rowb = (size_t)b * SEQ;
    const int t = i0 + wid * 32 + r32, tmin = i0 + wid * 32, tmax = tmin + 31;
    bf16x8 qr[8];
    {
      const u16* qp = qkv + (rowb + t) * 3072 + h * 128 + hi * 8;
#pragma unroll
      for (int d0 = 0; d0 < 8; ++d0) qr[d0] = *(const bf16x8*)(qp + d0 * 16);
    }
    f32x16 o[4];
#pragma unroll
    for (int d = 0; d < 4; ++d)
#pragma unroll
      for (int r = 0; r < 16; ++r) o[d][r] = 0.f;
    float run = 1.f;
    const u16* kbase = qkv + rowb * 3072 + 1024 + h * 128 + sc;
    u32x4 stk[4], stv[4];
#define SLOAD(KT) do { _Pragma("unroll") for (int ii = 0; ii < 4; ++ii) { const u16* kp = kbase + (size_t)((KT) * 64 + sr + 16 * ii) * 3072; \
      stk[ii] = *(const u32x4*)kp; stv[ii] = *(const u32x4*)(kp + 1024); } } while (0)
#define SWRITE(B) do { _Pragma("unroll") for (int ii = 0; ii < 4; ++ii) { const int row = sr + 16 * ii; \
      *(u32x4*)(K_lds0 + (B) * 32768 + KSWZ(row, sc * 2)) = stk[ii]; *(u32x4*)(V_lds0 + (B) * 32768 + v_st(row, sc)) = stv[ii]; } } while (0)
    const int NT = 2 * j + 2;
    __syncthreads();
    SLOAD(NT - 1); SWRITE(0); __syncthreads();
    int cur = 0;
    for (int kt = NT - 1; kt >= 0; --kt) {
      const int k0 = kt * 64;
      const char* K_lds = K_lds0 + cur * 32768; const int vb0 = vb00 + cur * 32768;
      if (kt > 0) SLOAD(kt - 1);
      if (k0 <= tmax) {
        bf16x8 pa0, pa1, pa2, pa3;
#define PK4(P, BASE, OUT) do { unsigned a0 = cvtpk(P[BASE + 0], P[BASE + 1]), a1 = cvtpk(P[BASE + 2], P[BASE + 3]); \
    unsigned b0_ = cvtpk(P[BASE + 4], P[BASE + 5]), b1_ = cvtpk(P[BASE + 6], P[BASE + 7]); \
    auto r0 = __builtin_amdgcn_permlane32_swap(a0, b0_, false, false); auto r1 = __builtin_amdgcn_permlane32_swap(a1, b1_, false, false); \
    u32x4 w = {r0[0], r1[0], r0[1], r1[1]}; OUT = *reinterpret_cast<bf16x8*>(&w); } while (0)
        if (k0 + 32 <= tmax) {
          f32x16 pz;
#pragma unroll
          for (int r = 0; r < 16; ++r) pz[r] = 0.f;
#pragma unroll
          for (int d0 = 0; d0 < 8; ++d0) {
            const bf16x8 kf = *(const bf16x8*)(K_lds + KSWZ(32 + r32, (d0 * 16 + hi * 8) * 2));
            pz = __builtin_amdgcn_mfma_f32_32x32x16_bf16(kf, qr[d0], pz, 0, 0, 0);
          }
          sb_half(pz, run, k0 + 63 >= tmin, k0 + 32, t, hi);
          PK4(pz, 0, pa2); PK4(pz, 8, pa3);
        } else {
          pa2 = bf16x8{0, 0, 0, 0, 0, 0, 0, 0}; pa3 = pa2;
        }
        {
          f32x16 pz;
#pragma unroll
          for (int r = 0; r < 16; ++r) pz[r] = 0.f;
#pragma unroll
          for (int d0 = 0; d0 < 8; ++d0) {
            const bf16x8 kf = *(const bf16x8*)(K_lds + KSWZ(r32, (d0 * 16 + hi * 8) * 2));
            pz = __builtin_amdgcn_mfma_f32_32x32x16_bf16(kf, qr[d0], pz, 0, 0, 0);
          }
          sb_half(pz, run, k0 + 31 >= tmin, k0, t, hi);
          PK4(pz, 0, pa0); PK4(pz, 8, pa1);
        }
#undef PK4
        pv_one<0>(o[0], vb0, pa0, pa1, pa2, pa3); pv_one<1>(o[1], vb0, pa0, pa1, pa2, pa3);
        pv_one<2>(o[2], vb0, pa0, pa1, pa2, pa3); pv_one<3>(o[3], vb0, pa0, pa1, pa2, pa3);
      }
      if (kt > 0) SWRITE(cur ^ 1);
      __syncthreads();
      cur ^= 1;
    }
#undef SLOAD
#undef SWRITE
    {
      const int orow0 = (int)rowb + i0 + wid * 32;
#pragma unroll
      for (int r = 0; r < 16; ++r) {
        const int orow = crow(r, hi);
#pragma unroll
        for (int d0 = 0; d0 < 4; ++d0) ao[a_off(orow0 + orow, h * 128 + d0 * 32 + r32, 32)] = f2bf(o[d0][r]);
      }
    }
  }
}

#define XB_TMO      128
#define XB_XCNT(j)  (256  + 64 * (j))
#define XB_XSUB(j)  (1280 + 64 * (j))
#define XB_XGEN(j)  (2304 + 64 * (j))
#define XB_TOP      3328
#define XB_TOPGEN   3392
#define XCD_BAR_WORDS 3456
#define XB_SPIN_CAP (1u << 23)
#define LAS __attribute__((address_space(3)))
__device__ __forceinline__ unsigned xb_ld(unsigned* p)              { return __hip_atomic_load(p, __ATOMIC_RELAXED, __HIP_MEMORY_SCOPE_AGENT); }
__device__ __forceinline__ unsigned xb_add(unsigned* p, unsigned v) { return __hip_atomic_fetch_add(p, v, __ATOMIC_RELAXED, __HIP_MEMORY_SCOPE_AGENT); }
__device__ __forceinline__ unsigned xb_xcc_id() { return (unsigned)__builtin_amdgcn_s_getreg((3 << 11) | 20) & 0xFu; }
#define XB_SPIN(cond, bar) do { unsigned _sp = 0; while (cond) { __builtin_amdgcn_s_sleep(1); \
    if ((++_sp & 255u) == 0u) { if (xb_ld(&(bar)[XB_TMO])) break; if (_sp > XB_SPIN_CAP) { atomicAdd(&(bar)[XB_TMO], 1u); break; } } } } while (0)
struct XcdBarrier { unsigned* bar; unsigned x; volatile LAS unsigned* st; };
__device__ __forceinline__ XcdBarrier xcd_barrier_post(unsigned* bar, volatile LAS unsigned* st) {
  XcdBarrier b; b.bar = bar; b.x = xb_xcc_id(); b.st = st;
  if (__builtin_amdgcn_workitem_id_x() == 0) (void)xb_add(&bar[XB_XCNT(b.x)], 1u);
  return b;
}
__device__ __forceinline__ void xcd_barrier_complete(unsigned* bar, unsigned x, unsigned& nloc, unsigned& nx) {
  const unsigned G = gridDim.x * gridDim.y * gridDim.z;
  unsigned sum, cnt, mine, sp = 0u;
  for (;;) {
    sum = 0u; cnt = 0u; mine = 0u;
#pragma unroll
    for (unsigned j = 0; j < 16; ++j) { const unsigned c = xb_ld(&bar[XB_XCNT(j)]); sum += c; cnt += (c > 0u) ? 1u : 0u; mine = (j == x) ? c : mine; }
    if (sum == G) break;
    __builtin_amdgcn_s_sleep(1);
    if ((++sp & 255u) == 0u) { if (xb_ld(&bar[XB_TMO])) break; if (sp > XB_SPIN_CAP) { atomicAdd(&bar[XB_TMO], 1u); break; } }
  }
  nloc = mine > 0u ? mine : 1u; nx = cnt > 0u ? cnt : 1u;
}
__device__ __forceinline__ void xcd_barrier(const XcdBarrier& b) {
  asm volatile("s_waitcnt vmcnt(0)" ::: "memory");
  __syncthreads();
  if (__builtin_amdgcn_workitem_id_x() == 0) {
    unsigned* bar = b.bar;
    __builtin_amdgcn_s_waitcnt(0);
    unsigned nloc = b.st[0], nx = b.st[1];
    if (nloc == 0u) { xcd_barrier_complete(bar, b.x, nloc, nx); b.st[0] = nloc; b.st[1] = nx; }
    const unsigned old = xb_add(&bar[XB_XSUB(b.x)], 1u);
    const unsigned gen = old / nloc;
    if (old + 1u == (gen + 1u) * nloc) {
      __builtin_amdgcn_fence(__ATOMIC_RELEASE, "agent");
      asm volatile("s_waitcnt vmcnt(0)" ::: "memory");
      const unsigned og = xb_add(&bar[XB_TOP], 1u);
      const unsigned tg = og / nx;
      if (og + 1u == (tg + 1u) * nx) xb_add(&bar[XB_TOPGEN], 1u);
      else XB_SPIN(xb_ld(&bar[XB_TOPGEN]) == tg, bar);
      __builtin_amdgcn_fence(__ATOMIC_ACQUIRE, "agent");
      xb_add(&bar[XB_XGEN(b.x)], 1u);
      asm volatile("s_waitcnt vmcnt(0)" ::: "memory");
    } else {
      XB_SPIN(xb_ld(&bar[XB_XGEN(b.x)]) == gen, bar);
      __builtin_amdgcn_fence(__ATOMIC_ACQUIRE, "agent");
      asm volatile("s_waitcnt vmcnt(0)" ::: "memory");
    }
  }
  __syncthreads();
}

__global__ void __launch_bounds__(256, 2) mega(Params p) {
  __shared__ __attribute__((aligned(16))) char smem[SMEM_BYTES];
  __shared__ uint4 xb_words;
  const int bid = blockIdx.x, nblk = gridDim.x;
  char* ws = p.ws;
  if (__builtin_amdgcn_workitem_id_x() == 0) xb_words = make_uint4(0u, 0u, 0u, 0u);
  __syncthreads();
  const XcdBarrier xbar = xcd_barrier_post((unsigned*)(ws + OFF_BAR), (volatile LAS unsigned*)&xb_words);
  const float* mod = (const float*)(ws + OFF_MOD);
  u16* hn = (u16*)(ws + OFF_HN);
#define PH_BEGIN(n) if (p.phase_lo <= (n) && (n) < p.phase_hi) {
#define PH_END(n) if ((n) + 1 < p.phase_hi) { if ((n) == 0) cg::this_grid().sync(); else xcd_barrier(xbar); } }
  PH_BEGIN(0) phase0(p, smem, bid, nblk); PH_END(0)
  PH_BEGIN(1) norm_phase<1>(p, p.x, p.norm_mix_w, mod, 0, 1024, smem, bid, nblk); PH_END(1)
  PH_BEGIN(2) { EpiArgs ea{}; ea.outb = (u16*)(ws + OFF_PROJ); ea.ux = (u16*)(ws + OFF_UX);
        gemm_phase<E_PROJ0>(hn, 32, 0, (const u16*)(ws + OFF_WT_HYIN), 32, 0, 1024, M / 256, PN / 128, 1, ea, smem, bid, nblk); } PH_END(2)
  PH_BEGIN(3) { EpiArgs ea{}; ea.outf = (float*)(ws + OFF_XE);
        gemm_phase<E_XE>((const u16*)(ws + OFF_UX), 20, (size_t)S5C * UXW, (const u16*)(ws + OFF_EG), 16, (size_t)128 * 512, 512, S5C / 256, 1, 32, ea, smem, bid, nblk); } PH_END(3)
  PH_BEGIN(4) { s5_carry_phase(p, bid, nblk); gdn_prep_phase(p, smem, bid, nblk); } PH_END(4)
  PH_BEGIN(5) {
        if (bid < 16) { gdn_scan_item(p, bid, smem); }
        else { EpiArgs ea{}; ea.outb = (u16*)(ws + OFF_Y5); ea.ux = (u16*)(ws + OFF_UX); ea.bias = p.s5_d;
          gemm_phase<E_S5Y>((const u16*)(ws + OFF_UX), 20, (size_t)S5C * UXW, (const u16*)(ws + OFF_MF), 20, (size_t)512 * UXW, UXW, S5C / 256, 4, 32, ea, smem, bid - 16, nblk - 16); }
      } PH_END(5)
  PH_BEGIN(6) { gdn_out_phase(p, smem, bid, nblk); __syncthreads();
 EpiArgs ea{}; ea.outb = hn; ea.y5 = (const u16*)(ws + OFF_Y5); ea.bias = p.s5_glu_b;
        gemm_phase<E_GLU>((const u16*)(ws + OFF_Y5), 16, 0, (const u16*)(ws + OFF_WT_GLU), 16, 0, 512, M / 256, 4, 1, ea, smem, bid, nblk); } PH_END(6)
  PH_BEGIN(8) { EpiArgs ea{}; ea.outf = p.out; ea.res = p.x; ea.gate = mod + 2048;
        gemm_phase<E_RESID>(hn, 32, 0, (const u16*)(ws + OFF_WT_HYOUT), 32, 0, 1024, M / 256, 8, 1, ea, smem, bid, nblk); } PH_END(8)
  PH_BEGIN(9) norm_phase<0>(p, p.out, p.norm_ffn_w, mod, 3072, 4096, smem, bid, nblk); PH_END(9)
  PH_BEGIN(10) { EpiArgs ea{}; ea.outb = (u16*)(ws + OFF_PROJ);
        gemm_phase<E_SWIGLU>(hn, 32, 0, (const u16*)(ws + OFF_WT_FFNIN), 32, 0, 1024, M / 256, 2 * FF / 128, 1, ea, smem, bid, nblk); } PH_END(10)
  PH_BEGIN(11) { EpiArgs ea{}; ea.outf = p.out; ea.res = p.out; ea.gate = mod + 5120;
        gemm_phase<E_RESID>((const u16*)(ws + OFF_PROJ), FF / 32, 0, (const u16*)(ws + OFF_WT_FFNOUT), FF / 32, 0, FF, M / 256, 8, 1, ea, smem, bid, nblk); } PH_END(11)
  PH_BEGIN(12) norm_phase<0>(p, p.out, p.norm_mix_w + 1024, mod + 4 * 6144, 0, 1024, smem, bid, nblk); PH_END(12)
  PH_BEGIN(13) { EpiArgs ea{}; ea.outb = (u16*)(ws + OFF_PROJ); ea.ldc = 3072;
        gemm_phase<E_BF16>(hn, 32, 0, (const u16*)(ws + OFF_WT_SBIN), 32, 0, 1024, M / 256, 24, 1, ea, smem, bid, nblk); } PH_END(13)
  PH_BEGIN(14) attn_phase(p, smem, bid, nblk); PH_END(14)
  PH_BEGIN(15) { EpiArgs ea{}; ea.outf = p.out; ea.res = p.out; ea.gate = mod + 4 * 6144 + 2048;
        gemm_phase<E_RESID>(hn, 32, 0, (const u16*)(ws + OFF_WT_SBOUT), 32, 0, 1024, M / 256, 8, 1, ea, smem, bid, nblk); } PH_END(15)
  PH_BEGIN(16) norm_phase<0>(p, p.out, p.norm_ffn_w + 1024, mod + 4 * 6144, 3072, 4096, smem, bid, nblk); PH_END(16)
  PH_BEGIN(17) { EpiArgs ea{}; ea.outb = (u16*)(ws + OFF_PROJ);
        gemm_phase<E_SWIGLU>(hn, 32, 0, (const u16*)(ws + OFF_WT_FFNIN + SZ_WT_FFNIN), 32, 0, 1024, M / 256, 2 * FF / 128, 1, ea, smem, bid, nblk); } PH_END(17)
  PH_BEGIN(18) { EpiArgs ea{}; ea.outf = p.out; ea.res = p.out; ea.gate = mod + 4 * 6144 + 5120;
        gemm_phase<E_RESID>((const u16*)(ws + OFF_PROJ), FF / 32, 0, (const u16*)(ws + OFF_WT_FFNOUT + SZ_WT_FFNOUT), FF / 32, 0, FF, M / 256, 8, 1, ea, smem, bid, nblk); } PH_END(18)
  PH_BEGIN(19) norm_phase<2>(p, p.out, p.final_norm_w, mod, 0, 0, smem, bid, nblk); PH_END(19)
}

extern "C" void kernel_launch(void* const* d_in, const int* in_sizes, int n_in, void* d_out, int out_size, void* d_ws, size_t ws_size,
                              hipStream_t stream) {
  static int grid_blocks = 0;
  if (!grid_blocks) {
    int dev = 0, cus = 0, per_cu = 0;
    hipGetDevice(&dev);
    hipDeviceGetAttribute(&cus, hipDeviceAttributeMultiprocessorCount, dev);
    hipOccupancyMaxActiveBlocksPerMultiprocessor(&per_cu, mega, 256, 0);
    if (per_cu > 2) per_cu = 2;
    if (per_cu < 1) per_cu = 1;
    grid_blocks = cus * per_cu;
  }
  Params p{};
  const float* const* in = (const float* const*)d_in;
  p.x = in[0]; p.c = in[1]; p.ada_w = in[2]; p.ada_b = in[3]; p.norm_mix_w = in[4]; p.norm_ffn_w = in[5]; p.ffn_w_in = in[6]; p.ffn_w_out = in[7];
  p.hy_w_in = in[8]; p.hy_conv_w = in[9]; p.hy_a_log = in[10]; p.hy_dt_bias = in[11]; p.hy_head_norm_w = in[12];
  p.s5_lam_re = in[13]; p.s5_lam_im = in[14]; p.s5_log_dt = in[15]; p.s5_b_re = in[16]; p.s5_b_im = in[17]; p.s5_c_re = in[18]; p.s5_c_im = in[19];
  p.s5_d = in[20]; p.s5_glu_w = in[21]; p.s5_glu_b = in[22]; p.hy_w_out = in[23]; p.sb_w_in = in[24]; p.sb_w_out = in[25]; p.final_norm_w = in[26];
  p.out = (float*)d_out; p.ws = (char*)d_ws;
#if ONE_LAUNCH
  p.phase_lo = 0; p.phase_hi = NPHASE;
  (void)hipMemsetAsync((char*)d_ws + OFF_BAR, 0, (size_t)XCD_BAR_WORDS_C * 4, stream);
  void* args[] = {&p};
  hipError_t e = hipLaunchCooperativeKernel((void*)mega, dim3(grid_blocks), dim3(256), args, 0, stream);
  if (e != hipSuccess) fprintf(stderr, "cooperative launch failed: %s (grid %d)\n", hipGetErrorString(e), grid_blocks);
#else
  for (int ph = 0; ph < NPHASE; ++ph) {
    p.phase_lo = ph; p.phase_hi = ph + 1;
    hipLaunchKernelGGL(mega, dim3(grid_blocks), dim3(256), 0, stream, p);
  }
#endif
}
```

```cpp
#include <hip/hip_runtime.h>
#include <hip/hip_cooperative_groups.h>
#include <stdint.h>
#include <cstdio>
namespace cg = cooperative_groups;

#ifndef ONE_LAUNCH
#define ONE_LAUNCH 1
#endif

typedef unsigned short u16;
using bf16x8 = __attribute__((ext_vector_type(8))) short;
using f32x4 = __attribute__((ext_vector_type(4))) float;
using u32x4 = __attribute__((ext_vector_type(4))) unsigned;

constexpr int D = 1024, NB = 4, SEQ = 8192, M = NB * SEQ, FF = 2816, EIN = 2568, PN = 2560, PJ = 2048;
constexpr int NPHASE = 20;
constexpr int XCD_BAR_WORDS_C = 3456;
constexpr int S5T = 32, S5C = M / S5T, UXW = 640;

constexpr size_t SZ_WT_HYIN = (size_t)PN * 1024 * 2, SZ_WT_SQ = (size_t)1024 * 1024 * 2, SZ_WT_GLU = (size_t)512 * 512 * 2;
constexpr size_t SZ_WT_FFNIN = (size_t)2 * FF * 1024 * 2, SZ_WT_FFNOUT = (size_t)1024 * FF * 2, SZ_WT_SBIN = (size_t)3072 * 1024 * 2;
constexpr size_t OFF_WT_HYIN = 0;
constexpr size_t OFF_WT_HYOUT = OFF_WT_HYIN + SZ_WT_HYIN;
constexpr size_t OFF_WT_GLU = OFF_WT_HYOUT + SZ_WT_SQ;
constexpr size_t OFF_WT_FFNIN = OFF_WT_GLU + SZ_WT_GLU;
constexpr size_t OFF_WT_FFNOUT = OFF_WT_FFNIN + 2 * SZ_WT_FFNIN;
constexpr size_t OFF_WT_SBIN = OFF_WT_FFNOUT + 2 * SZ_WT_FFNOUT;
constexpr size_t OFF_WT_SBOUT = OFF_WT_SBIN + SZ_WT_SBIN;
constexpr size_t OFF_MOD = OFF_WT_SBOUT + SZ_WT_SQ;
constexpr size_t OFF_BETA = OFF_MOD + (size_t)2 * 4 * 6144 * 4;
constexpr size_t OFF_G = OFF_BETA + (size_t)M * 4 * 4;
constexpr size_t OFF_HN = OFF_G + (size_t)M * 4 * 4;
constexpr size_t OFF_Y5 = OFF_HN + (size_t)M * 1024 * 2;
constexpr size_t OFF_UX = OFF_Y5 + (size_t)M * 512 * 2;
constexpr size_t OFF_MF = OFF_UX + (size_t)32 * S5C * UXW * 2;
constexpr size_t OFF_EG = OFF_MF + (size_t)32 * 512 * UXW * 2;
constexpr size_t OFF_XE = OFF_EG + (size_t)32 * 128 * 512 * 2;
constexpr size_t OFF_A32 = OFF_XE + (size_t)32 * S5C * 128 * 4;
constexpr size_t OFF_PROJ = OFF_A32 + (size_t)32 * 64 * 2 * 4;
constexpr size_t OFF_GW = OFF_PROJ + (size_t)M * PJ * 2;
constexpr size_t OFF_GQD = OFF_GW + (size_t)2048 * 8192 * 2;
constexpr size_t OFF_GKT = OFF_GQD + (size_t)2048 * 8192 * 2;
constexpr size_t OFF_GUT = OFF_GKT + (size_t)2048 * 8192 * 2;
constexpr size_t OFF_GAT = OFF_GUT + (size_t)2048 * 8192 * 2;
constexpr size_t OFF_GSD = OFF_GAT + (size_t)2048 * 4096 * 2;
constexpr size_t OFF_BAR = OFF_GSD + (size_t)2048 * 4;
constexpr size_t WS_TOTAL = OFF_BAR + (size_t)XCD_BAR_WORDS_C * 4;
static_assert((size_t)M * 3072 * 2 <= WS_TOTAL - OFF_PROJ, "QKV alias");
static_assert(WS_TOTAL <= (size_t)512 * 1024 * 1024, "workspace too large");

struct Params {
  const float *x, *c, *ada_w, *ada_b, *norm_mix_w, *norm_ffn_w, *ffn_w_in, *ffn_w_out;
  const float *hy_w_in, *hy_conv_w, *hy_a_log, *hy_dt_bias, *hy_head_norm_w;
  const float *s5_lam_re, *s5_lam_im, *s5_log_dt, *s5_b_re, *s5_b_im, *s5_c_re, *s5_c_im, *s5_d, *s5_glu_w, *s5_glu_b, *hy_w_out;
  const float *sb_w_in, *sb_w_out, *final_norm_w;
  float* out;
  char* ws;
  int phase_lo, phase_hi;
};

constexpr int SMEM_BYTES = 73728;

__device__ __forceinline__ int otid() { int t = __builtin_amdgcn_workitem_id_x(); asm volatile("" : "+v"(t)); return t; }
__device__ __forceinline__ u16 f2bf(float x) { unsigned u = __float_as_uint(x); u += 0x7fffu + ((u >> 16) & 1u); return (u16)(u >> 16); }
typedef __bf16 bf16v2 __attribute__((ext_vector_type(2)));
typedef float f32v2 __attribute__((ext_vector_type(2)));
__device__ __forceinline__ unsigned pk2(float a, float b) { f32v2 v = {a, b}; bf16v2 r = __builtin_convertvector(v, bf16v2); return __builtin_bit_cast(unsigned, r); }
__device__ __forceinline__ float bf2f(u16 v) { return __uint_as_float(((unsigned)v) << 16); }
__device__ __forceinline__ float sigmoid_(float x) { return __builtin_amdgcn_rcpf(1.f + __expf(-x)); }
__device__ __forceinline__ float silu_(float x) { return x * sigmoid_(x); }
__device__ __forceinline__ float softplus_(float x) { return fmaxf(x, 0.f) + log1pf(__expf(-fabsf(x))); }
__device__ __forceinline__ float gelu_tanh_(float y) { return 0.5f * y * (1.f + tanhf(0.7978845608028654f * (y + 0.044715f * y * y * y))); }

__device__ __forceinline__ size_t pj_idx(int row, int col) { return (size_t)(col >> 9) * ((size_t)M * 512) + (size_t)row * 512 + (col & 511); }
__device__ __forceinline__ int swzf(int r) { return (4 - ((r >> 2) & 3)) & 3; }
__device__ __forceinline__ int swzc(int r, int c) { return ((((c >> 3) ^ swzf(r)) << 3) | (c & 7)); }
__device__ __forceinline__ size_t a_off(int row, int col, int nks) { return ((size_t)((row >> 8) * nks + (col >> 5)) << 13) + ((row & 255) << 5) + swzc(row, col & 31); }
__device__ __forceinline__ size_t b_off(int n, int k, int nks) { return ((size_t)((n >> 7) * nks + (k >> 5)) << 12) + ((n & 127) << 5) + swzc(n, k & 31); }

struct TrJob { const float* src; u16* dst; int K, Nsrc, Nd, mode; };
__device__ __forceinline__ TrJob get_job(const Params& p, int j) {
  TrJob t;
  switch (j) {
    case 0: t = {p.hy_w_in, (u16*)(p.ws + OFF_WT_HYIN), 1024, EIN, PN, 1}; break;
    case 1: t = {p.hy_w_out, (u16*)(p.ws + OFF_WT_HYOUT), 1024, 1024, 1024, 0}; break;
    case 2: t = {p.s5_glu_w, (u16*)(p.ws + OFF_WT_GLU), 512, 512, 512, 0}; break;
    case 3: t = {p.ffn_w_in, (u16*)(p.ws + OFF_WT_FFNIN), 1024, 2 * FF, 2 * FF, 2}; break;
    case 4: t = {p.ffn_w_in + (size_t)1024 * 2 * FF, (u16*)(p.ws + OFF_WT_FFNIN + SZ_WT_FFNIN), 1024, 2 * FF, 2 * FF, 2}; break;
    case 5: t = {p.ffn_w_out, (u16*)(p.ws + OFF_WT_FFNOUT), FF, 1024, 1024, 0}; break;
    case 6: t = {p.ffn_w_out + (size_t)FF * 1024, (u16*)(p.ws + OFF_WT_FFNOUT + SZ_WT_FFNOUT), FF, 1024, 1024, 0}; break;
    case 7: t = {p.sb_w_in, (u16*)(p.ws + OFF_WT_SBIN), 1024, 3072, 3072, 0}; break;
    default: t = {p.sb_w_out, (u16*)(p.ws + OFF_WT_SBOUT), 1024, 1024, 1024, 0}; break;
  }
  return t;
}
__device__ __forceinline__ int src_col(int R, int mode) {
  if (mode == 0) return R;
  if (mode == 1) return R < 2048 ? R : R + 8;
  return ((R >> 4) & 1) * FF + (R >> 5) * 16 + (R & 15);
}
constexpr int N_TR_ITEMS = (640 + 256 + 64 + 2 * 1408 + 2 * 704 + 768 + 256) / 4;
constexpr int N_MOD_ITEMS = 2 * 6144 / 16;

__device__ __forceinline__ void s5_table_item(const Params& p, int item, char* smem) {
  const int tid = otid(), g = item >> 5, tau = item & 31;
  float* pwr = (float*)smem; float* pwi = pwr + 64; float* p1r = pwi + 64; float* p1i = p1r + 64;
  float* bbr = p1i + 64; float* bbi = bbr + 1024; float* cre = bbi + 1024; float* cim = cre + 1024;
  const float dt = expf(p.s5_log_dt[g]);
  if (tid < 64) {
    const float lr = p.s5_lam_re[g * 64 + tid], li = p.s5_lam_im[g * 64 + tid];
    float sn, cs;
    float mg = expf(lr * dt * (float)tau); sincosf(li * dt * (float)tau, &sn, &cs); pwr[tid] = mg * cs; pwi[tid] = mg * sn;
    mg = expf(lr * dt * (float)(tau + 1)); sincosf(li * dt * (float)(tau + 1), &sn, &cs); p1r[tid] = mg * cs; p1i[tid] = mg * sn;
    if (tau == 31) { float* a32 = (float*)(p.ws + OFF_A32); a32[(g * 64 + tid) * 2] = mg * cs; a32[(g * 64 + tid) * 2 + 1] = mg * sn; }
  }
  {
    const int pp = tid >> 2, hq = (tid & 3) * 4;
    const float lr = p.s5_lam_re[g * 64 + pp], li = p.s5_lam_im[g * 64 + pp];
    const float mg = expf(lr * dt); float sn, cs; sincosf(li * dt, &sn, &cs);
    const float ar = mg * cs, ai = mg * sn, den = lr * lr + li * li, nr = ar - 1.f, ni = ai;
    const float fre = (nr * lr + ni * li) / den, fim = (ni * lr - nr * li) / den;
#pragma unroll
    for (int e = 0; e < 4; ++e) {
      const float br = p.s5_b_re[(size_t)(g * 64 + pp) * 16 + hq + e], bi = p.s5_b_im[(size_t)(g * 64 + pp) * 16 + hq + e];
      bbr[pp * 16 + hq + e] = fre * br - fim * bi; bbi[pp * 16 + hq + e] = fre * bi + fim * br;
    }
    for (int i = tid; i < 1024; i += 256) { cre[i] = p.s5_c_re[(size_t)g * 1024 + i]; cim[i] = p.s5_c_im[(size_t)g * 1024 + i]; }
  }
  __syncthreads();
  u16* mf = (u16*)(p.ws + OFF_MF) + (size_t)g * 512 * UXW;
  u16* eg = (u16*)(p.ws + OFF_EG) + (size_t)g * 128 * 512;
  {
    const int h = tid >> 4, hp = tid & 15;
    float kv = 0.f;
    for (int pp = 0; pp < 64; ++pp) {
      const float cr = cre[h * 64 + pp], ci = cim[h * 64 + pp], pr = pwr[pp], pi = pwi[pp];
      kv += (cr * pr - ci * pi) * bbr[pp * 16 + hp] - (cr * pi + ci * pr) * bbi[pp * 16 + hp];
    }
    const u16 kb = f2bf(kv);
    for (int s0 = 0; s0 + tau < 32; ++s0) mf[b_off((s0 + tau) * 16 + h, s0 * 16 + hp, 20)] = kb;
    for (int t0 = 0; t0 + tau + 1 < 32; ++t0) mf[b_off(t0 * 16 + h, (t0 + tau + 1) * 16 + hp, 20)] = 0;
#pragma unroll
    for (int e = 0; e < 4; ++e) {
      const int pp = hp * 4 + e;
      const float cr = cre[h * 64 + pp], ci = cim[h * 64 + pp], pr = p1r[pp], pi = p1i[pp];
      mf[b_off(tau * 16 + h, 512 + pp, 20)] = f2bf(cr * pr - ci * pi);
      mf[b_off(tau * 16 + h, 576 + pp, 20)] = f2bf(-(cr * pi + ci * pr));
    }
  }
  {
    const int pp = tid >> 2, hq = (tid & 3) * 4, s0 = 31 - tau;
#pragma unroll
    for (int e = 0; e < 4; ++e) {
      const float br = bbr[pp * 16 + hq + e], bi = bbi[pp * 16 + hq + e], pr = pwr[pp], pi = pwi[pp];
      eg[b_off(pp, s0 * 16 + hq + e, 16)] = f2bf(pr * br - pi * bi);
      eg[b_off(64 + pp, s0 * 16 + hq + e, 16)] = f2bf(pr * bi + pi * br);
    }
  }
  __syncthreads();
}

constexpr int N_TR_FIRST = 160;
__device__ __forceinline__ void transpose_items(const Params& p, char* smem, int bid, int nblk, int lo, int hi) {
  const int tid = otid();
#pragma unroll 1
  for (int it = lo + bid; it < hi; it += nblk) {
      int rem = it * 4, j = 0; TrJob jb;
      for (;; ++j) { jb = get_job(p, j); int n = (jb.Nd >> 6) * (jb.K >> 6); if (rem < n) break; rem -= n; }
      const int nk = jb.K >> 6;
      u16* s = (u16*)smem;
      {
        const int r = tid & 63, kk = tid >> 6;
#pragma unroll
        for (int q = 0; q < 4; ++q) {
          const int R0 = ((rem + q) / nk) * 64, k0 = ((rem + q) % nk) * 64;
          const float* sp = jb.src + (size_t)k0 * jb.Nsrc + src_col(R0 + r, jb.mode);
#pragma unroll
          for (int i = 0; i < 16; ++i) { int k = kk + 4 * i; s[q * 4608 + r * 72 + k] = f2bf(sp[(size_t)k * jb.Nsrc]); }
        }
      }
      __syncthreads();
      {
        const int r = tid >> 2, ch = tid & 3;
#pragma unroll
        for (int q = 0; q < 4; ++q) {
          const int R0 = ((rem + q) / nk) * 64, k0 = ((rem + q) % nk) * 64;
#pragma unroll
          for (int i = 0; i < 2; ++i) {
            int c8 = (ch + 4 * i) * 8;
            *(u32x4*)(jb.dst + b_off(R0 + r, k0 + c8, jb.K >> 5)) = *(const u32x4*)(s + q * 4608 + r * 72 + c8);
          }
        }
      }
      __syncthreads();
  }
}

__device__ __forceinline__ void phase0(const Params& p, char* smem, int bid, int nblk) {
  const int tid = otid();
  transpose_items(p, smem, bid, nblk, 0, N_TR_FIRST);
  for (int it = N_TR_ITEMS + bid; it < N_TR_ITEMS + N_MOD_ITEMS + 1024; it += nblk) {
    if (it >= N_TR_ITEMS + N_MOD_ITEMS) { s5_table_item(p, it - N_TR_ITEMS - N_MOD_ITEMS, smem); continue; }
    {
      const int mi = it - N_TR_ITEMS, l = mi / 384, n0 = (mi % 384) * 16;
      float* cact = (float*)smem;
      float* red = cact + 4096;
      for (int i = tid; i < 4096; i += 256) cact[i] = silu_(p.c[i]);
      __syncthreads();
      const int cl = tid & 15, ksub = tid >> 4;
      float a0 = 0, a1 = 0, a2 = 0, a3 = 0;
      const float* wp = p.ada_w + (size_t)l * 1024 * 6144 + n0 + cl;
#pragma unroll 16
      for (int k = ksub * 64; k < ksub * 64 + 64; ++k) {
        float w = wp[(size_t)k * 6144];
        a0 += cact[k] * w; a1 += cact[1024 + k] * w; a2 += cact[2048 + k] * w; a3 += cact[3072 + k] * w;
      }
      red[(ksub * 4 + 0) * 16 + cl] = a0; red[(ksub * 4 + 1) * 16 + cl] = a1;
      red[(ksub * 4 + 2) * 16 + cl] = a2; red[(ksub * 4 + 3) * 16 + cl] = a3;
      __syncthreads();
      if (tid < 64) {
        const int b = tid >> 4;
        float sum = 0.f;
#pragma unroll
        for (int q = 0; q < 16; ++q) sum += red[(q * 4 + b) * 16 + cl];
        float* mod = (float*)(p.ws + OFF_MOD);
        mod[(size_t)(l * 4 + b) * 6144 + n0 + cl] = sum + p.ada_b[l * 6144 + n0 + cl];
      }
      __syncthreads();
    }
  }
}

template <int MODE>
__device__ __forceinline__ void norm_phase(const Params& p, const float* src, const float* w, const float* modl, int sh_off, int sc_off,
                           char* smem, int bid, int nblk) {
  const int tid = otid(), wid = tid >> 6, lane = tid & 63;
  float* wba = (float*)smem;
  if (MODE == 1) {
    for (int i = tid; i < 1024 * 8; i += 256) wba[i] = p.hy_w_in[(size_t)(i >> 3) * EIN + 2048 + (i & 7)];
    __syncthreads();
  }
  u16* hn = (u16*)(p.ws + OFF_HN);
  auto process = [&](int row, f32x4 (&v)[4]) {
    float ss = 0.f;
#pragma unroll
    for (int i = 0; i < 4; ++i) ss += v[i][0] * v[i][0] + v[i][1] * v[i][1] + v[i][2] * v[i][2] + v[i][3] * v[i][3];
#pragma unroll
    for (int o = 32; o >= 1; o >>= 1) ss += __shfl_xor(ss, o);
    const float rstd = rsqrtf(ss * (1.f / 1024.f) + 1e-6f);
    const int b = row >> 13;
    float dots[8];
    if (MODE == 1) { for (int j = 0; j < 8; ++j) dots[j] = 0.f; }
#pragma unroll
    for (int i = 0; i < 4; ++i) {
      const int c0 = i * 256 + lane * 4;
      f32x4 ww = *(const f32x4*)(w + c0);
      f32x4 y;
      if (MODE == 2) {
#pragma unroll
        for (int e = 0; e < 4; ++e) y[e] = v[i][e] * rstd * ww[e];
        *(f32x4*)(p.out + (size_t)row * 1024 + c0) = y;
      } else {
        f32x4 sc = *(const f32x4*)(modl + (size_t)b * 6144 + sc_off + c0);
        f32x4 sh = *(const f32x4*)(modl + (size_t)b * 6144 + sh_off + c0);
#pragma unroll
        for (int e = 0; e < 4; ++e) y[e] = v[i][e] * rstd * ww[e] * (1.f + sc[e]) + sh[e];
        uint2 pk; pk.x = (unsigned)f2bf(y[0]) | ((unsigned)f2bf(y[1]) << 16); pk.y = (unsigned)f2bf(y[2]) | ((unsigned)f2bf(y[3]) << 16);
        *(uint2*)(hn + a_off(row, c0, 32)) = pk;
        if (MODE == 1) {
#pragma unroll
          for (int e = 0; e < 4; ++e) {
            f32x4 w0 = *(const f32x4*)(wba + (c0 + e) * 8), w1 = *(const f32x4*)(wba + (c0 + e) * 8 + 4);
#pragma unroll
            for (int j = 0; j < 4; ++j) { dots[j] += y[e] * w0[j]; dots[4 + j] += y[e] * w1[j]; }
          }
        }
      }
    }
    if (MODE == 1) {
#pragma unroll
      for (int j = 0; j < 8; ++j) {
#pragma unroll
        for (int o = 32; o >= 1; o >>= 1) dots[j] += __shfl_xor(dots[j], o);
      }
      if (lane == 0) {
        float* beta = (float*)(p.ws + OFF_BETA); float* gg = (float*)(p.ws + OFF_G);
#pragma unroll
        for (int h = 0; h < 4; ++h) {
          beta[(size_t)row * 4 + h] = sigmoid_(dots[h]);
          gg[(size_t)row * 4 + h] = -__expf(p.hy_a_log[h]) * softplus_(dots[4 + h] + p.hy_dt_bias[h]);
        }
      }
    }
  };
#pragma unroll 1
  for (int row = bid * 4 + wid; row < M; row += nblk * 8) {
    const int row1 = row + nblk * 4;
    const bool has1 = row1 < M;
    f32x4 v0[4], v1[4];
#pragma unroll
    for (int i = 0; i < 4; ++i) v0[i] = *(const f32x4*)(src + (size_t)row * 1024 + i * 256 + lane * 4);
#pragma unroll
    for (int i = 0; i < 4; ++i) v1[i] = has1 ? *(const f32x4*)(src + (size_t)row1 * 1024 + i * 256 + lane * 4) : f32x4{0.f, 0.f, 0.f, 0.f};
    process(row, v0);
    if (has1) process(row1, v1);
  }
}

enum { E_PROJ0 = 0, E_BF16 = 1, E_RESID = 2, E_GLU = 3, E_SWIGLU = 4, E_XE = 5, E_S5Y = 6 };
struct EpiArgs { float* outf; u16* outb; const float* res; const float* gate; const u16* y5; const float* bias; u16* ux; int ldc; };

template <int EPI>
__device__ __forceinline__ void gemm_phase(const u16* __restrict__ A0, int nksA, size_t sA, const u16* __restrict__ B0, int nksB, size_t sB,
                                           int K, int nM, int nN, int nbatch, const EpiArgs ea, char* smem, int bid, int nblk) {
  const int tid = otid(), wid = tid >> 6, lane = tid & 63, wr = wid >> 1, wc = wid & 1, fr = lane & 15, fq = lane >> 4;
  char* SA = smem; char* SB = smem + 49152;
  const int sa0 = (int)(uintptr_t)SA + (wr * 128 + fr) * 64 + (fq ^ swzf(fr)) * 16, sb0 = (int)(uintptr_t)SB + (wc * 64 + fr) * 64 + (fq ^ swzf(fr)) * 16;
  const int NR = nbatch * nM, ntiles = NR * nN;
  const int STN = (nN & 7) == 0 ? 8 : ((nN & 3) == 0 ? 4 : 1), STM = 64 / STN, nSN = nN / STN;
  const bool swz = ((nblk & 7) == 0) && (NR % STM == 0);
  const int lpx = nblk >> 3;
  int si = bid & 7, l = bid >> 3, tl = bid;
#pragma unroll 1
  for (;;) {
    int R, pn;
    if (swz) {
      if (si >= (NR / STM) * nSN) break;
      R = (si / nSN) * STM + l / STN; pn = (si % nSN) * STN + l % STN;
      l += lpx; if (l >= 64) { l = bid >> 3; si += 8; }
    } else {
      if (tl >= ntiles) break;
      R = tl / nN; pn = tl % nN; tl += nblk;
    }
    const int g = R / nM, rt = R % nM, brow = rt << 8, bcol = pn << 7;
    const char* A = (const char*)(A0 + (size_t)g * sA) + ((size_t)rt * nksA << 14) + tid * 16;
    const char* Bt = (const char*)(B0 + (size_t)g * sB) + ((size_t)pn * nksB << 13) + tid * 16;
    int nk = K >> 5, klim = nk;
    if (EPI == E_S5Y) { klim = 4 * (pn + 1); nk = klim + 4; }
    f32x4 acc[8][4];
#pragma unroll
    for (int m = 0; m < 8; ++m)
#pragma unroll
      for (int n = 0; n < 4; ++n) acc[m][n] = f32x4{0.f, 0.f, 0.f, 0.f};
#define GSTAGE(KK, BUF) do { const int kt_ = (EPI == E_S5Y && (KK) >= klim) ? (16 + (KK) - klim) : (KK); \
      _Pragma("unroll") for (int i = 0; i < 4; ++i) \
        __builtin_amdgcn_global_load_lds((const unsigned*)(A + ((size_t)kt_ << 14) + i * 4096), (__attribute__((address_space(3))) unsigned*)(SA + (BUF) * 16384 + tid * 16 + i * 4096), 16, 0, 0); \
      _Pragma("unroll") for (int i = 0; i < 2; ++i) \
        __builtin_amdgcn_global_load_lds((const unsigned*)(Bt + ((size_t)kt_ << 13) + i * 4096), (__attribute__((address_space(3))) unsigned*)(SB + (BUF) * 8192 + tid * 16 + i * 4096), 16, 0, 0); } while (0)
    asm volatile("s_waitcnt vmcnt(0)" ::: "memory");
    GSTAGE(0, 0);
    if (nk > 1) { GSTAGE(1, 1); asm volatile("s_waitcnt vmcnt(6)\n\ts_barrier" ::: "memory"); }
    else { asm volatile("s_waitcnt vmcnt(0)\n\ts_barrier" ::: "memory"); }
    int buf = 0, nbuf = 2;
#pragma unroll 1
    for (int kk = 0; kk < nk; ++kk) {
      const bool more = kk + 2 < nk;
      if (more) GSTAGE(kk + 2, nbuf);
      bf16x8 Bl[4], At[8];
      {
        const int bb = sb0 + buf * 8192, ab = sa0 + buf * 16384;
        asm volatile(
            "ds_read_b128 %0, %12\n\tds_read_b128 %1, %12 offset:1024\n\tds_read_b128 %2, %12 offset:2048\n\tds_read_b128 %3, %12 offset:3072\n\t"
            "ds_read_b128 %4, %13\n\tds_read_b128 %5, %13 offset:1024\n\tds_read_b128 %6, %13 offset:2048\n\tds_read_b128 %7, %13 offset:3072\n\t"
            "ds_read_b128 %8, %13 offset:4096\n\tds_read_b128 %9, %13 offset:5120\n\tds_read_b128 %10, %13 offset:6144\n\tds_read_b128 %11, %13 offset:7168\n\t"
            "s_waitcnt lgkmcnt(4)"
            : "=&v"(Bl[0]), "=&v"(Bl[1]), "=&v"(Bl[2]), "=&v"(Bl[3]), "=&v"(At[0]), "=&v"(At[1]), "=&v"(At[2]), "=&v"(At[3]),
              "=&v"(At[4]), "=&v"(At[5]), "=&v"(At[6]), "=&v"(At[7])
            : "v"(bb), "v"(ab)
            : "memory");
      }
      __builtin_amdgcn_s_setprio(1);
#pragma unroll
      for (int m = 0; m < 4; ++m)
#pragma unroll
        for (int n = 0; n < 4; ++n) acc[m][n] = __builtin_amdgcn_mfma_f32_16x16x32_bf16(Bl[n], At[m], acc[m][n], 0, 0, 0);
      __builtin_amdgcn_sched_barrier(0);
      asm volatile("s_waitcnt lgkmcnt(0)" : "+v"(At[4]), "+v"(At[5]), "+v"(At[6]), "+v"(At[7]) :: "memory");
      __builtin_amdgcn_sched_barrier(0);
#pragma unroll
      for (int m = 4; m < 8; ++m)
#pragma unroll
        for (int n = 0; n < 4; ++n) acc[m][n] = __builtin_amdgcn_mfma_f32_16x16x32_bf16(Bl[n], At[m], acc[m][n], 0, 0, 0);
      __builtin_amdgcn_s_setprio(0);
      if (more) asm volatile("s_waitcnt vmcnt(6)\n\ts_barrier" ::: "memory");
      else asm volatile("s_waitcnt vmcnt(0)\n\ts_barrier" ::: "memory");
      buf = (buf == 2) ? 0 : buf + 1; nbuf = (nbuf == 2) ? 0 : nbuf + 1;
    }
#undef GSTAGE
#pragma unroll
    for (int m = 0; m < 8; ++m)
#pragma unroll
      for (int n = 0; n < 4; ++n) {
        const int row = brow + wr * 128 + m * 16 + fr, col = bcol + wc * 64 + n * 16 + fq * 4;
        const f32x4 v = acc[m][n];
        if (EPI == E_PROJ0) {
          const uint2 pk = uint2{pk2(v[0], v[1]), pk2(v[2], v[3])};
          if (bcol < 2048) *(uint2*)(ea.outb + pj_idx(row, col)) = pk;
          else { const int cc = col - 2048; *(uint2*)(ea.ux + (size_t)(cc >> 4) * S5C * UXW + a_off(row >> 5, (row & 31) * 16 + (cc & 15), 20)) = pk; }
        }
        if (EPI == E_BF16) *(uint2*)(ea.outb + (size_t)row * ea.ldc + col) = uint2{pk2(v[0], v[1]), pk2(v[2], v[3])};
        if (EPI == E_RESID) {
          const size_t idx = (size_t)row * 1024 + col;
          const f32x4 r4 = *(const f32x4*)(ea.res + idx), g4 = *(const f32x4*)(ea.gate + (size_t)(row >> 13) * 6144 + col);
          *(f32x4*)(ea.outf + idx) = f32x4{r4[0] + g4[0] * v[0], r4[1] + g4[1] * v[1], r4[2] + g4[2] * v[2], r4[3] + g4[3] * v[3]};
        }
        if (EPI == E_GLU) {
          const uint2 yy = *(const uint2*)(ea.y5 + a_off(row, col, 16));
          const f32x4 b4 = *(const f32x4*)(ea.bias + col);
          const float y0 = __uint_as_float(yy.x << 16), y1 = __uint_as_float(yy.x & 0xffff0000u), y2 = __uint_as_float(yy.y << 16), y3 = __uint_as_float(yy.y & 0xffff0000u);
          *(uint2*)(ea.outb + a_off(row, 512 + col, 32)) = uint2{pk2(y0 * sigmoid_(v[0] + b4[0]), y1 * sigmoid_(v[1] + b4[1])), pk2(y2 * sigmoid_(v[2] + b4[2]), y3 * sigmoid_(v[3] + b4[3]))};
        }
        if (EPI == E_SWIGLU) {
          if ((n & 1) == 0) {
            const f32x4 u = acc[m][n | 1];
            const int co = (bcol >> 1) + wc * 32 + (n >> 1) * 16 + fq * 4;
            *(uint2*)(ea.outb + a_off(row, co, FF / 32)) = uint2{pk2(silu_(v[0]) * u[0], silu_(v[1]) * u[1]), pk2(silu_(v[2]) * u[2], silu_(v[3]) * u[3])};
          }
        }
        if (EPI == E_XE) *(f32x4*)(ea.outf + ((size_t)g * S5C + row) * 128 + col) = v;
        if (EPI == E_S5Y) {
          const uint2 uu = *(const uint2*)(ea.ux + (size_t)g * S5C * UXW + a_off(row, col, 20));
          const f32x4 d4 = *(const f32x4*)(ea.bias + g * 16 + (col & 15));
          const float u0 = __uint_as_float(uu.x << 16), u1 = __uint_as_float(uu.x & 0xffff0000u), u2 = __uint_as_float(uu.y << 16), u3 = __uint_as_float(uu.y & 0xffff0000u);
          *(uint2*)(ea.outb + a_off(row * 32 + (col >> 4), g * 16 + (col & 15), 16)) =
              uint2{pk2(gelu_tanh_(v[0] + d4[0] * u0), gelu_tanh_(v[1] + d4[1] * u1)), pk2(gelu_tanh_(v[2] + d4[2] * u2), gelu_tanh_(v[3] + d4[3] * u3))};
        }
      }
  }
}

__device__ __forceinline__ void s5_carry_phase(const Params& p, int bid, int nblk) {
  const float* xe = (const float*)(p.ws + OFF_XE); const float* a32 = (const float*)(p.ws + OFF_A32);
  u16* ux = (u16*)(p.ws + OFF_UX);
  for (int it = bid; it < 32; it += nblk) {
    const int idx = it * 256 + otid(), pp = idx & 63, g = (idx >> 6) & 31, b = idx >> 11;
    const float ar = a32[(g * 64 + pp) * 2], ai = a32[(g * 64 + pp) * 2 + 1];
    float xr = 0.f, xi = 0.f;
    const size_t cbase = (size_t)g * S5C + b * 256, gbase = (size_t)g * S5C * UXW;
    for (int n = 0; n < 256; n += 8) {
      float er[8], ei[8];
#pragma unroll
      for (int e = 0; e < 8; ++e) { er[e] = xe[(cbase + n + e) * 128 + pp]; ei[e] = xe[(cbase + n + e) * 128 + 64 + pp]; }
#pragma unroll
      for (int e = 0; e < 8; ++e) {
        ux[gbase + a_off(b * 256 + n + e, 512 + pp, 20)] = f2bf(xr); ux[gbase + a_off(b * 256 + n + e, 576 + pp, 20)] = f2bf(xi);
        const float nr = ar * xr - ai * xi + er[e], ni = ar * xi + ai * xr + ei[e];
        xr = nr; xi = ni;
      }
    }
  }
}

__device__ __forceinline__ int crow(int r, int hi) { return (r & 3) + 8 * (r >> 2) + 4 * hi; }
using f32x16 = __attribute__((ext_vector_type(16))) float;
__device__ __forceinline__ void unpack8(const u32x4 w, float* f) {
#pragma unroll
  for (int e = 0; e < 4; ++e) { f[2 * e] = __uint_as_float(w[e] << 16); f[2 * e + 1] = __uint_as_float(w[e] & 0xffff0000u); }
}
__device__ __forceinline__ void gdn_prep_phase(const Params& p, char* smem, int bid, int nblk) {
  const int tid = otid(), wid = tid >> 6, lane = tid & 63, fr = lane & 15, fq = lane >> 4;
  u16* qs = (u16*)smem;
  u16* ks = qs + 64 * 136;
  float* Lm = (float*)(ks + 64 * 136);
  float* gcs = Lm + 4096; float* bts = gcs + 64; float* egs = bts + 64;
  const u16* proj = (const u16*)(p.ws + OFF_PROJ);
  const float* beta = (const float*)(p.ws + OFF_BETA); const float* gg = (const float*)(p.ws + OFF_G);
#pragma unroll 1
  for (int it = bid; it < 2048; it += nblk) {
    const int n = it & 127, bh = it >> 7, b = bh >> 2, h = bh & 3;
    const size_t row0 = (size_t)b * SEQ + n * 64;
    if (wid == 0) {
      float c = gg[(row0 + lane) * 4 + h];
#pragma unroll
      for (int o = 1; o < 64; o <<= 1) { const float tt = __shfl_up(c, o); if (lane >= o) c += tt; }
      gcs[lane] = c; egs[lane] = __expf(c); bts[lane] = beta[(row0 + lane) * 4 + h];
    }
    {
      const int tok = tid >> 2, part = tid & 3, l = n * 64 + tok;
      float qo[32], ko[32]; float sq = 0.f, sk = 0.f;
#pragma unroll
      for (int cb = 0; cb < 4; ++cb) {
        const int colq = h * 128 + part * 32 + cb * 8, colk = 512 + colq;
        const size_t kblk = (size_t)M * 512 - 512;
        float aq[8], ak[8];
#pragma unroll
        for (int e = 0; e < 8; ++e) { aq[e] = 0.f; ak[e] = 0.f; }
#pragma unroll
        for (int j = 0; j < 4; ++j) {
          const int lt = l - 3 + j;
          if (lt >= 0) {
            const u16* rp = proj + ((size_t)b * SEQ + lt) * 512;
            float xq[8], xk[8];
            unpack8(*(const u32x4*)(rp + colq), xq); unpack8(*(const u32x4*)(rp + kblk + colk), xk);
            const f32x4 wq0 = *(const f32x4*)(p.hy_conv_w + j * 1536 + colq), wq1 = *(const f32x4*)(p.hy_conv_w + j * 1536 + colq + 4);
            const f32x4 wk0 = *(const f32x4*)(p.hy_conv_w + j * 1536 + colk), wk1 = *(const f32x4*)(p.hy_conv_w + j * 1536 + colk + 4);
#pragma unroll
            for (int e = 0; e < 4; ++e) { aq[e] += wq0[e] * xq[e]; aq[4 + e] += wq1[e] * xq[4 + e]; ak[e] += wk0[e] * xk[e]; ak[4 + e] += wk1[e] * xk[4 + e]; }
          }
        }
#pragma unroll
        for (int e = 0; e < 8; ++e) { const float a = silu_(aq[e]), k = silu_(ak[e]); qo[cb * 8 + e] = a; ko[cb * 8 + e] = k; sq += a * a; sk += k * k; }
      }
      sq += __shfl_xor(sq, 1); sq += __shfl_xor(sq, 2); sk += __shfl_xor(sk, 1); sk += __shfl_xor(sk, 2);
      const float rq = rsqrtf(sq + 1e-6f) * 0.08838834764831845f, rk = rsqrtf(sk + 1e-6f);
#pragma unroll
      for (int cb = 0; cb < 4; ++cb) {
        u32x4 wq, wk;
#pragma unroll
        for (int e = 0; e < 4; ++e) { wq[e] = pk2(qo[cb * 8 + 2 * e] * rq, qo[cb * 8 + 2 * e + 1] * rq); wk[e] = pk2(ko[cb * 8 + 2 * e] * rk, ko[cb * 8 + 2 * e + 1] * rk); }
        *(u32x4*)(qs + tok * 136 + part * 32 + cb * 8) = wq; *(u32x4*)(ks + tok * 136 + part * 32 + cb * 8) = wk;
      }
    }
    __syncthreads();
    {
      f32x4 akk[4], aqk[4];
#pragma unroll
      for (int nb = 0; nb < 4; ++nb) { akk[nb] = f32x4{0.f, 0.f, 0.f, 0.f}; aqk[nb] = f32x4{0.f, 0.f, 0.f, 0.f}; }
#pragma unroll
      for (int kk = 0; kk < 4; ++kk) {
        const bf16x8 ak = *(const bf16x8*)(ks + (16 * wid + fr) * 136 + kk * 32 + fq * 8);
        const bf16x8 aq = *(const bf16x8*)(qs + (16 * wid + fr) * 136 + kk * 32 + fq * 8);
#pragma unroll
        for (int nb = 0; nb < 4; ++nb) {
          const bf16x8 bk = *(const bf16x8*)(ks + (16 * nb + fr) * 136 + kk * 32 + fq * 8);
          akk[nb] = __builtin_amdgcn_mfma_f32_16x16x32_bf16(ak, bk, akk[nb], 0, 0, 0);
          aqk[nb] = __builtin_amdgcn_mfma_f32_16x16x32_bf16(aq, bk, aqk[nb], 0, 0, 0);
        }
      }
      u16* att = (u16*)(p.ws + OFF_GAT) + (size_t)it * 4096;
#pragma unroll
      for (int nb = 0; nb < 4; ++nb)
#pragma unroll
        for (int r = 0; r < 4; ++r) {
          const int i = 16 * wid + fq * 4 + r, j = 16 * nb + fr;
          const float dec = __expf(fminf(gcs[i] - gcs[j], 0.f));
          Lm[i * 64 + j] = (i > j) ? bts[i] * akk[nb][r] * dec : 0.f;
          att[i * 64 + j] = f2bf((i >= j) ? aqk[nb][r] * dec : 0.f);
        }
    }
    __syncthreads();
    {
      float x[64];
      if (tid < 128) {
        const int col = 1024 + h * 128 + tid;
        const u16* vp = proj + (size_t)2 * M * 512 + h * 128 + tid;
        const float w0 = p.hy_conv_w[col], w1 = p.hy_conv_w[1536 + col], w2 = p.hy_conv_w[2 * 1536 + col], w3 = p.hy_conv_w[3 * 1536 + col];
        float x1 = 0.f, x2 = 0.f, x3 = 0.f;
        if (n > 0) { x3 = bf2f(vp[(row0 - 3) * 512]); x2 = bf2f(vp[(row0 - 2) * 512]); x1 = bf2f(vp[(row0 - 1) * 512]); }
#pragma unroll
        for (int i = 0; i < 64; ++i) {
          const float xv = bf2f(vp[(row0 + i) * 512]);
          x[i] = silu_(w0 * x3 + w1 * x2 + w2 * x1 + w3 * xv) * bts[i];
          x3 = x2; x2 = x1; x1 = xv;
        }
      } else {
#pragma unroll
        for (int i = 0; i < 64; ++i) x[i] = bf2f(ks[i * 136 + tid - 128]) * bts[i] * egs[i];
      }
#pragma unroll
      for (int i = 1; i < 64; ++i) {
        float acc = x[i];
#pragma unroll
        for (int j4 = 0; j4 < (i + 3) / 4; ++j4) {
          const f32x4 l4 = *(const f32x4*)(Lm + i * 64 + j4 * 4);
#pragma unroll
          for (int e = 0; e < 4; ++e) if (j4 * 4 + e < i) acc -= l4[e] * x[j4 * 4 + e];
        }
        x[i] = acc;
      }
      if (tid < 128) {
        u16* ut = (u16*)(p.ws + OFF_GUT) + (size_t)it * 8192 + tid * 64;
#pragma unroll
        for (int c8 = 0; c8 < 8; ++c8) {
          u32x4 w;
#pragma unroll
          for (int e = 0; e < 4; ++e) w[e] = pk2(x[c8 * 8 + 2 * e], x[c8 * 8 + 2 * e + 1]);
          *(u32x4*)(ut + c8 * 8) = w;
        }
      } else {
        u16* wg = (u16*)(p.ws + OFF_GW) + (size_t)it * 8192 + (tid - 128);
#pragma unroll
        for (int i = 0; i < 64; ++i) wg[i * 128] = f2bf(x[i]);
      }
    }
    {
      u16* qd = (u16*)(p.ws + OFF_GQD) + (size_t)it * 8192;
#pragma unroll
      for (int k = 0; k < 4; ++k) {
        const int piece = tid + 256 * k, i = piece >> 4, d0 = (piece & 15) * 8;
        float f[8]; unpack8(*(const u32x4*)(qs + i * 136 + d0), f);
        const float e = egs[i];
        u32x4 w;
#pragma unroll
        for (int e2 = 0; e2 < 4; ++e2) w[e2] = pk2(f[2 * e2] * e, f[2 * e2 + 1] * e);
        *(u32x4*)(qd + i * 128 + d0) = w;
      }
      u16* kt = (u16*)(p.ws + OFF_GKT) + (size_t)it * 8192;
      const int dk = tid & 127, half = tid >> 7;
      const float gl = gcs[63];
#pragma unroll
      for (int c8 = 0; c8 < 4; ++c8) {
        u32x4 w;
#pragma unroll
        for (int e = 0; e < 4; ++e) {
          const int i0 = half * 32 + c8 * 8 + 2 * e;
          w[e] = pk2(bf2f(ks[i0 * 136 + dk]) * __expf(gl - gcs[i0]), bf2f(ks[(i0 + 1) * 136 + dk]) * __expf(gl - gcs[i0 + 1]));
        }
        *(u32x4*)(kt + dk * 64 + half * 32 + c8 * 8) = w;
      }
      if (tid == 0) ((float*)(p.ws + OFF_GSD))[it] = egs[63];
    }
    __syncthreads();
  }
}

__device__ __forceinline__ uint2 lds64(const char* p) { return *(const uint2*)p; }
__device__ __forceinline__ bf16x8 mk8(uint2 a, uint2 b) { u32x4 w = {a.x, a.y, b.x, b.y}; return __builtin_bit_cast(bf16x8, w); }
__device__ __forceinline__ bf16x8 pack8(const f32x16& x, int s) {
  u32x4 w = {pk2(x[8 * s], x[8 * s + 1]), pk2(x[8 * s + 2], x[8 * s + 3]), pk2(x[8 * s + 4], x[8 * s + 5]), pk2(x[8 * s + 6], x[8 * s + 7])};
  return __builtin_bit_cast(bf16x8, w);
}
__device__ __forceinline__ void gdn_scan_item(const Params& p, int bh, char* smem) {
  const int tid = otid(), wid = tid >> 6, lane = tid & 63, r32 = lane & 31, hi = lane >> 5;
  char* Wl = smem; char* KTl = smem + 16896;
  const char* gw = p.ws + OFF_GW; const char* gkt = p.ws + OFF_GKT;
  const u16* gut = (const u16*)(p.ws + OFF_GUT);
  const float* gsd = (const float*)(p.ws + OFF_GSD);
  u32x4* sbg = (u32x4*)(p.ws + OFF_PROJ); u32x4* vbg = (u32x4*)(p.ws + OFF_PROJ + (size_t)2048 * 32768);
  f32x16 S[4];
#pragma unroll
  for (int T = 0; T < 4; ++T)
#pragma unroll
    for (int r = 0; r < 16; ++r) S[T][r] = 0.f;
  u32x4 sa[8], sb_[8]; uint2 uc[8];
  const int dv = wid * 32 + r32;
#define G_LOAD(ST, IT) do { const size_t o16 = (size_t)(IT) * 16384; \
    _Pragma("unroll") for (int k = 0; k < 4; ++k) { ST[k] = *(const u32x4*)(gw + o16 + (tid + 256 * k) * 16); ST[4 + k] = *(const u32x4*)(gkt + o16 + (tid + 256 * k) * 16); } } while (0)
#define U_LOAD(IT) do { _Pragma("unroll") for (int k = 0; k < 8; ++k) uc[k] = *(const uint2*)(gut + (size_t)(IT) * 8192 + dv * 64 + 32 * (k >> 2) + 8 * (k & 3) + 4 * hi); } while (0)
#define G_WRITE(ST) do { \
    _Pragma("unroll") for (int k = 0; k < 4; ++k) { const int pc = tid + 256 * k; \
      { char* d = Wl + (pc >> 4) * 264 + (pc & 15) * 16; *(uint2*)d = uint2{ST[k][0], ST[k][1]}; *(uint2*)(d + 8) = uint2{ST[k][2], ST[k][3]}; } \
      { char* d = KTl + (pc >> 3) * 136 + (pc & 7) * 16; *(uint2*)d = uint2{ST[4 + k][0], ST[4 + k][1]}; *(uint2*)(d + 8) = uint2{ST[4 + k][2], ST[4 + k][3]}; } } } while (0)
#define SCAN_STEP(N, NXT, FAR) do { const int n = (N); const int item = bh * 128 + n; \
    const float sd_nxt = gsd[item + (n + 1 < 128 ? 1 : 0)]; \
    if (n + 2 < 128) G_LOAD(FAR, item + 2); \
    f32x16 av[2]; \
    _Pragma("unroll") for (int r = 0; r < 16; ++r) { av[0][r] = 0.f; av[1][r] = 0.f; } \
    _Pragma("unroll") for (int T = 0; T < 4; ++T) {     \
      bf16x8 wf[4]; \
      _Pragma("unroll") for (int q = 0; q < 4; ++q) { const int s = q >> 1, it = q & 1; \
        const char* wp = Wl + (32 * it + r32) * 264 + (32 * T + 16 * s + 4 * hi) * 2; wf[q] = mk8(lds64(wp), lds64(wp + 16)); } \
      __builtin_amdgcn_sched_barrier(0); \
      _Pragma("unroll") for (int s = 0; s < 2; ++s) { \
        const bf16x8 sb = pack8(S[T], s); \
        sbg[((size_t)(item * 4 + wid) * 8 + T * 2 + s) * 64 + lane] = __builtin_bit_cast(u32x4, sb); \
        av[0] = __builtin_amdgcn_mfma_f32_32x32x16_bf16(wf[s * 2], sb, av[0], 0, 0, 0); \
        av[1] = __builtin_amdgcn_mfma_f32_32x32x16_bf16(wf[s * 2 + 1], sb, av[1], 0, 0, 0); } } \
    bf16x8 vb[2][2]; \
    _Pragma("unroll") for (int it = 0; it < 2; ++it) { \
      f32x16 vn; \
      _Pragma("unroll") for (int g = 0; g < 4; ++g) { const uint2 u2 = uc[it * 4 + g]; \
        vn[4 * g] = __uint_as_float(u2.x << 16) - av[it][4 * g]; vn[4 * g + 1] = __uint_as_float(u2.x & 0xffff0000u) - av[it][4 * g + 1]; \
        vn[4 * g + 2] = __uint_as_float(u2.y << 16) - av[it][4 * g + 2]; vn[4 * g + 3] = __uint_as_float(u2.y & 0xffff0000u) - av[it][4 * g + 3]; } \
      vb[it][0] = pack8(vn, 0); vb[it][1] = pack8(vn, 1); \
      vbg[((size_t)(item * 4 + wid) * 4 + it * 2) * 64 + lane] = __builtin_bit_cast(u32x4, vb[it][0]); \
      vbg[((size_t)(item * 4 + wid) * 4 + it * 2 + 1) * 64 + lane] = __builtin_bit_cast(u32x4, vb[it][1]); } \
    if (n + 1 < 128) U_LOAD(item + 1); \
    _Pragma("unroll") for (int T = 0; T < 4; ++T) { \
      bf16x8 kf[4]; \
      _Pragma("unroll") for (int q = 0; q < 4; ++q) { const int it = q >> 1, s = q & 1; \
        const char* kp = KTl + (32 * T + r32) * 136 + (32 * it + 16 * s + 4 * hi) * 2; kf[q] = mk8(lds64(kp), lds64(kp + 16)); } \
      __builtin_amdgcn_sched_barrier(0); \
      _Pragma("unroll") for (int r = 0; r < 16; ++r) S[T][r] *= sd_cur; \
      _Pragma("unroll") for (int q3 = 0; q3 < 4; ++q3) \
        S[T] = __builtin_amdgcn_mfma_f32_32x32x16_bf16(kf[q3], vb[q3 >> 1][q3 & 1], S[T], 0, 0, 0); } \
    sd_cur = sd_nxt; \
    __syncthreads(); \
    if (n + 1 < 128) G_WRITE(NXT); \
    __syncthreads(); } while (0)
  float sd_cur = gsd[bh * 128];
  G_LOAD(sa, bh * 128); U_LOAD(bh * 128); G_WRITE(sa);
  G_LOAD(sb_, bh * 128 + 1);
  __syncthreads();
#pragma unroll 1
  for (int n2 = 0; n2 < 128; n2 += 2) {
    SCAN_STEP(n2, sb_, sa);
    SCAN_STEP(n2 + 1, sa, sb_);
  }
#undef SCAN_STEP
#undef G_LOAD
#undef G_WRITE
#undef U_LOAD
}

__device__ __forceinline__ void gdn_out_phase(const Params& p, char* smem, int bid, int nblk) {
  const int tid = otid(), wid = tid >> 6, lane = tid & 63, r32 = lane & 31, hi = lane >> 5;
  char* QDl = smem; char* ATl = smem + 16896; float* Ol = (float*)(smem + 16896 + 8704);
  const char* gqd = p.ws + OFF_GQD; const char* gat = p.ws + OFF_GAT;
  const u32x4* sbg = (const u32x4*)(p.ws + OFF_PROJ); const u32x4* vbg = (const u32x4*)(p.ws + OFF_PROJ + (size_t)2048 * 32768);
  const u16* zb = (const u16*)(p.ws + OFF_PROJ) + (size_t)3 * M * 512;
  u16* concat = (u16*)(p.ws + OFF_HN);
#pragma unroll 1
  for (int item = bid; item < 2048; item += nblk) {
    const int n = item & 127, bh = item >> 7, b = bh >> 2, h = bh & 3;
    {
      u32x4 st[6];
#pragma unroll
      for (int k = 0; k < 4; ++k) st[k] = *(const u32x4*)(gqd + (size_t)item * 16384 + (tid + 256 * k) * 16);
#pragma unroll
      for (int k = 0; k < 2; ++k) st[4 + k] = *(const u32x4*)(gat + (size_t)item * 8192 + (tid + 256 * k) * 16);
#pragma unroll
      for (int k = 0; k < 4; ++k) { const int pc = tid + 256 * k; char* d = QDl + (pc >> 4) * 264 + (pc & 15) * 16;
        *(uint2*)d = uint2{st[k][0], st[k][1]}; *(uint2*)(d + 8) = uint2{st[k][2], st[k][3]}; }
#pragma unroll
      for (int k = 0; k < 2; ++k) { const int pc = tid + 256 * k; char* d = ATl + (pc >> 3) * 136 + (pc & 7) * 16;
        *(uint2*)d = uint2{st[4 + k][0], st[4 + k][1]}; *(uint2*)(d + 8) = uint2{st[4 + k][2], st[4 + k][3]}; }
    }
    bf16x8 sb[8], vb[4];
#pragma unroll
    for (int f = 0; f < 8; ++f) sb[f] = __builtin_bit_cast(bf16x8, sbg[((size_t)(item * 4 + wid) * 8 + f) * 64 + lane]);
#pragma unroll
    for (int f = 0; f < 4; ++f) vb[f] = __builtin_bit_cast(bf16x8, vbg[((size_t)(item * 4 + wid) * 4 + f) * 64 + lane]);
    __syncthreads();
    f32x16 ao[2];
#pragma unroll
    for (int r = 0; r < 16; ++r) { ao[0][r] = 0.f; ao[1][r] = 0.f; }
#pragma unroll
    for (int T = 0; T < 4; ++T)
#pragma unroll
      for (int s = 0; s < 2; ++s) {
        const int cb = (32 * T + 16 * s + 4 * hi) * 2;
#pragma unroll
        for (int it = 0; it < 2; ++it) {
          const char* qp = QDl + (32 * it + r32) * 264 + cb;
          ao[it] = __builtin_amdgcn_mfma_f32_32x32x16_bf16(mk8(lds64(qp), lds64(qp + 16)), sb[T * 2 + s], ao[it], 0, 0, 0);
        }
      }
#pragma unroll
    for (int it2 = 0; it2 < 2; ++it2)
#pragma unroll
      for (int it = 0; it <= it2; ++it)
#pragma unroll
        for (int s = 0; s < 2; ++s) {
          const char* ap = ATl + (32 * it2 + r32) * 136 + (32 * it + 16 * s + 4 * hi) * 2;
          ao[it2] = __builtin_amdgcn_mfma_f32_32x32x16_bf16(mk8(lds64(ap), lds64(ap + 16)), vb[it * 2 + s], ao[it2], 0, 0, 0);
        }
#pragma unroll
    for (int it = 0; it < 2; ++it)
#pragma unroll
      for (int r = 0; r < 16; ++r) Ol[(32 * it + crow(r, hi)) * 132 + wid * 32 + r32] = ao[it][r];
    __syncthreads();
    {
      const int tok = tid >> 2, part = tid & 3;
      const int row = b * SEQ + n * 64 + tok;
      f32x4 a[8]; float ss = 0.f;
#pragma unroll
      for (int k = 0; k < 8; ++k) { a[k] = *(const f32x4*)(Ol + tok * 132 + part * 32 + k * 4); ss += a[k][0] * a[k][0] + a[k][1] * a[k][1] + a[k][2] * a[k][2] + a[k][3] * a[k][3]; }
      ss += __shfl_xor(ss, 1); ss += __shfl_xor(ss, 2);
      const float rs = rsqrtf(ss * (1.f / 128.f) + 1e-6f);
      const u16* zp = zb + (size_t)row * 512 + h * 128 + part * 32;
      const float* hw = p.hy_head_norm_w + part * 32;
      const int ccol = h * 128 + part * 32;
#pragma unroll
      for (int k = 0; k < 4; ++k) {
        float zf[8]; unpack8(*(const u32x4*)(zp + k * 8), zf);
        const f32x4 h0 = *(const f32x4*)(hw + k * 8), h1 = *(const f32x4*)(hw + k * 8 + 4);
        const f32x4 x0 = a[2 * k], x1 = a[2 * k + 1];
        u32x4 w;
        w[0] = pk2(x0[0] * rs * h0[0] * silu_(zf[0]), x0[1] * rs * h0[1] * silu_(zf[1]));
        w[1] = pk2(x0[2] * rs * h0[2] * silu_(zf[2]), x0[3] * rs * h0[3] * silu_(zf[3]));
        w[2] = pk2(x1[0] * rs * h1[0] * silu_(zf[4]), x1[1] * rs * h1[1] * silu_(zf[5]));
        w[3] = pk2(x1[2] * rs * h1[2] * silu_(zf[6]), x1[3] * rs * h1[3] * silu_(zf[7]));
        *(u32x4*)(concat + a_off(row, ccol + k * 8, 32)) = w;
      }
    }
    __syncthreads();
  }
}

using s16x4 = __attribute__((ext_vector_type(4))) short;
#define KSWZ(row, colB) ((row) * 256 + ((colB) ^ (((row) & 7) << 4)))
#define SBAR() __builtin_amdgcn_sched_barrier(0)
__device__ __forceinline__ unsigned cvtpk(float lo, float hi) { unsigned r; asm volatile("v_cvt_pk_bf16_f32 %0, %1, %2" : "=v"(r) : "v"(lo), "v"(hi)); return r; }
__device__ __forceinline__ int v_st(int k, int c) { const int kk = (k & ~0xC) | ((k & 4) << 1) | ((k & 8) >> 1); return ((kk >> 3) * 4 + (c >> 5)) * 512 + ((kk & 7) * 32 + (c & 31)) * 2; }
__device__ __forceinline__ int v_rd_base(int lane) { return ((lane & 3) << 3) | (((lane >> 2) & 3) << 6) | (((lane >> 4) & 1) << 5) | (((lane >> 5) & 1) << 8); }
constexpr int v_rd_off(int d0, int ks, int half) { return d0 * 512 + ks * 4096 + half * 2048; }
template <int OFF> __device__ __forceinline__ s16x4 tr_read(int vb) {
  s16x4 r; asm volatile("ds_read_b64_tr_b16 %0, %1 offset:%2" : "=&v"(r) : "v"(vb), "i"(OFF) : "memory"); return r;
}
template <int D0> __device__ __forceinline__ void pv_one(f32x16& od, int vb, bf16x8 pa0, bf16x8 pa1, bf16x8 pa2, bf16x8 pa3) {
  const s16x4 l0 = tr_read<v_rd_off(D0, 0, 0)>(vb), h0 = tr_read<v_rd_off(D0, 0, 1)>(vb), l1 = tr_read<v_rd_off(D0, 1, 0)>(vb), h1 = tr_read<v_rd_off(D0, 1, 1)>(vb);
  const s16x4 l2 = tr_read<v_rd_off(D0, 2, 0)>(vb), h2 = tr_read<v_rd_off(D0, 2, 1)>(vb), l3 = tr_read<v_rd_off(D0, 3, 0)>(vb), h3 = tr_read<v_rd_off(D0, 3, 1)>(vb);
  asm volatile("s_waitcnt lgkmcnt(0)" ::: "memory"); SBAR();
#define PK(L, H) (bf16x8){L[0], L[1], L[2], L[3], H[0], H[1], H[2], H[3]}
  od = __builtin_amdgcn_mfma_f32_32x32x16_bf16(pa0, PK(l0, h0), od, 0, 0, 0);
  od = __builtin_amdgcn_mfma_f32_32x32x16_bf16(pa1, PK(l1, h1), od, 0, 0, 0);
  od = __builtin_amdgcn_mfma_f32_32x32x16_bf16(pa2, PK(l2, h2), od, 0, 0, 0);
  od = __builtin_amdgcn_mfma_f32_32x32x16_bf16(pa3, PK(l3, h3), od, 0, 0, 0);
#undef PK
}
__device__ __forceinline__ float pl32_other(float a, float b, int hi) {
  auto rr = __builtin_amdgcn_permlane32_swap(__float_as_uint(a), __float_as_uint(b), false, false);
  return __uint_as_float(hi ? rr[0] : rr[1]);
}
__device__ __forceinline__ void sb_half(f32x16& pz, float& run, bool need_mask, int kb, int t, int hi) {
  constexpr float C2 = 0.08838834764831845f * 1.4426950408889634f;
  f32x16 l;
#pragma unroll
  for (int r = 0; r < 16; ++r) {
    const float e = __builtin_amdgcn_exp2f(fminf(pz[r] * C2, 60.f));
    l[r] = __builtin_amdgcn_rcpf(1.f + e);
    pz[r] = e;
  }
  if (need_mask) {
#pragma unroll
    for (int r = 0; r < 16; ++r) { if (kb + crow(r, hi) >= t) { l[r] = 1.f; pz[r] = 0.f; } }
  }
#pragma unroll
  for (int g = 0; g < 4; ++g) { l[4 * g + 2] *= l[4 * g + 3]; l[4 * g + 1] *= l[4 * g + 2]; l[4 * g] *= l[4 * g + 1]; }
  const float cs3 = l[12], cs2 = l[8] * cs3, cs1 = l[4] * cs2, cs0 = l[0] * cs1;
  const float off0 = cs1 * pl32_other(cs0, cs1, hi) * run;
  const float off1 = cs2 * pl32_other(cs1, cs2, hi) * run;
  const float off2 = cs3 * pl32_other(cs2, cs3, hi) * run;
  const float off3 = pl32_other(cs3, 1.f, hi) * run;
  float tot;
  { auto rr = __builtin_amdgcn_permlane32_swap(__float_as_uint(cs0), __float_as_uint(cs0), false, false); tot = __uint_as_float(rr[0]) * __uint_as_float(rr[1]); }
#pragma unroll
  for (int r = 0; r < 4; ++r) {
    pz[r] = pz[r] * l[r] * off0; pz[4 + r] = pz[4 + r] * l[4 + r] * off1;
    pz[8 + r] = pz[8 + r] * l[8 + r] * off2; pz[12 + r] = pz[12 + r] * l[12 + r] * off3;
  }
  run *= tot;
}

__device__ __forceinline__ void attn_phase(const Params& p, char* smem, int bid, int nblk) {
  const int tid = otid(), wid = tid >> 6, lane = tid & 63, r32 = lane & 31, hi = lane >> 5;
  char* K_lds0 = smem; char* V_lds0 = smem + 16384;
  const u16* qkv = (const u16*)(p.ws + OFF_PROJ);
  u16* ao = (u16*)(p.ws + OFF_HN);
  const int sr = tid >> 4, sc = (tid & 15) * 8;
  const int vb00 = (int)(uintptr_t)V_lds0 + v_rd_base(lane);
  for (int k = 0; k * nblk < 2048; ++k) {
    const int i = (k & 1) ? ((k + 1) * nblk - 1 - bid) : (k * nblk + bid);
    if (i >= 2048) continue;
    const int j = 63 - (i >> 5), bh = i & 31, b = bh >> 3, h = bh & 7;
    const int i0 = j * 128;
    const size_t rowb = (size_t)b * SEQ;
    const int t = i0 + wid * 32 + r32, tmin = i0 + wid * 32, tmax = tmin + 31;
    bf16x8 qr[8];
    {
      const u16* qp = qkv + (rowb + t) * 3072 + h * 128 + hi * 8;
#pragma unroll
      for (int d0 = 0; d0 < 8; ++d0) qr[d0] = *(const bf16x8*)(qp + d0 * 16);
    }
    f32x16 o[4];
#pragma unroll
    for (int d = 0; d < 4; ++d)
#pragma unroll
      for (int r = 0; r < 16; ++r) o[d][r] = 0.f;
    float run = 1.f;
    const u16* kbase = qkv + rowb * 3072 + 1024 + h * 128 + sc;
    u32x4 stk[4], stv[4];
#define SLOAD(KT) do { _Pragma("unroll") for (int ii = 0; ii < 4; ++ii) { const u16* kp = kbase + (size_t)((KT) * 64 + sr + 16 * ii) * 3072; \
      stk[ii] = *(const u32x4*)kp; stv[ii] = *(const u32x4*)(kp + 1024); } } while (0)
#define SWRITE(B) do { _Pragma("unroll") for (int ii = 0; ii < 4; ++ii) { const int row = sr + 16 * ii; \
      *(u32x4*)(K_lds0 + (B) * 32768 + KSWZ(row, sc * 2)) = stk[ii]; *(u32x4*)(V_lds0 + (B) * 32768 + v_st(row, sc)) = stv[ii]; } } while (0)
    const int NT = 2 * j + 2;
    __syncthreads();
    SLOAD(NT - 1); SWRITE(0); __syncthreads();
    int cur = 0;
    for (int kt = NT - 1; kt >= 0; --kt) {
      const int k0 = kt * 64;
      const char* K_lds = K_lds0 + cur * 32768; const int vb0 = vb00 + cur * 32768;
      if (kt > 0) SLOAD(kt - 1);
      if (k0 <= tmax) {
        bf16x8 pa0, pa1, pa2, pa3;
#define PK4(P, BASE, OUT) do { unsigned a0 = cvtpk(P[BASE + 0], P[BASE + 1]), a1 = cvtpk(P[BASE + 2], P[BASE + 3]); \
    unsigned b0_ = cvtpk(P[BASE + 4], P[BASE + 5]), b1_ = cvtpk(P[BASE + 6], P[BASE + 7]); \
    auto r0 = __builtin_amdgcn_permlane32_swap(a0, b0_, false, false); auto r1 = __builtin_amdgcn_permlane32_swap(a1, b1_, false, false); \
    u32x4 w = {r0[0], r1[0], r0[1], r1[1]}; OUT = *reinterpret_cast<bf16x8*>(&w); } while (0)
        if (k0 + 32 <= tmax) {
          f32x16 pz;
#pragma unroll
          for (int r = 0; r < 16; ++r) pz[r] = 0.f;
#pragma unroll
          for (int d0 = 0; d0 < 8; ++d0) {
            const bf16x8 kf = *(const bf16x8*)(K_lds + KSWZ(32 + r32, (d0 * 16 + hi * 8) * 2));
            pz = __builtin_amdgcn_mfma_f32_32x32x16_bf16(kf, qr[d0], pz, 0, 0, 0);
          }
          sb_half(pz, run, k0 + 63 >= tmin, k0 + 32, t, hi);
          PK4(pz, 0, pa2); PK4(pz, 8, pa3);
        } else {
          pa2 = bf16x8{0, 0, 0, 0, 0, 0, 0, 0}; pa3 = pa2;
        }
        {
          f32x16 pz;
#pragma unroll
          for (int r = 0; r < 16; ++r) pz[r] = 0.f;
#pragma unroll
          for (int d0 = 0; d0 < 8; ++d0) {
            const bf16x8 kf = *(const bf16x8*)(K_lds + KSWZ(r32, (d0 * 16 + hi * 8) * 2));
            pz = __builtin_amdgcn_mfma_f32_32x32x16_bf16(kf, qr[d0], pz, 0, 0, 0);
          }
          sb_half(pz, run, k0 + 31 >= tmin, k0, t, hi);
          PK4(pz, 0, pa0); PK4(pz, 8, pa1);
        }
#undef PK4
        pv_one<0>(o[0], vb0, pa0, pa1, pa2, pa3); pv_one<1>(o[1], vb0, pa0, pa1, pa2, pa3);
        pv_one<2>(o[2], vb0, pa0, pa1, pa2, pa3); pv_one<3>(o[3], vb0, pa0, pa1, pa2, pa3);
      }
      if (kt > 0) SWRITE(cur ^ 1);
      __syncthreads();
      cur ^= 1;
    }
#undef SLOAD
#undef SWRITE
    {
      const int orow0 = (int)rowb + i0 + wid * 32;
#pragma unroll
      for (int r = 0; r < 16; ++r) {
        const int orow = crow(r, hi);
#pragma unroll
        for (int d0 = 0; d0 < 4; ++d0) ao[a_off(orow0 + orow, h * 128 + d0 * 32 + r32, 32)] = f2bf(o[d0][r]);
      }
    }
  }
}

#define XB_TMO      128
#define XB_XCNT(j)  (256  + 64 * (j))
#define XB_XSUB(j)  (1280 + 64 * (j))
#define XB_XGEN(j)  (2304 + 64 * (j))
#define XB_TOP      3328
#define XB_TOPGEN   3392
#define XCD_BAR_WORDS 3456
#define XB_SPIN_CAP (1u << 23)
#define LAS __attribute__((address_space(3)))
__device__ __forceinline__ unsigned xb_ld(unsigned* p)              { return __hip_atomic_load(p, __ATOMIC_RELAXED, __HIP_MEMORY_SCOPE_AGENT); }
__device__ __forceinline__ unsigned xb_add(unsigned* p, unsigned v) { return __hip_atomic_fetch_add(p, v, __ATOMIC_RELAXED, __HIP_MEMORY_SCOPE_AGENT); }
__device__ __forceinline__ unsigned xb_xcc_id() { return (unsigned)__builtin_amdgcn_s_getreg((3 << 11) | 20) & 0xFu; }
#define XB_SPIN(cond, bar) do { unsigned _sp = 0; while (cond) { __builtin_amdgcn_s_sleep(1); \
    if ((++_sp & 255u) == 0u) { if (xb_ld(&(bar)[XB_TMO])) break; if (_sp > XB_SPIN_CAP) { atomicAdd(&(bar)[XB_TMO], 1u); break; } } } } while (0)
struct XcdBarrier { unsigned* bar; unsigned x; volatile LAS unsigned* st; };
__device__ __forceinline__ XcdBarrier xcd_barrier_post(unsigned* bar, volatile LAS unsigned* st) {
  XcdBarrier b; b.bar = bar; b.x = xb_xcc_id(); b.st = st;
  if (__builtin_amdgcn_workitem_id_x() == 0) (void)xb_add(&bar[XB_XCNT(b.x)], 1u);
  return b;
}
__device__ __forceinline__ void xcd_barrier_complete(unsigned* bar, unsigned x, unsigned& nloc, unsigned& nx) {
  const unsigned G = gridDim.x * gridDim.y * gridDim.z;
  unsigned sum, cnt, mine, sp = 0u;
  for (;;) {
    sum = 0u; cnt = 0u; mine = 0u;
#pragma unroll
    for (unsigned j = 0; j < 16; ++j) { const unsigned c = xb_ld(&bar[XB_XCNT(j)]); sum += c; cnt += (c > 0u) ? 1u : 0u; mine = (j == x) ? c : mine; }
    if (sum == G) break;
    __builtin_amdgcn_s_sleep(1);
    if ((++sp & 255u) == 0u) { if (xb_ld(&bar[XB_TMO])) break; if (sp > XB_SPIN_CAP) { atomicAdd(&bar[XB_TMO], 1u); break; } }
  }
  nloc = mine > 0u ? mine : 1u; nx = cnt > 0u ? cnt : 1u;
}
__device__ __forceinline__ void xcd_barrier(const XcdBarrier& b) {
  asm volatile("s_waitcnt vmcnt(0)" ::: "memory");
  __syncthreads();
  if (__builtin_amdgcn_workitem_id_x() == 0) {
    unsigned* bar = b.bar;
    __builtin_amdgcn_s_waitcnt(0);
    unsigned nloc = b.st[0], nx = b.st[1];
    if (nloc == 0u) { xcd_barrier_complete(bar, b.x, nloc, nx); b.st[0] = nloc; b.st[1] = nx; }
    const unsigned old = xb_add(&bar[XB_XSUB(b.x)], 1u);
    const unsigned gen = old / nloc;
    if (old + 1u == (gen + 1u) * nloc) {
      __builtin_amdgcn_fence(__ATOMIC_RELEASE, "agent");
      asm volatile("s_waitcnt vmcnt(0)" ::: "memory");
      const unsigned og = xb_add(&bar[XB_TOP], 1u);
      const unsigned tg = og / nx;
      if (og + 1u == (tg + 1u) * nx) xb_add(&bar[XB_TOPGEN], 1u);
      else XB_SPIN(xb_ld(&bar[XB_TOPGEN]) == tg, bar);
      __builtin_amdgcn_fence(__ATOMIC_ACQUIRE, "agent");
      xb_add(&bar[XB_XGEN(b.x)], 1u);
      asm volatile("s_waitcnt vmcnt(0)" ::: "memory");
    } else {
      XB_SPIN(xb_ld(&bar[XB_XGEN(b.x)]) == gen, bar);
      __builtin_amdgcn_fence(__ATOMIC_ACQUIRE, "agent");
      asm volatile("s_waitcnt vmcnt(0)" ::: "memory");
    }
  }
  __syncthreads();
}

__global__ void __launch_bounds__(256, 2) mega(Params p) {
  __shared__ __attribute__((aligned(16))) char smem[SMEM_BYTES];
  __shared__ uint4 xb_words;
  const int bid = blockIdx.x, nblk = gridDim.x;
  char* ws = p.ws;
  if (__builtin_amdgcn_workitem_id_x() == 0) xb_words = make_uint4(0u, 0u, 0u, 0u);
  __syncthreads();
  const XcdBarrier xbar = xcd_barrier_post((unsigned*)(ws + OFF_BAR), (volatile LAS unsigned*)&xb_words);
  const float* mod = (const float*)(ws + OFF_MOD);
  u16* hn = (u16*)(ws + OFF_HN);
#define PH_BEGIN(n) if (p.phase_lo <= (n) && (n) < p.phase_hi) {
#define PH_END(n) if ((n) + 1 < p.phase_hi) { if ((n) == 0) cg::this_grid().sync(); else xcd_barrier(xbar); } }
  PH_BEGIN(0) phase0(p, smem, bid, nblk); PH_END(0)
  PH_BEGIN(1) norm_phase<1>(p, p.x, p.norm_mix_w, mod, 0, 1024, smem, bid, nblk); PH_END(1)
  PH_BEGIN(2) { EpiArgs ea{}; ea.outb = (u16*)(ws + OFF_PROJ); ea.ux = (u16*)(ws + OFF_UX);
        gemm_phase<E_PROJ0>(hn, 32, 0, (const u16*)(ws + OFF_WT_HYIN), 32, 0, 1024, M / 256, PN / 128, 1, ea, smem, bid, nblk); } PH_END(2)
  PH_BEGIN(3) { EpiArgs ea{}; ea.outf = (float*)(ws + OFF_XE);
        gemm_phase<E_XE>((const u16*)(ws + OFF_UX), 20, (size_t)S5C * UXW, (const u16*)(ws + OFF_EG), 16, (size_t)128 * 512, 512, S5C / 256, 1, 32, ea, smem, bid, nblk); } PH_END(3)
  PH_BEGIN(4) { s5_carry_phase(p, bid, nblk); gdn_prep_phase(p, smem, bid, nblk); } PH_END(4)
  PH_BEGIN(5) {
        if (bid < 16) { gdn_scan_item(p, bid, smem); }
        else { EpiArgs ea{}; ea.outb = (u16*)(ws + OFF_Y5); ea.ux = (u16*)(ws + OFF_UX); ea.bias = p.s5_d;
          gemm_phase<E_S5Y>((const u16*)(ws + OFF_UX), 20, (size_t)S5C * UXW, (const u16*)(ws + OFF_MF), 20, (size_t)512 * UXW, UXW, S5C / 256, 4, 32, ea, smem, bid - 16, nblk - 16);
          __syncthreads();
          transpose_items(p, smem, bid - 16, nblk - 16, N_TR_FIRST, N_TR_ITEMS); }
      } PH_END(5)
  PH_BEGIN(6) { gdn_out_phase(p, smem, bid, nblk); __syncthreads();
 EpiArgs ea{}; ea.outb = hn; ea.y5 = (const u16*)(ws + OFF_Y5); ea.bias = p.s5_glu_b;
        gemm_phase<E_GLU>((const u16*)(ws + OFF_Y5), 16, 0, (const u16*)(ws + OFF_WT_GLU), 16, 0, 512, M / 256, 4, 1, ea, smem, bid, nblk); } PH_END(6)
  PH_BEGIN(8) { EpiArgs ea{}; ea.outf = p.out; ea.res = p.x; ea.gate = mod + 2048;
        gemm_phase<E_RESID>(hn, 32, 0, (const u16*)(ws + OFF_WT_HYOUT), 32, 0, 1024, M / 256, 8, 1, ea, smem, bid, nblk); } PH_END(8)
  PH_BEGIN(9) norm_phase<0>(p, p.out, p.norm_ffn_w, mod, 3072, 4096, smem, bid, nblk); PH_END(9)
  PH_BEGIN(10) { EpiArgs ea{}; ea.outb = (u16*)(ws + OFF_PROJ);
        gemm_phase<E_SWIGLU>(hn, 32, 0, (const u16*)(ws + OFF_WT_FFNIN), 32, 0, 1024, M / 256, 2 * FF / 128, 1, ea, smem, bid, nblk); } PH_END(10)
  PH_BEGIN(11) { EpiArgs ea{}; ea.outf = p.out; ea.res = p.out; ea.gate = mod + 5120;
        gemm_phase<E_RESID>((const u16*)(ws + OFF_PROJ), FF / 32, 0, (const u16*)(ws + OFF_WT_FFNOUT), FF / 32, 0, FF, M / 256, 8, 1, ea, smem, bid, nblk); } PH_END(11)
  PH_BEGIN(12) norm_phase<0>(p, p.out, p.norm_mix_w + 1024, mod + 4 * 6144, 0, 1024, smem, bid, nblk); PH_END(12)
  PH_BEGIN(13) { EpiArgs ea{}; ea.outb = (u16*)(ws + OFF_PROJ); ea.ldc = 3072;
        gemm_phase<E_BF16>(hn, 32, 0, (const u16*)(ws + OFF_WT_SBIN), 32, 0, 1024, M / 256, 24, 1, ea, smem, bid, nblk); } PH_END(13)
  PH_BEGIN(14) attn_phase(p, smem, bid, nblk); PH_END(14)
  PH_BEGIN(15) { EpiArgs ea{}; ea.outf = p.out; ea.res = p.out; ea.gate = mod + 4 * 6144 + 2048;
        gemm_phase<E_RESID>(hn, 32, 0, (const u16*)(ws + OFF_WT_SBOUT), 32, 0, 1024, M / 256, 8, 1, ea, smem, bid, nblk); } PH_END(15)
  PH_BEGIN(16) norm_phase<0>(p, p.out, p.norm_ffn_w + 1024, mod + 4 * 6144, 3072, 4096, smem, bid, nblk); PH_END(16)
  PH_BEGIN(17) { EpiArgs ea{}; ea.outb = (u16*)(ws + OFF_PROJ);
        gemm_phase<E_SWIGLU>(hn, 32, 0, (const u16*)(ws + OFF_WT_FFNIN + SZ_WT_FFNIN), 32, 0, 1024, M / 256, 2 * FF / 128, 1, ea, smem, bid, nblk); } PH_END(17)
  PH_BEGIN(18) { EpiArgs ea{}; ea.outf = p.out; ea.res = p.out; ea.gate = mod + 4 * 6144 + 5120;
        gemm_phase<E_RESID>((const u16*)(ws + OFF_PROJ), FF / 32, 0, (const u16*)(ws + OFF_WT_FFNOUT + SZ_WT_FFNOUT), FF / 32, 0, FF, M / 256, 8, 1, ea, smem, bid, nblk); } PH_END(18)
  PH_BEGIN(19) norm_phase<2>(p, p.out, p.final_norm_w, mod, 0, 0, smem, bid, nblk); PH_END(19)
}

extern "C" void kernel_launch(void* const* d_in, const int* in_sizes, int n_in, void* d_out, int out_size, void* d_ws, size_t ws_size,
                              hipStream_t stream) {
  static int grid_blocks = 0;
  if (!grid_blocks) {
    int dev = 0, cus = 0, per_cu = 0;
    hipGetDevice(&dev);
    hipDeviceGetAttribute(&cus, hipDeviceAttributeMultiprocessorCount, dev);
    hipOccupancyMaxActiveBlocksPerMultiprocessor(&per_cu, mega, 256, 0);
    if (per_cu > 2) per_cu = 2;
    if (per_cu < 1) per_cu = 1;
    grid_blocks = cus * per_cu;
  }
  Params p{};
  const float* const* in = (const float* const*)d_in;
  p.x = in[0]; p.c = in[1]; p.ada_w = in[2]; p.ada_b = in[3]; p.norm_mix_w = in[4]; p.norm_ffn_w = in[5]; p.ffn_w_in = in[6]; p.ffn_w_out = in[7];
  p.hy_w_in = in[8]; p.hy_conv_w = in[9]; p.hy_a_log = in[10]; p.hy_dt_bias = in[11]; p.hy_head_norm_w = in[12];
  p.s5_lam_re = in[13]; p.s5_lam_im = in[14]; p.s5_log_dt = in[15]; p.s5_b_re = in[16]; p.s5_b_im = in[17]; p.s5_c_re = in[18]; p.s5_c_im = in[19];
  p.s5_d = in[20]; p.s5_glu_w = in[21]; p.s5_glu_b = in[22]; p.hy_w_out = in[23]; p.sb_w_in = in[24]; p.sb_w_out = in[25]; p.final_norm_w = in[26];
  p.out = (float*)d_out; p.ws = (char*)d_ws;
#if ONE_LAUNCH
  p.phase_lo = 0; p.phase_hi = NPHASE;
  (void)hipMemsetAsync((char*)d_ws + OFF_BAR, 0, (size_t)XCD_BAR_WORDS_C * 4, stream);
  void* args[] = {&p};
  hipError_t e = hipLaunchCooperativeKernel((void*)mega, dim3(grid_blocks), dim3(256), args, 0, stream);
  if (e != hipSuccess) fprintf(stderr, "cooperative launch failed: %s (grid %d)\n", hipGetErrorString(e), grid_blocks);
#else
  for (int ph = 0; ph < NPHASE; ++ph) {
    p.phase_lo = ph; p.phase_hi = ph + 1;
    hipLaunchKernelGGL(mega, dim3(grid_blocks), dim3(256), 0, stream, p);
  }
#endif
}
```
